# Optimizing an MI355X kernel written in HIP

```python
import jax, jax.numpy as jnp
from jax import lax
import numpy as np

D_MODEL = 1024
BATCH = 8
SEQ = 2048
DEPTH = 2

GRID_W = 64
CTX_LEN = 256
N_MIXERS = 2
N_POOL_LAYERS = (DEPTH + 1) // 2
N_DELTA_LAYERS = DEPTH // 2
NORM_EPS = 1e-6
POOL_WINDOWS = (2, 4, 8, 16)
N_POOL_GROUPS = 4
POOL_GROUP = D_MODEL // N_POOL_GROUPS
DN_HEADS = 8
DN_HEAD_DIM = D_MODEL // DN_HEADS
DN_CONV = 5
DN_CHUNK = 64
PEER_HEADS = 8
PEER_KEY_DIM = 256
PEER_N_KEYS = 128
PEER_N_EXPERTS = PEER_N_KEYS ** 2
PEER_TOPK = 16
PEER_BLOCK = 128

kernel_name = "hybrid_pool_deltanet_peer_dit"


def rmsnorm(h, gain):
    hf = h.astype(jnp.float32)
    y = hf * lax.rsqrt(jnp.mean(hf * hf, axis=-1, keepdims=True) + NORM_EPS)
    return (y * gain.astype(jnp.float32)).astype(h.dtype)


def modulate(h, gain, shift, scale):
    return rmsnorm(h, gain) * (1.0 + scale) + shift


def box_mean(u, axis, w):
    n = u.shape[axis]
    cs = jnp.cumsum(u, axis=axis)
    cs = jnp.concatenate([jnp.zeros_like(lax.slice_in_dim(cs, 0, 1, axis=axis)), cs], axis=axis)
    t = jnp.arange(n)
    lo = jnp.clip(t - w // 2, 0, n)
    hi = jnp.clip(t - w // 2 + w, 0, n)
    s = jnp.take(cs, hi, axis=axis) - jnp.take(cs, lo, axis=axis)
    shape = [1] * u.ndim
    shape[axis] = n
    return s / (hi - lo).astype(u.dtype).reshape(shape)


def pool_mixer(h, w_groups, scale, on_grid):
    B, L, D = h.shape
    hf = h.astype(jnp.float32).reshape(B, L, N_POOL_GROUPS, POOL_GROUP)
    if on_grid:
        rows = L // GRID_W
        hf = hf.reshape(B, rows, GRID_W, N_POOL_GROUPS, POOL_GROUP)
    groups = []
    for gi, w in enumerate(POOL_WINDOWS):
        xg = hf[..., gi, :]
        pooled = box_mean(box_mean(xg, 1, w), 2, w) if on_grid else box_mean(xg, 1, w)
        groups.append(pooled - xg)
    p = jnp.stack(groups, axis=-2).reshape(B, L, N_POOL_GROUPS, POOL_GROUP).astype(h.dtype)
    y = jnp.einsum('blgi,gio->blgo', p, w_groups).reshape(B, L, D)
    return y * scale


def short_conv(u, w):
    ch = u.shape[-1]
    y = lax.conv_general_dilated(u, w[:, None, :].astype(u.dtype), window_strides=(1,),
                                 padding=[(DN_CONV // 2, DN_CONV // 2)],
                                 dimension_numbers=('NWC', 'WIO', 'NWC'), feature_group_count=ch)
    return jax.nn.silu(y)


def l2norm(u):
    return u * lax.rsqrt(jnp.sum(u * u, axis=-1, keepdims=True) + NORM_EPS)


def dn_project(h, w_in, conv_w, a_log, dt_bias):
    B, L, D = h.shape
    p = h @ w_in
    qkv = short_conv(p[..., :3 * D], conv_w).astype(jnp.float32)
    qkv = qkv.reshape(B, L, 3, DN_HEADS, DN_HEAD_DIM).transpose(2, 0, 3, 1, 4)
    q = l2norm(qkv[0]) * (DN_HEAD_DIM ** -0.5)
    k = l2norm(qkv[1])
    v = qkv[2]
    z = p[..., 3 * D:4 * D]
    ab = p[..., 4 * D:].astype(jnp.float32).reshape(B, L, 2, 2, DN_HEADS).transpose(2, 3, 0, 4, 1)
    g = -jnp.exp(a_log.astype(jnp.float32))[:, None, :, None] * jax.nn.softplus(
        ab[:, 0] + dt_bias.astype(jnp.float32)[:, None, :, None])
    beta = jax.nn.sigmoid(ab[:, 1])
    return q, k, v, z, g, beta


def gated_delta_chunk(q, k, v, beta, g, s0, with_output):
    B, H, L, dk = q.shape
    dv = v.shape[-1]
    n = L // DN_CHUNK
    q = q.reshape(B, H, n, DN_CHUNK, dk)
    k = k.reshape(B, H, n, DN_CHUNK, dk)
    v = v.reshape(B, H, n, DN_CHUNK, dv)
    beta = beta.reshape(B, H, n, DN_CHUNK)
    g = jnp.cumsum(g.reshape(B, H, n, DN_CHUNK), axis=-1)
    kb = k * beta[..., None]
    vb = v * beta[..., None]
    idx = jnp.arange(DN_CHUNK)
    incl = idx[:, None] >= idx[None, :]
    strict = idx[:, None] > idx[None, :]
    decay = jnp.exp(jnp.where(incl, g[..., :, None] - g[..., None, :], -jnp.inf))
    a = jnp.where(strict, jnp.einsum('bhnid,bhnjd->bhnij', kb, k) * decay, 0.0)
    eye = jnp.eye(DN_CHUNK, dtype=q.dtype)
    t_inv = lax.linalg.triangular_solve(eye + a, jnp.broadcast_to(eye, a.shape), left_side=True,
                                        lower=True, unit_diagonal=True)
    u = t_inv @ vb
    w = t_inv @ (kb * jnp.exp(g)[..., None])
    kg = k * jnp.exp(g[..., -1:] - g)[..., None]
    glast = jnp.exp(g[..., -1])
    seq_first = lambda t: jnp.moveaxis(t, 2, 0)
    if with_output:
        attn = jnp.einsum('bhnid,bhnjd->bhnij', q, k) * decay
        qg = q * jnp.exp(g)[..., None]
        xs = tuple(seq_first(t) for t in (kg, u, w, glast, qg, attn))
    else:
        xs = tuple(seq_first(t) for t in (kg, u, w, glast))

    def step(s, inp):
        kg_i, u_i, w_i, gl_i = inp[:4]
        v_new = u_i - w_i @ s
        s_new = s * gl_i[..., None, None] + jnp.swapaxes(kg_i, -1, -2) @ v_new
        if with_output:
            qg_i, attn_i = inp[4:]
            return s_new, qg_i @ s + attn_i @ v_new
        return s_new, None

    s_fin, o = lax.scan(step, s0, xs)
    if with_output:
        o = jnp.moveaxis(o, 0, 2).reshape(B, H, L, dv)
    return o, s_fin


def dn_output(o, z, norm_g, w_out):
    B, H, L, dh = o.shape
    o = o.transpose(0, 2, 1, 3)
    o = o * lax.rsqrt(jnp.mean(o * o, axis=-1, keepdims=True) + NORM_EPS) * norm_g.astype(jnp.float32)
    o = o * jax.nn.silu(z.astype(jnp.float32).reshape(B, L, H, dh))
    return o.reshape(B, L, H * dh).astype(z.dtype) @ w_out


def delta_mixer(hx, hc, w_in, conv_w, a_log, dt_bias, norm_g, w_out, ctx_out):
    qx, kx, vx, zx, gx, bx = dn_project(hx, w_in, conv_w, a_log, dt_bias)
    qc, kc, vc, zc, gc, bc = dn_project(hc, w_in, conv_w, a_log, dt_bias)
    B = hx.shape[0]
    s0 = jnp.zeros((B, DN_HEADS, DN_HEAD_DIM, DN_HEAD_DIM), jnp.float32)
    flip = lambda t: jnp.flip(t, axis=2)
    oc_f, sc_f = gated_delta_chunk(qc, kc, vc, bc[0], gc[0], s0, ctx_out)
    ox_f, _ = gated_delta_chunk(qx, kx, vx, bx[0], gx[0], sc_f, True)
    oc_b, sc_b = gated_delta_chunk(flip(qc), flip(kc), flip(vc), flip(bc[1]), flip(gc[1]), s0, ctx_out)
    ox_b, _ = gated_delta_chunk(flip(qx), flip(kx), flip(vx), flip(bx[1]), flip(gx[1]), sc_b, True)
    yx = dn_output(ox_f + flip(ox_b), zx, norm_g, w_out)
    yc = dn_output(oc_f + flip(oc_b), zc, norm_g, w_out) if ctx_out else None
    return yx, yc


def peer(h, wq, keys, u_tab, v_tab):
    B, L, D = h.shape
    T = B * L
    hf = h.reshape(T, D)
    q = (hf @ wq).reshape(T, PEER_HEADS, 2, PEER_KEY_DIM // 2)
    s = jnp.einsum('thpd,hpkd->thpk', q, keys).astype(jnp.float32)
    s1, i1 = lax.top_k(s[:, :, 0], PEER_TOPK)
    s2, i2 = lax.top_k(s[:, :, 1], PEER_TOPK)
    cand = (s1[..., :, None] + s2[..., None, :]).reshape(T, PEER_HEADS, PEER_TOPK * PEER_TOPK)
    cidx = (i1[..., :, None] * PEER_N_KEYS + i2[..., None, :]).reshape(T, PEER_HEADS, PEER_TOPK * PEER_TOPK)
    sc, pos = lax.top_k(cand, PEER_TOPK)
    nb = T // PEER_BLOCK
    eidx = jnp.take_along_axis(cidx, pos, axis=-1).reshape(nb, PEER_BLOCK, PEER_HEADS * PEER_TOPK)
    gate = jax.nn.softmax(sc, axis=-1).astype(h.dtype).reshape(nb, PEER_BLOCK, PEER_HEADS * PEER_TOPK)
    xb = hf.reshape(nb, PEER_BLOCK, D)

    def block(args):
        xt, et, gt = args
        act = jax.nn.gelu(jnp.einsum('td,ted->te', xt, jnp.take(u_tab, et, axis=0)), approximate=False)
        return jnp.einsum('te,ted->td', gt * act, jnp.take(v_tab, et, axis=0))

    y = lax.map(block, (xb, eidx, gate))
    return y.reshape(B, L, D)


def setup_inputs(seed: int = 0) -> dict:
    key = jax.random.key(seed)
    ks = jax.random.split(key, 24)
    D = D_MODEL
    f32 = jnp.float32
    nrm = lambda k, shape, s: jax.random.normal(k, shape, f32) * s
    dt = jnp.exp(jax.random.uniform(ks[13], (N_DELTA_LAYERS, 2, DN_HEADS), f32,
                                    minval=float(np.log(1e-3)), maxval=float(np.log(1e-1))))
    return {
        "x": nrm(ks[0], (BATCH, SEQ, D), 1.0),
        "c": nrm(ks[1], (BATCH, D), 1.0),
        "ctx": nrm(ks[2], (BATCH, CTX_LEN, D), 1.0),
        "c_ctx": nrm(ks[3], (D,), 1.0),
        "mod_w": nrm(ks[4], (DEPTH, D, 6 * D), 0.5 * D ** -0.5),
        "mod_b": nrm(ks[5], (DEPTH, 6 * D), 0.02),
        "norm1_g": 1.0 + nrm(ks[6], (DEPTH, D), 0.02),
        "norm2_g": 1.0 + nrm(ks[7], (DEPTH, D), 0.02),
        "pool_w": nrm(ks[8], (N_POOL_LAYERS, N_POOL_GROUPS, POOL_GROUP, POOL_GROUP), POOL_GROUP ** -0.5),
        "pool_scale": 1.0 + nrm(ks[9], (N_POOL_LAYERS, D), 0.1),
        "dn_w_in": nrm(ks[10], (N_DELTA_LAYERS, D, 4 * D + 4 * DN_HEADS), D ** -0.5),
        "dn_conv_w": nrm(ks[11], (N_DELTA_LAYERS, DN_CONV, 3 * D), DN_CONV ** -0.5),
        "dn_a_log": jnp.log(jax.random.uniform(ks[12], (N_DELTA_LAYERS, 2, DN_HEADS), f32, minval=1.0, maxval=16.0)),
        "dn_dt_bias": dt + jnp.log(-jnp.expm1(-dt)),
        "dn_norm_g": 1.0 + nrm(ks[14], (N_DELTA_LAYERS, DN_HEAD_DIM), 0.02),
        "dn_w_out": nrm(ks[15], (N_DELTA_LAYERS, D, D), D ** -0.5),
        "peer_wq": nrm(ks[16], (DEPTH, D, PEER_HEADS * PEER_KEY_DIM), D ** -0.5),
        "peer_keys": nrm(ks[17], (DEPTH, PEER_HEADS, 2, PEER_N_KEYS, PEER_KEY_DIM // 2), (PEER_KEY_DIM // 2) ** -0.5),
        "peer_u": nrm(ks[18], (DEPTH, PEER_N_EXPERTS, D), D ** -0.5),
        "peer_v": nrm(ks[19], (DEPTH, PEER_N_EXPERTS, D), 0.5),
        "final_g": 1.0 + nrm(ks[20], (D,), 0.02),
    }


def reference(x, c, ctx, c_ctx, mod_w, mod_b, norm1_g, norm2_g, pool_w, pool_scale,
              dn_w_in, dn_conv_w, dn_a_log, dn_dt_bias, dn_norm_g, dn_w_out,
              peer_wq, peer_keys, peer_u, peer_v, final_g):
    hx, hc = x, ctx
    for i in range(DEPTH):
        last = i == DEPTH - 1
        is_pool = (i % N_MIXERS) == 0
        j = i // N_MIXERS
        mx = [m[:, None, :] for m in jnp.split(jax.nn.silu(c) @ mod_w[i] + mod_b[i], 6, axis=-1)]
        need_ctx = (not last) or (not is_pool)
        if need_ctx:
            mc = jnp.split(jax.nn.silu(c_ctx) @ mod_w[i] + mod_b[i], 6, axis=-1)
        ax = modulate(hx, norm1_g[i], mx[0], mx[1])
        if is_pool:
            hx = hx + mx[2] * pool_mixer(ax, pool_w[j], pool_scale[j], True)
            if not last:
                ac = modulate(hc, norm1_g[i], mc[0], mc[1])
                hc = hc + mc[2] * pool_mixer(ac, pool_w[j], pool_scale[j], False)
        else:
            ac = modulate(hc, norm1_g[i], mc[0], mc[1])
            yx, yc = delta_mixer(ax, ac, dn_w_in[j], dn_conv_w[j], dn_a_log[j], dn_dt_bias[j],
                                 dn_norm_g[j], dn_w_out[j], not last)
            hx = hx + mx[2] * yx
            if not last:
                hc = hc + mc[2] * yc
        hx = hx + mx[5] * peer(modulate(hx, norm2_g[i], mx[3], mx[4]),
                               peer_wq[i], peer_keys[i], peer_u[i], peer_v[i])
        if not last:
            hc = hc + mc[5] * peer(modulate(hc, norm2_g[i], mc[3], mc[4]),
                                   peer_wq[i], peer_keys[i], peer_u[i], peer_v[i])
    return rmsnorm(hx, final_g)
```

```cpp
#include <hip/hip_runtime.h>
#include <hip/hip_cooperative_groups.h>
#include <cstdio>
#include <cstdint>
namespace cg = cooperative_groups;

#define DEV __device__ __forceinline__
typedef unsigned short bf16_t;
typedef short bf16x8 __attribute__((ext_vector_type(8)));
typedef float f32x4 __attribute__((ext_vector_type(4)));
typedef float f32x16 __attribute__((ext_vector_type(16)));
typedef unsigned u32x4 __attribute__((ext_vector_type(4)));
typedef unsigned u32x2 __attribute__((ext_vector_type(2)));
#define LAS __attribute__((address_space(3)))
typedef LAS unsigned char* ldsp;
DEV int tid_fresh() { int t = threadIdx.x; asm volatile("" : "+v"(t)); return t; }
DEV ldsp launder(ldsp p) { asm volatile("" : "+v"(p)); return p; }

constexpr int D = 1024, NB = 8, SEQ = 2048, CTX = 256;
constexpr int NX = NB * SEQ, NC = NB * CTX, NT = NX + NC;
constexpr int NTHREADS = 512;
constexpr float EPS = 1e-6f;
#ifndef REP_PREP
#define REP_PREP 1
#endif
#ifndef REP_MOD
#define REP_MOD 1
#endif
#ifndef REP_POOL
#define REP_POOL 1
#endif
#ifndef REP_GEMM
#define REP_GEMM 1
#endif
#ifndef REP_TOPK
#define REP_TOPK 1
#endif
#ifndef REP_CONV
#define REP_CONV 1
#endif
#ifndef REP_CHUNK
#define REP_CHUNK 1
#endif
#ifndef REP_SCAN
#define REP_SCAN 1
#endif
#ifndef REP_DNOUT
#define REP_DNOUT 1
#endif

constexpr size_t MiB = 1024 * 1024;
constexpr size_t TAB_ELEMS = (size_t)16384 * 1024;
constexpr size_t OFF_TAB   = 0;
constexpr size_t OFF_WQT   = 128 * MiB;
constexpr size_t OFF_WINT  = OFF_WQT + 8 * MiB;
constexpr size_t OFF_WOUTT = OFF_WINT + (size_t)4352 * 1024 * 2;
constexpr size_t OFF_POOLT = OFF_WOUTT + 2 * MiB;
constexpr size_t OFF_KEYS  = OFF_POOLT + 512 * 1024;
constexpr size_t OFF_MODV  = OFF_KEYS + 1 * MiB;
constexpr size_t OFF_HC    = OFF_MODV + 512 * 1024;
constexpr size_t OFF_SELI  = OFF_HC + 8 * MiB;
constexpr size_t OFF_SELG  = OFF_SELI + (size_t)NT * 128 * 4;
constexpr size_t OFF_AB    = OFF_SELG + (size_t)NT * 128 * 4;
constexpr size_t OFF_G     = OFF_AB + (size_t)NT * 32 * 4;
constexpr size_t OFF_BETA  = OFF_G + (size_t)2 * NT * 8 * 4;
constexpr size_t OFF_GC    = OFF_BETA + (size_t)2 * NT * 8 * 4;
constexpr size_t OFF_QC    = OFF_GC + (size_t)4608 * 64 * 4;
constexpr size_t OFF_KC    = OFF_QC + (size_t)NT * 1024 * 2;
constexpr size_t OFF_VC    = OFF_KC + (size_t)NT * 1024 * 2;
constexpr size_t OFF_A     = OFF_VC + (size_t)NT * 1024 * 2;
constexpr size_t OFF_R1    = OFF_A + (size_t)NT * 1024 * 2;
constexpr size_t OFF_PZ    = OFF_R1 + (size_t)NT * 3072 * 2;
constexpr size_t OFF_BAR   = OFF_R1 + (size_t)NT * 4096 * 2;
constexpr size_t OFF_H     = OFF_BAR + 16384;
constexpr size_t OFF_XS    = OFF_H + (size_t)NT * 1024 * 2;
constexpr size_t OFF_RSC   = OFF_XS + (size_t)NT * 4;
constexpr size_t WS_END    = OFF_RSC + (size_t)4 * 16384 * 4;
constexpr size_t OFF_WBUF  = OFF_A;
constexpr size_t OFF_UBUF  = OFF_A + (size_t)4608 * 8192 * 2;
constexpr size_t OFF_OBUF  = OFF_TAB + 64 * MiB;
constexpr size_t OFF_PART  = OFF_QC;
constexpr size_t OFF_WEXP  = OFF_QC + (size_t)8 * NT * 128 * 4;
constexpr size_t OFF_A8    = OFF_WEXP + (size_t)NT * 128 * 4;
static_assert(OFF_UBUF + (size_t)4608 * 8192 * 2 <= OFF_PZ, "w/u overlay must not reach Pz");
static_assert(OFF_A8 + (size_t)NT * 1024 <= OFF_A, "PEER partial buffers must fit the q/k/v conv region");

struct Params {
    const float *x, *c, *ctx, *c_ctx, *mod_w, *mod_b, *norm1_g, *norm2_g, *pool_w, *pool_scale;
    const float *dn_w_in, *dn_conv_w, *dn_a_log, *dn_dt_bias, *dn_norm_g, *dn_w_out;
    const float *peer_wq, *peer_keys, *peer_u, *peer_v, *final_g;
    float* out; unsigned char* ws;
};

DEV bf16_t f2bf(float f) { return __builtin_bit_cast(unsigned short, (__bf16)f); }
DEV float bf2f(bf16_t h) { return __uint_as_float(((unsigned)h) << 16); }
typedef float f32x2_t __attribute__((ext_vector_type(2)));
typedef __bf16 bf16x2_t __attribute__((ext_vector_type(2)));
DEV unsigned pk2(float a, float b) { const f32x2_t v = {a, b}; const bf16x2_t r = __builtin_convertvector(v, bf16x2_t); return __builtin_bit_cast(unsigned, r); }
DEV float bflo(unsigned u) { return __uint_as_float(u << 16); }
DEV float bfhi(unsigned u) { return __uint_as_float(u & 0xffff0000u); }
DEV float wave_sum(float v) {
#pragma unroll
    for (int o = 32; o >= 1; o >>= 1) v += __shfl_xor(v, o);
    return v;
}
DEV float wave_max(float v) {
#pragma unroll
    for (int o = 32; o >= 1; o >>= 1) v = fmaxf(v, __shfl_xor(v, o));
    return v;
}
DEV float sum16(float v) {
#pragma unroll
    for (int o = 8; o >= 1; o >>= 1) v += __shfl_xor(v, o);
    return v;
}
DEV f32x16 mfma32(bf16x8 a, bf16x8 b, f32x16 c) { return __builtin_amdgcn_mfma_f32_32x32x16_bf16(a, b, c, 0, 0, 0); }
DEV int crow(int reg, int lane) { return (reg & 3) + 8 * (reg >> 2) + 4 * (lane >> 5); }
DEV f32x16 zero16() { f32x16 z;
#pragma unroll
    for (int i = 0; i < 16; ++i) z[i] = 0.f; return z; }
DEV bf16_t* hrow(const Params& P, int r) { return (bf16_t*)(P.ws + OFF_H) + (size_t)r * 1024; }
DEV float silu(float v) { return v * __builtin_amdgcn_rcpf(1.f + __expf(-v)); }

DEV bf16x8 frag_row(const LAS bf16_t* m, int ld, int r0, int k0, int lane) {
    return *(const LAS bf16x8*)(m + (r0 + (lane & 31)) * ld + k0 + 8 * (lane >> 5));
}
DEV bf16x8 frag_col(const LAS bf16_t* m, int ld, int c0, int k0, int lane) {
    bf16x8 f;
#pragma unroll
    for (int j = 0; j < 8; ++j) f[j] = (short)m[(k0 + 8 * (lane >> 5) + j) * ld + c0 + (lane & 31)];
    return f;
}

typedef short s16x4 __attribute__((ext_vector_type(4)));
DEV s16x4 ds_tr16(ldsp p) { return __builtin_amdgcn_ds_read_tr16_b64_v4i16((LAS s16x4*)p); }
DEV bf16x8 frag_col_tr(const LAS bf16_t* m, int ld, int c0, int k0, int lane) {
    const int gi = lane >> 4, li = lane & 15, q = li >> 2, pc = li & 3, h = gi >> 1;
    const LAS bf16_t* p = m + (k0 + 8 * h + q) * ld + c0 + 16 * (gi & 1) + 4 * pc;
    const s16x4 lo = ds_tr16((ldsp)p), hi = ds_tr16((ldsp)(p + 4 * ld));
    bf16x8 f; f[0] = lo[0]; f[1] = lo[1]; f[2] = lo[2]; f[3] = lo[3]; f[4] = hi[0]; f[5] = hi[1]; f[6] = hi[2]; f[7] = hi[3];
    return f;
}
DEV void p0_convert_item(const float* src, bf16_t* dst, size_t base) {
    const int tid = tid_fresh();
#pragma unroll
    for (int it = 0; it < 8; ++it) {
        const size_t e = base + ((size_t)it * NTHREADS + tid) * 8;
        const f32x4 a = *(const f32x4*)(src + e), b = *(const f32x4*)(src + e + 4);
        u32x4 o; o.x = pk2(a.x, a.y); o.y = pk2(a.z, a.w); o.z = pk2(b.x, b.y); o.w = pk2(b.z, b.w);
        *(u32x4*)(dst + e) = o;
    }
}
DEV void p0_table_item(const float* src, unsigned char* dst, float* rscale, int row0, bool as_int8) {
    const int tid = tid_fresh(), wave = tid >> 6, lane = tid & 63;
#pragma unroll 8
    for (int rr = 0; rr < 16; ++rr) {
        const int e = row0 + wave * 16 + rr;
        f32x4 v[4]; float am = 0.f;
#pragma unroll
        for (int q = 0; q < 4; ++q) { v[q] = *(const f32x4*)(src + (size_t)e * 1024 + 256 * q + 4 * lane);
            am = fmaxf(am, fmaxf(fmaxf(fabsf(v[q].x), fabsf(v[q].y)), fmaxf(fabsf(v[q].z), fabsf(v[q].w)))); }
        am = wave_max(am);
        if (as_int8) {
            float ssq = 0.f;
#pragma unroll
            for (int q = 0; q < 4; ++q) ssq += v[q].x * v[q].x + v[q].y * v[q].y + v[q].z * v[q].z + v[q].w * v[q].w;
            ssq = wave_sum(ssq);
            const float top = fminf(am, 2.7f * sqrtf(ssq * (1.f / 1024.f)));
            am = top;
            const float sc = am > 0.f ? 7.f / am : 0.f;
#pragma unroll
            for (int q = 0; q < 4; ++q) {
                const int n0 = (int)fminf(fmaxf(rintf(v[q].x * sc), -7.f), 7.f) + 8, n1 = (int)fminf(fmaxf(rintf(v[q].y * sc), -7.f), 7.f) + 8;
                const int n2 = (int)fminf(fmaxf(rintf(v[q].z * sc), -7.f), 7.f) + 8, n3 = (int)fminf(fmaxf(rintf(v[q].w * sc), -7.f), 7.f) + 8;
                *(unsigned short*)(dst + ((size_t)q * 16384 + e) * 128 + 2 * lane) = (unsigned short)(n0 | (n1 << 4) | (n2 << 8) | (n3 << 12));
            }
            if (lane == 0) rscale[e] = am * (1.f / 7.f);
        } else {
            float ssq = 0.f;
#pragma unroll
            for (int q = 0; q < 4; ++q) ssq += v[q].x * v[q].x + v[q].y * v[q].y + v[q].z * v[q].z + v[q].w * v[q].w;
            ssq = wave_sum(ssq);
            const float top = fminf(am, 2.8f * sqrtf(ssq * (1.f / 1024.f)));
            const float sc = top > 0.f ? 6.f / top : 0.f;
#pragma unroll
            for (int q = 0; q < 4; ++q) {
                const float x0 = fminf(fmaxf(v[q].x * sc, -6.f), 6.f), x1 = fminf(fmaxf(v[q].y * sc, -6.f), 6.f), x2 = fminf(fmaxf(v[q].z * sc, -6.f), 6.f), x3 = fminf(fmaxf(v[q].w * sc, -6.f), 6.f);
                unsigned w = __builtin_amdgcn_cvt_scalef32_pk_fp4_f32(0u, x0, x1, 1.0f, 0);
                w = __builtin_amdgcn_cvt_scalef32_pk_fp4_f32(w, x2, x3, 1.0f, 1);
                *(unsigned short*)(dst + ((size_t)q * 16384 + e) * 128 + 2 * lane) = (unsigned short)(w & 0xffffu);
            }
            if (lane == 0) rscale[e] = top * (1.f / 6.f);
        }
    }
}
DEV void p0_transpose_item(const float* W, int K, int N, bf16_t* Wt, int kt, int nt, LAS float* tile) {
    const int tid = tid_fresh(), k0 = kt * 64, n0 = nt * 256;
    f32x4 v[8];
#pragma unroll
    for (int p = 0; p < 8; ++p) {
        const int kk = p * 8 + (tid >> 6), nn = (tid & 63) * 4, n = n0 + nn;
        v[p] = (f32x4){0.f, 0.f, 0.f, 0.f};
        if (n < N) v[p] = *(const f32x4*)(W + (size_t)(k0 + kk) * N + n);
    }
#pragma unroll
    for (int p = 0; p < 8; ++p) {
        const int kk = p * 8 + (tid >> 6), nn = (tid & 63) * 4;
        tile[kk * 257 + nn + 0] = v[p].x; tile[kk * 257 + nn + 1] = v[p].y; tile[kk * 257 + nn + 2] = v[p].z; tile[kk * 257 + nn + 3] = v[p].w;
    }
    __syncthreads();
#pragma unroll
    for (int q = 0; q < 4; ++q) {
        const int n = q * 64 + (tid >> 3), kc = (tid & 7) * 8;
        u32x4 o;
        o.x = pk2(tile[(kc + 0) * 257 + n], tile[(kc + 1) * 257 + n]);
        o.y = pk2(tile[(kc + 2) * 257 + n], tile[(kc + 3) * 257 + n]);
        o.z = pk2(tile[(kc + 4) * 257 + n], tile[(kc + 5) * 257 + n]);
        o.w = pk2(tile[(kc + 6) * 257 + n], tile[(kc + 7) * 257 + n]);
        *(u32x4*)(Wt + (size_t)(n0 + n) * K + k0 + kc) = o;
    }
    __syncthreads();
}
DEV void p0_mod_item(const Params& P, int i, int cb, LAS float* lds) {
    LAS float* s = lds;
    LAS float* red = lds + 9 * 1024;
    const int tid = tid_fresh();
    for (int e = tid; e < 9 * 1024; e += NTHREADS) {
        const int m = e >> 10, k = e & 1023;
        const float cv = m < 8 ? P.c[m * 1024 + k] : P.c_ctx[k];
        s[e] = silu(cv);
    }
    __syncthreads();
    const int cq = tid & 31, kg = tid >> 5;
    const float* W = P.mod_w + (size_t)i * 1024 * 6144 + cb * 128 + cq * 4;
    f32x4 acc[9];
#pragma unroll
    for (int m = 0; m < 9; ++m) acc[m] = (f32x4){0.f, 0.f, 0.f, 0.f};
#pragma unroll 16
    for (int kk = 0; kk < 64; ++kk) {
        const int k = kg * 64 + kk;
        const f32x4 w = *(const f32x4*)(W + (size_t)k * 6144);
#pragma unroll
        for (int m = 0; m < 9; ++m) { const float sv = s[m * 1024 + k]; acc[m] += w * sv; }
    }
#pragma unroll
    for (int m = 0; m < 9; ++m) *(LAS f32x4*)&red[(kg * 9 + m) * 128 + cq * 4] = acc[m];
    __syncthreads();
    float* modv = (float*)(P.ws + OFF_MODV);
    for (int e = tid; e < 9 * 128; e += NTHREADS) {
        const int m = e >> 7, col = e & 127;
        float sum = 0.f;
#pragma unroll
        for (int g = 0; g < 16; ++g) sum += red[(g * 9 + m) * 128 + col];
        modv[(size_t)(i * 9 + m) * 6144 + cb * 128 + col] = sum + P.mod_b[i * 6144 + cb * 128 + col];
    }
    __syncthreads();
}
DEV void phase_prep(const Params& P, ldsp lds0) {
    constexpr int N_MOD = 96, N_WQ = 2 * 16 * 8, N_WIN = 16 * 17, N_WOUT = 16 * 4, N_POOL = 4 * 4;
    constexpr int N_TR = N_WQ + N_WIN + N_WOUT + N_POOL, N_TAB = 4 * 128, N_KEYS = 16;
    constexpr int TOTAL = N_MOD + N_TR + N_TAB + N_KEYS;
    for (int item = blockIdx.x; item < TOTAL; item += gridDim.x) {
        LAS float* lds = (LAS float*)launder(lds0);
        int r = item;
        if (r < N_MOD) { p0_mod_item(P, r / 48, r % 48, lds); continue; }
        r -= N_MOD;
        if (r < N_WQ) { const int i = r / 128, t = r % 128;
            p0_transpose_item(P.peer_wq + (size_t)i * 1024 * 2048, 1024, 2048, (bf16_t*)(P.ws + OFF_WQT) + (size_t)i * 2048 * 1024, t / 8, t % 8, lds); continue; }
        r -= N_WQ;
        if (r < N_WIN) { p0_transpose_item(P.dn_w_in, 1024, 4128, (bf16_t*)(P.ws + OFF_WINT), r / 17, r % 17, lds); continue; }
        r -= N_WIN;
        if (r < N_WOUT) { p0_transpose_item(P.dn_w_out, 1024, 1024, (bf16_t*)(P.ws + OFF_WOUTT), r / 4, r % 4, lds); continue; }
        r -= N_WOUT;
        if (r < N_POOL) { const int g = r / 4, t = r % 4;
            p0_transpose_item(P.pool_w + (size_t)g * 65536, 256, 256, (bf16_t*)(P.ws + OFF_POOLT) + (size_t)g * 65536, t, 0, lds); continue; }
        r -= N_POOL;
        if (r < N_TAB) { const int tb = r / 128, ch = r % 128;
            const float* src = ((tb & 1) ? P.peer_v : P.peer_u) + (size_t)(tb >> 1) * TAB_ELEMS;
            p0_table_item(src, P.ws + OFF_TAB + (size_t)tb * 16 * MiB, (float*)(P.ws + OFF_RSC) + tb * 16384, ch * 128, (tb & 1) == 0); continue; }
        r -= N_TAB;
        p0_convert_item(P.peer_keys, (bf16_t*)(P.ws + OFF_KEYS), (size_t)r * 32768);
    }
}

template <int SRC>
DEV void phase_modulate(const Params& P, int layer, int which, int nrows, bool q8 = false) {
    const float* gain = (which ? P.norm2_g : P.norm1_g) + layer * 1024;
    const float* modv = (const float*)(P.ws + OFF_MODV) + (size_t)layer * 9 * 6144;
    bf16_t* A = (bf16_t*)(P.ws + OFF_A);
    const int tid = tid_fresh(); const int wave = tid >> 6, lane = tid & 63;
    for (int r = blockIdx.x * 8 + wave; r < nrows; r += gridDim.x * 8) {
        const int m = r < NX ? (r >> 11) : 8;
        const float* sh = modv + m * 6144 + which * 3072;
        const float* sc = sh + 1024;
        f32x4 v[4]; float ss = 0.f;
#pragma unroll
        for (int j = 0; j < 4; ++j) {
            if (SRC == 0) { const float* src = r < NX ? P.x + (size_t)r * 1024 : P.ctx + (size_t)(r - NX) * 1024; v[j] = *(const f32x4*)(src + j * 256 + lane * 4); }
            else { const u32x2 hv = *(const u32x2*)(hrow(P, r) + j * 256 + lane * 4); v[j] = (f32x4){bflo(hv.x), bfhi(hv.x), bflo(hv.y), bfhi(hv.y)}; }
            ss += v[j].x * v[j].x + v[j].y * v[j].y + v[j].z * v[j].z + v[j].w * v[j].w;
        }
        ss = wave_sum(ss);
        const float rstd = rsqrtf(ss * (1.f / 1024.f) + EPS);
#pragma unroll
        for (int j = 0; j < 4; ++j) {
            const int col = j * 256 + lane * 4;
            const f32x4 g = *(const f32x4*)(gain + col), s1 = *(const f32x4*)(sc + col), s0 = *(const f32x4*)(sh + col);
            const f32x4 y = v[j] * rstd * g * (1.f + s1) + s0;
            u32x2 o; o.x = pk2(y.x, y.y); o.y = pk2(y.z, y.w);
            *(u32x2*)(A + (size_t)r * 1024 + col) = o;
            v[j] = y;
        }
        if (q8) {
            float am = 0.f;
#pragma unroll
            for (int j = 0; j < 4; ++j) am = fmaxf(am, fmaxf(fmaxf(fabsf(v[j].x), fabsf(v[j].y)), fmaxf(fabsf(v[j].z), fabsf(v[j].w))));
            am = wave_max(am);
            const float sc = am > 0.f ? 127.f / am : 0.f;
            unsigned char* a8 = P.ws + OFF_A8 + (size_t)r * 1024;
#pragma unroll
            for (int j = 0; j < 4; ++j) {
                const int b0 = (int)rintf(v[j].x * sc), b1 = (int)rintf(v[j].y * sc), b2 = (int)rintf(v[j].z * sc), b3 = (int)rintf(v[j].w * sc);
                const unsigned mine = (unsigned)((b0 & 255) | ((b1 & 255) << 8) | ((b2 & 255) << 16) | ((b3 & 255) << 24));
                const unsigned other = (unsigned)__shfl_xor((int)mine, 1);
                const unsigned lo4 = (lane & 1) ? other : mine, hi4 = (lane & 1) ? mine : other;
                const unsigned outw = (lane & 1) ? __builtin_amdgcn_perm(hi4, lo4, 0x07050301u) : __builtin_amdgcn_perm(hi4, lo4, 0x06040200u);
                *(unsigned*)(a8 + j * 256 + lane * 4) = outw;
            }
            if (lane == 0) ((float*)(P.ws + OFF_XS))[r] = am * (1.f / 127.f);
        }
    }
}

DEV void unpack8(const u32x4 v, float* f) {
    f[0] = bflo(v.x); f[1] = bfhi(v.x); f[2] = bflo(v.y); f[3] = bfhi(v.y); f[4] = bflo(v.z); f[5] = bfhi(v.z); f[6] = bflo(v.w); f[7] = bfhi(v.w);
}
template <int W>
DEV void pool_vertical(const bf16_t* A0, LAS float* V, int b, int r, int cbase, int tq, int ch8, float (&cen)[4][8]) {
    const int rlo = max(0, r - W / 2), rhi = min(32, r - W / 2 + W);
    const float inv = 1.f / (float)(rhi - rlo);
#pragma unroll
    for (int jh = 0; jh < 2; ++jh) {
        u32x4 ld[2][W];
#pragma unroll
        for (int jj = 0; jj < 2; ++jj)
#pragma unroll
            for (int k = 0; k < W; ++k) {
                const int rr = min(rlo + k, 31), tok = tq + 16 * (2 * jh + jj);
                ld[jj][k] = *(const u32x4*)(A0 + ((size_t)b * 2048 + rr * 64 + tok) * 1024 + cbase);
            }
#pragma unroll
        for (int jj = 0; jj < 2; ++jj) {
            const int j = 2 * jh + jj, tok = tq + 16 * j;
            float acc[8];
#pragma unroll
            for (int e = 0; e < 8; ++e) acc[e] = 0.f;
#pragma unroll
            for (int k = 0; k < W; ++k) {
                float f[8]; unpack8(ld[jj][k], f);
                const bool in = rlo + k < rhi;
#pragma unroll
                for (int e = 0; e < 8; ++e) acc[e] += in ? f[e] : 0.f;
                if (rlo + k == r) {
#pragma unroll
                    for (int e = 0; e < 8; ++e) cen[j][e] = f[e];
                }
            }
            LAS float* vp = V + (tok + 8) * 260 + ch8 * 8;
            *(LAS f32x4*)vp = (f32x4){acc[0] * inv, acc[1] * inv, acc[2] * inv, acc[3] * inv};
            *(LAS f32x4*)(vp + 4) = (f32x4){acc[4] * inv, acc[5] * inv, acc[6] * inv, acc[7] * inv};
        }
    }
}
template <int W>
DEV void pool_horizontal(const LAS float* V, ldsp At, bool isx, int seg, int tq, int ch8, const float (&cen)[4][8]) {
#pragma unroll
    for (int j = 0; j < 4; ++j) {
        const int tok = tq + 16 * j;
        const int pos = isx ? tok : 64 * seg + tok, lim = isx ? 64 : 256, off = isx ? 8 : 8 - 64 * seg;
        const int lo = max(0, pos - W / 2), hi = min(lim, pos - W / 2 + W);
        f32x4 s0 = {0.f, 0.f, 0.f, 0.f}, s1 = {0.f, 0.f, 0.f, 0.f};
#pragma unroll
        for (int k = 0; k < W; ++k) {
            const int t = min(lo + k, lim - 1);
            const LAS float* vp = V + (t + off) * 260 + ch8 * 8;
            const f32x4 a = *(const LAS f32x4*)vp, b2 = *(const LAS f32x4*)(vp + 4);
            const float m = (lo + k < hi) ? 1.f : 0.f;
            s0 += a * m; s1 += b2 * m;
        }
        const float inv = 1.f / (float)(hi - lo);
        u32x4 o;
        o.x = pk2(s0.x * inv - cen[j][0], s0.y * inv - cen[j][1]);
        o.y = pk2(s0.z * inv - cen[j][2], s0.w * inv - cen[j][3]);
        o.z = pk2(s1.x * inv - cen[j][4], s1.y * inv - cen[j][5]);
        o.w = pk2(s1.z * inv - cen[j][6], s1.w * inv - cen[j][7]);
        *(LAS u32x4*)(At + tok * 512 + ((ch8 ^ (tok & 7)) << 4)) = o;
    }
}
DEV void phase_pool(const Params& P, ldsp lds0) {
    const bf16_t* A0 = (const bf16_t*)(P.ws + OFF_A);
    const float* modv = (const float*)(P.ws + OFF_MODV);
    const bf16_t* Wt = (const bf16_t*)(P.ws + OFF_POOLT);
    const int tid = tid_fresh(), lane = tid & 63, wave = tid >> 6;
    const int ch8 = tid & 31, tq = tid >> 5;
    for (int item = blockIdx.x; item < 1152; item += gridDim.x) {
        const ldsp lds = launder(lds0);
        LAS float* V = (LAS float*)lds;
        const ldsp At = lds + 80 * 260 * 4;
        const bool isx = item < 1024;
        int b, r = 0, seg = 0, g;
        if (isx) { b = item >> 7; r = (item >> 2) & 31; }
        else { const int it = item - 1024; b = it >> 4; seg = (it >> 2) & 3; }
        g = ((item & 3) + (item >> 8)) & 3;
        const int cbase = g * 256 + ch8 * 8;
        float cen[4][8];
        if (isx) {
            if (g == 0) pool_vertical<2>(A0, V, b, r, cbase, tq, ch8, cen);
            else if (g == 1) pool_vertical<4>(A0, V, b, r, cbase, tq, ch8, cen);
            else if (g == 2) pool_vertical<8>(A0, V, b, r, cbase, tq, ch8, cen);
            else pool_vertical<16>(A0, V, b, r, cbase, tq, ch8, cen);
        } else {
            for (int q = tq; q < 80; q += 16) {
                const int t = 64 * seg - 8 + q;
                if (t >= 0 && t < 256) {
                    const u32x4 pv = *(const u32x4*)(A0 + ((size_t)NX + b * 256 + t) * 1024 + cbase);
                    float f[8]; unpack8(pv, f);
                    LAS float* vp = V + q * 260 + ch8 * 8;
                    *(LAS f32x4*)vp = (f32x4){f[0], f[1], f[2], f[3]};
                    *(LAS f32x4*)(vp + 4) = (f32x4){f[4], f[5], f[6], f[7]};
                }
            }
#pragma unroll
            for (int j = 0; j < 4; ++j) {
                const int tok = tq + 16 * j;
                const u32x4 pv = *(const u32x4*)(A0 + ((size_t)NX + b * 256 + 64 * seg + tok) * 1024 + cbase);
                unpack8(pv, cen[j]);
            }
        }
        __syncthreads();
        if (g == 0) pool_horizontal<2>(V, At, isx, seg, tq, ch8, cen);
        else if (g == 1) pool_horizontal<4>(V, At, isx, seg, tq, ch8, cen);
        else if (g == 2) pool_horizontal<8>(V, At, isx, seg, tq, ch8, cen);
        else pool_horizontal<16>(V, At, isx, seg, tq, ch8, cen);
        __syncthreads();
        f32x16 acc[2]; acc[0] = zero16(); acc[1] = zero16();
        const bf16_t* Wg = Wt + (size_t)g * 65536 + (size_t)(32 * wave + (lane & 31)) * 256 + (lane >> 5) * 8;
#pragma unroll 4
        for (int ks = 0; ks < 16; ++ks) {
            const bf16x8 wfr = *(const bf16x8*)(Wg + ks * 16);
            const int ch = ks * 2 + (lane >> 5);
#pragma unroll
            for (int mt = 0; mt < 2; ++mt) {
                const int row = mt * 32 + (lane & 31);
                const bf16x8 a = *(const LAS bf16x8*)(At + row * 512 + ((ch ^ (row & 7)) << 4));
                acc[mt] = mfma32(wfr, a, acc[mt]);
            }
        }
        const int m = isx ? b : 8;
#pragma unroll
        for (int mt = 0; mt < 2; ++mt)
#pragma unroll
            for (int rg = 0; rg < 4; ++rg) {
                const int tok = mt * 32 + (lane & 31), col = g * 256 + 32 * wave + 8 * rg + 4 * (lane >> 5);
                const f32x4 gs = *(const f32x4*)(modv + m * 6144 + 2048 + col) * *(const f32x4*)(P.pool_scale + col);
                const f32x4 av = {acc[mt][rg * 4 + 0], acc[mt][rg * 4 + 1], acc[mt][rg * 4 + 2], acc[mt][rg * 4 + 3]};
                f32x4 hv; int grow;
                if (isx) { grow = b * 2048 + r * 64 + tok; hv = *(const f32x4*)(P.x + (size_t)grow * 1024 + col) + gs * av; }
                else { const size_t gi = ((size_t)b * 256 + 64 * seg + tok) * 1024 + col; grow = NX + b * 256 + 64 * seg + tok; hv = *(const f32x4*)(P.ctx + gi) + gs * av; }
                u32x2 hp; hp.x = pk2(hv.x, hv.y); hp.y = pk2(hv.z, hv.w);
                *(u32x2*)(hrow(P, grow) + col) = hp;
            }
        __syncthreads();
    }
}

DEV bf16x8 frag_row_x(ldsp x, int r0, int k0, int lane) {
    const int row = r0 + (lane & 31), ch = (k0 >> 3) + (lane >> 5);
    return *(const LAS bf16x8*)(x + row * 256 + ((ch ^ (row & 15)) << 4));
}
DEV unsigned key_of(float f) { const unsigned u = __float_as_uint(f); return u ^ ((unsigned)((int)u >> 31) | 0x80000000u); }
DEV float val_of(unsigned k) { const unsigned u = (k & 0x80000000u) ? (k ^ 0x80000000u) : ~k; return __uint_as_float(u); }
DEV void cmpx(unsigned& hi, unsigned& lo) { const unsigned a = hi, b = lo; hi = a > b ? a : b; lo = a > b ? b : a; }
DEV void sort16_desc(unsigned* v) {
#pragma unroll
    for (int k = 2; k <= 16; k <<= 1)
#pragma unroll
        for (int j = k >> 1; j > 0; j >>= 1)
#pragma unroll
            for (int i = 0; i < 16; ++i) {
                const int l = i ^ j;
                if (l > i) { if ((i & k) == 0) cmpx(v[i], v[l]); else cmpx(v[l], v[i]); }
            }
}
DEV void merge16(unsigned* r, const unsigned* b) {
#pragma unroll
    for (int k = 0; k < 16; ++k) r[k] = r[k] > b[15 - k] ? r[k] : b[15 - k];
#pragma unroll
    for (int j = 8; j > 0; j >>= 1)
#pragma unroll
        for (int i = 0; i < 16; ++i) { const int l = i ^ j; if (l > i) cmpx(r[i], r[l]); }
}
DEV void top16_of_64(unsigned* v, unsigned* r) {
#pragma unroll
    for (int blk = 0; blk < 4; ++blk) sort16_desc(v + 16 * blk);
#pragma unroll
    for (int k = 0; k < 16; ++k) r[k] = v[k];
    merge16(r, v + 16); merge16(r, v + 32); merge16(r, v + 48);
}
DEV void phase_topk(const Params& P, int layer, int nrows, ldsp lds0) {
    const bf16_t* Q = (const bf16_t*)(P.ws + OFF_R1);
    const bf16_t* keys = (const bf16_t*)(P.ws + OFF_KEYS) + (size_t)layer * 8 * 2 * 128 * 128;
    bf16_t* seli = (bf16_t*)(P.ws + OFF_SELI);
    float* selg = (float*)(P.ws + OFF_SELG);
    const int tid = tid_fresh(), lane = tid & 63, wave = tid >> 6;
    const int nitems = (nrows / 256) * 4;
    const unsigned hoff = (unsigned)(lane >> 5) * 4u;
    for (int item = blockIdx.x; item < nitems; item += gridDim.x) {
        const ldsp lds = launder(lds0);
        LAS unsigned* sl = (LAS unsigned*)(lds + 65536 + wave * 8192);
        const int tg = item >> 2, hp = item & 3, row0 = tg * 256 + wave * 32;
        u32x4 kr[4]; bf16x8 qf[8];
        {
            const bf16_t* kt = keys + (size_t)((hp * 2) * 2) * 128 * 128;
#pragma unroll
            for (int j = 0; j < 4; ++j) { const int cid = tid + NTHREADS * j, r = cid >> 4, ch = cid & 15; kr[j] = *(const u32x4*)(kt + r * 128 + ch * 8); }
#pragma unroll
            for (int j = 0; j < 4; ++j) { const int cid = tid + NTHREADS * j, r = cid >> 4, ch = cid & 15; *(LAS u32x4*)(lds + r * 256 + ((ch ^ (r & 15)) << 4)) = kr[j]; }
            const bf16_t* qb = Q + (size_t)(row0 + (lane & 31)) * 2048 + (hp * 2) * 256 + (lane >> 5) * 8;
#pragma unroll
            for (int ks = 0; ks < 8; ++ks) qf[ks] = *(const bf16x8*)(qb + ks * 16);
        }
        __syncthreads();
        unsigned s1[16], s2[16];
#pragma unroll
        for (int k = 0; k < 16; ++k) { s1[k] = 0u; s2[k] = 0u; }
#pragma unroll 1
        for (int step = 0; step < 4; ++step) {
            const int hs = step >> 1, p = step & 1;
            const bool mine = (lane >> 5) == hs;
            const ldsp kb = lds + (step & 1) * 32768;
            if (step < 3) {
                const bf16_t* kt = keys + (size_t)((hp * 2 + ((step + 1) >> 1)) * 2 + ((step + 1) & 1)) * 128 * 128;
#pragma unroll
                for (int j = 0; j < 4; ++j) { const int cid = tid + NTHREADS * j, r = cid >> 4, ch = cid & 15; kr[j] = *(const u32x4*)(kt + r * 128 + ch * 8); }
            }
            f32x16 acc[4];
#pragma unroll
            for (int mt = 0; mt < 4; ++mt) acc[mt] = zero16();
#pragma unroll
            for (int ks = 0; ks < 8; ++ks)
#pragma unroll
                for (int mt = 0; mt < 4; ++mt) acc[mt] = mfma32(frag_row_x(kb, mt * 32, ks * 16, lane), qf[ks], acc[mt]);
            if (step < 3) {
                const ldsp kn = lds + ((step + 1) & 1) * 32768;
#pragma unroll
                for (int j = 0; j < 4; ++j) { const int cid = tid + NTHREADS * j, r = cid >> 4, ch = cid & 15; *(LAS u32x4*)(kn + r * 256 + ((ch ^ (r & 15)) << 4)) = kr[j]; }
                const bf16_t* qb = Q + (size_t)(row0 + (lane & 31)) * 2048 + (hp * 2 + ((step + 1) >> 1)) * 256 + ((step + 1) & 1) * 128 + (lane >> 5) * 8;
#pragma unroll
                for (int ks = 0; ks < 8; ++ks) qf[ks] = *(const bf16x8*)(qb + ks * 16);
            }
            unsigned v[64];
#pragma unroll
            for (int mt = 0; mt < 4; ++mt)
#pragma unroll
                for (int reg = 0; reg < 16; ++reg) {
                    const unsigned c = mt * 32 + (reg & 3) + 8 * (reg >> 2);
                    v[mt * 16 + reg] = ((key_of(acc[mt][reg]) & ~127u) | (127u - c)) ^ hoff;
                }
            unsigned r[16], o[16];
            top16_of_64(v, r);
#pragma unroll
            for (int k = 0; k < 16; ++k) o[k] = (unsigned)__shfl_xor((int)r[k], 32);
            merge16(r, o);
#pragma unroll
            for (int k = 0; k < 16; ++k) { if (p == 0) s1[k] = mine ? r[k] : s1[k]; else s2[k] = mine ? r[k] : s2[k]; }
            __syncthreads();
        }
        float f1[16], f2[16];
#pragma unroll
        for (int k = 0; k < 16; ++k) {
            sl[k * 64 + lane] = s1[k]; sl[(16 + k) * 64 + lane] = s2[k];
            f1[k] = val_of(s1[k] & ~127u); f2[k] = val_of(s2[k] & ~127u);
        }
        unsigned cv[64];
        {
            int n = 0;
#pragma unroll
            for (int a = 0; a < 16; ++a)
#pragma unroll
                for (int b = 0; b < 16; ++b)
                    if ((a + 1) * (b + 1) <= 16) { cv[n] = (key_of(f1[a] + f2[b]) & ~255u) | (255u - (unsigned)(a * 16 + b)); ++n; }
#pragma unroll
            for (int q = 50; q < 64; ++q) cv[q] = 0u;
        }
        unsigned w[16];
        top16_of_64(cv, w);
        float sc[16]; int ei[16];
#pragma unroll
        for (int k = 0; k < 16; ++k) {
            const unsigned ab = 255u - (w[k] & 255u);
            const unsigned k1 = sl[(ab >> 4) * 64 + lane], k2 = sl[(16 + (ab & 15u)) * 64 + lane];
            ei[k] = (int)((127u - (k1 & 127u)) * 128u + (127u - (k2 & 127u)));
            sc[k] = val_of(w[k] & ~255u);
        }
        const float mx = sc[0];
        float tot = 0.f;
#pragma unroll
        for (int k = 0; k < 16; ++k) { sc[k] = expf(sc[k] - mx); tot += sc[k]; }
        const int row = row0 + (lane & 31), head = hp * 2 + (lane >> 5);
        bf16_t* ip = seli + (size_t)row * 128 + head * 16;
        float* gp = selg + (size_t)row * 128 + head * 16;
        const float inv = 1.f / tot;
#pragma unroll
        for (int q = 0; q < 2; ++q) {
            u32x4 o;
#pragma unroll
            for (int d = 0; d < 4; ++d) o[d] = (unsigned)ei[8 * q + 2 * d] | ((unsigned)ei[8 * q + 2 * d + 1] << 16);
            *(u32x4*)(ip + 8 * q) = o;
        }
#pragma unroll
        for (int q = 0; q < 4; ++q) *(float4*)(gp + 4 * q) = make_float4(sc[4 * q] * inv, sc[4 * q + 1] * inv, sc[4 * q + 2] * inv, sc[4 * q + 3] * inv);
    }
}

struct XGeo { int nloc, rank, nact, pos; };
typedef float f32x2 __attribute__((ext_vector_type(2)));
DEV void fp8x16_to_f32(const u32x4 r, float* f) {
#pragma unroll
    for (int d = 0; d < 4; ++d) {
        const f32x2 lo = __builtin_amdgcn_cvt_pk_f32_fp8((int)r[d], false), hi = __builtin_amdgcn_cvt_pk_f32_fp8((int)r[d], true);
        f[4 * d + 0] = lo.x; f[4 * d + 1] = lo.y; f[4 * d + 2] = hi.x; f[4 * d + 3] = hi.y;
    }
}
template <int S, int MUL, class T>
DEV void bfly_stage(T* p, int lane) {
    const bool hi = (lane & (S * MUL)) != 0;
#pragma unroll
    for (int i = 0; i < 2 * S; ++i) { const T keep = hi ? p[i + 2 * S] : p[i], send = hi ? p[i] : p[i + 2 * S]; p[i] = keep + __shfl_xor(send, S * MUL); }
}
template <int STAGE>
DEV void ex_issue(u32x4 (&buf)[16], u32x4 (&aux)[4], f32x2 (&hg)[2], const u32x4 (&idn)[2], const unsigned char* slice, const Params& P, const bf16_t* A, const bf16_t* wexp,
                  const float* gatev, int t, int sl, int g, int c) {
    int id[16];
#pragma unroll
    for (int q = 0; q < 2; ++q)
#pragma unroll
        for (int d = 0; d < 4; ++d) { id[8 * q + 2 * d] = (int)(idn[q][d] & 0xffffu); id[8 * q + 2 * d + 1] = (int)(idn[q][d] >> 16); }
#pragma unroll
    for (int k = 0; k < 16; ++k) buf[k] = *(const u32x4*)(slice + (size_t)id[k] * 128);
    if (STAGE == 1) {
        aux[0] = *(const u32x4*)(P.ws + OFF_A8 + (size_t)t * 1024 + 256 * sl + 32 * c); aux[1] = *(const u32x4*)(P.ws + OFF_A8 + (size_t)t * 1024 + 256 * sl + 32 * c + 16);
        hg[0].x = ((const float*)(P.ws + OFF_XS))[t];
    } else {
#pragma unroll
        for (int q = 0; q < 2; ++q) aux[q] = *(const u32x4*)(wexp + (size_t)t * 128 + 16 * g + 8 * q);
        const int col = 256 * sl + 32 * c + 4 * g, m = t < NX ? (t >> 11) : 8;
        const u32x2 hv = *(const u32x2*)(hrow(P, t) + col);
        aux[2] = (u32x4){hv.x, hv.y, 0u, 0u};
        aux[3] = *(const u32x4*)(gatev + m * 6144 + col);
    }
}
template <int STAGE>
DEV void ex_compute(const u32x4 (&buf)[16], const u32x4 (&aux)[4], const f32x2 (&hg)[2], const Params& P, float* part, int t, int sl, int lane, int g, int c) {
    if (STAGE == 1) {
        int sx = 0;
#pragma unroll
        for (int q = 0; q < 2; ++q)
#pragma unroll
            for (int d = 0; d < 4; ++d) sx = __builtin_amdgcn_sdot4(0x01010101, (int)aux[q][d], sx, false);
        int p[16];
#pragma unroll
        for (int k = 0; k < 16; ++k) {
            int a = -8 * sx;
#pragma unroll
            for (int d = 0; d < 4; ++d) {
                const unsigned w = buf[k][d];
                a = __builtin_amdgcn_sdot4((int)(w & 0x0F0F0F0Fu), (int)aux[d >> 1][2 * (d & 1)], a, false);
                a = __builtin_amdgcn_sdot4((int)((w >> 4) & 0x0F0F0F0Fu), (int)aux[d >> 1][2 * (d & 1) + 1], a, false);
            }
            p[k] = a;
        }
        bfly_stage<4, 1>(p, lane); bfly_stage<2, 1>(p, lane); bfly_stage<1, 1>(p, lane);
        const float xs = hg[0].x;
        *(unsigned*)((bf16_t*)part + ((size_t)sl * NT + t) * 128 + 2 * lane) = pk2((float)p[0] * xs, (float)p[1] * xs);
    } else {
        f32x2 p2[16];
#pragma unroll
        for (int i = 0; i < 16; ++i) p2[i] = (f32x2){0.f, 0.f};
#pragma unroll
        for (int k = 0; k < 16; ++k) {
            const unsigned wpk = aux[k >> 3][(k >> 1) & 3];
            const float wkf = (k & 1) ? bfhi(wpk) : bflo(wpk);
            const f32x2 w2 = {wkf, wkf};
#pragma unroll
            for (int d = 0; d < 4; ++d) {
                p2[4 * d + 0] += w2 * __builtin_amdgcn_cvt_scalef32_pk_f32_fp4(buf[k][d], 1.0f, 0);
                p2[4 * d + 1] += w2 * __builtin_amdgcn_cvt_scalef32_pk_f32_fp4(buf[k][d], 1.0f, 1);
                p2[4 * d + 2] += w2 * __builtin_amdgcn_cvt_scalef32_pk_f32_fp4(buf[k][d], 1.0f, 2);
                p2[4 * d + 3] += w2 * __builtin_amdgcn_cvt_scalef32_pk_f32_fp4(buf[k][d], 1.0f, 3);
            }
            asm volatile("" : "+v"(p2[0]), "+v"(p2[1]), "+v"(p2[2]), "+v"(p2[3]), "+v"(p2[4]), "+v"(p2[5]), "+v"(p2[6]), "+v"(p2[7]),
                              "+v"(p2[8]), "+v"(p2[9]), "+v"(p2[10]), "+v"(p2[11]), "+v"(p2[12]), "+v"(p2[13]), "+v"(p2[14]), "+v"(p2[15]));
        }
        float p[32];
#pragma unroll
        for (int i = 0; i < 16; ++i) { p[2 * i] = p2[i].x; p[2 * i + 1] = p2[i].y; }
        bfly_stage<8, 4>(p, lane); bfly_stage<4, 4>(p, lane); bfly_stage<2, 4>(p, lane);
        const int col = 256 * sl + 32 * c + 4 * g;
        const unsigned h0 = aux[2].x, h1 = aux[2].y;
        u32x2 ho;
        ho.x = pk2(bflo(h0) + __uint_as_float(aux[3].x) * p[0], bfhi(h0) + __uint_as_float(aux[3].y) * p[1]);
        ho.y = pk2(bflo(h1) + __uint_as_float(aux[3].z) * p[2], bfhi(h1) + __uint_as_float(aux[3].w) * p[3]);
        *(u32x2*)(hrow(P, t) + col) = ho;
    }
}
template <int STAGE>
DEV void phase_experts_sliced(const Params& P, int layer, int nrows, const XGeo geo) {
    const unsigned char* tab = P.ws + OFF_TAB + (size_t)(layer * 2 + (STAGE - 1)) * 16 * MiB;
    const bf16_t* A = (const bf16_t*)(P.ws + OFF_A);
    const bf16_t* seli = (const bf16_t*)(P.ws + OFF_SELI);
    float* part = (float*)(P.ws + OFF_PART);
    const bf16_t* wexp = (const bf16_t*)(P.ws + OFF_WEXP);
    const float* gatev = (const float*)(P.ws + OFF_MODV) + (size_t)layer * 9 * 6144 + 5 * 1024;
    const int tid = tid_fresh(), wave = tid >> 6, lane = tid & 63, g = lane >> 3, c = lane & 7;
    const int nw = geo.nloc * 8, wr = geo.rank * 8 + wave;
    for (int vs = geo.pos; vs < 8; vs += geo.nact) {
        const int sl = vs >> 1, tmul = 2, tadd = vs & 1;
        const unsigned char* slice = tab + (size_t)sl * 2 * MiB + 16 * c;
        const int nws = nw * tmul;
        int t = wr * tmul + tadd;
        if (t >= nrows) continue;
        u32x4 bufA[16], bufB[16], auxA[4], auxB[4]; f32x2 hgA[2], hgB[2]; u32x4 idn[2];
#pragma unroll
        for (int q = 0; q < 2; ++q) idn[q] = *(const u32x4*)(seli + (size_t)t * 128 + 16 * g + 8 * q);
        ex_issue<STAGE>(bufA, auxA, hgA, idn, slice, P, A, wexp, gatev, t, sl, g, c);
        if (t + nws < nrows) {
#pragma unroll
            for (int q = 0; q < 2; ++q) idn[q] = *(const u32x4*)(seli + (size_t)(t + nws) * 128 + 16 * g + 8 * q);
        }
        for (;;) {
            {
                const int t1 = t + nws;
                if (t1 < nrows) {
                    ex_issue<STAGE>(bufB, auxB, hgB, idn, slice, P, A, wexp, gatev, t1, sl, g, c);
                    if (t1 + nws < nrows) {
#pragma unroll
                        for (int q = 0; q < 2; ++q) idn[q] = *(const u32x4*)(seli + (size_t)(t1 + nws) * 128 + 16 * g + 8 * q);
                    }
                }
                ex_compute<STAGE>(bufA, auxA, hgA, P, part, t, sl, lane, g, c);
            }
            t += nws; if (t >= nrows) break;
            {
                const int t1 = t + nws;
                if (t1 < nrows) {
                    ex_issue<STAGE>(bufA, auxA, hgA, idn, slice, P, A, wexp, gatev, t1, sl, g, c);
                    if (t1 + nws < nrows) {
#pragma unroll
                        for (int q = 0; q < 2; ++q) idn[q] = *(const u32x4*)(seli + (size_t)(t1 + nws) * 128 + 16 * g + 8 * q);
                    }
                }
                ex_compute<STAGE>(bufB, auxB, hgB, P, part, t, sl, lane, g, c);
            }
            t += nws; if (t >= nrows) break;
        }
    }
}
DEV void phase_experts_act(const Params& P, int layer, int nrows) {
    const bf16_t* seli = (const bf16_t*)(P.ws + OFF_SELI);
    const float* selg = (const float*)(P.ws + OFF_SELG);
    const float* part = (const float*)(P.ws + OFF_PART);
    bf16_t* wexp = (bf16_t*)(P.ws + OFF_WEXP);
    const float* rsu = (const float*)(P.ws + OFF_RSC) + (size_t)(layer * 2) * 16384;
    const float* rsv = rsu + 16384;
    const int tid = tid_fresh();
    const int n4 = nrows * 32;
    for (int i4 = blockIdx.x * NTHREADS + tid; i4 < n4; i4 += gridDim.x * NTHREADS) {
        const size_t idx = (size_t)i4 * 4;
        f32x4 h = {0.f, 0.f, 0.f, 0.f};
#pragma unroll
        for (int s = 0; s < 4; ++s) { const u32x2 pv = *(const u32x2*)((const bf16_t*)part + (size_t)s * NT * 128 + idx); h += (f32x4){bflo(pv.x), bfhi(pv.x), bflo(pv.y), bfhi(pv.y)}; }
        const u32x2 e = *(const u32x2*)(seli + idx);
        const f32x4 gt = *(const f32x4*)(selg + idx);
        const int ee[4] = {(int)(e.x & 0xffffu), (int)(e.x >> 16), (int)(e.y & 0xffffu), (int)(e.y >> 16)};
        f32x4 o;
#pragma unroll
        for (int q = 0; q < 4; ++q) {
            const float hh = h[q] * rsu[ee[q]];
            o[q] = gt[q] * (0.5f * hh * (1.f + erff(hh * 0.70710678118654752f))) * rsv[ee[q]];
        }
        u32x2 ow; ow.x = pk2(o[0], o[1]); ow.y = pk2(o[2], o[3]);
        *(u32x2*)(wexp + idx) = ow;
    }
}
DEV void phase_final(const Params& P) {
    const int tid = tid_fresh(), wave = tid >> 6, lane = tid & 63;
    for (int r = blockIdx.x * 8 + wave; r < NX; r += gridDim.x * 8) {
        float* h = P.out + (size_t)r * 1024;
        f32x4 v[4]; float ss = 0.f;
#pragma unroll
        for (int j = 0; j < 4; ++j) { const u32x2 hv = *(const u32x2*)(hrow(P, r) + j * 256 + lane * 4); v[j] = (f32x4){bflo(hv.x), bfhi(hv.x), bflo(hv.y), bfhi(hv.y)};
            ss += v[j].x * v[j].x + v[j].y * v[j].y + v[j].z * v[j].z + v[j].w * v[j].w; }
        ss = wave_sum(ss);
        const float rstd = rsqrtf(ss * (1.f / 1024.f) + EPS);
#pragma unroll
        for (int j = 0; j < 4; ++j) { const f32x4 gg = *(const f32x4*)(P.final_g + j * 256 + lane * 4); *(f32x4*)(h + j * 256 + lane * 4) = v[j] * rstd * gg; }
    }
}

DEV void phase_conv(const Params& P) {
    const bf16_t* Pq = (const bf16_t*)(P.ws + OFF_R1);
    const float* ab = (const float*)(P.ws + OFF_AB);
    bf16_t* dst[3] = {(bf16_t*)(P.ws + OFF_QC), (bf16_t*)(P.ws + OFF_KC), (bf16_t*)(P.ws + OFF_VC)};
    float* gbuf = (float*)(P.ws + OFF_G);
    float* bbuf = (float*)(P.ws + OFF_BETA);
    const int tid = tid_fresh(), wave = tid >> 6, lane = tid & 63;
    constexpr int NSEG = NT / 16;
    for (int item = blockIdx.x * 8 + wave; item < NSEG * 6; item += gridDim.x * 8) {
        const int seg = item / 6, jc = item - seg * 6, row0 = seg * 16;
        int t0, L;
        if (row0 < NX) { t0 = row0 & 2047; L = 2048; } else { t0 = (row0 - NX) & 255; L = 256; }
        const int chunk = lane + 64 * jc, col = chunk * 8, part = jc >> 1;
        f32x4 w0[5], w1[5];
#pragma unroll
        for (int tap = 0; tap < 5; ++tap) { w0[tap] = *(const f32x4*)(P.dn_conv_w + tap * 3072 + col); w1[tap] = *(const f32x4*)(P.dn_conv_w + tap * 3072 + col + 4); }
        u32x4 raw[20];
#pragma unroll
        for (int i = 0; i < 20; ++i) {
            const int tt = t0 + i - 2;
            const bool ok = tt >= 0 && tt < L;
            const u32x4 v = *(const u32x4*)(Pq + (size_t)(row0 + (ok ? i - 2 : 0)) * 3072 + col);
            raw[i] = ok ? v : (u32x4){0u, 0u, 0u, 0u};
        }
        const float qs = part == 0 ? 0.08838834764831845f : 1.f;
        bf16_t* dp = dst[part] + (size_t)row0 * 1024 + (chunk & 127) * 8;
#pragma unroll
        for (int i = 0; i < 16; ++i) {
            float acc[8];
#pragma unroll
            for (int e = 0; e < 8; ++e) acc[e] = 0.f;
#pragma unroll
            for (int tap = 0; tap < 5; ++tap) {
                float f[8]; unpack8(raw[i + tap], f);
                acc[0] += f[0] * w0[tap].x; acc[1] += f[1] * w0[tap].y; acc[2] += f[2] * w0[tap].z; acc[3] += f[3] * w0[tap].w;
                acc[4] += f[4] * w1[tap].x; acc[5] += f[5] * w1[tap].y; acc[6] += f[6] * w1[tap].z; acc[7] += f[7] * w1[tap].w;
            }
            float ss = 0.f;
#pragma unroll
            for (int e = 0; e < 8; ++e) { acc[e] = silu(acc[e]); ss += acc[e] * acc[e]; }
            if (part < 2) {
                ss = sum16(ss);
                const float rn = rsqrtf(ss + EPS) * qs;
#pragma unroll
                for (int e = 0; e < 8; ++e) acc[e] *= rn;
            }
            u32x4 o; o.x = pk2(acc[0], acc[1]); o.y = pk2(acc[2], acc[3]); o.z = pk2(acc[4], acc[5]); o.w = pk2(acc[6], acc[7]);
            *(u32x4*)(dp + (size_t)i * 1024) = o;
        }
        if (jc == 0) {
            const int cc = lane & 31, d = cc >> 4, sx = (cc >> 3) & 1, h = cc & 7;
            const float a = __expf(P.dn_a_log[d * 8 + h]), dtb = P.dn_dt_bias[d * 8 + h];
            float v[8];
#pragma unroll
            for (int q = 0; q < 8; ++q) v[q] = ab[(size_t)(row0 + 2 * q + (lane >> 5)) * 32 + cc];
#pragma unroll
            for (int q = 0; q < 8; ++q) {
                const int row = row0 + 2 * q + (lane >> 5);
                if (sx == 0) {
                    const float xx = v[q] + dtb;
                    const float ex = __expf(fminf(xx, 30.f)), u = 1.f + ex;
                    const float l1p = (u == 1.f) ? ex : __logf(u) * ex * __builtin_amdgcn_rcpf(u - 1.f);
                    const float sp = xx > 20.f ? xx : l1p;
                    gbuf[((size_t)d * NT + row) * 8 + h] = -a * sp;
                } else {
                    bbuf[((size_t)d * NT + row) * 8 + h] = __builtin_amdgcn_rcpf(1.f + __expf(-v[q]));
                }
            }
        }
    }
}

DEV int chunk_rowbase(int b, int d, int n) {
    if (n < 4) { const int m = d ? 3 - n : n; return NX + b * 256 + m * 64; }
    const int m = d ? 31 - (n - 4) : n - 4; return b * 2048 + m * 64;
}

DEV bf16x8 frag_col_x(ldsp x, int c0, int k0, int lane) {
    const int col = c0 + (lane & 31), ch = col >> 3, sub = (col & 7) * 2;
    bf16x8 f;
#pragma unroll
    for (int j = 0; j < 8; ++j) { const int row = k0 + 8 * (lane >> 5) + j; f[j] = (short)*(const LAS bf16_t*)(x + row * 256 + ((ch ^ (row & 15)) << 4) + sub); }
    return f;
}
DEV void tile_rows8(const f32x16& acc, u32x4& o0, u32x4& o1) {
    unsigned p[4][2];
#pragma unroll
    for (int rg = 0; rg < 4; ++rg) { p[rg][0] = pk2(acc[rg * 4 + 0], acc[rg * 4 + 1]); p[rg][1] = pk2(acc[rg * 4 + 2], acc[rg * 4 + 3]); }
    const auto s00 = __builtin_amdgcn_permlane32_swap(p[0][0], p[2][0], false, false), s01 = __builtin_amdgcn_permlane32_swap(p[0][1], p[2][1], false, false);
    const auto s10 = __builtin_amdgcn_permlane32_swap(p[1][0], p[3][0], false, false), s11 = __builtin_amdgcn_permlane32_swap(p[1][1], p[3][1], false, false);
    o0 = (u32x4){s00[0], s01[0], s00[1], s01[1]};
    o1 = (u32x4){s10[0], s11[0], s10[1], s11[1]};
}
DEV bf16x8 frag_row_t(ldsp t, int r0, int k0, int lane) {
    const int row = r0 + (lane & 31), ch = (k0 >> 3) + (lane >> 5);
    return *(const LAS bf16x8*)(t + row * 128 + ((ch ^ (row & 7)) << 4));
}
DEV void phase_chunk(const Params& P, ldsp lds0) {
    const bf16_t* kc = (const bf16_t*)(P.ws + OFF_KC);
    const bf16_t* vc = (const bf16_t*)(P.ws + OFF_VC);
    const float* gbuf = (const float*)(P.ws + OFF_G);
    const float* bbuf = (const float*)(P.ws + OFF_BETA);
    bf16_t* wbuf = (bf16_t*)(P.ws + OFF_WBUF);
    bf16_t* ubuf = (bf16_t*)(P.ws + OFF_UBUF);
    float* gcbuf = (float*)(P.ws + OFF_GC);
    const int tid = tid_fresh(), lane = tid & 63, wave = tid >> 6, team = wave >> 1, tw = wave & 1, ttid = tid & 127;
    const int nteams = gridDim.x * 4, niter = (4608 + nteams - 1) / nteams;
    u32x4 rk[8];
    {
        const int item0 = min((int)(blockIdx.x * 4 + team), 4607);
        const int n = item0 % 36, d = (item0 / 36) & 1, bh = item0 / 72, rb0 = chunk_rowbase(bh >> 3, d, n);
#pragma unroll
        for (int j = 0; j < 8; ++j) { const int cid = ttid + 128 * j, i = cid >> 4, ch = cid & 15; rk[j] = *(const u32x4*)(kc + ((size_t)rb0 + (d ? 63 - i : i)) * 1024 + (bh & 7) * 128 + ch * 8); }
    }
    for (int it = 0; it < niter; ++it) {
        const int item = it * nteams + blockIdx.x * 4 + team;
        const bool act = item < 4608;
        const ldsp lds = launder(lds0);
        const ldsp sX = lds + team * 32768;
        const ldsp sT = sX + 16384;
        LAS float* sA = (LAS float*)sT;
        LAS float* sg = (LAS float*)(lds + 131072 + 128 + team * 768);
        const int n = item % 36, d = (item / 36) & 1, bh = item / 72, b = bh >> 3, h = bh & 7;
        const int rowbase = act ? chunk_rowbase(b, d, n) : 0;
        if (act) {
#pragma unroll
            for (int j = 0; j < 8; ++j) { const int cid = ttid + 128 * j, i = cid >> 4, ch = cid & 15; *(LAS u32x4*)(sX + i * 256 + ((ch ^ (i & 15)) << 4)) = rk[j]; }
            if (tw == 0) {
                const size_t grow = (size_t)rowbase + (d ? 63 - lane : lane);
                float v = gbuf[((size_t)d * NT + grow) * 8 + h];
#pragma unroll
                for (int o = 1; o < 64; o <<= 1) { const float t = __shfl_up(v, o); if (lane >= o) v += t; }
                sg[lane] = v; sg[64 + lane] = bbuf[((size_t)d * NT + grow) * 8 + h];
            }
        }
        __syncthreads();
        if (act) {
#pragma unroll 1
            for (int q = 0; q < 2; ++q) {
                const int mt = tw, nt = q;
                f32x16 acc = zero16();
#pragma unroll 4
                for (int ks = 0; ks < 8; ++ks) acc = mfma32(frag_row_x(sX, mt * 32, ks * 16, lane), frag_row_x(sX, nt * 32, ks * 16, lane), acc);
#pragma unroll
                for (int reg = 0; reg < 16; ++reg) {
                    const int i = mt * 32 + crow(reg, lane), j = nt * 32 + (lane & 31);
                    sA[i * 64 + j] = (i > j) ? sg[64 + i] * acc[reg] * __expf(sg[i] - sg[j]) : 0.f;
                }
            }
        }
        __syncthreads();
        if (act && tw == 0) {
            float t[64];
            int ln = lane; asm volatile("" : "+v"(ln));
#pragma unroll
            for (int i = 0; i < 64; ++i) {
                float a0 = (i == ln) ? 1.f : 0.f, a1 = 0.f, a2 = 0.f, a3 = 0.f;
#pragma unroll
                for (int j = 0; j < i; j += 4) {
                    const f32x4 av = *(const LAS f32x4*)(sA + i * 64 + j);
                    a0 -= av.x * t[j];
                    if (j + 1 < i) a1 -= av.y * t[j + 1];
                    if (j + 2 < i) a2 -= av.z * t[j + 2];
                    if (j + 3 < i) a3 -= av.w * t[j + 3];
                }
                t[i] = (a0 + a1) + (a2 + a3);
                __builtin_amdgcn_sched_barrier(0);
            }
            const float cu = sg[64 + lane], cw = cu * __expf(sg[lane]);
            const int ch = lane >> 3, sub = (lane & 7) * 2;
#pragma unroll
            for (int i = 0; i < 64; ++i) {
                const int off = i * 128 + ((ch ^ (i & 7)) << 4) + sub;
                *(LAS bf16_t*)(sT + off) = f2bf(t[i] * cw);
                *(LAS bf16_t*)(sT + 8192 + off) = f2bf(t[i] * cu);
                if ((i & 7) == 7) __builtin_amdgcn_sched_barrier(0);
            }
        }
        __syncthreads();
            {
                const int itemn = min(item + nteams, 4607);
                const int nn = itemn % 36, dn = (itemn / 36) & 1, bhn = itemn / 72, rbn = chunk_rowbase(bhn >> 3, dn, nn);
#pragma unroll
                for (int j = 0; j < 8; ++j) { const int cid = ttid + 128 * j, i = cid >> 4, ch = cid & 15; rk[j] = *(const u32x4*)(kc + ((size_t)rbn + (dn ? 63 - i : i)) * 1024 + (bhn & 7) * 128 + ch * 8); }
            }
        u32x4 rv[8];
        if (act) {
#pragma unroll
            for (int j = 0; j < 8; ++j) {
                const int cid = ttid + 128 * j, i = cid >> 4, ch = cid & 15;
                const size_t grow = (size_t)rowbase + (d ? 63 - i : i);
                rv[j] = *(const u32x4*)(vc + grow * 1024 + h * 128 + ch * 8);
            }
#pragma unroll 1
            for (int q = 0; q < 2; ++q) {
                const int mtk = 2 * tw + q;
                f32x16 acc[2]; acc[0] = zero16(); acc[1] = zero16();
#pragma unroll
                for (int ks = 0; ks < 4; ++ks) {
                    const bf16x8 afr = frag_col_x(sX, mtk * 32, ks * 16, lane);
#pragma unroll
                    for (int it2 = 0; it2 < 2; ++it2) acc[it2] = mfma32(afr, frag_row_t(sT, it2 * 32, ks * 16, lane), acc[it2]);
                }
                bf16_t* dstp = wbuf + (size_t)item * 8192;
#pragma unroll
                for (int it2 = 0; it2 < 2; ++it2) {
                    u32x4 o0, o1; tile_rows8(acc[it2], o0, o1);
                    bf16_t* rp = dstp + (it2 * 32 + (lane & 31)) * 128 + mtk * 32 + 16 * (lane >> 5);
                    *(u32x4*)rp = o0; *(u32x4*)(rp + 8) = o1;
                }
            }
        }
        __syncthreads();
        if (act) {
#pragma unroll
            for (int j = 0; j < 8; ++j) { const int cid = ttid + 128 * j, i = cid >> 4, ch = cid & 15; *(LAS u32x4*)(sX + i * 256 + ((ch ^ (i & 15)) << 4)) = rv[j]; }
        }
        __syncthreads();
        if (act) {
#pragma unroll 1
            for (int q = 0; q < 2; ++q) {
                const int nt = 2 * tw + q;
                f32x16 acc[2]; acc[0] = zero16(); acc[1] = zero16();
#pragma unroll
                for (int ks = 0; ks < 4; ++ks) {
                    const bf16x8 bfr = frag_col_x(sX, nt * 32, ks * 16, lane);
#pragma unroll
                    for (int mt = 0; mt < 2; ++mt) acc[mt] = mfma32(frag_row_t(sT + 8192, mt * 32, ks * 16, lane), bfr, acc[mt]);
                }
                bf16_t* dstp = ubuf + (size_t)item * 8192;
#pragma unroll
                for (int mt = 0; mt < 2; ++mt) {
                    u32x4 o0, o1; tile_rows8(acc[mt], o0, o1);
                    bf16_t* rp = dstp + (nt * 32 + (lane & 31)) * 64 + mt * 32 + 16 * (lane >> 5);
                    *(u32x4*)rp = o0; *(u32x4*)(rp + 8) = o1;
                }
            }
            if (tw == 0) gcbuf[(size_t)item * 64 + lane] = sg[lane];
        }
        __syncthreads();
    }
}

DEV u32x2 pack4(float a, float b, float c, float d) { u32x2 o; o.x = pk2(a, b); o.y = pk2(c, d); return o; }
DEV void phase_scan(const Params& P, ldsp lds0) {
    const bf16_t* qc = (const bf16_t*)(P.ws + OFF_QC);
    const bf16_t* kc = (const bf16_t*)(P.ws + OFF_KC);
    const bf16_t* wbuf = (const bf16_t*)(P.ws + OFF_WBUF);
    const bf16_t* ubuf = (const bf16_t*)(P.ws + OFF_UBUF);
    const float* gcbuf = (const float*)(P.ws + OFF_GC);
    bf16_t* obuf = (bf16_t*)(P.ws + OFF_OBUF);
    const int tid = tid_fresh(), lane = tid & 63, wave = tid >> 6;
    const int mt = wave >> 1, nt = wave & 1;
    const int mt2 = (wave & 3) >> 1, nt2 = wave & 1;
    for (int item = blockIdx.x; item < 256; item += gridDim.x) {
        const int half = item & 1, d = (item >> 1) & 1, bh = item >> 2, b = bh >> 3, h = bh & 7;
        f32x16 S = zero16();
        { LAS unsigned* z = (LAS unsigned*)(lds0 + 1024 + 3 * 17408 + 9216); for (int e = tid; e < 64 * 136 / 2; e += NTHREADS) z[e] = 0u; }
        u32x4 rW[2][2], rK[2][2], rQ[2][2], rU[2]; float rG[2] = {0.f, 0.f};
#pragma unroll
        for (int u = 0; u < 2; ++u) {
            const int citem = (bh * 2 + d) * 36 + u, rowbase = chunk_rowbase(b, d, u);
#pragma unroll
            for (int j = 0; j < 2; ++j) {
                const int cid = tid + NTHREADS * j, i = cid >> 4, ch = cid & 15;
                const size_t grow = (size_t)rowbase + (d ? 63 - i : i);
                rW[u][j] = *(const u32x4*)(wbuf + (size_t)citem * 8192 + i * 128 + ch * 8);
                rK[u][j] = *(const u32x4*)(kc + grow * 1024 + h * 128 + ch * 8);
                rQ[u][j] = rK[u][j];
            }
            { const int dvr = tid >> 3, ch = tid & 7; rU[u] = *(const u32x4*)(ubuf + (size_t)citem * 8192 + (half * 64 + dvr) * 64 + ch * 8); }
            if (tid < 64) rG[u] = gcbuf[(size_t)citem * 64 + tid];
        }
        for (int n2 = 0; n2 < 36; n2 += 2) {
#pragma unroll
        for (int u = 0; u < 2; ++u) {
            const int n = n2 + u;
            const ldsp lds = launder(lds0);
            int ln = lane; asm volatile("" : "+v"(ln));
            LAS float* sg = (LAS float*)lds;
            LAS bf16_t* sW = (LAS bf16_t*)(lds + 1024);
            LAS bf16_t* sK = sW + 64 * 136;
            LAS bf16_t* sQ = sK + 64 * 136;
            LAS bf16_t* sU = sQ + 64 * 136;
            LAS bf16_t* sST = sU + 64 * 72;
            LAS bf16_t* sVNT = sST + 64 * 136;
            LAS bf16_t* sVNsT = sVNT + 64 * 72;
            LAS bf16_t* sATT = sVNsT + 64 * 72;
            LAS bf16_t* sO = sATT + 64 * 72;
            const int rowbase = chunk_rowbase(b, d, n);
            const bool wantO = n >= 4;
#pragma unroll
            for (int j = 0; j < 2; ++j) {
                const int cid = tid + NTHREADS * j, i = cid >> 4, ch = cid & 15;
                *(LAS u32x4*)(sW + i * 136 + ch * 8) = rW[u][j];
                *(LAS u32x4*)(sK + i * 136 + ch * 8) = rK[u][j];
                *(LAS u32x4*)(sQ + i * 136 + ch * 8) = rQ[u][j];
            }
            { const int i = tid >> 3, ch = tid & 7; *(LAS u32x4*)(sU + i * 72 + ch * 8) = rU[u]; }
            if (tid < 64) sg[tid] = rG[u];
            __syncthreads();
            if (n + 2 < 36) {
                const int citem = (bh * 2 + d) * 36 + n + 2, rb1 = chunk_rowbase(b, d, n + 2);
                const bool wq = n + 2 >= 4;
#pragma unroll
                for (int j = 0; j < 2; ++j) {
                    const int cid = tid + NTHREADS * j, i = cid >> 4, ch = cid & 15;
                    const size_t grow = (size_t)rb1 + (d ? 63 - i : i);
                    rW[u][j] = *(const u32x4*)(wbuf + (size_t)citem * 8192 + i * 128 + ch * 8);
                    rK[u][j] = *(const u32x4*)(kc + grow * 1024 + h * 128 + ch * 8);
                    if (wq) rQ[u][j] = *(const u32x4*)(qc + grow * 1024 + h * 128 + ch * 8);
                }
                { const int dvr = tid >> 3, ch = tid & 7; rU[u] = *(const u32x4*)(ubuf + (size_t)citem * 8192 + (half * 64 + dvr) * 64 + ch * 8); }
                if (tid < 64) rG[u] = gcbuf[(size_t)citem * 64 + tid];
            }
            const float g63 = sg[63];
            if (wave < 4) {
                const int dv = nt2 * 32 + (ln & 31);
                float uf[16], ef[16];
#pragma unroll
                for (int rg = 0; rg < 4; ++rg) {
                    const int i0 = mt2 * 32 + 8 * rg + 4 * (ln >> 5);
                    const u32x2 uu = *(const LAS u32x2*)(sU + dv * 72 + i0);
                    const f32x4 gg = *(const LAS f32x4*)(sg + i0);
                    uf[rg * 4 + 0] = bflo(uu.x); uf[rg * 4 + 1] = bfhi(uu.x); uf[rg * 4 + 2] = bflo(uu.y); uf[rg * 4 + 3] = bfhi(uu.y);
#pragma unroll
                    for (int e = 0; e < 4; ++e) ef[rg * 4 + e] = __expf(g63 - gg[e]);
                }
                f32x16 acc = zero16(), accb = zero16();
#pragma unroll
                for (int ks = 0; ks < 8; ks += 2) { acc = mfma32(frag_row(sW, 136, mt2 * 32, ks * 16, ln), frag_row(sST, 136, nt2 * 32, ks * 16, ln), acc);
                    accb = mfma32(frag_row(sW, 136, mt2 * 32, ks * 16 + 16, ln), frag_row(sST, 136, nt2 * 32, ks * 16 + 16, ln), accb); }
#pragma unroll
                for (int rg = 0; rg < 4; ++rg) {
                    const int i0 = mt2 * 32 + 8 * rg + 4 * (ln >> 5);
                    float v[4], vs[4];
#pragma unroll
                    for (int e = 0; e < 4; ++e) { v[e] = uf[rg * 4 + e] - (acc[rg * 4 + e] + accb[rg * 4 + e]); vs[e] = v[e] * ef[rg * 4 + e]; }
                    *(LAS u32x2*)(sVNT + dv * 72 + i0) = pack4(v[0], v[1], v[2], v[3]);
                    *(LAS u32x2*)(sVNsT + dv * 72 + i0) = pack4(vs[0], vs[1], vs[2], vs[3]);
                }
            } else if (wantO) {
                const int i = nt2 * 32 + (ln & 31);
                const float gi = sg[i];
                float df[16];
#pragma unroll
                for (int rg = 0; rg < 4; ++rg) {
                    const int j0 = mt2 * 32 + 8 * rg + 4 * (ln >> 5);
                    const f32x4 gg = *(const LAS f32x4*)(sg + j0);
#pragma unroll
                    for (int e = 0; e < 4; ++e) df[rg * 4 + e] = (i >= j0 + e) ? __expf(fminf(gi - gg[e], 0.f)) : 0.f;
                }
                f32x16 acc = zero16(), accb = zero16();
#pragma unroll
                for (int ks = 0; ks < 8; ks += 2) { acc = mfma32(frag_row(sK, 136, mt2 * 32, ks * 16, ln), frag_row(sQ, 136, nt2 * 32, ks * 16, ln), acc);
                    accb = mfma32(frag_row(sK, 136, mt2 * 32, ks * 16 + 16, ln), frag_row(sQ, 136, nt2 * 32, ks * 16 + 16, ln), accb); }
#pragma unroll
                for (int rg = 0; rg < 4; ++rg) {
                    const int j0 = mt2 * 32 + 8 * rg + 4 * (ln >> 5);
                    float v[4];
#pragma unroll
                    for (int e = 0; e < 4; ++e) v[e] = (acc[rg * 4 + e] + accb[rg * 4 + e]) * df[rg * 4 + e];
                    *(LAS u32x2*)(sATT + i * 72 + j0) = pack4(v[0], v[1], v[2], v[3]);
                }
            }
            __syncthreads();
            if (wave < 4 && wantO) {
                float eg[16];
#pragma unroll
                for (int rg = 0; rg < 4; ++rg) {
                    const f32x4 gg = *(const LAS f32x4*)(sg + mt2 * 32 + 8 * rg + 4 * (ln >> 5));
#pragma unroll
                    for (int e = 0; e < 4; ++e) eg[rg * 4 + e] = __expf(gg[e]);
                }
                f32x16 a1 = zero16(), a1b = zero16(), a2 = zero16();
#pragma unroll
                for (int ks = 0; ks < 8; ks += 2) { a1 = mfma32(frag_row(sQ, 136, mt2 * 32, ks * 16, ln), frag_row(sST, 136, nt2 * 32, ks * 16, ln), a1);
                    a1b = mfma32(frag_row(sQ, 136, mt2 * 32, ks * 16 + 16, ln), frag_row(sST, 136, nt2 * 32, ks * 16 + 16, ln), a1b); }
#pragma unroll
                for (int ks = 0; ks < 4; ++ks) a2 = mfma32(frag_row(sATT, 72, mt2 * 32, ks * 16, ln), frag_row(sVNT, 72, nt2 * 32, ks * 16, ln), a2);
                const int dv = nt2 * 32 + (ln & 31);
#pragma unroll
                for (int rg = 0; rg < 4; ++rg) {
                    const int i0 = mt2 * 32 + 8 * rg + 4 * (ln >> 5);
#pragma unroll
                    for (int e = 0; e < 4; ++e) sO[(i0 + e) * 72 + dv] = f2bf((a1[rg * 4 + e] + a1b[rg * 4 + e]) * eg[rg * 4 + e] + a2[rg * 4 + e]);
                }
            }
            {
                const float gl = __expf(g63);
#pragma unroll
                for (int reg = 0; reg < 16; ++reg) S[reg] *= gl;
#pragma unroll
                for (int ks = 0; ks < 4; ++ks) S = mfma32(frag_col_tr(sK, 136, mt * 32, ks * 16, ln), frag_row(sVNsT, 72, nt * 32, ks * 16, ln), S);
            }
            __syncthreads();
            if (wantO) {
                const int i = tid >> 3, ch = tid & 7;
                const size_t grow = (size_t)rowbase + (d ? 63 - i : i);
                *(u32x4*)(obuf + ((size_t)d * NX + grow) * 1024 + h * 128 + half * 64 + ch * 8) = *(const LAS u32x4*)(sO + i * 72 + ch * 8);
            }
#pragma unroll
            for (int rg = 0; rg < 4; ++rg) {
                const int dk0 = mt * 32 + 8 * rg + 4 * (ln >> 5);
                *(LAS u32x2*)(sST + (nt * 32 + (ln & 31)) * 136 + dk0) = pack4(S[rg * 4 + 0], S[rg * 4 + 1], S[rg * 4 + 2], S[rg * 4 + 3]);
            }
        }
        }
        __syncthreads();
    }
}

DEV void phase_dnout(const Params& P) {
    const bf16_t* obuf = (const bf16_t*)(P.ws + OFF_OBUF);
    const bf16_t* Pz = (const bf16_t*)(P.ws + OFF_PZ);
    bf16_t* A = (bf16_t*)(P.ws + OFF_A);
    const int tid = tid_fresh(); const int wave = tid >> 6, lane = tid & 63;
    for (int row = blockIdx.x * 8 + wave; row < NX; row += gridDim.x * 8) {
#pragma unroll
        for (int c = 0; c < 2; ++c) {
            const int col = c * 512 + lane * 8;
            const u32x4 of = *(const u32x4*)(obuf + (size_t)row * 1024 + col), ob = *(const u32x4*)(obuf + ((size_t)NX + row) * 1024 + col);
            const u32x4 zz = *(const u32x4*)(Pz + (size_t)row * 1024 + col);
            float o[8], o2[8], z[8]; unpack8(of, o); unpack8(ob, o2); unpack8(zz, z);
            float ss = 0.f;
#pragma unroll
            for (int e = 0; e < 8; ++e) { o[e] += o2[e]; ss += o[e] * o[e]; }
            ss = sum16(ss);
            const float rn = rsqrtf(ss * (1.f / 128.f) + EPS);
            float y[8];
#pragma unroll
            for (int e = 0; e < 8; ++e) y[e] = o[e] * rn * P.dn_norm_g[(col & 127) + e] * silu(z[e]);
            u32x4 ov; ov.x = pk2(y[0], y[1]); ov.y = pk2(y[2], y[3]); ov.z = pk2(y[4], y[5]); ov.w = pk2(y[6], y[7]);
            *(u32x4*)(A + (size_t)row * 1024 + col) = ov;
        }
    }
}

namespace pg8 {
#define PG8_LAS __attribute__((address_space(3)))
typedef unsigned short bf16_t;
typedef short bf16x8 __attribute__((ext_vector_type(8)));
typedef float f32x4 __attribute__((ext_vector_type(4)));
typedef unsigned u32x4 __attribute__((ext_vector_type(4)));
constexpr int BM = 256, BK = 64, HALF = 128, HTB = HALF * BK * 2  , STAGE_BYTES = 8 * HTB, NXCD = 8, WGM = 8;

__host__ __device__ __forceinline__ int lds_byte(int r, int c) { const int st = (r >> 4) * 2 + (c >> 5), rr = r & 15, cc = c & 31, ob = rr * 64 + cc * 2; return st * 1024 + (ob ^ (((ob >> 9) & 1) << 5)); }
__host__ __device__ __forceinline__ void stage_rc(int b, int& R, int& C) { const int st = b / 1024, sb = b % 1024, swz = sb ^ (((sb >> 9) & 1) << 5); R = (st >> 1) * 16 + swz / 64; C = (st & 1) * 32 + (swz % 64) / 2; }
__host__ __device__ __forceinline__ int perm32(int rho) { const int n = rho >> 4, i = rho & 15; return 8 * (i >> 2) + 4 * n + (i & 3); }

struct Unit { int pm, pn; };
struct Gemm { const bf16_t* A; const bf16_t* Bt; int M, N, K; };

struct StaticOrder {
    int nM, nN, nwg, G, c;
    __host__ __device__ void init(int M, int N, int G_, int c_) { nM = M / BM; nN = N / BM; nwg = nM * nN; G = G_; c = c_; }
    __host__ __device__ bool next(int i, Unit& u) const {
        const long L = (long)i * G + c; if (L >= nwg) return false;
        int wgid = (int)L; { const int q = nwg / NXCD, r = nwg % NXCD, xcd = wgid % NXCD, off = wgid / NXCD; wgid = (xcd < r ? xcd * (q + 1) : r * (q + 1) + (xcd - r) * q) + off; }
        const int nig = WGM * nN, gid = wgid / nig, fm = gid * WGM, gsz = (nM - fm) < WGM ? (nM - fm) : WGM;
        u.pm = fm + ((wgid % nig) % gsz); u.pn = (wgid % nig) / gsz; return true;
    }
    __device__ __forceinline__ void a_ready(const Unit&) const {}
    __device__ __forceinline__ void done(const Unit&) const {}
};

__device__ __forceinline__ unsigned cvt_pk_bf16(float lo, float hi) { typedef float v2f __attribute__((ext_vector_type(2))); typedef __bf16 v2b __attribute__((ext_vector_type(2))); const v2f v = {lo, hi}; return __builtin_bit_cast(unsigned, __builtin_convertvector(v, v2b)); }
__device__ __forceinline__ u32x4 pack8(const f32x4 v0, const f32x4 v1) { u32x4 w; w.x = cvt_pk_bf16(v0[0], v0[1]); w.y = cvt_pk_bf16(v0[2], v0[3]); w.z = cvt_pk_bf16(v1[0], v1[1]); w.w = cvt_pk_bf16(v1[2], v1[3]); return w; }
struct EpiQ {
    static constexpr bool PERM = true, AFTER_DRAIN = false;
    bf16_t* O; int ldc;
    __device__ __forceinline__ void operator()(const f32x4 (&acc)[2][2][4][2], const Unit& u, int wr, int wc, int fr, int fq) const {
        const int row0 = u.pm * BM + wr * 64 + fr, col0 = u.pn * BM + wc * 32 + 8 * fq;
#pragma unroll
        for (int ai = 0; ai < 2; ++ai)
#pragma unroll
            for (int m = 0; m < 4; ++m) { bf16_t* rowp = O + (size_t)(row0 + ai * HALF + m * 16) * ldc + col0;
#pragma unroll
                for (int bj = 0; bj < 2; ++bj) *(u32x4*)(rowp + bj * HALF) = pack8(acc[ai][bj][m][0], acc[ai][bj][m][1]); }
    }
};
struct EpiWinP {
    static constexpr bool PERM = true, AFTER_DRAIN = false;
    bf16_t* qkv; bf16_t* z; float* ab;
    __device__ __forceinline__ void operator()(const f32x4 (&acc)[2][2][4][2], const Unit& u, int wr, int wc, int fr, int fq) const {
        const int row0 = u.pm * BM + wr * 64 + fr;
        if (u.pn < 16) {
            bf16_t* base = u.pn < 12 ? qkv : z; const int ldc = u.pn < 12 ? 3072 : 1024, col0 = (u.pn < 12 ? u.pn : u.pn - 12) * BM + wc * 32 + 8 * fq;
#pragma unroll
            for (int ai = 0; ai < 2; ++ai)
#pragma unroll
                for (int m = 0; m < 4; ++m) { bf16_t* rowp = base + (size_t)(row0 + ai * HALF + m * 16) * ldc + col0;
#pragma unroll
                    for (int bj = 0; bj < 2; ++bj) *(u32x4*)(rowp + bj * HALF) = pack8(acc[ai][bj][m][0], acc[ai][bj][m][1]); }
        } else if (wc == 0) {
#pragma unroll
            for (int ai = 0; ai < 2; ++ai)
#pragma unroll
                for (int m = 0; m < 4; ++m) { float* rowp = ab + (size_t)(row0 + ai * HALF + m * 16) * 32 + 8 * fq;
                    *(f32x4*)rowp = acc[ai][0][m][0]; *(f32x4*)(rowp + 4) = acc[ai][0][m][1]; }
        }
    }
};
struct EpiRes {
    static constexpr bool PERM = true, AFTER_DRAIN = false;
    bf16_t* h; const float* gate;
    __device__ __forceinline__ void operator()(const f32x4 (&acc)[2][2][4][2], const Unit& u, int wr, int wc, int fr, int fq) const {
        const int row0 = u.pm * BM + wr * 64 + fr, col0 = u.pn * BM + wc * 32 + 8 * fq;
#pragma unroll
        for (int ai = 0; ai < 2; ++ai)
#pragma unroll
            for (int m = 0; m < 4; ++m) { const int row = row0 + ai * HALF + m * 16; bf16_t* rowp = h + (size_t)row * 1024 + col0; const float* gp = gate + (row >> 11) * 6144 + col0;
#pragma unroll
                for (int bj = 0; bj < 2; ++bj) {
                    const u32x4 hv = *(const u32x4*)(rowp + bj * HALF);
                    const f32x4 g0 = *(const f32x4*)(gp + bj * HALF), g1 = *(const f32x4*)(gp + bj * HALF + 4);
                    const f32x4 a0 = acc[ai][bj][m][0], a1 = acc[ai][bj][m][1];
                    f32x4 n0, n1;
                    n0[0] = __uint_as_float(hv.x << 16) + g0[0] * a0[0]; n0[1] = __uint_as_float(hv.x & 0xffff0000u) + g0[1] * a0[1];
                    n0[2] = __uint_as_float(hv.y << 16) + g0[2] * a0[2]; n0[3] = __uint_as_float(hv.y & 0xffff0000u) + g0[3] * a0[3];
                    n1[0] = __uint_as_float(hv.z << 16) + g1[0] * a1[0]; n1[1] = __uint_as_float(hv.z & 0xffff0000u) + g1[1] * a1[1];
                    n1[2] = __uint_as_float(hv.w << 16) + g1[2] * a1[2]; n1[3] = __uint_as_float(hv.w & 0xffff0000u) + g1[3] * a1[3];
                    *(u32x4*)(rowp + bj * HALF) = pack8(n0, n1);
                } }
    }
};

template <class Epi, class Sched, bool ALIGN_EPI = false, bool SP2 = false>
__device__ __forceinline__ void gemm_phase(PG8_LAS unsigned char* lds, const Gemm g, const Sched& S, const Epi& E) {
    const int tid = tid_fresh(), wid = __builtin_amdgcn_readfirstlane(tid >> 6), lane = tid & 63, wr = wid >> 2, wc = wid & 3, fr = lane & 15, fq = lane >> 4;
    const int K = g.K, nt = K / BK;
    unsigned voffA[2], voffB[2];
#pragma unroll
    for (int i = 0; i < 2; ++i) { int R, C; stage_rc(tid * 16 + i * 8192, R, C); const int Rb = Epi::PERM ? ((R & ~31) + perm32(R & 31)) : R;
        voffA[i] = (unsigned)(R * K + C) * 2u; voffB[i] = (unsigned)(Rb * K + C) * 2u; }
    const size_t kstep = (size_t)(BK * 2);
    const size_t hstep = (size_t)HALF * K * 2;
    const size_t tstep = 2 * hstep;
    const unsigned ldsw = (unsigned)wid * 1024u;
    const int aoff = lds_byte(wr * 64 + fr, fq * 8), boff = lds_byte(wc * 32 + fr, fq * 8);
#define PG8_SA(b, h) (((b) * 2 + (h)) * HTB)
#define PG8_SB(b, h) ((4 + (b) * 2 + (h)) * HTB)
#define PG8_STAGE(bufoff, gbase, voff) do { _Pragma("unroll") for (int _i = 0; _i < 2; ++_i) \
        __builtin_amdgcn_global_load_lds((const unsigned*)((const char*)(gbase) + (voff)[_i]), (PG8_LAS unsigned*)(lds + (bufoff) + ldsw + _i * 8192), 16, 0, 0); } while (0)
#define PG8_LDA(dst, b, h) do { _Pragma("unroll") for (int m = 0; m < 4; ++m) _Pragma("unroll") for (int k = 0; k < 2; ++k) dst[m][k] = *(const PG8_LAS bf16x8*)(lds + PG8_SA(b, h) + aoff + m * 2048 + k * 1024); } while (0)
#define PG8_LDB(dst, b, h) do { _Pragma("unroll") for (int n = 0; n < 2; ++n) _Pragma("unroll") for (int k = 0; k < 2; ++k) dst[n][k] = *(const PG8_LAS bf16x8*)(lds + PG8_SB(b, h) + boff + n * 2048 + k * 1024); } while (0)
#define PG8_MMA(ai, bj, At, Bt) do { __builtin_amdgcn_s_setprio(1); _Pragma("unroll") for (int m = 0; m < 4; ++m) _Pragma("unroll") for (int n = 0; n < 2; ++n) _Pragma("unroll") for (int k = 0; k < 2; ++k) \
        acc[ai][bj][m][n] = __builtin_amdgcn_mfma_f32_16x16x32_bf16(Bt[n][k], At[m][k], acc[ai][bj][m][n], 0, 0, 0); __builtin_amdgcn_s_setprio(0); } while (0)
#define PG8_WAIT_V(n) asm volatile("s_waitcnt vmcnt(" #n ")" ::: "memory")
#define PG8_WAIT_L(n) asm volatile("s_waitcnt lgkmcnt(" #n ")" ::: "memory")
#define PG8_BAR __builtin_amdgcn_s_barrier()
#define PG8_SCHED __builtin_amdgcn_sched_barrier(0)
    Unit cur, nxt; int ui = 0;
    if (!S.next(0, cur)) return;
    f32x4 acc[2][2][4][2];
#pragma unroll
    for (int a = 0; a < 2; ++a)
#pragma unroll
        for (int b = 0; b < 2; ++b)
#pragma unroll
            for (int m = 0; m < 4; ++m)
#pragma unroll
                for (int n = 0; n < 2; ++n) acc[a][b][m][n] = (f32x4){0.f, 0.f, 0.f, 0.f};
    bf16x8 At[4][2], B0[2][2], B1[2][2];
    const char* cA = (const char*)g.A + (size_t)cur.pm * tstep; const char* cB = (const char*)g.Bt + (size_t)cur.pn * tstep;
    S.a_ready(cur);
    if constexpr (SP2) {
        PG8_STAGE(PG8_SB(0, 0), cB, voffB); PG8_STAGE(PG8_SB(0, 1), cB + hstep, voffB); PG8_STAGE(PG8_SA(0, 0), cA, voffA); PG8_STAGE(PG8_SA(0, 1), cA + hstep, voffA);
        if (wr == 1) PG8_BAR;
        PG8_WAIT_V(2); PG8_BAR;
        PG8_STAGE(PG8_SB(1, 0), cB + kstep, voffB); PG8_STAGE(PG8_SA(1, 0), cA + kstep, voffA); PG8_STAGE(PG8_SB(1, 1), cB + hstep + kstep, voffB);
        PG8_WAIT_V(6); PG8_BAR;
    } else {
        PG8_STAGE(PG8_SB(0, 0), cB, voffB); PG8_STAGE(PG8_SA(0, 0), cA, voffA); PG8_STAGE(PG8_SB(0, 1), cB + hstep, voffB); PG8_STAGE(PG8_SA(0, 1), cA + hstep, voffA);
        if (wr == 1) PG8_BAR;
        PG8_WAIT_V(4); PG8_BAR;
        PG8_STAGE(PG8_SB(1, 0), cB + kstep, voffB); PG8_STAGE(PG8_SA(1, 0), cA + kstep, voffA); PG8_STAGE(PG8_SB(1, 1), cB + hstep + kstep, voffB);
        PG8_WAIT_V(6); PG8_BAR;
    }
    for (;;) {
        const bool has_next = S.next(ui + 1, nxt);
        const char* nA = has_next ? (const char*)g.A + (size_t)nxt.pm * tstep : cA; const char* nB = has_next ? (const char*)g.Bt + (size_t)nxt.pn * tstep : cB;
        for (int t = 0; t < nt; t += 2) {
            const bool last = (t == nt - 2);
            const char* a1 = cA + (size_t)(t + 1) * kstep;
            const char* a2 = last ? nA : cA + (size_t)(t + 2) * kstep; const char* b2 = last ? nB : cB + (size_t)(t + 2) * kstep;
            const char* a3 = a2 + kstep; const char* b3 = b2 + kstep;
            if (last && has_next) S.a_ready(nxt);
            if constexpr (SP2) {
            PG8_LDB(B0, 0, 0); PG8_LDB(B1, 0, 1); PG8_SCHED; PG8_LDA(At, 0, 0); PG8_STAGE(PG8_SA(1, 1), a1 + hstep, voffA);
            PG8_WAIT_V(8); PG8_WAIT_L(0); PG8_BAR; PG8_MMA(0, 0, At, B0); PG8_MMA(0, 1, At, B1); PG8_BAR; PG8_SCHED;
            PG8_LDA(At, 0, 1); PG8_STAGE(PG8_SB(0, 0), b2, voffB); PG8_STAGE(PG8_SB(0, 1), b2 + hstep, voffB); PG8_STAGE(PG8_SA(0, 0), a2, voffA);
            PG8_WAIT_V(8); PG8_WAIT_L(0); PG8_BAR; PG8_MMA(1, 0, At, B0); PG8_MMA(1, 1, At, B1); PG8_BAR; PG8_SCHED;
            PG8_LDB(B0, 1, 0); PG8_LDB(B1, 1, 1); PG8_SCHED; PG8_LDA(At, 1, 0); PG8_STAGE(PG8_SA(0, 1), a2 + hstep, voffA);
            PG8_WAIT_V(8); PG8_WAIT_L(0); PG8_BAR; PG8_MMA(0, 0, At, B0); PG8_MMA(0, 1, At, B1); PG8_BAR; PG8_SCHED;
            PG8_LDA(At, 1, 1); PG8_STAGE(PG8_SB(1, 0), b3, voffB); PG8_STAGE(PG8_SB(1, 1), b3 + hstep, voffB); PG8_STAGE(PG8_SA(1, 0), a3, voffA);
            PG8_WAIT_V(8); PG8_WAIT_L(0); PG8_BAR; PG8_MMA(1, 0, At, B0); PG8_MMA(1, 1, At, B1); PG8_BAR; PG8_SCHED;
            } else {
            PG8_LDB(B0, 0, 0); PG8_SCHED; PG8_LDA(At, 0, 0); PG8_STAGE(PG8_SA(1, 1), a1 + hstep, voffA);
            PG8_WAIT_L(8); PG8_BAR; PG8_WAIT_L(0); PG8_MMA(0, 0, At, B0); PG8_BAR; PG8_SCHED;
            PG8_LDB(B1, 0, 1); PG8_STAGE(PG8_SB(0, 0), b2, voffB);
            PG8_BAR; PG8_WAIT_L(0); PG8_MMA(0, 1, At, B1); PG8_BAR;
            PG8_LDA(At, 0, 1); PG8_STAGE(PG8_SA(0, 0), a2, voffA);
            PG8_BAR; PG8_WAIT_L(0); PG8_MMA(1, 0, At, B0); PG8_BAR; PG8_SCHED;
            PG8_STAGE(PG8_SB(0, 1), b2 + hstep, voffB);
            PG8_WAIT_V(6); PG8_BAR; PG8_MMA(1, 1, At, B1); PG8_BAR;
            PG8_LDB(B0, 1, 0); PG8_SCHED; PG8_LDA(At, 1, 0); PG8_STAGE(PG8_SA(0, 1), a2 + hstep, voffA);
            PG8_WAIT_L(8); PG8_BAR; PG8_WAIT_L(0); PG8_MMA(0, 0, At, B0); PG8_BAR; PG8_SCHED;
            PG8_LDB(B1, 1, 1); PG8_STAGE(PG8_SB(1, 0), b3, voffB);
            PG8_BAR; PG8_WAIT_L(0); PG8_MMA(0, 1, At, B1); PG8_BAR;
            PG8_LDA(At, 1, 1); PG8_STAGE(PG8_SA(1, 0), a3, voffA);
            PG8_BAR; PG8_WAIT_L(0); PG8_MMA(1, 0, At, B0); PG8_BAR; PG8_SCHED;
            PG8_STAGE(PG8_SB(1, 1), b3 + hstep, voffB);
            PG8_WAIT_V(6); PG8_BAR; PG8_MMA(1, 1, At, B1); PG8_BAR;
            }
        }
        if constexpr (ALIGN_EPI) { if (wr == 0) PG8_BAR; }
        if constexpr (!Epi::AFTER_DRAIN) { E(acc, cur, wr, wc, fr, fq); S.done(cur); }
        if (!has_next) break;
#pragma unroll
        for (int a = 0; a < 2; ++a)
#pragma unroll
            for (int b = 0; b < 2; ++b)
#pragma unroll
                for (int m = 0; m < 4; ++m)
#pragma unroll
                    for (int n = 0; n < 2; ++n) acc[a][b][m][n] = (f32x4){0.f, 0.f, 0.f, 0.f};
        cur = nxt; cA = nA; cB = nB; ++ui;
        if constexpr (ALIGN_EPI) { if (wr == 1) PG8_BAR; }
    }
    PG8_WAIT_V(0);
    if constexpr (!ALIGN_EPI) { if (wr == 0) PG8_BAR; }
    PG8_BAR;
    if constexpr (Epi::AFTER_DRAIN) { E.fused(acc, cur, wr, wc, fr, fq, lds, wid, lane); S.done(cur); }
#undef PG8_SA
#undef PG8_SB
#undef PG8_STAGE
#undef PG8_LDA
#undef PG8_LDB
#undef PG8_MMA
#undef PG8_WAIT_V
#undef PG8_WAIT_L
#undef PG8_BAR
#undef PG8_SCHED
}
}

#define XB_TMO      128
#define XB_XCNT(j)  (256  + 64 * (j))
#define XB_XSUB(j)  (1280 + 64 * (j))
#define XB_XGEN(j)  (2304 + 64 * (j))
#define XB_TOP      3328
#define XB_TOPGEN   3392
#define XCD_BAR_WORDS 3456
#define XB_SPIN_CAP (1u << 22)
DEV unsigned xb_ld(unsigned* p)              { return __hip_atomic_load(p, __ATOMIC_RELAXED, __HIP_MEMORY_SCOPE_AGENT); }
DEV unsigned xb_add(unsigned* p, unsigned v) { return __hip_atomic_fetch_add(p, v, __ATOMIC_RELAXED, __HIP_MEMORY_SCOPE_AGENT); }
DEV unsigned xb_xcc_id() { return (unsigned)__builtin_amdgcn_s_getreg((3 << 11) | 20) & 0xFu; }
#define XB_SPIN(cond, bar) do { unsigned _sp = 0; while (cond) { __builtin_amdgcn_s_sleep(1); \
    if ((++_sp & 255u) == 0u) { if (xb_ld(&(bar)[XB_TMO])) break; if (_sp > XB_SPIN_CAP) { atomicAdd(&(bar)[XB_TMO], 1u); break; } } } } while (0)
struct XcdBarrier { unsigned* bar; unsigned x; volatile LAS unsigned* st; };
DEV XcdBarrier xcd_barrier_post(unsigned* bar, volatile LAS unsigned* st) {
    XcdBarrier b; b.bar = bar; b.x = xb_xcc_id(); b.st = st;
    if (threadIdx.x == 0) (void)xb_add(&bar[XB_XCNT(b.x)], 1u);
    return b;
}
DEV void xcd_barrier_complete(unsigned* bar, unsigned x, unsigned& nloc, unsigned& nx) {
    const unsigned G = gridDim.x * gridDim.y * gridDim.z;
    unsigned sum, cnt, mine, sp = 0u;
    for (;;) {
        sum = 0u; cnt = 0u; mine = 0u;
#pragma unroll
        for (unsigned j = 0; j < 16; ++j) { const unsigned c = xb_ld(&bar[XB_XCNT(j)]); sum += c; cnt += (c > 0u) ? 1u : 0u; mine = (j == x) ? c : mine; }
        if (sum == G) break;
        __builtin_amdgcn_s_sleep(1);
        if ((++sp & 255u) == 0u) { if (xb_ld(&bar[XB_TMO])) break; if (sp > XB_SPIN_CAP) { atomicAdd(&bar[XB_TMO], 1u); break; } }
    }
    nloc = mine > 0u ? mine : 1u; nx = cnt > 0u ? cnt : 1u;
}
DEV void xcd_barrier(const XcdBarrier& b) {
    asm volatile("s_waitcnt vmcnt(0)" ::: "memory");
    __syncthreads();
    if (threadIdx.x == 0) {
        unsigned* bar = b.bar;
        __builtin_amdgcn_s_waitcnt(0);
        unsigned nloc = b.st[0], nx = b.st[1];
        if (nloc == 0u) { xcd_barrier_complete(bar, b.x, nloc, nx); b.st[0] = nloc; b.st[1] = nx; }
        const unsigned old = xb_add(&bar[XB_XSUB(b.x)], 1u);
        const unsigned gen = old / nloc;
        if (old + 1u == (gen + 1u) * nloc) {
            __builtin_amdgcn_fence(__ATOMIC_RELEASE, "agent");
            asm volatile("s_waitcnt vmcnt(0)" ::: "memory");
            const unsigned og = xb_add(&bar[XB_TOP], 1u);
            const unsigned tg = og / nx;
            if (og + 1u == (tg + 1u) * nx) xb_add(&bar[XB_TOPGEN], 1u);
            else XB_SPIN(xb_ld(&bar[XB_TOPGEN]) == tg, bar);
            __builtin_amdgcn_fence(__ATOMIC_ACQUIRE, "agent");
            xb_add(&bar[XB_XGEN(b.x)], 1u);
            asm volatile("s_waitcnt vmcnt(0)" ::: "memory");
        } else {
            XB_SPIN(xb_ld(&bar[XB_XGEN(b.x)]) == gen, bar);
            __builtin_amdgcn_fence(__ATOMIC_ACQUIRE, "agent");
            asm volatile("s_waitcnt vmcnt(0)" ::: "memory");
        }
    }
    __syncthreads();
}

__global__ void __launch_bounds__(NTHREADS) fwd_megakernel(Params P) {
    __shared__ __attribute__((aligned(16))) unsigned char lds_raw[131072 + 4096];
    const ldsp lds = (ldsp)lds_raw;
    cg::grid_group grid = cg::this_grid();
    volatile LAS unsigned* xbst = (volatile LAS unsigned*)(lds + 131072);
    if (threadIdx.x == 0) { xbst[0] = 0u; xbst[1] = 0u; }
    __syncthreads();
    const XcdBarrier xbar = xcd_barrier_post((unsigned*)(P.ws + OFF_BAR), xbst);
    if (threadIdx.x == 0) xbst[2] = xb_add((unsigned*)(P.ws + OFF_BAR) + xbar.x, 1u);
#define GBAR() xcd_barrier(xbar)
    const float* modv = (const float*)(P.ws + OFF_MODV);
    bf16_t* Abuf = (bf16_t*)(P.ws + OFF_A);

#define RUN(rep, ...) for (int rep_i = 0; rep_i < (rep); ++rep_i) { __VA_ARGS__; GBAR(); }
    for (int rep_i = 0; rep_i < REP_PREP; ++rep_i) { phase_prep(P, lds); grid.sync(); }
    if (threadIdx.x == 0) {
        unsigned* bar = (unsigned*)(P.ws + OFF_BAR);
        unsigned nact = 0, pos = 0, mine = 1;
        for (unsigned j = 0; j < 16; ++j) { const unsigned cn = xb_ld(&bar[XB_XCNT(j)]); if (cn) { if (j < xbar.x) ++pos; ++nact; } if (j == xbar.x) mine = cn; }
        xbst[3] = nact ? nact : 1u; xbst[4] = pos; xbst[5] = mine ? mine : 1u;
    }
    __syncthreads();
    XGeo geo; geo.rank = __builtin_amdgcn_readfirstlane((int)xbst[2]); geo.nact = __builtin_amdgcn_readfirstlane((int)xbst[3]); geo.pos = __builtin_amdgcn_readfirstlane((int)xbst[4]); geo.nloc = __builtin_amdgcn_readfirstlane((int)xbst[5]);
    RUN(REP_MOD, phase_modulate<0>(P, 0, 0, NT))
    RUN(REP_POOL, phase_pool(P, lds))
    RUN(REP_MOD, phase_modulate<1>(P, 0, 1, NT, true))
    RUN(REP_GEMM, { pg8::Gemm g{Abuf, (const bf16_t*)(P.ws + OFF_WQT), NT, 2048, 1024}; pg8::StaticOrder S; S.init(NT, 2048, gridDim.x, blockIdx.x); pg8::EpiQ e{(bf16_t*)(P.ws + OFF_R1), 2048}; pg8::gemm_phase<pg8::EpiQ, pg8::StaticOrder, true, true>(lds, g, S, e); })
    RUN(REP_TOPK, phase_topk(P, 0, NT, lds))
    phase_experts_sliced<1>(P, 0, NT, geo); GBAR();
    phase_experts_act(P, 0, NT); GBAR();
    phase_experts_sliced<2>(P, 0, NT, geo); GBAR();
    RUN(REP_MOD, phase_modulate<1>(P, 1, 0, NT))
    RUN(REP_GEMM, { pg8::Gemm g{Abuf, (const bf16_t*)(P.ws + OFF_WINT), NT, 4352, 1024}; pg8::StaticOrder S; S.init(NT, 4352, gridDim.x, blockIdx.x);
      pg8::EpiWinP e{(bf16_t*)(P.ws + OFF_R1), (bf16_t*)(P.ws + OFF_PZ), (float*)(P.ws + OFF_AB)}; pg8::gemm_phase<pg8::EpiWinP, pg8::StaticOrder, true, true>(lds, g, S, e); })
    RUN(REP_CONV, phase_conv(P))
    RUN(REP_CHUNK, phase_chunk(P, lds))
    RUN(REP_SCAN, phase_scan(P, lds))
    RUN(REP_DNOUT, phase_dnout(P))
    { pg8::Gemm g{Abuf, (const bf16_t*)(P.ws + OFF_WOUTT), NX, 1024, 1024}; pg8::StaticOrder S; S.init(NX, 1024, gridDim.x, blockIdx.x); pg8::EpiRes e{(bf16_t*)(P.ws + OFF_H), modv + 9 * 6144 + 2048}; pg8::gemm_phase<pg8::EpiRes, pg8::StaticOrder, false, true>(lds, g, S, e); }
    GBAR();
    RUN(REP_MOD, phase_modulate<1>(P, 1, 1, NX, true))
    RUN(REP_GEMM, { pg8::Gemm g{Abuf, (const bf16_t*)(P.ws + OFF_WQT) + (size_t)2048 * 1024, NX, 2048, 1024}; pg8::StaticOrder S; S.init(NX, 2048, gridDim.x, blockIdx.x); pg8::EpiQ e{(bf16_t*)(P.ws + OFF_R1), 2048}; pg8::gemm_phase<pg8::EpiQ, pg8::StaticOrder, true, true>(lds, g, S, e); })
    RUN(REP_TOPK, phase_topk(P, 1, NX, lds))
    phase_experts_sliced<1>(P, 1, NX, geo); GBAR();
    phase_experts_act(P, 1, NX); GBAR();
    phase_experts_sliced<2>(P, 1, NX, geo); GBAR();
    phase_final(P);
}

extern "C" void kernel_launch(void* const* d_in, const int* in_sizes, int n_in, void* d_out, int out_size, void* d_ws, size_t ws_size, hipStream_t stream) {
    static int grid_blocks = 0;
    if (grid_blocks == 0) {
        if (n_in != 21 || out_size != NX * D || ws_size < WS_END) {
            fprintf(stderr, "kernel_launch: unexpected shapes: n_in %d out %d ws %zu (need %zu)\n", n_in, out_size, ws_size, (size_t)WS_END);
            grid_blocks = -1; return;
        }
        int dev = 0, cus = 0, per_cu = 0;
        hipGetDevice(&dev);
        hipDeviceGetAttribute(&cus, hipDeviceAttributeMultiprocessorCount, dev);
        hipOccupancyMaxActiveBlocksPerMultiprocessor(&per_cu, fwd_megakernel, NTHREADS, 0);
        if (per_cu < 1) { fprintf(stderr, "kernel_launch: occupancy query reports %d blocks per CU\n", per_cu); grid_blocks = -1; return; }
        grid_blocks = cus;
    }
    if (grid_blocks < 0) return;
    if (hipMemsetAsync((char*)d_ws + OFF_BAR, 0, XCD_BAR_WORDS * 4, stream) != hipSuccess) { fprintf(stderr, "kernel_launch: memset of barrier words failed\n"); return; }
    Params p{};
    const float** pp = (const float**)&p;
    for (int i = 0; i < 21; ++i) pp[i] = (const float*)d_in[i];
    p.out = (float*)d_out; p.ws = (unsigned char*)d_ws;
    void* args[] = {&p};
    hipError_t e = hipLaunchCooperativeKernel((void*)fwd_megakernel, dim3(grid_blocks), dim3(NTHREADS), args, 0, stream);
    if (e != hipSuccess) fprintf(stderr, "cooperative launch failed: %s (grid %d)\n", hipGetErrorString(e), grid_blocks);
}
```

```cpp
#include <hip/hip_runtime.h>
#include <hip/hip_cooperative_groups.h>
#include <cstdio>
#include <cstdint>
namespace cg = cooperative_groups;

#define DEV __device__ __forceinline__
typedef unsigned short bf16_t;
typedef short bf16x8 __attribute__((ext_vector_type(8)));
typedef float f32x4 __attribute__((ext_vector_type(4)));
typedef float f32x16 __attribute__((ext_vector_type(16)));
typedef unsigned u32x4 __attribute__((ext_vector_type(4)));
typedef unsigned u32x2 __attribute__((ext_vector_type(2)));
#define LAS __attribute__((address_space(3)))
typedef LAS unsigned char* ldsp;
DEV int tid_fresh() { int t = threadIdx.x; asm volatile("" : "+v"(t)); return t; }
DEV ldsp launder(ldsp p) { asm volatile("" : "+v"(p)); return p; }

constexpr int D = 1024, NB = 8, SEQ = 2048, CTX = 256;
constexpr int NX = NB * SEQ, NC = NB * CTX, NT = NX + NC;
constexpr int NTHREADS = 512;
constexpr float EPS = 1e-6f;
#ifndef REP_PREP
#define REP_PREP 1
#endif
#ifndef REP_MOD
#define REP_MOD 1
#endif
#ifndef REP_POOL
#define REP_POOL 1
#endif
#ifndef REP_GEMM
#define REP_GEMM 1
#endif
#ifndef REP_TOPK
#define REP_TOPK 1
#endif
#ifndef REP_CONV
#define REP_CONV 1
#endif
#ifndef REP_CHUNK
#define REP_CHUNK 1
#endif
#ifndef REP_SCAN
#define REP_SCAN 1
#endif
#ifndef REP_DNOUT
#define REP_DNOUT 1
#endif

constexpr size_t MiB = 1024 * 1024;
constexpr size_t TAB_ELEMS = (size_t)16384 * 1024;
constexpr size_t OFF_TAB   = 0;
constexpr size_t OFF_WQT   = 128 * MiB;
constexpr size_t OFF_WINT  = OFF_WQT + 8 * MiB;
constexpr size_t OFF_WOUTT = OFF_WINT + (size_t)4352 * 1024 * 2;
constexpr size_t OFF_POOLT = OFF_WOUTT + 2 * MiB;
constexpr size_t OFF_KEYS  = OFF_POOLT + 512 * 1024;
constexpr size_t OFF_MODV  = OFF_KEYS + 1 * MiB;
constexpr size_t OFF_HC    = OFF_MODV + 512 * 1024;
constexpr size_t OFF_SELI  = OFF_HC + 8 * MiB;
constexpr size_t OFF_SELG  = OFF_SELI + (size_t)NT * 128 * 4;
constexpr size_t OFF_AB    = OFF_SELG + (size_t)NT * 128 * 4;
constexpr size_t OFF_G     = OFF_AB + (size_t)NT * 32 * 4;
constexpr size_t OFF_BETA  = OFF_G + (size_t)2 * NT * 8 * 4;
constexpr size_t OFF_GC    = OFF_BETA + (size_t)2 * NT * 8 * 4;
constexpr size_t OFF_QC    = OFF_GC + (size_t)4608 * 64 * 4;
constexpr size_t OFF_KC    = OFF_QC + (size_t)NT * 1024 * 2;
constexpr size_t OFF_VC    = OFF_KC + (size_t)NT * 1024 * 2;
constexpr size_t OFF_A     = OFF_VC + (size_t)NT * 1024 * 2;
constexpr size_t OFF_R1    = OFF_A + (size_t)NT * 1024 * 2;
constexpr size_t OFF_PZ    = OFF_R1 + (size_t)NT * 3072 * 2;
constexpr size_t OFF_BAR   = OFF_R1 + (size_t)NT * 4096 * 2;
constexpr size_t OFF_H     = OFF_BAR + 16384;
constexpr size_t OFF_XS    = OFF_H + (size_t)NT * 1024 * 2;
constexpr size_t OFF_RSC   = OFF_XS + (size_t)NT * 4;
constexpr size_t WS_END    = OFF_RSC + (size_t)4 * 16384 * 4;
constexpr size_t OFF_WBUF  = OFF_A;
constexpr size_t OFF_UBUF  = OFF_A + (size_t)4608 * 8192 * 2;
constexpr size_t OFF_OBUF  = OFF_TAB + 64 * MiB;
constexpr size_t OFF_PART  = OFF_QC;
constexpr size_t OFF_WEXP  = OFF_QC + (size_t)8 * NT * 128 * 4;
constexpr size_t OFF_A8    = OFF_WEXP + (size_t)NT * 128 * 4;
static_assert(OFF_UBUF + (size_t)4608 * 8192 * 2 <= OFF_PZ, "w/u overlay must not reach Pz");
static_assert(OFF_A8 + (size_t)NT * 1024 <= OFF_A, "PEER partial buffers must fit the q/k/v conv region");

struct Params {
    const float *x, *c, *ctx, *c_ctx, *mod_w, *mod_b, *norm1_g, *norm2_g, *pool_w, *pool_scale;
    const float *dn_w_in, *dn_conv_w, *dn_a_log, *dn_dt_bias, *dn_norm_g, *dn_w_out;
    const float *peer_wq, *peer_keys, *peer_u, *peer_v, *final_g;
    float* out; unsigned char* ws;
};

DEV bf16_t f2bf(float f) { return __builtin_bit_cast(unsigned short, (__bf16)f); }
DEV float bf2f(bf16_t h) { return __uint_as_float(((unsigned)h) << 16); }
typedef float f32x2_t __attribute__((ext_vector_type(2)));
typedef __bf16 bf16x2_t __attribute__((ext_vector_type(2)));
DEV unsigned pk2(float a, float b) { const f32x2_t v = {a, b}; const bf16x2_t r = __builtin_convertvector(v, bf16x2_t); return __builtin_bit_cast(unsigned, r); }
DEV float bflo(unsigned u) { return __uint_as_float(u << 16); }
DEV float bfhi(unsigned u) { return __uint_as_float(u & 0xffff0000u); }
DEV float wave_sum(float v) {
#pragma unroll
    for (int o = 32; o >= 1; o >>= 1) v += __shfl_xor(v, o);
    return v;
}
DEV float wave_max(float v) {
#pragma unroll
    for (int o = 32; o >= 1; o >>= 1) v = fmaxf(v, __shfl_xor(v, o));
    return v;
}
DEV float sum16(float v) {
#pragma unroll
    for (int o = 8; o >= 1; o >>= 1) v += __shfl_xor(v, o);
    return v;
}
DEV f32x16 mfma32(bf16x8 a, bf16x8 b, f32x16 c) { return __builtin_amdgcn_mfma_f32_32x32x16_bf16(a, b, c, 0, 0, 0); }
DEV int crow(int reg, int lane) { return (reg & 3) + 8 * (reg >> 2) + 4 * (lane >> 5); }
DEV f32x16 zero16() { f32x16 z;
#pragma unroll
    for (int i = 0; i < 16; ++i) z[i] = 0.f; return z; }
DEV bf16_t* hrow(const Params& P, int r) { return (bf16_t*)(P.ws + OFF_H) + (size_t)r * 1024; }
DEV float silu(float v) { return v * __builtin_amdgcn_rcpf(1.f + __expf(-v)); }

DEV bf16x8 frag_row(const LAS bf16_t* m, int ld, int r0, int k0, int lane) {
    return *(const LAS bf16x8*)(m + (r0 + (lane & 31)) * ld + k0 + 8 * (lane >> 5));
}
DEV bf16x8 frag_col(const LAS bf16_t* m, int ld, int c0, int k0, int lane) {
    bf16x8 f;
#pragma unroll
    for (int j = 0; j < 8; ++j) f[j] = (short)m[(k0 + 8 * (lane >> 5) + j) * ld + c0 + (lane & 31)];
    return f;
}

typedef short s16x4 __attribute__((ext_vector_type(4)));
DEV s16x4 ds_tr16(ldsp p) { return __builtin_amdgcn_ds_read_tr16_b64_v4i16((LAS s16x4*)p); }
DEV bf16x8 frag_col_tr(const LAS bf16_t* m, int ld, int c0, int k0, int lane) {
    const int gi = lane >> 4, li = lane & 15, q = li >> 2, pc = li & 3, h = gi >> 1;
    const LAS bf16_t* p = m + (k0 + 8 * h + q) * ld + c0 + 16 * (gi & 1) + 4 * pc;
    const s16x4 lo = ds_tr16((ldsp)p), hi = ds_tr16((ldsp)(p + 4 * ld));
    bf16x8 f; f[0] = lo[0]; f[1] = lo[1]; f[2] = lo[2]; f[3] = lo[3]; f[4] = hi[0]; f[5] = hi[1]; f[6] = hi[2]; f[7] = hi[3];
    return f;
}
DEV void p0_convert_item(const float* src, bf16_t* dst, size_t base) {
    const int tid = tid_fresh();
#pragma unroll
    for (int it = 0; it < 8; ++it) {
        const size_t e = base + ((size_t)it * NTHREADS + tid) * 8;
        const f32x4 a = *(const f32x4*)(src + e), b = *(const f32x4*)(src + e + 4);
        u32x4 o; o.x = pk2(a.x, a.y); o.y = pk2(a.z, a.w); o.z = pk2(b.x, b.y); o.w = pk2(b.z, b.w);
        *(u32x4*)(dst + e) = o;
    }
}
DEV void p0_table_item(const float* src, unsigned char* dst, float* rscale, int row0, bool as_int8) {
    const int tid = tid_fresh(), wave = tid >> 6, lane = tid & 63;
#pragma unroll 8
    for (int rr = 0; rr < 16; ++rr) {
        const int e = row0 + wave * 16 + rr;
        f32x4 v[4]; float am = 0.f;
#pragma unroll
        for (int q = 0; q < 4; ++q) { v[q] = __builtin_nontemporal_load((const f32x4*)(src + (size_t)e * 1024 + 256 * q + 4 * lane));
            am = fmaxf(am, fmaxf(fmaxf(fabsf(v[q].x), fabsf(v[q].y)), fmaxf(fabsf(v[q].z), fabsf(v[q].w)))); }
        am = wave_max(am);
        if (as_int8) {
            float ssq = 0.f;
#pragma unroll
            for (int q = 0; q < 4; ++q) ssq += v[q].x * v[q].x + v[q].y * v[q].y + v[q].z * v[q].z + v[q].w * v[q].w;
            ssq = wave_sum(ssq);
            const float top = fminf(am, 2.7f * sqrtf(ssq * (1.f / 1024.f)));
            am = top;
            const float sc = am > 0.f ? 7.f / am : 0.f;
#pragma unroll
            for (int q = 0; q < 4; ++q) {
                const int n0 = (int)fminf(fmaxf(rintf(v[q].x * sc), -7.f), 7.f) + 8, n1 = (int)fminf(fmaxf(rintf(v[q].y * sc), -7.f), 7.f) + 8;
                const int n2 = (int)fminf(fmaxf(rintf(v[q].z * sc), -7.f), 7.f) + 8, n3 = (int)fminf(fmaxf(rintf(v[q].w * sc), -7.f), 7.f) + 8;
                *(unsigned short*)(dst + ((size_t)q * 16384 + e) * 128 + 2 * lane) = (unsigned short)(n0 | (n1 << 4) | (n2 << 8) | (n3 << 12));
            }
            if (lane == 0) rscale[e] = am * (1.f / 7.f);
        } else {
            float ssq = 0.f;
#pragma unroll
            for (int q = 0; q < 4; ++q) ssq += v[q].x * v[q].x + v[q].y * v[q].y + v[q].z * v[q].z + v[q].w * v[q].w;
            ssq = wave_sum(ssq);
            const float top = fminf(am, 2.8f * sqrtf(ssq * (1.f / 1024.f)));
            const float sc = top > 0.f ? 6.f / top : 0.f;
#pragma unroll
            for (int q = 0; q < 4; ++q) {
                const float x0 = fminf(fmaxf(v[q].x * sc, -6.f), 6.f), x1 = fminf(fmaxf(v[q].y * sc, -6.f), 6.f), x2 = fminf(fmaxf(v[q].z * sc, -6.f), 6.f), x3 = fminf(fmaxf(v[q].w * sc, -6.f), 6.f);
                unsigned w = __builtin_amdgcn_cvt_scalef32_pk_fp4_f32(0u, x0, x1, 1.0f, 0);
                w = __builtin_amdgcn_cvt_scalef32_pk_fp4_f32(w, x2, x3, 1.0f, 1);
                *(unsigned short*)(dst + ((size_t)q * 16384 + e) * 128 + 2 * lane) = (unsigned short)(w & 0xffffu);
            }
            if (lane == 0) rscale[e] = top * (1.f / 6.f);
        }
    }
}
DEV void p0_transpose_item(const float* W, int K, int N, bf16_t* Wt, int kt, int nt, LAS float* tile) {
    const int tid = tid_fresh(), k0 = kt * 64, n0 = nt * 256;
    f32x4 v[8];
#pragma unroll
    for (int p = 0; p < 8; ++p) {
        const int kk = p * 8 + (tid >> 6), nn = (tid & 63) * 4, n = n0 + nn;
        v[p] = (f32x4){0.f, 0.f, 0.f, 0.f};
        if (n < N) v[p] = __builtin_nontemporal_load((const f32x4*)(W + (size_t)(k0 + kk) * N + n));
    }
#pragma unroll
    for (int p = 0; p < 8; ++p) {
        const int kk = p * 8 + (tid >> 6), nn = (tid & 63) * 4;
        tile[kk * 257 + nn + 0] = v[p].x; tile[kk * 257 + nn + 1] = v[p].y; tile[kk * 257 + nn + 2] = v[p].z; tile[kk * 257 + nn + 3] = v[p].w;
    }
    __syncthreads();
#pragma unroll
    for (int q = 0; q < 4; ++q) {
        const int n = q * 64 + (tid >> 3), kc = (tid & 7) * 8;
        u32x4 o;
        o.x = pk2(tile[(kc + 0) * 257 + n], tile[(kc + 1) * 257 + n]);
        o.y = pk2(tile[(kc + 2) * 257 + n], tile[(kc + 3) * 257 + n]);
        o.z = pk2(tile[(kc + 4) * 257 + n], tile[(kc + 5) * 257 + n]);
        o.w = pk2(tile[(kc + 6) * 257 + n], tile[(kc + 7) * 257 + n]);
        *(u32x4*)(Wt + (size_t)(n0 + n) * K + k0 + kc) = o;
    }
    __syncthreads();
}
DEV void p0_mod_item(const Params& P, int i, int cb, LAS float* lds) {
    LAS float* s = lds;
    LAS float* red = lds + 9 * 1024;
    const int tid = tid_fresh();
    for (int e = tid; e < 9 * 1024; e += NTHREADS) {
        const int m = e >> 10, k = e & 1023;
        const float cv = m < 8 ? P.c[m * 1024 + k] : P.c_ctx[k];
        s[e] = silu(cv);
    }
    __syncthreads();
    const int cq = tid & 31, kg = tid >> 5;
    const float* W = P.mod_w + (size_t)i * 1024 * 6144 + cb * 128 + cq * 4;
    f32x4 acc[9];
#pragma unroll
    for (int m = 0; m < 9; ++m) acc[m] = (f32x4){0.f, 0.f, 0.f, 0.f};
#pragma unroll 16
    for (int kk = 0; kk < 64; ++kk) {
        const int k = kg * 64 + kk;
        const f32x4 w = __builtin_nontemporal_load((const f32x4*)(W + (size_t)k * 6144));
#pragma unroll
        for (int m = 0; m < 9; ++m) { const float sv = s[m * 1024 + k]; acc[m] += w * sv; }
    }
#pragma unroll
    for (int m = 0; m < 9; ++m) *(LAS f32x4*)&red[(kg * 9 + m) * 128 + cq * 4] = acc[m];
    __syncthreads();
    float* modv = (float*)(P.ws + OFF_MODV);
    for (int e = tid; e < 9 * 128; e += NTHREADS) {
        const int m = e >> 7, col = e & 127;
        float sum = 0.f;
#pragma unroll
        for (int g = 0; g < 16; ++g) sum += red[(g * 9 + m) * 128 + col];
        modv[(size_t)(i * 9 + m) * 6144 + cb * 128 + col] = sum + P.mod_b[i * 6144 + cb * 128 + col];
    }
    __syncthreads();
}
DEV void phase_prep(const Params& P, ldsp lds0) {
    constexpr int N_MOD = 96, N_WQ = 2 * 16 * 8, N_WIN = 16 * 17, N_WOUT = 16 * 4, N_POOL = 4 * 4;
    constexpr int N_TR = N_WQ + N_WIN + N_WOUT + N_POOL, N_TAB = 4 * 128, N_KEYS = 16;
    constexpr int TOTAL = N_MOD + N_TR + N_TAB + N_KEYS;
    for (int item = blockIdx.x; item < TOTAL; item += gridDim.x) {
        LAS float* lds = (LAS float*)launder(lds0);
        int r = item;
        if (r < N_MOD) { p0_mod_item(P, r / 48, r % 48, lds); continue; }
        r -= N_MOD;
        if (r < N_WQ) { const int i = r / 128, t = r % 128;
            p0_transpose_item(P.peer_wq + (size_t)i * 1024 * 2048, 1024, 2048, (bf16_t*)(P.ws + OFF_WQT) + (size_t)i * 2048 * 1024, t / 8, t % 8, lds); continue; }
        r -= N_WQ;
        if (r < N_WIN) { p0_transpose_item(P.dn_w_in, 1024, 4128, (bf16_t*)(P.ws + OFF_WINT), r / 17, r % 17, lds); continue; }
        r -= N_WIN;
        if (r < N_WOUT) { p0_transpose_item(P.dn_w_out, 1024, 1024, (bf16_t*)(P.ws + OFF_WOUTT), r / 4, r % 4, lds); continue; }
        r -= N_WOUT;
        if (r < N_POOL) { const int g = r / 4, t = r % 4;
            p0_transpose_item(P.pool_w + (size_t)g * 65536, 256, 256, (bf16_t*)(P.ws + OFF_POOLT) + (size_t)g * 65536, t, 0, lds); continue; }
        r -= N_POOL;
        if (r < N_TAB) { const int tb = r / 128, ch = r % 128;
            const float* src = ((tb & 1) ? P.peer_v : P.peer_u) + (size_t)(tb >> 1) * TAB_ELEMS;
            p0_table_item(src, P.ws + OFF_TAB + (size_t)tb * 16 * MiB, (float*)(P.ws + OFF_RSC) + tb * 16384, ch * 128, (tb & 1) == 0); continue; }
        r -= N_TAB;
        p0_convert_item(P.peer_keys, (bf16_t*)(P.ws + OFF_KEYS), (size_t)r * 32768);
    }
}

template <int SRC>
DEV void phase_modulate(const Params& P, int layer, int which, int nrows, bool q8 = false) {
    const float* gain = (which ? P.norm2_g : P.norm1_g) + layer * 1024;
    const float* modv = (const float*)(P.ws + OFF_MODV) + (size_t)layer * 9 * 6144;
    bf16_t* A = (bf16_t*)(P.ws + OFF_A);
    const int tid = tid_fresh(); const int wave = tid >> 6, lane = tid & 63;
    for (int r = blockIdx.x * 8 + wave; r < nrows; r += gridDim.x * 8) {
        const int m = r < NX ? (r >> 11) : 8;
        const float* sh = modv + m * 6144 + which * 3072;
        const float* sc = sh + 1024;
        f32x4 v[4]; float ss = 0.f;
#pragma unroll
        for (int j = 0; j < 4; ++j) {
            if (SRC == 0) { const float* src = r < NX ? P.x + (size_t)r * 1024 : P.ctx + (size_t)(r - NX) * 1024; v[j] = *(const f32x4*)(src + j * 256 + lane * 4); }
            else { const u32x2 hv = *(const u32x2*)(hrow(P, r) + j * 256 + lane * 4); v[j] = (f32x4){bflo(hv.x), bfhi(hv.x), bflo(hv.y), bfhi(hv.y)}; }
            ss += v[j].x * v[j].x + v[j].y * v[j].y + v[j].z * v[j].z + v[j].w * v[j].w;
        }
        ss = wave_sum(ss);
        const float rstd = rsqrtf(ss * (1.f / 1024.f) + EPS);
#pragma unroll
        for (int j = 0; j < 4; ++j) {
            const int col = j * 256 + lane * 4;
            const f32x4 g = *(const f32x4*)(gain + col), s1 = *(const f32x4*)(sc + col), s0 = *(const f32x4*)(sh + col);
            const f32x4 y = v[j] * rstd * g * (1.f + s1) + s0;
            u32x2 o; o.x = pk2(y.x, y.y); o.y = pk2(y.z, y.w);
            *(u32x2*)(A + (size_t)r * 1024 + col) = o;
            v[j] = y;
        }
        if (q8) {
            float am = 0.f;
#pragma unroll
            for (int j = 0; j < 4; ++j) am = fmaxf(am, fmaxf(fmaxf(fabsf(v[j].x), fabsf(v[j].y)), fmaxf(fabsf(v[j].z), fabsf(v[j].w))));
            am = wave_max(am);
            const float sc = am > 0.f ? 127.f / am : 0.f;
            unsigned char* a8 = P.ws + OFF_A8 + (size_t)r * 1024;
#pragma unroll
            for (int j = 0; j < 4; ++j) {
                const int b0 = (int)rintf(v[j].x * sc), b1 = (int)rintf(v[j].y * sc), b2 = (int)rintf(v[j].z * sc), b3 = (int)rintf(v[j].w * sc);
                const unsigned mine = (unsigned)((b0 & 255) | ((b1 & 255) << 8) | ((b2 & 255) << 16) | ((b3 & 255) << 24));
                const unsigned other = (unsigned)__shfl_xor((int)mine, 1);
                const unsigned lo4 = (lane & 1) ? other : mine, hi4 = (lane & 1) ? mine : other;
                const unsigned outw = (lane & 1) ? __builtin_amdgcn_perm(hi4, lo4, 0x07050301u) : __builtin_amdgcn_perm(hi4, lo4, 0x06040200u);
                *(unsigned*)(a8 + j * 256 + lane * 4) = outw;
            }
            if (lane == 0) ((float*)(P.ws + OFF_XS))[r] = am * (1.f / 127.f);
        }
    }
}

DEV void unpack8(const u32x4 v, float* f) {
    f[0] = bflo(v.x); f[1] = bfhi(v.x); f[2] = bflo(v.y); f[3] = bfhi(v.y); f[4] = bflo(v.z); f[5] = bfhi(v.z); f[6] = bflo(v.w); f[7] = bfhi(v.w);
}
template <int W>
DEV void pool_vertical(const bf16_t* A0, LAS float* V, int b, int r, int cbase, int tq, int ch8, float (&cen)[4][8]) {
    const int rlo = max(0, r - W / 2), rhi = min(32, r - W / 2 + W);
    const float inv = 1.f / (float)(rhi - rlo);
#pragma unroll
    for (int jh = 0; jh < 2; ++jh) {
        u32x4 ld[2][W];
#pragma unroll
        for (int jj = 0; jj < 2; ++jj)
#pragma unroll
            for (int k = 0; k < W; ++k) {
                const int rr = min(rlo + k, 31), tok = tq + 16 * (2 * jh + jj);
                ld[jj][k] = *(const u32x4*)(A0 + ((size_t)b * 2048 + rr * 64 + tok) * 1024 + cbase);
            }
#pragma unroll
        for (int jj = 0; jj < 2; ++jj) {
            const int j = 2 * jh + jj, tok = tq + 16 * j;
            float acc[8];
#pragma unroll
            for (int e = 0; e < 8; ++e) acc[e] = 0.f;
#pragma unroll
            for (int k = 0; k < W; ++k) {
                float f[8]; unpack8(ld[jj][k], f);
                const bool in = rlo + k < rhi;
#pragma unroll
                for (int e = 0; e < 8; ++e) acc[e] += in ? f[e] : 0.f;
                if (rlo + k == r) {
#pragma unroll
                    for (int e = 0; e < 8; ++e) cen[j][e] = f[e];
                }
            }
            LAS float* vp = V + (tok + 8) * 260 + ch8 * 8;
            *(LAS f32x4*)vp = (f32x4){acc[0] * inv, acc[1] * inv, acc[2] * inv, acc[3] * inv};
            *(LAS f32x4*)(vp + 4) = (f32x4){acc[4] * inv, acc[5] * inv, acc[6] * inv, acc[7] * inv};
        }
    }
}
template <int W>
DEV void pool_horizontal(const LAS float* V, ldsp At, bool isx, int seg, int tq, int ch8, const float (&cen)[4][8]) {
#pragma unroll
    for (int j = 0; j < 4; ++j) {
        const int tok = tq + 16 * j;
        const int pos = isx ? tok : 64 * seg + tok, lim = isx ? 64 : 256, off = isx ? 8 : 8 - 64 * seg;
        const int lo = max(0, pos - W / 2), hi = min(lim, pos - W / 2 + W);
        f32x4 s0 = {0.f, 0.f, 0.f, 0.f}, s1 = {0.f, 0.f, 0.f, 0.f};
#pragma unroll
        for (int k = 0; k < W; ++k) {
            const int t = min(lo + k, lim - 1);
            const LAS float* vp = V + (t + off) * 260 + ch8 * 8;
            const f32x4 a = *(const LAS f32x4*)vp, b2 = *(const LAS f32x4*)(vp + 4);
            const float m = (lo + k < hi) ? 1.f : 0.f;
            s0 += a * m; s1 += b2 * m;
        }
        const float inv = 1.f / (float)(hi - lo);
        u32x4 o;
        o.x = pk2(s0.x * inv - cen[j][0], s0.y * inv - cen[j][1]);
        o.y = pk2(s0.z * inv - cen[j][2], s0.w * inv - cen[j][3]);
        o.z = pk2(s1.x * inv - cen[j][4], s1.y * inv - cen[j][5]);
        o.w = pk2(s1.z * inv - cen[j][6], s1.w * inv - cen[j][7]);
        *(LAS u32x4*)(At + tok * 512 + ((ch8 ^ (tok & 7)) << 4)) = o;
    }
}
DEV void phase_pool(const Params& P, ldsp lds0) {
    const bf16_t* A0 = (const bf16_t*)(P.ws + OFF_A);
    const float* modv = (const float*)(P.ws + OFF_MODV);
    const bf16_t* Wt = (const bf16_t*)(P.ws + OFF_POOLT);
    const int tid = tid_fresh(), lane = tid & 63, wave = tid >> 6;
    const int ch8 = tid & 31, tq = tid >> 5;
    for (int item = blockIdx.x; item < 1152; item += gridDim.x) {
        const ldsp lds = launder(lds0);
        LAS float* V = (LAS float*)lds;
        const ldsp At = lds + 80 * 260 * 4;
        const bool isx = item < 1024;
        int b, r = 0, seg = 0, g;
        if (isx) { b = item >> 7; r = (item >> 2) & 31; }
        else { const int it = item - 1024; b = it >> 4; seg = (it >> 2) & 3; }
        g = ((item & 3) + (item >> 8)) & 3;
        const int cbase = g * 256 + ch8 * 8;
        float cen[4][8];
        if (isx) {
            if (g == 0) pool_vertical<2>(A0, V, b, r, cbase, tq, ch8, cen);
            else if (g == 1) pool_vertical<4>(A0, V, b, r, cbase, tq, ch8, cen);
            else if (g == 2) pool_vertical<8>(A0, V, b, r, cbase, tq, ch8, cen);
            else pool_vertical<16>(A0, V, b, r, cbase, tq, ch8, cen);
        } else {
            for (int q = tq; q < 80; q += 16) {
                const int t = 64 * seg - 8 + q;
                if (t >= 0 && t < 256) {
                    const u32x4 pv = *(const u32x4*)(A0 + ((size_t)NX + b * 256 + t) * 1024 + cbase);
                    float f[8]; unpack8(pv, f);
                    LAS float* vp = V + q * 260 + ch8 * 8;
                    *(LAS f32x4*)vp = (f32x4){f[0], f[1], f[2], f[3]};
                    *(LAS f32x4*)(vp + 4) = (f32x4){f[4], f[5], f[6], f[7]};
                }
            }
#pragma unroll
            for (int j = 0; j < 4; ++j) {
                const int tok = tq + 16 * j;
                const u32x4 pv = *(const u32x4*)(A0 + ((size_t)NX + b * 256 + 64 * seg + tok) * 1024 + cbase);
                unpack8(pv, cen[j]);
            }
        }
        __syncthreads();
        if (g == 0) pool_horizontal<2>(V, At, isx, seg, tq, ch8, cen);
        else if (g == 1) pool_horizontal<4>(V, At, isx, seg, tq, ch8, cen);
        else if (g == 2) pool_horizontal<8>(V, At, isx, seg, tq, ch8, cen);
        else pool_horizontal<16>(V, At, isx, seg, tq, ch8, cen);
        __syncthreads();
        f32x16 acc[2]; acc[0] = zero16(); acc[1] = zero16();
        const bf16_t* Wg = Wt + (size_t)g * 65536 + (size_t)(32 * wave + (lane & 31)) * 256 + (lane >> 5) * 8;
#pragma unroll 4
        for (int ks = 0; ks < 16; ++ks) {
            const bf16x8 wfr = *(const bf16x8*)(Wg + ks * 16);
            const int ch = ks * 2 + (lane >> 5);
#pragma unroll
            for (int mt = 0; mt < 2; ++mt) {
                const int row = mt * 32 + (lane & 31);
                const bf16x8 a = *(const LAS bf16x8*)(At + row * 512 + ((ch ^ (row & 7)) << 4));
                acc[mt] = mfma32(wfr, a, acc[mt]);
            }
        }
        const int m = isx ? b : 8;
#pragma unroll
        for (int mt = 0; mt < 2; ++mt)
#pragma unroll
            for (int rg = 0; rg < 4; ++rg) {
                const int tok = mt * 32 + (lane & 31), col = g * 256 + 32 * wave + 8 * rg + 4 * (lane >> 5);
                const f32x4 gs = *(const f32x4*)(modv + m * 6144 + 2048 + col) * *(const f32x4*)(P.pool_scale + col);
                const f32x4 av = {acc[mt][rg * 4 + 0], acc[mt][rg * 4 + 1], acc[mt][rg * 4 + 2], acc[mt][rg * 4 + 3]};
                f32x4 hv; int grow;
                if (isx) { grow = b * 2048 + r * 64 + tok; hv = __builtin_nontemporal_load((const f32x4*)(P.x + (size_t)grow * 1024 + col)) + gs * av; }
                else { const size_t gi = ((size_t)b * 256 + 64 * seg + tok) * 1024 + col; grow = NX + b * 256 + 64 * seg + tok; hv = *(const f32x4*)(P.ctx + gi) + gs * av; }
                u32x2 hp; hp.x = pk2(hv.x, hv.y); hp.y = pk2(hv.z, hv.w);
                *(u32x2*)(hrow(P, grow) + col) = hp;
            }
        __syncthreads();
    }
}

DEV bf16x8 frag_row_x(ldsp x, int r0, int k0, int lane) {
    const int row = r0 + (lane & 31), ch = (k0 >> 3) + (lane >> 5);
    return *(const LAS bf16x8*)(x + row * 256 + ((ch ^ (row & 15)) << 4));
}
DEV unsigned key_of(float f) { const unsigned u = __float_as_uint(f); return u ^ ((unsigned)((int)u >> 31) | 0x80000000u); }
DEV float val_of(unsigned k) { const unsigned u = (k & 0x80000000u) ? (k ^ 0x80000000u) : ~k; return __uint_as_float(u); }
DEV void cmpx(unsigned& hi, unsigned& lo) { const unsigned a = hi, b = lo; hi = a > b ? a : b; lo = a > b ? b : a; }
DEV void sort16_desc(unsigned* v) {
#pragma unroll
    for (int k = 2; k <= 16; k <<= 1)
#pragma unroll
        for (int j = k >> 1; j > 0; j >>= 1)
#pragma unroll
            for (int i = 0; i < 16; ++i) {
                const int l = i ^ j;
                if (l > i) { if ((i & k) == 0) cmpx(v[i], v[l]); else cmpx(v[l], v[i]); }
            }
}
DEV void merge16(unsigned* r, const unsigned* b) {
#pragma unroll
    for (int k = 0; k < 16; ++k) r[k] = r[k] > b[15 - k] ? r[k] : b[15 - k];
#pragma unroll
    for (int j = 8; j > 0; j >>= 1)
#pragma unroll
        for (int i = 0; i < 16; ++i) { const int l = i ^ j; if (l > i) cmpx(r[i], r[l]); }
}
DEV void top16_of_64(unsigned* v, unsigned* r) {
#pragma unroll
    for (int blk = 0; blk < 4; ++blk) sort16_desc(v + 16 * blk);
#pragma unroll
    for (int k = 0; k < 16; ++k) r[k] = v[k];
    merge16(r, v + 16); merge16(r, v + 32); merge16(r, v + 48);
}
DEV void phase_topk(const Params& P, int layer, int nrows, ldsp lds0) {
    const bf16_t* Q = (const bf16_t*)(P.ws + OFF_R1);
    const bf16_t* keys = (const bf16_t*)(P.ws + OFF_KEYS) + (size_t)layer * 8 * 2 * 128 * 128;
    bf16_t* seli = (bf16_t*)(P.ws + OFF_SELI);
    float* selg = (float*)(P.ws + OFF_SELG);
    const int tid = tid_fresh(), lane = tid & 63, wave = tid >> 6;
    const int nitems = (nrows / 256) * 4;
    const unsigned hoff = (unsigned)(lane >> 5) * 4u;
    for (int item = blockIdx.x; item < nitems; item += gridDim.x) {
        const ldsp lds = launder(lds0);
        LAS unsigned* sl = (LAS unsigned*)(lds + 65536 + wave * 8192);
        const int tg = item >> 2, hp = item & 3, row0 = tg * 256 + wave * 32;
        u32x4 kr[4]; bf16x8 qf[8];
        {
            const bf16_t* kt = keys + (size_t)((hp * 2) * 2) * 128 * 128;
#pragma unroll
            for (int j = 0; j < 4; ++j) { const int cid = tid + NTHREADS * j, r = cid >> 4, ch = cid & 15; kr[j] = *(const u32x4*)(kt + r * 128 + ch * 8); }
#pragma unroll
            for (int j = 0; j < 4; ++j) { const int cid = tid + NTHREADS * j, r = cid >> 4, ch = cid & 15; *(LAS u32x4*)(lds + r * 256 + ((ch ^ (r & 15)) << 4)) = kr[j]; }
            const bf16_t* qb = Q + (size_t)(row0 + (lane & 31)) * 2048 + (hp * 2) * 256 + (lane >> 5) * 8;
#pragma unroll
            for (int ks = 0; ks < 8; ++ks) qf[ks] = *(const bf16x8*)(qb + ks * 16);
        }
        __syncthreads();
        unsigned s1[16], s2[16];
#pragma unroll
        for (int k = 0; k < 16; ++k) { s1[k] = 0u; s2[k] = 0u; }
#pragma unroll 1
        for (int step = 0; step < 4; ++step) {
            const int hs = step >> 1, p = step & 1;
            const bool mine = (lane >> 5) == hs;
            const ldsp kb = lds + (step & 1) * 32768;
            if (step < 3) {
                const bf16_t* kt = keys + (size_t)((hp * 2 + ((step + 1) >> 1)) * 2 + ((step + 1) & 1)) * 128 * 128;
#pragma unroll
                for (int j = 0; j < 4; ++j) { const int cid = tid + NTHREADS * j, r = cid >> 4, ch = cid & 15; kr[j] = *(const u32x4*)(kt + r * 128 + ch * 8); }
            }
            f32x16 acc[4];
#pragma unroll
            for (int mt = 0; mt < 4; ++mt) acc[mt] = zero16();
#pragma unroll
            for (int ks = 0; ks < 8; ++ks)
#pragma unroll
                for (int mt = 0; mt < 4; ++mt) acc[mt] = mfma32(frag_row_x(kb, mt * 32, ks * 16, lane), qf[ks], acc[mt]);
            if (step < 3) {
                const ldsp kn = lds + ((step + 1) & 1) * 32768;
#pragma unroll
                for (int j = 0; j < 4; ++j) { const int cid = tid + NTHREADS * j, r = cid >> 4, ch = cid & 15; *(LAS u32x4*)(kn + r * 256 + ((ch ^ (r & 15)) << 4)) = kr[j]; }
                const bf16_t* qb = Q + (size_t)(row0 + (lane & 31)) * 2048 + (hp * 2 + ((step + 1) >> 1)) * 256 + ((step + 1) & 1) * 128 + (lane >> 5) * 8;
#pragma unroll
                for (int ks = 0; ks < 8; ++ks) qf[ks] = *(const bf16x8*)(qb + ks * 16);
            }
            unsigned v[64];
#pragma unroll
            for (int mt = 0; mt < 4; ++mt)
#pragma unroll
                for (int reg = 0; reg < 16; ++reg) {
                    const unsigned c = mt * 32 + (reg & 3) + 8 * (reg >> 2);
                    v[mt * 16 + reg] = ((key_of(acc[mt][reg]) & ~127u) | (127u - c)) ^ hoff;
                }
            unsigned r[16], o[16];
            top16_of_64(v, r);
#pragma unroll
            for (int k = 0; k < 16; ++k) o[k] = (unsigned)__shfl_xor((int)r[k], 32);
            merge16(r, o);
#pragma unroll
            for (int k = 0; k < 16; ++k) { if (p == 0) s1[k] = mine ? r[k] : s1[k]; else s2[k] = mine ? r[k] : s2[k]; }
            __syncthreads();
        }
        float f1[16], f2[16];
#pragma unroll
        for (int k = 0; k < 16; ++k) {
            sl[k * 64 + lane] = s1[k]; sl[(16 + k) * 64 + lane] = s2[k];
            f1[k] = val_of(s1[k] & ~127u); f2[k] = val_of(s2[k] & ~127u);
        }
        unsigned cv[64];
        {
            int n = 0;
#pragma unroll
            for (int a = 0; a < 16; ++a)
#pragma unroll
                for (int b = 0; b < 16; ++b)
                    if ((a + 1) * (b + 1) <= 16) { cv[n] = (key_of(f1[a] + f2[b]) & ~255u) | (255u - (unsigned)(a * 16 + b)); ++n; }
#pragma unroll
            for (int q = 50; q < 64; ++q) cv[q] = 0u;
        }
        unsigned w[16];
        top16_of_64(cv, w);
        float sc[16]; int ei[16];
#pragma unroll
        for (int k = 0; k < 16; ++k) {
            const unsigned ab = 255u - (w[k] & 255u);
            const unsigned k1 = sl[(ab >> 4) * 64 + lane], k2 = sl[(16 + (ab & 15u)) * 64 + lane];
            ei[k] = (int)((127u - (k1 & 127u)) * 128u + (127u - (k2 & 127u)));
            sc[k] = val_of(w[k] & ~255u);
        }
        const float mx = sc[0];
        float tot = 0.f;
#pragma unroll
        for (int k = 0; k < 16; ++k) { sc[k] = expf(sc[k] - mx); tot += sc[k]; }
        const int row = row0 + (lane & 31), head = hp * 2 + (lane >> 5);
        bf16_t* ip = seli + (size_t)row * 128 + head * 16;
        float* gp = selg + (size_t)row * 128 + head * 16;
        const float inv = 1.f / tot;
#pragma unroll
        for (int q = 0; q < 2; ++q) {
            u32x4 o;
#pragma unroll
            for (int d = 0; d < 4; ++d) o[d] = (unsigned)ei[8 * q + 2 * d] | ((unsigned)ei[8 * q + 2 * d + 1] << 16);
            *(u32x4*)(ip + 8 * q) = o;
        }
#pragma unroll
        for (int q = 0; q < 4; ++q) *(float4*)(gp + 4 * q) = make_float4(sc[4 * q] * inv, sc[4 * q + 1] * inv, sc[4 * q + 2] * inv, sc[4 * q + 3] * inv);
    }
}

struct XGeo { int nloc, rank, nact, pos; };
typedef float f32x2 __attribute__((ext_vector_type(2)));
DEV void fp8x16_to_f32(const u32x4 r, float* f) {
#pragma unroll
    for (int d = 0; d < 4; ++d) {
        const f32x2 lo = __builtin_amdgcn_cvt_pk_f32_fp8((int)r[d], false), hi = __builtin_amdgcn_cvt_pk_f32_fp8((int)r[d], true);
        f[4 * d + 0] = lo.x; f[4 * d + 1] = lo.y; f[4 * d + 2] = hi.x; f[4 * d + 3] = hi.y;
    }
}
template <int S, int MUL, class T>
DEV void bfly_stage(T* p, int lane) {
    const bool hi = (lane & (S * MUL)) != 0;
#pragma unroll
    for (int i = 0; i < 2 * S; ++i) { const T keep = hi ? p[i + 2 * S] : p[i], send = hi ? p[i] : p[i + 2 * S]; p[i] = keep + __shfl_xor(send, S * MUL); }
}
template <int STAGE>
DEV void ex_issue(u32x4 (&buf)[16], u32x4 (&aux)[4], f32x2 (&hg)[2], const u32x4 (&idn)[2], const unsigned char* slice, const Params& P, const bf16_t* A, const bf16_t* wexp,
                  const float* gatev, int t, int sl, int g, int c) {
    int id[16];
#pragma unroll
    for (int q = 0; q < 2; ++q)
#pragma unroll
        for (int d = 0; d < 4; ++d) { id[8 * q + 2 * d] = (int)(idn[q][d] & 0xffffu); id[8 * q + 2 * d + 1] = (int)(idn[q][d] >> 16); }
#pragma unroll
    for (int k = 0; k < 16; ++k) buf[k] = *(const u32x4*)(slice + (size_t)id[k] * 128);
    if (STAGE == 1) {
        aux[0] = *(const u32x4*)(P.ws + OFF_A8 + (size_t)t * 1024 + 256 * sl + 32 * c); aux[1] = *(const u32x4*)(P.ws + OFF_A8 + (size_t)t * 1024 + 256 * sl + 32 * c + 16);
        hg[0].x = ((const float*)(P.ws + OFF_XS))[t];
    } else {
#pragma unroll
        for (int q = 0; q < 2; ++q) aux[q] = *(const u32x4*)(wexp + (size_t)t * 128 + 16 * g + 8 * q);
        const int col = 256 * sl + 32 * c + 4 * g, m = t < NX ? (t >> 11) : 8;
        const u32x2 hv = *(const u32x2*)(hrow(P, t) + col);
        aux[2] = (u32x4){hv.x, hv.y, 0u, 0u};
        aux[3] = *(const u32x4*)(gatev + m * 6144 + col);
    }
}
template <int STAGE>
DEV void ex_compute(const u32x4 (&buf)[16], const u32x4 (&aux)[4], const f32x2 (&hg)[2], const Params& P, float* part, int t, int sl, int lane, int g, int c) {
    if (STAGE == 1) {
        int sx = 0;
#pragma unroll
        for (int q = 0; q < 2; ++q)
#pragma unroll
            for (int d = 0; d < 4; ++d) sx = __builtin_amdgcn_sdot4(0x01010101, (int)aux[q][d], sx, false);
        int p[16];
#pragma unroll
        for (int k = 0; k < 16; ++k) {
            int a = -8 * sx;
#pragma unroll
            for (int d = 0; d < 4; ++d) {
                const unsigned w = buf[k][d];
                a = __builtin_amdgcn_sdot4((int)(w & 0x0F0F0F0Fu), (int)aux[d >> 1][2 * (d & 1)], a, false);
                a = __builtin_amdgcn_sdot4((int)((w >> 4) & 0x0F0F0F0Fu), (int)aux[d >> 1][2 * (d & 1) + 1], a, false);
            }
            p[k] = a;
        }
        bfly_stage<4, 1>(p, lane); bfly_stage<2, 1>(p, lane); bfly_stage<1, 1>(p, lane);
        const float xs = hg[0].x;
        *(unsigned*)((bf16_t*)part + ((size_t)sl * NT + t) * 128 + 2 * lane) = pk2((float)p[0] * xs, (float)p[1] * xs);
    } else {
        f32x2 p2[16];
#pragma unroll
        for (int i = 0; i < 16; ++i) p2[i] = (f32x2){0.f, 0.f};
#pragma unroll
        for (int k = 0; k < 16; ++k) {
            const unsigned wpk = aux[k >> 3][(k >> 1) & 3];
            const float wkf = (k & 1) ? bfhi(wpk) : bflo(wpk);
            const f32x2 w2 = {wkf, wkf};
#pragma unroll
            for (int d = 0; d < 4; ++d) {
                p2[4 * d + 0] += w2 * __builtin_amdgcn_cvt_scalef32_pk_f32_fp4(buf[k][d], 1.0f, 0);
                p2[4 * d + 1] += w2 * __builtin_amdgcn_cvt_scalef32_pk_f32_fp4(buf[k][d], 1.0f, 1);
                p2[4 * d + 2] += w2 * __builtin_amdgcn_cvt_scalef32_pk_f32_fp4(buf[k][d], 1.0f, 2);
                p2[4 * d + 3] += w2 * __builtin_amdgcn_cvt_scalef32_pk_f32_fp4(buf[k][d], 1.0f, 3);
            }
            asm volatile("" : "+v"(p2[0]), "+v"(p2[1]), "+v"(p2[2]), "+v"(p2[3]), "+v"(p2[4]), "+v"(p2[5]), "+v"(p2[6]), "+v"(p2[7]),
                              "+v"(p2[8]), "+v"(p2[9]), "+v"(p2[10]), "+v"(p2[11]), "+v"(p2[12]), "+v"(p2[13]), "+v"(p2[14]), "+v"(p2[15]));
        }
        float p[32];
#pragma unroll
        for (int i = 0; i < 16; ++i) { p[2 * i] = p2[i].x; p[2 * i + 1] = p2[i].y; }
        bfly_stage<8, 4>(p, lane); bfly_stage<4, 4>(p, lane); bfly_stage<2, 4>(p, lane);
        const int col = 256 * sl + 32 * c + 4 * g;
        const unsigned h0 = aux[2].x, h1 = aux[2].y;
        u32x2 ho;
        ho.x = pk2(bflo(h0) + __uint_as_float(aux[3].x) * p[0], bfhi(h0) + __uint_as_float(aux[3].y) * p[1]);
        ho.y = pk2(bflo(h1) + __uint_as_float(aux[3].z) * p[2], bfhi(h1) + __uint_as_float(aux[3].w) * p[3]);
        *(u32x2*)(hrow(P, t) + col) = ho;
    }
}
template <int STAGE>
DEV void phase_experts_sliced(const Params& P, int layer, int nrows, const XGeo geo) {
    const unsigned char* tab = P.ws + OFF_TAB + (size_t)(layer * 2 + (STAGE - 1)) * 16 * MiB;
    const bf16_t* A = (const bf16_t*)(P.ws + OFF_A);
    const bf16_t* seli = (const bf16_t*)(P.ws + OFF_SELI);
    float* part = (float*)(P.ws + OFF_PART);
    const bf16_t* wexp = (const bf16_t*)(P.ws + OFF_WEXP);
    const float* gatev = (const float*)(P.ws + OFF_MODV) + (size_t)layer * 9 * 6144 + 5 * 1024;
    const int tid = tid_fresh(), wave = tid >> 6, lane = tid & 63, g = lane >> 3, c = lane & 7;
    const int nw = geo.nloc * 8, wr = geo.rank * 8 + wave;
    for (int vs = geo.pos; vs < 8; vs += geo.nact) {
        const int sl = vs >> 1, tmul = 2, tadd = vs & 1;
        const unsigned char* slice = tab + (size_t)sl * 2 * MiB + 16 * c;
        const int nws = nw * tmul;
        int t = wr * tmul + tadd;
        if (t >= nrows) continue;
        u32x4 bufA[16], bufB[16], auxA[4], auxB[4]; f32x2 hgA[2], hgB[2]; u32x4 idn[2];
#pragma unroll
        for (int q = 0; q < 2; ++q) idn[q] = *(const u32x4*)(seli + (size_t)t * 128 + 16 * g + 8 * q);
        ex_issue<STAGE>(bufA, auxA, hgA, idn, slice, P, A, wexp, gatev, t, sl, g, c);
        if (t + nws < nrows) {
#pragma unroll
            for (int q = 0; q < 2; ++q) idn[q] = *(const u32x4*)(seli + (size_t)(t + nws) * 128 + 16 * g + 8 * q);
        }
        for (;;) {
            {
                const int t1 = t + nws;
                if (t1 < nrows) {
                    ex_issue<STAGE>(bufB, auxB, hgB, idn, slice, P, A, wexp, gatev, t1, sl, g, c);
                    if (t1 + nws < nrows) {
#pragma unroll
                        for (int q = 0; q < 2; ++q) idn[q] = *(const u32x4*)(seli + (size_t)(t1 + nws) * 128 + 16 * g + 8 * q);
                    }
                }
                ex_compute<STAGE>(bufA, auxA, hgA, P, part, t, sl, lane, g, c);
            }
            t += nws; if (t >= nrows) break;
            {
                const int t1 = t + nws;
                if (t1 < nrows) {
                    ex_issue<STAGE>(bufA, auxA, hgA, idn, slice, P, A, wexp, gatev, t1, sl, g, c);
                    if (t1 + nws < nrows) {
#pragma unroll
                        for (int q = 0; q < 2; ++q) idn[q] = *(const u32x4*)(seli + (size_t)(t1 + nws) * 128 + 16 * g + 8 * q);
                    }
                }
                ex_compute<STAGE>(bufB, auxB, hgB, P, part, t, sl, lane, g, c);
            }
            t += nws; if (t >= nrows) break;
        }
    }
}
DEV void phase_experts_act(const Params& P, int layer, int nrows) {
    const bf16_t* seli = (const bf16_t*)(P.ws + OFF_SELI);
    const float* selg = (const float*)(P.ws + OFF_SELG);
    const float* part = (const float*)(P.ws + OFF_PART);
    bf16_t* wexp = (bf16_t*)(P.ws + OFF_WEXP);
    const float* rsu = (const float*)(P.ws + OFF_RSC) + (size_t)(layer * 2) * 16384;
    const float* rsv = rsu + 16384;
    const int tid = tid_fresh();
    const int n4 = nrows * 32;
    for (int i4 = blockIdx.x * NTHREADS + tid; i4 < n4; i4 += gridDim.x * NTHREADS) {
        const size_t idx = (size_t)i4 * 4;
        f32x4 h = {0.f, 0.f, 0.f, 0.f};
#pragma unroll
        for (int s = 0; s < 4; ++s) { const u32x2 pv = *(const u32x2*)((const bf16_t*)part + (size_t)s * NT * 128 + idx); h += (f32x4){bflo(pv.x), bfhi(pv.x), bflo(pv.y), bfhi(pv.y)}; }
        const u32x2 e = *(const u32x2*)(seli + idx);
        const f32x4 gt = *(const f32x4*)(selg + idx);
        const int ee[4] = {(int)(e.x & 0xffffu), (int)(e.x >> 16), (int)(e.y & 0xffffu), (int)(e.y >> 16)};
        f32x4 o;
#pragma unroll
        for (int q = 0; q < 4; ++q) {
            const float hh = h[q] * rsu[ee[q]];
            o[q] = gt[q] * (0.5f * hh * (1.f + erff(hh * 0.70710678118654752f))) * rsv[ee[q]];
        }
        u32x2 ow; ow.x = pk2(o[0], o[1]); ow.y = pk2(o[2], o[3]);
        *(u32x2*)(wexp + idx) = ow;
    }
}
DEV void phase_final(const Params& P) {
    const int tid = tid_fresh(), wave = tid >> 6, lane = tid & 63;
    for (int r = blockIdx.x * 8 + wave; r < NX; r += gridDim.x * 8) {
        float* h = P.out + (size_t)r * 1024;
        f32x4 v[4]; float ss = 0.f;
#pragma unroll
        for (int j = 0; j < 4; ++j) { const u32x2 hv = *(const u32x2*)(hrow(P, r) + j * 256 + lane * 4); v[j] = (f32x4){bflo(hv.x), bfhi(hv.x), bflo(hv.y), bfhi(hv.y)};
            ss += v[j].x * v[j].x + v[j].y * v[j].y + v[j].z * v[j].z + v[j].w * v[j].w; }
        ss = wave_sum(ss);
        const float rstd = rsqrtf(ss * (1.f / 1024.f) + EPS);
#pragma unroll
        for (int j = 0; j < 4; ++j) { const f32x4 gg = *(const f32x4*)(P.final_g + j * 256 + lane * 4); __builtin_nontemporal_store(v[j] * rstd * gg, (f32x4*)(h + j * 256 + lane * 4)); }
    }
}

DEV void phase_conv(const Params& P) {
    const bf16_t* Pq = (const bf16_t*)(P.ws + OFF_R1);
    const float* ab = (const float*)(P.ws + OFF_AB);
    bf16_t* dst[3] = {(bf16_t*)(P.ws + OFF_QC), (bf16_t*)(P.ws + OFF_KC), (bf16_t*)(P.ws + OFF_VC)};
    float* gbuf = (float*)(P.ws + OFF_G);
    float* bbuf = (float*)(P.ws + OFF_BETA);
    const int tid = tid_fresh(), wave = tid >> 6, lane = tid & 63;
    constexpr int NSEG = NT / 16;
    for (int item = blockIdx.x * 8 + wave; item < NSEG * 6; item += gridDim.x * 8) {
        const int seg = item / 6, jc = item - seg * 6, row0 = seg * 16;
        int t0, L;
        if (row0 < NX) { t0 = row0 & 2047; L = 2048; } else { t0 = (row0 - NX) & 255; L = 256; }
        const int chunk = lane + 64 * jc, col = chunk * 8, part = jc >> 1;
        f32x4 w0[5], w1[5];
#pragma unroll
        for (int tap = 0; tap < 5; ++tap) { w0[tap] = *(const f32x4*)(P.dn_conv_w + tap * 3072 + col); w1[tap] = *(const f32x4*)(P.dn_conv_w + tap * 3072 + col + 4); }
        u32x4 raw[20];
#pragma unroll
        for (int i = 0; i < 20; ++i) {
            const int tt = t0 + i - 2;
            const bool ok = tt >= 0 && tt < L;
            const u32x4 v = *(const u32x4*)(Pq + (size_t)(row0 + (ok ? i - 2 : 0)) * 3072 + col);
            raw[i] = ok ? v : (u32x4){0u, 0u, 0u, 0u};
        }
        const float qs = part == 0 ? 0.08838834764831845f : 1.f;
        bf16_t* dp = dst[part] + (size_t)row0 * 1024 + (chunk & 127) * 8;
#pragma unroll
        for (int i = 0; i < 16; ++i) {
            float acc[8];
#pragma unroll
            for (int e = 0; e < 8; ++e) acc[e] = 0.f;
#pragma unroll
            for (int tap = 0; tap < 5; ++tap) {
                float f[8]; unpack8(raw[i + tap], f);
                acc[0] += f[0] * w0[tap].x; acc[1] += f[1] * w0[tap].y; acc[2] += f[2] * w0[tap].z; acc[3] += f[3] * w0[tap].w;
                acc[4] += f[4] * w1[tap].x; acc[5] += f[5] * w1[tap].y; acc[6] += f[6] * w1[tap].z; acc[7] += f[7] * w1[tap].w;
            }
            float ss = 0.f;
#pragma unroll
            for (int e = 0; e < 8; ++e) { acc[e] = silu(acc[e]); ss += acc[e] * acc[e]; }
            if (part < 2) {
                ss = sum16(ss);
                const float rn = rsqrtf(ss + EPS) * qs;
#pragma unroll
                for (int e = 0; e < 8; ++e) acc[e] *= rn;
            }
            u32x4 o; o.x = pk2(acc[0], acc[1]); o.y = pk2(acc[2], acc[3]); o.z = pk2(acc[4], acc[5]); o.w = pk2(acc[6], acc[7]);
            *(u32x4*)(dp + (size_t)i * 1024) = o;
        }
        if (jc == 0) {
            const int cc = lane & 31, d = cc >> 4, sx = (cc >> 3) & 1, h = cc & 7;
            const float a = __expf(P.dn_a_log[d * 8 + h]), dtb = P.dn_dt_bias[d * 8 + h];
            float v[8];
#pragma unroll
            for (int q = 0; q < 8; ++q) v[q] = ab[(size_t)(row0 + 2 * q + (lane >> 5)) * 32 + cc];
#pragma unroll
            for (int q = 0; q < 8; ++q) {
                const int row = row0 + 2 * q + (lane >> 5);
                if (sx == 0) {
                    const float xx = v[q] + dtb;
                    const float ex = __expf(fminf(xx, 30.f)), u = 1.f + ex;
                    const float l1p = (u == 1.f) ? ex : __logf(u) * ex * __builtin_amdgcn_rcpf(u - 1.f);
                    const float sp = xx > 20.f ? xx : l1p;
                    gbuf[((size_t)d * NT + row) * 8 + h] = -a * sp;
                } else {
                    bbuf[((size_t)d * NT + row) * 8 + h] = __builtin_amdgcn_rcpf(1.f + __expf(-v[q]));
                }
            }
        }
    }
}

DEV int chunk_rowbase(int b, int d, int n) {
    if (n < 4) { const int m = d ? 3 - n : n; return NX + b * 256 + m * 64; }
    const int m = d ? 31 - (n - 4) : n - 4; return b * 2048 + m * 64;
}

DEV bf16x8 frag_col_x(ldsp x, int c0, int k0, int lane) {
    const int col = c0 + (lane & 31), ch = col >> 3, sub = (col & 7) * 2;
    bf16x8 f;
#pragma unroll
    for (int j = 0; j < 8; ++j) { const int row = k0 + 8 * (lane >> 5) + j; f[j] = (short)*(const LAS bf16_t*)(x + row * 256 + ((ch ^ (row & 15)) << 4) + sub); }
    return f;
}
DEV void tile_rows8(const f32x16& acc, u32x4& o0, u32x4& o1) {
    unsigned p[4][2];
#pragma unroll
    for (int rg = 0; rg < 4; ++rg) { p[rg][0] = pk2(acc[rg * 4 + 0], acc[rg * 4 + 1]); p[rg][1] = pk2(acc[rg * 4 + 2], acc[rg * 4 + 3]); }
    const auto s00 = __builtin_amdgcn_permlane32_swap(p[0][0], p[2][0], false, false), s01 = __builtin_amdgcn_permlane32_swap(p[0][1], p[2][1], false, false);
    const auto s10 = __builtin_amdgcn_permlane32_swap(p[1][0], p[3][0], false, false), s11 = __builtin_amdgcn_permlane32_swap(p[1][1], p[3][1], false, false);
    o0 = (u32x4){s00[0], s01[0], s00[1], s01[1]};
    o1 = (u32x4){s10[0], s11[0], s10[1], s11[1]};
}
DEV bf16x8 frag_row_t(ldsp t, int r0, int k0, int lane) {
    const int row = r0 + (lane & 31), ch = (k0 >> 3) + (lane >> 5);
    return *(const LAS bf16x8*)(t + row * 128 + ((ch ^ (row & 7)) << 4));
}
DEV void phase_chunk(const Params& P, ldsp lds0) {
    const bf16_t* kc = (const bf16_t*)(P.ws + OFF_KC);
    const bf16_t* vc = (const bf16_t*)(P.ws + OFF_VC);
    const float* gbuf = (const float*)(P.ws + OFF_G);
    const float* bbuf = (const float*)(P.ws + OFF_BETA);
    bf16_t* wbuf = (bf16_t*)(P.ws + OFF_WBUF);
    bf16_t* ubuf = (bf16_t*)(P.ws + OFF_UBUF);
    float* gcbuf = (float*)(P.ws + OFF_GC);
    const int tid = tid_fresh(), lane = tid & 63, wave = tid >> 6, team = wave >> 1, tw = wave & 1, ttid = tid & 127;
    const int nteams = gridDim.x * 4, niter = (4608 + nteams - 1) / nteams;
    u32x4 rk[8];
    {
        const int item0 = min((int)(blockIdx.x * 4 + team), 4607);
        const int n = item0 % 36, d = (item0 / 36) & 1, bh = item0 / 72, rb0 = chunk_rowbase(bh >> 3, d, n);
#pragma unroll
        for (int j = 0; j < 8; ++j) { const int cid = ttid + 128 * j, i = cid >> 4, ch = cid & 15; rk[j] = *(const u32x4*)(kc + ((size_t)rb0 + (d ? 63 - i : i)) * 1024 + (bh & 7) * 128 + ch * 8); }
    }
    for (int it = 0; it < niter; ++it) {
        const int item = it * nteams + blockIdx.x * 4 + team;
        const bool act = item < 4608;
        const ldsp lds = launder(lds0);
        const ldsp sX = lds + team * 32768;
        const ldsp sT = sX + 16384;
        LAS float* sA = (LAS float*)sT;
        LAS float* sg = (LAS float*)(lds + 131072 + 128 + team * 768);
        const int n = item % 36, d = (item / 36) & 1, bh = item / 72, b = bh >> 3, h = bh & 7;
        const int rowbase = act ? chunk_rowbase(b, d, n) : 0;
        if (act) {
#pragma unroll
            for (int j = 0; j < 8; ++j) { const int cid = ttid + 128 * j, i = cid >> 4, ch = cid & 15; *(LAS u32x4*)(sX + i * 256 + ((ch ^ (i & 15)) << 4)) = rk[j]; }
            if (tw == 0) {
                const size_t grow = (size_t)rowbase + (d ? 63 - lane : lane);
                float v = gbuf[((size_t)d * NT + grow) * 8 + h];
#pragma unroll
                for (int o = 1; o < 64; o <<= 1) { const float t = __shfl_up(v, o); if (lane >= o) v += t; }
                sg[lane] = v; sg[64 + lane] = bbuf[((size_t)d * NT + grow) * 8 + h];
            }
        }
        __syncthreads();
        if (act) {
#pragma unroll 1
            for (int q = 0; q < 2; ++q) {
                const int mt = tw, nt = q;
                f32x16 acc = zero16();
#pragma unroll 4
                for (int ks = 0; ks < 8; ++ks) acc = mfma32(frag_row_x(sX, mt * 32, ks * 16, lane), frag_row_x(sX, nt * 32, ks * 16, lane), acc);
#pragma unroll
                for (int reg = 0; reg < 16; ++reg) {
                    const int i = mt * 32 + crow(reg, lane), j = nt * 32 + (lane & 31);
                    sA[i * 64 + j] = (i > j) ? sg[64 + i] * acc[reg] * __expf(sg[i] - sg[j]) : 0.f;
                }
            }
        }
        __syncthreads();
        if (act && tw == 0) {
            float t[64];
            int ln = lane; asm volatile("" : "+v"(ln));
#pragma unroll
            for (int i = 0; i < 64; ++i) {
                float a0 = (i == ln) ? 1.f : 0.f, a1 = 0.f, a2 = 0.f, a3 = 0.f;
#pragma unroll
                for (int j = 0; j < i; j += 4) {
                    const f32x4 av = *(const LAS f32x4*)(sA + i * 64 + j);
                    a0 -= av.x * t[j];
                    if (j + 1 < i) a1 -= av.y * t[j + 1];
                    if (j + 2 < i) a2 -= av.z * t[j + 2];
                    if (j + 3 < i) a3 -= av.w * t[j + 3];
                }
                t[i] = (a0 + a1) + (a2 + a3);
                __builtin_amdgcn_sched_barrier(0);
            }
            const float cu = sg[64 + lane], cw = cu * __expf(sg[lane]);
            const int ch = lane >> 3, sub = (lane & 7) * 2;
#pragma unroll
            for (int i = 0; i < 64; ++i) {
                const int off = i * 128 + ((ch ^ (i & 7)) << 4) + sub;
                *(LAS bf16_t*)(sT + off) = f2bf(t[i] * cw);
                *(LAS bf16_t*)(sT + 8192 + off) = f2bf(t[i] * cu);
                if ((i & 7) == 7) __builtin_amdgcn_sched_barrier(0);
            }
        }
        __syncthreads();
            {
                const int itemn = min(item + nteams, 4607);
                const int nn = itemn % 36, dn = (itemn / 36) & 1, bhn = itemn / 72, rbn = chunk_rowbase(bhn >> 3, dn, nn);
#pragma unroll
                for (int j = 0; j < 8; ++j) { const int cid = ttid + 128 * j, i = cid >> 4, ch = cid & 15; rk[j] = *(const u32x4*)(kc + ((size_t)rbn + (dn ? 63 - i : i)) * 1024 + (bhn & 7) * 128 + ch * 8); }
            }
        u32x4 rv[8];
        if (act) {
#pragma unroll
            for (int j = 0; j < 8; ++j) {
                const int cid = ttid + 128 * j, i = cid >> 4, ch = cid & 15;
                const size_t grow = (size_t)rowbase + (d ? 63 - i : i);
                rv[j] = *(const u32x4*)(vc + grow * 1024 + h * 128 + ch * 8);
            }
#pragma unroll 1
            for (int q = 0; q < 2; ++q) {
                const int mtk = 2 * tw + q;
                f32x16 acc[2]; acc[0] = zero16(); acc[1] = zero16();
#pragma unroll
                for (int ks = 0; ks < 4; ++ks) {
                    const bf16x8 afr = frag_col_x(sX, mtk * 32, ks * 16, lane);
#pragma unroll
                    for (int it2 = 0; it2 < 2; ++it2) acc[it2] = mfma32(afr, frag_row_t(sT, it2 * 32, ks * 16, lane), acc[it2]);
                }
                bf16_t* dstp = wbuf + (size_t)item * 8192;
#pragma unroll
                for (int it2 = 0; it2 < 2; ++it2) {
                    u32x4 o0, o1; tile_rows8(acc[it2], o0, o1);
                    bf16_t* rp = dstp + (it2 * 32 + (lane & 31)) * 128 + mtk * 32 + 16 * (lane >> 5);
                    *(u32x4*)rp = o0; *(u32x4*)(rp + 8) = o1;
                }
            }
        }
        __syncthreads();
        if (act) {
#pragma unroll
            for (int j = 0; j < 8; ++j) { const int cid = ttid + 128 * j, i = cid >> 4, ch = cid & 15; *(LAS u32x4*)(sX + i * 256 + ((ch ^ (i & 15)) << 4)) = rv[j]; }
        }
        __syncthreads();
        if (act) {
#pragma unroll 1
            for (int q = 0; q < 2; ++q) {
                const int nt = 2 * tw + q;
                f32x16 acc[2]; acc[0] = zero16(); acc[1] = zero16();
#pragma unroll
                for (int ks = 0; ks < 4; ++ks) {
                    const bf16x8 bfr = frag_col_x(sX, nt * 32, ks * 16, lane);
#pragma unroll
                    for (int mt = 0; mt < 2; ++mt) acc[mt] = mfma32(frag_row_t(sT + 8192, mt * 32, ks * 16, lane), bfr, acc[mt]);
                }
                bf16_t* dstp = ubuf + (size_t)item * 8192;
#pragma unroll
                for (int mt = 0; mt < 2; ++mt) {
                    u32x4 o0, o1; tile_rows8(acc[mt], o0, o1);
                    bf16_t* rp = dstp + (nt * 32 + (lane & 31)) * 64 + mt * 32 + 16 * (lane >> 5);
                    *(u32x4*)rp = o0; *(u32x4*)(rp + 8) = o1;
                }
            }
            if (tw == 0) gcbuf[(size_t)item * 64 + lane] = sg[lane];
        }
        __syncthreads();
    }
}

DEV u32x2 pack4(float a, float b, float c, float d) { u32x2 o; o.x = pk2(a, b); o.y = pk2(c, d); return o; }
DEV void phase_scan(const Params& P, ldsp lds0) {
    const bf16_t* qc = (const bf16_t*)(P.ws + OFF_QC);
    const bf16_t* kc = (const bf16_t*)(P.ws + OFF_KC);
    const bf16_t* wbuf = (const bf16_t*)(P.ws + OFF_WBUF);
    const bf16_t* ubuf = (const bf16_t*)(P.ws + OFF_UBUF);
    const float* gcbuf = (const float*)(P.ws + OFF_GC);
    bf16_t* obuf = (bf16_t*)(P.ws + OFF_OBUF);
    const int tid = tid_fresh(), lane = tid & 63, wave = tid >> 6;
    const int mt = wave >> 1, nt = wave & 1;
    const int mt2 = (wave & 3) >> 1, nt2 = wave & 1;
    for (int item = blockIdx.x; item < 256; item += gridDim.x) {
        const int half = item & 1, d = (item >> 1) & 1, bh = item >> 2, b = bh >> 3, h = bh & 7;
        f32x16 S = zero16();
        { LAS unsigned* z = (LAS unsigned*)(lds0 + 1024 + 3 * 17408 + 9216); for (int e = tid; e < 64 * 136 / 2; e += NTHREADS) z[e] = 0u; }
        u32x4 rW[2][2], rK[2][2], rQ[2][2], rU[2]; float rG[2] = {0.f, 0.f};
#pragma unroll
        for (int u = 0; u < 2; ++u) {
            const int citem = (bh * 2 + d) * 36 + u, rowbase = chunk_rowbase(b, d, u);
#pragma unroll
            for (int j = 0; j < 2; ++j) {
                const int cid = tid + NTHREADS * j, i = cid >> 4, ch = cid & 15;
                const size_t grow = (size_t)rowbase + (d ? 63 - i : i);
                rW[u][j] = *(const u32x4*)(wbuf + (size_t)citem * 8192 + i * 128 + ch * 8);
                rK[u][j] = *(const u32x4*)(kc + grow * 1024 + h * 128 + ch * 8);
                rQ[u][j] = rK[u][j];
            }
            { const int dvr = tid >> 3, ch = tid & 7; rU[u] = *(const u32x4*)(ubuf + (size_t)citem * 8192 + (half * 64 + dvr) * 64 + ch * 8); }
            if (tid < 64) rG[u] = gcbuf[(size_t)citem * 64 + tid];
        }
        for (int n2 = 0; n2 < 36; n2 += 2) {
#pragma unroll
        for (int u = 0; u < 2; ++u) {
            const int n = n2 + u;
            const ldsp lds = launder(lds0);
            int ln = lane; asm volatile("" : "+v"(ln));
            LAS float* sg = (LAS float*)lds;
            LAS bf16_t* sW = (LAS bf16_t*)(lds + 1024);
            LAS bf16_t* sK = sW + 64 * 136;
            LAS bf16_t* sQ = sK + 64 * 136;
            LAS bf16_t* sU = sQ + 64 * 136;
            LAS bf16_t* sST = sU + 64 * 72;
            LAS bf16_t* sVNT = sST + 64 * 136;
            LAS bf16_t* sVNsT = sVNT + 64 * 72;
            LAS bf16_t* sATT = sVNsT + 64 * 72;
            LAS bf16_t* sO = sATT + 64 * 72;
            const int rowbase = chunk_rowbase(b, d, n);
            const bool wantO = n >= 4;
#pragma unroll
            for (int j = 0; j < 2; ++j) {
                const int cid = tid + NTHREADS * j, i = cid >> 4, ch = cid & 15;
                *(LAS u32x4*)(sW + i * 136 + ch * 8) = rW[u][j];
                *(LAS u32x4*)(sK + i * 136 + ch * 8) = rK[u][j];
                *(LAS u32x4*)(sQ + i * 136 + ch * 8) = rQ[u][j];
            }
            { const int i = tid >> 3, ch = tid & 7; *(LAS u32x4*)(sU + i * 72 + ch * 8) = rU[u]; }
            if (tid < 64) sg[tid] = rG[u];
            __syncthreads();
            if (n + 2 < 36) {
                const int citem = (bh * 2 + d) * 36 + n + 2, rb1 = chunk_rowbase(b, d, n + 2);
                const bool wq = n + 2 >= 4;
#pragma unroll
                for (int j = 0; j < 2; ++j) {
                    const int cid = tid + NTHREADS * j, i = cid >> 4, ch = cid & 15;
                    const size_t grow = (size_t)rb1 + (d ? 63 - i : i);
                    rW[u][j] = *(const u32x4*)(wbuf + (size_t)citem * 8192 + i * 128 + ch * 8);
                    rK[u][j] = *(const u32x4*)(kc + grow * 1024 + h * 128 + ch * 8);
                    if (wq) rQ[u][j] = *(const u32x4*)(qc + grow * 1024 + h * 128 + ch * 8);
                }
                { const int dvr = tid >> 3, ch = tid & 7; rU[u] = *(const u32x4*)(ubuf + (size_t)citem * 8192 + (half * 64 + dvr) * 64 + ch * 8); }
                if (tid < 64) rG[u] = gcbuf[(size_t)citem * 64 + tid];
            }
            const float g63 = sg[63];
            if (wave < 4) {
                const int dv = nt2 * 32 + (ln & 31);
                float uf[16], ef[16];
#pragma unroll
                for (int rg = 0; rg < 4; ++rg) {
                    const int i0 = mt2 * 32 + 8 * rg + 4 * (ln >> 5);
                    const u32x2 uu = *(const LAS u32x2*)(sU + dv * 72 + i0);
                    const f32x4 gg = *(const LAS f32x4*)(sg + i0);
                    uf[rg * 4 + 0] = bflo(uu.x); uf[rg * 4 + 1] = bfhi(uu.x); uf[rg * 4 + 2] = bflo(uu.y); uf[rg * 4 + 3] = bfhi(uu.y);
#pragma unroll
                    for (int e = 0; e < 4; ++e) ef[rg * 4 + e] = __expf(g63 - gg[e]);
                }
                f32x16 acc = zero16(), accb = zero16();
#pragma unroll
                for (int ks = 0; ks < 8; ks += 2) { acc = mfma32(frag_row(sW, 136, mt2 * 32, ks * 16, ln), frag_row(sST, 136, nt2 * 32, ks * 16, ln), acc);
                    accb = mfma32(frag_row(sW, 136, mt2 * 32, ks * 16 + 16, ln), frag_row(sST, 136, nt2 * 32, ks * 16 + 16, ln), accb); }
#pragma unroll
                for (int rg = 0; rg < 4; ++rg) {
                    const int i0 = mt2 * 32 + 8 * rg + 4 * (ln >> 5);
                    float v[4], vs[4];
#pragma unroll
                    for (int e = 0; e < 4; ++e) { v[e] = uf[rg * 4 + e] - (acc[rg * 4 + e] + accb[rg * 4 + e]); vs[e] = v[e] * ef[rg * 4 + e]; }
                    *(LAS u32x2*)(sVNT + dv * 72 + i0) = pack4(v[0], v[1], v[2], v[3]);
                    *(LAS u32x2*)(sVNsT + dv * 72 + i0) = pack4(vs[0], vs[1], vs[2], vs[3]);
                }
            } else if (wantO) {
                const int i = nt2 * 32 + (ln & 31);
                const float gi = sg[i];
                float df[16];
#pragma unroll
                for (int rg = 0; rg < 4; ++rg) {
                    const int j0 = mt2 * 32 + 8 * rg + 4 * (ln >> 5);
                    const f32x4 gg = *(const LAS f32x4*)(sg + j0);
#pragma unroll
                    for (int e = 0; e < 4; ++e) df[rg * 4 + e] = (i >= j0 + e) ? __expf(fminf(gi - gg[e], 0.f)) : 0.f;
                }
                f32x16 acc = zero16(), accb = zero16();
#pragma unroll
                for (int ks = 0; ks < 8; ks += 2) { acc = mfma32(frag_row(sK, 136, mt2 * 32, ks * 16, ln), frag_row(sQ, 136, nt2 * 32, ks * 16, ln), acc);
                    accb = mfma32(frag_row(sK, 136, mt2 * 32, ks * 16 + 16, ln), frag_row(sQ, 136, nt2 * 32, ks * 16 + 16, ln), accb); }
#pragma unroll
                for (int rg = 0; rg < 4; ++rg) {
                    const int j0 = mt2 * 32 + 8 * rg + 4 * (ln >> 5);
                    float v[4];
#pragma unroll
                    for (int e = 0; e < 4; ++e) v[e] = (acc[rg * 4 + e] + accb[rg * 4 + e]) * df[rg * 4 + e];
                    *(LAS u32x2*)(sATT + i * 72 + j0) = pack4(v[0], v[1], v[2], v[3]);
                }
            }
            __syncthreads();
            if (wave < 4 && wantO) {
                float eg[16];
#pragma unroll
                for (int rg = 0; rg < 4; ++rg) {
                    const f32x4 gg = *(const LAS f32x4*)(sg + mt2 * 32 + 8 * rg + 4 * (ln >> 5));
#pragma unroll
                    for (int e = 0; e < 4; ++e) eg[rg * 4 + e] = __expf(gg[e]);
                }
                f32x16 a1 = zero16(), a1b = zero16(), a2 = zero16();
#pragma unroll
                for (int ks = 0; ks < 8; ks += 2) { a1 = mfma32(frag_row(sQ, 136, mt2 * 32, ks * 16, ln), frag_row(sST, 136, nt2 * 32, ks * 16, ln), a1);
                    a1b = mfma32(frag_row(sQ, 136, mt2 * 32, ks * 16 + 16, ln), frag_row(sST, 136, nt2 * 32, ks * 16 + 16, ln), a1b); }
#pragma unroll
                for (int ks = 0; ks < 4; ++ks) a2 = mfma32(frag_row(sATT, 72, mt2 * 32, ks * 16, ln), frag_row(sVNT, 72, nt2 * 32, ks * 16, ln), a2);
                const int dv = nt2 * 32 + (ln & 31);
#pragma unroll
                for (int rg = 0; rg < 4; ++rg) {
                    const int i0 = mt2 * 32 + 8 * rg + 4 * (ln >> 5);
#pragma unroll
                    for (int e = 0; e < 4; ++e) sO[(i0 + e) * 72 + dv] = f2bf((a1[rg * 4 + e] + a1b[rg * 4 + e]) * eg[rg * 4 + e] + a2[rg * 4 + e]);
                }
            }
            {
                const float gl = __expf(g63);
#pragma unroll
                for (int reg = 0; reg < 16; ++reg) S[reg] *= gl;
#pragma unroll
                for (int ks = 0; ks < 4; ++ks) S = mfma32(frag_col_tr(sK, 136, mt * 32, ks * 16, ln), frag_row(sVNsT, 72, nt * 32, ks * 16, ln), S);
            }
            __syncthreads();
            if (wantO) {
                const int i = tid >> 3, ch = tid & 7;
                const size_t grow = (size_t)rowbase + (d ? 63 - i : i);
                *(u32x4*)(obuf + ((size_t)d * NX + grow) * 1024 + h * 128 + half * 64 + ch * 8) = *(const LAS u32x4*)(sO + i * 72 + ch * 8);
            }
#pragma unroll
            for (int rg = 0; rg < 4; ++rg) {
                const int dk0 = mt * 32 + 8 * rg + 4 * (ln >> 5);
                *(LAS u32x2*)(sST + (nt * 32 + (ln & 31)) * 136 + dk0) = pack4(S[rg * 4 + 0], S[rg * 4 + 1], S[rg * 4 + 2], S[rg * 4 + 3]);
            }
        }
        }
        __syncthreads();
    }
}

DEV void phase_dnout(const Params& P) {
    const bf16_t* obuf = (const bf16_t*)(P.ws + OFF_OBUF);
    const bf16_t* Pz = (const bf16_t*)(P.ws + OFF_PZ);
    bf16_t* A = (bf16_t*)(P.ws + OFF_A);
    const int tid = tid_fresh(); const int wave = tid >> 6, lane = tid & 63;
    for (int row = blockIdx.x * 8 + wave; row < NX; row += gridDim.x * 8) {
#pragma unroll
        for (int c = 0; c < 2; ++c) {
            const int col = c * 512 + lane * 8;
            const u32x4 of = *(const u32x4*)(obuf + (size_t)row * 1024 + col), ob = *(const u32x4*)(obuf + ((size_t)NX + row) * 1024 + col);
            const u32x4 zz = *(const u32x4*)(Pz + (size_t)row * 1024 + col);
            float o[8], o2[8], z[8]; unpack8(of, o); unpack8(ob, o2); unpack8(zz, z);
            float ss = 0.f;
#pragma unroll
            for (int e = 0; e < 8; ++e) { o[e] += o2[e]; ss += o[e] * o[e]; }
            ss = sum16(ss);
            const float rn = rsqrtf(ss * (1.f / 128.f) + EPS);
            float y[8];
#pragma unroll
            for (int e = 0; e < 8; ++e) y[e] = o[e] * rn * P.dn_norm_g[(col & 127) + e] * silu(z[e]);
            u32x4 ov; ov.x = pk2(y[0], y[1]); ov.y = pk2(y[2], y[3]); ov.z = pk2(y[4], y[5]); ov.w = pk2(y[6], y[7]);
            *(u32x4*)(A + (size_t)row * 1024 + col) = ov;
        }
    }
}

namespace pg8 {
#define PG8_LAS __attribute__((address_space(3)))
typedef unsigned short bf16_t;
typedef short bf16x8 __attribute__((ext_vector_type(8)));
typedef float f32x4 __attribute__((ext_vector_type(4)));
typedef unsigned u32x4 __attribute__((ext_vector_type(4)));
constexpr int BM = 256, BK = 64, HALF = 128, HTB = HALF * BK * 2  , STAGE_BYTES = 8 * HTB, NXCD = 8, WGM = 8;

__host__ __device__ __forceinline__ int lds_byte(int r, int c) { const int st = (r >> 4) * 2 + (c >> 5), rr = r & 15, cc = c & 31, ob = rr * 64 + cc * 2; return st * 1024 + (ob ^ (((ob >> 9) & 1) << 5)); }
__host__ __device__ __forceinline__ void stage_rc(int b, int& R, int& C) { const int st = b / 1024, sb = b % 1024, swz = sb ^ (((sb >> 9) & 1) << 5); R = (st >> 1) * 16 + swz / 64; C = (st & 1) * 32 + (swz % 64) / 2; }
__host__ __device__ __forceinline__ int perm32(int rho) { const int n = rho >> 4, i = rho & 15; return 8 * (i >> 2) + 4 * n + (i & 3); }

struct Unit { int pm, pn; };
struct Gemm { const bf16_t* A; const bf16_t* Bt; int M, N, K; };

struct StaticOrder {
    int nM, nN, nwg, G, c;
    __host__ __device__ void init(int M, int N, int G_, int c_) { nM = M / BM; nN = N / BM; nwg = nM * nN; G = G_; c = c_; }
    __host__ __device__ bool next(int i, Unit& u) const {
        const long L = (long)i * G + c; if (L >= nwg) return false;
        int wgid = (int)L; { const int q = nwg / NXCD, r = nwg % NXCD, xcd = wgid % NXCD, off = wgid / NXCD; wgid = (xcd < r ? xcd * (q + 1) : r * (q + 1) + (xcd - r) * q) + off; }
        const int nig = WGM * nN, gid = wgid / nig, fm = gid * WGM, gsz = (nM - fm) < WGM ? (nM - fm) : WGM;
        u.pm = fm + ((wgid % nig) % gsz); u.pn = (wgid % nig) / gsz; return true;
    }
    __device__ __forceinline__ void a_ready(const Unit&) const {}
    __device__ __forceinline__ void done(const Unit&) const {}
};

__device__ __forceinline__ unsigned cvt_pk_bf16(float lo, float hi) { typedef float v2f __attribute__((ext_vector_type(2))); typedef __bf16 v2b __attribute__((ext_vector_type(2))); const v2f v = {lo, hi}; return __builtin_bit_cast(unsigned, __builtin_convertvector(v, v2b)); }
__device__ __forceinline__ u32x4 pack8(const f32x4 v0, const f32x4 v1) { u32x4 w; w.x = cvt_pk_bf16(v0[0], v0[1]); w.y = cvt_pk_bf16(v0[2], v0[3]); w.z = cvt_pk_bf16(v1[0], v1[1]); w.w = cvt_pk_bf16(v1[2], v1[3]); return w; }
struct EpiQ {
    static constexpr bool PERM = true, AFTER_DRAIN = false;
    bf16_t* O; int ldc;
    __device__ __forceinline__ void operator()(const f32x4 (&acc)[2][2][4][2], const Unit& u, int wr, int wc, int fr, int fq) const {
        const int row0 = u.pm * BM + wr * 64 + fr, col0 = u.pn * BM + wc * 32 + 8 * fq;
#pragma unroll
        for (int ai = 0; ai < 2; ++ai)
#pragma unroll
            for (int m = 0; m < 4; ++m) { bf16_t* rowp = O + (size_t)(row0 + ai * HALF + m * 16) * ldc + col0;
#pragma unroll
                for (int bj = 0; bj < 2; ++bj) *(u32x4*)(rowp + bj * HALF) = pack8(acc[ai][bj][m][0], acc[ai][bj][m][1]); }
    }
};
struct EpiWinP {
    static constexpr bool PERM = true, AFTER_DRAIN = false;
    bf16_t* qkv; bf16_t* z; float* ab;
    __device__ __forceinline__ void operator()(const f32x4 (&acc)[2][2][4][2], const Unit& u, int wr, int wc, int fr, int fq) const {
        const int row0 = u.pm * BM + wr * 64 + fr;
        if (u.pn < 16) {
            bf16_t* base = u.pn < 12 ? qkv : z; const int ldc = u.pn < 12 ? 3072 : 1024, col0 = (u.pn < 12 ? u.pn : u.pn - 12) * BM + wc * 32 + 8 * fq;
#pragma unroll
            for (int ai = 0; ai < 2; ++ai)
#pragma unroll
                for (int m = 0; m < 4; ++m) { bf16_t* rowp = base + (size_t)(row0 + ai * HALF + m * 16) * ldc + col0;
#pragma unroll
                    for (int bj = 0; bj < 2; ++bj) *(u32x4*)(rowp + bj * HALF) = pack8(acc[ai][bj][m][0], acc[ai][bj][m][1]); }
        } else if (wc == 0) {
#pragma unroll
            for (int ai = 0; ai < 2; ++ai)
#pragma unroll
                for (int m = 0; m < 4; ++m) { float* rowp = ab + (size_t)(row0 + ai * HALF + m * 16) * 32 + 8 * fq;
                    *(f32x4*)rowp = acc[ai][0][m][0]; *(f32x4*)(rowp + 4) = acc[ai][0][m][1]; }
        }
    }
};
struct EpiRes {
    static constexpr bool PERM = true, AFTER_DRAIN = false;
    bf16_t* h; const float* gate;
    __device__ __forceinline__ void operator()(const f32x4 (&acc)[2][2][4][2], const Unit& u, int wr, int wc, int fr, int fq) const {
        const int row0 = u.pm * BM + wr * 64 + fr, col0 = u.pn * BM + wc * 32 + 8 * fq;
#pragma unroll
        for (int ai = 0; ai < 2; ++ai)
#pragma unroll
            for (int m = 0; m < 4; ++m) { const int row = row0 + ai * HALF + m * 16; bf16_t* rowp = h + (size_t)row * 1024 + col0; const float* gp = gate + (row >> 11) * 6144 + col0;
#pragma unroll
                for (int bj = 0; bj < 2; ++bj) {
                    const u32x4 hv = *(const u32x4*)(rowp + bj * HALF);
                    const f32x4 g0 = *(const f32x4*)(gp + bj * HALF), g1 = *(const f32x4*)(gp + bj * HALF + 4);
                    const f32x4 a0 = acc[ai][bj][m][0], a1 = acc[ai][bj][m][1];
                    f32x4 n0, n1;
                    n0[0] = __uint_as_float(hv.x << 16) + g0[0] * a0[0]; n0[1] = __uint_as_float(hv.x & 0xffff0000u) + g0[1] * a0[1];
                    n0[2] = __uint_as_float(hv.y << 16) + g0[2] * a0[2]; n0[3] = __uint_as_float(hv.y & 0xffff0000u) + g0[3] * a0[3];
                    n1[0] = __uint_as_float(hv.z << 16) + g1[0] * a1[0]; n1[1] = __uint_as_float(hv.z & 0xffff0000u) + g1[1] * a1[1];
                    n1[2] = __uint_as_float(hv.w << 16) + g1[2] * a1[2]; n1[3] = __uint_as_float(hv.w & 0xffff0000u) + g1[3] * a1[3];
                    *(u32x4*)(rowp + bj * HALF) = pack8(n0, n1);
                } }
    }
};

template <class Epi, class Sched, bool ALIGN_EPI = false, bool SP2 = false>
__device__ __forceinline__ void gemm_phase(PG8_LAS unsigned char* lds, const Gemm g, const Sched& S, const Epi& E) {
    const int tid = tid_fresh(), wid = __builtin_amdgcn_readfirstlane(tid >> 6), lane = tid & 63, wr = wid >> 2, wc = wid & 3, fr = lane & 15, fq = lane >> 4;
    const int K = g.K, nt = K / BK;
    unsigned voffA[2], voffB[2];
#pragma unroll
    for (int i = 0; i < 2; ++i) { int R, C; stage_rc(tid * 16 + i * 8192, R, C); const int Rb = Epi::PERM ? ((R & ~31) + perm32(R & 31)) : R;
        voffA[i] = (unsigned)(R * K + C) * 2u; voffB[i] = (unsigned)(Rb * K + C) * 2u; }
    const size_t kstep = (size_t)(BK * 2);
    const size_t hstep = (size_t)HALF * K * 2;
    const size_t tstep = 2 * hstep;
    const unsigned ldsw = (unsigned)wid * 1024u;
    const int aoff = lds_byte(wr * 64 + fr, fq * 8), boff = lds_byte(wc * 32 + fr, fq * 8);
#define PG8_SA(b, h) (((b) * 2 + (h)) * HTB)
#define PG8_SB(b, h) ((4 + (b) * 2 + (h)) * HTB)
#define PG8_STAGE(bufoff, gbase, voff) do { _Pragma("unroll") for (int _i = 0; _i < 2; ++_i) \
        __builtin_amdgcn_global_load_lds((const unsigned*)((const char*)(gbase) + (voff)[_i]), (PG8_LAS unsigned*)(lds + (bufoff) + ldsw + _i * 8192), 16, 0, 0); } while (0)
#define PG8_LDA(dst, b, h) do { _Pragma("unroll") for (int m = 0; m < 4; ++m) _Pragma("unroll") for (int k = 0; k < 2; ++k) dst[m][k] = *(const PG8_LAS bf16x8*)(lds + PG8_SA(b, h) + aoff + m * 2048 + k * 1024); } while (0)
#define PG8_LDB(dst, b, h) do { _Pragma("unroll") for (int n = 0; n < 2; ++n) _Pragma("unroll") for (int k = 0; k < 2; ++k) dst[n][k] = *(const PG8_LAS bf16x8*)(lds + PG8_SB(b, h) + boff + n * 2048 + k * 1024); } while (0)
#define PG8_MMA(ai, bj, At, Bt) do { __builtin_amdgcn_s_setprio(1); _Pragma("unroll") for (int m = 0; m < 4; ++m) _Pragma("unroll") for (int n = 0; n < 2; ++n) _Pragma("unroll") for (int k = 0; k < 2; ++k) \
        acc[ai][bj][m][n] = __builtin_amdgcn_mfma_f32_16x16x32_bf16(Bt[n][k], At[m][k], acc[ai][bj][m][n], 0, 0, 0); __builtin_amdgcn_s_setprio(0); } while (0)
#define PG8_WAIT_V(n) asm volatile("s_waitcnt vmcnt(" #n ")" ::: "memory")
#define PG8_WAIT_L(n) asm volatile("s_waitcnt lgkmcnt(" #n ")" ::: "memory")
#define PG8_BAR __builtin_amdgcn_s_barrier()
#define PG8_SCHED __builtin_amdgcn_sched_barrier(0)
    Unit cur, nxt; int ui = 0;
    if (!S.next(0, cur)) return;
    f32x4 acc[2][2][4][2];
#pragma unroll
    for (int a = 0; a < 2; ++a)
#pragma unroll
        for (int b = 0; b < 2; ++b)
#pragma unroll
            for (int m = 0; m < 4; ++m)
#pragma unroll
                for (int n = 0; n < 2; ++n) acc[a][b][m][n] = (f32x4){0.f, 0.f, 0.f, 0.f};
    bf16x8 At[4][2], B0[2][2], B1[2][2];
    const char* cA = (const char*)g.A + (size_t)cur.pm * tstep; const char* cB = (const char*)g.Bt + (size_t)cur.pn * tstep;
    S.a_ready(cur);
    if constexpr (SP2) {
        PG8_STAGE(PG8_SB(0, 0), cB, voffB); PG8_STAGE(PG8_SB(0, 1), cB + hstep, voffB); PG8_STAGE(PG8_SA(0, 0), cA, voffA); PG8_STAGE(PG8_SA(0, 1), cA + hstep, voffA);
        if (wr == 1) PG8_BAR;
        PG8_WAIT_V(2); PG8_BAR;
        PG8_STAGE(PG8_SB(1, 0), cB + kstep, voffB); PG8_STAGE(PG8_SA(1, 0), cA + kstep, voffA); PG8_STAGE(PG8_SB(1, 1), cB + hstep + kstep, voffB);
        PG8_WAIT_V(6); PG8_BAR;
    } else {
        PG8_STAGE(PG8_SB(0, 0), cB, voffB); PG8_STAGE(PG8_SA(0, 0), cA, voffA); PG8_STAGE(PG8_SB(0, 1), cB + hstep, voffB); PG8_STAGE(PG8_SA(0, 1), cA + hstep, voffA);
        if (wr == 1) PG8_BAR;
        PG8_WAIT_V(4); PG8_BAR;
        PG8_STAGE(PG8_SB(1, 0), cB + kstep, voffB); PG8_STAGE(PG8_SA(1, 0), cA + kstep, voffA); PG8_STAGE(PG8_SB(1, 1), cB + hstep + kstep, voffB);
        PG8_WAIT_V(6); PG8_BAR;
    }
    for (;;) {
        const bool has_next = S.next(ui + 1, nxt);
        const char* nA = has_next ? (const char*)g.A + (size_t)nxt.pm * tstep : cA; const char* nB = has_next ? (const char*)g.Bt + (size_t)nxt.pn * tstep : cB;
        for (int t = 0; t < nt; t += 2) {
            const bool last = (t == nt - 2);
            const char* a1 = cA + (size_t)(t + 1) * kstep;
            const char* a2 = last ? nA : cA + (size_t)(t + 2) * kstep; const char* b2 = last ? nB : cB + (size_t)(t + 2) * kstep;
            const char* a3 = a2 + kstep; const char* b3 = b2 + kstep;
            if (last && has_next) S.a_ready(nxt);
            if constexpr (SP2) {
            PG8_LDB(B0, 0, 0); PG8_LDB(B1, 0, 1); PG8_SCHED; PG8_LDA(At, 0, 0); PG8_STAGE(PG8_SA(1, 1), a1 + hstep, voffA);
            PG8_WAIT_V(8); PG8_WAIT_L(0); PG8_BAR; PG8_MMA(0, 0, At, B0); PG8_MMA(0, 1, At, B1); PG8_BAR; PG8_SCHED;
            PG8_LDA(At, 0, 1); PG8_STAGE(PG8_SB(0, 0), b2, voffB); PG8_STAGE(PG8_SB(0, 1), b2 + hstep, voffB); PG8_STAGE(PG8_SA(0, 0), a2, voffA);
            PG8_WAIT_V(8); PG8_WAIT_L(0); PG8_BAR; PG8_MMA(1, 0, At, B0); PG8_MMA(1, 1, At, B1); PG8_BAR; PG8_SCHED;
            PG8_LDB(B0, 1, 0); PG8_LDB(B1, 1, 1); PG8_SCHED; PG8_LDA(At, 1, 0); PG8_STAGE(PG8_SA(0, 1), a2 + hstep, voffA);
            PG8_WAIT_V(8); PG8_WAIT_L(0); PG8_BAR; PG8_MMA(0, 0, At, B0); PG8_MMA(0, 1, At, B1); PG8_BAR; PG8_SCHED;
            PG8_LDA(At, 1, 1); PG8_STAGE(PG8_SB(1, 0), b3, voffB); PG8_STAGE(PG8_SB(1, 1), b3 + hstep, voffB); PG8_STAGE(PG8_SA(1, 0), a3, voffA);
            PG8_WAIT_V(8); PG8_WAIT_L(0); PG8_BAR; PG8_MMA(1, 0, At, B0); PG8_MMA(1, 1, At, B1); PG8_BAR; PG8_SCHED;
            } else {
            PG8_LDB(B0, 0, 0); PG8_SCHED; PG8_LDA(At, 0, 0); PG8_STAGE(PG8_SA(1, 1), a1 + hstep, voffA);
            PG8_WAIT_L(8); PG8_BAR; PG8_WAIT_L(0); PG8_MMA(0, 0, At, B0); PG8_BAR; PG8_SCHED;
            PG8_LDB(B1, 0, 1); PG8_STAGE(PG8_SB(0, 0), b2, voffB);
            PG8_BAR; PG8_WAIT_L(0); PG8_MMA(0, 1, At, B1); PG8_BAR;
            PG8_LDA(At, 0, 1); PG8_STAGE(PG8_SA(0, 0), a2, voffA);
            PG8_BAR; PG8_WAIT_L(0); PG8_MMA(1, 0, At, B0); PG8_BAR; PG8_SCHED;
            PG8_STAGE(PG8_SB(0, 1), b2 + hstep, voffB);
            PG8_WAIT_V(6); PG8_BAR; PG8_MMA(1, 1, At, B1); PG8_BAR;
            PG8_LDB(B0, 1, 0); PG8_SCHED; PG8_LDA(At, 1, 0); PG8_STAGE(PG8_SA(0, 1), a2 + hstep, voffA);
            PG8_WAIT_L(8); PG8_BAR; PG8_WAIT_L(0); PG8_MMA(0, 0, At, B0); PG8_BAR; PG8_SCHED;
            PG8_LDB(B1, 1, 1); PG8_STAGE(PG8_SB(1, 0), b3, voffB);
            PG8_BAR; PG8_WAIT_L(0); PG8_MMA(0, 1, At, B1); PG8_BAR;
            PG8_LDA(At, 1, 1); PG8_STAGE(PG8_SA(1, 0), a3, voffA);
            PG8_BAR; PG8_WAIT_L(0); PG8_MMA(1, 0, At, B0); PG8_BAR; PG8_SCHED;
            PG8_STAGE(PG8_SB(1, 1), b3 + hstep, voffB);
            PG8_WAIT_V(6); PG8_BAR; PG8_MMA(1, 1, At, B1); PG8_BAR;
            }
        }
        if constexpr (ALIGN_EPI) { if (wr == 0) PG8_BAR; }
        if constexpr (!Epi::AFTER_DRAIN) { E(acc, cur, wr, wc, fr, fq); S.done(cur); }
        if (!has_next) break;
#pragma unroll
        for (int a = 0; a < 2; ++a)
#pragma unroll
            for (int b = 0; b < 2; ++b)
#pragma unroll
                for (int m = 0; m < 4; ++m)
#pragma unroll
                    for (int n = 0; n < 2; ++n) acc[a][b][m][n] = (f32x4){0.f, 0.f, 0.f, 0.f};
        cur = nxt; cA = nA; cB = nB; ++ui;
        if constexpr (ALIGN_EPI) { if (wr == 1) PG8_BAR; }
    }
    PG8_WAIT_V(0);
    if constexpr (!ALIGN_EPI) { if (wr == 0) PG8_BAR; }
    PG8_BAR;
    if constexpr (Epi::AFTER_DRAIN) { E.fused(acc, cur, wr, wc, fr, fq, lds, wid, lane); S.done(cur); }
#undef PG8_SA
#undef PG8_SB
#undef PG8_STAGE
#undef PG8_LDA
#undef PG8_LDB
#undef PG8_MMA
#undef PG8_WAIT_V
#undef PG8_WAIT_L
#undef PG8_BAR
#undef PG8_SCHED
}
}

#define XB_TMO      128
#define XB_XCNT(j)  (256  + 64 * (j))
#define XB_XSUB(j)  (1280 + 64 * (j))
#define XB_XGEN(j)  (2304 + 64 * (j))
#define XB_TOP      3328
#define XB_TOPGEN   3392
#define XCD_BAR_WORDS 3456
#define XB_SPIN_CAP (1u << 22)
DEV unsigned xb_ld(unsigned* p)              { return __hip_atomic_load(p, __ATOMIC_RELAXED, __HIP_MEMORY_SCOPE_AGENT); }
DEV unsigned xb_add(unsigned* p, unsigned v) { return __hip_atomic_fetch_add(p, v, __ATOMIC_RELAXED, __HIP_MEMORY_SCOPE_AGENT); }
DEV unsigned xb_xcc_id() { return (unsigned)__builtin_amdgcn_s_getreg((3 << 11) | 20) & 0xFu; }
#define XB_SPIN(cond, bar) do { unsigned _sp = 0; while (cond) { __builtin_amdgcn_s_sleep(1); \
    if ((++_sp & 255u) == 0u) { if (xb_ld(&(bar)[XB_TMO])) break; if (_sp > XB_SPIN_CAP) { atomicAdd(&(bar)[XB_TMO], 1u); break; } } } } while (0)
struct XcdBarrier { unsigned* bar; unsigned x; volatile LAS unsigned* st; };
DEV XcdBarrier xcd_barrier_post(unsigned* bar, volatile LAS unsigned* st) {
    XcdBarrier b; b.bar = bar; b.x = xb_xcc_id(); b.st = st;
    if (threadIdx.x == 0) (void)xb_add(&bar[XB_XCNT(b.x)], 1u);
    return b;
}
DEV void xcd_barrier_complete(unsigned* bar, unsigned x, unsigned& nloc, unsigned& nx) {
    const unsigned G = gridDim.x * gridDim.y * gridDim.z;
    unsigned sum, cnt, mine, sp = 0u;
    for (;;) {
        sum = 0u; cnt = 0u; mine = 0u;
#pragma unroll
        for (unsigned j = 0; j < 16; ++j) { const unsigned c = xb_ld(&bar[XB_XCNT(j)]); sum += c; cnt += (c > 0u) ? 1u : 0u; mine = (j == x) ? c : mine; }
        if (sum == G) break;
        __builtin_amdgcn_s_sleep(1);
        if ((++sp & 255u) == 0u) { if (xb_ld(&bar[XB_TMO])) break; if (sp > XB_SPIN_CAP) { atomicAdd(&bar[XB_TMO], 1u); break; } }
    }
    nloc = mine > 0u ? mine : 1u; nx = cnt > 0u ? cnt : 1u;
}
DEV void xcd_barrier(const XcdBarrier& b) {
    asm volatile("s_waitcnt vmcnt(0)" ::: "memory");
    __syncthreads();
    if (threadIdx.x == 0) {
        unsigned* bar = b.bar;
        __builtin_amdgcn_s_waitcnt(0);
        unsigned nloc = b.st[0], nx = b.st[1];
        if (nloc == 0u) { xcd_barrier_complete(bar, b.x, nloc, nx); b.st[0] = nloc; b.st[1] = nx; }
        const unsigned old = xb_add(&bar[XB_XSUB(b.x)], 1u);
        const unsigned gen = old / nloc;
        if (old + 1u == (gen + 1u) * nloc) {
            __builtin_amdgcn_fence(__ATOMIC_RELEASE, "agent");
            asm volatile("s_waitcnt vmcnt(0)" ::: "memory");
            const unsigned og = xb_add(&bar[XB_TOP], 1u);
            const unsigned tg = og / nx;
            if (og + 1u == (tg + 1u) * nx) xb_add(&bar[XB_TOPGEN], 1u);
            else XB_SPIN(xb_ld(&bar[XB_TOPGEN]) == tg, bar);
            __builtin_amdgcn_fence(__ATOMIC_ACQUIRE, "agent");
            xb_add(&bar[XB_XGEN(b.x)], 1u);
            asm volatile("s_waitcnt vmcnt(0)" ::: "memory");
        } else {
            XB_SPIN(xb_ld(&bar[XB_XGEN(b.x)]) == gen, bar);
            __builtin_amdgcn_fence(__ATOMIC_ACQUIRE, "agent");
            asm volatile("s_waitcnt vmcnt(0)" ::: "memory");
        }
    }
    __syncthreads();
}

__global__ void __launch_bounds__(NTHREADS) fwd_megakernel(Params P) {
    __shared__ __attribute__((aligned(16))) unsigned char lds_raw[131072 + 4096];
    const ldsp lds = (ldsp)lds_raw;
    cg::grid_group grid = cg::this_grid();
    volatile LAS unsigned* xbst = (volatile LAS unsigned*)(lds + 131072);
    if (threadIdx.x == 0) { xbst[0] = 0u; xbst[1] = 0u; }
    __syncthreads();
    const XcdBarrier xbar = xcd_barrier_post((unsigned*)(P.ws + OFF_BAR), xbst);
    if (threadIdx.x == 0) xbst[2] = xb_add((unsigned*)(P.ws + OFF_BAR) + xbar.x, 1u);
#define GBAR() xcd_barrier(xbar)
    const float* modv = (const float*)(P.ws + OFF_MODV);
    bf16_t* Abuf = (bf16_t*)(P.ws + OFF_A);

#define RUN(rep, ...) for (int rep_i = 0; rep_i < (rep); ++rep_i) { __VA_ARGS__; GBAR(); }
    for (int rep_i = 0; rep_i < REP_PREP; ++rep_i) { phase_prep(P, lds); grid.sync(); }
    if (threadIdx.x == 0) {
        unsigned* bar = (unsigned*)(P.ws + OFF_BAR);
        unsigned nact = 0, pos = 0, mine = 1;
        for (unsigned j = 0; j < 16; ++j) { const unsigned cn = xb_ld(&bar[XB_XCNT(j)]); if (cn) { if (j < xbar.x) ++pos; ++nact; } if (j == xbar.x) mine = cn; }
        xbst[3] = nact ? nact : 1u; xbst[4] = pos; xbst[5] = mine ? mine : 1u;
    }
    __syncthreads();
    XGeo geo; geo.rank = __builtin_amdgcn_readfirstlane((int)xbst[2]); geo.nact = __builtin_amdgcn_readfirstlane((int)xbst[3]); geo.pos = __builtin_amdgcn_readfirstlane((int)xbst[4]); geo.nloc = __builtin_amdgcn_readfirstlane((int)xbst[5]);
    RUN(REP_MOD, phase_modulate<0>(P, 0, 0, NT))
    RUN(REP_POOL, phase_pool(P, lds))
    RUN(REP_MOD, phase_modulate<1>(P, 0, 1, NT, true))
    RUN(REP_GEMM, { pg8::Gemm g{Abuf, (const bf16_t*)(P.ws + OFF_WQT), NT, 2048, 1024}; pg8::StaticOrder S; S.init(NT, 2048, gridDim.x, blockIdx.x); pg8::EpiQ e{(bf16_t*)(P.ws + OFF_R1), 2048}; pg8::gemm_phase<pg8::EpiQ, pg8::StaticOrder, true, true>(lds, g, S, e); })
    RUN(REP_TOPK, phase_topk(P, 0, NT, lds))
    phase_experts_sliced<1>(P, 0, NT, geo); GBAR();
    phase_experts_act(P, 0, NT); GBAR();
    phase_experts_sliced<2>(P, 0, NT, geo); GBAR();
    RUN(REP_MOD, phase_modulate<1>(P, 1, 0, NT))
    RUN(REP_GEMM, { pg8::Gemm g{Abuf, (const bf16_t*)(P.ws + OFF_WINT), NT, 4352, 1024}; pg8::StaticOrder S; S.init(NT, 4352, gridDim.x, blockIdx.x);
      pg8::EpiWinP e{(bf16_t*)(P.ws + OFF_R1), (bf16_t*)(P.ws + OFF_PZ), (float*)(P.ws + OFF_AB)}; pg8::gemm_phase<pg8::EpiWinP, pg8::StaticOrder, true, true>(lds, g, S, e); })
    RUN(REP_CONV, phase_conv(P))
    RUN(REP_CHUNK, phase_chunk(P, lds))
    RUN(REP_SCAN, phase_scan(P, lds))
    RUN(REP_DNOUT, phase_dnout(P))
    { pg8::Gemm g{Abuf, (const bf16_t*)(P.ws + OFF_WOUTT), NX, 1024, 1024}; pg8::StaticOrder S; S.init(NX, 1024, gridDim.x, blockIdx.x); pg8::EpiRes e{(bf16_t*)(P.ws + OFF_H), modv + 9 * 6144 + 2048}; pg8::gemm_phase<pg8::EpiRes, pg8::StaticOrder, false, true>(lds, g, S, e); }
    GBAR();
    RUN(REP_MOD, phase_modulate<1>(P, 1, 1, NX, true))
    RUN(REP_GEMM, { pg8::Gemm g{Abuf, (const bf16_t*)(P.ws + OFF_WQT) + (size_t)2048 * 1024, NX, 2048, 1024}; pg8::StaticOrder S; S.init(NX, 2048, gridDim.x, blockIdx.x); pg8::EpiQ e{(bf16_t*)(P.ws + OFF_R1), 2048}; pg8::gemm_phase<pg8::EpiQ, pg8::StaticOrder, true, true>(lds, g, S, e); })
    RUN(REP_TOPK, phase_topk(P, 1, NX, lds))
    phase_experts_sliced<1>(P, 1, NX, geo); GBAR();
    phase_experts_act(P, 1, NX); GBAR();
    phase_experts_sliced<2>(P, 1, NX, geo); GBAR();
    phase_final(P);
}

extern "C" void kernel_launch(void* const* d_in, const int* in_sizes, int n_in, void* d_out, int out_size, void* d_ws, size_t ws_size, hipStream_t stream) {
    static int grid_blocks = 0;
    if (grid_blocks == 0) {
        if (n_in != 21 || out_size != NX * D || ws_size < WS_END) {
            fprintf(stderr, "kernel_launch: unexpected shapes: n_in %d out %d ws %zu (need %zu)\n", n_in, out_size, ws_size, (size_t)WS_END);
            grid_blocks = -1; return;
        }
        int dev = 0, cus = 0, per_cu = 0;
        hipGetDevice(&dev);
        hipDeviceGetAttribute(&cus, hipDeviceAttributeMultiprocessorCount, dev);
        hipOccupancyMaxActiveBlocksPerMultiprocessor(&per_cu, fwd_megakernel, NTHREADS, 0);
        if (per_cu < 1) { fprintf(stderr, "kernel_launch: occupancy query reports %d blocks per CU\n", per_cu); grid_blocks = -1; return; }
        grid_blocks = cus;
    }
    if (grid_blocks < 0) return;
    if (hipMemsetAsync((char*)d_ws + OFF_BAR, 0, XCD_BAR_WORDS * 4, stream) != hipSuccess) { fprintf(stderr, "kernel_launch: memset of barrier words failed\n"); return; }
    Params p{};
    const float** pp = (const float**)&p;
    for (int i = 0; i < 21; ++i) pp[i] = (const float*)d_in[i];
    p.out = (float*)d_out; p.ws = (unsigned char*)d_ws;
    void* args[] = {&p};
    hipError_t e = hipLaunchCooperativeKernel((void*)fwd_megakernel, dim3(grid_blocks), dim3(NTHREADS), args, 0, stream);
    if (e != hipSuccess) fprintf(stderr, "cooperative launch failed: %s (grid %d)\n", hipGetErrorString(e), grid_blocks);
}
```

```cpp
#include <hip/hip_runtime.h>
#include <hip/hip_cooperative_groups.h>
#include <cstdio>
#include <cstdint>
namespace cg = cooperative_groups;

#define DEV __device__ __forceinline__
typedef unsigned short bf16_t;
typedef short bf16x8 __attribute__((ext_vector_type(8)));
typedef float f32x4 __attribute__((ext_vector_type(4)));
typedef float f32x16 __attribute__((ext_vector_type(16)));
typedef unsigned u32x4 __attribute__((ext_vector_type(4)));
typedef unsigned u32x2 __attribute__((ext_vector_type(2)));
#define LAS __attribute__((address_space(3)))
typedef LAS unsigned char* ldsp;
DEV int tid_fresh() { int t = threadIdx.x; asm volatile("" : "+v"(t)); return t; }
DEV ldsp launder(ldsp p) { asm volatile("" : "+v"(p)); return p; }

constexpr int D = 1024, NB = 8, SEQ = 2048, CTX = 256;
constexpr int NX = NB * SEQ, NC = NB * CTX, NT = NX + NC;
constexpr int NTHREADS = 512;
constexpr float EPS = 1e-6f;
#ifndef REP_PREP
#define REP_PREP 1
#endif
#ifndef REP_MOD
#define REP_MOD 1
#endif
#ifndef REP_POOL
#define REP_POOL 1
#endif
#ifndef REP_GEMM
#define REP_GEMM 1
#endif
#ifndef REP_TOPK
#define REP_TOPK 1
#endif
#ifndef REP_CONV
#define REP_CONV 1
#endif
#ifndef REP_CHUNK
#define REP_CHUNK 1
#endif
#ifndef REP_SCAN
#define REP_SCAN 1
#endif
#ifndef REP_DNOUT
#define REP_DNOUT 1
#endif

constexpr size_t MiB = 1024 * 1024;
constexpr size_t TAB_ELEMS = (size_t)16384 * 1024;
constexpr size_t OFF_TAB   = 0;
constexpr size_t OFF_WQT   = 128 * MiB;
constexpr size_t OFF_WINT  = OFF_WQT + 8 * MiB;
constexpr size_t OFF_WOUTT = OFF_WINT + (size_t)4352 * 1024 * 2;
constexpr size_t OFF_POOLT = OFF_WOUTT + 2 * MiB;
constexpr size_t OFF_KEYS  = OFF_POOLT + 512 * 1024;
constexpr size_t OFF_MODV  = OFF_KEYS + 1 * MiB;
constexpr size_t OFF_HC    = OFF_MODV + 512 * 1024;
constexpr size_t OFF_SELI  = OFF_HC + 8 * MiB;
constexpr size_t OFF_SELG  = OFF_SELI + (size_t)NT * 128 * 4;
constexpr size_t OFF_AB    = OFF_SELG + (size_t)NT * 128 * 4;
constexpr size_t OFF_G     = OFF_AB + (size_t)NT * 32 * 4;
constexpr size_t OFF_BETA  = OFF_G + (size_t)2 * NT * 8 * 4;
constexpr size_t OFF_GC    = OFF_BETA + (size_t)2 * NT * 8 * 4;
constexpr size_t OFF_QC    = OFF_GC + (size_t)4608 * 64 * 4;
constexpr size_t OFF_KC    = OFF_QC + (size_t)NT * 1024 * 2;
constexpr size_t OFF_VC    = OFF_KC + (size_t)NT * 1024 * 2;
constexpr size_t OFF_A     = OFF_VC + (size_t)NT * 1024 * 2;
constexpr size_t OFF_R1    = OFF_A + (size_t)NT * 1024 * 2;
constexpr size_t OFF_PZ    = OFF_R1 + (size_t)NT * 3072 * 2;
constexpr size_t OFF_BAR   = OFF_R1 + (size_t)NT * 4096 * 2;
constexpr size_t OFF_H     = OFF_BAR + 16384;
constexpr size_t OFF_XS    = OFF_H + (size_t)NT * 1024 * 2;
constexpr size_t OFF_RSC   = OFF_XS + (size_t)NT * 4;
constexpr size_t WS_END    = OFF_RSC + (size_t)4 * 16384 * 4;
constexpr size_t OFF_WBUF  = OFF_A;
constexpr size_t OFF_UBUF  = OFF_A + (size_t)4608 * 8192 * 2;
constexpr size_t OFF_OBUF  = OFF_TAB + 64 * MiB;
constexpr size_t OFF_PART  = OFF_QC;
constexpr size_t OFF_WEXP  = OFF_QC + (size_t)8 * NT * 128 * 4;
constexpr size_t OFF_A8    = OFF_WEXP + (size_t)NT * 128 * 4;
static_assert(OFF_UBUF + (size_t)4608 * 8192 * 2 <= OFF_PZ, "w/u overlay must not reach Pz");
static_assert(OFF_A8 + (size_t)NT * 1024 <= OFF_A, "PEER partial buffers must fit the q/k/v conv region");

struct Params {
    const float *x, *c, *ctx, *c_ctx, *mod_w, *mod_b, *norm1_g, *norm2_g, *pool_w, *pool_scale;
    const float *dn_w_in, *dn_conv_w, *dn_a_log, *dn_dt_bias, *dn_norm_g, *dn_w_out;
    const float *peer_wq, *peer_keys, *peer_u, *peer_v, *final_g;
    float* out; unsigned char* ws;
};

DEV bf16_t f2bf(float f) { return __builtin_bit_cast(unsigned short, (__bf16)f); }
DEV float bf2f(bf16_t h) { return __uint_as_float(((unsigned)h) << 16); }
typedef float f32x2_t __attribute__((ext_vector_type(2)));
typedef __bf16 bf16x2_t __attribute__((ext_vector_type(2)));
DEV unsigned pk2(float a, float b) { const f32x2_t v = {a, b}; const bf16x2_t r = __builtin_convertvector(v, bf16x2_t); return __builtin_bit_cast(unsigned, r); }
DEV float bflo(unsigned u) { return __uint_as_float(u << 16); }
DEV float bfhi(unsigned u) { return __uint_as_float(u & 0xffff0000u); }
DEV float wave_sum(float v) {
#pragma unroll
    for (int o = 32; o >= 1; o >>= 1) v += __shfl_xor(v, o);
    return v;
}
DEV float wave_max(float v) {
#pragma unroll
    for (int o = 32; o >= 1; o >>= 1) v = fmaxf(v, __shfl_xor(v, o));
    return v;
}
DEV float sum16(float v) {
#pragma unroll
    for (int o = 8; o >= 1; o >>= 1) v += __shfl_xor(v, o);
    return v;
}
DEV f32x16 mfma32(bf16x8 a, bf16x8 b, f32x16 c) { return __builtin_amdgcn_mfma_f32_32x32x16_bf16(a, b, c, 0, 0, 0); }
DEV int crow(int reg, int lane) { return (reg & 3) + 8 * (reg >> 2) + 4 * (lane >> 5); }
DEV f32x16 zero16() { f32x16 z;
#pragma unroll
    for (int i = 0; i < 16; ++i) z[i] = 0.f; return z; }
DEV bf16_t* hrow(const Params& P, int r) { return (bf16_t*)(P.ws + OFF_H) + (size_t)r * 1024; }
DEV float silu(float v) { return v * __builtin_amdgcn_rcpf(1.f + __expf(-v)); }

DEV bf16x8 frag_row(const LAS bf16_t* m, int ld, int r0, int k0, int lane) {
    return *(const LAS bf16x8*)(m + (r0 + (lane & 31)) * ld + k0 + 8 * (lane >> 5));
}
DEV bf16x8 frag_col(const LAS bf16_t* m, int ld, int c0, int k0, int lane) {
    bf16x8 f;
#pragma unroll
    for (int j = 0; j < 8; ++j) f[j] = (short)m[(k0 + 8 * (lane >> 5) + j) * ld + c0 + (lane & 31)];
    return f;
}

typedef short s16x4 __attribute__((ext_vector_type(4)));
DEV s16x4 ds_tr16(ldsp p) { return __builtin_amdgcn_ds_read_tr16_b64_v4i16((LAS s16x4*)p); }
DEV bf16x8 frag_col_tr(const LAS bf16_t* m, int ld, int c0, int k0, int lane) {
    const int gi = lane >> 4, li = lane & 15, q = li >> 2, pc = li & 3, h = gi >> 1;
    const LAS bf16_t* p = m + (k0 + 8 * h + q) * ld + c0 + 16 * (gi & 1) + 4 * pc;
    const s16x4 lo = ds_tr16((ldsp)p), hi = ds_tr16((ldsp)(p + 4 * ld));
    bf16x8 f; f[0] = lo[0]; f[1] = lo[1]; f[2] = lo[2]; f[3] = lo[3]; f[4] = hi[0]; f[5] = hi[1]; f[6] = hi[2]; f[7] = hi[3];
    return f;
}
DEV void p0_convert_item(const float* src, bf16_t* dst, size_t base) {
    const int tid = tid_fresh();
#pragma unroll
    for (int it = 0; it < 8; ++it) {
        const size_t e = base + ((size_t)it * NTHREADS + tid) * 8;
        const f32x4 a = *(const f32x4*)(src + e), b = *(const f32x4*)(src + e + 4);
        u32x4 o; o.x = pk2(a.x, a.y); o.y = pk2(a.z, a.w); o.z = pk2(b.x, b.y); o.w = pk2(b.z, b.w);
        *(u32x4*)(dst + e) = o;
    }
}
DEV void p0_table_item(const float* src, unsigned char* dst, float* rscale, int row0, bool as_int8) {
    const int tid = tid_fresh(), wave = tid >> 6, lane = tid & 63;
#pragma unroll 8
    for (int rr = 0; rr < 16; ++rr) {
        const int e = row0 + wave * 16 + rr;
        f32x4 v[4]; float am = 0.f;
#pragma unroll
        for (int q = 0; q < 4; ++q) { v[q] = __builtin_nontemporal_load((const f32x4*)(src + (size_t)e * 1024 + 256 * q + 4 * lane));
            am = fmaxf(am, fmaxf(fmaxf(fabsf(v[q].x), fabsf(v[q].y)), fmaxf(fabsf(v[q].z), fabsf(v[q].w)))); }
        am = wave_max(am);
        if (as_int8) {
            float ssq = 0.f;
#pragma unroll
            for (int q = 0; q < 4; ++q) ssq += v[q].x * v[q].x + v[q].y * v[q].y + v[q].z * v[q].z + v[q].w * v[q].w;
            ssq = wave_sum(ssq);
            const float top = fminf(am, 2.7f * sqrtf(ssq * (1.f / 1024.f)));
            am = top;
            const float sc = am > 0.f ? 7.f / am : 0.f;
#pragma unroll
            for (int q = 0; q < 4; ++q) {
                const int n0 = (int)fminf(fmaxf(rintf(v[q].x * sc), -7.f), 7.f) + 8, n1 = (int)fminf(fmaxf(rintf(v[q].y * sc), -7.f), 7.f) + 8;
                const int n2 = (int)fminf(fmaxf(rintf(v[q].z * sc), -7.f), 7.f) + 8, n3 = (int)fminf(fmaxf(rintf(v[q].w * sc), -7.f), 7.f) + 8;
                *(unsigned short*)(dst + ((size_t)q * 16384 + e) * 128 + 2 * lane) = (unsigned short)(n0 | (n1 << 4) | (n2 << 8) | (n3 << 12));
            }
            if (lane == 0) rscale[e] = am * (1.f / 7.f);
        } else {
            float ssq = 0.f;
#pragma unroll
            for (int q = 0; q < 4; ++q) ssq += v[q].x * v[q].x + v[q].y * v[q].y + v[q].z * v[q].z + v[q].w * v[q].w;
            ssq = wave_sum(ssq);
            const float top = fminf(am, 2.8f * sqrtf(ssq * (1.f / 1024.f)));
            const float sc = top > 0.f ? 6.f / top : 0.f;
#pragma unroll
            for (int q = 0; q < 4; ++q) {
                const float x0 = fminf(fmaxf(v[q].x * sc, -6.f), 6.f), x1 = fminf(fmaxf(v[q].y * sc, -6.f), 6.f), x2 = fminf(fmaxf(v[q].z * sc, -6.f), 6.f), x3 = fminf(fmaxf(v[q].w * sc, -6.f), 6.f);
                unsigned w = __builtin_amdgcn_cvt_scalef32_pk_fp4_f32(0u, x0, x1, 1.0f, 0);
                w = __builtin_amdgcn_cvt_scalef32_pk_fp4_f32(w, x2, x3, 1.0f, 1);
                *(unsigned short*)(dst + ((size_t)q * 16384 + e) * 128 + 2 * lane) = (unsigned short)(w & 0xffffu);
            }
            if (lane == 0) rscale[e] = top * (1.f / 6.f);
        }
    }
}
DEV void p0_transpose_item(const float* W, int K, int N, bf16_t* Wt, int kt, int nt, LAS float* tile) {
    const int tid = tid_fresh(), k0 = kt * 64, n0 = nt * 256;
    f32x4 v[8];
#pragma unroll
    for (int p = 0; p < 8; ++p) {
        const int kk = p * 8 + (tid >> 6), nn = (tid & 63) * 4, n = n0 + nn;
        v[p] = (f32x4){0.f, 0.f, 0.f, 0.f};
        if (n < N) v[p] = __builtin_nontemporal_load((const f32x4*)(W + (size_t)(k0 + kk) * N + n));
    }
#pragma unroll
    for (int p = 0; p < 8; ++p) {
        const int kk = p * 8 + (tid >> 6), nn = (tid & 63) * 4;
        tile[kk * 257 + nn + 0] = v[p].x; tile[kk * 257 + nn + 1] = v[p].y; tile[kk * 257 + nn + 2] = v[p].z; tile[kk * 257 + nn + 3] = v[p].w;
    }
    __syncthreads();
#pragma unroll
    for (int q = 0; q < 4; ++q) {
        const int n = q * 64 + (tid >> 3), kc = (tid & 7) * 8;
        u32x4 o;
        o.x = pk2(tile[(kc + 0) * 257 + n], tile[(kc + 1) * 257 + n]);
        o.y = pk2(tile[(kc + 2) * 257 + n], tile[(kc + 3) * 257 + n]);
        o.z = pk2(tile[(kc + 4) * 257 + n], tile[(kc + 5) * 257 + n]);
        o.w = pk2(tile[(kc + 6) * 257 + n], tile[(kc + 7) * 257 + n]);
        *(u32x4*)(Wt + (size_t)(n0 + n) * K + k0 + kc) = o;
    }
    __syncthreads();
}
DEV void p0_mod_item(const Params& P, int i, int cb, LAS float* lds) {
    LAS float* s = lds;
    LAS float* red = lds + 9 * 1024;
    const int tid = tid_fresh();
    for (int e = tid; e < 9 * 1024; e += NTHREADS) {
        const int m = e >> 10, k = e & 1023;
        const float cv = m < 8 ? P.c[m * 1024 + k] : P.c_ctx[k];
        s[e] = silu(cv);
    }
    __syncthreads();
    const int cq = tid & 31, kg = tid >> 5;
    const float* W = P.mod_w + (size_t)i * 1024 * 6144 + cb * 128 + cq * 4;
    f32x4 acc[9];
#pragma unroll
    for (int m = 0; m < 9; ++m) acc[m] = (f32x4){0.f, 0.f, 0.f, 0.f};
#pragma unroll 16
    for (int kk = 0; kk < 64; ++kk) {
        const int k = kg * 64 + kk;
        const f32x4 w = __builtin_nontemporal_load((const f32x4*)(W + (size_t)k * 6144));
#pragma unroll
        for (int m = 0; m < 9; ++m) { const float sv = s[m * 1024 + k]; acc[m] += w * sv; }
    }
#pragma unroll
    for (int m = 0; m < 9; ++m) *(LAS f32x4*)&red[(kg * 9 + m) * 128 + cq * 4] = acc[m];
    __syncthreads();
    float* modv = (float*)(P.ws + OFF_MODV);
    for (int e = tid; e < 9 * 128; e += NTHREADS) {
        const int m = e >> 7, col = e & 127;
        float sum = 0.f;
#pragma unroll
        for (int g = 0; g < 16; ++g) sum += red[(g * 9 + m) * 128 + col];
        modv[(size_t)(i * 9 + m) * 6144 + cb * 128 + col] = sum + P.mod_b[i * 6144 + cb * 128 + col];
    }
    __syncthreads();
}
DEV void phase_prep(const Params& P, ldsp lds0) {
    constexpr int N_MOD = 96, N_WQ = 2 * 16 * 8, N_WIN = 16 * 17, N_WOUT = 16 * 4, N_POOL = 4 * 4;
    constexpr int N_TR = N_WQ + N_WIN + N_WOUT + N_POOL, N_TAB = 4 * 128, N_KEYS = 16;
    constexpr int TOTAL = N_MOD + N_TR + N_TAB + N_KEYS;
    for (int item = blockIdx.x; item < TOTAL; item += gridDim.x) {
        LAS float* lds = (LAS float*)launder(lds0);
        int r = item;
        if (r < N_MOD) { p0_mod_item(P, r / 48, r % 48, lds); continue; }
        r -= N_MOD;
        if (r < N_WQ) { const int i = r / 128, t = r % 128;
            p0_transpose_item(P.peer_wq + (size_t)i * 1024 * 2048, 1024, 2048, (bf16_t*)(P.ws + OFF_WQT) + (size_t)i * 2048 * 1024, t / 8, t % 8, lds); continue; }
        r -= N_WQ;
        if (r < N_WIN) { p0_transpose_item(P.dn_w_in, 1024, 4128, (bf16_t*)(P.ws + OFF_WINT), r / 17, r % 17, lds); continue; }
        r -= N_WIN;
        if (r < N_WOUT) { p0_transpose_item(P.dn_w_out, 1024, 1024, (bf16_t*)(P.ws + OFF_WOUTT), r / 4, r % 4, lds); continue; }
        r -= N_WOUT;
        if (r < N_POOL) { const int g = r / 4, t = r % 4;
            p0_transpose_item(P.pool_w + (size_t)g * 65536, 256, 256, (bf16_t*)(P.ws + OFF_POOLT) + (size_t)g * 65536, t, 0, lds); continue; }
        r -= N_POOL;
        if (r < N_TAB) { const int tb = r / 128, ch = r % 128;
            const float* src = ((tb & 1) ? P.peer_v : P.peer_u) + (size_t)(tb >> 1) * TAB_ELEMS;
            p0_table_item(src, P.ws + OFF_TAB + (size_t)tb * 16 * MiB, (float*)(P.ws + OFF_RSC) + tb * 16384, ch * 128, (tb & 1) == 0); continue; }
        r -= N_TAB;
        p0_convert_item(P.peer_keys, (bf16_t*)(P.ws + OFF_KEYS), (size_t)r * 32768);
    }
}

template <int SRC>
DEV void phase_modulate(const Params& P, int layer, int which, int nrows, bool q8 = false) {
    const float* gain = (which ? P.norm2_g : P.norm1_g) + layer * 1024;
    const float* modv = (const float*)(P.ws + OFF_MODV) + (size_t)layer * 9 * 6144;
    bf16_t* A = (bf16_t*)(P.ws + OFF_A);
    const int tid = tid_fresh(); const int wave = tid >> 6, lane = tid & 63;
    for (int r = blockIdx.x * 8 + wave; r < nrows; r += gridDim.x * 8) {
        const int m = r < NX ? (r >> 11) : 8;
        const float* sh = modv + m * 6144 + which * 3072;
        const float* sc = sh + 1024;
        f32x4 v[4]; float ss = 0.f;
#pragma unroll
        for (int j = 0; j < 4; ++j) {
            if (SRC == 0) { const float* src = r < NX ? P.x + (size_t)r * 1024 : P.ctx + (size_t)(r - NX) * 1024; v[j] = *(const f32x4*)(src + j * 256 + lane * 4); }
            else { const u32x2 hv = *(const u32x2*)(hrow(P, r) + j * 256 + lane * 4); v[j] = (f32x4){bflo(hv.x), bfhi(hv.x), bflo(hv.y), bfhi(hv.y)}; }
            ss += v[j].x * v[j].x + v[j].y * v[j].y + v[j].z * v[j].z + v[j].w * v[j].w;
        }
        ss = wave_sum(ss);
        const float rstd = rsqrtf(ss * (1.f / 1024.f) + EPS);
#pragma unroll
        for (int j = 0; j < 4; ++j) {
            const int col = j * 256 + lane * 4;
            const f32x4 g = *(const f32x4*)(gain + col), s1 = *(const f32x4*)(sc + col), s0 = *(const f32x4*)(sh + col);
            const f32x4 y = v[j] * rstd * g * (1.f + s1) + s0;
            u32x2 o; o.x = pk2(y.x, y.y); o.y = pk2(y.z, y.w);
            *(u32x2*)(A + (size_t)r * 1024 + col) = o;
            v[j] = y;
        }
        if (q8) {
            float am = 0.f;
#pragma unroll
            for (int j = 0; j < 4; ++j) am = fmaxf(am, fmaxf(fmaxf(fabsf(v[j].x), fabsf(v[j].y)), fmaxf(fabsf(v[j].z), fabsf(v[j].w))));
            am = wave_max(am);
            const float sc = am > 0.f ? 127.f / am : 0.f;
            unsigned char* a8 = P.ws + OFF_A8 + (size_t)r * 1024;
#pragma unroll
            for (int j = 0; j < 4; ++j) {
                const int b0 = (int)rintf(v[j].x * sc), b1 = (int)rintf(v[j].y * sc), b2 = (int)rintf(v[j].z * sc), b3 = (int)rintf(v[j].w * sc);
                const unsigned mine = (unsigned)((b0 & 255) | ((b1 & 255) << 8) | ((b2 & 255) << 16) | ((b3 & 255) << 24));
                const unsigned other = (unsigned)__shfl_xor((int)mine, 1);
                const unsigned lo4 = (lane & 1) ? other : mine, hi4 = (lane & 1) ? mine : other;
                const unsigned outw = (lane & 1) ? __builtin_amdgcn_perm(hi4, lo4, 0x07050301u) : __builtin_amdgcn_perm(hi4, lo4, 0x06040200u);
                *(unsigned*)(a8 + j * 256 + lane * 4) = outw;
            }
            if (lane == 0) ((float*)(P.ws + OFF_XS))[r] = am * (1.f / 127.f);
        }
    }
}

DEV void unpack8(const u32x4 v, float* f) {
    f[0] = bflo(v.x); f[1] = bfhi(v.x); f[2] = bflo(v.y); f[3] = bfhi(v.y); f[4] = bflo(v.z); f[5] = bfhi(v.z); f[6] = bflo(v.w); f[7] = bfhi(v.w);
}
template <int W>
DEV void pool_vertical(const bf16_t* A0, LAS float* V, int b, int r, int cbase, int tq, int ch8, float (&cen)[4][8]) {
    const int rlo = max(0, r - W / 2), rhi = min(32, r - W / 2 + W);
    const float inv = 1.f / (float)(rhi - rlo);
#pragma unroll
    for (int jh = 0; jh < 2; ++jh) {
        u32x4 ld[2][W];
#pragma unroll
        for (int jj = 0; jj < 2; ++jj)
#pragma unroll
            for (int k = 0; k < W; ++k) {
                const int rr = min(rlo + k, 31), tok = tq + 16 * (2 * jh + jj);
                ld[jj][k] = *(const u32x4*)(A0 + ((size_t)b * 2048 + rr * 64 + tok) * 1024 + cbase);
            }
#pragma unroll
        for (int jj = 0; jj < 2; ++jj) {
            const int j = 2 * jh + jj, tok = tq + 16 * j;
            float acc[8];
#pragma unroll
            for (int e = 0; e < 8; ++e) acc[e] = 0.f;
#pragma unroll
            for (int k = 0; k < W; ++k) {
                float f[8]; unpack8(ld[jj][k], f);
                const bool in = rlo + k < rhi;
#pragma unroll
                for (int e = 0; e < 8; ++e) acc[e] += in ? f[e] : 0.f;
                if (rlo + k == r) {
#pragma unroll
                    for (int e = 0; e < 8; ++e) cen[j][e] = f[e];
                }
            }
            LAS float* vp = V + (tok + 8) * 260 + ch8 * 8;
            *(LAS f32x4*)vp = (f32x4){acc[0] * inv, acc[1] * inv, acc[2] * inv, acc[3] * inv};
            *(LAS f32x4*)(vp + 4) = (f32x4){acc[4] * inv, acc[5] * inv, acc[6] * inv, acc[7] * inv};
        }
    }
}
template <int W>
DEV void pool_horizontal(const LAS float* V, ldsp At, bool isx, int seg, int tq, int ch8, const float (&cen)[4][8]) {
#pragma unroll
    for (int j = 0; j < 4; ++j) {
        const int tok = tq + 16 * j;
        const int pos = isx ? tok : 64 * seg + tok, lim = isx ? 64 : 256, off = isx ? 8 : 8 - 64 * seg;
        const int lo = max(0, pos - W / 2), hi = min(lim, pos - W / 2 + W);
        f32x4 s0 = {0.f, 0.f, 0.f, 0.f}, s1 = {0.f, 0.f, 0.f, 0.f};
#pragma unroll
        for (int k = 0; k < W; ++k) {
            const int t = min(lo + k, lim - 1);
            const LAS float* vp = V + (t + off) * 260 + ch8 * 8;
            const f32x4 a = *(const LAS f32x4*)vp, b2 = *(const LAS f32x4*)(vp + 4);
            const float m = (lo + k < hi) ? 1.f : 0.f;
            s0 += a * m; s1 += b2 * m;
        }
        const float inv = 1.f / (float)(hi - lo);
        u32x4 o;
        o.x = pk2(s0.x * inv - cen[j][0], s0.y * inv - cen[j][1]);
        o.y = pk2(s0.z * inv - cen[j][2], s0.w * inv - cen[j][3]);
        o.z = pk2(s1.x * inv - cen[j][4], s1.y * inv - cen[j][5]);
        o.w = pk2(s1.z * inv - cen[j][6], s1.w * inv - cen[j][7]);
        *(LAS u32x4*)(At + tok * 512 + ((ch8 ^ (tok & 7)) << 4)) = o;
    }
}
DEV void phase_pool(const Params& P, ldsp lds0) {
    const bf16_t* A0 = (const bf16_t*)(P.ws + OFF_A);
    const float* modv = (const float*)(P.ws + OFF_MODV);
    const bf16_t* Wt = (const bf16_t*)(P.ws + OFF_POOLT);
    const int tid = tid_fresh(), lane = tid & 63, wave = tid >> 6;
    const int ch8 = tid & 31, tq = tid >> 5;
    for (int item = blockIdx.x; item < 1152; item += gridDim.x) {
        const ldsp lds = launder(lds0);
        LAS float* V = (LAS float*)lds;
        const ldsp At = lds + 80 * 260 * 4;
        const bool isx = item < 1024;
        int b, r = 0, seg = 0, g;
        if (isx) { b = item >> 7; r = (item >> 2) & 31; }
        else { const int it = item - 1024; b = it >> 4; seg = (it >> 2) & 3; }
        g = ((item & 3) + (item >> 8)) & 3;
        const int cbase = g * 256 + ch8 * 8;
        float cen[4][8];
        if (isx) {
            if (g == 0) pool_vertical<2>(A0, V, b, r, cbase, tq, ch8, cen);
            else if (g == 1) pool_vertical<4>(A0, V, b, r, cbase, tq, ch8, cen);
            else if (g == 2) pool_vertical<8>(A0, V, b, r, cbase, tq, ch8, cen);
            else pool_vertical<16>(A0, V, b, r, cbase, tq, ch8, cen);
        } else {
            for (int q = tq; q < 80; q += 16) {
                const int t = 64 * seg - 8 + q;
                if (t >= 0 && t < 256) {
                    const u32x4 pv = *(const u32x4*)(A0 + ((size_t)NX + b * 256 + t) * 1024 + cbase);
                    float f[8]; unpack8(pv, f);
                    LAS float* vp = V + q * 260 + ch8 * 8;
                    *(LAS f32x4*)vp = (f32x4){f[0], f[1], f[2], f[3]};
                    *(LAS f32x4*)(vp + 4) = (f32x4){f[4], f[5], f[6], f[7]};
                }
            }
#pragma unroll
            for (int j = 0; j < 4; ++j) {
                const int tok = tq + 16 * j;
                const u32x4 pv = *(const u32x4*)(A0 + ((size_t)NX + b * 256 + 64 * seg + tok) * 1024 + cbase);
                unpack8(pv, cen[j]);
            }
        }
        __syncthreads();
        if (g == 0) pool_horizontal<2>(V, At, isx, seg, tq, ch8, cen);
        else if (g == 1) pool_horizontal<4>(V, At, isx, seg, tq, ch8, cen);
        else if (g == 2) pool_horizontal<8>(V, At, isx, seg, tq, ch8, cen);
        else pool_horizontal<16>(V, At, isx, seg, tq, ch8, cen);
        __syncthreads();
        f32x16 acc[2]; acc[0] = zero16(); acc[1] = zero16();
        const bf16_t* Wg = Wt + (size_t)g * 65536 + (size_t)(32 * wave + (lane & 31)) * 256 + (lane >> 5) * 8;
#pragma unroll 4
        for (int ks = 0; ks < 16; ++ks) {
            const bf16x8 wfr = *(const bf16x8*)(Wg + ks * 16);
            const int ch = ks * 2 + (lane >> 5);
#pragma unroll
            for (int mt = 0; mt < 2; ++mt) {
                const int row = mt * 32 + (lane & 31);
                const bf16x8 a = *(const LAS bf16x8*)(At + row * 512 + ((ch ^ (row & 7)) << 4));
                acc[mt] = mfma32(wfr, a, acc[mt]);
            }
        }
        const int m = isx ? b : 8;
#pragma unroll
        for (int mt = 0; mt < 2; ++mt)
#pragma unroll
            for (int rg = 0; rg < 4; ++rg) {
                const int tok = mt * 32 + (lane & 31), col = g * 256 + 32 * wave + 8 * rg + 4 * (lane >> 5);
                const f32x4 gs = *(const f32x4*)(modv + m * 6144 + 2048 + col) * *(const f32x4*)(P.pool_scale + col);
                const f32x4 av = {acc[mt][rg * 4 + 0], acc[mt][rg * 4 + 1], acc[mt][rg * 4 + 2], acc[mt][rg * 4 + 3]};
                f32x4 hv; int grow;
                if (isx) { grow = b * 2048 + r * 64 + tok; hv = __builtin_nontemporal_load((const f32x4*)(P.x + (size_t)grow * 1024 + col)) + gs * av; }
                else { const size_t gi = ((size_t)b * 256 + 64 * seg + tok) * 1024 + col; grow = NX + b * 256 + 64 * seg + tok; hv = *(const f32x4*)(P.ctx + gi) + gs * av; }
                u32x2 hp; hp.x = pk2(hv.x, hv.y); hp.y = pk2(hv.z, hv.w);
                *(u32x2*)(hrow(P, grow) + col) = hp;
            }
        __syncthreads();
    }
}

DEV bf16x8 frag_row_x(ldsp x, int r0, int k0, int lane) {
    const int row = r0 + (lane & 31), ch = (k0 >> 3) + (lane >> 5);
    return *(const LAS bf16x8*)(x + row * 256 + ((ch ^ (row & 15)) << 4));
}
DEV unsigned key_of(float f) { const unsigned u = __float_as_uint(f); return u ^ ((unsigned)((int)u >> 31) | 0x80000000u); }
DEV float val_of(unsigned k) { const unsigned u = (k & 0x80000000u) ? (k ^ 0x80000000u) : ~k; return __uint_as_float(u); }
DEV void cmpx(unsigned& hi, unsigned& lo) { const unsigned a = hi, b = lo; hi = a > b ? a : b; lo = a > b ? b : a; }
DEV void sort16_desc(unsigned* v) {
#pragma unroll
    for (int k = 2; k <= 16; k <<= 1)
#pragma unroll
        for (int j = k >> 1; j > 0; j >>= 1)
#pragma unroll
            for (int i = 0; i < 16; ++i) {
                const int l = i ^ j;
                if (l > i) { if ((i & k) == 0) cmpx(v[i], v[l]); else cmpx(v[l], v[i]); }
            }
}
DEV void merge16(unsigned* r, const unsigned* b) {
#pragma unroll
    for (int k = 0; k < 16; ++k) r[k] = r[k] > b[15 - k] ? r[k] : b[15 - k];
#pragma unroll
    for (int j = 8; j > 0; j >>= 1)
#pragma unroll
        for (int i = 0; i < 16; ++i) { const int l = i ^ j; if (l > i) cmpx(r[i], r[l]); }
}
DEV void top16_of_64(unsigned* v, unsigned* r) {
#pragma unroll
    for (int blk = 0; blk < 4; ++blk) sort16_desc(v + 16 * blk);
#pragma unroll
    for (int k = 0; k < 16; ++k) r[k] = v[k];
    merge16(r, v + 16); merge16(r, v + 32); merge16(r, v + 48);
}
DEV void phase_topk(const Params& P, int layer, int nrows, ldsp lds0) {
    const bf16_t* Q = (const bf16_t*)(P.ws + OFF_R1);
    const bf16_t* keys = (const bf16_t*)(P.ws + OFF_KEYS) + (size_t)layer * 8 * 2 * 128 * 128;
    bf16_t* seli = (bf16_t*)(P.ws + OFF_SELI);
    float* selg = (float*)(P.ws + OFF_SELG);
    const int tid = tid_fresh(), lane = tid & 63, wave = tid >> 6;
    const int nitems = (nrows / 256) * 4;
    const unsigned hoff = (unsigned)(lane >> 5) * 4u;
    for (int item = blockIdx.x; item < nitems; item += gridDim.x) {
        const ldsp lds = launder(lds0);
        LAS unsigned* sl = (LAS unsigned*)(lds + 65536 + wave * 8192);
        const int tg = item >> 2, hp = item & 3, row0 = tg * 256 + wave * 32;
        u32x4 kr[4]; bf16x8 qf[8];
        {
            const bf16_t* kt = keys + (size_t)((hp * 2) * 2) * 128 * 128;
#pragma unroll
            for (int j = 0; j < 4; ++j) { const int cid = tid + NTHREADS * j, r = cid >> 4, ch = cid & 15; kr[j] = *(const u32x4*)(kt + r * 128 + ch * 8); }
#pragma unroll
            for (int j = 0; j < 4; ++j) { const int cid = tid + NTHREADS * j, r = cid >> 4, ch = cid & 15; *(LAS u32x4*)(lds + r * 256 + ((ch ^ (r & 15)) << 4)) = kr[j]; }
            const bf16_t* qb = Q + (size_t)(row0 + (lane & 31)) * 2048 + (hp * 2) * 256 + (lane >> 5) * 8;
#pragma unroll
            for (int ks = 0; ks < 8; ++ks) qf[ks] = *(const bf16x8*)(qb + ks * 16);
        }
        __syncthreads();
        unsigned s1[16], s2[16];
#pragma unroll
        for (int k = 0; k < 16; ++k) { s1[k] = 0u; s2[k] = 0u; }
#pragma unroll 1
        for (int step = 0; step < 4; ++step) {
            const int hs = step >> 1, p = step & 1;
            const bool mine = (lane >> 5) == hs;
            const ldsp kb = lds + (step & 1) * 32768;
            if (step < 3) {
                const bf16_t* kt = keys + (size_t)((hp * 2 + ((step + 1) >> 1)) * 2 + ((step + 1) & 1)) * 128 * 128;
#pragma unroll
                for (int j = 0; j < 4; ++j) { const int cid = tid + NTHREADS * j, r = cid >> 4, ch = cid & 15; kr[j] = *(const u32x4*)(kt + r * 128 + ch * 8); }
            }
            f32x16 acc[4];
#pragma unroll
            for (int mt = 0; mt < 4; ++mt) acc[mt] = zero16();
#pragma unroll
            for (int ks = 0; ks < 8; ++ks)
#pragma unroll
                for (int mt = 0; mt < 4; ++mt) acc[mt] = mfma32(frag_row_x(kb, mt * 32, ks * 16, lane), qf[ks], acc[mt]);
            if (step < 3) {
                const ldsp kn = lds + ((step + 1) & 1) * 32768;
#pragma unroll
                for (int j = 0; j < 4; ++j) { const int cid = tid + NTHREADS * j, r = cid >> 4, ch = cid & 15; *(LAS u32x4*)(kn + r * 256 + ((ch ^ (r & 15)) << 4)) = kr[j]; }
                const bf16_t* qb = Q + (size_t)(row0 + (lane & 31)) * 2048 + (hp * 2 + ((step + 1) >> 1)) * 256 + ((step + 1) & 1) * 128 + (lane >> 5) * 8;
#pragma unroll
                for (int ks = 0; ks < 8; ++ks) qf[ks] = *(const bf16x8*)(qb + ks * 16);
            }
            unsigned v[64];
#pragma unroll
            for (int mt = 0; mt < 4; ++mt)
#pragma unroll
                for (int reg = 0; reg < 16; ++reg) {
                    const unsigned c = mt * 32 + (reg & 3) + 8 * (reg >> 2);
                    v[mt * 16 + reg] = ((key_of(acc[mt][reg]) & ~127u) | (127u - c)) ^ hoff;
                }
            unsigned r[16], o[16];
            top16_of_64(v, r);
#pragma unroll
            for (int k = 0; k < 16; ++k) o[k] = (unsigned)__shfl_xor((int)r[k], 32);
            merge16(r, o);
#pragma unroll
            for (int k = 0; k < 16; ++k) { if (p == 0) s1[k] = mine ? r[k] : s1[k]; else s2[k] = mine ? r[k] : s2[k]; }
            __syncthreads();
        }
        float f1[16], f2[16];
#pragma unroll
        for (int k = 0; k < 16; ++k) {
            sl[k * 64 + lane] = s1[k]; sl[(16 + k) * 64 + lane] = s2[k];
            f1[k] = val_of(s1[k] & ~127u); f2[k] = val_of(s2[k] & ~127u);
        }
        unsigned cv[64];
        {
            int n = 0;
#pragma unroll
            for (int a = 0; a < 16; ++a)
#pragma unroll
                for (int b = 0; b < 16; ++b)
                    if ((a + 1) * (b + 1) <= 16) { cv[n] = (key_of(f1[a] + f2[b]) & ~255u) | (255u - (unsigned)(a * 16 + b)); ++n; }
#pragma unroll
            for (int q = 50; q < 64; ++q) cv[q] = 0u;
        }
        unsigned w[16];
        top16_of_64(cv, w);
        float sc[16]; int ei[16];
#pragma unroll
        for (int k = 0; k < 16; ++k) {
            const unsigned ab = 255u - (w[k] & 255u);
            const unsigned k1 = sl[(ab >> 4) * 64 + lane], k2 = sl[(16 + (ab & 15u)) * 64 + lane];
            ei[k] = (int)((127u - (k1 & 127u)) * 128u + (127u - (k2 & 127u)));
            sc[k] = val_of(w[k] & ~255u);
        }
        const float mx = sc[0];
        float tot = 0.f;
#pragma unroll
        for (int k = 0; k < 16; ++k) { sc[k] = expf(sc[k] - mx); tot += sc[k]; }
        const int row = row0 + (lane & 31), head = hp * 2 + (lane >> 5);
        bf16_t* ip = seli + (size_t)row * 128 + head * 16;
        float* gp = selg + (size_t)row * 128 + head * 16;
        const float inv = 1.f / tot;
#pragma unroll
        for (int q = 0; q < 2; ++q) {
            u32x4 o;
#pragma unroll
            for (int d = 0; d < 4; ++d) o[d] = (unsigned)ei[8 * q + 2 * d] | ((unsigned)ei[8 * q + 2 * d + 1] << 16);
            *(u32x4*)(ip + 8 * q) = o;
        }
#pragma unroll
        for (int q = 0; q < 4; ++q) *(float4*)(gp + 4 * q) = make_float4(sc[4 * q] * inv, sc[4 * q + 1] * inv, sc[4 * q + 2] * inv, sc[4 * q + 3] * inv);
    }
}

struct XGeo { int nloc, rank, nact, pos; };
typedef float f32x2 __attribute__((ext_vector_type(2)));
DEV void fp8x16_to_f32(const u32x4 r, float* f) {
#pragma unroll
    for (int d = 0; d < 4; ++d) {
        const f32x2 lo = __builtin_amdgcn_cvt_pk_f32_fp8((int)r[d], false), hi = __builtin_amdgcn_cvt_pk_f32_fp8((int)r[d], true);
        f[4 * d + 0] = lo.x; f[4 * d + 1] = lo.y; f[4 * d + 2] = hi.x; f[4 * d + 3] = hi.y;
    }
}
template <int S, int MUL, class T>
DEV void bfly_stage(T* p, int lane) {
    const bool hi = (lane & (S * MUL)) != 0;
#pragma unroll
    for (int i = 0; i < 2 * S; ++i) { const T keep = hi ? p[i + 2 * S] : p[i], send = hi ? p[i] : p[i + 2 * S]; p[i] = keep + __shfl_xor(send, S * MUL); }
}
template <int STAGE>
DEV void ex_issue(u32x4 (&buf)[16], u32x4 (&aux)[4], f32x2 (&hg)[2], const u32x4 (&idn)[2], const unsigned char* slice, const Params& P, const bf16_t* A, const bf16_t* wexp,
                  const float* gatev, int t, int sl, int g, int c) {
    int id[16];
#pragma unroll
    for (int q = 0; q < 2; ++q)
#pragma unroll
        for (int d = 0; d < 4; ++d) { id[8 * q + 2 * d] = (int)(idn[q][d] & 0xffffu); id[8 * q + 2 * d + 1] = (int)(idn[q][d] >> 16); }
#pragma unroll
    for (int k = 0; k < 16; ++k) buf[k] = *(const u32x4*)(slice + (size_t)id[k] * 128);
    if (STAGE == 1) {
        aux[0] = *(const u32x4*)(P.ws + OFF_A8 + (size_t)t * 1024 + 256 * sl + 32 * c); aux[1] = *(const u32x4*)(P.ws + OFF_A8 + (size_t)t * 1024 + 256 * sl + 32 * c + 16);
        hg[0].x = ((const float*)(P.ws + OFF_XS))[t];
    } else {
#pragma unroll
        for (int q = 0; q < 2; ++q) aux[q] = *(const u32x4*)(wexp + (size_t)t * 128 + 16 * g + 8 * q);
        const int col = 256 * sl + 32 * c + 4 * g, m = t < NX ? (t >> 11) : 8;
        const u32x2 hv = *(const u32x2*)(hrow(P, t) + col);
        aux[2] = (u32x4){hv.x, hv.y, 0u, 0u};
        aux[3] = *(const u32x4*)(gatev + m * 6144 + col);
    }
}
template <int STAGE>
DEV void ex_compute(const u32x4 (&buf)[16], const u32x4 (&aux)[4], const f32x2 (&hg)[2], const Params& P, float* part, int t, int sl, int lane, int g, int c) {
    if (STAGE == 1) {
        int sx = 0;
#pragma unroll
        for (int q = 0; q < 2; ++q)
#pragma unroll
            for (int d = 0; d < 4; ++d) sx = __builtin_amdgcn_sdot4(0x01010101, (int)aux[q][d], sx, false);
        int p[16];
#pragma unroll
        for (int k = 0; k < 16; ++k) {
            int a = -8 * sx;
#pragma unroll
            for (int d = 0; d < 4; ++d) {
                const unsigned w = buf[k][d];
                a = __builtin_amdgcn_sdot4((int)(w & 0x0F0F0F0Fu), (int)aux[d >> 1][2 * (d & 1)], a, false);
                a = __builtin_amdgcn_sdot4((int)((w >> 4) & 0x0F0F0F0Fu), (int)aux[d >> 1][2 * (d & 1) + 1], a, false);
            }
            p[k] = a;
        }
        bfly_stage<4, 1>(p, lane); bfly_stage<2, 1>(p, lane); bfly_stage<1, 1>(p, lane);
        const float xs = hg[0].x;
        *(unsigned*)((bf16_t*)part + ((size_t)sl * NT + t) * 128 + 2 * lane) = pk2((float)p[0] * xs, (float)p[1] * xs);
    } else {
        f32x2 p2[16];
#pragma unroll
        for (int i = 0; i < 16; ++i) p2[i] = (f32x2){0.f, 0.f};
#pragma unroll
        for (int k = 0; k < 16; ++k) {
            const unsigned wpk = aux[k >> 3][(k >> 1) & 3];
            const float wkf = (k & 1) ? bfhi(wpk) : bflo(wpk);
            const f32x2 w2 = {wkf, wkf};
#pragma unroll
            for (int d = 0; d < 4; ++d) {
                p2[4 * d + 0] += w2 * __builtin_amdgcn_cvt_scalef32_pk_f32_fp4(buf[k][d], 1.0f, 0);
                p2[4 * d + 1] += w2 * __builtin_amdgcn_cvt_scalef32_pk_f32_fp4(buf[k][d], 1.0f, 1);
                p2[4 * d + 2] += w2 * __builtin_amdgcn_cvt_scalef32_pk_f32_fp4(buf[k][d], 1.0f, 2);
                p2[4 * d + 3] += w2 * __builtin_amdgcn_cvt_scalef32_pk_f32_fp4(buf[k][d], 1.0f, 3);
            }
            asm volatile("" : "+v"(p2[0]), "+v"(p2[1]), "+v"(p2[2]), "+v"(p2[3]), "+v"(p2[4]), "+v"(p2[5]), "+v"(p2[6]), "+v"(p2[7]),
                              "+v"(p2[8]), "+v"(p2[9]), "+v"(p2[10]), "+v"(p2[11]), "+v"(p2[12]), "+v"(p2[13]), "+v"(p2[14]), "+v"(p2[15]));
        }
        float p[32];
#pragma unroll
        for (int i = 0; i < 16; ++i) { p[2 * i] = p2[i].x; p[2 * i + 1] = p2[i].y; }
        bfly_stage<8, 4>(p, lane); bfly_stage<4, 4>(p, lane); bfly_stage<2, 4>(p, lane);
        const int col = 256 * sl + 32 * c + 4 * g;
        const unsigned h0 = aux[2].x, h1 = aux[2].y;
        u32x2 ho;
        ho.x = pk2(bflo(h0) + __uint_as_float(aux[3].x) * p[0], bfhi(h0) + __uint_as_float(aux[3].y) * p[1]);
        ho.y = pk2(bflo(h1) + __uint_as_float(aux[3].z) * p[2], bfhi(h1) + __uint_as_float(aux[3].w) * p[3]);
        *(u32x2*)(hrow(P, t) + col) = ho;
    }
}
template <int STAGE>
DEV void phase_experts_sliced(const Params& P, int layer, int nrows, const XGeo geo) {
    const unsigned char* tab = P.ws + OFF_TAB + (size_t)(layer * 2 + (STAGE - 1)) * 16 * MiB;
    const bf16_t* A = (const bf16_t*)(P.ws + OFF_A);
    const bf16_t* seli = (const bf16_t*)(P.ws + OFF_SELI);
    float* part = (float*)(P.ws + OFF_PART);
    const bf16_t* wexp = (const bf16_t*)(P.ws + OFF_WEXP);
    const float* gatev = (const float*)(P.ws + OFF_MODV) + (size_t)layer * 9 * 6144 + 5 * 1024;
    const int tid = tid_fresh(), wave = tid >> 6, lane = tid & 63, g = lane >> 3, c = lane & 7;
    const int nw = geo.nloc * 8, wr = geo.rank * 8 + wave;
    for (int vs = geo.pos; vs < 8; vs += geo.nact) {
        const int sl = vs >> 1, tmul = 2, tadd = vs & 1;
        const unsigned char* slice = tab + (size_t)sl * 2 * MiB + 16 * c;
        const int nws = nw * tmul;
        int t = wr * tmul + tadd;
        if (t >= nrows) continue;
        u32x4 bufA[16], bufB[16], auxA[4], auxB[4]; f32x2 hgA[2], hgB[2]; u32x4 idn[2];
#pragma unroll
        for (int q = 0; q < 2; ++q) idn[q] = *(const u32x4*)(seli + (size_t)t * 128 + 16 * g + 8 * q);
        ex_issue<STAGE>(bufA, auxA, hgA, idn, slice, P, A, wexp, gatev, t, sl, g, c);
        if (t + nws < nrows) {
#pragma unroll
            for (int q = 0; q < 2; ++q) idn[q] = *(const u32x4*)(seli + (size_t)(t + nws) * 128 + 16 * g + 8 * q);
        }
        for (;;) {
            {
                const int t1 = t + nws;
                if (t1 < nrows) {
                    ex_issue<STAGE>(bufB, auxB, hgB, idn, slice, P, A, wexp, gatev, t1, sl, g, c);
                    if (t1 + nws < nrows) {
#pragma unroll
                        for (int q = 0; q < 2; ++q) idn[q] = *(const u32x4*)(seli + (size_t)(t1 + nws) * 128 + 16 * g + 8 * q);
                    }
                }
                ex_compute<STAGE>(bufA, auxA, hgA, P, part, t, sl, lane, g, c);
            }
            t += nws; if (t >= nrows) break;
            {
                const int t1 = t + nws;
                if (t1 < nrows) {
                    ex_issue<STAGE>(bufA, auxA, hgA, idn, slice, P, A, wexp, gatev, t1, sl, g, c);
                    if (t1 + nws < nrows) {
#pragma unroll
                        for (int q = 0; q < 2; ++q) idn[q] = *(const u32x4*)(seli + (size_t)(t1 + nws) * 128 + 16 * g + 8 * q);
                    }
                }
                ex_compute<STAGE>(bufB, auxB, hgB, P, part, t, sl, lane, g, c);
            }
            t += nws; if (t >= nrows) break;
        }
    }
}
DEV void eu_issue_unit(u32x4 (&buf)[16], u32x4 (&xq)[2], const u32x4 (&idn)[2], const unsigned char* tab, const Params& P, int t, int sl, int c) {
    int id[16];
#pragma unroll
    for (int q = 0; q < 2; ++q)
#pragma unroll
        for (int d = 0; d < 4; ++d) { id[8 * q + 2 * d] = (int)(idn[q][d] & 0xffffu); id[8 * q + 2 * d + 1] = (int)(idn[q][d] >> 16); }
    const unsigned char* slice = tab + (size_t)sl * 2 * MiB + 16 * c;
#pragma unroll
    for (int k = 0; k < 16; ++k) buf[k] = *(const u32x4*)(slice + (size_t)id[k] * 128);
    xq[0] = *(const u32x4*)(P.ws + OFF_A8 + (size_t)t * 1024 + 256 * sl + 32 * c); xq[1] = *(const u32x4*)(P.ws + OFF_A8 + (size_t)t * 1024 + 256 * sl + 32 * c + 16);
}
DEV void eu_compute_unit(const u32x4 (&buf)[16], const u32x4 (&xq)[2], LAS float* acc2, int lane) {
    int sx = 0;
#pragma unroll
    for (int q = 0; q < 2; ++q)
#pragma unroll
        for (int d = 0; d < 4; ++d) sx = __builtin_amdgcn_sdot4(0x01010101, (int)xq[q][d], sx, false);
    int p[16];
#pragma unroll
    for (int k = 0; k < 16; ++k) {
        int a = -8 * sx;
#pragma unroll
        for (int d = 0; d < 4; ++d) {
            const unsigned w = buf[k][d];
            a = __builtin_amdgcn_sdot4((int)(w & 0x0F0F0F0Fu), (int)xq[d >> 1][2 * (d & 1)], a, false);
            a = __builtin_amdgcn_sdot4((int)((w >> 4) & 0x0F0F0F0Fu), (int)xq[d >> 1][2 * (d & 1) + 1], a, false);
        }
        p[k] = a;
    }
    bfly_stage<4, 1>(p, lane); bfly_stage<2, 1>(p, lane); bfly_stage<1, 1>(p, lane);
    f32x2 a2 = *(const LAS f32x2*)acc2;
    a2.x += (float)p[0]; a2.y += (float)p[1];
    *(LAS f32x2*)acc2 = a2;
}
DEV void phase_experts_u(const Params& P, int layer, int nrows, ldsp lds0) {
    const unsigned char* tab = P.ws + OFF_TAB + (size_t)(layer * 2) * 16 * MiB;
    const bf16_t* seli = (const bf16_t*)(P.ws + OFF_SELI);
    const float* selg = (const float*)(P.ws + OFF_SELG);
    bf16_t* wexp = (bf16_t*)(P.ws + OFF_WEXP);
    const float* rsu = (const float*)(P.ws + OFF_RSC) + (size_t)(layer * 2) * 16384;
    const float* rsv = rsu + 16384;
    const float* xsv = (const float*)(P.ws + OFF_XS);
    const int tid = tid_fresh(), wave = __builtin_amdgcn_readfirstlane(tid >> 6), lane = tid & 63, g = lane >> 3, c = lane & 7;
    const int gw = blockIdx.x * 8 + wave, nwv = gridDim.x * 8;
    if (gw >= nrows) return;
    const int ntok = (nrows - gw + nwv - 1) / nwv, U = 4 * ntok;
    LAS float* accs = (LAS float*)(launder(lds0) + wave * 8192);
    for (int k = 0; k < ntok; ++k) *(LAS f32x2*)(accs + k * 128 + 2 * lane) = (f32x2){0.f, 0.f};
    u32x4 bufA[16], bufB[16], xqA[2], xqB[2], idn[2];
    int ku = 0, slu = 0;
#define EU_NEXT_IDX() do { const int tt = gw + ku * nwv; _Pragma("unroll") for (int q = 0; q < 2; ++q) idn[q] = *(const u32x4*)(seli + (size_t)tt * 128 + 16 * g + 8 * q); } while (0)
#define EU_ADVANCE() do { if (++ku == ntok) { ku = 0; ++slu; } } while (0)
    EU_NEXT_IDX();
    int kA = ku, slA = slu; eu_issue_unit(bufA, xqA, idn, tab, P, gw + kA * nwv, slA, c); EU_ADVANCE();
    if (U > 1) EU_NEXT_IDX();
    int kB = 0, slB = 0;
    for (int u = 0; u < U; u += 2) {
        if (u + 1 < U) { kB = ku; slB = slu; eu_issue_unit(bufB, xqB, idn, tab, P, gw + kB * nwv, slB, c); EU_ADVANCE(); if (u + 2 < U) EU_NEXT_IDX(); }
        eu_compute_unit(bufA, xqA, accs + kA * 128 + 2 * lane, lane);
        if (u + 1 >= U) break;
        if (u + 2 < U) { kA = ku; slA = slu; eu_issue_unit(bufA, xqA, idn, tab, P, gw + kA * nwv, slA, c); EU_ADVANCE(); if (u + 3 < U) EU_NEXT_IDX(); }
        eu_compute_unit(bufB, xqB, accs + kB * 128 + 2 * lane, lane);
    }
#undef EU_NEXT_IDX
#undef EU_ADVANCE
    for (int k = 0; k < ntok; ++k) {
        const int t = gw + k * nwv;
        const unsigned ep = *(const unsigned*)(seli + (size_t)t * 128 + 2 * lane);
        const f32x2 gt = *(const f32x2*)(selg + (size_t)t * 128 + 2 * lane);
        const f32x2 a2 = *(const LAS f32x2*)(accs + k * 128 + 2 * lane);
        const int e0 = (int)(ep & 0xffffu), e1 = (int)(ep >> 16);
        const float xs = xsv[t];
        const float h0 = a2.x * xs * rsu[e0], h1 = a2.y * xs * rsu[e1];
        const float w0 = gt.x * (0.5f * h0 * (1.f + erff(h0 * 0.70710678118654752f))) * rsv[e0];
        const float w1 = gt.y * (0.5f * h1 * (1.f + erff(h1 * 0.70710678118654752f))) * rsv[e1];
        *(unsigned*)(wexp + (size_t)t * 128 + 2 * lane) = pk2(w0, w1);
    }
}
DEV void phase_experts_act(const Params& P, int layer, int nrows) {
    const bf16_t* seli = (const bf16_t*)(P.ws + OFF_SELI);
    const float* selg = (const float*)(P.ws + OFF_SELG);
    const float* part = (const float*)(P.ws + OFF_PART);
    bf16_t* wexp = (bf16_t*)(P.ws + OFF_WEXP);
    const float* rsu = (const float*)(P.ws + OFF_RSC) + (size_t)(layer * 2) * 16384;
    const float* rsv = rsu + 16384;
    const int tid = tid_fresh();
    const int n4 = nrows * 32;
    for (int i4 = blockIdx.x * NTHREADS + tid; i4 < n4; i4 += gridDim.x * NTHREADS) {
        const size_t idx = (size_t)i4 * 4;
        f32x4 h = {0.f, 0.f, 0.f, 0.f};
#pragma unroll
        for (int s = 0; s < 4; ++s) { const u32x2 pv = *(const u32x2*)((const bf16_t*)part + (size_t)s * NT * 128 + idx); h += (f32x4){bflo(pv.x), bfhi(pv.x), bflo(pv.y), bfhi(pv.y)}; }
        const u32x2 e = *(const u32x2*)(seli + idx);
        const f32x4 gt = *(const f32x4*)(selg + idx);
        const int ee[4] = {(int)(e.x & 0xffffu), (int)(e.x >> 16), (int)(e.y & 0xffffu), (int)(e.y >> 16)};
        f32x4 o;
#pragma unroll
        for (int q = 0; q < 4; ++q) {
            const float hh = h[q] * rsu[ee[q]];
            o[q] = gt[q] * (0.5f * hh * (1.f + erff(hh * 0.70710678118654752f))) * rsv[ee[q]];
        }
        u32x2 ow; ow.x = pk2(o[0], o[1]); ow.y = pk2(o[2], o[3]);
        *(u32x2*)(wexp + idx) = ow;
    }
}
DEV void phase_final(const Params& P) {
    const int tid = tid_fresh(), wave = tid >> 6, lane = tid & 63;
    for (int r = blockIdx.x * 8 + wave; r < NX; r += gridDim.x * 8) {
        float* h = P.out + (size_t)r * 1024;
        f32x4 v[4]; float ss = 0.f;
#pragma unroll
        for (int j = 0; j < 4; ++j) { const u32x2 hv = *(const u32x2*)(hrow(P, r) + j * 256 + lane * 4); v[j] = (f32x4){bflo(hv.x), bfhi(hv.x), bflo(hv.y), bfhi(hv.y)};
            ss += v[j].x * v[j].x + v[j].y * v[j].y + v[j].z * v[j].z + v[j].w * v[j].w; }
        ss = wave_sum(ss);
        const float rstd = rsqrtf(ss * (1.f / 1024.f) + EPS);
#pragma unroll
        for (int j = 0; j < 4; ++j) { const f32x4 gg = *(const f32x4*)(P.final_g + j * 256 + lane * 4); __builtin_nontemporal_store(v[j] * rstd * gg, (f32x4*)(h + j * 256 + lane * 4)); }
    }
}

DEV void phase_conv(const Params& P) {
    const bf16_t* Pq = (const bf16_t*)(P.ws + OFF_R1);
    const float* ab = (const float*)(P.ws + OFF_AB);
    bf16_t* dst[3] = {(bf16_t*)(P.ws + OFF_QC), (bf16_t*)(P.ws + OFF_KC), (bf16_t*)(P.ws + OFF_VC)};
    float* gbuf = (float*)(P.ws + OFF_G);
    float* bbuf = (float*)(P.ws + OFF_BETA);
    const int tid = tid_fresh(), wave = tid >> 6, lane = tid & 63;
    constexpr int NSEG = NT / 16;
    for (int item = blockIdx.x * 8 + wave; item < NSEG * 6; item += gridDim.x * 8) {
        const int seg = item / 6, jc = item - seg * 6, row0 = seg * 16;
        int t0, L;
        if (row0 < NX) { t0 = row0 & 2047; L = 2048; } else { t0 = (row0 - NX) & 255; L = 256; }
        const int chunk = lane + 64 * jc, col = chunk * 8, part = jc >> 1;
        f32x4 w0[5], w1[5];
#pragma unroll
        for (int tap = 0; tap < 5; ++tap) { w0[tap] = *(const f32x4*)(P.dn_conv_w + tap * 3072 + col); w1[tap] = *(const f32x4*)(P.dn_conv_w + tap * 3072 + col + 4); }
        u32x4 raw[20];
#pragma unroll
        for (int i = 0; i < 20; ++i) {
            const int tt = t0 + i - 2;
            const bool ok = tt >= 0 && tt < L;
            const u32x4 v = *(const u32x4*)(Pq + (size_t)(row0 + (ok ? i - 2 : 0)) * 3072 + col);
            raw[i] = ok ? v : (u32x4){0u, 0u, 0u, 0u};
        }
        const float qs = part == 0 ? 0.08838834764831845f : 1.f;
        bf16_t* dp = dst[part] + (size_t)row0 * 1024 + (chunk & 127) * 8;
#pragma unroll
        for (int i = 0; i < 16; ++i) {
            float acc[8];
#pragma unroll
            for (int e = 0; e < 8; ++e) acc[e] = 0.f;
#pragma unroll
            for (int tap = 0; tap < 5; ++tap) {
                float f[8]; unpack8(raw[i + tap], f);
                acc[0] += f[0] * w0[tap].x; acc[1] += f[1] * w0[tap].y; acc[2] += f[2] * w0[tap].z; acc[3] += f[3] * w0[tap].w;
                acc[4] += f[4] * w1[tap].x; acc[5] += f[5] * w1[tap].y; acc[6] += f[6] * w1[tap].z; acc[7] += f[7] * w1[tap].w;
            }
            float ss = 0.f;
#pragma unroll
            for (int e = 0; e < 8; ++e) { acc[e] = silu(acc[e]); ss += acc[e] * acc[e]; }
            if (part < 2) {
                ss = sum16(ss);
                const float rn = rsqrtf(ss + EPS) * qs;
#pragma unroll
                for (int e = 0; e < 8; ++e) acc[e] *= rn;
            }
            u32x4 o; o.x = pk2(acc[0], acc[1]); o.y = pk2(acc[2], acc[3]); o.z = pk2(acc[4], acc[5]); o.w = pk2(acc[6], acc[7]);
            *(u32x4*)(dp + (size_t)i * 1024) = o;
        }
        if (jc == 0) {
            const int cc = lane & 31, d = cc >> 4, sx = (cc >> 3) & 1, h = cc & 7;
            const float a = __expf(P.dn_a_log[d * 8 + h]), dtb = P.dn_dt_bias[d * 8 + h];
            float v[8];
#pragma unroll
            for (int q = 0; q < 8; ++q) v[q] = ab[(size_t)(row0 + 2 * q + (lane >> 5)) * 32 + cc];
#pragma unroll
            for (int q = 0; q < 8; ++q) {
                const int row = row0 + 2 * q + (lane >> 5);
                if (sx == 0) {
                    const float xx = v[q] + dtb;
                    const float ex = __expf(fminf(xx, 30.f)), u = 1.f + ex;
                    const float l1p = (u == 1.f) ? ex : __logf(u) * ex * __builtin_amdgcn_rcpf(u - 1.f);
                    const float sp = xx > 20.f ? xx : l1p;
                    gbuf[((size_t)d * NT + row) * 8 + h] = -a * sp;
                } else {
                    bbuf[((size_t)d * NT + row) * 8 + h] = __builtin_amdgcn_rcpf(1.f + __expf(-v[q]));
                }
            }
        }
    }
}

DEV int chunk_rowbase(int b, int d, int n) {
    if (n < 4) { const int m = d ? 3 - n : n; return NX + b * 256 + m * 64; }
    const int m = d ? 31 - (n - 4) : n - 4; return b * 2048 + m * 64;
}

DEV bf16x8 frag_col_x(ldsp x, int c0, int k0, int lane) {
    const int col = c0 + (lane & 31), ch = col >> 3, sub = (col & 7) * 2;
    bf16x8 f;
#pragma unroll
    for (int j = 0; j < 8; ++j) { const int row = k0 + 8 * (lane >> 5) + j; f[j] = (short)*(const LAS bf16_t*)(x + row * 256 + ((ch ^ (row & 15)) << 4) + sub); }
    return f;
}
DEV void tile_rows8(const f32x16& acc, u32x4& o0, u32x4& o1) {
    unsigned p[4][2];
#pragma unroll
    for (int rg = 0; rg < 4; ++rg) { p[rg][0] = pk2(acc[rg * 4 + 0], acc[rg * 4 + 1]); p[rg][1] = pk2(acc[rg * 4 + 2], acc[rg * 4 + 3]); }
    const auto s00 = __builtin_amdgcn_permlane32_swap(p[0][0], p[2][0], false, false), s01 = __builtin_amdgcn_permlane32_swap(p[0][1], p[2][1], false, false);
    const auto s10 = __builtin_amdgcn_permlane32_swap(p[1][0], p[3][0], false, false), s11 = __builtin_amdgcn_permlane32_swap(p[1][1], p[3][1], false, false);
    o0 = (u32x4){s00[0], s01[0], s00[1], s01[1]};
    o1 = (u32x4){s10[0], s11[0], s10[1], s11[1]};
}
DEV bf16x8 frag_row_t(ldsp t, int r0, int k0, int lane) {
    const int row = r0 + (lane & 31), ch = (k0 >> 3) + (lane >> 5);
    return *(const LAS bf16x8*)(t + row * 128 + ((ch ^ (row & 7)) << 4));
}
DEV void phase_chunk(const Params& P, ldsp lds0) {
    const bf16_t* kc = (const bf16_t*)(P.ws + OFF_KC);
    const bf16_t* vc = (const bf16_t*)(P.ws + OFF_VC);
    const float* gbuf = (const float*)(P.ws + OFF_G);
    const float* bbuf = (const float*)(P.ws + OFF_BETA);
    bf16_t* wbuf = (bf16_t*)(P.ws + OFF_WBUF);
    bf16_t* ubuf = (bf16_t*)(P.ws + OFF_UBUF);
    float* gcbuf = (float*)(P.ws + OFF_GC);
    const int tid = tid_fresh(), lane = tid & 63, wave = tid >> 6, team = wave >> 1, tw = wave & 1, ttid = tid & 127;
    const int nteams = gridDim.x * 4, niter = (4608 + nteams - 1) / nteams;
    u32x4 rk[8];
    {
        const int item0 = min((int)(blockIdx.x * 4 + team), 4607);
        const int n = item0 % 36, d = (item0 / 36) & 1, bh = item0 / 72, rb0 = chunk_rowbase(bh >> 3, d, n);
#pragma unroll
        for (int j = 0; j < 8; ++j) { const int cid = ttid + 128 * j, i = cid >> 4, ch = cid & 15; rk[j] = *(const u32x4*)(kc + ((size_t)rb0 + (d ? 63 - i : i)) * 1024 + (bh & 7) * 128 + ch * 8); }
    }
    for (int it = 0; it < niter; ++it) {
        const int item = it * nteams + blockIdx.x * 4 + team;
        const bool act = item < 4608;
        const ldsp lds = launder(lds0);
        const ldsp sX = lds + team * 32768;
        const ldsp sT = sX + 16384;
        LAS float* sA = (LAS float*)sT;
        LAS float* sg = (LAS float*)(lds + 131072 + 128 + team * 768);
        const int n = item % 36, d = (item / 36) & 1, bh = item / 72, b = bh >> 3, h = bh & 7;
        const int rowbase = act ? chunk_rowbase(b, d, n) : 0;
        if (act) {
#pragma unroll
            for (int j = 0; j < 8; ++j) { const int cid = ttid + 128 * j, i = cid >> 4, ch = cid & 15; *(LAS u32x4*)(sX + i * 256 + ((ch ^ (i & 15)) << 4)) = rk[j]; }
            if (tw == 0) {
                const size_t grow = (size_t)rowbase + (d ? 63 - lane : lane);
                float v = gbuf[((size_t)d * NT + grow) * 8 + h];
#pragma unroll
                for (int o = 1; o < 64; o <<= 1) { const float t = __shfl_up(v, o); if (lane >= o) v += t; }
                sg[lane] = v; sg[64 + lane] = bbuf[((size_t)d * NT + grow) * 8 + h];
            }
        }
        __syncthreads();
        if (act) {
#pragma unroll 1
            for (int q = 0; q < 2; ++q) {
                const int mt = tw, nt = q;
                f32x16 acc = zero16();
#pragma unroll 4
                for (int ks = 0; ks < 8; ++ks) acc = mfma32(frag_row_x(sX, mt * 32, ks * 16, lane), frag_row_x(sX, nt * 32, ks * 16, lane), acc);
#pragma unroll
                for (int reg = 0; reg < 16; ++reg) {
                    const int i = mt * 32 + crow(reg, lane), j = nt * 32 + (lane & 31);
                    sA[i * 64 + j] = (i > j) ? sg[64 + i] * acc[reg] * __expf(sg[i] - sg[j]) : 0.f;
                }
            }
        }
        __syncthreads();
        if (act && tw == 0) {
            float t[64];
            int ln = lane; asm volatile("" : "+v"(ln));
#pragma unroll
            for (int i = 0; i < 64; ++i) {
                float a0 = (i == ln) ? 1.f : 0.f, a1 = 0.f, a2 = 0.f, a3 = 0.f;
#pragma unroll
                for (int j = 0; j < i; j += 4) {
                    const f32x4 av = *(const LAS f32x4*)(sA + i * 64 + j);
                    a0 -= av.x * t[j];
                    if (j + 1 < i) a1 -= av.y * t[j + 1];
                    if (j + 2 < i) a2 -= av.z * t[j + 2];
                    if (j + 3 < i) a3 -= av.w * t[j + 3];
                }
                t[i] = (a0 + a1) + (a2 + a3);
                __builtin_amdgcn_sched_barrier(0);
            }
            const float cu = sg[64 + lane], cw = cu * __expf(sg[lane]);
            const int ch = lane >> 3, sub = (lane & 7) * 2;
#pragma unroll
            for (int i = 0; i < 64; ++i) {
                const int off = i * 128 + ((ch ^ (i & 7)) << 4) + sub;
                *(LAS bf16_t*)(sT + off) = f2bf(t[i] * cw);
                *(LAS bf16_t*)(sT + 8192 + off) = f2bf(t[i] * cu);
                if ((i & 7) == 7) __builtin_amdgcn_sched_barrier(0);
            }
        }
        __syncthreads();
            {
                const int itemn = min(item + nteams, 4607);
                const int nn = itemn % 36, dn = (itemn / 36) & 1, bhn = itemn / 72, rbn = chunk_rowbase(bhn >> 3, dn, nn);
#pragma unroll
                for (int j = 0; j < 8; ++j) { const int cid = ttid + 128 * j, i = cid >> 4, ch = cid & 15; rk[j] = *(const u32x4*)(kc + ((size_t)rbn + (dn ? 63 - i : i)) * 1024 + (bhn & 7) * 128 + ch * 8); }
            }
        u32x4 rv[8];
        if (act) {
#pragma unroll
            for (int j = 0; j < 8; ++j) {
                const int cid = ttid + 128 * j, i = cid >> 4, ch = cid & 15;
                const size_t grow = (size_t)rowbase + (d ? 63 - i : i);
                rv[j] = *(const u32x4*)(vc + grow * 1024 + h * 128 + ch * 8);
            }
#pragma unroll 1
            for (int q = 0; q < 2; ++q) {
                const int mtk = 2 * tw + q;
                f32x16 acc[2]; acc[0] = zero16(); acc[1] = zero16();
#pragma unroll
                for (int ks = 0; ks < 4; ++ks) {
                    const bf16x8 afr = frag_col_x(sX, mtk * 32, ks * 16, lane);
#pragma unroll
                    for (int it2 = 0; it2 < 2; ++it2) acc[it2] = mfma32(afr, frag_row_t(sT, it2 * 32, ks * 16, lane), acc[it2]);
                }
                bf16_t* dstp = wbuf + (size_t)item * 8192;
#pragma unroll
                for (int it2 = 0; it2 < 2; ++it2) {
                    u32x4 o0, o1; tile_rows8(acc[it2], o0, o1);
                    bf16_t* rp = dstp + (it2 * 32 + (lane & 31)) * 128 + mtk * 32 + 16 * (lane >> 5);
                    *(u32x4*)rp = o0; *(u32x4*)(rp + 8) = o1;
                }
            }
        }
        __syncthreads();
        if (act) {
#pragma unroll
            for (int j = 0; j < 8; ++j) { const int cid = ttid + 128 * j, i = cid >> 4, ch = cid & 15; *(LAS u32x4*)(sX + i * 256 + ((ch ^ (i & 15)) << 4)) = rv[j]; }
        }
        __syncthreads();
        if (act) {
#pragma unroll 1
            for (int q = 0; q < 2; ++q) {
                const int nt = 2 * tw + q;
                f32x16 acc[2]; acc[0] = zero16(); acc[1] = zero16();
#pragma unroll
                for (int ks = 0; ks < 4; ++ks) {
                    const bf16x8 bfr = frag_col_x(sX, nt * 32, ks * 16, lane);
#pragma unroll
                    for (int mt = 0; mt < 2; ++mt) acc[mt] = mfma32(frag_row_t(sT + 8192, mt * 32, ks * 16, lane), bfr, acc[mt]);
                }
                bf16_t* dstp = ubuf + (size_t)item * 8192;
#pragma unroll
                for (int mt = 0; mt < 2; ++mt) {
                    u32x4 o0, o1; tile_rows8(acc[mt], o0, o1);
                    bf16_t* rp = dstp + (nt * 32 + (lane & 31)) * 64 + mt * 32 + 16 * (lane >> 5);
                    *(u32x4*)rp = o0; *(u32x4*)(rp + 8) = o1;
                }
            }
            if (tw == 0) gcbuf[(size_t)item * 64 + lane] = sg[lane];
        }
        __syncthreads();
    }
}

DEV u32x2 pack4(float a, float b, float c, float d) { u32x2 o; o.x = pk2(a, b); o.y = pk2(c, d); return o; }
DEV void phase_scan(const Params& P, ldsp lds0) {
    const bf16_t* qc = (const bf16_t*)(P.ws + OFF_QC);
    const bf16_t* kc = (const bf16_t*)(P.ws + OFF_KC);
    const bf16_t* wbuf = (const bf16_t*)(P.ws + OFF_WBUF);
    const bf16_t* ubuf = (const bf16_t*)(P.ws + OFF_UBUF);
    const float* gcbuf = (const float*)(P.ws + OFF_GC);
    bf16_t* obuf = (bf16_t*)(P.ws + OFF_OBUF);
    const int tid = tid_fresh(), lane = tid & 63, wave = tid >> 6;
    const int mt = wave >> 1, nt = wave & 1;
    const int mt2 = (wave & 3) >> 1, nt2 = wave & 1;
    for (int item = blockIdx.x; item < 256; item += gridDim.x) {
        const int half = item & 1, d = (item >> 1) & 1, bh = item >> 2, b = bh >> 3, h = bh & 7;
        f32x16 S = zero16();
        { LAS unsigned* z = (LAS unsigned*)(lds0 + 1024 + 3 * 17408 + 9216); for (int e = tid; e < 64 * 136 / 2; e += NTHREADS) z[e] = 0u; }
        u32x4 rW[2][2], rK[2][2], rQ[2][2], rU[2]; float rG[2] = {0.f, 0.f};
#pragma unroll
        for (int u = 0; u < 2; ++u) {
            const int citem = (bh * 2 + d) * 36 + u, rowbase = chunk_rowbase(b, d, u);
#pragma unroll
            for (int j = 0; j < 2; ++j) {
                const int cid = tid + NTHREADS * j, i = cid >> 4, ch = cid & 15;
                const size_t grow = (size_t)rowbase + (d ? 63 - i : i);
                rW[u][j] = *(const u32x4*)(wbuf + (size_t)citem * 8192 + i * 128 + ch * 8);
                rK[u][j] = *(const u32x4*)(kc + grow * 1024 + h * 128 + ch * 8);
                rQ[u][j] = rK[u][j];
            }
            { const int dvr = tid >> 3, ch = tid & 7; rU[u] = *(const u32x4*)(ubuf + (size_t)citem * 8192 + (half * 64 + dvr) * 64 + ch * 8); }
            if (tid < 64) rG[u] = gcbuf[(size_t)citem * 64 + tid];
        }
        for (int n2 = 0; n2 < 36; n2 += 2) {
#pragma unroll
        for (int u = 0; u < 2; ++u) {
            const int n = n2 + u;
            const ldsp lds = launder(lds0);
            int ln = lane; asm volatile("" : "+v"(ln));
            LAS float* sg = (LAS float*)lds;
            LAS bf16_t* sW = (LAS bf16_t*)(lds + 1024);
            LAS bf16_t* sK = sW + 64 * 136;
            LAS bf16_t* sQ = sK + 64 * 136;
            LAS bf16_t* sU = sQ + 64 * 136;
            LAS bf16_t* sST = sU + 64 * 72;
            LAS bf16_t* sVNT = sST + 64 * 136;
            LAS bf16_t* sVNsT = sVNT + 64 * 72;
            LAS bf16_t* sATT = sVNsT + 64 * 72;
            LAS bf16_t* sO = sATT + 64 * 72;
            const int rowbase = chunk_rowbase(b, d, n);
            const bool wantO = n >= 4;
#pragma unroll
            for (int j = 0; j < 2; ++j) {
                const int cid = tid + NTHREADS * j, i = cid >> 4, ch = cid & 15;
                *(LAS u32x4*)(sW + i * 136 + ch * 8) = rW[u][j];
                *(LAS u32x4*)(sK + i * 136 + ch * 8) = rK[u][j];
                *(LAS u32x4*)(sQ + i * 136 + ch * 8) = rQ[u][j];
            }
            { const int i = tid >> 3, ch = tid & 7; *(LAS u32x4*)(sU + i * 72 + ch * 8) = rU[u]; }
            if (tid < 64) sg[tid] = rG[u];
            __syncthreads();
            if (n + 2 < 36) {
                const int citem = (bh * 2 + d) * 36 + n + 2, rb1 = chunk_rowbase(b, d, n + 2);
                const bool wq = n + 2 >= 4;
#pragma unroll
                for (int j = 0; j < 2; ++j) {
                    const int cid = tid + NTHREADS * j, i = cid >> 4, ch = cid & 15;
                    const size_t grow = (size_t)rb1 + (d ? 63 - i : i);
                    rW[u][j] = *(const u32x4*)(wbuf + (size_t)citem * 8192 + i * 128 + ch * 8);
                    rK[u][j] = *(const u32x4*)(kc + grow * 1024 + h * 128 + ch * 8);
                    if (wq) rQ[u][j] = *(const u32x4*)(qc + grow * 1024 + h * 128 + ch * 8);
                }
                { const int dvr = tid >> 3, ch = tid & 7; rU[u] = *(const u32x4*)(ubuf + (size_t)citem * 8192 + (half * 64 + dvr) * 64 + ch * 8); }
                if (tid < 64) rG[u] = gcbuf[(size_t)citem * 64 + tid];
            }
            const float g63 = sg[63];
            if (wave < 4) {
                const int dv = nt2 * 32 + (ln & 31);
                float uf[16], ef[16];
#pragma unroll
                for (int rg = 0; rg < 4; ++rg) {
                    const int i0 = mt2 * 32 + 8 * rg + 4 * (ln >> 5);
                    const u32x2 uu = *(const LAS u32x2*)(sU + dv * 72 + i0);
                    const f32x4 gg = *(const LAS f32x4*)(sg + i0);
                    uf[rg * 4 + 0] = bflo(uu.x); uf[rg * 4 + 1] = bfhi(uu.x); uf[rg * 4 + 2] = bflo(uu.y); uf[rg * 4 + 3] = bfhi(uu.y);
#pragma unroll
                    for (int e = 0; e < 4; ++e) ef[rg * 4 + e] = __expf(g63 - gg[e]);
                }
                f32x16 acc = zero16(), accb = zero16();
#pragma unroll
                for (int ks = 0; ks < 8; ks += 2) { acc = mfma32(frag_row(sW, 136, mt2 * 32, ks * 16, ln), frag_row(sST, 136, nt2 * 32, ks * 16, ln), acc);
                    accb = mfma32(frag_row(sW, 136, mt2 * 32, ks * 16 + 16, ln), frag_row(sST, 136, nt2 * 32, ks * 16 + 16, ln), accb); }
#pragma unroll
                for (int rg = 0; rg < 4; ++rg) {
                    const int i0 = mt2 * 32 + 8 * rg + 4 * (ln >> 5);
                    float v[4], vs[4];
#pragma unroll
                    for (int e = 0; e < 4; ++e) { v[e] = uf[rg * 4 + e] - (acc[rg * 4 + e] + accb[rg * 4 + e]); vs[e] = v[e] * ef[rg * 4 + e]; }
                    *(LAS u32x2*)(sVNT + dv * 72 + i0) = pack4(v[0], v[1], v[2], v[3]);
                    *(LAS u32x2*)(sVNsT + dv * 72 + i0) = pack4(vs[0], vs[1], vs[2], vs[3]);
                }
            } else if (wantO) {
                const int i = nt2 * 32 + (ln & 31);
                const float gi = sg[i];
                float df[16];
#pragma unroll
                for (int rg = 0; rg < 4; ++rg) {
                    const int j0 = mt2 * 32 + 8 * rg + 4 * (ln >> 5);
                    const f32x4 gg = *(const LAS f32x4*)(sg + j0);
#pragma unroll
                    for (int e = 0; e < 4; ++e) df[rg * 4 + e] = (i >= j0 + e) ? __expf(fminf(gi - gg[e], 0.f)) : 0.f;
                }
                f32x16 acc = zero16(), accb = zero16();
#pragma unroll
                for (int ks = 0; ks < 8; ks += 2) { acc = mfma32(frag_row(sK, 136, mt2 * 32, ks * 16, ln), frag_row(sQ, 136, nt2 * 32, ks * 16, ln), acc);
                    accb = mfma32(frag_row(sK, 136, mt2 * 32, ks * 16 + 16, ln), frag_row(sQ, 136, nt2 * 32, ks * 16 + 16, ln), accb); }
#pragma unroll
                for (int rg = 0; rg < 4; ++rg) {
                    const int j0 = mt2 * 32 + 8 * rg + 4 * (ln >> 5);
                    float v[4];
#pragma unroll
                    for (int e = 0; e < 4; ++e) v[e] = (acc[rg * 4 + e] + accb[rg * 4 + e]) * df[rg * 4 + e];
                    *(LAS u32x2*)(sATT + i * 72 + j0) = pack4(v[0], v[1], v[2], v[3]);
                }
            }
            __syncthreads();
            if (wave < 4 && wantO) {
                float eg[16];
#pragma unroll
                for (int rg = 0; rg < 4; ++rg) {
                    const f32x4 gg = *(const LAS f32x4*)(sg + mt2 * 32 + 8 * rg + 4 * (ln >> 5));
#pragma unroll
                    for (int e = 0; e < 4; ++e) eg[rg * 4 + e] = __expf(gg[e]);
                }
                f32x16 a1 = zero16(), a1b = zero16(), a2 = zero16();
#pragma unroll
                for (int ks = 0; ks < 8; ks += 2) { a1 = mfma32(frag_row(sQ, 136, mt2 * 32, ks * 16, ln), frag_row(sST, 136, nt2 * 32, ks * 16, ln), a1);
                    a1b = mfma32(frag_row(sQ, 136, mt2 * 32, ks * 16 + 16, ln), frag_row(sST, 136, nt2 * 32, ks * 16 + 16, ln), a1b); }
#pragma unroll
                for (int ks = 0; ks < 4; ++ks) a2 = mfma32(frag_row(sATT, 72, mt2 * 32, ks * 16, ln), frag_row(sVNT, 72, nt2 * 32, ks * 16, ln), a2);
                const int dv = nt2 * 32 + (ln & 31);
#pragma unroll
                for (int rg = 0; rg < 4; ++rg) {
                    const int i0 = mt2 * 32 + 8 * rg + 4 * (ln >> 5);
#pragma unroll
                    for (int e = 0; e < 4; ++e) sO[(i0 + e) * 72 + dv] = f2bf((a1[rg * 4 + e] + a1b[rg * 4 + e]) * eg[rg * 4 + e] + a2[rg * 4 + e]);
                }
            }
            {
                const float gl = __expf(g63);
#pragma unroll
                for (int reg = 0; reg < 16; ++reg) S[reg] *= gl;
#pragma unroll
                for (int ks = 0; ks < 4; ++ks) S = mfma32(frag_col_tr(sK, 136, mt * 32, ks * 16, ln), frag_row(sVNsT, 72, nt * 32, ks * 16, ln), S);
            }
            __syncthreads();
            if (wantO) {
                const int i = tid >> 3, ch = tid & 7;
                const size_t grow = (size_t)rowbase + (d ? 63 - i : i);
                *(u32x4*)(obuf + ((size_t)d * NX + grow) * 1024 + h * 128 + half * 64 + ch * 8) = *(const LAS u32x4*)(sO + i * 72 + ch * 8);
            }
#pragma unroll
            for (int rg = 0; rg < 4; ++rg) {
                const int dk0 = mt * 32 + 8 * rg + 4 * (ln >> 5);
                *(LAS u32x2*)(sST + (nt * 32 + (ln & 31)) * 136 + dk0) = pack4(S[rg * 4 + 0], S[rg * 4 + 1], S[rg * 4 + 2], S[rg * 4 + 3]);
            }
        }
        }
        __syncthreads();
    }
}

DEV void phase_dnout(const Params& P) {
    const bf16_t* obuf = (const bf16_t*)(P.ws + OFF_OBUF);
    const bf16_t* Pz = (const bf16_t*)(P.ws + OFF_PZ);
    bf16_t* A = (bf16_t*)(P.ws + OFF_A);
    const int tid = tid_fresh(); const int wave = tid >> 6, lane = tid & 63;
    for (int row = blockIdx.x * 8 + wave; row < NX; row += gridDim.x * 8) {
#pragma unroll
        for (int c = 0; c < 2; ++c) {
            const int col = c * 512 + lane * 8;
            const u32x4 of = *(const u32x4*)(obuf + (size_t)row * 1024 + col), ob = *(const u32x4*)(obuf + ((size_t)NX + row) * 1024 + col);
            const u32x4 zz = *(const u32x4*)(Pz + (size_t)row * 1024 + col);
            float o[8], o2[8], z[8]; unpack8(of, o); unpack8(ob, o2); unpack8(zz, z);
            float ss = 0.f;
#pragma unroll
            for (int e = 0; e < 8; ++e) { o[e] += o2[e]; ss += o[e] * o[e]; }
            ss = sum16(ss);
            const float rn = rsqrtf(ss * (1.f / 128.f) + EPS);
            float y[8];
#pragma unroll
            for (int e = 0; e < 8; ++e) y[e] = o[e] * rn * P.dn_norm_g[(col & 127) + e] * silu(z[e]);
            u32x4 ov; ov.x = pk2(y[0], y[1]); ov.y = pk2(y[2], y[3]); ov.z = pk2(y[4], y[5]); ov.w = pk2(y[6], y[7]);
            *(u32x4*)(A + (size_t)row * 1024 + col) = ov;
        }
    }
}

namespace pg8 {
#define PG8_LAS __attribute__((address_space(3)))
typedef unsigned short bf16_t;
typedef short bf16x8 __attribute__((ext_vector_type(8)));
typedef float f32x4 __attribute__((ext_vector_type(4)));
typedef unsigned u32x4 __attribute__((ext_vector_type(4)));
constexpr int BM = 256, BK = 64, HALF = 128, HTB = HALF * BK * 2  , STAGE_BYTES = 8 * HTB, NXCD = 8, WGM = 8;

__host__ __device__ __forceinline__ int lds_byte(int r, int c) { const int st = (r >> 4) * 2 + (c >> 5), rr = r & 15, cc = c & 31, ob = rr * 64 + cc * 2; return st * 1024 + (ob ^ (((ob >> 9) & 1) << 5)); }
__host__ __device__ __forceinline__ void stage_rc(int b, int& R, int& C) { const int st = b / 1024, sb = b % 1024, swz = sb ^ (((sb >> 9) & 1) << 5); R = (st >> 1) * 16 + swz / 64; C = (st & 1) * 32 + (swz % 64) / 2; }
__host__ __device__ __forceinline__ int perm32(int rho) { const int n = rho >> 4, i = rho & 15; return 8 * (i >> 2) + 4 * n + (i & 3); }

struct Unit { int pm, pn; };
struct Gemm { const bf16_t* A; const bf16_t* Bt; int M, N, K; };

struct StaticOrder {
    int nM, nN, nwg, G, c;
    __host__ __device__ void init(int M, int N, int G_, int c_) { nM = M / BM; nN = N / BM; nwg = nM * nN; G = G_; c = c_; }
    __host__ __device__ bool next(int i, Unit& u) const {
        const long L = (long)i * G + c; if (L >= nwg) return false;
        int wgid = (int)L; { const int q = nwg / NXCD, r = nwg % NXCD, xcd = wgid % NXCD, off = wgid / NXCD; wgid = (xcd < r ? xcd * (q + 1) : r * (q + 1) + (xcd - r) * q) + off; }
        const int nig = WGM * nN, gid = wgid / nig, fm = gid * WGM, gsz = (nM - fm) < WGM ? (nM - fm) : WGM;
        u.pm = fm + ((wgid % nig) % gsz); u.pn = (wgid % nig) / gsz; return true;
    }
    __device__ __forceinline__ void a_ready(const Unit&) const {}
    __device__ __forceinline__ void done(const Unit&) const {}
};

__device__ __forceinline__ unsigned cvt_pk_bf16(float lo, float hi) { typedef float v2f __attribute__((ext_vector_type(2))); typedef __bf16 v2b __attribute__((ext_vector_type(2))); const v2f v = {lo, hi}; return __builtin_bit_cast(unsigned, __builtin_convertvector(v, v2b)); }
__device__ __forceinline__ u32x4 pack8(const f32x4 v0, const f32x4 v1) { u32x4 w; w.x = cvt_pk_bf16(v0[0], v0[1]); w.y = cvt_pk_bf16(v0[2], v0[3]); w.z = cvt_pk_bf16(v1[0], v1[1]); w.w = cvt_pk_bf16(v1[2], v1[3]); return w; }
struct EpiQ {
    static constexpr bool PERM = true, AFTER_DRAIN = false;
    bf16_t* O; int ldc;
    __device__ __forceinline__ void operator()(const f32x4 (&acc)[2][2][4][2], const Unit& u, int wr, int wc, int fr, int fq) const {
        const int row0 = u.pm * BM + wr * 64 + fr, col0 = u.pn * BM + wc * 32 + 8 * fq;
#pragma unroll
        for (int ai = 0; ai < 2; ++ai)
#pragma unroll
            for (int m = 0; m < 4; ++m) { bf16_t* rowp = O + (size_t)(row0 + ai * HALF + m * 16) * ldc + col0;
#pragma unroll
                for (int bj = 0; bj < 2; ++bj) *(u32x4*)(rowp + bj * HALF) = pack8(acc[ai][bj][m][0], acc[ai][bj][m][1]); }
    }
};
struct EpiWinP {
    static constexpr bool PERM = true, AFTER_DRAIN = false;
    bf16_t* qkv; bf16_t* z; float* ab;
    __device__ __forceinline__ void operator()(const f32x4 (&acc)[2][2][4][2], const Unit& u, int wr, int wc, int fr, int fq) const {
        const int row0 = u.pm * BM + wr * 64 + fr;
        if (u.pn < 16) {
            bf16_t* base = u.pn < 12 ? qkv : z; const int ldc = u.pn < 12 ? 3072 : 1024, col0 = (u.pn < 12 ? u.pn : u.pn - 12) * BM + wc * 32 + 8 * fq;
#pragma unroll
            for (int ai = 0; ai < 2; ++ai)
#pragma unroll
                for (int m = 0; m < 4; ++m) { bf16_t* rowp = base + (size_t)(row0 + ai * HALF + m * 16) * ldc + col0;
#pragma unroll
                    for (int bj = 0; bj < 2; ++bj) *(u32x4*)(rowp + bj * HALF) = pack8(acc[ai][bj][m][0], acc[ai][bj][m][1]); }
        } else if (wc == 0) {
#pragma unroll
            for (int ai = 0; ai < 2; ++ai)
#pragma unroll
                for (int m = 0; m < 4; ++m) { float* rowp = ab + (size_t)(row0 + ai * HALF + m * 16) * 32 + 8 * fq;
                    *(f32x4*)rowp = acc[ai][0][m][0]; *(f32x4*)(rowp + 4) = acc[ai][0][m][1]; }
        }
    }
};
struct EpiRes {
    static constexpr bool PERM = true, AFTER_DRAIN = false;
    bf16_t* h; const float* gate;
    __device__ __forceinline__ void operator()(const f32x4 (&acc)[2][2][4][2], const Unit& u, int wr, int wc, int fr, int fq) const {
        const int row0 = u.pm * BM + wr * 64 + fr, col0 = u.pn * BM + wc * 32 + 8 * fq;
#pragma unroll
        for (int ai = 0; ai < 2; ++ai)
#pragma unroll
            for (int m = 0; m < 4; ++m) { const int row = row0 + ai * HALF + m * 16; bf16_t* rowp = h + (size_t)row * 1024 + col0; const float* gp = gate + (row >> 11) * 6144 + col0;
#pragma unroll
                for (int bj = 0; bj < 2; ++bj) {
                    const u32x4 hv = *(const u32x4*)(rowp + bj * HALF);
                    const f32x4 g0 = *(const f32x4*)(gp + bj * HALF), g1 = *(const f32x4*)(gp + bj * HALF + 4);
                    const f32x4 a0 = acc[ai][bj][m][0], a1 = acc[ai][bj][m][1];
                    f32x4 n0, n1;
                    n0[0] = __uint_as_float(hv.x << 16) + g0[0] * a0[0]; n0[1] = __uint_as_float(hv.x & 0xffff0000u) + g0[1] * a0[1];
                    n0[2] = __uint_as_float(hv.y << 16) + g0[2] * a0[2]; n0[3] = __uint_as_float(hv.y & 0xffff0000u) + g0[3] * a0[3];
                    n1[0] = __uint_as_float(hv.z << 16) + g1[0] * a1[0]; n1[1] = __uint_as_float(hv.z & 0xffff0000u) + g1[1] * a1[1];
                    n1[2] = __uint_as_float(hv.w << 16) + g1[2] * a1[2]; n1[3] = __uint_as_float(hv.w & 0xffff0000u) + g1[3] * a1[3];
                    *(u32x4*)(rowp + bj * HALF) = pack8(n0, n1);
                } }
    }
};

template <class Epi, class Sched, bool ALIGN_EPI = false, bool SP2 = false>
__device__ __forceinline__ void gemm_phase(PG8_LAS unsigned char* lds, const Gemm g, const Sched& S, const Epi& E) {
    const int tid = tid_fresh(), wid = __builtin_amdgcn_readfirstlane(tid >> 6), lane = tid & 63, wr = wid >> 2, wc = wid & 3, fr = lane & 15, fq = lane >> 4;
    const int K = g.K, nt = K / BK;
    unsigned voffA[2], voffB[2];
#pragma unroll
    for (int i = 0; i < 2; ++i) { int R, C; stage_rc(tid * 16 + i * 8192, R, C); const int Rb = Epi::PERM ? ((R & ~31) + perm32(R & 31)) : R;
        voffA[i] = (unsigned)(R * K + C) * 2u; voffB[i] = (unsigned)(Rb * K + C) * 2u; }
    const size_t kstep = (size_t)(BK * 2);
    const size_t hstep = (size_t)HALF * K * 2;
    const size_t tstep = 2 * hstep;
    const unsigned ldsw = (unsigned)wid * 1024u;
    const int aoff = lds_byte(wr * 64 + fr, fq * 8), boff = lds_byte(wc * 32 + fr, fq * 8);
#define PG8_SA(b, h) (((b) * 2 + (h)) * HTB)
#define PG8_SB(b, h) ((4 + (b) * 2 + (h)) * HTB)
#define PG8_STAGE(bufoff, gbase, voff) do { _Pragma("unroll") for (int _i = 0; _i < 2; ++_i) \
        __builtin_amdgcn_global_load_lds((const unsigned*)((const char*)(gbase) + (voff)[_i]), (PG8_LAS unsigned*)(lds + (bufoff) + ldsw + _i * 8192), 16, 0, 0); } while (0)
#define PG8_LDA(dst, b, h) do { _Pragma("unroll") for (int m = 0; m < 4; ++m) _Pragma("unroll") for (int k = 0; k < 2; ++k) dst[m][k] = *(const PG8_LAS bf16x8*)(lds + PG8_SA(b, h) + aoff + m * 2048 + k * 1024); } while (0)
#define PG8_LDB(dst, b, h) do { _Pragma("unroll") for (int n = 0; n < 2; ++n) _Pragma("unroll") for (int k = 0; k < 2; ++k) dst[n][k] = *(const PG8_LAS bf16x8*)(lds + PG8_SB(b, h) + boff + n * 2048 + k * 1024); } while (0)
#define PG8_MMA(ai, bj, At, Bt) do { __builtin_amdgcn_s_setprio(1); _Pragma("unroll") for (int m = 0; m < 4; ++m) _Pragma("unroll") for (int n = 0; n < 2; ++n) _Pragma("unroll") for (int k = 0; k < 2; ++k) \
        acc[ai][bj][m][n] = __builtin_amdgcn_mfma_f32_16x16x32_bf16(Bt[n][k], At[m][k], acc[ai][bj][m][n], 0, 0, 0); __builtin_amdgcn_s_setprio(0); } while (0)
#define PG8_WAIT_V(n) asm volatile("s_waitcnt vmcnt(" #n ")" ::: "memory")
#define PG8_WAIT_L(n) asm volatile("s_waitcnt lgkmcnt(" #n ")" ::: "memory")
#define PG8_BAR __builtin_amdgcn_s_barrier()
#define PG8_SCHED __builtin_amdgcn_sched_barrier(0)
    Unit cur, nxt; int ui = 0;
    if (!S.next(0, cur)) return;
    f32x4 acc[2][2][4][2];
#pragma unroll
    for (int a = 0; a < 2; ++a)
#pragma unroll
        for (int b = 0; b < 2; ++b)
#pragma unroll
            for (int m = 0; m < 4; ++m)
#pragma unroll
                for (int n = 0; n < 2; ++n) acc[a][b][m][n] = (f32x4){0.f, 0.f, 0.f, 0.f};
    bf16x8 At[4][2], B0[2][2], B1[2][2];
    const char* cA = (const char*)g.A + (size_t)cur.pm * tstep; const char* cB = (const char*)g.Bt + (size_t)cur.pn * tstep;
    S.a_ready(cur);
    if constexpr (SP2) {
        PG8_STAGE(PG8_SB(0, 0), cB, voffB); PG8_STAGE(PG8_SB(0, 1), cB + hstep, voffB); PG8_STAGE(PG8_SA(0, 0), cA, voffA); PG8_STAGE(PG8_SA(0, 1), cA + hstep, voffA);
        if (wr == 1) PG8_BAR;
        PG8_WAIT_V(2); PG8_BAR;
        PG8_STAGE(PG8_SB(1, 0), cB + kstep, voffB); PG8_STAGE(PG8_SA(1, 0), cA + kstep, voffA); PG8_STAGE(PG8_SB(1, 1), cB + hstep + kstep, voffB);
        PG8_WAIT_V(6); PG8_BAR;
    } else {
        PG8_STAGE(PG8_SB(0, 0), cB, voffB); PG8_STAGE(PG8_SA(0, 0), cA, voffA); PG8_STAGE(PG8_SB(0, 1), cB + hstep, voffB); PG8_STAGE(PG8_SA(0, 1), cA + hstep, voffA);
        if (wr == 1) PG8_BAR;
        PG8_WAIT_V(4); PG8_BAR;
        PG8_STAGE(PG8_SB(1, 0), cB + kstep, voffB); PG8_STAGE(PG8_SA(1, 0), cA + kstep, voffA); PG8_STAGE(PG8_SB(1, 1), cB + hstep + kstep, voffB);
        PG8_WAIT_V(6); PG8_BAR;
    }
    for (;;) {
        const bool has_next = S.next(ui + 1, nxt);
        const char* nA = has_next ? (const char*)g.A + (size_t)nxt.pm * tstep : cA; const char* nB = has_next ? (const char*)g.Bt + (size_t)nxt.pn * tstep : cB;
        for (int t = 0; t < nt; t += 2) {
            const bool last = (t == nt - 2);
            const char* a1 = cA + (size_t)(t + 1) * kstep;
            const char* a2 = last ? nA : cA + (size_t)(t + 2) * kstep; const char* b2 = last ? nB : cB + (size_t)(t + 2) * kstep;
            const char* a3 = a2 + kstep; const char* b3 = b2 + kstep;
            if (last && has_next) S.a_ready(nxt);
            if constexpr (SP2) {
            PG8_LDB(B0, 0, 0); PG8_LDB(B1, 0, 1); PG8_SCHED; PG8_LDA(At, 0, 0); PG8_STAGE(PG8_SA(1, 1), a1 + hstep, voffA);
            PG8_WAIT_V(8); PG8_WAIT_L(0); PG8_BAR; PG8_MMA(0, 0, At, B0); PG8_MMA(0, 1, At, B1); PG8_BAR; PG8_SCHED;
            PG8_LDA(At, 0, 1); PG8_STAGE(PG8_SB(0, 0), b2, voffB); PG8_STAGE(PG8_SB(0, 1), b2 + hstep, voffB); PG8_STAGE(PG8_SA(0, 0), a2, voffA);
            PG8_WAIT_V(8); PG8_WAIT_L(0); PG8_BAR; PG8_MMA(1, 0, At, B0); PG8_MMA(1, 1, At, B1); PG8_BAR; PG8_SCHED;
            PG8_LDB(B0, 1, 0); PG8_LDB(B1, 1, 1); PG8_SCHED; PG8_LDA(At, 1, 0); PG8_STAGE(PG8_SA(0, 1), a2 + hstep, voffA);
            PG8_WAIT_V(8); PG8_WAIT_L(0); PG8_BAR; PG8_MMA(0, 0, At, B0); PG8_MMA(0, 1, At, B1); PG8_BAR; PG8_SCHED;
            PG8_LDA(At, 1, 1); PG8_STAGE(PG8_SB(1, 0), b3, voffB); PG8_STAGE(PG8_SB(1, 1), b3 + hstep, voffB); PG8_STAGE(PG8_SA(1, 0), a3, voffA);
            PG8_WAIT_V(8); PG8_WAIT_L(0); PG8_BAR; PG8_MMA(1, 0, At, B0); PG8_MMA(1, 1, At, B1); PG8_BAR; PG8_SCHED;
            } else {
            PG8_LDB(B0, 0, 0); PG8_SCHED; PG8_LDA(At, 0, 0); PG8_STAGE(PG8_SA(1, 1), a1 + hstep, voffA);
            PG8_WAIT_L(8); PG8_BAR; PG8_WAIT_L(0); PG8_MMA(0, 0, At, B0); PG8_BAR; PG8_SCHED;
            PG8_LDB(B1, 0, 1); PG8_STAGE(PG8_SB(0, 0), b2, voffB);
            PG8_BAR; PG8_WAIT_L(0); PG8_MMA(0, 1, At, B1); PG8_BAR;
            PG8_LDA(At, 0, 1); PG8_STAGE(PG8_SA(0, 0), a2, voffA);
            PG8_BAR; PG8_WAIT_L(0); PG8_MMA(1, 0, At, B0); PG8_BAR; PG8_SCHED;
            PG8_STAGE(PG8_SB(0, 1), b2 + hstep, voffB);
            PG8_WAIT_V(6); PG8_BAR; PG8_MMA(1, 1, At, B1); PG8_BAR;
            PG8_LDB(B0, 1, 0); PG8_SCHED; PG8_LDA(At, 1, 0); PG8_STAGE(PG8_SA(0, 1), a2 + hstep, voffA);
            PG8_WAIT_L(8); PG8_BAR; PG8_WAIT_L(0); PG8_MMA(0, 0, At, B0); PG8_BAR; PG8_SCHED;
            PG8_LDB(B1, 1, 1); PG8_STAGE(PG8_SB(1, 0), b3, voffB);
            PG8_BAR; PG8_WAIT_L(0); PG8_MMA(0, 1, At, B1); PG8_BAR;
            PG8_LDA(At, 1, 1); PG8_STAGE(PG8_SA(1, 0), a3, voffA);
            PG8_BAR; PG8_WAIT_L(0); PG8_MMA(1, 0, At, B0); PG8_BAR; PG8_SCHED;
            PG8_STAGE(PG8_SB(1, 1), b3 + hstep, voffB);
            PG8_WAIT_V(6); PG8_BAR; PG8_MMA(1, 1, At, B1); PG8_BAR;
            }
        }
        if constexpr (ALIGN_EPI) { if (wr == 0) PG8_BAR; }
        if constexpr (!Epi::AFTER_DRAIN) { E(acc, cur, wr, wc, fr, fq); S.done(cur); }
        if (!has_next) break;
#pragma unroll
        for (int a = 0; a < 2; ++a)
#pragma unroll
            for (int b = 0; b < 2; ++b)
#pragma unroll
                for (int m = 0; m < 4; ++m)
#pragma unroll
                    for (int n = 0; n < 2; ++n) acc[a][b][m][n] = (f32x4){0.f, 0.f, 0.f, 0.f};
        cur = nxt; cA = nA; cB = nB; ++ui;
        if constexpr (ALIGN_EPI) { if (wr == 1) PG8_BAR; }
    }
    PG8_WAIT_V(0);
    if constexpr (!ALIGN_EPI) { if (wr == 0) PG8_BAR; }
    PG8_BAR;
    if constexpr (Epi::AFTER_DRAIN) { E.fused(acc, cur, wr, wc, fr, fq, lds, wid, lane); S.done(cur); }
#undef PG8_SA
#undef PG8_SB
#undef PG8_STAGE
#undef PG8_LDA
#undef PG8_LDB
#undef PG8_MMA
#undef PG8_WAIT_V
#undef PG8_WAIT_L
#undef PG8_BAR
#undef PG8_SCHED
}
}

#define XB_TMO      128
#define XB_XCNT(j)  (256  + 64 * (j))
#define XB_XSUB(j)  (1280 + 64 * (j))
#define XB_XGEN(j)  (2304 + 64 * (j))
#define XB_TOP      3328
#define XB_TOPGEN   3392
#define XCD_BAR_WORDS 3456
#define XB_SPIN_CAP (1u << 22)
DEV unsigned xb_ld(unsigned* p)              { return __hip_atomic_load(p, __ATOMIC_RELAXED, __HIP_MEMORY_SCOPE_AGENT); }
DEV unsigned xb_add(unsigned* p, unsigned v) { return __hip_atomic_fetch_add(p, v, __ATOMIC_RELAXED, __HIP_MEMORY_SCOPE_AGENT); }
DEV unsigned xb_xcc_id() { return (unsigned)__builtin_amdgcn_s_getreg((3 << 11) | 20) & 0xFu; }
#define XB_SPIN(cond, bar) do { unsigned _sp = 0; while (cond) { __builtin_amdgcn_s_sleep(1); \
    if ((++_sp & 255u) == 0u) { if (xb_ld(&(bar)[XB_TMO])) break; if (_sp > XB_SPIN_CAP) { atomicAdd(&(bar)[XB_TMO], 1u); break; } } } } while (0)
struct XcdBarrier { unsigned* bar; unsigned x; volatile LAS unsigned* st; };
DEV XcdBarrier xcd_barrier_post(unsigned* bar, volatile LAS unsigned* st) {
    XcdBarrier b; b.bar = bar; b.x = xb_xcc_id(); b.st = st;
    if (threadIdx.x == 0) (void)xb_add(&bar[XB_XCNT(b.x)], 1u);
    return b;
}
DEV void xcd_barrier_complete(unsigned* bar, unsigned x, unsigned& nloc, unsigned& nx) {
    const unsigned G = gridDim.x * gridDim.y * gridDim.z;
    unsigned sum, cnt, mine, sp = 0u;
    for (;;) {
        sum = 0u; cnt = 0u; mine = 0u;
#pragma unroll
        for (unsigned j = 0; j < 16; ++j) { const unsigned c = xb_ld(&bar[XB_XCNT(j)]); sum += c; cnt += (c > 0u) ? 1u : 0u; mine = (j == x) ? c : mine; }
        if (sum == G) break;
        __builtin_amdgcn_s_sleep(1);
        if ((++sp & 255u) == 0u) { if (xb_ld(&bar[XB_TMO])) break; if (sp > XB_SPIN_CAP) { atomicAdd(&bar[XB_TMO], 1u); break; } }
    }
    nloc = mine > 0u ? mine : 1u; nx = cnt > 0u ? cnt : 1u;
}
DEV void xcd_barrier(const XcdBarrier& b) {
    asm volatile("s_waitcnt vmcnt(0)" ::: "memory");
    __syncthreads();
    if (threadIdx.x == 0) {
        unsigned* bar = b.bar;
        __builtin_amdgcn_s_waitcnt(0);
        unsigned nloc = b.st[0], nx = b.st[1];
        if (nloc == 0u) { xcd_barrier_complete(bar, b.x, nloc, nx); b.st[0] = nloc; b.st[1] = nx; }
        const unsigned old = xb_add(&bar[XB_XSUB(b.x)], 1u);
        const unsigned gen = old / nloc;
        if (old + 1u == (gen + 1u) * nloc) {
            __builtin_amdgcn_fence(__ATOMIC_RELEASE, "agent");
            asm volatile("s_waitcnt vmcnt(0)" ::: "memory");
            const unsigned og = xb_add(&bar[XB_TOP], 1u);
            const unsigned tg = og / nx;
            if (og + 1u == (tg + 1u) * nx) xb_add(&bar[XB_TOPGEN], 1u);
            else XB_SPIN(xb_ld(&bar[XB_TOPGEN]) == tg, bar);
            __builtin_amdgcn_fence(__ATOMIC_ACQUIRE, "agent");
            xb_add(&bar[XB_XGEN(b.x)], 1u);
            asm volatile("s_waitcnt vmcnt(0)" ::: "memory");
        } else {
            XB_SPIN(xb_ld(&bar[XB_XGEN(b.x)]) == gen, bar);
            __builtin_amdgcn_fence(__ATOMIC_ACQUIRE, "agent");
            asm volatile("s_waitcnt vmcnt(0)" ::: "memory");
        }
    }
    __syncthreads();
}

__global__ void __launch_bounds__(NTHREADS) fwd_megakernel(Params P) {
    __shared__ __attribute__((aligned(16))) unsigned char lds_raw[131072 + 4096];
    const ldsp lds = (ldsp)lds_raw;
    cg::grid_group grid = cg::this_grid();
    volatile LAS unsigned* xbst = (volatile LAS unsigned*)(lds + 131072);
    if (threadIdx.x == 0) { xbst[0] = 0u; xbst[1] = 0u; }
    __syncthreads();
    const XcdBarrier xbar = xcd_barrier_post((unsigned*)(P.ws + OFF_BAR), xbst);
    if (threadIdx.x == 0) xbst[2] = xb_add((unsigned*)(P.ws + OFF_BAR) + xbar.x, 1u);
#define GBAR() xcd_barrier(xbar)
    const float* modv = (const float*)(P.ws + OFF_MODV);
    bf16_t* Abuf = (bf16_t*)(P.ws + OFF_A);

#define RUN(rep, ...) for (int rep_i = 0; rep_i < (rep); ++rep_i) { __VA_ARGS__; GBAR(); }
    for (int rep_i = 0; rep_i < REP_PREP; ++rep_i) { phase_prep(P, lds); grid.sync(); }
    if (threadIdx.x == 0) {
        unsigned* bar = (unsigned*)(P.ws + OFF_BAR);
        unsigned nact = 0, pos = 0, mine = 1;
        for (unsigned j = 0; j < 16; ++j) { const unsigned cn = xb_ld(&bar[XB_XCNT(j)]); if (cn) { if (j < xbar.x) ++pos; ++nact; } if (j == xbar.x) mine = cn; }
        xbst[3] = nact ? nact : 1u; xbst[4] = pos; xbst[5] = mine ? mine : 1u;
    }
    __syncthreads();
    XGeo geo; geo.rank = __builtin_amdgcn_readfirstlane((int)xbst[2]); geo.nact = __builtin_amdgcn_readfirstlane((int)xbst[3]); geo.pos = __builtin_amdgcn_readfirstlane((int)xbst[4]); geo.nloc = __builtin_amdgcn_readfirstlane((int)xbst[5]);
    RUN(REP_MOD, phase_modulate<0>(P, 0, 0, NT))
    RUN(REP_POOL, phase_pool(P, lds))
    RUN(REP_MOD, phase_modulate<1>(P, 0, 1, NT, true))
    RUN(REP_GEMM, { pg8::Gemm g{Abuf, (const bf16_t*)(P.ws + OFF_WQT), NT, 2048, 1024}; pg8::StaticOrder S; S.init(NT, 2048, gridDim.x, blockIdx.x); pg8::EpiQ e{(bf16_t*)(P.ws + OFF_R1), 2048}; pg8::gemm_phase<pg8::EpiQ, pg8::StaticOrder, true, true>(lds, g, S, e); })
    RUN(REP_TOPK, phase_topk(P, 0, NT, lds))
    phase_experts_u(P, 0, NT, lds); GBAR();
    phase_experts_sliced<2>(P, 0, NT, geo); GBAR();
    RUN(REP_MOD, phase_modulate<1>(P, 1, 0, NT))
    RUN(REP_GEMM, { pg8::Gemm g{Abuf, (const bf16_t*)(P.ws + OFF_WINT), NT, 4352, 1024}; pg8::StaticOrder S; S.init(NT, 4352, gridDim.x, blockIdx.x);
      pg8::EpiWinP e{(bf16_t*)(P.ws + OFF_R1), (bf16_t*)(P.ws + OFF_PZ), (float*)(P.ws + OFF_AB)}; pg8::gemm_phase<pg8::EpiWinP, pg8::StaticOrder, true, true>(lds, g, S, e); })
    RUN(REP_CONV, phase_conv(P))
    RUN(REP_CHUNK, phase_chunk(P, lds))
    RUN(REP_SCAN, phase_scan(P, lds))
    RUN(REP_DNOUT, phase_dnout(P))
    { pg8::Gemm g{Abuf, (const bf16_t*)(P.ws + OFF_WOUTT), NX, 1024, 1024}; pg8::StaticOrder S; S.init(NX, 1024, gridDim.x, blockIdx.x); pg8::EpiRes e{(bf16_t*)(P.ws + OFF_H), modv + 9 * 6144 + 2048}; pg8::gemm_phase<pg8::EpiRes, pg8::StaticOrder, false, true>(lds, g, S, e); }
    GBAR();
    RUN(REP_MOD, phase_modulate<1>(P, 1, 1, NX, true))
    RUN(REP_GEMM, { pg8::Gemm g{Abuf, (const bf16_t*)(P.ws + OFF_WQT) + (size_t)2048 * 1024, NX, 2048, 1024}; pg8::StaticOrder S; S.init(NX, 2048, gridDim.x, blockIdx.x); pg8::EpiQ e{(bf16_t*)(P.ws + OFF_R1), 2048}; pg8::gemm_phase<pg8::EpiQ, pg8::StaticOrder, true, true>(lds, g, S, e); })
    RUN(REP_TOPK, phase_topk(P, 1, NX, lds))
    phase_experts_u(P, 1, NX, lds); GBAR();
    phase_experts_sliced<2>(P, 1, NX, geo); GBAR();
    phase_final(P);
}

extern "C" void kernel_launch(void* const* d_in, const int* in_sizes, int n_in, void* d_out, int out_size, void* d_ws, size_t ws_size, hipStream_t stream) {
    static int grid_blocks = 0;
    if (grid_blocks == 0) {
        if (n_in != 21 || out_size != NX * D || ws_size < WS_END) {
            fprintf(stderr, "kernel_launch: unexpected shapes: n_in %d out %d ws %zu (need %zu)\n", n_in, out_size, ws_size, (size_t)WS_END);
            grid_blocks = -1; return;
        }
        int dev = 0, cus = 0, per_cu = 0;
        hipGetDevice(&dev);
        hipDeviceGetAttribute(&cus, hipDeviceAttributeMultiprocessorCount, dev);
        hipOccupancyMaxActiveBlocksPerMultiprocessor(&per_cu, fwd_megakernel, NTHREADS, 0);
        if (per_cu < 1) { fprintf(stderr, "kernel_launch: occupancy query reports %d blocks per CU\n", per_cu); grid_blocks = -1; return; }
        grid_blocks = cus;
    }
    if (grid_blocks < 0) return;
    if (hipMemsetAsync((char*)d_ws + OFF_BAR, 0, XCD_BAR_WORDS * 4, stream) != hipSuccess) { fprintf(stderr, "kernel_launch: memset of barrier words failed\n"); return; }
    Params p{};
    const float** pp = (const float**)&p;
    for (int i = 0; i < 21; ++i) pp[i] = (const float*)d_in[i];
    p.out = (float*)d_out; p.ws = (unsigned char*)d_ws;
    void* args[] = {&p};
    hipError_t e = hipLaunchCooperativeKernel((void*)fwd_megakernel, dim3(grid_blocks), dim3(NTHREADS), args, 0, stream);
    if (e != hipSuccess) fprintf(stderr, "cooperative launch failed: %s (grid %d)\n", hipGetErrorString(e), grid_blocks);
}
```

```cpp
#include <hip/hip_runtime.h>
#include <hip/hip_cooperative_groups.h>
#include <cstdio>
#include <cstdint>
namespace cg = cooperative_groups;

#define DEV __device__ __forceinline__
typedef unsigned short bf16_t;
typedef short bf16x8 __attribute__((ext_vector_type(8)));
typedef float f32x4 __attribute__((ext_vector_type(4)));
typedef float f32x16 __attribute__((ext_vector_type(16)));
typedef unsigned u32x4 __attribute__((ext_vector_type(4)));
typedef unsigned u32x2 __attribute__((ext_vector_type(2)));
#define LAS __attribute__((address_space(3)))
typedef LAS unsigned char* ldsp;
DEV int tid_fresh() { int t = threadIdx.x; asm volatile("" : "+v"(t)); return t; }
DEV ldsp launder(ldsp p) { asm volatile("" : "+v"(p)); return p; }

constexpr int D = 1024, NB = 8, SEQ = 2048, CTX = 256;
constexpr int NX = NB * SEQ, NC = NB * CTX, NT = NX + NC;
constexpr int NTHREADS = 512;
constexpr float EPS = 1e-6f;
#ifndef REP_PREP
#define REP_PREP 1
#endif
#ifndef REP_MOD
#define REP_MOD 1
#endif
#ifndef REP_POOL
#define REP_POOL 1
#endif
#ifndef REP_GEMM
#define REP_GEMM 1
#endif
#ifndef REP_TOPK
#define REP_TOPK 1
#endif
#ifndef REP_CONV
#define REP_CONV 1
#endif
#ifndef REP_CHUNK
#define REP_CHUNK 1
#endif
#ifndef REP_SCAN
#define REP_SCAN 1
#endif
#ifndef REP_DNOUT
#define REP_DNOUT 1
#endif

constexpr size_t MiB = 1024 * 1024;
constexpr size_t TAB_ELEMS = (size_t)16384 * 1024;
constexpr size_t OFF_TAB   = 0;
constexpr size_t OFF_WQT   = 128 * MiB;
constexpr size_t OFF_WINT  = OFF_WQT + 8 * MiB;
constexpr size_t OFF_WOUTT = OFF_WINT + (size_t)4352 * 1024 * 2;
constexpr size_t OFF_POOLT = OFF_WOUTT + 2 * MiB;
constexpr size_t OFF_KEYS  = OFF_POOLT + 512 * 1024;
constexpr size_t OFF_MODV  = OFF_KEYS + 1 * MiB;
constexpr size_t OFF_HC    = OFF_MODV + 512 * 1024;
constexpr size_t OFF_SELI  = OFF_HC + 8 * MiB;
constexpr size_t OFF_SELG  = OFF_SELI + (size_t)NT * 128 * 4;
constexpr size_t OFF_AB    = OFF_SELG + (size_t)NT * 128 * 4;
constexpr size_t OFF_G     = OFF_AB + (size_t)NT * 32 * 4;
constexpr size_t OFF_BETA  = OFF_G + (size_t)2 * NT * 8 * 4;
constexpr size_t OFF_GC    = OFF_BETA + (size_t)2 * NT * 8 * 4;
constexpr size_t OFF_QC    = OFF_GC + (size_t)4608 * 64 * 4;
constexpr size_t OFF_KC    = OFF_QC + (size_t)NT * 1024 * 2;
constexpr size_t OFF_VC    = OFF_KC + (size_t)NT * 1024 * 2;
constexpr size_t OFF_A     = OFF_VC + (size_t)NT * 1024 * 2;
constexpr size_t OFF_R1    = OFF_A + (size_t)NT * 1024 * 2;
constexpr size_t OFF_PZ    = OFF_R1 + (size_t)NT * 3072 * 2;
constexpr size_t OFF_BAR   = OFF_R1 + (size_t)NT * 4096 * 2;
constexpr size_t OFF_H     = OFF_BAR + 16384;
constexpr size_t OFF_XS    = OFF_H + (size_t)NT * 1024 * 2;
constexpr size_t OFF_RSC   = OFF_XS + (size_t)NT * 4;
constexpr size_t WS_END    = OFF_RSC + (size_t)4 * 16384 * 4;
constexpr size_t OFF_WBUF  = OFF_A;
constexpr size_t OFF_UBUF  = OFF_A + (size_t)4608 * 8192 * 2;
constexpr size_t OFF_OBUF  = OFF_TAB + 64 * MiB;
constexpr size_t OFF_PART  = OFF_QC;
constexpr size_t OFF_WEXP  = OFF_QC + (size_t)8 * NT * 128 * 4;
constexpr size_t OFF_A8    = OFF_WEXP + (size_t)NT * 128 * 4;
static_assert(OFF_UBUF + (size_t)4608 * 8192 * 2 <= OFF_PZ, "w/u overlay must not reach Pz");
static_assert(OFF_A8 + (size_t)NT * 1024 <= OFF_A, "PEER partial buffers must fit the q/k/v conv region");

struct Params {
    const float *x, *c, *ctx, *c_ctx, *mod_w, *mod_b, *norm1_g, *norm2_g, *pool_w, *pool_scale;
    const float *dn_w_in, *dn_conv_w, *dn_a_log, *dn_dt_bias, *dn_norm_g, *dn_w_out;
    const float *peer_wq, *peer_keys, *peer_u, *peer_v, *final_g;
    float* out; unsigned char* ws;
};

DEV bf16_t f2bf(float f) { return __builtin_bit_cast(unsigned short, (__bf16)f); }
DEV float bf2f(bf16_t h) { return __uint_as_float(((unsigned)h) << 16); }
typedef float f32x2_t __attribute__((ext_vector_type(2)));
typedef __bf16 bf16x2_t __attribute__((ext_vector_type(2)));
DEV unsigned pk2(float a, float b) { const f32x2_t v = {a, b}; const bf16x2_t r = __builtin_convertvector(v, bf16x2_t); return __builtin_bit_cast(unsigned, r); }
DEV float bflo(unsigned u) { return __uint_as_float(u << 16); }
DEV float bfhi(unsigned u) { return __uint_as_float(u & 0xffff0000u); }
DEV float wave_sum(float v) {
#pragma unroll
    for (int o = 32; o >= 1; o >>= 1) v += __shfl_xor(v, o);
    return v;
}
DEV float wave_max(float v) {
#pragma unroll
    for (int o = 32; o >= 1; o >>= 1) v = fmaxf(v, __shfl_xor(v, o));
    return v;
}
DEV float sum16(float v) {
#pragma unroll
    for (int o = 8; o >= 1; o >>= 1) v += __shfl_xor(v, o);
    return v;
}
DEV f32x16 mfma32(bf16x8 a, bf16x8 b, f32x16 c) { return __builtin_amdgcn_mfma_f32_32x32x16_bf16(a, b, c, 0, 0, 0); }
DEV int crow(int reg, int lane) { return (reg & 3) + 8 * (reg >> 2) + 4 * (lane >> 5); }
DEV f32x16 zero16() { f32x16 z;
#pragma unroll
    for (int i = 0; i < 16; ++i) z[i] = 0.f; return z; }
DEV bf16_t* hrow(const Params& P, int r) { return (bf16_t*)(P.ws + OFF_H) + (size_t)r * 1024; }
DEV float silu(float v) { return v * __builtin_amdgcn_rcpf(1.f + __expf(-v)); }

DEV bf16x8 frag_row(const LAS bf16_t* m, int ld, int r0, int k0, int lane) {
    return *(const LAS bf16x8*)(m + (r0 + (lane & 31)) * ld + k0 + 8 * (lane >> 5));
}
DEV bf16x8 frag_col(const LAS bf16_t* m, int ld, int c0, int k0, int lane) {
    bf16x8 f;
#pragma unroll
    for (int j = 0; j < 8; ++j) f[j] = (short)m[(k0 + 8 * (lane >> 5) + j) * ld + c0 + (lane & 31)];
    return f;
}

typedef short s16x4 __attribute__((ext_vector_type(4)));
DEV s16x4 ds_tr16(ldsp p) { return __builtin_amdgcn_ds_read_tr16_b64_v4i16((LAS s16x4*)p); }
DEV bf16x8 frag_col_tr(const LAS bf16_t* m, int ld, int c0, int k0, int lane) {
    const int gi = lane >> 4, li = lane & 15, q = li >> 2, pc = li & 3, h = gi >> 1;
    const LAS bf16_t* p = m + (k0 + 8 * h + q) * ld + c0 + 16 * (gi & 1) + 4 * pc;
    const s16x4 lo = ds_tr16((ldsp)p), hi = ds_tr16((ldsp)(p + 4 * ld));
    bf16x8 f; f[0] = lo[0]; f[1] = lo[1]; f[2] = lo[2]; f[3] = lo[3]; f[4] = hi[0]; f[5] = hi[1]; f[6] = hi[2]; f[7] = hi[3];
    return f;
}
DEV void p0_convert_item(const float* src, bf16_t* dst, size_t base) {
    const int tid = tid_fresh();
#pragma unroll
    for (int it = 0; it < 8; ++it) {
        const size_t e = base + ((size_t)it * NTHREADS + tid) * 8;
        const f32x4 a = *(const f32x4*)(src + e), b = *(const f32x4*)(src + e + 4);
        u32x4 o; o.x = pk2(a.x, a.y); o.y = pk2(a.z, a.w); o.z = pk2(b.x, b.y); o.w = pk2(b.z, b.w);
        *(u32x4*)(dst + e) = o;
    }
}
DEV void p0_table_item(const float* src, unsigned char* dst, float* rscale, int row0, bool as_int8) {
    const int tid = tid_fresh(), wave = tid >> 6, lane = tid & 63;
#pragma unroll 8
    for (int rr = 0; rr < 16; ++rr) {
        const int e = row0 + wave * 16 + rr;
        f32x4 v[4]; float am = 0.f;
#pragma unroll
        for (int q = 0; q < 4; ++q) { v[q] = __builtin_nontemporal_load((const f32x4*)(src + (size_t)e * 1024 + 256 * q + 4 * lane));
            am = fmaxf(am, fmaxf(fmaxf(fabsf(v[q].x), fabsf(v[q].y)), fmaxf(fabsf(v[q].z), fabsf(v[q].w)))); }
        am = wave_max(am);
        if (as_int8) {
            float ssq = 0.f;
#pragma unroll
            for (int q = 0; q < 4; ++q) ssq += v[q].x * v[q].x + v[q].y * v[q].y + v[q].z * v[q].z + v[q].w * v[q].w;
            ssq = wave_sum(ssq);
            const float top = fminf(am, 2.7f * sqrtf(ssq * (1.f / 1024.f)));
            am = top;
            const float sc = am > 0.f ? 7.f / am : 0.f;
#pragma unroll
            for (int q = 0; q < 4; ++q) {
                const int n0 = (int)fminf(fmaxf(rintf(v[q].x * sc), -7.f), 7.f) + 8, n1 = (int)fminf(fmaxf(rintf(v[q].y * sc), -7.f), 7.f) + 8;
                const int n2 = (int)fminf(fmaxf(rintf(v[q].z * sc), -7.f), 7.f) + 8, n3 = (int)fminf(fmaxf(rintf(v[q].w * sc), -7.f), 7.f) + 8;
                *(unsigned short*)(dst + ((size_t)q * 16384 + e) * 128 + 2 * lane) = (unsigned short)(n0 | (n1 << 4) | (n2 << 8) | (n3 << 12));
            }
            if (lane == 0) rscale[e] = am * (1.f / 7.f);
        } else {
            float ssq = 0.f;
#pragma unroll
            for (int q = 0; q < 4; ++q) ssq += v[q].x * v[q].x + v[q].y * v[q].y + v[q].z * v[q].z + v[q].w * v[q].w;
            ssq = wave_sum(ssq);
            const float top = fminf(am, 2.8f * sqrtf(ssq * (1.f / 1024.f)));
            const float sc = top > 0.f ? 6.f / top : 0.f;
#pragma unroll
            for (int q = 0; q < 4; ++q) {
                const float x0 = fminf(fmaxf(v[q].x * sc, -6.f), 6.f), x1 = fminf(fmaxf(v[q].y * sc, -6.f), 6.f), x2 = fminf(fmaxf(v[q].z * sc, -6.f), 6.f), x3 = fminf(fmaxf(v[q].w * sc, -6.f), 6.f);
                unsigned w = __builtin_amdgcn_cvt_scalef32_pk_fp4_f32(0u, x0, x1, 1.0f, 0);
                w = __builtin_amdgcn_cvt_scalef32_pk_fp4_f32(w, x2, x3, 1.0f, 1);
                *(unsigned short*)(dst + ((size_t)q * 16384 + e) * 128 + 2 * lane) = (unsigned short)(w & 0xffffu);
            }
            if (lane == 0) rscale[e] = top * (1.f / 6.f);
        }
    }
}
DEV void p0_transpose_item(const float* W, int K, int N, bf16_t* Wt, int kt, int nt, LAS float* tile) {
    const int tid = tid_fresh(), k0 = kt * 64, n0 = nt * 256;
    f32x4 v[8];
#pragma unroll
    for (int p = 0; p < 8; ++p) {
        const int kk = p * 8 + (tid >> 6), nn = (tid & 63) * 4, n = n0 + nn;
        v[p] = (f32x4){0.f, 0.f, 0.f, 0.f};
        if (n < N) v[p] = __builtin_nontemporal_load((const f32x4*)(W + (size_t)(k0 + kk) * N + n));
    }
#pragma unroll
    for (int p = 0; p < 8; ++p) {
        const int kk = p * 8 + (tid >> 6), nn = (tid & 63) * 4;
        tile[kk * 257 + nn + 0] = v[p].x; tile[kk * 257 + nn + 1] = v[p].y; tile[kk * 257 + nn + 2] = v[p].z; tile[kk * 257 + nn + 3] = v[p].w;
    }
    __syncthreads();
#pragma unroll
    for (int q = 0; q < 4; ++q) {
        const int n = q * 64 + (tid >> 3), kc = (tid & 7) * 8;
        u32x4 o;
        o.x = pk2(tile[(kc + 0) * 257 + n], tile[(kc + 1) * 257 + n]);
        o.y = pk2(tile[(kc + 2) * 257 + n], tile[(kc + 3) * 257 + n]);
        o.z = pk2(tile[(kc + 4) * 257 + n], tile[(kc + 5) * 257 + n]);
        o.w = pk2(tile[(kc + 6) * 257 + n], tile[(kc + 7) * 257 + n]);
        *(u32x4*)(Wt + (size_t)(n0 + n) * K + k0 + kc) = o;
    }
    __syncthreads();
}
DEV void p0_mod_item(const Params& P, int i, int cb, LAS float* lds) {
    LAS float* s = lds;
    LAS float* red = lds + 9 * 1024;
    const int tid = tid_fresh();
    for (int e = tid; e < 9 * 1024; e += NTHREADS) {
        const int m = e >> 10, k = e & 1023;
        const float cv = m < 8 ? P.c[m * 1024 + k] : P.c_ctx[k];
        s[e] = silu(cv);
    }
    __syncthreads();
    const int cq = tid & 31, kg = tid >> 5;
    const float* W = P.mod_w + (size_t)i * 1024 * 6144 + cb * 128 + cq * 4;
    f32x4 acc[9];
#pragma unroll
    for (int m = 0; m < 9; ++m) acc[m] = (f32x4){0.f, 0.f, 0.f, 0.f};
#pragma unroll 16
    for (int kk = 0; kk < 64; ++kk) {
        const int k = kg * 64 + kk;
        const f32x4 w = __builtin_nontemporal_load((const f32x4*)(W + (size_t)k * 6144));
#pragma unroll
        for (int m = 0; m < 9; ++m) { const float sv = s[m * 1024 + k]; acc[m] += w * sv; }
    }
#pragma unroll
    for (int m = 0; m < 9; ++m) *(LAS f32x4*)&red[(kg * 9 + m) * 128 + cq * 4] = acc[m];
    __syncthreads();
    float* modv = (float*)(P.ws + OFF_MODV);
    for (int e = tid; e < 9 * 128; e += NTHREADS) {
        const int m = e >> 7, col = e & 127;
        float sum = 0.f;
#pragma unroll
        for (int g = 0; g < 16; ++g) sum += red[(g * 9 + m) * 128 + col];
        modv[(size_t)(i * 9 + m) * 6144 + cb * 128 + col] = sum + P.mod_b[i * 6144 + cb * 128 + col];
    }
    __syncthreads();
}
DEV void phase_prep(const Params& P, ldsp lds0) {
    constexpr int N_MOD = 96, N_WQ = 2 * 16 * 8, N_WIN = 16 * 17, N_WOUT = 16 * 4, N_POOL = 4 * 4;
    constexpr int N_TR = N_WQ + N_WIN + N_WOUT + N_POOL, N_TAB = 4 * 128, N_KEYS = 16;
    constexpr int TOTAL = N_MOD + N_TR + N_TAB + N_KEYS;
    for (int item = blockIdx.x; item < TOTAL; item += gridDim.x) {
        LAS float* lds = (LAS float*)launder(lds0);
        int r = item;
        if (r < N_MOD) { p0_mod_item(P, r / 48, r % 48, lds); continue; }
        r -= N_MOD;
        if (r < N_WQ) { const int i = r / 128, t = r % 128;
            p0_transpose_item(P.peer_wq + (size_t)i * 1024 * 2048, 1024, 2048, (bf16_t*)(P.ws + OFF_WQT) + (size_t)i * 2048 * 1024, t / 8, t % 8, lds); continue; }
        r -= N_WQ;
        if (r < N_WIN) { p0_transpose_item(P.dn_w_in, 1024, 4128, (bf16_t*)(P.ws + OFF_WINT), r / 17, r % 17, lds); continue; }
        r -= N_WIN;
        if (r < N_WOUT) { p0_transpose_item(P.dn_w_out, 1024, 1024, (bf16_t*)(P.ws + OFF_WOUTT), r / 4, r % 4, lds); continue; }
        r -= N_WOUT;
        if (r < N_POOL) { const int g = r / 4, t = r % 4;
            p0_transpose_item(P.pool_w + (size_t)g * 65536, 256, 256, (bf16_t*)(P.ws + OFF_POOLT) + (size_t)g * 65536, t, 0, lds); continue; }
        r -= N_POOL;
        if (r < N_TAB) { const int tb = r / 128, ch = r % 128;
            const float* src = ((tb & 1) ? P.peer_v : P.peer_u) + (size_t)(tb >> 1) * TAB_ELEMS;
            p0_table_item(src, P.ws + OFF_TAB + (size_t)tb * 16 * MiB, (float*)(P.ws + OFF_RSC) + tb * 16384, ch * 128, (tb & 1) == 0); continue; }
        r -= N_TAB;
        p0_convert_item(P.peer_keys, (bf16_t*)(P.ws + OFF_KEYS), (size_t)r * 32768);
    }
}

template <int SRC>
DEV void phase_modulate(const Params& P, int layer, int which, int nrows, bool q8 = false) {
    const float* gain = (which ? P.norm2_g : P.norm1_g) + layer * 1024;
    const float* modv = (const float*)(P.ws + OFF_MODV) + (size_t)layer * 9 * 6144;
    bf16_t* A = (bf16_t*)(P.ws + OFF_A);
    const int tid = tid_fresh(); const int wave = tid >> 6, lane = tid & 63;
    for (int r = blockIdx.x * 8 + wave; r < nrows; r += gridDim.x * 8) {
        const int m = r < NX ? (r >> 11) : 8;
        const float* sh = modv + m * 6144 + which * 3072;
        const float* sc = sh + 1024;
        f32x4 v[4]; float ss = 0.f;
#pragma unroll
        for (int j = 0; j < 4; ++j) {
            if (SRC == 0) { const float* src = r < NX ? P.x + (size_t)r * 1024 : P.ctx + (size_t)(r - NX) * 1024; v[j] = *(const f32x4*)(src + j * 256 + lane * 4); }
            else { const u32x2 hv = *(const u32x2*)(hrow(P, r) + j * 256 + lane * 4); v[j] = (f32x4){bflo(hv.x), bfhi(hv.x), bflo(hv.y), bfhi(hv.y)}; }
            ss += v[j].x * v[j].x + v[j].y * v[j].y + v[j].z * v[j].z + v[j].w * v[j].w;
        }
        ss = wave_sum(ss);
        const float rstd = rsqrtf(ss * (1.f / 1024.f) + EPS);
#pragma unroll
        for (int j = 0; j < 4; ++j) {
            const int col = j * 256 + lane * 4;
            const f32x4 g = *(const f32x4*)(gain + col), s1 = *(const f32x4*)(sc + col), s0 = *(const f32x4*)(sh + col);
            const f32x4 y = v[j] * rstd * g * (1.f + s1) + s0;
            u32x2 o; o.x = pk2(y.x, y.y); o.y = pk2(y.z, y.w);
            *(u32x2*)(A + (size_t)r * 1024 + col) = o;
            v[j] = y;
        }
        if (q8) {
            float am = 0.f;
#pragma unroll
            for (int j = 0; j < 4; ++j) am = fmaxf(am, fmaxf(fmaxf(fabsf(v[j].x), fabsf(v[j].y)), fmaxf(fabsf(v[j].z), fabsf(v[j].w))));
            am = wave_max(am);
            const float sc = am > 0.f ? 127.f / am : 0.f;
            unsigned char* a8 = P.ws + OFF_A8 + (size_t)r * 1024;
#pragma unroll
            for (int j = 0; j < 4; ++j) {
                const int b0 = (int)rintf(v[j].x * sc), b1 = (int)rintf(v[j].y * sc), b2 = (int)rintf(v[j].z * sc), b3 = (int)rintf(v[j].w * sc);
                const unsigned mine = (unsigned)((b0 & 255) | ((b1 & 255) << 8) | ((b2 & 255) << 16) | ((b3 & 255) << 24));
                const unsigned other = (unsigned)__shfl_xor((int)mine, 1);
                const unsigned lo4 = (lane & 1) ? other : mine, hi4 = (lane & 1) ? mine : other;
                const unsigned outw = (lane & 1) ? __builtin_amdgcn_perm(hi4, lo4, 0x07050301u) : __builtin_amdgcn_perm(hi4, lo4, 0x06040200u);
                *(unsigned*)(a8 + j * 256 + lane * 4) = outw;
            }
            if (lane == 0) ((float*)(P.ws + OFF_XS))[r] = am * (1.f / 127.f);
        }
    }
}

DEV void unpack8(const u32x4 v, float* f) {
    f[0] = bflo(v.x); f[1] = bfhi(v.x); f[2] = bflo(v.y); f[3] = bfhi(v.y); f[4] = bflo(v.z); f[5] = bfhi(v.z); f[6] = bflo(v.w); f[7] = bfhi(v.w);
}
template <int W>
DEV void pool_vertical(const bf16_t* A0, LAS float* V, int b, int r, int cbase, int tq, int ch8, float (&cen)[4][8]) {
    const int rlo = max(0, r - W / 2), rhi = min(32, r - W / 2 + W);
    const float inv = 1.f / (float)(rhi - rlo);
#pragma unroll
    for (int jh = 0; jh < 2; ++jh) {
        u32x4 ld[2][W];
#pragma unroll
        for (int jj = 0; jj < 2; ++jj)
#pragma unroll
            for (int k = 0; k < W; ++k) {
                const int rr = min(rlo + k, 31), tok = tq + 16 * (2 * jh + jj);
                ld[jj][k] = *(const u32x4*)(A0 + ((size_t)b * 2048 + rr * 64 + tok) * 1024 + cbase);
            }
#pragma unroll
        for (int jj = 0; jj < 2; ++jj) {
            const int j = 2 * jh + jj, tok = tq + 16 * j;
            float acc[8];
#pragma unroll
            for (int e = 0; e < 8; ++e) acc[e] = 0.f;
#pragma unroll
            for (int k = 0; k < W; ++k) {
                float f[8]; unpack8(ld[jj][k], f);
                const bool in = rlo + k < rhi;
#pragma unroll
                for (int e = 0; e < 8; ++e) acc[e] += in ? f[e] : 0.f;
                if (rlo + k == r) {
#pragma unroll
                    for (int e = 0; e < 8; ++e) cen[j][e] = f[e];
                }
            }
            LAS float* vp = V + (tok + 8) * 260 + ch8 * 8;
            *(LAS f32x4*)vp = (f32x4){acc[0] * inv, acc[1] * inv, acc[2] * inv, acc[3] * inv};
            *(LAS f32x4*)(vp + 4) = (f32x4){acc[4] * inv, acc[5] * inv, acc[6] * inv, acc[7] * inv};
        }
    }
}
template <int W>
DEV void pool_horizontal(const LAS float* V, ldsp At, bool isx, int seg, int tq, int ch8, const float (&cen)[4][8]) {
#pragma unroll
    for (int j = 0; j < 4; ++j) {
        const int tok = tq + 16 * j;
        const int pos = isx ? tok : 64 * seg + tok, lim = isx ? 64 : 256, off = isx ? 8 : 8 - 64 * seg;
        const int lo = max(0, pos - W / 2), hi = min(lim, pos - W / 2 + W);
        f32x4 s0 = {0.f, 0.f, 0.f, 0.f}, s1 = {0.f, 0.f, 0.f, 0.f};
#pragma unroll
        for (int k = 0; k < W; ++k) {
            const int t = min(lo + k, lim - 1);
            const LAS float* vp = V + (t + off) * 260 + ch8 * 8;
            const f32x4 a = *(const LAS f32x4*)vp, b2 = *(const LAS f32x4*)(vp + 4);
            const float m = (lo + k < hi) ? 1.f : 0.f;
            s0 += a * m; s1 += b2 * m;
        }
        const float inv = 1.f / (float)(hi - lo);
        u32x4 o;
        o.x = pk2(s0.x * inv - cen[j][0], s0.y * inv - cen[j][1]);
        o.y = pk2(s0.z * inv - cen[j][2], s0.w * inv - cen[j][3]);
        o.z = pk2(s1.x * inv - cen[j][4], s1.y * inv - cen[j][5]);
        o.w = pk2(s1.z * inv - cen[j][6], s1.w * inv - cen[j][7]);
        *(LAS u32x4*)(At + tok * 512 + ((ch8 ^ (tok & 7)) << 4)) = o;
    }
}
DEV void phase_pool(const Params& P, ldsp lds0) {
    const bf16_t* A0 = (const bf16_t*)(P.ws + OFF_A);
    const float* modv = (const float*)(P.ws + OFF_MODV);
    const bf16_t* Wt = (const bf16_t*)(P.ws + OFF_POOLT);
    const int tid = tid_fresh(), lane = tid & 63, wave = tid >> 6;
    const int ch8 = tid & 31, tq = tid >> 5;
    for (int item = blockIdx.x; item < 1152; item += gridDim.x) {
        const ldsp lds = launder(lds0);
        LAS float* V = (LAS float*)lds;
        const ldsp At = lds + 80 * 260 * 4;
        const bool isx = item < 1024;
        int b, r = 0, seg = 0, g;
        if (isx) { b = item >> 7; r = (item >> 2) & 31; }
        else { const int it = item - 1024; b = it >> 4; seg = (it >> 2) & 3; }
        g = ((item & 3) + (item >> 8)) & 3;
        const int cbase = g * 256 + ch8 * 8;
        float cen[4][8];
        if (isx) {
            if (g == 0) pool_vertical<2>(A0, V, b, r, cbase, tq, ch8, cen);
            else if (g == 1) pool_vertical<4>(A0, V, b, r, cbase, tq, ch8, cen);
            else if (g == 2) pool_vertical<8>(A0, V, b, r, cbase, tq, ch8, cen);
            else pool_vertical<16>(A0, V, b, r, cbase, tq, ch8, cen);
        } else {
            for (int q = tq; q < 80; q += 16) {
                const int t = 64 * seg - 8 + q;
                if (t >= 0 && t < 256) {
                    const u32x4 pv = *(const u32x4*)(A0 + ((size_t)NX + b * 256 + t) * 1024 + cbase);
                    float f[8]; unpack8(pv, f);
                    LAS float* vp = V + q * 260 + ch8 * 8;
                    *(LAS f32x4*)vp = (f32x4){f[0], f[1], f[2], f[3]};
                    *(LAS f32x4*)(vp + 4) = (f32x4){f[4], f[5], f[6], f[7]};
                }
            }
#pragma unroll
            for (int j = 0; j < 4; ++j) {
                const int tok = tq + 16 * j;
                const u32x4 pv = *(const u32x4*)(A0 + ((size_t)NX + b * 256 + 64 * seg + tok) * 1024 + cbase);
                unpack8(pv, cen[j]);
            }
        }
        __syncthreads();
        if (g == 0) pool_horizontal<2>(V, At, isx, seg, tq, ch8, cen);
        else if (g == 1) pool_horizontal<4>(V, At, isx, seg, tq, ch8, cen);
        else if (g == 2) pool_horizontal<8>(V, At, isx, seg, tq, ch8, cen);
        else pool_horizontal<16>(V, At, isx, seg, tq, ch8, cen);
        __syncthreads();
        f32x16 acc[2]; acc[0] = zero16(); acc[1] = zero16();
        const bf16_t* Wg = Wt + (size_t)g * 65536 + (size_t)(32 * wave + (lane & 31)) * 256 + (lane >> 5) * 8;
#pragma unroll 4
        for (int ks = 0; ks < 16; ++ks) {
            const bf16x8 wfr = *(const bf16x8*)(Wg + ks * 16);
            const int ch = ks * 2 + (lane >> 5);
#pragma unroll
            for (int mt = 0; mt < 2; ++mt) {
                const int row = mt * 32 + (lane & 31);
                const bf16x8 a = *(const LAS bf16x8*)(At + row * 512 + ((ch ^ (row & 7)) << 4));
                acc[mt] = mfma32(wfr, a, acc[mt]);
            }
        }
        const int m = isx ? b : 8;
#pragma unroll
        for (int mt = 0; mt < 2; ++mt)
#pragma unroll
            for (int rg = 0; rg < 4; ++rg) {
                const int tok = mt * 32 + (lane & 31), col = g * 256 + 32 * wave + 8 * rg + 4 * (lane >> 5);
                const f32x4 gs = *(const f32x4*)(modv + m * 6144 + 2048 + col) * *(const f32x4*)(P.pool_scale + col);
                const f32x4 av = {acc[mt][rg * 4 + 0], acc[mt][rg * 4 + 1], acc[mt][rg * 4 + 2], acc[mt][rg * 4 + 3]};
                f32x4 hv; int grow;
                if (isx) { grow = b * 2048 + r * 64 + tok; hv = __builtin_nontemporal_load((const f32x4*)(P.x + (size_t)grow * 1024 + col)) + gs * av; }
                else { const size_t gi = ((size_t)b * 256 + 64 * seg + tok) * 1024 + col; grow = NX + b * 256 + 64 * seg + tok; hv = *(const f32x4*)(P.ctx + gi) + gs * av; }
                u32x2 hp; hp.x = pk2(hv.x, hv.y); hp.y = pk2(hv.z, hv.w);
                *(u32x2*)(hrow(P, grow) + col) = hp;
            }
        __syncthreads();
    }
}

DEV bf16x8 frag_row_x(ldsp x, int r0, int k0, int lane) {
    const int row = r0 + (lane & 31), ch = (k0 >> 3) + (lane >> 5);
    return *(const LAS bf16x8*)(x + row * 256 + ((ch ^ (row & 15)) << 4));
}
DEV unsigned key_of(float f) { const unsigned u = __float_as_uint(f); return u ^ ((unsigned)((int)u >> 31) | 0x80000000u); }
DEV float val_of(unsigned k) { const unsigned u = (k & 0x80000000u) ? (k ^ 0x80000000u) : ~k; return __uint_as_float(u); }
DEV void cmpx(unsigned& hi, unsigned& lo) { const unsigned a = hi, b = lo; hi = a > b ? a : b; lo = a > b ? b : a; }
DEV void sort16_desc(unsigned* v) {
#pragma unroll
    for (int k = 2; k <= 16; k <<= 1)
#pragma unroll
        for (int j = k >> 1; j > 0; j >>= 1)
#pragma unroll
            for (int i = 0; i < 16; ++i) {
                const int l = i ^ j;
                if (l > i) { if ((i & k) == 0) cmpx(v[i], v[l]); else cmpx(v[l], v[i]); }
            }
}
DEV void merge16(unsigned* r, const unsigned* b) {
#pragma unroll
    for (int k = 0; k < 16; ++k) r[k] = r[k] > b[15 - k] ? r[k] : b[15 - k];
#pragma unroll
    for (int j = 8; j > 0; j >>= 1)
#pragma unroll
        for (int i = 0; i < 16; ++i) { const int l = i ^ j; if (l > i) cmpx(r[i], r[l]); }
}
DEV void top16_of_64(unsigned* v, unsigned* r) {
#pragma unroll
    for (int blk = 0; blk < 4; ++blk) sort16_desc(v + 16 * blk);
#pragma unroll
    for (int k = 0; k < 16; ++k) r[k] = v[k];
    merge16(r, v + 16); merge16(r, v + 32); merge16(r, v + 48);
}
DEV void phase_topk(const Params& P, int layer, int nrows, ldsp lds0) {
    const bf16_t* Q = (const bf16_t*)(P.ws + OFF_R1);
    const bf16_t* keys = (const bf16_t*)(P.ws + OFF_KEYS) + (size_t)layer * 8 * 2 * 128 * 128;
    bf16_t* seli = (bf16_t*)(P.ws + OFF_SELI);
    float* selg = (float*)(P.ws + OFF_SELG);
    const int tid = tid_fresh(), lane = tid & 63, wave = tid >> 6;
    const int nitems = (nrows / 256) * 4;
    const unsigned hoff = (unsigned)(lane >> 5) * 4u;
    for (int item = blockIdx.x; item < nitems; item += gridDim.x) {
        const ldsp lds = launder(lds0);
        LAS unsigned* sl = (LAS unsigned*)(lds + 65536 + wave * 8192);
        const int tg = item >> 2, hp = item & 3, row0 = tg * 256 + wave * 32;
        u32x4 kr[4]; bf16x8 qf[8];
        {
            const bf16_t* kt = keys + (size_t)((hp * 2) * 2) * 128 * 128;
#pragma unroll
            for (int j = 0; j < 4; ++j) { const int cid = tid + NTHREADS * j, r = cid >> 4, ch = cid & 15; kr[j] = *(const u32x4*)(kt + r * 128 + ch * 8); }
#pragma unroll
            for (int j = 0; j < 4; ++j) { const int cid = tid + NTHREADS * j, r = cid >> 4, ch = cid & 15; *(LAS u32x4*)(lds + r * 256 + ((ch ^ (r & 15)) << 4)) = kr[j]; }
            const bf16_t* qb = Q + (size_t)(row0 + (lane & 31)) * 2048 + (hp * 2) * 256 + (lane >> 5) * 8;
#pragma unroll
            for (int ks = 0; ks < 8; ++ks) qf[ks] = *(const bf16x8*)(qb + ks * 16);
        }
        __syncthreads();
        unsigned s1[16], s2[16];
#pragma unroll
        for (int k = 0; k < 16; ++k) { s1[k] = 0u; s2[k] = 0u; }
#pragma unroll 1
        for (int step = 0; step < 4; ++step) {
            const int hs = step >> 1, p = step & 1;
            const bool mine = (lane >> 5) == hs;
            const ldsp kb = lds + (step & 1) * 32768;
            if (step < 3) {
                const bf16_t* kt = keys + (size_t)((hp * 2 + ((step + 1) >> 1)) * 2 + ((step + 1) & 1)) * 128 * 128;
#pragma unroll
                for (int j = 0; j < 4; ++j) { const int cid = tid + NTHREADS * j, r = cid >> 4, ch = cid & 15; kr[j] = *(const u32x4*)(kt + r * 128 + ch * 8); }
            }
            f32x16 acc[4];
#pragma unroll
            for (int mt = 0; mt < 4; ++mt) acc[mt] = zero16();
#pragma unroll
            for (int ks = 0; ks < 8; ++ks)
#pragma unroll
                for (int mt = 0; mt < 4; ++mt) acc[mt] = mfma32(frag_row_x(kb, mt * 32, ks * 16, lane), qf[ks], acc[mt]);
            if (step < 3) {
                const ldsp kn = lds + ((step + 1) & 1) * 32768;
#pragma unroll
                for (int j = 0; j < 4; ++j) { const int cid = tid + NTHREADS * j, r = cid >> 4, ch = cid & 15; *(LAS u32x4*)(kn + r * 256 + ((ch ^ (r & 15)) << 4)) = kr[j]; }
                const bf16_t* qb = Q + (size_t)(row0 + (lane & 31)) * 2048 + (hp * 2 + ((step + 1) >> 1)) * 256 + ((step + 1) & 1) * 128 + (lane >> 5) * 8;
#pragma unroll
                for (int ks = 0; ks < 8; ++ks) qf[ks] = *(const bf16x8*)(qb + ks * 16);
            }
            unsigned v[64];
#pragma unroll
            for (int mt = 0; mt < 4; ++mt)
#pragma unroll
                for (int reg = 0; reg < 16; ++reg) {
                    const unsigned c = mt * 32 + (reg & 3) + 8 * (reg >> 2);
                    v[mt * 16 + reg] = ((key_of(acc[mt][reg]) & ~127u) | (127u - c)) ^ hoff;
                }
            unsigned r[16], o[16];
            top16_of_64(v, r);
#pragma unroll
            for (int k = 0; k < 16; ++k) o[k] = (unsigned)__shfl_xor((int)r[k], 32);
            merge16(r, o);
#pragma unroll
            for (int k = 0; k < 16; ++k) { if (p == 0) s1[k] = mine ? r[k] : s1[k]; else s2[k] = mine ? r[k] : s2[k]; }
            __syncthreads();
        }
        float f1[16], f2[16];
#pragma unroll
        for (int k = 0; k < 16; ++k) {
            sl[k * 64 + lane] = s1[k]; sl[(16 + k) * 64 + lane] = s2[k];
            f1[k] = val_of(s1[k] & ~127u); f2[k] = val_of(s2[k] & ~127u);
        }
        unsigned cv[64];
        {
            int n = 0;
#pragma unroll
            for (int a = 0; a < 16; ++a)
#pragma unroll
                for (int b = 0; b < 16; ++b)
                    if ((a + 1) * (b + 1) <= 16) { cv[n] = (key_of(f1[a] + f2[b]) & ~255u) | (255u - (unsigned)(a * 16 + b)); ++n; }
#pragma unroll
            for (int q = 50; q < 64; ++q) cv[q] = 0u;
        }
        unsigned w[16];
        top16_of_64(cv, w);
        float sc[16]; int ei[16];
#pragma unroll
        for (int k = 0; k < 16; ++k) {
            const unsigned ab = 255u - (w[k] & 255u);
            const unsigned k1 = sl[(ab >> 4) * 64 + lane], k2 = sl[(16 + (ab & 15u)) * 64 + lane];
            ei[k] = (int)((127u - (k1 & 127u)) * 128u + (127u - (k2 & 127u)));
            sc[k] = val_of(w[k] & ~255u);
        }
        const float mx = sc[0];
        float tot = 0.f;
#pragma unroll
        for (int k = 0; k < 16; ++k) { sc[k] = expf(sc[k] - mx); tot += sc[k]; }
        const int row = row0 + (lane & 31), head = hp * 2 + (lane >> 5);
        bf16_t* ip = seli + (size_t)row * 128 + head * 16;
        float* gp = selg + (size_t)row * 128 + head * 16;
        const float inv = 1.f / tot;
#pragma unroll
        for (int q = 0; q < 2; ++q) {
            u32x4 o;
#pragma unroll
            for (int d = 0; d < 4; ++d) o[d] = (unsigned)ei[8 * q + 2 * d] | ((unsigned)ei[8 * q + 2 * d + 1] << 16);
            *(u32x4*)(ip + 8 * q) = o;
        }
#pragma unroll
        for (int q = 0; q < 4; ++q) *(float4*)(gp + 4 * q) = make_float4(sc[4 * q] * inv, sc[4 * q + 1] * inv, sc[4 * q + 2] * inv, sc[4 * q + 3] * inv);
    }
}

struct XGeo { int nloc, rank, nact, pos; };
typedef float f32x2 __attribute__((ext_vector_type(2)));
DEV void fp8x16_to_f32(const u32x4 r, float* f) {
#pragma unroll
    for (int d = 0; d < 4; ++d) {
        const f32x2 lo = __builtin_amdgcn_cvt_pk_f32_fp8((int)r[d], false), hi = __builtin_amdgcn_cvt_pk_f32_fp8((int)r[d], true);
        f[4 * d + 0] = lo.x; f[4 * d + 1] = lo.y; f[4 * d + 2] = hi.x; f[4 * d + 3] = hi.y;
    }
}
template <int S, int MUL, class T>
DEV void bfly_stage(T* p, int lane) {
    const bool hi = (lane & (S * MUL)) != 0;
#pragma unroll
    for (int i = 0; i < 2 * S; ++i) { const T keep = hi ? p[i + 2 * S] : p[i], send = hi ? p[i] : p[i + 2 * S]; p[i] = keep + __shfl_xor(send, S * MUL); }
}
template <int STAGE>
DEV void ex_issue(u32x4 (&buf)[16], u32x4 (&aux)[4], f32x2 (&hg)[2], const u32x4 (&idn)[2], const unsigned char* slice, const Params& P, const bf16_t* A, const bf16_t* wexp,
                  const float* gatev, int t, int sl, int g, int c) {
    int id[16];
#pragma unroll
    for (int q = 0; q < 2; ++q)
#pragma unroll
        for (int d = 0; d < 4; ++d) { id[8 * q + 2 * d] = (int)(idn[q][d] & 0xffffu); id[8 * q + 2 * d + 1] = (int)(idn[q][d] >> 16); }
#pragma unroll
    for (int k = 0; k < 16; ++k) buf[k] = *(const u32x4*)(slice + (size_t)id[k] * 128);
    if (STAGE == 1) {
        aux[0] = *(const u32x4*)(P.ws + OFF_A8 + (size_t)t * 1024 + 256 * sl + 32 * c); aux[1] = *(const u32x4*)(P.ws + OFF_A8 + (size_t)t * 1024 + 256 * sl + 32 * c + 16);
        hg[0].x = ((const float*)(P.ws + OFF_XS))[t];
    } else {
#pragma unroll
        for (int q = 0; q < 2; ++q) aux[q] = *(const u32x4*)(wexp + (size_t)t * 128 + 16 * g + 8 * q);
        const int col = 256 * sl + 32 * c + 4 * g, m = t < NX ? (t >> 11) : 8;
        const u32x2 hv = *(const u32x2*)(hrow(P, t) + col);
        aux[2] = (u32x4){hv.x, hv.y, 0u, 0u};
        aux[3] = *(const u32x4*)(gatev + m * 6144 + col);
    }
}
template <int STAGE>
DEV void ex_compute(const u32x4 (&buf)[16], const u32x4 (&aux)[4], const f32x2 (&hg)[2], const Params& P, float* part, int t, int sl, int lane, int g, int c) {
    if (STAGE == 1) {
        int sx = 0;
#pragma unroll
        for (int q = 0; q < 2; ++q)
#pragma unroll
            for (int d = 0; d < 4; ++d) sx = __builtin_amdgcn_sdot4(0x01010101, (int)aux[q][d], sx, false);
        int p[16];
#pragma unroll
        for (int k = 0; k < 16; ++k) {
            int a = -8 * sx;
#pragma unroll
            for (int d = 0; d < 4; ++d) {
                const unsigned w = buf[k][d];
                a = __builtin_amdgcn_sdot4((int)(w & 0x0F0F0F0Fu), (int)aux[d >> 1][2 * (d & 1)], a, false);
                a = __builtin_amdgcn_sdot4((int)((w >> 4) & 0x0F0F0F0Fu), (int)aux[d >> 1][2 * (d & 1) + 1], a, false);
            }
            p[k] = a;
        }
        bfly_stage<4, 1>(p, lane); bfly_stage<2, 1>(p, lane); bfly_stage<1, 1>(p, lane);
        const float xs = hg[0].x;
        *(unsigned*)((bf16_t*)part + ((size_t)sl * NT + t) * 128 + 2 * lane) = pk2((float)p[0] * xs, (float)p[1] * xs);
    } else {
        f32x2 p2[16];
#pragma unroll
        for (int i = 0; i < 16; ++i) p2[i] = (f32x2){0.f, 0.f};
#pragma unroll
        for (int k = 0; k < 16; ++k) {
            const unsigned wpk = aux[k >> 3][(k >> 1) & 3];
            const float wkf = (k & 1) ? bfhi(wpk) : bflo(wpk);
            const f32x2 w2 = {wkf, wkf};
#pragma unroll
            for (int d = 0; d < 4; ++d) {
                p2[4 * d + 0] += w2 * __builtin_amdgcn_cvt_scalef32_pk_f32_fp4(buf[k][d], 1.0f, 0);
                p2[4 * d + 1] += w2 * __builtin_amdgcn_cvt_scalef32_pk_f32_fp4(buf[k][d], 1.0f, 1);
                p2[4 * d + 2] += w2 * __builtin_amdgcn_cvt_scalef32_pk_f32_fp4(buf[k][d], 1.0f, 2);
                p2[4 * d + 3] += w2 * __builtin_amdgcn_cvt_scalef32_pk_f32_fp4(buf[k][d], 1.0f, 3);
            }
            asm volatile("" : "+v"(p2[0]), "+v"(p2[1]), "+v"(p2[2]), "+v"(p2[3]), "+v"(p2[4]), "+v"(p2[5]), "+v"(p2[6]), "+v"(p2[7]),
                              "+v"(p2[8]), "+v"(p2[9]), "+v"(p2[10]), "+v"(p2[11]), "+v"(p2[12]), "+v"(p2[13]), "+v"(p2[14]), "+v"(p2[15]));
        }
        float p[32];
#pragma unroll
        for (int i = 0; i < 16; ++i) { p[2 * i] = p2[i].x; p[2 * i + 1] = p2[i].y; }
        bfly_stage<8, 4>(p, lane); bfly_stage<4, 4>(p, lane); bfly_stage<2, 4>(p, lane);
        const int col = 256 * sl + 32 * c + 4 * g;
        const unsigned h0 = aux[2].x, h1 = aux[2].y;
        u32x2 ho;
        ho.x = pk2(bflo(h0) + __uint_as_float(aux[3].x) * p[0], bfhi(h0) + __uint_as_float(aux[3].y) * p[1]);
        ho.y = pk2(bflo(h1) + __uint_as_float(aux[3].z) * p[2], bfhi(h1) + __uint_as_float(aux[3].w) * p[3]);
        *(u32x2*)(hrow(P, t) + col) = ho;
    }
}
template <int STAGE>
DEV void phase_experts_sliced(const Params& P, int layer, int nrows, const XGeo geo) {
    const unsigned char* tab = P.ws + OFF_TAB + (size_t)(layer * 2 + (STAGE - 1)) * 16 * MiB;
    const bf16_t* A = (const bf16_t*)(P.ws + OFF_A);
    const bf16_t* seli = (const bf16_t*)(P.ws + OFF_SELI);
    float* part = (float*)(P.ws + OFF_PART);
    const bf16_t* wexp = (const bf16_t*)(P.ws + OFF_WEXP);
    const float* gatev = (const float*)(P.ws + OFF_MODV) + (size_t)layer * 9 * 6144 + 5 * 1024;
    const int tid = tid_fresh(), wave = tid >> 6, lane = tid & 63, g = lane >> 3, c = lane & 7;
    const int nw = geo.nloc * 8, wr = geo.rank * 8 + wave;
    for (int vs = geo.pos; vs < 8; vs += geo.nact) {
        const int sl = vs >> 1, tmul = 2, tadd = vs & 1;
        const unsigned char* slice = tab + (size_t)sl * 2 * MiB + 16 * c;
        const int nws = nw * tmul;
        int t = wr * tmul + tadd;
        if (t >= nrows) continue;
        u32x4 bufA[16], bufB[16], auxA[4], auxB[4]; f32x2 hgA[2], hgB[2]; u32x4 idn[2];
#pragma unroll
        for (int q = 0; q < 2; ++q) idn[q] = *(const u32x4*)(seli + (size_t)t * 128 + 16 * g + 8 * q);
        ex_issue<STAGE>(bufA, auxA, hgA, idn, slice, P, A, wexp, gatev, t, sl, g, c);
        if (t + nws < nrows) {
#pragma unroll
            for (int q = 0; q < 2; ++q) idn[q] = *(const u32x4*)(seli + (size_t)(t + nws) * 128 + 16 * g + 8 * q);
        }
        for (;;) {
            {
                const int t1 = t + nws;
                if (t1 < nrows) {
                    ex_issue<STAGE>(bufB, auxB, hgB, idn, slice, P, A, wexp, gatev, t1, sl, g, c);
                    if (t1 + nws < nrows) {
#pragma unroll
                        for (int q = 0; q < 2; ++q) idn[q] = *(const u32x4*)(seli + (size_t)(t1 + nws) * 128 + 16 * g + 8 * q);
                    }
                }
                ex_compute<STAGE>(bufA, auxA, hgA, P, part, t, sl, lane, g, c);
            }
            t += nws; if (t >= nrows) break;
            {
                const int t1 = t + nws;
                if (t1 < nrows) {
                    ex_issue<STAGE>(bufA, auxA, hgA, idn, slice, P, A, wexp, gatev, t1, sl, g, c);
                    if (t1 + nws < nrows) {
#pragma unroll
                        for (int q = 0; q < 2; ++q) idn[q] = *(const u32x4*)(seli + (size_t)(t1 + nws) * 128 + 16 * g + 8 * q);
                    }
                }
                ex_compute<STAGE>(bufB, auxB, hgB, P, part, t, sl, lane, g, c);
            }
            t += nws; if (t >= nrows) break;
        }
    }
}
DEV void eu_issue_unit(u32x4 (&buf)[16], u32x4 (&xq)[2], const u32x4 (&idn)[2], const unsigned char* tab, const Params& P, int t, int sl, int c) {
    int id[16];
#pragma unroll
    for (int q = 0; q < 2; ++q)
#pragma unroll
        for (int d = 0; d < 4; ++d) { id[8 * q + 2 * d] = (int)(idn[q][d] & 0xffffu); id[8 * q + 2 * d + 1] = (int)(idn[q][d] >> 16); }
    const unsigned char* slice = tab + (size_t)sl * 2 * MiB + 16 * c;
#pragma unroll
    for (int k = 0; k < 16; ++k) buf[k] = *(const u32x4*)(slice + (size_t)id[k] * 128);
    xq[0] = *(const u32x4*)(P.ws + OFF_A8 + (size_t)t * 1024 + 256 * sl + 32 * c); xq[1] = *(const u32x4*)(P.ws + OFF_A8 + (size_t)t * 1024 + 256 * sl + 32 * c + 16);
}
DEV void eu_compute_unit(const u32x4 (&buf)[16], const u32x4 (&xq)[2], LAS float* acc2, int lane) {
    int sx = 0;
#pragma unroll
    for (int q = 0; q < 2; ++q)
#pragma unroll
        for (int d = 0; d < 4; ++d) sx = __builtin_amdgcn_sdot4(0x01010101, (int)xq[q][d], sx, false);
    int p[16];
#pragma unroll
    for (int k = 0; k < 16; ++k) {
        int a = -8 * sx;
#pragma unroll
        for (int d = 0; d < 4; ++d) {
            const unsigned w = buf[k][d];
            a = __builtin_amdgcn_sdot4((int)(w & 0x0F0F0F0Fu), (int)xq[d >> 1][2 * (d & 1)], a, false);
            a = __builtin_amdgcn_sdot4((int)((w >> 4) & 0x0F0F0F0Fu), (int)xq[d >> 1][2 * (d & 1) + 1], a, false);
        }
        p[k] = a;
    }
    bfly_stage<4, 1>(p, lane); bfly_stage<2, 1>(p, lane); bfly_stage<1, 1>(p, lane);
    f32x2 a2 = *(const LAS f32x2*)acc2;
    a2.x += (float)p[0]; a2.y += (float)p[1];
    *(LAS f32x2*)acc2 = a2;
}
DEV void phase_experts_u(const Params& P, int layer, int nrows, ldsp lds0) {
    const unsigned char* tab = P.ws + OFF_TAB + (size_t)(layer * 2) * 16 * MiB;
    const bf16_t* seli = (const bf16_t*)(P.ws + OFF_SELI);
    const float* selg = (const float*)(P.ws + OFF_SELG);
    bf16_t* wexp = (bf16_t*)(P.ws + OFF_WEXP);
    const float* rsu = (const float*)(P.ws + OFF_RSC) + (size_t)(layer * 2) * 16384;
    const float* rsv = rsu + 16384;
    const float* xsv = (const float*)(P.ws + OFF_XS);
    const int tid = tid_fresh(), wave = __builtin_amdgcn_readfirstlane(tid >> 6), lane = tid & 63, g = lane >> 3, c = lane & 7;
    const int gw = blockIdx.x * 8 + wave, nwv = gridDim.x * 8;
    if (gw >= nrows) return;
    const int ntok = (nrows - gw + nwv - 1) / nwv, U = 4 * ntok;
    LAS float* accs = (LAS float*)(launder(lds0) + wave * 8192);
    for (int k = 0; k < ntok; ++k) *(LAS f32x2*)(accs + k * 128 + 2 * lane) = (f32x2){0.f, 0.f};
    u32x4 bufA[16], bufB[16], xqA[2], xqB[2], idn[2];
    int ku = 0, slu = 0;
#define EU_NEXT_IDX() do { const int tt = gw + ku * nwv; _Pragma("unroll") for (int q = 0; q < 2; ++q) idn[q] = *(const u32x4*)(seli + (size_t)tt * 128 + 16 * g + 8 * q); } while (0)
#define EU_ADVANCE() do { if (++ku == ntok) { ku = 0; ++slu; } } while (0)
    EU_NEXT_IDX();
    int kA = ku, slA = slu; eu_issue_unit(bufA, xqA, idn, tab, P, gw + kA * nwv, slA, c); EU_ADVANCE();
    if (U > 1) EU_NEXT_IDX();
    int kB = 0, slB = 0;
    for (int u = 0; u < U; u += 2) {
        if (u + 1 < U) { kB = ku; slB = slu; eu_issue_unit(bufB, xqB, idn, tab, P, gw + kB * nwv, slB, c); EU_ADVANCE(); if (u + 2 < U) EU_NEXT_IDX(); }
        eu_compute_unit(bufA, xqA, accs + kA * 128 + 2 * lane, lane);
        if (u + 1 >= U) break;
        if (u + 2 < U) { kA = ku; slA = slu; eu_issue_unit(bufA, xqA, idn, tab, P, gw + kA * nwv, slA, c); EU_ADVANCE(); if (u + 3 < U) EU_NEXT_IDX(); }
        eu_compute_unit(bufB, xqB, accs + kB * 128 + 2 * lane, lane);
    }
#undef EU_NEXT_IDX
#undef EU_ADVANCE
    for (int k = 0; k < ntok; ++k) {
        const int t = gw + k * nwv;
        const unsigned ep = *(const unsigned*)(seli + (size_t)t * 128 + 2 * lane);
        const f32x2 gt = *(const f32x2*)(selg + (size_t)t * 128 + 2 * lane);
        const f32x2 a2 = *(const LAS f32x2*)(accs + k * 128 + 2 * lane);
        const int e0 = (int)(ep & 0xffffu), e1 = (int)(ep >> 16);
        const float xs = xsv[t];
        const float h0 = a2.x * xs * rsu[e0], h1 = a2.y * xs * rsu[e1];
        const float w0 = gt.x * (0.5f * h0 * (1.f + erff(h0 * 0.70710678118654752f))) * rsv[e0];
        const float w1 = gt.y * (0.5f * h1 * (1.f + erff(h1 * 0.70710678118654752f))) * rsv[e1];
        *(unsigned*)(wexp + (size_t)t * 128 + 2 * lane) = pk2(w0, w1);
    }
}
DEV void ev_issue_unit(u32x4 (&buf)[16], u32x2& hv, u32x4& gt, const u32x4 (&idn)[2], const unsigned char* tab, const Params& P, const float* gatev, int t, int sl, int g, int c) {
    int id[16];
#pragma unroll
    for (int q = 0; q < 2; ++q)
#pragma unroll
        for (int d = 0; d < 4; ++d) { id[8 * q + 2 * d] = (int)(idn[q][d] & 0xffffu); id[8 * q + 2 * d + 1] = (int)(idn[q][d] >> 16); }
    const unsigned char* slice = tab + (size_t)sl * 2 * MiB + 16 * c;
#pragma unroll
    for (int k = 0; k < 16; ++k) buf[k] = *(const u32x4*)(slice + (size_t)id[k] * 128);
    const int col = 256 * sl + 32 * c + 4 * g, m = t < NX ? (t >> 11) : 8;
    hv = *(const u32x2*)(hrow(P, t) + col);
    gt = *(const u32x4*)(gatev + m * 6144 + col);
}
DEV void ev_compute_unit(const u32x4 (&buf)[16], const u32x2 hv, const u32x4 gt, const LAS float* wS, const Params& P, int t, int sl, int lane, int g, int c) {
    f32x2 p2[16];
#pragma unroll
    for (int i = 0; i < 16; ++i) p2[i] = (f32x2){0.f, 0.f};
    f32x4 wq[4];
#pragma unroll
    for (int q = 0; q < 4; ++q) wq[q] = *(const LAS f32x4*)(wS + 4 * q);
#pragma unroll
    for (int k = 0; k < 16; ++k) {
        const float wkf = wq[k >> 2][k & 3];
        const f32x2 w2 = {wkf, wkf};
#pragma unroll
        for (int d = 0; d < 4; ++d) {
            p2[4 * d + 0] += w2 * __builtin_amdgcn_cvt_scalef32_pk_f32_fp4(buf[k][d], 1.0f, 0);
            p2[4 * d + 1] += w2 * __builtin_amdgcn_cvt_scalef32_pk_f32_fp4(buf[k][d], 1.0f, 1);
            p2[4 * d + 2] += w2 * __builtin_amdgcn_cvt_scalef32_pk_f32_fp4(buf[k][d], 1.0f, 2);
            p2[4 * d + 3] += w2 * __builtin_amdgcn_cvt_scalef32_pk_f32_fp4(buf[k][d], 1.0f, 3);
        }
        asm volatile("" : "+v"(p2[0]), "+v"(p2[1]), "+v"(p2[2]), "+v"(p2[3]), "+v"(p2[4]), "+v"(p2[5]), "+v"(p2[6]), "+v"(p2[7]),
                          "+v"(p2[8]), "+v"(p2[9]), "+v"(p2[10]), "+v"(p2[11]), "+v"(p2[12]), "+v"(p2[13]), "+v"(p2[14]), "+v"(p2[15]));
    }
    float p[32];
#pragma unroll
    for (int i = 0; i < 16; ++i) { p[2 * i] = p2[i].x; p[2 * i + 1] = p2[i].y; }
    bfly_stage<8, 4>(p, lane); bfly_stage<4, 4>(p, lane); bfly_stage<2, 4>(p, lane);
    const int col = 256 * sl + 32 * c + 4 * g;
    u32x2 ho;
    ho.x = pk2(bflo(hv.x) + __uint_as_float(gt.x) * p[0], bfhi(hv.x) + __uint_as_float(gt.y) * p[1]);
    ho.y = pk2(bflo(hv.y) + __uint_as_float(gt.z) * p[2], bfhi(hv.y) + __uint_as_float(gt.w) * p[3]);
    *(u32x2*)(hrow(P, t) + col) = ho;
}
DEV void phase_experts(const Params& P, int layer, int nrows, ldsp lds0) {
    const unsigned char* tabu = P.ws + OFF_TAB + (size_t)(layer * 2) * 16 * MiB;
    const unsigned char* tabv = tabu + 16 * MiB;
    const bf16_t* seli = (const bf16_t*)(P.ws + OFF_SELI);
    const float* selg = (const float*)(P.ws + OFF_SELG);
    const float* rsu = (const float*)(P.ws + OFF_RSC) + (size_t)(layer * 2) * 16384;
    const float* rsv = rsu + 16384;
    const float* xsv = (const float*)(P.ws + OFF_XS);
    const float* gatev = (const float*)(P.ws + OFF_MODV) + (size_t)layer * 9 * 6144 + 5 * 1024;
    const int tid = tid_fresh(), wave = __builtin_amdgcn_readfirstlane(tid >> 6), lane = tid & 63, g = lane >> 3, c = lane & 7;
    const int gw = blockIdx.x * 8 + wave, nwv = gridDim.x * 8;
    if (gw >= nrows) return;
    const int ntok = (nrows - gw + nwv - 1) / nwv, U = 4 * ntok;
    LAS float* accs = (LAS float*)(launder(lds0) + wave * 8192);
    for (int k = 0; k < ntok; ++k) *(LAS f32x2*)(accs + k * 128 + 2 * lane) = (f32x2){0.f, 0.f};
    u32x4 bufA[16], bufB[16], idn[2];
    int ku = 0, slu = 0;
#define EU_NEXT_IDX() do { const int tt = gw + ku * nwv; _Pragma("unroll") for (int q = 0; q < 2; ++q) idn[q] = *(const u32x4*)(seli + (size_t)tt * 128 + 16 * g + 8 * q); } while (0)
#define EU_ADVANCE() do { if (++ku == ntok) { ku = 0; ++slu; } } while (0)
    int kA, slA, kB = 0, slB = 0;
    {
        u32x4 xqA[2], xqB[2];
        EU_NEXT_IDX();
        kA = ku; slA = slu; eu_issue_unit(bufA, xqA, idn, tabu, P, gw + kA * nwv, slA, c); EU_ADVANCE();
        if (U > 1) EU_NEXT_IDX();
        for (int u = 0; u < U; u += 2) {
            if (u + 1 < U) { kB = ku; slB = slu; eu_issue_unit(bufB, xqB, idn, tabu, P, gw + kB * nwv, slB, c); EU_ADVANCE(); if (u + 2 < U) EU_NEXT_IDX(); }
            eu_compute_unit(bufA, xqA, accs + kA * 128 + 2 * lane, lane);
            if (u + 1 >= U) break;
            if (u + 2 < U) { kA = ku; slA = slu; eu_issue_unit(bufA, xqA, idn, tabu, P, gw + kA * nwv, slA, c); EU_ADVANCE(); if (u + 3 < U) EU_NEXT_IDX(); }
            eu_compute_unit(bufB, xqB, accs + kB * 128 + 2 * lane, lane);
        }
    }
    u32x2 hvA, hvB; u32x4 gtA, gtB;
    ku = 0; slu = 0;
    EU_NEXT_IDX();
    kA = ku; slA = slu; ev_issue_unit(bufA, hvA, gtA, idn, tabv, P, gatev, gw + kA * nwv, slA, g, c); EU_ADVANCE();
    if (U > 1) EU_NEXT_IDX();
    for (int k = 0; k < ntok; ++k) {
        const int t = gw + k * nwv;
        const unsigned ep = *(const unsigned*)(seli + (size_t)t * 128 + 2 * lane);
        const f32x2 gt = *(const f32x2*)(selg + (size_t)t * 128 + 2 * lane);
        const f32x2 a2 = *(const LAS f32x2*)(accs + k * 128 + 2 * lane);
        const int e0 = (int)(ep & 0xffffu), e1 = (int)(ep >> 16);
        const float xs = xsv[t];
        const float h0 = a2.x * xs * rsu[e0], h1 = a2.y * xs * rsu[e1];
        f32x2 w;
        w.x = gt.x * (0.5f * h0 * (1.f + erff(h0 * 0.70710678118654752f))) * rsv[e0];
        w.y = gt.y * (0.5f * h1 * (1.f + erff(h1 * 0.70710678118654752f))) * rsv[e1];
        *(LAS f32x2*)(accs + k * 128 + 2 * lane) = w;
    }
    for (int u = 0; u < U; u += 2) {
        if (u + 1 < U) { kB = ku; slB = slu; ev_issue_unit(bufB, hvB, gtB, idn, tabv, P, gatev, gw + kB * nwv, slB, g, c); EU_ADVANCE(); if (u + 2 < U) EU_NEXT_IDX(); }
        ev_compute_unit(bufA, hvA, gtA, accs + kA * 128 + 16 * g, P, gw + kA * nwv, slA, lane, g, c);
        if (u + 1 >= U) break;
        if (u + 2 < U) { kA = ku; slA = slu; ev_issue_unit(bufA, hvA, gtA, idn, tabv, P, gatev, gw + kA * nwv, slA, g, c); EU_ADVANCE(); if (u + 3 < U) EU_NEXT_IDX(); }
        ev_compute_unit(bufB, hvB, gtB, accs + kB * 128 + 16 * g, P, gw + kB * nwv, slB, lane, g, c);
    }
#undef EU_NEXT_IDX
#undef EU_ADVANCE
}
DEV void phase_experts_act(const Params& P, int layer, int nrows) {
    const bf16_t* seli = (const bf16_t*)(P.ws + OFF_SELI);
    const float* selg = (const float*)(P.ws + OFF_SELG);
    const float* part = (const float*)(P.ws + OFF_PART);
    bf16_t* wexp = (bf16_t*)(P.ws + OFF_WEXP);
    const float* rsu = (const float*)(P.ws + OFF_RSC) + (size_t)(layer * 2) * 16384;
    const float* rsv = rsu + 16384;
    const int tid = tid_fresh();
    const int n4 = nrows * 32;
    for (int i4 = blockIdx.x * NTHREADS + tid; i4 < n4; i4 += gridDim.x * NTHREADS) {
        const size_t idx = (size_t)i4 * 4;
        f32x4 h = {0.f, 0.f, 0.f, 0.f};
#pragma unroll
        for (int s = 0; s < 4; ++s) { const u32x2 pv = *(const u32x2*)((const bf16_t*)part + (size_t)s * NT * 128 + idx); h += (f32x4){bflo(pv.x), bfhi(pv.x), bflo(pv.y), bfhi(pv.y)}; }
        const u32x2 e = *(const u32x2*)(seli + idx);
        const f32x4 gt = *(const f32x4*)(selg + idx);
        const int ee[4] = {(int)(e.x & 0xffffu), (int)(e.x >> 16), (int)(e.y & 0xffffu), (int)(e.y >> 16)};
        f32x4 o;
#pragma unroll
        for (int q = 0; q < 4; ++q) {
            const float hh = h[q] * rsu[ee[q]];
            o[q] = gt[q] * (0.5f * hh * (1.f + erff(hh * 0.70710678118654752f))) * rsv[ee[q]];
        }
        u32x2 ow; ow.x = pk2(o[0], o[1]); ow.y = pk2(o[2], o[3]);
        *(u32x2*)(wexp + idx) = ow;
    }
}
DEV void phase_final(const Params& P) {
    const int tid = tid_fresh(), wave = tid >> 6, lane = tid & 63;
    for (int r = blockIdx.x * 8 + wave; r < NX; r += gridDim.x * 8) {
        float* h = P.out + (size_t)r * 1024;
        f32x4 v[4]; float ss = 0.f;
#pragma unroll
        for (int j = 0; j < 4; ++j) { const u32x2 hv = *(const u32x2*)(hrow(P, r) + j * 256 + lane * 4); v[j] = (f32x4){bflo(hv.x), bfhi(hv.x), bflo(hv.y), bfhi(hv.y)};
            ss += v[j].x * v[j].x + v[j].y * v[j].y + v[j].z * v[j].z + v[j].w * v[j].w; }
        ss = wave_sum(ss);
        const float rstd = rsqrtf(ss * (1.f / 1024.f) + EPS);
#pragma unroll
        for (int j = 0; j < 4; ++j) { const f32x4 gg = *(const f32x4*)(P.final_g + j * 256 + lane * 4); __builtin_nontemporal_store(v[j] * rstd * gg, (f32x4*)(h + j * 256 + lane * 4)); }
    }
}

DEV void phase_conv(const Params& P) {
    const bf16_t* Pq = (const bf16_t*)(P.ws + OFF_R1);
    const float* ab = (const float*)(P.ws + OFF_AB);
    bf16_t* dst[3] = {(bf16_t*)(P.ws + OFF_QC), (bf16_t*)(P.ws + OFF_KC), (bf16_t*)(P.ws + OFF_VC)};
    float* gbuf = (float*)(P.ws + OFF_G);
    float* bbuf = (float*)(P.ws + OFF_BETA);
    const int tid = tid_fresh(), wave = tid >> 6, lane = tid & 63;
    constexpr int NSEG = NT / 16;
    for (int item = blockIdx.x * 8 + wave; item < NSEG * 6; item += gridDim.x * 8) {
        const int seg = item / 6, jc = item - seg * 6, row0 = seg * 16;
        int t0, L;
        if (row0 < NX) { t0 = row0 & 2047; L = 2048; } else { t0 = (row0 - NX) & 255; L = 256; }
        const int chunk = lane + 64 * jc, col = chunk * 8, part = jc >> 1;
        f32x4 w0[5], w1[5];
#pragma unroll
        for (int tap = 0; tap < 5; ++tap) { w0[tap] = *(const f32x4*)(P.dn_conv_w + tap * 3072 + col); w1[tap] = *(const f32x4*)(P.dn_conv_w + tap * 3072 + col + 4); }
        u32x4 raw[20];
#pragma unroll
        for (int i = 0; i < 20; ++i) {
            const int tt = t0 + i - 2;
            const bool ok = tt >= 0 && tt < L;
            const u32x4 v = *(const u32x4*)(Pq + (size_t)(row0 + (ok ? i - 2 : 0)) * 3072 + col);
            raw[i] = ok ? v : (u32x4){0u, 0u, 0u, 0u};
        }
        const float qs = part == 0 ? 0.08838834764831845f : 1.f;
        bf16_t* dp = dst[part] + (size_t)row0 * 1024 + (chunk & 127) * 8;
#pragma unroll
        for (int i = 0; i < 16; ++i) {
            float acc[8];
#pragma unroll
            for (int e = 0; e < 8; ++e) acc[e] = 0.f;
#pragma unroll
            for (int tap = 0; tap < 5; ++tap) {
                float f[8]; unpack8(raw[i + tap], f);
                acc[0] += f[0] * w0[tap].x; acc[1] += f[1] * w0[tap].y; acc[2] += f[2] * w0[tap].z; acc[3] += f[3] * w0[tap].w;
                acc[4] += f[4] * w1[tap].x; acc[5] += f[5] * w1[tap].y; acc[6] += f[6] * w1[tap].z; acc[7] += f[7] * w1[tap].w;
            }
            float ss = 0.f;
#pragma unroll
            for (int e = 0; e < 8; ++e) { acc[e] = silu(acc[e]); ss += acc[e] * acc[e]; }
            if (part < 2) {
                ss = sum16(ss);
                const float rn = rsqrtf(ss + EPS) * qs;
#pragma unroll
                for (int e = 0; e < 8; ++e) acc[e] *= rn;
            }
            u32x4 o; o.x = pk2(acc[0], acc[1]); o.y = pk2(acc[2], acc[3]); o.z = pk2(acc[4], acc[5]); o.w = pk2(acc[6], acc[7]);
            *(u32x4*)(dp + (size_t)i * 1024) = o;
        }
        if (jc == 0) {
            const int cc = lane & 31, d = cc >> 4, sx = (cc >> 3) & 1, h = cc & 7;
            const float a = __expf(P.dn_a_log[d * 8 + h]), dtb = P.dn_dt_bias[d * 8 + h];
            float v[8];
#pragma unroll
            for (int q = 0; q < 8; ++q) v[q] = ab[(size_t)(row0 + 2 * q + (lane >> 5)) * 32 + cc];
#pragma unroll
            for (int q = 0; q < 8; ++q) {
                const int row = row0 + 2 * q + (lane >> 5);
                if (sx == 0) {
                    const float xx = v[q] + dtb;
                    const float ex = __expf(fminf(xx, 30.f)), u = 1.f + ex;
                    const float l1p = (u == 1.f) ? ex : __logf(u) * ex * __builtin_amdgcn_rcpf(u - 1.f);
                    const float sp = xx > 20.f ? xx : l1p;
                    gbuf[((size_t)d * NT + row) * 8 + h] = -a * sp;
                } else {
                    bbuf[((size_t)d * NT + row) * 8 + h] = __builtin_amdgcn_rcpf(1.f + __expf(-v[q]));
                }
            }
        }
    }
}

DEV int chunk_rowbase(int b, int d, int n) {
    if (n < 4) { const int m = d ? 3 - n : n; return NX + b * 256 + m * 64; }
    const int m = d ? 31 - (n - 4) : n - 4; return b * 2048 + m * 64;
}

DEV bf16x8 frag_col_x(ldsp x, int c0, int k0, int lane) {
    const int col = c0 + (lane & 31), ch = col >> 3, sub = (col & 7) * 2;
    bf16x8 f;
#pragma unroll
    for (int j = 0; j < 8; ++j) { const int row = k0 + 8 * (lane >> 5) + j; f[j] = (short)*(const LAS bf16_t*)(x + row * 256 + ((ch ^ (row & 15)) << 4) + sub); }
    return f;
}
DEV void tile_rows8(const f32x16& acc, u32x4& o0, u32x4& o1) {
    unsigned p[4][2];
#pragma unroll
    for (int rg = 0; rg < 4; ++rg) { p[rg][0] = pk2(acc[rg * 4 + 0], acc[rg * 4 + 1]); p[rg][1] = pk2(acc[rg * 4 + 2], acc[rg * 4 + 3]); }
    const auto s00 = __builtin_amdgcn_permlane32_swap(p[0][0], p[2][0], false, false), s01 = __builtin_amdgcn_permlane32_swap(p[0][1], p[2][1], false, false);
    const auto s10 = __builtin_amdgcn_permlane32_swap(p[1][0], p[3][0], false, false), s11 = __builtin_amdgcn_permlane32_swap(p[1][1], p[3][1], false, false);
    o0 = (u32x4){s00[0], s01[0], s00[1], s01[1]};
    o1 = (u32x4){s10[0], s11[0], s10[1], s11[1]};
}
DEV bf16x8 frag_row_t(ldsp t, int r0, int k0, int lane) {
    const int row = r0 + (lane & 31), ch = (k0 >> 3) + (lane >> 5);
    return *(const LAS bf16x8*)(t + row * 128 + ((ch ^ (row & 7)) << 4));
}
DEV void phase_chunk(const Params& P, ldsp lds0) {
    const bf16_t* kc = (const bf16_t*)(P.ws + OFF_KC);
    const bf16_t* vc = (const bf16_t*)(P.ws + OFF_VC);
    const float* gbuf = (const float*)(P.ws + OFF_G);
    const float* bbuf = (const float*)(P.ws + OFF_BETA);
    bf16_t* wbuf = (bf16_t*)(P.ws + OFF_WBUF);
    bf16_t* ubuf = (bf16_t*)(P.ws + OFF_UBUF);
    float* gcbuf = (float*)(P.ws + OFF_GC);
    const int tid = tid_fresh(), lane = tid & 63, wave = tid >> 6, team = wave >> 1, tw = wave & 1, ttid = tid & 127;
    const int nteams = gridDim.x * 4, niter = (4608 + nteams - 1) / nteams;
    u32x4 rk[8];
    {
        const int item0 = min((int)(blockIdx.x * 4 + team), 4607);
        const int n = item0 % 36, d = (item0 / 36) & 1, bh = item0 / 72, rb0 = chunk_rowbase(bh >> 3, d, n);
#pragma unroll
        for (int j = 0; j < 8; ++j) { const int cid = ttid + 128 * j, i = cid >> 4, ch = cid & 15; rk[j] = *(const u32x4*)(kc + ((size_t)rb0 + (d ? 63 - i : i)) * 1024 + (bh & 7) * 128 + ch * 8); }
    }
    for (int it = 0; it < niter; ++it) {
        const int item = it * nteams + blockIdx.x * 4 + team;
        const bool act = item < 4608;
        const ldsp lds = launder(lds0);
        const ldsp sX = lds + team * 32768;
        const ldsp sT = sX + 16384;
        LAS float* sA = (LAS float*)sT;
        LAS float* sg = (LAS float*)(lds + 131072 + 128 + team * 768);
        const int n = item % 36, d = (item / 36) & 1, bh = item / 72, b = bh >> 3, h = bh & 7;
        const int rowbase = act ? chunk_rowbase(b, d, n) : 0;
        if (act) {
#pragma unroll
            for (int j = 0; j < 8; ++j) { const int cid = ttid + 128 * j, i = cid >> 4, ch = cid & 15; *(LAS u32x4*)(sX + i * 256 + ((ch ^ (i & 15)) << 4)) = rk[j]; }
            if (tw == 0) {
                const size_t grow = (size_t)rowbase + (d ? 63 - lane : lane);
                float v = gbuf[((size_t)d * NT + grow) * 8 + h];
#pragma unroll
                for (int o = 1; o < 64; o <<= 1) { const float t = __shfl_up(v, o); if (lane >= o) v += t; }
                sg[lane] = v; sg[64 + lane] = bbuf[((size_t)d * NT + grow) * 8 + h];
            }
        }
        __syncthreads();
        if (act) {
#pragma unroll 1
            for (int q = 0; q < 2; ++q) {
                const int mt = tw, nt = q;
                f32x16 acc = zero16();
#pragma unroll 4
                for (int ks = 0; ks < 8; ++ks) acc = mfma32(frag_row_x(sX, mt * 32, ks * 16, lane), frag_row_x(sX, nt * 32, ks * 16, lane), acc);
#pragma unroll
                for (int reg = 0; reg < 16; ++reg) {
                    const int i = mt * 32 + crow(reg, lane), j = nt * 32 + (lane & 31);
                    sA[i * 64 + j] = (i > j) ? sg[64 + i] * acc[reg] * __expf(sg[i] - sg[j]) : 0.f;
                }
            }
        }
        __syncthreads();
        if (act && tw == 0) {
            float t[64];
            int ln = lane; asm volatile("" : "+v"(ln));
#pragma unroll
            for (int i = 0; i < 64; ++i) {
                float a0 = (i == ln) ? 1.f : 0.f, a1 = 0.f, a2 = 0.f, a3 = 0.f;
#pragma unroll
                for (int j = 0; j < i; j += 4) {
                    const f32x4 av = *(const LAS f32x4*)(sA + i * 64 + j);
                    a0 -= av.x * t[j];
                    if (j + 1 < i) a1 -= av.y * t[j + 1];
                    if (j + 2 < i) a2 -= av.z * t[j + 2];
                    if (j + 3 < i) a3 -= av.w * t[j + 3];
                }
                t[i] = (a0 + a1) + (a2 + a3);
                __builtin_amdgcn_sched_barrier(0);
            }
            const float cu = sg[64 + lane], cw = cu * __expf(sg[lane]);
            const int ch = lane >> 3, sub = (lane & 7) * 2;
#pragma unroll
            for (int i = 0; i < 64; ++i) {
                const int off = i * 128 + ((ch ^ (i & 7)) << 4) + sub;
                *(LAS bf16_t*)(sT + off) = f2bf(t[i] * cw);
                *(LAS bf16_t*)(sT + 8192 + off) = f2bf(t[i] * cu);
                if ((i & 7) == 7) __builtin_amdgcn_sched_barrier(0);
            }
        }
        __syncthreads();
            {
                const int itemn = min(item + nteams, 4607);
                const int nn = itemn % 36, dn = (itemn / 36) & 1, bhn = itemn / 72, rbn = chunk_rowbase(bhn >> 3, dn, nn);
#pragma unroll
                for (int j = 0; j < 8; ++j) { const int cid = ttid + 128 * j, i = cid >> 4, ch = cid & 15; rk[j] = *(const u32x4*)(kc + ((size_t)rbn + (dn ? 63 - i : i)) * 1024 + (bhn & 7) * 128 + ch * 8); }
            }
        u32x4 rv[8];
        if (act) {
#pragma unroll
            for (int j = 0; j < 8; ++j) {
                const int cid = ttid + 128 * j, i = cid >> 4, ch = cid & 15;
                const size_t grow = (size_t)rowbase + (d ? 63 - i : i);
                rv[j] = *(const u32x4*)(vc + grow * 1024 + h * 128 + ch * 8);
            }
#pragma unroll 1
            for (int q = 0; q < 2; ++q) {
                const int mtk = 2 * tw + q;
                f32x16 acc[2]; acc[0] = zero16(); acc[1] = zero16();
#pragma unroll
                for (int ks = 0; ks < 4; ++ks) {
                    const bf16x8 afr = frag_col_x(sX, mtk * 32, ks * 16, lane);
#pragma unroll
                    for (int it2 = 0; it2 < 2; ++it2) acc[it2] = mfma32(afr, frag_row_t(sT, it2 * 32, ks * 16, lane), acc[it2]);
                }
                bf16_t* dstp = wbuf + (size_t)item * 8192;
#pragma unroll
                for (int it2 = 0; it2 < 2; ++it2) {
                    u32x4 o0, o1; tile_rows8(acc[it2], o0, o1);
                    bf16_t* rp = dstp + (it2 * 32 + (lane & 31)) * 128 + mtk * 32 + 16 * (lane >> 5);
                    *(u32x4*)rp = o0; *(u32x4*)(rp + 8) = o1;
                }
            }
        }
        __syncthreads();
        if (act) {
#pragma unroll
            for (int j = 0; j < 8; ++j) { const int cid = ttid + 128 * j, i = cid >> 4, ch = cid & 15; *(LAS u32x4*)(sX + i * 256 + ((ch ^ (i & 15)) << 4)) = rv[j]; }
        }
        __syncthreads();
        if (act) {
#pragma unroll 1
            for (int q = 0; q < 2; ++q) {
                const int nt = 2 * tw + q;
                f32x16 acc[2]; acc[0] = zero16(); acc[1] = zero16();
#pragma unroll
                for (int ks = 0; ks < 4; ++ks) {
                    const bf16x8 bfr = frag_col_x(sX, nt * 32, ks * 16, lane);
#pragma unroll
                    for (int mt = 0; mt < 2; ++mt) acc[mt] = mfma32(frag_row_t(sT + 8192, mt * 32, ks * 16, lane), bfr, acc[mt]);
                }
                bf16_t* dstp = ubuf + (size_t)item * 8192;
#pragma unroll
                for (int mt = 0; mt < 2; ++mt) {
                    u32x4 o0, o1; tile_rows8(acc[mt], o0, o1);
                    bf16_t* rp = dstp + (nt * 32 + (lane & 31)) * 64 + mt * 32 + 16 * (lane >> 5);
                    *(u32x4*)rp = o0; *(u32x4*)(rp + 8) = o1;
                }
            }
            if (tw == 0) gcbuf[(size_t)item * 64 + lane] = sg[lane];
        }
        __syncthreads();
    }
}

DEV u32x2 pack4(float a, float b, float c, float d) { u32x2 o; o.x = pk2(a, b); o.y = pk2(c, d); return o; }
DEV void phase_scan(const Params& P, ldsp lds0) {
    const bf16_t* qc = (const bf16_t*)(P.ws + OFF_QC);
    const bf16_t* kc = (const bf16_t*)(P.ws + OFF_KC);
    const bf16_t* wbuf = (const bf16_t*)(P.ws + OFF_WBUF);
    const bf16_t* ubuf = (const bf16_t*)(P.ws + OFF_UBUF);
    const float* gcbuf = (const float*)(P.ws + OFF_GC);
    bf16_t* obuf = (bf16_t*)(P.ws + OFF_OBUF);
    const int tid = tid_fresh(), lane = tid & 63, wave = tid >> 6;
    const int mt = wave >> 1, nt = wave & 1;
    const int mt2 = (wave & 3) >> 1, nt2 = wave & 1;
    for (int item = blockIdx.x; item < 256; item += gridDim.x) {
        const int half = item & 1, d = (item >> 1) & 1, bh = item >> 2, b = bh >> 3, h = bh & 7;
        f32x16 S = zero16();
        { LAS unsigned* z = (LAS unsigned*)(lds0 + 1024 + 3 * 17408 + 9216); for (int e = tid; e < 64 * 136 / 2; e += NTHREADS) z[e] = 0u; }
        u32x4 rW[2][2], rK[2][2], rQ[2][2], rU[2]; float rG[2] = {0.f, 0.f};
#pragma unroll
        for (int u = 0; u < 2; ++u) {
            const int citem = (bh * 2 + d) * 36 + u, rowbase = chunk_rowbase(b, d, u);
#pragma unroll
            for (int j = 0; j < 2; ++j) {
                const int cid = tid + NTHREADS * j, i = cid >> 4, ch = cid & 15;
                const size_t grow = (size_t)rowbase + (d ? 63 - i : i);
                rW[u][j] = *(const u32x4*)(wbuf + (size_t)citem * 8192 + i * 128 + ch * 8);
                rK[u][j] = *(const u32x4*)(kc + grow * 1024 + h * 128 + ch * 8);
                rQ[u][j] = rK[u][j];
            }
            { const int dvr = tid >> 3, ch = tid & 7; rU[u] = *(const u32x4*)(ubuf + (size_t)citem * 8192 + (half * 64 + dvr) * 64 + ch * 8); }
            if (tid < 64) rG[u] = gcbuf[(size_t)citem * 64 + tid];
        }
        for (int n2 = 0; n2 < 36; n2 += 2) {
#pragma unroll
        for (int u = 0; u < 2; ++u) {
            const int n = n2 + u;
            const ldsp lds = launder(lds0);
            int ln = lane; asm volatile("" : "+v"(ln));
            LAS float* sg = (LAS float*)lds;
            LAS bf16_t* sW = (LAS bf16_t*)(lds + 1024);
            LAS bf16_t* sK = sW + 64 * 136;
            LAS bf16_t* sQ = sK + 64 * 136;
            LAS bf16_t* sU = sQ + 64 * 136;
            LAS bf16_t* sST = sU + 64 * 72;
            LAS bf16_t* sVNT = sST + 64 * 136;
            LAS bf16_t* sVNsT = sVNT + 64 * 72;
            LAS bf16_t* sATT = sVNsT + 64 * 72;
            LAS bf16_t* sO = sATT + 64 * 72;
            const int rowbase = chunk_rowbase(b, d, n);
            const bool wantO = n >= 4;
#pragma unroll
            for (int j = 0; j < 2; ++j) {
                const int cid = tid + NTHREADS * j, i = cid >> 4, ch = cid & 15;
                *(LAS u32x4*)(sW + i * 136 + ch * 8) = rW[u][j];
                *(LAS u32x4*)(sK + i * 136 + ch * 8) = rK[u][j];
                *(LAS u32x4*)(sQ + i * 136 + ch * 8) = rQ[u][j];
            }
            { const int i = tid >> 3, ch = tid & 7; *(LAS u32x4*)(sU + i * 72 + ch * 8) = rU[u]; }
            if (tid < 64) sg[tid] = rG[u];
            __syncthreads();
            if (n + 2 < 36) {
                const int citem = (bh * 2 + d) * 36 + n + 2, rb1 = chunk_rowbase(b, d, n + 2);
                const bool wq = n + 2 >= 4;
#pragma unroll
                for (int j = 0; j < 2; ++j) {
                    const int cid = tid + NTHREADS * j, i = cid >> 4, ch = cid & 15;
                    const size_t grow = (size_t)rb1 + (d ? 63 - i : i);
                    rW[u][j] = *(const u32x4*)(wbuf + (size_t)citem * 8192 + i * 128 + ch * 8);
                    rK[u][j] = *(const u32x4*)(kc + grow * 1024 + h * 128 + ch * 8);
                    if (wq) rQ[u][j] = *(const u32x4*)(qc + grow * 1024 + h * 128 + ch * 8);
                }
                { const int dvr = tid >> 3, ch = tid & 7; rU[u] = *(const u32x4*)(ubuf + (size_t)citem * 8192 + (half * 64 + dvr) * 64 + ch * 8); }
                if (tid < 64) rG[u] = gcbuf[(size_t)citem * 64 + tid];
            }
            const float g63 = sg[63];
            if (wave < 4) {
                const int dv = nt2 * 32 + (ln & 31);
                float uf[16], ef[16];
#pragma unroll
                for (int rg = 0; rg < 4; ++rg) {
                    const int i0 = mt2 * 32 + 8 * rg + 4 * (ln >> 5);
                    const u32x2 uu = *(const LAS u32x2*)(sU + dv * 72 + i0);
                    const f32x4 gg = *(const LAS f32x4*)(sg + i0);
                    uf[rg * 4 + 0] = bflo(uu.x); uf[rg * 4 + 1] = bfhi(uu.x); uf[rg * 4 + 2] = bflo(uu.y); uf[rg * 4 + 3] = bfhi(uu.y);
#pragma unroll
                    for (int e = 0; e < 4; ++e) ef[rg * 4 + e] = __expf(g63 - gg[e]);
                }
                f32x16 acc = zero16(), accb = zero16();
#pragma unroll
                for (int ks = 0; ks < 8; ks += 2) { acc = mfma32(frag_row(sW, 136, mt2 * 32, ks * 16, ln), frag_row(sST, 136, nt2 * 32, ks * 16, ln), acc);
                    accb = mfma32(frag_row(sW, 136, mt2 * 32, ks * 16 + 16, ln), frag_row(sST, 136, nt2 * 32, ks * 16 + 16, ln), accb); }
#pragma unroll
                for (int rg = 0; rg < 4; ++rg) {
                    const int i0 = mt2 * 32 + 8 * rg + 4 * (ln >> 5);
                    float v[4], vs[4];
#pragma unroll
                    for (int e = 0; e < 4; ++e) { v[e] = uf[rg * 4 + e] - (acc[rg * 4 + e] + accb[rg * 4 + e]); vs[e] = v[e] * ef[rg * 4 + e]; }
                    *(LAS u32x2*)(sVNT + dv * 72 + i0) = pack4(v[0], v[1], v[2], v[3]);
                    *(LAS u32x2*)(sVNsT + dv * 72 + i0) = pack4(vs[0], vs[1], vs[2], vs[3]);
                }
            } else if (wantO) {
                const int i = nt2 * 32 + (ln & 31);
                const float gi = sg[i];
                float df[16];
#pragma unroll
                for (int rg = 0; rg < 4; ++rg) {
                    const int j0 = mt2 * 32 + 8 * rg + 4 * (ln >> 5);
                    const f32x4 gg = *(const LAS f32x4*)(sg + j0);
#pragma unroll
                    for (int e = 0; e < 4; ++e) df[rg * 4 + e] = (i >= j0 + e) ? __expf(fminf(gi - gg[e], 0.f)) : 0.f;
                }
                f32x16 acc = zero16(), accb = zero16();
#pragma unroll
                for (int ks = 0; ks < 8; ks += 2) { acc = mfma32(frag_row(sK, 136, mt2 * 32, ks * 16, ln), frag_row(sQ, 136, nt2 * 32, ks * 16, ln), acc);
                    accb = mfma32(frag_row(sK, 136, mt2 * 32, ks * 16 + 16, ln), frag_row(sQ, 136, nt2 * 32, ks * 16 + 16, ln), accb); }
#pragma unroll
                for (int rg = 0; rg < 4; ++rg) {
                    const int j0 = mt2 * 32 + 8 * rg + 4 * (ln >> 5);
                    float v[4];
#pragma unroll
                    for (int e = 0; e < 4; ++e) v[e] = (acc[rg * 4 + e] + accb[rg * 4 + e]) * df[rg * 4 + e];
                    *(LAS u32x2*)(sATT + i * 72 + j0) = pack4(v[0], v[1], v[2], v[3]);
                }
            }
            __syncthreads();
            if (wave < 4 && wantO) {
                float eg[16];
#pragma unroll
                for (int rg = 0; rg < 4; ++rg) {
                    const f32x4 gg = *(const LAS f32x4*)(sg + mt2 * 32 + 8 * rg + 4 * (ln >> 5));
#pragma unroll
                    for (int e = 0; e < 4; ++e) eg[rg * 4 + e] = __expf(gg[e]);
                }
                f32x16 a1 = zero16(), a1b = zero16(), a2 = zero16();
#pragma unroll
                for (int ks = 0; ks < 8; ks += 2) { a1 = mfma32(frag_row(sQ, 136, mt2 * 32, ks * 16, ln), frag_row(sST, 136, nt2 * 32, ks * 16, ln), a1);
                    a1b = mfma32(frag_row(sQ, 136, mt2 * 32, ks * 16 + 16, ln), frag_row(sST, 136, nt2 * 32, ks * 16 + 16, ln), a1b); }
#pragma unroll
                for (int ks = 0; ks < 4; ++ks) a2 = mfma32(frag_row(sATT, 72, mt2 * 32, ks * 16, ln), frag_row(sVNT, 72, nt2 * 32, ks * 16, ln), a2);
                const int dv = nt2 * 32 + (ln & 31);
#pragma unroll
                for (int rg = 0; rg < 4; ++rg) {
                    const int i0 = mt2 * 32 + 8 * rg + 4 * (ln >> 5);
#pragma unroll
                    for (int e = 0; e < 4; ++e) sO[(i0 + e) * 72 + dv] = f2bf((a1[rg * 4 + e] + a1b[rg * 4 + e]) * eg[rg * 4 + e] + a2[rg * 4 + e]);
                }
            }
            {
                const float gl = __expf(g63);
#pragma unroll
                for (int reg = 0; reg < 16; ++reg) S[reg] *= gl;
#pragma unroll
                for (int ks = 0; ks < 4; ++ks) S = mfma32(frag_col_tr(sK, 136, mt * 32, ks * 16, ln), frag_row(sVNsT, 72, nt * 32, ks * 16, ln), S);
            }
            __syncthreads();
            if (wantO) {
                const int i = tid >> 3, ch = tid & 7;
                const size_t grow = (size_t)rowbase + (d ? 63 - i : i);
                *(u32x4*)(obuf + ((size_t)d * NX + grow) * 1024 + h * 128 + half * 64 + ch * 8) = *(const LAS u32x4*)(sO + i * 72 + ch * 8);
            }
#pragma unroll
            for (int rg = 0; rg < 4; ++rg) {
                const int dk0 = mt * 32 + 8 * rg + 4 * (ln >> 5);
                *(LAS u32x2*)(sST + (nt * 32 + (ln & 31)) * 136 + dk0) = pack4(S[rg * 4 + 0], S[rg * 4 + 1], S[rg * 4 + 2], S[rg * 4 + 3]);
            }
        }
        }
        __syncthreads();
    }
}

DEV void phase_dnout(const Params& P) {
    const bf16_t* obuf = (const bf16_t*)(P.ws + OFF_OBUF);
    const bf16_t* Pz = (const bf16_t*)(P.ws + OFF_PZ);
    bf16_t* A = (bf16_t*)(P.ws + OFF_A);
    const int tid = tid_fresh(); const int wave = tid >> 6, lane = tid & 63;
    for (int row = blockIdx.x * 8 + wave; row < NX; row += gridDim.x * 8) {
#pragma unroll
        for (int c = 0; c < 2; ++c) {
            const int col = c * 512 + lane * 8;
            const u32x4 of = *(const u32x4*)(obuf + (size_t)row * 1024 + col), ob = *(const u32x4*)(obuf + ((size_t)NX + row) * 1024 + col);
            const u32x4 zz = *(const u32x4*)(Pz + (size_t)row * 1024 + col);
            float o[8], o2[8], z[8]; unpack8(of, o); unpack8(ob, o2); unpack8(zz, z);
            float ss = 0.f;
#pragma unroll
            for (int e = 0; e < 8; ++e) { o[e] += o2[e]; ss += o[e] * o[e]; }
            ss = sum16(ss);
            const float rn = rsqrtf(ss * (1.f / 128.f) + EPS);
            float y[8];
#pragma unroll
            for (int e = 0; e < 8; ++e) y[e] = o[e] * rn * P.dn_norm_g[(col & 127) + e] * silu(z[e]);
            u32x4 ov; ov.x = pk2(y[0], y[1]); ov.y = pk2(y[2], y[3]); ov.z = pk2(y[4], y[5]); ov.w = pk2(y[6], y[7]);
            *(u32x4*)(A + (size_t)row * 1024 + col) = ov;
        }
    }
}

namespace pg8 {
#define PG8_LAS __attribute__((address_space(3)))
typedef unsigned short bf16_t;
typedef short bf16x8 __attribute__((ext_vector_type(8)));
typedef float f32x4 __attribute__((ext_vector_type(4)));
typedef unsigned u32x4 __attribute__((ext_vector_type(4)));
constexpr int BM = 256, BK = 64, HALF = 128, HTB = HALF * BK * 2  , STAGE_BYTES = 8 * HTB, NXCD = 8, WGM = 8;

__host__ __device__ __forceinline__ int lds_byte(int r, int c) { const int st = (r >> 4) * 2 + (c >> 5), rr = r & 15, cc = c & 31, ob = rr * 64 + cc * 2; return st * 1024 + (ob ^ (((ob >> 9) & 1) << 5)); }
__host__ __device__ __forceinline__ void stage_rc(int b, int& R, int& C) { const int st = b / 1024, sb = b % 1024, swz = sb ^ (((sb >> 9) & 1) << 5); R = (st >> 1) * 16 + swz / 64; C = (st & 1) * 32 + (swz % 64) / 2; }
__host__ __device__ __forceinline__ int perm32(int rho) { const int n = rho >> 4, i = rho & 15; return 8 * (i >> 2) + 4 * n + (i & 3); }

struct Unit { int pm, pn; };
struct Gemm { const bf16_t* A; const bf16_t* Bt; int M, N, K; };

struct StaticOrder {
    int nM, nN, nwg, G, c;
    __host__ __device__ void init(int M, int N, int G_, int c_) { nM = M / BM; nN = N / BM; nwg = nM * nN; G = G_; c = c_; }
    __host__ __device__ bool next(int i, Unit& u) const {
        const long L = (long)i * G + c; if (L >= nwg) return false;
        int wgid = (int)L; { const int q = nwg / NXCD, r = nwg % NXCD, xcd = wgid % NXCD, off = wgid / NXCD; wgid = (xcd < r ? xcd * (q + 1) : r * (q + 1) + (xcd - r) * q) + off; }
        const int nig = WGM * nN, gid = wgid / nig, fm = gid * WGM, gsz = (nM - fm) < WGM ? (nM - fm) : WGM;
        u.pm = fm + ((wgid % nig) % gsz); u.pn = (wgid % nig) / gsz; return true;
    }
    __device__ __forceinline__ void a_ready(const Unit&) const {}
    __device__ __forceinline__ void done(const Unit&) const {}
};

__device__ __forceinline__ unsigned cvt_pk_bf16(float lo, float hi) { typedef float v2f __attribute__((ext_vector_type(2))); typedef __bf16 v2b __attribute__((ext_vector_type(2))); const v2f v = {lo, hi}; return __builtin_bit_cast(unsigned, __builtin_convertvector(v, v2b)); }
__device__ __forceinline__ u32x4 pack8(const f32x4 v0, const f32x4 v1) { u32x4 w; w.x = cvt_pk_bf16(v0[0], v0[1]); w.y = cvt_pk_bf16(v0[2], v0[3]); w.z = cvt_pk_bf16(v1[0], v1[1]); w.w = cvt_pk_bf16(v1[2], v1[3]); return w; }
struct EpiQ {
    static constexpr bool PERM = true, AFTER_DRAIN = false;
    bf16_t* O; int ldc;
    __device__ __forceinline__ void operator()(const f32x4 (&acc)[2][2][4][2], const Unit& u, int wr, int wc, int fr, int fq) const {
        const int row0 = u.pm * BM + wr * 64 + fr, col0 = u.pn * BM + wc * 32 + 8 * fq;
#pragma unroll
        for (int ai = 0; ai < 2; ++ai)
#pragma unroll
            for (int m = 0; m < 4; ++m) { bf16_t* rowp = O + (size_t)(row0 + ai * HALF + m * 16) * ldc + col0;
#pragma unroll
                for (int bj = 0; bj < 2; ++bj) *(u32x4*)(rowp + bj * HALF) = pack8(acc[ai][bj][m][0], acc[ai][bj][m][1]); }
    }
};
struct EpiWinP {
    static constexpr bool PERM = true, AFTER_DRAIN = false;
    bf16_t* qkv; bf16_t* z; float* ab;
    __device__ __forceinline__ void operator()(const f32x4 (&acc)[2][2][4][2], const Unit& u, int wr, int wc, int fr, int fq) const {
        const int row0 = u.pm * BM + wr * 64 + fr;
        if (u.pn < 16) {
            bf16_t* base = u.pn < 12 ? qkv : z; const int ldc = u.pn < 12 ? 3072 : 1024, col0 = (u.pn < 12 ? u.pn : u.pn - 12) * BM + wc * 32 + 8 * fq;
#pragma unroll
            for (int ai = 0; ai < 2; ++ai)
#pragma unroll
                for (int m = 0; m < 4; ++m) { bf16_t* rowp = base + (size_t)(row0 + ai * HALF + m * 16) * ldc + col0;
#pragma unroll
                    for (int bj = 0; bj < 2; ++bj) *(u32x4*)(rowp + bj * HALF) = pack8(acc[ai][bj][m][0], acc[ai][bj][m][1]); }
        } else if (wc == 0) {
#pragma unroll
            for (int ai = 0; ai < 2; ++ai)
#pragma unroll
                for (int m = 0; m < 4; ++m) { float* rowp = ab + (size_t)(row0 + ai * HALF + m * 16) * 32 + 8 * fq;
                    *(f32x4*)rowp = acc[ai][0][m][0]; *(f32x4*)(rowp + 4) = acc[ai][0][m][1]; }
        }
    }
};
struct EpiRes {
    static constexpr bool PERM = true, AFTER_DRAIN = false;
    bf16_t* h; const float* gate;
    __device__ __forceinline__ void operator()(const f32x4 (&acc)[2][2][4][2], const Unit& u, int wr, int wc, int fr, int fq) const {
        const int row0 = u.pm * BM + wr * 64 + fr, col0 = u.pn * BM + wc * 32 + 8 * fq;
#pragma unroll
        for (int ai = 0; ai < 2; ++ai)
#pragma unroll
            for (int m = 0; m < 4; ++m) { const int row = row0 + ai * HALF + m * 16; bf16_t* rowp = h + (size_t)row * 1024 + col0; const float* gp = gate + (row >> 11) * 6144 + col0;
#pragma unroll
                for (int bj = 0; bj < 2; ++bj) {
                    const u32x4 hv = *(const u32x4*)(rowp + bj * HALF);
                    const f32x4 g0 = *(const f32x4*)(gp + bj * HALF), g1 = *(const f32x4*)(gp + bj * HALF + 4);
                    const f32x4 a0 = acc[ai][bj][m][0], a1 = acc[ai][bj][m][1];
                    f32x4 n0, n1;
                    n0[0] = __uint_as_float(hv.x << 16) + g0[0] * a0[0]; n0[1] = __uint_as_float(hv.x & 0xffff0000u) + g0[1] * a0[1];
                    n0[2] = __uint_as_float(hv.y << 16) + g0[2] * a0[2]; n0[3] = __uint_as_float(hv.y & 0xffff0000u) + g0[3] * a0[3];
                    n1[0] = __uint_as_float(hv.z << 16) + g1[0] * a1[0]; n1[1] = __uint_as_float(hv.z & 0xffff0000u) + g1[1] * a1[1];
                    n1[2] = __uint_as_float(hv.w << 16) + g1[2] * a1[2]; n1[3] = __uint_as_float(hv.w & 0xffff0000u) + g1[3] * a1[3];
                    *(u32x4*)(rowp + bj * HALF) = pack8(n0, n1);
                } }
    }
};

template <class Epi, class Sched, bool ALIGN_EPI = false, bool SP2 = false>
__device__ __forceinline__ void gemm_phase(PG8_LAS unsigned char* lds, const Gemm g, const Sched& S, const Epi& E) {
    const int tid = tid_fresh(), wid = __builtin_amdgcn_readfirstlane(tid >> 6), lane = tid & 63, wr = wid >> 2, wc = wid & 3, fr = lane & 15, fq = lane >> 4;
    const int K = g.K, nt = K / BK;
    unsigned voffA[2], voffB[2];
#pragma unroll
    for (int i = 0; i < 2; ++i) { int R, C; stage_rc(tid * 16 + i * 8192, R, C); const int Rb = Epi::PERM ? ((R & ~31) + perm32(R & 31)) : R;
        voffA[i] = (unsigned)(R * K + C) * 2u; voffB[i] = (unsigned)(Rb * K + C) * 2u; }
    const size_t kstep = (size_t)(BK * 2);
    const size_t hstep = (size_t)HALF * K * 2;
    const size_t tstep = 2 * hstep;
    const unsigned ldsw = (unsigned)wid * 1024u;
    const int aoff = lds_byte(wr * 64 + fr, fq * 8), boff = lds_byte(wc * 32 + fr, fq * 8);
#define PG8_SA(b, h) (((b) * 2 + (h)) * HTB)
#define PG8_SB(b, h) ((4 + (b) * 2 + (h)) * HTB)
#define PG8_STAGE(bufoff, gbase, voff) do { _Pragma("unroll") for (int _i = 0; _i < 2; ++_i) \
        __builtin_amdgcn_global_load_lds((const unsigned*)((const char*)(gbase) + (voff)[_i]), (PG8_LAS unsigned*)(lds + (bufoff) + ldsw + _i * 8192), 16, 0, 0); } while (0)
#define PG8_LDA(dst, b, h) do { _Pragma("unroll") for (int m = 0; m < 4; ++m) _Pragma("unroll") for (int k = 0; k < 2; ++k) dst[m][k] = *(const PG8_LAS bf16x8*)(lds + PG8_SA(b, h) + aoff + m * 2048 + k * 1024); } while (0)
#define PG8_LDB(dst, b, h) do { _Pragma("unroll") for (int n = 0; n < 2; ++n) _Pragma("unroll") for (int k = 0; k < 2; ++k) dst[n][k] = *(const PG8_LAS bf16x8*)(lds + PG8_SB(b, h) + boff + n * 2048 + k * 1024); } while (0)
#define PG8_MMA(ai, bj, At, Bt) do { __builtin_amdgcn_s_setprio(1); _Pragma("unroll") for (int m = 0; m < 4; ++m) _Pragma("unroll") for (int n = 0; n < 2; ++n) _Pragma("unroll") for (int k = 0; k < 2; ++k) \
        acc[ai][bj][m][n] = __builtin_amdgcn_mfma_f32_16x16x32_bf16(Bt[n][k], At[m][k], acc[ai][bj][m][n], 0, 0, 0); __builtin_amdgcn_s_setprio(0); } while (0)
#define PG8_WAIT_V(n) asm volatile("s_waitcnt vmcnt(" #n ")" ::: "memory")
#define PG8_WAIT_L(n) asm volatile("s_waitcnt lgkmcnt(" #n ")" ::: "memory")
#define PG8_BAR __builtin_amdgcn_s_barrier()
#define PG8_SCHED __builtin_amdgcn_sched_barrier(0)
    Unit cur, nxt; int ui = 0;
    if (!S.next(0, cur)) return;
    f32x4 acc[2][2][4][2];
#pragma unroll
    for (int a = 0; a < 2; ++a)
#pragma unroll
        for (int b = 0; b < 2; ++b)
#pragma unroll
            for (int m = 0; m < 4; ++m)
#pragma unroll
                for (int n = 0; n < 2; ++n) acc[a][b][m][n] = (f32x4){0.f, 0.f, 0.f, 0.f};
    bf16x8 At[4][2], B0[2][2], B1[2][2];
    const char* cA = (const char*)g.A + (size_t)cur.pm * tstep; const char* cB = (const char*)g.Bt + (size_t)cur.pn * tstep;
    S.a_ready(cur);
    if constexpr (SP2) {
        PG8_STAGE(PG8_SB(0, 0), cB, voffB); PG8_STAGE(PG8_SB(0, 1), cB + hstep, voffB); PG8_STAGE(PG8_SA(0, 0), cA, voffA); PG8_STAGE(PG8_SA(0, 1), cA + hstep, voffA);
        if (wr == 1) PG8_BAR;
        PG8_WAIT_V(2); PG8_BAR;
        PG8_STAGE(PG8_SB(1, 0), cB + kstep, voffB); PG8_STAGE(PG8_SA(1, 0), cA + kstep, voffA); PG8_STAGE(PG8_SB(1, 1), cB + hstep + kstep, voffB);
        PG8_WAIT_V(6); PG8_BAR;
    } else {
        PG8_STAGE(PG8_SB(0, 0), cB, voffB); PG8_STAGE(PG8_SA(0, 0), cA, voffA); PG8_STAGE(PG8_SB(0, 1), cB + hstep, voffB); PG8_STAGE(PG8_SA(0, 1), cA + hstep, voffA);
        if (wr == 1) PG8_BAR;
        PG8_WAIT_V(4); PG8_BAR;
        PG8_STAGE(PG8_SB(1, 0), cB + kstep, voffB); PG8_STAGE(PG8_SA(1, 0), cA + kstep, voffA); PG8_STAGE(PG8_SB(1, 1), cB + hstep + kstep, voffB);
        PG8_WAIT_V(6); PG8_BAR;
    }
    for (;;) {
        const bool has_next = S.next(ui + 1, nxt);
        const char* nA = has_next ? (const char*)g.A + (size_t)nxt.pm * tstep : cA; const char* nB = has_next ? (const char*)g.Bt + (size_t)nxt.pn * tstep : cB;
        for (int t = 0; t < nt; t += 2) {
            const bool last = (t == nt - 2);
            const char* a1 = cA + (size_t)(t + 1) * kstep;
            const char* a2 = last ? nA : cA + (size_t)(t + 2) * kstep; const char* b2 = last ? nB : cB + (size_t)(t + 2) * kstep;
            const char* a3 = a2 + kstep; const char* b3 = b2 + kstep;
            if (last && has_next) S.a_ready(nxt);
            if constexpr (SP2) {
            PG8_LDB(B0, 0, 0); PG8_LDB(B1, 0, 1); PG8_SCHED; PG8_LDA(At, 0, 0); PG8_STAGE(PG8_SA(1, 1), a1 + hstep, voffA);
            PG8_WAIT_V(8); PG8_WAIT_L(0); PG8_BAR; PG8_MMA(0, 0, At, B0); PG8_MMA(0, 1, At, B1); PG8_BAR; PG8_SCHED;
            PG8_LDA(At, 0, 1); PG8_STAGE(PG8_SB(0, 0), b2, voffB); PG8_STAGE(PG8_SB(0, 1), b2 + hstep, voffB); PG8_STAGE(PG8_SA(0, 0), a2, voffA);
            PG8_WAIT_V(8); PG8_WAIT_L(0); PG8_BAR; PG8_MMA(1, 0, At, B0); PG8_MMA(1, 1, At, B1); PG8_BAR; PG8_SCHED;
            PG8_LDB(B0, 1, 0); PG8_LDB(B1, 1, 1); PG8_SCHED; PG8_LDA(At, 1, 0); PG8_STAGE(PG8_SA(0, 1), a2 + hstep, voffA);
            PG8_WAIT_V(8); PG8_WAIT_L(0); PG8_BAR; PG8_MMA(0, 0, At, B0); PG8_MMA(0, 1, At, B1); PG8_BAR; PG8_SCHED;
            PG8_LDA(At, 1, 1); PG8_STAGE(PG8_SB(1, 0), b3, voffB); PG8_STAGE(PG8_SB(1, 1), b3 + hstep, voffB); PG8_STAGE(PG8_SA(1, 0), a3, voffA);
            PG8_WAIT_V(8); PG8_WAIT_L(0); PG8_BAR; PG8_MMA(1, 0, At, B0); PG8_MMA(1, 1, At, B1); PG8_BAR; PG8_SCHED;
            } else {
            PG8_LDB(B0, 0, 0); PG8_SCHED; PG8_LDA(At, 0, 0); PG8_STAGE(PG8_SA(1, 1), a1 + hstep, voffA);
            PG8_WAIT_L(8); PG8_BAR; PG8_WAIT_L(0); PG8_MMA(0, 0, At, B0); PG8_BAR; PG8_SCHED;
            PG8_LDB(B1, 0, 1); PG8_STAGE(PG8_SB(0, 0), b2, voffB);
            PG8_BAR; PG8_WAIT_L(0); PG8_MMA(0, 1, At, B1); PG8_BAR;
            PG8_LDA(At, 0, 1); PG8_STAGE(PG8_SA(0, 0), a2, voffA);
            PG8_BAR; PG8_WAIT_L(0); PG8_MMA(1, 0, At, B0); PG8_BAR; PG8_SCHED;
            PG8_STAGE(PG8_SB(0, 1), b2 + hstep, voffB);
            PG8_WAIT_V(6); PG8_BAR; PG8_MMA(1, 1, At, B1); PG8_BAR;
            PG8_LDB(B0, 1, 0); PG8_SCHED; PG8_LDA(At, 1, 0); PG8_STAGE(PG8_SA(0, 1), a2 + hstep, voffA);
            PG8_WAIT_L(8); PG8_BAR; PG8_WAIT_L(0); PG8_MMA(0, 0, At, B0); PG8_BAR; PG8_SCHED;
            PG8_LDB(B1, 1, 1); PG8_STAGE(PG8_SB(1, 0), b3, voffB);
            PG8_BAR; PG8_WAIT_L(0); PG8_MMA(0, 1, At, B1); PG8_BAR;
            PG8_LDA(At, 1, 1); PG8_STAGE(PG8_SA(1, 0), a3, voffA);
            PG8_BAR; PG8_WAIT_L(0); PG8_MMA(1, 0, At, B0); PG8_BAR; PG8_SCHED;
            PG8_STAGE(PG8_SB(1, 1), b3 + hstep, voffB);
            PG8_WAIT_V(6); PG8_BAR; PG8_MMA(1, 1, At, B1); PG8_BAR;
            }
        }
        if constexpr (ALIGN_EPI) { if (wr == 0) PG8_BAR; }
        if constexpr (!Epi::AFTER_DRAIN) { E(acc, cur, wr, wc, fr, fq); S.done(cur); }
        if (!has_next) break;
#pragma unroll
        for (int a = 0; a < 2; ++a)
#pragma unroll
            for (int b = 0; b < 2; ++b)
#pragma unroll
                for (int m = 0; m < 4; ++m)
#pragma unroll
                    for (int n = 0; n < 2; ++n) acc[a][b][m][n] = (f32x4){0.f, 0.f, 0.f, 0.f};
        cur = nxt; cA = nA; cB = nB; ++ui;
        if constexpr (ALIGN_EPI) { if (wr == 1) PG8_BAR; }
    }
    PG8_WAIT_V(0);
    if constexpr (!ALIGN_EPI) { if (wr == 0) PG8_BAR; }
    PG8_BAR;
    if constexpr (Epi::AFTER_DRAIN) { E.fused(acc, cur, wr, wc, fr, fq, lds, wid, lane); S.done(cur); }
#undef PG8_SA
#undef PG8_SB
#undef PG8_STAGE
#undef PG8_LDA
#undef PG8_LDB
#undef PG8_MMA
#undef PG8_WAIT_V
#undef PG8_WAIT_L
#undef PG8_BAR
#undef PG8_SCHED
}
}

#define XB_TMO      128
#define XB_XCNT(j)  (256  + 64 * (j))
#define XB_XSUB(j)  (1280 + 64 * (j))
#define XB_XGEN(j)  (2304 + 64 * (j))
#define XB_TOP      3328
#define XB_TOPGEN   3392
#define XCD_BAR_WORDS 3456
#define XB_SPIN_CAP (1u << 22)
DEV unsigned xb_ld(unsigned* p)              { return __hip_atomic_load(p, __ATOMIC_RELAXED, __HIP_MEMORY_SCOPE_AGENT); }
DEV unsigned xb_add(unsigned* p, unsigned v) { return __hip_atomic_fetch_add(p, v, __ATOMIC_RELAXED, __HIP_MEMORY_SCOPE_AGENT); }
DEV unsigned xb_xcc_id() { return (unsigned)__builtin_amdgcn_s_getreg((3 << 11) | 20) & 0xFu; }
#define XB_SPIN(cond, bar) do { unsigned _sp = 0; while (cond) { __builtin_amdgcn_s_sleep(1); \
    if ((++_sp & 255u) == 0u) { if (xb_ld(&(bar)[XB_TMO])) break; if (_sp > XB_SPIN_CAP) { atomicAdd(&(bar)[XB_TMO], 1u); break; } } } } while (0)
struct XcdBarrier { unsigned* bar; unsigned x; volatile LAS unsigned* st; };
DEV XcdBarrier xcd_barrier_post(unsigned* bar, volatile LAS unsigned* st) {
    XcdBarrier b; b.bar = bar; b.x = xb_xcc_id(); b.st = st;
    if (threadIdx.x == 0) (void)xb_add(&bar[XB_XCNT(b.x)], 1u);
    return b;
}
DEV void xcd_barrier_complete(unsigned* bar, unsigned x, unsigned& nloc, unsigned& nx) {
    const unsigned G = gridDim.x * gridDim.y * gridDim.z;
    unsigned sum, cnt, mine, sp = 0u;
    for (;;) {
        sum = 0u; cnt = 0u; mine = 0u;
#pragma unroll
        for (unsigned j = 0; j < 16; ++j) { const unsigned c = xb_ld(&bar[XB_XCNT(j)]); sum += c; cnt += (c > 0u) ? 1u : 0u; mine = (j == x) ? c : mine; }
        if (sum == G) break;
        __builtin_amdgcn_s_sleep(1);
        if ((++sp & 255u) == 0u) { if (xb_ld(&bar[XB_TMO])) break; if (sp > XB_SPIN_CAP) { atomicAdd(&bar[XB_TMO], 1u); break; } }
    }
    nloc = mine > 0u ? mine : 1u; nx = cnt > 0u ? cnt : 1u;
}
DEV void xcd_barrier(const XcdBarrier& b) {
    asm volatile("s_waitcnt vmcnt(0)" ::: "memory");
    __syncthreads();
    if (threadIdx.x == 0) {
        unsigned* bar = b.bar;
        __builtin_amdgcn_s_waitcnt(0);
        unsigned nloc = b.st[0], nx = b.st[1];
        if (nloc == 0u) { xcd_barrier_complete(bar, b.x, nloc, nx); b.st[0] = nloc; b.st[1] = nx; }
        const unsigned old = xb_add(&bar[XB_XSUB(b.x)], 1u);
        const unsigned gen = old / nloc;
        if (old + 1u == (gen + 1u) * nloc) {
            __builtin_amdgcn_fence(__ATOMIC_RELEASE, "agent");
            asm volatile("s_waitcnt vmcnt(0)" ::: "memory");
            const unsigned og = xb_add(&bar[XB_TOP], 1u);
            const unsigned tg = og / nx;
            if (og + 1u == (tg + 1u) * nx) xb_add(&bar[XB_TOPGEN], 1u);
            else XB_SPIN(xb_ld(&bar[XB_TOPGEN]) == tg, bar);
            __builtin_amdgcn_fence(__ATOMIC_ACQUIRE, "agent");
            xb_add(&bar[XB_XGEN(b.x)], 1u);
            asm volatile("s_waitcnt vmcnt(0)" ::: "memory");
        } else {
            XB_SPIN(xb_ld(&bar[XB_XGEN(b.x)]) == gen, bar);
            __builtin_amdgcn_fence(__ATOMIC_ACQUIRE, "agent");
            asm volatile("s_waitcnt vmcnt(0)" ::: "memory");
        }
    }
    __syncthreads();
}

__global__ void __launch_bounds__(NTHREADS) fwd_megakernel(Params P) {
    __shared__ __attribute__((aligned(16))) unsigned char lds_raw[131072 + 4096];
    const ldsp lds = (ldsp)lds_raw;
    cg::grid_group grid = cg::this_grid();
    volatile LAS unsigned* xbst = (volatile LAS unsigned*)(lds + 131072);
    if (threadIdx.x == 0) { xbst[0] = 0u; xbst[1] = 0u; }
    __syncthreads();
    const XcdBarrier xbar = xcd_barrier_post((unsigned*)(P.ws + OFF_BAR), xbst);
    if (threadIdx.x == 0) xbst[2] = xb_add((unsigned*)(P.ws + OFF_BAR) + xbar.x, 1u);
#define GBAR() xcd_barrier(xbar)
    const float* modv = (const float*)(P.ws + OFF_MODV);
    bf16_t* Abuf = (bf16_t*)(P.ws + OFF_A);

#define RUN(rep, ...) for (int rep_i = 0; rep_i < (rep); ++rep_i) { __VA_ARGS__; GBAR(); }
    for (int rep_i = 0; rep_i < REP_PREP; ++rep_i) { phase_prep(P, lds); grid.sync(); }
    if (threadIdx.x == 0) {
        unsigned* bar = (unsigned*)(P.ws + OFF_BAR);
        unsigned nact = 0, pos = 0, mine = 1;
        for (unsigned j = 0; j < 16; ++j) { const unsigned cn = xb_ld(&bar[XB_XCNT(j)]); if (cn) { if (j < xbar.x) ++pos; ++nact; } if (j == xbar.x) mine = cn; }
        xbst[3] = nact ? nact : 1u; xbst[4] = pos; xbst[5] = mine ? mine : 1u;
    }
    __syncthreads();
    XGeo geo; geo.rank = __builtin_amdgcn_readfirstlane((int)xbst[2]); geo.nact = __builtin_amdgcn_readfirstlane((int)xbst[3]); geo.pos = __builtin_amdgcn_readfirstlane((int)xbst[4]); geo.nloc = __builtin_amdgcn_readfirstlane((int)xbst[5]);
    RUN(REP_MOD, phase_modulate<0>(P, 0, 0, NT))
    RUN(REP_POOL, phase_pool(P, lds))
    RUN(REP_MOD, phase_modulate<1>(P, 0, 1, NT, true))
    RUN(REP_GEMM, { pg8::Gemm g{Abuf, (const bf16_t*)(P.ws + OFF_WQT), NT, 2048, 1024}; pg8::StaticOrder S; S.init(NT, 2048, gridDim.x, blockIdx.x); pg8::EpiQ e{(bf16_t*)(P.ws + OFF_R1), 2048}; pg8::gemm_phase<pg8::EpiQ, pg8::StaticOrder, true, true>(lds, g, S, e); })
    RUN(REP_TOPK, phase_topk(P, 0, NT, lds))
    phase_experts(P, 0, NT, lds); GBAR();
    RUN(REP_MOD, phase_modulate<1>(P, 1, 0, NT))
    RUN(REP_GEMM, { pg8::Gemm g{Abuf, (const bf16_t*)(P.ws + OFF_WINT), NT, 4352, 1024}; pg8::StaticOrder S; S.init(NT, 4352, gridDim.x, blockIdx.x);
      pg8::EpiWinP e{(bf16_t*)(P.ws + OFF_R1), (bf16_t*)(P.ws + OFF_PZ), (float*)(P.ws + OFF_AB)}; pg8::gemm_phase<pg8::EpiWinP, pg8::StaticOrder, true, true>(lds, g, S, e); })
    RUN(REP_CONV, phase_conv(P))
    RUN(REP_CHUNK, phase_chunk(P, lds))
    RUN(REP_SCAN, phase_scan(P, lds))
    RUN(REP_DNOUT, phase_dnout(P))
    { pg8::Gemm g{Abuf, (const bf16_t*)(P.ws + OFF_WOUTT), NX, 1024, 1024}; pg8::StaticOrder S; S.init(NX, 1024, gridDim.x, blockIdx.x); pg8::EpiRes e{(bf16_t*)(P.ws + OFF_H), modv + 9 * 6144 + 2048}; pg8::gemm_phase<pg8::EpiRes, pg8::StaticOrder, false, true>(lds, g, S, e); }
    GBAR();
    RUN(REP_MOD, phase_modulate<1>(P, 1, 1, NX, true))
    RUN(REP_GEMM, { pg8::Gemm g{Abuf, (const bf16_t*)(P.ws + OFF_WQT) + (size_t)2048 * 1024, NX, 2048, 1024}; pg8::StaticOrder S; S.init(NX, 2048, gridDim.x, blockIdx.x); pg8::EpiQ e{(bf16_t*)(P.ws + OFF_R1), 2048}; pg8::gemm_phase<pg8::EpiQ, pg8::StaticOrder, true, true>(lds, g, S, e); })
    RUN(REP_TOPK, phase_topk(P, 1, NX, lds))
    phase_experts(P, 1, NX, lds); GBAR();
    phase_final(P);
}

extern "C" void kernel_launch(void* const* d_in, const int* in_sizes, int n_in, void* d_out, int out_size, void* d_ws, size_t ws_size, hipStream_t stream) {
    static int grid_blocks = 0;
    if (grid_blocks == 0) {
        if (n_in != 21 || out_size != NX * D || ws_size < WS_END) {
            fprintf(stderr, "kernel_launch: unexpected shapes: n_in %d out %d ws %zu (need %zu)\n", n_in, out_size, ws_size, (size_t)WS_END);
            grid_blocks = -1; return;
        }
        int dev = 0, cus = 0, per_cu = 0;
        hipGetDevice(&dev);
        hipDeviceGetAttribute(&cus, hipDeviceAttributeMultiprocessorCount, dev);
        hipOccupancyMaxActiveBlocksPerMultiprocessor(&per_cu, fwd_megakernel, NTHREADS, 0);
        if (per_cu < 1) { fprintf(stderr, "kernel_launch: occupancy query reports %d blocks per CU\n", per_cu); grid_blocks = -1; return; }
        grid_blocks = cus;
    }
    if (grid_blocks < 0) return;
    if (hipMemsetAsync((char*)d_ws + OFF_BAR, 0, XCD_BAR_WORDS * 4, stream) != hipSuccess) { fprintf(stderr, "kernel_launch: memset of barrier words failed\n"); return; }
    Params p{};
    const float** pp = (const float**)&p;
    for (int i = 0; i < 21; ++i) pp[i] = (const float*)d_in[i];
    p.out = (float*)d_out; p.ws = (unsigned char*)d_ws;
    void* args[] = {&p};
    hipError_t e = hipLaunchCooperativeKernel((void*)fwd_megakernel, dim3(grid_blocks), dim3(NTHREADS), args, 0, stream);
    if (e != hipSuccess) fprintf(stderr, "cooperative launch failed: %s (grid %d)\n", hipGetErrorString(e), grid_blocks);
}
```

```cpp
#include <hip/hip_runtime.h>
#include <hip/hip_cooperative_groups.h>
#include <cstdio>
#include <cstdint>
namespace cg = cooperative_groups;

#define DEV __device__ __forceinline__
typedef unsigned short bf16_t;
typedef short bf16x8 __attribute__((ext_vector_type(8)));
typedef float f32x4 __attribute__((ext_vector_type(4)));
typedef float f32x16 __attribute__((ext_vector_type(16)));
typedef unsigned u32x4 __attribute__((ext_vector_type(4)));
typedef unsigned u32x2 __attribute__((ext_vector_type(2)));
#define LAS __attribute__((address_space(3)))
typedef LAS unsigned char* ldsp;
DEV int tid_fresh() { int t = threadIdx.x; asm volatile("" : "+v"(t)); return t; }
DEV ldsp launder(ldsp p) { asm volatile("" : "+v"(p)); return p; }

constexpr int D = 1024, NB = 8, SEQ = 2048, CTX = 256;
constexpr int NX = NB * SEQ, NC = NB * CTX, NT = NX + NC;
constexpr int NTHREADS = 512;
constexpr float EPS = 1e-6f;
#ifndef REP_PREP
#define REP_PREP 1
#endif
#ifndef REP_MOD
#define REP_MOD 1
#endif
#ifndef REP_POOL
#define REP_POOL 1
#endif
#ifndef REP_GEMM
#define REP_GEMM 1
#endif
#ifndef REP_TOPK
#define REP_TOPK 1
#endif
#ifndef REP_CONV
#define REP_CONV 1
#endif
#ifndef REP_CHUNK
#define REP_CHUNK 1
#endif
#ifndef REP_SCAN
#define REP_SCAN 1
#endif
#ifndef REP_DNOUT
#define REP_DNOUT 1
#endif

constexpr size_t MiB = 1024 * 1024;
constexpr size_t TAB_ELEMS = (size_t)16384 * 1024;
constexpr size_t OFF_TAB   = 0;
constexpr size_t OFF_WQT   = 128 * MiB;
constexpr size_t OFF_WINT  = OFF_WQT + 8 * MiB;
constexpr size_t OFF_WOUTT = OFF_WINT + (size_t)4352 * 1024 * 2;
constexpr size_t OFF_POOLT = OFF_WOUTT + 2 * MiB;
constexpr size_t OFF_KEYS  = OFF_POOLT + 512 * 1024;
constexpr size_t OFF_MODV  = OFF_KEYS + 1 * MiB;
constexpr size_t OFF_HC    = OFF_MODV + 512 * 1024;
constexpr size_t OFF_SELI  = OFF_HC + 8 * MiB;
constexpr size_t OFF_SELG  = OFF_SELI + (size_t)NT * 128 * 4;
constexpr size_t OFF_AB    = OFF_SELG + (size_t)NT * 128 * 4;
constexpr size_t OFF_G     = OFF_AB + (size_t)NT * 32 * 4;
constexpr size_t OFF_BETA  = OFF_G + (size_t)2 * NT * 8 * 4;
constexpr size_t OFF_GC    = OFF_BETA + (size_t)2 * NT * 8 * 4;
constexpr size_t OFF_QC    = OFF_GC + (size_t)4608 * 64 * 4;
constexpr size_t OFF_KC    = OFF_QC + (size_t)NT * 1024 * 2;
constexpr size_t OFF_VC    = OFF_KC + (size_t)NT * 1024 * 2;
constexpr size_t OFF_A     = OFF_VC + (size_t)NT * 1024 * 2;
constexpr size_t OFF_R1    = OFF_A + (size_t)NT * 1024 * 2;
constexpr size_t OFF_PZ    = OFF_R1 + (size_t)NT * 3072 * 2;
constexpr size_t OFF_BAR   = OFF_R1 + (size_t)NT * 4096 * 2;
constexpr size_t OFF_H     = OFF_BAR + 16384;
constexpr size_t OFF_XS    = OFF_H + (size_t)NT * 1024 * 2;
constexpr size_t OFF_RSC   = OFF_XS + (size_t)NT * 4;
constexpr size_t WS_END    = OFF_RSC + (size_t)4 * 16384 * 4;
constexpr size_t OFF_WBUF  = OFF_A;
constexpr size_t OFF_UBUF  = OFF_A + (size_t)4608 * 8192 * 2;
constexpr size_t OFF_OBUF  = OFF_TAB + 64 * MiB;
constexpr size_t OFF_PART  = OFF_QC;
constexpr size_t OFF_WEXP  = OFF_QC + (size_t)8 * NT * 128 * 4;
constexpr size_t OFF_A8    = OFF_WEXP + (size_t)NT * 128 * 4;
static_assert(OFF_UBUF + (size_t)4608 * 8192 * 2 <= OFF_PZ, "w/u overlay must not reach Pz");
static_assert(OFF_A8 + (size_t)NT * 1024 <= OFF_A, "PEER partial buffers must fit the q/k/v conv region");

struct Params {
    const float *x, *c, *ctx, *c_ctx, *mod_w, *mod_b, *norm1_g, *norm2_g, *pool_w, *pool_scale;
    const float *dn_w_in, *dn_conv_w, *dn_a_log, *dn_dt_bias, *dn_norm_g, *dn_w_out;
    const float *peer_wq, *peer_keys, *peer_u, *peer_v, *final_g;
    float* out; unsigned char* ws;
};

DEV bf16_t f2bf(float f) { return __builtin_bit_cast(unsigned short, (__bf16)f); }
DEV float bf2f(bf16_t h) { return __uint_as_float(((unsigned)h) << 16); }
typedef float f32x2_t __attribute__((ext_vector_type(2)));
typedef __bf16 bf16x2_t __attribute__((ext_vector_type(2)));
DEV unsigned pk2(float a, float b) { const f32x2_t v = {a, b}; const bf16x2_t r = __builtin_convertvector(v, bf16x2_t); return __builtin_bit_cast(unsigned, r); }
DEV float bflo(unsigned u) { return __uint_as_float(u << 16); }
DEV float bfhi(unsigned u) { return __uint_as_float(u & 0xffff0000u); }
DEV float wave_sum(float v) {
#pragma unroll
    for (int o = 32; o >= 1; o >>= 1) v += __shfl_xor(v, o);
    return v;
}
DEV float wave_max(float v) {
#pragma unroll
    for (int o = 32; o >= 1; o >>= 1) v = fmaxf(v, __shfl_xor(v, o));
    return v;
}
DEV float sum16(float v) {
#pragma unroll
    for (int o = 8; o >= 1; o >>= 1) v += __shfl_xor(v, o);
    return v;
}
DEV f32x16 mfma32(bf16x8 a, bf16x8 b, f32x16 c) { return __builtin_amdgcn_mfma_f32_32x32x16_bf16(a, b, c, 0, 0, 0); }
DEV int crow(int reg, int lane) { return (reg & 3) + 8 * (reg >> 2) + 4 * (lane >> 5); }
DEV f32x16 zero16() { f32x16 z;
#pragma unroll
    for (int i = 0; i < 16; ++i) z[i] = 0.f; return z; }
DEV bf16_t* hrow(const Params& P, int r) { return (bf16_t*)(P.ws + OFF_H) + (size_t)r * 1024; }
DEV float silu(float v) { return v * __builtin_amdgcn_rcpf(1.f + __expf(-v)); }

DEV bf16x8 frag_row(const LAS bf16_t* m, int ld, int r0, int k0, int lane) {
    return *(const LAS bf16x8*)(m + (r0 + (lane & 31)) * ld + k0 + 8 * (lane >> 5));
}
DEV bf16x8 frag_col(const LAS bf16_t* m, int ld, int c0, int k0, int lane) {
    bf16x8 f;
#pragma unroll
    for (int j = 0; j < 8; ++j) f[j] = (short)m[(k0 + 8 * (lane >> 5) + j) * ld + c0 + (lane & 31)];
    return f;
}

typedef short s16x4 __attribute__((ext_vector_type(4)));
DEV s16x4 ds_tr16(ldsp p) { return __builtin_amdgcn_ds_read_tr16_b64_v4i16((LAS s16x4*)p); }
DEV bf16x8 frag_col_tr(const LAS bf16_t* m, int ld, int c0, int k0, int lane) {
    const int gi = lane >> 4, li = lane & 15, q = li >> 2, pc = li & 3, h = gi >> 1;
    const LAS bf16_t* p = m + (k0 + 8 * h + q) * ld + c0 + 16 * (gi & 1) + 4 * pc;
    const s16x4 lo = ds_tr16((ldsp)p), hi = ds_tr16((ldsp)(p + 4 * ld));
    bf16x8 f; f[0] = lo[0]; f[1] = lo[1]; f[2] = lo[2]; f[3] = lo[3]; f[4] = hi[0]; f[5] = hi[1]; f[6] = hi[2]; f[7] = hi[3];
    return f;
}
DEV void p0_convert_item(const float* src, bf16_t* dst, size_t base) {
    const int tid = tid_fresh();
#pragma unroll
    for (int it = 0; it < 8; ++it) {
        const size_t e = base + ((size_t)it * NTHREADS + tid) * 8;
        const f32x4 a = *(const f32x4*)(src + e), b = *(const f32x4*)(src + e + 4);
        u32x4 o; o.x = pk2(a.x, a.y); o.y = pk2(a.z, a.w); o.z = pk2(b.x, b.y); o.w = pk2(b.z, b.w);
        *(u32x4*)(dst + e) = o;
    }
}
DEV void p0_table_item(const float* src, unsigned char* dst, float* rscale, int row0, bool as_int8) {
    const int tid = tid_fresh(), wave = tid >> 6, lane = tid & 63;
#pragma unroll 8
    for (int rr = 0; rr < 16; ++rr) {
        const int e = row0 + wave * 16 + rr;
        f32x4 v[4]; float am = 0.f;
#pragma unroll
        for (int q = 0; q < 4; ++q) { v[q] = __builtin_nontemporal_load((const f32x4*)(src + (size_t)e * 1024 + 256 * q + 4 * lane));
            am = fmaxf(am, fmaxf(fmaxf(fabsf(v[q].x), fabsf(v[q].y)), fmaxf(fabsf(v[q].z), fabsf(v[q].w)))); }
        am = wave_max(am);
        if (as_int8) {
            float ssq = 0.f;
#pragma unroll
            for (int q = 0; q < 4; ++q) ssq += v[q].x * v[q].x + v[q].y * v[q].y + v[q].z * v[q].z + v[q].w * v[q].w;
            ssq = wave_sum(ssq);
            const float top = fminf(am, 2.7f * sqrtf(ssq * (1.f / 1024.f)));
            am = top;
            const float sc = am > 0.f ? 7.f / am : 0.f;
#pragma unroll
            for (int q = 0; q < 4; ++q) {
                const int n0 = (int)fminf(fmaxf(rintf(v[q].x * sc), -7.f), 7.f) + 8, n1 = (int)fminf(fmaxf(rintf(v[q].y * sc), -7.f), 7.f) + 8;
                const int n2 = (int)fminf(fmaxf(rintf(v[q].z * sc), -7.f), 7.f) + 8, n3 = (int)fminf(fmaxf(rintf(v[q].w * sc), -7.f), 7.f) + 8;
                *(unsigned short*)(dst + ((size_t)q * 16384 + e) * 128 + 2 * lane) = (unsigned short)(n0 | (n1 << 4) | (n2 << 8) | (n3 << 12));
            }
            if (lane == 0) rscale[e] = am * (1.f / 7.f);
        } else {
            float ssq = 0.f;
#pragma unroll
            for (int q = 0; q < 4; ++q) ssq += v[q].x * v[q].x + v[q].y * v[q].y + v[q].z * v[q].z + v[q].w * v[q].w;
            ssq = wave_sum(ssq);
            const float top = fminf(am, 2.8f * sqrtf(ssq * (1.f / 1024.f)));
            const float sc = top > 0.f ? 6.f / top : 0.f;
#pragma unroll
            for (int q = 0; q < 4; ++q) {
                const float x0 = fminf(fmaxf(v[q].x * sc, -6.f), 6.f), x1 = fminf(fmaxf(v[q].y * sc, -6.f), 6.f), x2 = fminf(fmaxf(v[q].z * sc, -6.f), 6.f), x3 = fminf(fmaxf(v[q].w * sc, -6.f), 6.f);
                unsigned w = __builtin_amdgcn_cvt_scalef32_pk_fp4_f32(0u, x0, x1, 1.0f, 0);
                w = __builtin_amdgcn_cvt_scalef32_pk_fp4_f32(w, x2, x3, 1.0f, 1);
                *(unsigned short*)(dst + ((size_t)q * 16384 + e) * 128 + 2 * lane) = (unsigned short)(w & 0xffffu);
            }
            if (lane == 0) rscale[e] = top * (1.f / 6.f);
        }
    }
}
DEV void p0_transpose_item(const float* W, int K, int N, bf16_t* Wt, int kt, int nt, LAS float* tile) {
    const int tid = tid_fresh(), k0 = kt * 64, n0 = nt * 256;
    f32x4 v[8];
#pragma unroll
    for (int p = 0; p < 8; ++p) {
        const int kk = p * 8 + (tid >> 6), nn = (tid & 63) * 4, n = n0 + nn;
        v[p] = (f32x4){0.f, 0.f, 0.f, 0.f};
        if (n < N) v[p] = __builtin_nontemporal_load((const f32x4*)(W + (size_t)(k0 + kk) * N + n));
    }
#pragma unroll
    for (int p = 0; p < 8; ++p) {
        const int kk = p * 8 + (tid >> 6), nn = (tid & 63) * 4;
        tile[kk * 257 + nn + 0] = v[p].x; tile[kk * 257 + nn + 1] = v[p].y; tile[kk * 257 + nn + 2] = v[p].z; tile[kk * 257 + nn + 3] = v[p].w;
    }
    __syncthreads();
#pragma unroll
    for (int q = 0; q < 4; ++q) {
        const int n = q * 64 + (tid >> 3), kc = (tid & 7) * 8;
        u32x4 o;
        o.x = pk2(tile[(kc + 0) * 257 + n], tile[(kc + 1) * 257 + n]);
        o.y = pk2(tile[(kc + 2) * 257 + n], tile[(kc + 3) * 257 + n]);
        o.z = pk2(tile[(kc + 4) * 257 + n], tile[(kc + 5) * 257 + n]);
        o.w = pk2(tile[(kc + 6) * 257 + n], tile[(kc + 7) * 257 + n]);
        *(u32x4*)(Wt + (size_t)(n0 + n) * K + k0 + kc) = o;
    }
    __syncthreads();
}
DEV void p0_mod_item(const Params& P, int i, int cb, LAS float* lds) {
    LAS float* s = lds;
    LAS float* red = lds + 9 * 1024;
    const int tid = tid_fresh();
    for (int e = tid; e < 9 * 1024; e += NTHREADS) {
        const int m = e >> 10, k = e & 1023;
        const float cv = m < 8 ? P.c[m * 1024 + k] : P.c_ctx[k];
        s[e] = silu(cv);
    }
    __syncthreads();
    const int cq = tid & 31, kg = tid >> 5;
    const float* W = P.mod_w + (size_t)i * 1024 * 6144 + cb * 128 + cq * 4;
    f32x4 acc[9];
#pragma unroll
    for (int m = 0; m < 9; ++m) acc[m] = (f32x4){0.f, 0.f, 0.f, 0.f};
#pragma unroll 16
    for (int kk = 0; kk < 64; ++kk) {
        const int k = kg * 64 + kk;
        const f32x4 w = __builtin_nontemporal_load((const f32x4*)(W + (size_t)k * 6144));
#pragma unroll
        for (int m = 0; m < 9; ++m) { const float sv = s[m * 1024 + k]; acc[m] += w * sv; }
    }
#pragma unroll
    for (int m = 0; m < 9; ++m) *(LAS f32x4*)&red[(kg * 9 + m) * 128 + cq * 4] = acc[m];
    __syncthreads();
    float* modv = (float*)(P.ws + OFF_MODV);
    for (int e = tid; e < 9 * 128; e += NTHREADS) {
        const int m = e >> 7, col = e & 127;
        float sum = 0.f;
#pragma unroll
        for (int g = 0; g < 16; ++g) sum += red[(g * 9 + m) * 128 + col];
        modv[(size_t)(i * 9 + m) * 6144 + cb * 128 + col] = sum + P.mod_b[i * 6144 + cb * 128 + col];
    }
    __syncthreads();
}
DEV void phase_prep(const Params& P, ldsp lds0) {
    constexpr int N_MOD = 96, N_WQ = 2 * 16 * 8, N_WIN = 16 * 17, N_WOUT = 16 * 4, N_POOL = 4 * 4;
    constexpr int N_TR = N_WQ + N_WIN + N_WOUT + N_POOL, N_TAB = 4 * 128, N_KEYS = 16;
    constexpr int TOTAL = N_MOD + N_TR + N_TAB + N_KEYS;
    for (int item = blockIdx.x; item < TOTAL; item += gridDim.x) {
        LAS float* lds = (LAS float*)launder(lds0);
        int r = item;
        if (r < N_MOD) { p0_mod_item(P, r / 48, r % 48, lds); continue; }
        r -= N_MOD;
        if (r < N_WQ) { const int i = r / 128, t = r % 128;
            p0_transpose_item(P.peer_wq + (size_t)i * 1024 * 2048, 1024, 2048, (bf16_t*)(P.ws + OFF_WQT) + (size_t)i * 2048 * 1024, t / 8, t % 8, lds); continue; }
        r -= N_WQ;
        if (r < N_WIN) { p0_transpose_item(P.dn_w_in, 1024, 4128, (bf16_t*)(P.ws + OFF_WINT), r / 17, r % 17, lds); continue; }
        r -= N_WIN;
        if (r < N_WOUT) { p0_transpose_item(P.dn_w_out, 1024, 1024, (bf16_t*)(P.ws + OFF_WOUTT), r / 4, r % 4, lds); continue; }
        r -= N_WOUT;
        if (r < N_POOL) { const int g = r / 4, t = r % 4;
            p0_transpose_item(P.pool_w + (size_t)g * 65536, 256, 256, (bf16_t*)(P.ws + OFF_POOLT) + (size_t)g * 65536, t, 0, lds); continue; }
        r -= N_POOL;
        if (r < N_TAB) { const int tb = r / 128, ch = r % 128;
            const float* src = ((tb & 1) ? P.peer_v : P.peer_u) + (size_t)(tb >> 1) * TAB_ELEMS;
            p0_table_item(src, P.ws + OFF_TAB + (size_t)tb * 16 * MiB, (float*)(P.ws + OFF_RSC) + tb * 16384, ch * 128, (tb & 1) == 0); continue; }
        r -= N_TAB;
        p0_convert_item(P.peer_keys, (bf16_t*)(P.ws + OFF_KEYS), (size_t)r * 32768);
    }
}

template <int SRC>
DEV void phase_modulate(const Params& P, int layer, int which, int nrows, bool q8 = false) {
    const float* gain = (which ? P.norm2_g : P.norm1_g) + layer * 1024;
    const float* modv = (const float*)(P.ws + OFF_MODV) + (size_t)layer * 9 * 6144;
    bf16_t* A = (bf16_t*)(P.ws + OFF_A);
    const int tid = tid_fresh(); const int wave = tid >> 6, lane = tid & 63;
    for (int r = blockIdx.x * 8 + wave; r < nrows; r += gridDim.x * 8) {
        const int m = r < NX ? (r >> 11) : 8;
        const float* sh = modv + m * 6144 + which * 3072;
        const float* sc = sh + 1024;
        f32x4 v[4]; float ss = 0.f;
#pragma unroll
        for (int j = 0; j < 4; ++j) {
            if (SRC == 0) { const float* src = r < NX ? P.x + (size_t)r * 1024 : P.ctx + (size_t)(r - NX) * 1024; v[j] = *(const f32x4*)(src + j * 256 + lane * 4); }
            else { const u32x2 hv = *(const u32x2*)(hrow(P, r) + j * 256 + lane * 4); v[j] = (f32x4){bflo(hv.x), bfhi(hv.x), bflo(hv.y), bfhi(hv.y)}; }
            ss += v[j].x * v[j].x + v[j].y * v[j].y + v[j].z * v[j].z + v[j].w * v[j].w;
        }
        ss = wave_sum(ss);
        const float rstd = rsqrtf(ss * (1.f / 1024.f) + EPS);
#pragma unroll
        for (int j = 0; j < 4; ++j) {
            const int col = j * 256 + lane * 4;
            const f32x4 g = *(const f32x4*)(gain + col), s1 = *(const f32x4*)(sc + col), s0 = *(const f32x4*)(sh + col);
            const f32x4 y = v[j] * rstd * g * (1.f + s1) + s0;
            u32x2 o; o.x = pk2(y.x, y.y); o.y = pk2(y.z, y.w);
            *(u32x2*)(A + (size_t)r * 1024 + col) = o;
            v[j] = y;
        }
        if (q8) {
            float am = 0.f;
#pragma unroll
            for (int j = 0; j < 4; ++j) am = fmaxf(am, fmaxf(fmaxf(fabsf(v[j].x), fabsf(v[j].y)), fmaxf(fabsf(v[j].z), fabsf(v[j].w))));
            am = wave_max(am);
            const float sc = am > 0.f ? 127.f / am : 0.f;
            unsigned char* a8 = P.ws + OFF_A8 + (size_t)r * 1024;
#pragma unroll
            for (int j = 0; j < 4; ++j) {
                const int b0 = (int)rintf(v[j].x * sc), b1 = (int)rintf(v[j].y * sc), b2 = (int)rintf(v[j].z * sc), b3 = (int)rintf(v[j].w * sc);
                const unsigned mine = (unsigned)((b0 & 255) | ((b1 & 255) << 8) | ((b2 & 255) << 16) | ((b3 & 255) << 24));
                const unsigned other = (unsigned)__shfl_xor((int)mine, 1);
                const unsigned lo4 = (lane & 1) ? other : mine, hi4 = (lane & 1) ? mine : other;
                const unsigned outw = (lane & 1) ? __builtin_amdgcn_perm(hi4, lo4, 0x07050301u) : __builtin_amdgcn_perm(hi4, lo4, 0x06040200u);
                *(unsigned*)(a8 + j * 256 + lane * 4) = outw;
            }
            if (lane == 0) ((float*)(P.ws + OFF_XS))[r] = am * (1.f / 127.f);
        }
    }
}

DEV void unpack8(const u32x4 v, float* f) {
    f[0] = bflo(v.x); f[1] = bfhi(v.x); f[2] = bflo(v.y); f[3] = bfhi(v.y); f[4] = bflo(v.z); f[5] = bfhi(v.z); f[6] = bflo(v.w); f[7] = bfhi(v.w);
}
template <int W>
DEV void pool_vertical(const bf16_t* A0, LAS float* V, int b, int r, int cbase, int tq, int ch8, float (&cen)[4][8]) {
    const int rlo = max(0, r - W / 2), rhi = min(32, r - W / 2 + W);
    const float inv = 1.f / (float)(rhi - rlo);
#pragma unroll
    for (int jh = 0; jh < 2; ++jh) {
        u32x4 ld[2][W];
#pragma unroll
        for (int jj = 0; jj < 2; ++jj)
#pragma unroll
            for (int k = 0; k < W; ++k) {
                const int rr = min(rlo + k, 31), tok = tq + 16 * (2 * jh + jj);
                ld[jj][k] = *(const u32x4*)(A0 + ((size_t)b * 2048 + rr * 64 + tok) * 1024 + cbase);
            }
#pragma unroll
        for (int jj = 0; jj < 2; ++jj) {
            const int j = 2 * jh + jj, tok = tq + 16 * j;
            float acc[8];
#pragma unroll
            for (int e = 0; e < 8; ++e) acc[e] = 0.f;
#pragma unroll
            for (int k = 0; k < W; ++k) {
                float f[8]; unpack8(ld[jj][k], f);
                const bool in = rlo + k < rhi;
#pragma unroll
                for (int e = 0; e < 8; ++e) acc[e] += in ? f[e] : 0.f;
                if (rlo + k == r) {
#pragma unroll
                    for (int e = 0; e < 8; ++e) cen[j][e] = f[e];
                }
            }
            LAS float* vp = V + (tok + 8) * 260 + ch8 * 8;
            *(LAS f32x4*)vp = (f32x4){acc[0] * inv, acc[1] * inv, acc[2] * inv, acc[3] * inv};
            *(LAS f32x4*)(vp + 4) = (f32x4){acc[4] * inv, acc[5] * inv, acc[6] * inv, acc[7] * inv};
        }
    }
}
template <int W>
DEV void pool_horizontal(const LAS float* V, ldsp At, bool isx, int seg, int tq, int ch8, const float (&cen)[4][8]) {
#pragma unroll
    for (int j = 0; j < 4; ++j) {
        const int tok = tq + 16 * j;
        const int pos = isx ? tok : 64 * seg + tok, lim = isx ? 64 : 256, off = isx ? 8 : 8 - 64 * seg;
        const int lo = max(0, pos - W / 2), hi = min(lim, pos - W / 2 + W);
        f32x4 s0 = {0.f, 0.f, 0.f, 0.f}, s1 = {0.f, 0.f, 0.f, 0.f};
#pragma unroll
        for (int k = 0; k < W; ++k) {
            const int t = min(lo + k, lim - 1);
            const LAS float* vp = V + (t + off) * 260 + ch8 * 8;
            const f32x4 a = *(const LAS f32x4*)vp, b2 = *(const LAS f32x4*)(vp + 4);
            const float m = (lo + k < hi) ? 1.f : 0.f;
            s0 += a * m; s1 += b2 * m;
        }
        const float inv = 1.f / (float)(hi - lo);
        u32x4 o;
        o.x = pk2(s0.x * inv - cen[j][0], s0.y * inv - cen[j][1]);
        o.y = pk2(s0.z * inv - cen[j][2], s0.w * inv - cen[j][3]);
        o.z = pk2(s1.x * inv - cen[j][4], s1.y * inv - cen[j][5]);
        o.w = pk2(s1.z * inv - cen[j][6], s1.w * inv - cen[j][7]);
        *(LAS u32x4*)(At + tok * 512 + ((ch8 ^ (tok & 7)) << 4)) = o;
    }
}
DEV void phase_pool(const Params& P, ldsp lds0) {
    const bf16_t* A0 = (const bf16_t*)(P.ws + OFF_A);
    const float* modv = (const float*)(P.ws + OFF_MODV);
    const bf16_t* Wt = (const bf16_t*)(P.ws + OFF_POOLT);
    const int tid = tid_fresh(), lane = tid & 63, wave = tid >> 6;
    const int ch8 = tid & 31, tq = tid >> 5;
    for (int item = blockIdx.x; item < 1152; item += gridDim.x) {
        const ldsp lds = launder(lds0);
        LAS float* V = (LAS float*)lds;
        const ldsp At = lds + 80 * 260 * 4;
        const bool isx = item < 1024;
        int b, r = 0, seg = 0, g;
        if (isx) { b = item >> 7; r = (item >> 2) & 31; }
        else { const int it = item - 1024; b = it >> 4; seg = (it >> 2) & 3; }
        g = ((item & 3) + (item >> 8)) & 3;
        const int cbase = g * 256 + ch8 * 8;
        float cen[4][8];
        if (isx) {
            if (g == 0) pool_vertical<2>(A0, V, b, r, cbase, tq, ch8, cen);
            else if (g == 1) pool_vertical<4>(A0, V, b, r, cbase, tq, ch8, cen);
            else if (g == 2) pool_vertical<8>(A0, V, b, r, cbase, tq, ch8, cen);
            else pool_vertical<16>(A0, V, b, r, cbase, tq, ch8, cen);
        } else {
            for (int q = tq; q < 80; q += 16) {
                const int t = 64 * seg - 8 + q;
                if (t >= 0 && t < 256) {
                    const u32x4 pv = *(const u32x4*)(A0 + ((size_t)NX + b * 256 + t) * 1024 + cbase);
                    float f[8]; unpack8(pv, f);
                    LAS float* vp = V + q * 260 + ch8 * 8;
                    *(LAS f32x4*)vp = (f32x4){f[0], f[1], f[2], f[3]};
                    *(LAS f32x4*)(vp + 4) = (f32x4){f[4], f[5], f[6], f[7]};
                }
            }
#pragma unroll
            for (int j = 0; j < 4; ++j) {
                const int tok = tq + 16 * j;
                const u32x4 pv = *(const u32x4*)(A0 + ((size_t)NX + b * 256 + 64 * seg + tok) * 1024 + cbase);
                unpack8(pv, cen[j]);
            }
        }
        __syncthreads();
        if (g == 0) pool_horizontal<2>(V, At, isx, seg, tq, ch8, cen);
        else if (g == 1) pool_horizontal<4>(V, At, isx, seg, tq, ch8, cen);
        else if (g == 2) pool_horizontal<8>(V, At, isx, seg, tq, ch8, cen);
        else pool_horizontal<16>(V, At, isx, seg, tq, ch8, cen);
        __syncthreads();
        f32x16 acc[2]; acc[0] = zero16(); acc[1] = zero16();
        const bf16_t* Wg = Wt + (size_t)g * 65536 + (size_t)(32 * wave + (lane & 31)) * 256 + (lane >> 5) * 8;
#pragma unroll 4
        for (int ks = 0; ks < 16; ++ks) {
            const bf16x8 wfr = *(const bf16x8*)(Wg + ks * 16);
            const int ch = ks * 2 + (lane >> 5);
#pragma unroll
            for (int mt = 0; mt < 2; ++mt) {
                const int row = mt * 32 + (lane & 31);
                const bf16x8 a = *(const LAS bf16x8*)(At + row * 512 + ((ch ^ (row & 7)) << 4));
                acc[mt] = mfma32(wfr, a, acc[mt]);
            }
        }
        const int m = isx ? b : 8;
#pragma unroll
        for (int mt = 0; mt < 2; ++mt)
#pragma unroll
            for (int rg = 0; rg < 4; ++rg) {
                const int tok = mt * 32 + (lane & 31), col = g * 256 + 32 * wave + 8 * rg + 4 * (lane >> 5);
                const f32x4 gs = *(const f32x4*)(modv + m * 6144 + 2048 + col) * *(const f32x4*)(P.pool_scale + col);
                const f32x4 av = {acc[mt][rg * 4 + 0], acc[mt][rg * 4 + 1], acc[mt][rg * 4 + 2], acc[mt][rg * 4 + 3]};
                f32x4 hv; int grow;
                if (isx) { grow = b * 2048 + r * 64 + tok; hv = __builtin_nontemporal_load((const f32x4*)(P.x + (size_t)grow * 1024 + col)) + gs * av; }
                else { const size_t gi = ((size_t)b * 256 + 64 * seg + tok) * 1024 + col; grow = NX + b * 256 + 64 * seg + tok; hv = *(const f32x4*)(P.ctx + gi) + gs * av; }
                u32x2 hp; hp.x = pk2(hv.x, hv.y); hp.y = pk2(hv.z, hv.w);
                *(u32x2*)(hrow(P, grow) + col) = hp;
            }
        __syncthreads();
    }
}

DEV bf16x8 frag_row_x(ldsp x, int r0, int k0, int lane) {
    const int row = r0 + (lane & 31), ch = (k0 >> 3) + (lane >> 5);
    return *(const LAS bf16x8*)(x + row * 256 + ((ch ^ (row & 15)) << 4));
}
DEV unsigned key_of(float f) { const unsigned u = __float_as_uint(f); return u ^ ((unsigned)((int)u >> 31) | 0x80000000u); }
DEV float val_of(unsigned k) { const unsigned u = (k & 0x80000000u) ? (k ^ 0x80000000u) : ~k; return __uint_as_float(u); }
DEV void cmpx(unsigned& hi, unsigned& lo) { const unsigned a = hi, b = lo; hi = a > b ? a : b; lo = a > b ? b : a; }
DEV void sort16_desc(unsigned* v) {
#pragma unroll
    for (int k = 2; k <= 16; k <<= 1)
#pragma unroll
        for (int j = k >> 1; j > 0; j >>= 1)
#pragma unroll
            for (int i = 0; i < 16; ++i) {
                const int l = i ^ j;
                if (l > i) { if ((i & k) == 0) cmpx(v[i], v[l]); else cmpx(v[l], v[i]); }
            }
}
DEV void merge16(unsigned* r, const unsigned* b) {
#pragma unroll
    for (int k = 0; k < 16; ++k) r[k] = r[k] > b[15 - k] ? r[k] : b[15 - k];
#pragma unroll
    for (int j = 8; j > 0; j >>= 1)
#pragma unroll
        for (int i = 0; i < 16; ++i) { const int l = i ^ j; if (l > i) cmpx(r[i], r[l]); }
}
DEV void top16_of_64(unsigned* v, unsigned* r) {
#pragma unroll
    for (int blk = 0; blk < 4; ++blk) sort16_desc(v + 16 * blk);
#pragma unroll
    for (int k = 0; k < 16; ++k) r[k] = v[k];
    merge16(r, v + 16); merge16(r, v + 32); merge16(r, v + 48);
}
DEV void phase_topk(const Params& P, int layer, int nrows, ldsp lds0) {
    const bf16_t* Q = (const bf16_t*)(P.ws + OFF_R1);
    const bf16_t* keys = (const bf16_t*)(P.ws + OFF_KEYS) + (size_t)layer * 8 * 2 * 128 * 128;
    bf16_t* seli = (bf16_t*)(P.ws + OFF_SELI);
    float* selg = (float*)(P.ws + OFF_SELG);
    const int tid = tid_fresh(), lane = tid & 63, wave = tid >> 6;
    const int nitems = (nrows / 256) * 4;
    const unsigned hoff = (unsigned)(lane >> 5) * 4u;
    for (int item = blockIdx.x; item < nitems; item += gridDim.x) {
        const ldsp lds = launder(lds0);
        LAS unsigned* sl = (LAS unsigned*)(lds + 65536 + wave * 8192);
        const int tg = item >> 2, hp = item & 3, row0 = tg * 256 + wave * 32;
        u32x4 kr[4]; bf16x8 qf[8];
        {
            const bf16_t* kt = keys + (size_t)((hp * 2) * 2) * 128 * 128;
#pragma unroll
            for (int j = 0; j < 4; ++j) { const int cid = tid + NTHREADS * j, r = cid >> 4, ch = cid & 15; kr[j] = *(const u32x4*)(kt + r * 128 + ch * 8); }
#pragma unroll
            for (int j = 0; j < 4; ++j) { const int cid = tid + NTHREADS * j, r = cid >> 4, ch = cid & 15; *(LAS u32x4*)(lds + r * 256 + ((ch ^ (r & 15)) << 4)) = kr[j]; }
            const bf16_t* qb = Q + (size_t)(row0 + (lane & 31)) * 2048 + (hp * 2) * 256 + (lane >> 5) * 8;
#pragma unroll
            for (int ks = 0; ks < 8; ++ks) qf[ks] = *(const bf16x8*)(qb + ks * 16);
        }
        __syncthreads();
        unsigned s1[16], s2[16];
#pragma unroll
        for (int k = 0; k < 16; ++k) { s1[k] = 0u; s2[k] = 0u; }
#pragma unroll 1
        for (int step = 0; step < 4; ++step) {
            const int hs = step >> 1, p = step & 1;
            const bool mine = (lane >> 5) == hs;
            const ldsp kb = lds + (step & 1) * 32768;
            if (step < 3) {
                const bf16_t* kt = keys + (size_t)((hp * 2 + ((step + 1) >> 1)) * 2 + ((step + 1) & 1)) * 128 * 128;
#pragma unroll
                for (int j = 0; j < 4; ++j) { const int cid = tid + NTHREADS * j, r = cid >> 4, ch = cid & 15; kr[j] = *(const u32x4*)(kt + r * 128 + ch * 8); }
            }
            f32x16 acc[4];
#pragma unroll
            for (int mt = 0; mt < 4; ++mt) acc[mt] = zero16();
#pragma unroll
            for (int ks = 0; ks < 8; ++ks)
#pragma unroll
                for (int mt = 0; mt < 4; ++mt) acc[mt] = mfma32(frag_row_x(kb, mt * 32, ks * 16, lane), qf[ks], acc[mt]);
            if (step < 3) {
                const ldsp kn = lds + ((step + 1) & 1) * 32768;
#pragma unroll
                for (int j = 0; j < 4; ++j) { const int cid = tid + NTHREADS * j, r = cid >> 4, ch = cid & 15; *(LAS u32x4*)(kn + r * 256 + ((ch ^ (r & 15)) << 4)) = kr[j]; }
                const bf16_t* qb = Q + (size_t)(row0 + (lane & 31)) * 2048 + (hp * 2 + ((step + 1) >> 1)) * 256 + ((step + 1) & 1) * 128 + (lane >> 5) * 8;
#pragma unroll
                for (int ks = 0; ks < 8; ++ks) qf[ks] = *(const bf16x8*)(qb + ks * 16);
            }
            unsigned v[64];
#pragma unroll
            for (int mt = 0; mt < 4; ++mt)
#pragma unroll
                for (int reg = 0; reg < 16; ++reg) {
                    const unsigned c = mt * 32 + (reg & 3) + 8 * (reg >> 2);
                    v[mt * 16 + reg] = ((key_of(acc[mt][reg]) & ~127u) | (127u - c)) ^ hoff;
                }
            unsigned r[16], o[16];
            top16_of_64(v, r);
#pragma unroll
            for (int k = 0; k < 16; ++k) o[k] = (unsigned)__shfl_xor((int)r[k], 32);
            merge16(r, o);
#pragma unroll
            for (int k = 0; k < 16; ++k) { if (p == 0) s1[k] = mine ? r[k] : s1[k]; else s2[k] = mine ? r[k] : s2[k]; }
            __syncthreads();
        }
        float f1[16], f2[16];
#pragma unroll
        for (int k = 0; k < 16; ++k) {
            sl[k * 64 + lane] = s1[k]; sl[(16 + k) * 64 + lane] = s2[k];
            f1[k] = val_of(s1[k] & ~127u); f2[k] = val_of(s2[k] & ~127u);
        }
        unsigned cv[64];
        {
            int n = 0;
#pragma unroll
            for (int a = 0; a < 16; ++a)
#pragma unroll
                for (int b = 0; b < 16; ++b)
                    if ((a + 1) * (b + 1) <= 16) { cv[n] = (key_of(f1[a] + f2[b]) & ~255u) | (255u - (unsigned)(a * 16 + b)); ++n; }
#pragma unroll
            for (int q = 50; q < 64; ++q) cv[q] = 0u;
        }
        unsigned w[16];
        top16_of_64(cv, w);
        float sc[16]; int ei[16];
#pragma unroll
        for (int k = 0; k < 16; ++k) {
            const unsigned ab = 255u - (w[k] & 255u);
            const unsigned k1 = sl[(ab >> 4) * 64 + lane], k2 = sl[(16 + (ab & 15u)) * 64 + lane];
            ei[k] = (int)((127u - (k1 & 127u)) * 128u + (127u - (k2 & 127u)));
            sc[k] = val_of(w[k] & ~255u);
        }
        const float mx = sc[0];
        float tot = 0.f;
#pragma unroll
        for (int k = 0; k < 16; ++k) { sc[k] = expf(sc[k] - mx); tot += sc[k]; }
        const int row = row0 + (lane & 31), head = hp * 2 + (lane >> 5);
        bf16_t* ip = seli + (size_t)row * 128 + head * 16;
        float* gp = selg + (size_t)row * 128 + head * 16;
        const float inv = 1.f / tot;
#pragma unroll
        for (int q = 0; q < 2; ++q) {
            u32x4 o;
#pragma unroll
            for (int d = 0; d < 4; ++d) o[d] = (unsigned)ei[8 * q + 2 * d] | ((unsigned)ei[8 * q + 2 * d + 1] << 16);
            *(u32x4*)(ip + 8 * q) = o;
        }
#pragma unroll
        for (int q = 0; q < 4; ++q) *(float4*)(gp + 4 * q) = make_float4(sc[4 * q] * inv, sc[4 * q + 1] * inv, sc[4 * q + 2] * inv, sc[4 * q + 3] * inv);
    }
}

struct XGeo { int nloc, rank, nact, pos; };
typedef float f32x2 __attribute__((ext_vector_type(2)));
DEV void fp8x16_to_f32(const u32x4 r, float* f) {
#pragma unroll
    for (int d = 0; d < 4; ++d) {
        const f32x2 lo = __builtin_amdgcn_cvt_pk_f32_fp8((int)r[d], false), hi = __builtin_amdgcn_cvt_pk_f32_fp8((int)r[d], true);
        f[4 * d + 0] = lo.x; f[4 * d + 1] = lo.y; f[4 * d + 2] = hi.x; f[4 * d + 3] = hi.y;
    }
}
template <int S, int MUL, class T>
DEV void bfly_stage(T* p, int lane) {
    const bool hi = (lane & (S * MUL)) != 0;
#pragma unroll
    for (int i = 0; i < 2 * S; ++i) { const T keep = hi ? p[i + 2 * S] : p[i], send = hi ? p[i] : p[i + 2 * S]; p[i] = keep + __shfl_xor(send, S * MUL); }
}
template <int STAGE>
DEV void ex_issue(u32x4 (&buf)[16], u32x4 (&aux)[4], f32x2 (&hg)[2], const u32x4 (&idn)[2], const unsigned char* slice, const Params& P, const bf16_t* A, const bf16_t* wexp,
                  const float* gatev, int t, int sl, int g, int c) {
    int id[16];
#pragma unroll
    for (int q = 0; q < 2; ++q)
#pragma unroll
        for (int d = 0; d < 4; ++d) { id[8 * q + 2 * d] = (int)(idn[q][d] & 0xffffu); id[8 * q + 2 * d + 1] = (int)(idn[q][d] >> 16); }
#pragma unroll
    for (int k = 0; k < 16; ++k) buf[k] = *(const u32x4*)(slice + (size_t)id[k] * 128);
    if (STAGE == 1) {
        aux[0] = *(const u32x4*)(P.ws + OFF_A8 + (size_t)t * 1024 + 256 * sl + 32 * c); aux[1] = *(const u32x4*)(P.ws + OFF_A8 + (size_t)t * 1024 + 256 * sl + 32 * c + 16);
        hg[0].x = ((const float*)(P.ws + OFF_XS))[t];
    } else {
#pragma unroll
        for (int q = 0; q < 2; ++q) aux[q] = *(const u32x4*)(wexp + (size_t)t * 128 + 16 * g + 8 * q);
        const int col = 256 * sl + 32 * c + 4 * g, m = t < NX ? (t >> 11) : 8;
        const u32x2 hv = *(const u32x2*)(hrow(P, t) + col);
        aux[2] = (u32x4){hv.x, hv.y, 0u, 0u};
        aux[3] = *(const u32x4*)(gatev + m * 6144 + col);
    }
}
template <int STAGE>
DEV void ex_compute(const u32x4 (&buf)[16], const u32x4 (&aux)[4], const f32x2 (&hg)[2], const Params& P, float* part, int t, int sl, int lane, int g, int c) {
    if (STAGE == 1) {
        int sx = 0;
#pragma unroll
        for (int q = 0; q < 2; ++q)
#pragma unroll
            for (int d = 0; d < 4; ++d) sx = __builtin_amdgcn_sdot4(0x01010101, (int)aux[q][d], sx, false);
        int p[16];
#pragma unroll
        for (int k = 0; k < 16; ++k) {
            int a = -8 * sx;
#pragma unroll
            for (int d = 0; d < 4; ++d) {
                const unsigned w = buf[k][d];
                a = __builtin_amdgcn_sdot4((int)(w & 0x0F0F0F0Fu), (int)aux[d >> 1][2 * (d & 1)], a, false);
                a = __builtin_amdgcn_sdot4((int)((w >> 4) & 0x0F0F0F0Fu), (int)aux[d >> 1][2 * (d & 1) + 1], a, false);
            }
            p[k] = a;
        }
        bfly_stage<4, 1>(p, lane); bfly_stage<2, 1>(p, lane); bfly_stage<1, 1>(p, lane);
        const float xs = hg[0].x;
        *(unsigned*)((bf16_t*)part + ((size_t)sl * NT + t) * 128 + 2 * lane) = pk2((float)p[0] * xs, (float)p[1] * xs);
    } else {
        f32x2 p2[16];
#pragma unroll
        for (int i = 0; i < 16; ++i) p2[i] = (f32x2){0.f, 0.f};
#pragma unroll
        for (int k = 0; k < 16; ++k) {
            const unsigned wpk = aux[k >> 3][(k >> 1) & 3];
            const float wkf = (k & 1) ? bfhi(wpk) : bflo(wpk);
            const f32x2 w2 = {wkf, wkf};
#pragma unroll
            for (int d = 0; d < 4; ++d) {
                p2[4 * d + 0] += w2 * __builtin_amdgcn_cvt_scalef32_pk_f32_fp4(buf[k][d], 1.0f, 0);
                p2[4 * d + 1] += w2 * __builtin_amdgcn_cvt_scalef32_pk_f32_fp4(buf[k][d], 1.0f, 1);
                p2[4 * d + 2] += w2 * __builtin_amdgcn_cvt_scalef32_pk_f32_fp4(buf[k][d], 1.0f, 2);
                p2[4 * d + 3] += w2 * __builtin_amdgcn_cvt_scalef32_pk_f32_fp4(buf[k][d], 1.0f, 3);
            }
            asm volatile("" : "+v"(p2[0]), "+v"(p2[1]), "+v"(p2[2]), "+v"(p2[3]), "+v"(p2[4]), "+v"(p2[5]), "+v"(p2[6]), "+v"(p2[7]),
                              "+v"(p2[8]), "+v"(p2[9]), "+v"(p2[10]), "+v"(p2[11]), "+v"(p2[12]), "+v"(p2[13]), "+v"(p2[14]), "+v"(p2[15]));
        }
        float p[32];
#pragma unroll
        for (int i = 0; i < 16; ++i) { p[2 * i] = p2[i].x; p[2 * i + 1] = p2[i].y; }
        bfly_stage<8, 4>(p, lane); bfly_stage<4, 4>(p, lane); bfly_stage<2, 4>(p, lane);
        const int col = 256 * sl + 32 * c + 4 * g;
        const unsigned h0 = aux[2].x, h1 = aux[2].y;
        u32x2 ho;
        ho.x = pk2(bflo(h0) + __uint_as_float(aux[3].x) * p[0], bfhi(h0) + __uint_as_float(aux[3].y) * p[1]);
        ho.y = pk2(bflo(h1) + __uint_as_float(aux[3].z) * p[2], bfhi(h1) + __uint_as_float(aux[3].w) * p[3]);
        *(u32x2*)(hrow(P, t) + col) = ho;
    }
}
template <int STAGE>
DEV void phase_experts_sliced(const Params& P, int layer, int nrows, const XGeo geo) {
    const unsigned char* tab = P.ws + OFF_TAB + (size_t)(layer * 2 + (STAGE - 1)) * 16 * MiB;
    const bf16_t* A = (const bf16_t*)(P.ws + OFF_A);
    const bf16_t* seli = (const bf16_t*)(P.ws + OFF_SELI);
    float* part = (float*)(P.ws + OFF_PART);
    const bf16_t* wexp = (const bf16_t*)(P.ws + OFF_WEXP);
    const float* gatev = (const float*)(P.ws + OFF_MODV) + (size_t)layer * 9 * 6144 + 5 * 1024;
    const int tid = tid_fresh(), wave = tid >> 6, lane = tid & 63, g = lane >> 3, c = lane & 7;
    const int nw = geo.nloc * 8, wr = geo.rank * 8 + wave;
    for (int vs = geo.pos; vs < 8; vs += geo.nact) {
        const int sl = vs >> 1, tmul = 2, tadd = vs & 1;
        const unsigned char* slice = tab + (size_t)sl * 2 * MiB + 16 * c;
        const int nws = nw * tmul;
        int t = wr * tmul + tadd;
        if (t >= nrows) continue;
        u32x4 bufA[16], bufB[16], auxA[4], auxB[4]; f32x2 hgA[2], hgB[2]; u32x4 idn[2];
#pragma unroll
        for (int q = 0; q < 2; ++q) idn[q] = *(const u32x4*)(seli + (size_t)t * 128 + 16 * g + 8 * q);
        ex_issue<STAGE>(bufA, auxA, hgA, idn, slice, P, A, wexp, gatev, t, sl, g, c);
        if (t + nws < nrows) {
#pragma unroll
            for (int q = 0; q < 2; ++q) idn[q] = *(const u32x4*)(seli + (size_t)(t + nws) * 128 + 16 * g + 8 * q);
        }
        for (;;) {
            {
                const int t1 = t + nws;
                if (t1 < nrows) {
                    ex_issue<STAGE>(bufB, auxB, hgB, idn, slice, P, A, wexp, gatev, t1, sl, g, c);
                    if (t1 + nws < nrows) {
#pragma unroll
                        for (int q = 0; q < 2; ++q) idn[q] = *(const u32x4*)(seli + (size_t)(t1 + nws) * 128 + 16 * g + 8 * q);
                    }
                }
                ex_compute<STAGE>(bufA, auxA, hgA, P, part, t, sl, lane, g, c);
            }
            t += nws; if (t >= nrows) break;
            {
                const int t1 = t + nws;
                if (t1 < nrows) {
                    ex_issue<STAGE>(bufA, auxA, hgA, idn, slice, P, A, wexp, gatev, t1, sl, g, c);
                    if (t1 + nws < nrows) {
#pragma unroll
                        for (int q = 0; q < 2; ++q) idn[q] = *(const u32x4*)(seli + (size_t)(t1 + nws) * 128 + 16 * g + 8 * q);
                    }
                }
                ex_compute<STAGE>(bufB, auxB, hgB, P, part, t, sl, lane, g, c);
            }
            t += nws; if (t >= nrows) break;
        }
    }
}
DEV void eu_issue_unit(u32x4 (&buf)[16], u32x4 (&xq)[2], const u32x4 (&idn)[2], const unsigned char* tab, const Params& P, int t, int sl, int c) {
    int id[16];
#pragma unroll
    for (int q = 0; q < 2; ++q)
#pragma unroll
        for (int d = 0; d < 4; ++d) { id[8 * q + 2 * d] = (int)(idn[q][d] & 0xffffu); id[8 * q + 2 * d + 1] = (int)(idn[q][d] >> 16); }
    const unsigned char* slice = tab + (size_t)sl * 2 * MiB + 16 * c;
#pragma unroll
    for (int k = 0; k < 16; ++k) buf[k] = *(const u32x4*)(slice + (size_t)id[k] * 128);
    xq[0] = *(const u32x4*)(P.ws + OFF_A8 + (size_t)t * 1024 + 256 * sl + 32 * c); xq[1] = *(const u32x4*)(P.ws + OFF_A8 + (size_t)t * 1024 + 256 * sl + 32 * c + 16);
}
DEV void eu_compute_unit(const u32x4 (&buf)[16], const u32x4 (&xq)[2], LAS float* acc2, int lane) {
    int sx = 0;
#pragma unroll
    for (int q = 0; q < 2; ++q)
#pragma unroll
        for (int d = 0; d < 4; ++d) sx = __builtin_amdgcn_sdot4(0x01010101, (int)xq[q][d], sx, false);
    int p[16];
#pragma unroll
    for (int k = 0; k < 16; ++k) {
        int a = -8 * sx;
#pragma unroll
        for (int d = 0; d < 4; ++d) {
            const unsigned w = buf[k][d];
            a = __builtin_amdgcn_sdot4((int)(w & 0x0F0F0F0Fu), (int)xq[d >> 1][2 * (d & 1)], a, false);
            a = __builtin_amdgcn_sdot4((int)((w >> 4) & 0x0F0F0F0Fu), (int)xq[d >> 1][2 * (d & 1) + 1], a, false);
        }
        p[k] = a;
    }
    bfly_stage<4, 1>(p, lane); bfly_stage<2, 1>(p, lane); bfly_stage<1, 1>(p, lane);
    f32x2 a2 = *(const LAS f32x2*)acc2;
    a2.x += (float)p[0]; a2.y += (float)p[1];
    *(LAS f32x2*)acc2 = a2;
}
DEV void phase_experts_u(const Params& P, int layer, int nrows, ldsp lds0) {
    const unsigned char* tab = P.ws + OFF_TAB + (size_t)(layer * 2) * 16 * MiB;
    const bf16_t* seli = (const bf16_t*)(P.ws + OFF_SELI);
    const float* selg = (const float*)(P.ws + OFF_SELG);
    bf16_t* wexp = (bf16_t*)(P.ws + OFF_WEXP);
    const float* rsu = (const float*)(P.ws + OFF_RSC) + (size_t)(layer * 2) * 16384;
    const float* rsv = rsu + 16384;
    const float* xsv = (const float*)(P.ws + OFF_XS);
    const int tid = tid_fresh(), wave = __builtin_amdgcn_readfirstlane(tid >> 6), lane = tid & 63, g = lane >> 3, c = lane & 7;
    const int gw = blockIdx.x * 8 + wave, nwv = gridDim.x * 8;
    if (gw >= nrows) return;
    const int ntok = (nrows - gw + nwv - 1) / nwv, U = 4 * ntok;
    LAS float* accs = (LAS float*)(launder(lds0) + wave * 8192);
    for (int k = 0; k < ntok; ++k) *(LAS f32x2*)(accs + k * 128 + 2 * lane) = (f32x2){0.f, 0.f};
    u32x4 bufA[16], bufB[16], xqA[2], xqB[2], idn[2];
    int ku = 0, slu = 0;
#define EU_NEXT_IDX() do { const int tt = gw + ku * nwv; _Pragma("unroll") for (int q = 0; q < 2; ++q) idn[q] = *(const u32x4*)(seli + (size_t)tt * 128 + 16 * g + 8 * q); } while (0)
#define EU_ADVANCE() do { if (++ku == ntok) { ku = 0; ++slu; } } while (0)
    EU_NEXT_IDX();
    int kA = ku, slA = slu; eu_issue_unit(bufA, xqA, idn, tab, P, gw + kA * nwv, slA, c); EU_ADVANCE();
    if (U > 1) EU_NEXT_IDX();
    int kB = 0, slB = 0;
    for (int u = 0; u < U; u += 2) {
        if (u + 1 < U) { kB = ku; slB = slu; eu_issue_unit(bufB, xqB, idn, tab, P, gw + kB * nwv, slB, c); EU_ADVANCE(); if (u + 2 < U) EU_NEXT_IDX(); }
        eu_compute_unit(bufA, xqA, accs + kA * 128 + 2 * lane, lane);
        if (u + 1 >= U) break;
        if (u + 2 < U) { kA = ku; slA = slu; eu_issue_unit(bufA, xqA, idn, tab, P, gw + kA * nwv, slA, c); EU_ADVANCE(); if (u + 3 < U) EU_NEXT_IDX(); }
        eu_compute_unit(bufB, xqB, accs + kB * 128 + 2 * lane, lane);
    }
#undef EU_NEXT_IDX
#undef EU_ADVANCE
    for (int k = 0; k < ntok; ++k) {
        const int t = gw + k * nwv;
        const unsigned ep = *(const unsigned*)(seli + (size_t)t * 128 + 2 * lane);
        const f32x2 gt = *(const f32x2*)(selg + (size_t)t * 128 + 2 * lane);
        const f32x2 a2 = *(const LAS f32x2*)(accs + k * 128 + 2 * lane);
        const int e0 = (int)(ep & 0xffffu), e1 = (int)(ep >> 16);
        const float xs = xsv[t];
        const float h0 = a2.x * xs * rsu[e0], h1 = a2.y * xs * rsu[e1];
        const float w0 = gt.x * (0.5f * h0 * (1.f + erff(h0 * 0.70710678118654752f))) * rsv[e0];
        const float w1 = gt.y * (0.5f * h1 * (1.f + erff(h1 * 0.70710678118654752f))) * rsv[e1];
        *(unsigned*)(wexp + (size_t)t * 128 + 2 * lane) = pk2(w0, w1);
    }
}
DEV void ev_issue_unit(u32x4 (&buf)[16], u32x2& hv, u32x4& gt, const u32x4 (&idn)[2], const unsigned char* tab, const Params& P, const float* gatev, int t, int sl, int g, int c) {
    int id[16];
#pragma unroll
    for (int q = 0; q < 2; ++q)
#pragma unroll
        for (int d = 0; d < 4; ++d) { id[8 * q + 2 * d] = (int)(idn[q][d] & 0xffffu); id[8 * q + 2 * d + 1] = (int)(idn[q][d] >> 16); }
    const unsigned char* slice = tab + (size_t)sl * 2 * MiB + 16 * c;
#pragma unroll
    for (int k = 0; k < 16; ++k) buf[k] = *(const u32x4*)(slice + (size_t)id[k] * 128);
    const int col = 256 * sl + 32 * c + 4 * g, m = t < NX ? (t >> 11) : 8;
    hv = *(const u32x2*)(hrow(P, t) + col);
    gt = *(const u32x4*)(gatev + m * 6144 + col);
}
DEV void ev_compute_unit(const u32x4 (&buf)[16], const u32x2 hv, const u32x4 gt, const LAS float* wS, const Params& P, int t, int sl, int lane, int g, int c) {
    f32x2 p2[16];
#pragma unroll
    for (int i = 0; i < 16; ++i) p2[i] = (f32x2){0.f, 0.f};
    f32x4 wq[4];
#pragma unroll
    for (int q = 0; q < 4; ++q) wq[q] = *(const LAS f32x4*)(wS + 4 * q);
#pragma unroll
    for (int k = 0; k < 16; ++k) {
        const float wkf = wq[k >> 2][k & 3];
        const f32x2 w2 = {wkf, wkf};
#pragma unroll
        for (int d = 0; d < 4; ++d) {
            p2[4 * d + 0] += w2 * __builtin_amdgcn_cvt_scalef32_pk_f32_fp4(buf[k][d], 1.0f, 0);
            p2[4 * d + 1] += w2 * __builtin_amdgcn_cvt_scalef32_pk_f32_fp4(buf[k][d], 1.0f, 1);
            p2[4 * d + 2] += w2 * __builtin_amdgcn_cvt_scalef32_pk_f32_fp4(buf[k][d], 1.0f, 2);
            p2[4 * d + 3] += w2 * __builtin_amdgcn_cvt_scalef32_pk_f32_fp4(buf[k][d], 1.0f, 3);
        }
        asm volatile("" : "+v"(p2[0]), "+v"(p2[1]), "+v"(p2[2]), "+v"(p2[3]), "+v"(p2[4]), "+v"(p2[5]), "+v"(p2[6]), "+v"(p2[7]),
                          "+v"(p2[8]), "+v"(p2[9]), "+v"(p2[10]), "+v"(p2[11]), "+v"(p2[12]), "+v"(p2[13]), "+v"(p2[14]), "+v"(p2[15]));
    }
    float p[32];
#pragma unroll
    for (int i = 0; i < 16; ++i) { p[2 * i] = p2[i].x; p[2 * i + 1] = p2[i].y; }
    bfly_stage<8, 4>(p, lane); bfly_stage<4, 4>(p, lane); bfly_stage<2, 4>(p, lane);
    const int col = 256 * sl + 32 * c + 4 * g;
    u32x2 ho;
    ho.x = pk2(bflo(hv.x) + __uint_as_float(gt.x) * p[0], bfhi(hv.x) + __uint_as_float(gt.y) * p[1]);
    ho.y = pk2(bflo(hv.y) + __uint_as_float(gt.z) * p[2], bfhi(hv.y) + __uint_as_float(gt.w) * p[3]);
    *(u32x2*)(hrow(P, t) + col) = ho;
}
DEV void phase_experts(const Params& P, int layer, int nrows, ldsp lds0) {
    const unsigned char* tabu = P.ws + OFF_TAB + (size_t)(layer * 2) * 16 * MiB;
    const unsigned char* tabv = tabu + 16 * MiB;
    const bf16_t* seli = (const bf16_t*)(P.ws + OFF_SELI);
    const float* selg = (const float*)(P.ws + OFF_SELG);
    const float* rsu = (const float*)(P.ws + OFF_RSC) + (size_t)(layer * 2) * 16384;
    const float* rsv = rsu + 16384;
    const float* xsv = (const float*)(P.ws + OFF_XS);
    const float* gatev = (const float*)(P.ws + OFF_MODV) + (size_t)layer * 9 * 6144 + 5 * 1024;
    const int tid = tid_fresh(), wave = __builtin_amdgcn_readfirstlane(tid >> 6), lane = tid & 63, g = lane >> 3, c = lane & 7;
    const int gw = blockIdx.x * 8 + wave, nwv = gridDim.x * 8;
    if (gw >= nrows) return;
    const int ntok = (nrows - gw + nwv - 1) / nwv, U = 4 * ntok;
    LAS float* accs = (LAS float*)(launder(lds0) + wave * 8192);
    for (int k = 0; k < ntok; ++k) *(LAS f32x2*)(accs + k * 128 + 2 * lane) = (f32x2){0.f, 0.f};
    u32x4 bufA[16], bufB[16], idn[2];
    int ku = 0, slu = 0;
#define EU_NEXT_IDX() do { const int tt = gw + ku * nwv; _Pragma("unroll") for (int q = 0; q < 2; ++q) idn[q] = *(const u32x4*)(seli + (size_t)tt * 128 + 16 * g + 8 * q); } while (0)
#define EU_ADVANCE() do { if (++ku == ntok) { ku = 0; ++slu; } } while (0)
    int kA, slA, kB = 0, slB = 0;
    {
        u32x4 xqA[2], xqB[2];
        EU_NEXT_IDX();
        kA = ku; slA = slu; eu_issue_unit(bufA, xqA, idn, tabu, P, gw + kA * nwv, slA, c); EU_ADVANCE();
        if (U > 1) EU_NEXT_IDX();
        for (int u = 0; u < U; u += 2) {
            if (u + 1 < U) { kB = ku; slB = slu; eu_issue_unit(bufB, xqB, idn, tabu, P, gw + kB * nwv, slB, c); EU_ADVANCE(); if (u + 2 < U) EU_NEXT_IDX(); }
            eu_compute_unit(bufA, xqA, accs + kA * 128 + 2 * lane, lane);
            if (u + 1 >= U) break;
            if (u + 2 < U) { kA = ku; slA = slu; eu_issue_unit(bufA, xqA, idn, tabu, P, gw + kA * nwv, slA, c); EU_ADVANCE(); if (u + 3 < U) EU_NEXT_IDX(); }
            eu_compute_unit(bufB, xqB, accs + kB * 128 + 2 * lane, lane);
        }
    }
    u32x2 hvA, hvB; u32x4 gtA, gtB;
    ku = 0; slu = 0;
    EU_NEXT_IDX();
    kA = ku; slA = slu; ev_issue_unit(bufA, hvA, gtA, idn, tabv, P, gatev, gw + kA * nwv, slA, g, c); EU_ADVANCE();
    if (U > 1) EU_NEXT_IDX();
    for (int k = 0; k < ntok; ++k) {
        const int t = gw + k * nwv;
        const unsigned ep = *(const unsigned*)(seli + (size_t)t * 128 + 2 * lane);
        const f32x2 gt = *(const f32x2*)(selg + (size_t)t * 128 + 2 * lane);
        const f32x2 a2 = *(const LAS f32x2*)(accs + k * 128 + 2 * lane);
        const int e0 = (int)(ep & 0xffffu), e1 = (int)(ep >> 16);
        const float xs = xsv[t];
        const float h0 = a2.x * xs * rsu[e0], h1 = a2.y * xs * rsu[e1];
        f32x2 w;
        w.x = gt.x * (0.5f * h0 * (1.f + erff(h0 * 0.70710678118654752f))) * rsv[e0];
        w.y = gt.y * (0.5f * h1 * (1.f + erff(h1 * 0.70710678118654752f))) * rsv[e1];
        *(LAS f32x2*)(accs + k * 128 + 2 * lane) = w;
    }
    for (int u = 0; u < U; u += 2) {
        if (u + 1 < U) { kB = ku; slB = slu; ev_issue_unit(bufB, hvB, gtB, idn, tabv, P, gatev, gw + kB * nwv, slB, g, c); EU_ADVANCE(); if (u + 2 < U) EU_NEXT_IDX(); }
        ev_compute_unit(bufA, hvA, gtA, accs + kA * 128 + 16 * g, P, gw + kA * nwv, slA, lane, g, c);
        if (u + 1 >= U) break;
        if (u + 2 < U) { kA = ku; slA = slu; ev_issue_unit(bufA, hvA, gtA, idn, tabv, P, gatev, gw + kA * nwv, slA, g, c); EU_ADVANCE(); if (u + 3 < U) EU_NEXT_IDX(); }
        ev_compute_unit(bufB, hvB, gtB, accs + kB * 128 + 16 * g, P, gw + kB * nwv, slB, lane, g, c);
    }
#undef EU_NEXT_IDX
#undef EU_ADVANCE
}
DEV void phase_experts_act(const Params& P, int layer, int nrows) {
    const bf16_t* seli = (const bf16_t*)(P.ws + OFF_SELI);
    const float* selg = (const float*)(P.ws + OFF_SELG);
    const float* part = (const float*)(P.ws + OFF_PART);
    bf16_t* wexp = (bf16_t*)(P.ws + OFF_WEXP);
    const float* rsu = (const float*)(P.ws + OFF_RSC) + (size_t)(layer * 2) * 16384;
    const float* rsv = rsu + 16384;
    const int tid = tid_fresh();
    const int n4 = nrows * 32;
    for (int i4 = blockIdx.x * NTHREADS + tid; i4 < n4; i4 += gridDim.x * NTHREADS) {
        const size_t idx = (size_t)i4 * 4;
        f32x4 h = {0.f, 0.f, 0.f, 0.f};
#pragma unroll
        for (int s = 0; s < 4; ++s) { const u32x2 pv = *(const u32x2*)((const bf16_t*)part + (size_t)s * NT * 128 + idx); h += (f32x4){bflo(pv.x), bfhi(pv.x), bflo(pv.y), bfhi(pv.y)}; }
        const u32x2 e = *(const u32x2*)(seli + idx);
        const f32x4 gt = *(const f32x4*)(selg + idx);
        const int ee[4] = {(int)(e.x & 0xffffu), (int)(e.x >> 16), (int)(e.y & 0xffffu), (int)(e.y >> 16)};
        f32x4 o;
#pragma unroll
        for (int q = 0; q < 4; ++q) {
            const float hh = h[q] * rsu[ee[q]];
            o[q] = gt[q] * (0.5f * hh * (1.f + erff(hh * 0.70710678118654752f))) * rsv[ee[q]];
        }
        u32x2 ow; ow.x = pk2(o[0], o[1]); ow.y = pk2(o[2], o[3]);
        *(u32x2*)(wexp + idx) = ow;
    }
}
DEV void phase_final(const Params& P) {
    const int tid = tid_fresh(), wave = tid >> 6, lane = tid & 63;
    for (int r = blockIdx.x * 8 + wave; r < NX; r += gridDim.x * 8) {
        float* h = P.out + (size_t)r * 1024;
        f32x4 v[4]; float ss = 0.f;
#pragma unroll
        for (int j = 0; j < 4; ++j) { const u32x2 hv = *(const u32x2*)(hrow(P, r) + j * 256 + lane * 4); v[j] = (f32x4){bflo(hv.x), bfhi(hv.x), bflo(hv.y), bfhi(hv.y)};
            ss += v[j].x * v[j].x + v[j].y * v[j].y + v[j].z * v[j].z + v[j].w * v[j].w; }
        ss = wave_sum(ss);
        const float rstd = rsqrtf(ss * (1.f / 1024.f) + EPS);
#pragma unroll
        for (int j = 0; j < 4; ++j) { const f32x4 gg = *(const f32x4*)(P.final_g + j * 256 + lane * 4); __builtin_nontemporal_store(v[j] * rstd * gg, (f32x4*)(h + j * 256 + lane * 4)); }
    }
}

DEV void phase_conv(const Params& P) {
    const bf16_t* Pq = (const bf16_t*)(P.ws + OFF_R1);
    const float* ab = (const float*)(P.ws + OFF_AB);
    bf16_t* dst[3] = {(bf16_t*)(P.ws + OFF_QC), (bf16_t*)(P.ws + OFF_KC), (bf16_t*)(P.ws + OFF_VC)};
    float* gbuf = (float*)(P.ws + OFF_G);
    float* bbuf = (float*)(P.ws + OFF_BETA);
    const int tid = tid_fresh(), wave = tid >> 6, lane = tid & 63;
    constexpr int NSEG = NT / 16;
    for (int item = blockIdx.x * 8 + wave; item < NSEG * 6; item += gridDim.x * 8) {
        const int seg = item / 6, jc = item - seg * 6, row0 = seg * 16;
        int t0, L;
        if (row0 < NX) { t0 = row0 & 2047; L = 2048; } else { t0 = (row0 - NX) & 255; L = 256; }
        const int chunk = lane + 64 * jc, col = chunk * 8, part = jc >> 1;
        f32x4 w0[5], w1[5];
#pragma unroll
        for (int tap = 0; tap < 5; ++tap) { w0[tap] = *(const f32x4*)(P.dn_conv_w + tap * 3072 + col); w1[tap] = *(const f32x4*)(P.dn_conv_w + tap * 3072 + col + 4); }
        u32x4 raw[20];
#pragma unroll
        for (int i = 0; i < 20; ++i) {
            const int tt = t0 + i - 2;
            const bool ok = tt >= 0 && tt < L;
            const u32x4 v = *(const u32x4*)(Pq + (size_t)(row0 + (ok ? i - 2 : 0)) * 3072 + col);
            raw[i] = ok ? v : (u32x4){0u, 0u, 0u, 0u};
        }
        const float qs = part == 0 ? 0.08838834764831845f : 1.f;
        bf16_t* dp = dst[part] + (size_t)row0 * 1024 + (chunk & 127) * 8;
#pragma unroll
        for (int i = 0; i < 16; ++i) {
            float acc[8];
#pragma unroll
            for (int e = 0; e < 8; ++e) acc[e] = 0.f;
#pragma unroll
            for (int tap = 0; tap < 5; ++tap) {
                float f[8]; unpack8(raw[i + tap], f);
                acc[0] += f[0] * w0[tap].x; acc[1] += f[1] * w0[tap].y; acc[2] += f[2] * w0[tap].z; acc[3] += f[3] * w0[tap].w;
                acc[4] += f[4] * w1[tap].x; acc[5] += f[5] * w1[tap].y; acc[6] += f[6] * w1[tap].z; acc[7] += f[7] * w1[tap].w;
            }
            float ss = 0.f;
#pragma unroll
            for (int e = 0; e < 8; ++e) { acc[e] = silu(acc[e]); ss += acc[e] * acc[e]; }
            if (part < 2) {
                ss = sum16(ss);
                const float rn = rsqrtf(ss + EPS) * qs;
#pragma unroll
                for (int e = 0; e < 8; ++e) acc[e] *= rn;
            }
            u32x4 o; o.x = pk2(acc[0], acc[1]); o.y = pk2(acc[2], acc[3]); o.z = pk2(acc[4], acc[5]); o.w = pk2(acc[6], acc[7]);
            *(u32x4*)(dp + (size_t)i * 1024) = o;
        }
        if (jc == 0) {
            const int cc = lane & 31, d = cc >> 4, sx = (cc >> 3) & 1, h = cc & 7;
            const float a = __expf(P.dn_a_log[d * 8 + h]), dtb = P.dn_dt_bias[d * 8 + h];
            float v[8];
#pragma unroll
            for (int q = 0; q < 8; ++q) v[q] = ab[(size_t)(row0 + 2 * q + (lane >> 5)) * 32 + cc];
#pragma unroll
            for (int q = 0; q < 8; ++q) {
                const int row = row0 + 2 * q + (lane >> 5);
                if (sx == 0) {
                    const float xx = v[q] + dtb;
                    const float ex = __expf(fminf(xx, 30.f)), u = 1.f + ex;
                    const float l1p = (u == 1.f) ? ex : __logf(u) * ex * __builtin_amdgcn_rcpf(u - 1.f);
                    const float sp = xx > 20.f ? xx : l1p;
                    gbuf[((size_t)d * NT + row) * 8 + h] = -a * sp;
                } else {
                    bbuf[((size_t)d * NT + row) * 8 + h] = __builtin_amdgcn_rcpf(1.f + __expf(-v[q]));
                }
            }
        }
    }
}

DEV int chunk_rowbase(int b, int d, int n) {
    if (n < 4) { const int m = d ? 3 - n : n; return NX + b * 256 + m * 64; }
    const int m = d ? 31 - (n - 4) : n - 4; return b * 2048 + m * 64;
}

DEV bf16x8 frag_col_x(ldsp x, int c0, int k0, int lane) {
    const int col = c0 + (lane & 31), ch = col >> 3, sub = (col & 7) * 2;
    bf16x8 f;
#pragma unroll
    for (int j = 0; j < 8; ++j) { const int row = k0 + 8 * (lane >> 5) + j; f[j] = (short)*(const LAS bf16_t*)(x + row * 256 + ((ch ^ (row & 15)) << 4) + sub); }
    return f;
}
DEV void tile_rows8(const f32x16& acc, u32x4& o0, u32x4& o1) {
    unsigned p[4][2];
#pragma unroll
    for (int rg = 0; rg < 4; ++rg) { p[rg][0] = pk2(acc[rg * 4 + 0], acc[rg * 4 + 1]); p[rg][1] = pk2(acc[rg * 4 + 2], acc[rg * 4 + 3]); }
    const auto s00 = __builtin_amdgcn_permlane32_swap(p[0][0], p[2][0], false, false), s01 = __builtin_amdgcn_permlane32_swap(p[0][1], p[2][1], false, false);
    const auto s10 = __builtin_amdgcn_permlane32_swap(p[1][0], p[3][0], false, false), s11 = __builtin_amdgcn_permlane32_swap(p[1][1], p[3][1], false, false);
    o0 = (u32x4){s00[0], s01[0], s00[1], s01[1]};
    o1 = (u32x4){s10[0], s11[0], s10[1], s11[1]};
}
DEV bf16x8 frag_row_t(ldsp t, int r0, int k0, int lane) {
    const int row = r0 + (lane & 31), ch = (k0 >> 3) + (lane >> 5);
    return *(const LAS bf16x8*)(t + row * 128 + ((ch ^ (row & 7)) << 4));
}
DEV void phase_chunk(const Params& P, ldsp lds0) {
    const bf16_t* kc = (const bf16_t*)(P.ws + OFF_KC);
    const bf16_t* vc = (const bf16_t*)(P.ws + OFF_VC);
    const float* gbuf = (const float*)(P.ws + OFF_G);
    const float* bbuf = (const float*)(P.ws + OFF_BETA);
    bf16_t* wbuf = (bf16_t*)(P.ws + OFF_WBUF);
    bf16_t* ubuf = (bf16_t*)(P.ws + OFF_UBUF);
    float* gcbuf = (float*)(P.ws + OFF_GC);
    const int tid = tid_fresh(), lane = tid & 63, wave = tid >> 6, team = wave >> 1, tw = wave & 1, ttid = tid & 127;
    const int nteams = gridDim.x * 4, niter = (4608 + nteams - 1) / nteams;
    u32x4 rk[8];
    {
        const int item0 = min((int)(blockIdx.x * 4 + team), 4607);
        const int n = item0 % 36, d = (item0 / 36) & 1, bh = item0 / 72, rb0 = chunk_rowbase(bh >> 3, d, n);
#pragma unroll
        for (int j = 0; j < 8; ++j) { const int cid = ttid + 128 * j, i = cid >> 4, ch = cid & 15; rk[j] = *(const u32x4*)(kc + ((size_t)rb0 + (d ? 63 - i : i)) * 1024 + (bh & 7) * 128 + ch * 8); }
    }
    for (int it = 0; it < niter; ++it) {
        const int item = it * nteams + blockIdx.x * 4 + team;
        const bool act = item < 4608;
        const ldsp lds = launder(lds0);
        const ldsp sX = lds + team * 32768;
        const ldsp sT = sX + 16384;
        LAS float* sA = (LAS float*)sT;
        LAS float* sg = (LAS float*)(lds + 131072 + 128 + team * 768);
        const int n = item % 36, d = (item / 36) & 1, bh = item / 72, b = bh >> 3, h = bh & 7;
        const int rowbase = act ? chunk_rowbase(b, d, n) : 0;
        if (act) {
#pragma unroll
            for (int j = 0; j < 8; ++j) { const int cid = ttid + 128 * j, i = cid >> 4, ch = cid & 15; *(LAS u32x4*)(sX + i * 256 + ((ch ^ (i & 15)) << 4)) = rk[j]; }
            if (tw == 0) {
                const size_t grow = (size_t)rowbase + (d ? 63 - lane : lane);
                float v = gbuf[((size_t)d * NT + grow) * 8 + h];
#pragma unroll
                for (int o = 1; o < 64; o <<= 1) { const float t = __shfl_up(v, o); if (lane >= o) v += t; }
                sg[lane] = v; sg[64 + lane] = bbuf[((size_t)d * NT + grow) * 8 + h];
            }
        }
        __syncthreads();
        if (act) {
#pragma unroll 1
            for (int q = 0; q < 2; ++q) {
                const int mt = tw, nt = q;
                f32x16 acc = zero16();
#pragma unroll 4
                for (int ks = 0; ks < 8; ++ks) acc = mfma32(frag_row_x(sX, mt * 32, ks * 16, lane), frag_row_x(sX, nt * 32, ks * 16, lane), acc);
#pragma unroll
                for (int reg = 0; reg < 16; ++reg) {
                    const int i = mt * 32 + crow(reg, lane), j = nt * 32 + (lane & 31);
                    sA[i * 64 + j] = (i > j) ? sg[64 + i] * acc[reg] * __expf(sg[i] - sg[j]) : 0.f;
                }
            }
        }
        __syncthreads();
        if (act && tw == 0) {
            float t[64];
            int ln = lane; asm volatile("" : "+v"(ln));
#pragma unroll
            for (int i = 0; i < 64; ++i) {
                float a0 = (i == ln) ? 1.f : 0.f, a1 = 0.f, a2 = 0.f, a3 = 0.f;
#pragma unroll
                for (int j = 0; j < i; j += 4) {
                    const f32x4 av = *(const LAS f32x4*)(sA + i * 64 + j);
                    a0 -= av.x * t[j];
                    if (j + 1 < i) a1 -= av.y * t[j + 1];
                    if (j + 2 < i) a2 -= av.z * t[j + 2];
                    if (j + 3 < i) a3 -= av.w * t[j + 3];
                }
                t[i] = (a0 + a1) + (a2 + a3);
                __builtin_amdgcn_sched_barrier(0);
            }
            const float cu = sg[64 + lane], cw = cu * __expf(sg[lane]);
            const int ch = lane >> 3, sub = (lane & 7) * 2;
#pragma unroll
            for (int i = 0; i < 64; ++i) {
                const int off = i * 128 + ((ch ^ (i & 7)) << 4) + sub;
                *(LAS bf16_t*)(sT + off) = f2bf(t[i] * cw);
                *(LAS bf16_t*)(sT + 8192 + off) = f2bf(t[i] * cu);
                if ((i & 7) == 7) __builtin_amdgcn_sched_barrier(0);
            }
        }
        __syncthreads();
            {
                const int itemn = min(item + nteams, 4607);
                const int nn = itemn % 36, dn = (itemn / 36) & 1, bhn = itemn / 72, rbn = chunk_rowbase(bhn >> 3, dn, nn);
#pragma unroll
                for (int j = 0; j < 8; ++j) { const int cid = ttid + 128 * j, i = cid >> 4, ch = cid & 15; rk[j] = *(const u32x4*)(kc + ((size_t)rbn + (dn ? 63 - i : i)) * 1024 + (bhn & 7) * 128 + ch * 8); }
            }
        u32x4 rv[8];
        if (act) {
#pragma unroll
            for (int j = 0; j < 8; ++j) {
                const int cid = ttid + 128 * j, i = cid >> 4, ch = cid & 15;
                const size_t grow = (size_t)rowbase + (d ? 63 - i : i);
                rv[j] = *(const u32x4*)(vc + grow * 1024 + h * 128 + ch * 8);
            }
#pragma unroll 1
            for (int q = 0; q < 2; ++q) {
                const int mtk = 2 * tw + q;
                f32x16 acc[2]; acc[0] = zero16(); acc[1] = zero16();
#pragma unroll
                for (int ks = 0; ks < 4; ++ks) {
                    const bf16x8 afr = frag_col_x(sX, mtk * 32, ks * 16, lane);
#pragma unroll
                    for (int it2 = 0; it2 < 2; ++it2) acc[it2] = mfma32(afr, frag_row_t(sT, it2 * 32, ks * 16, lane), acc[it2]);
                }
                bf16_t* dstp = wbuf + (size_t)item * 8192;
#pragma unroll
                for (int it2 = 0; it2 < 2; ++it2) {
                    u32x4 o0, o1; tile_rows8(acc[it2], o0, o1);
                    bf16_t* rp = dstp + (it2 * 32 + (lane & 31)) * 128 + mtk * 32 + 16 * (lane >> 5);
                    *(u32x4*)rp = o0; *(u32x4*)(rp + 8) = o1;
                }
            }
        }
        __syncthreads();
        if (act) {
#pragma unroll
            for (int j = 0; j < 8; ++j) { const int cid = ttid + 128 * j, i = cid >> 4, ch = cid & 15; *(LAS u32x4*)(sX + i * 256 + ((ch ^ (i & 15)) << 4)) = rv[j]; }
        }
        __syncthreads();
        if (act) {
#pragma unroll 1
            for (int q = 0; q < 2; ++q) {
                const int nt = 2 * tw + q;
                f32x16 acc[2]; acc[0] = zero16(); acc[1] = zero16();
#pragma unroll
                for (int ks = 0; ks < 4; ++ks) {
                    const bf16x8 bfr = frag_col_x(sX, nt * 32, ks * 16, lane);
#pragma unroll
                    for (int mt = 0; mt < 2; ++mt) acc[mt] = mfma32(frag_row_t(sT + 8192, mt * 32, ks * 16, lane), bfr, acc[mt]);
                }
                bf16_t* dstp = ubuf + (size_t)item * 8192;
#pragma unroll
                for (int mt = 0; mt < 2; ++mt) {
                    u32x4 o0, o1; tile_rows8(acc[mt], o0, o1);
                    bf16_t* rp = dstp + (nt * 32 + (lane & 31)) * 64 + mt * 32 + 16 * (lane >> 5);
                    *(u32x4*)rp = o0; *(u32x4*)(rp + 8) = o1;
                }
            }
            if (tw == 0) gcbuf[(size_t)item * 64 + lane] = sg[lane];
        }
        __syncthreads();
    }
}

DEV u32x2 pack4(float a, float b, float c, float d) { u32x2 o; o.x = pk2(a, b); o.y = pk2(c, d); return o; }
DEV void phase_scan(const Params& P, ldsp lds0) {
    const bf16_t* qc = (const bf16_t*)(P.ws + OFF_QC);
    const bf16_t* kc = (const bf16_t*)(P.ws + OFF_KC);
    const bf16_t* wbuf = (const bf16_t*)(P.ws + OFF_WBUF);
    const bf16_t* ubuf = (const bf16_t*)(P.ws + OFF_UBUF);
    const float* gcbuf = (const float*)(P.ws + OFF_GC);
    bf16_t* obuf = (bf16_t*)(P.ws + OFF_OBUF);
    const int tid = tid_fresh(), lane = tid & 63, wave = tid >> 6;
    const int mt = wave >> 1, nt = wave & 1;
    const int mt2 = (wave & 3) >> 1, nt2 = wave & 1;
    for (int item = blockIdx.x; item < 256; item += gridDim.x) {
        const int half = item & 1, d = (item >> 1) & 1, bh = item >> 2, b = bh >> 3, h = bh & 7;
        f32x16 S = zero16();
        { LAS unsigned* z = (LAS unsigned*)(lds0 + 1024 + 3 * 17408 + 9216); for (int e = tid; e < 64 * 136 / 2; e += NTHREADS) z[e] = 0u; }
        u32x4 rW[2][2], rK[2][2], rQ[2][2], rU[2]; float rG[2] = {0.f, 0.f};
#pragma unroll
        for (int u = 0; u < 2; ++u) {
            const int citem = (bh * 2 + d) * 36 + u, rowbase = chunk_rowbase(b, d, u);
#pragma unroll
            for (int j = 0; j < 2; ++j) {
                const int cid = tid + NTHREADS * j, i = cid >> 4, ch = cid & 15;
                const size_t grow = (size_t)rowbase + (d ? 63 - i : i);
                rW[u][j] = *(const u32x4*)(wbuf + (size_t)citem * 8192 + i * 128 + ch * 8);
                rK[u][j] = *(const u32x4*)(kc + grow * 1024 + h * 128 + ch * 8);
                rQ[u][j] = rK[u][j];
            }
            { const int dvr = tid >> 3, ch = tid & 7; rU[u] = *(const u32x4*)(ubuf + (size_t)citem * 8192 + (half * 64 + dvr) * 64 + ch * 8); }
            if (tid < 64) rG[u] = gcbuf[(size_t)citem * 64 + tid];
        }
        for (int n2 = 0; n2 < 36; n2 += 2) {
#pragma unroll
        for (int u = 0; u < 2; ++u) {
            const int n = n2 + u;
            const ldsp lds = launder(lds0);
            int ln = lane; asm volatile("" : "+v"(ln));
            LAS float* sg = (LAS float*)lds;
            LAS bf16_t* sW = (LAS bf16_t*)(lds + 1024);
            LAS bf16_t* sK = sW + 64 * 136;
            LAS bf16_t* sQ = sK + 64 * 136;
            LAS bf16_t* sU = sQ + 64 * 136;
            LAS bf16_t* sST = sU + 64 * 72;
            LAS bf16_t* sVNT = sST + 64 * 136;
            LAS bf16_t* sVNsT = sVNT + 64 * 72;
            LAS bf16_t* sATT = sVNsT + 64 * 72;
            LAS bf16_t* sO = sATT + 64 * 72;
            const int rowbase = chunk_rowbase(b, d, n);
            const bool wantO = n >= 4;
#pragma unroll
            for (int j = 0; j < 2; ++j) {
                const int cid = tid + NTHREADS * j, i = cid >> 4, ch = cid & 15;
                *(LAS u32x4*)(sW + i * 136 + ch * 8) = rW[u][j];
                *(LAS u32x4*)(sK + i * 136 + ch * 8) = rK[u][j];
                *(LAS u32x4*)(sQ + i * 136 + ch * 8) = rQ[u][j];
            }
            { const int i = tid >> 3, ch = tid & 7; *(LAS u32x4*)(sU + i * 72 + ch * 8) = rU[u]; }
            if (tid < 64) sg[tid] = rG[u];
            __syncthreads();
            if (n + 2 < 36) {
                const int citem = (bh * 2 + d) * 36 + n + 2, rb1 = chunk_rowbase(b, d, n + 2);
                const bool wq = n + 2 >= 4;
#pragma unroll
                for (int j = 0; j < 2; ++j) {
                    const int cid = tid + NTHREADS * j, i = cid >> 4, ch = cid & 15;
                    const size_t grow = (size_t)rb1 + (d ? 63 - i : i);
                    rW[u][j] = *(const u32x4*)(wbuf + (size_t)citem * 8192 + i * 128 + ch * 8);
                    rK[u][j] = *(const u32x4*)(kc + grow * 1024 + h * 128 + ch * 8);
                    if (wq) rQ[u][j] = *(const u32x4*)(qc + grow * 1024 + h * 128 + ch * 8);
                }
                { const int dvr = tid >> 3, ch = tid & 7; rU[u] = *(const u32x4*)(ubuf + (size_t)citem * 8192 + (half * 64 + dvr) * 64 + ch * 8); }
                if (tid < 64) rG[u] = gcbuf[(size_t)citem * 64 + tid];
            }
            const float g63 = sg[63];
            if (wave < 4) {
                const int dv = nt2 * 32 + (ln & 31);
                float uf[16], ef[16];
#pragma unroll
                for (int rg = 0; rg < 4; ++rg) {
                    const int i0 = mt2 * 32 + 8 * rg + 4 * (ln >> 5);
                    const u32x2 uu = *(const LAS u32x2*)(sU + dv * 72 + i0);
                    const f32x4 gg = *(const LAS f32x4*)(sg + i0);
                    uf[rg * 4 + 0] = bflo(uu.x); uf[rg * 4 + 1] = bfhi(uu.x); uf[rg * 4 + 2] = bflo(uu.y); uf[rg * 4 + 3] = bfhi(uu.y);
#pragma unroll
                    for (int e = 0; e < 4; ++e) ef[rg * 4 + e] = __expf(g63 - gg[e]);
                }
                f32x16 acc = zero16(), accb = zero16();
#pragma unroll
                for (int ks = 0; ks < 8; ks += 2) { acc = mfma32(frag_row(sW, 136, mt2 * 32, ks * 16, ln), frag_row(sST, 136, nt2 * 32, ks * 16, ln), acc);
                    accb = mfma32(frag_row(sW, 136, mt2 * 32, ks * 16 + 16, ln), frag_row(sST, 136, nt2 * 32, ks * 16 + 16, ln), accb); }
#pragma unroll
                for (int rg = 0; rg < 4; ++rg) {
                    const int i0 = mt2 * 32 + 8 * rg + 4 * (ln >> 5);
                    float v[4], vs[4];
#pragma unroll
                    for (int e = 0; e < 4; ++e) { v[e] = uf[rg * 4 + e] - (acc[rg * 4 + e] + accb[rg * 4 + e]); vs[e] = v[e] * ef[rg * 4 + e]; }
                    *(LAS u32x2*)(sVNT + dv * 72 + i0) = pack4(v[0], v[1], v[2], v[3]);
                    *(LAS u32x2*)(sVNsT + dv * 72 + i0) = pack4(vs[0], vs[1], vs[2], vs[3]);
                }
            } else if (wantO) {
                const int i = nt2 * 32 + (ln & 31);
                const float gi = sg[i];
                float df[16];
#pragma unroll
                for (int rg = 0; rg < 4; ++rg) {
                    const int j0 = mt2 * 32 + 8 * rg + 4 * (ln >> 5);
                    const f32x4 gg = *(const LAS f32x4*)(sg + j0);
#pragma unroll
                    for (int e = 0; e < 4; ++e) df[rg * 4 + e] = (i >= j0 + e) ? __expf(fminf(gi - gg[e], 0.f)) : 0.f;
                }
                f32x16 acc = zero16(), accb = zero16();
#pragma unroll
                for (int ks = 0; ks < 8; ks += 2) { acc = mfma32(frag_row(sK, 136, mt2 * 32, ks * 16, ln), frag_row(sQ, 136, nt2 * 32, ks * 16, ln), acc);
                    accb = mfma32(frag_row(sK, 136, mt2 * 32, ks * 16 + 16, ln), frag_row(sQ, 136, nt2 * 32, ks * 16 + 16, ln), accb); }
#pragma unroll
                for (int rg = 0; rg < 4; ++rg) {
                    const int j0 = mt2 * 32 + 8 * rg + 4 * (ln >> 5);
                    float v[4];
#pragma unroll
                    for (int e = 0; e < 4; ++e) v[e] = (acc[rg * 4 + e] + accb[rg * 4 + e]) * df[rg * 4 + e];
                    *(LAS u32x2*)(sATT + i * 72 + j0) = pack4(v[0], v[1], v[2], v[3]);
                }
            }
            __syncthreads();
            if (wave < 4 && wantO) {
                float eg[16];
#pragma unroll
                for (int rg = 0; rg < 4; ++rg) {
                    const f32x4 gg = *(const LAS f32x4*)(sg + mt2 * 32 + 8 * rg + 4 * (ln >> 5));
#pragma unroll
                    for (int e = 0; e < 4; ++e) eg[rg * 4 + e] = __expf(gg[e]);
                }
                f32x16 a1 = zero16(), a1b = zero16(), a2 = zero16();
#pragma unroll
                for (int ks = 0; ks < 8; ks += 2) { a1 = mfma32(frag_row(sQ, 136, mt2 * 32, ks * 16, ln), frag_row(sST, 136, nt2 * 32, ks * 16, ln), a1);
                    a1b = mfma32(frag_row(sQ, 136, mt2 * 32, ks * 16 + 16, ln), frag_row(sST, 136, nt2 * 32, ks * 16 + 16, ln), a1b); }
#pragma unroll
                for (int ks = 0; ks < 4; ++ks) a2 = mfma32(frag_row(sATT, 72, mt2 * 32, ks * 16, ln), frag_row(sVNT, 72, nt2 * 32, ks * 16, ln), a2);
                const int dv = nt2 * 32 + (ln & 31);
#pragma unroll
                for (int rg = 0; rg < 4; ++rg) {
                    const int i0 = mt2 * 32 + 8 * rg + 4 * (ln >> 5);
#pragma unroll
                    for (int e = 0; e < 4; ++e) sO[(i0 + e) * 72 + dv] = f2bf((a1[rg * 4 + e] + a1b[rg * 4 + e]) * eg[rg * 4 + e] + a2[rg * 4 + e]);
                }
            }
            {
                const float gl = __expf(g63);
#pragma unroll
                for (int reg = 0; reg < 16; ++reg) S[reg] *= gl;
#pragma unroll
                for (int ks = 0; ks < 4; ++ks) S = mfma32(frag_col_tr(sK, 136, mt * 32, ks * 16, ln), frag_row(sVNsT, 72, nt * 32, ks * 16, ln), S);
            }
            __syncthreads();
            if (wantO) {
                const int i = tid >> 3, ch = tid & 7;
                const size_t grow = (size_t)rowbase + (d ? 63 - i : i);
                *(u32x4*)(obuf + ((size_t)d * NX + grow) * 1024 + h * 128 + half * 64 + ch * 8) = *(const LAS u32x4*)(sO + i * 72 + ch * 8);
            }
#pragma unroll
            for (int rg = 0; rg < 4; ++rg) {
                const int dk0 = mt * 32 + 8 * rg + 4 * (ln >> 5);
                *(LAS u32x2*)(sST + (nt * 32 + (ln & 31)) * 136 + dk0) = pack4(S[rg * 4 + 0], S[rg * 4 + 1], S[rg * 4 + 2], S[rg * 4 + 3]);
            }
        }
        }
        __syncthreads();
    }
}

DEV void phase_dnout(const Params& P) {
    const bf16_t* obuf = (const bf16_t*)(P.ws + OFF_OBUF);
    const bf16_t* Pz = (const bf16_t*)(P.ws + OFF_PZ);
    bf16_t* A = (bf16_t*)(P.ws + OFF_A);
    const int tid = tid_fresh(); const int wave = tid >> 6, lane = tid & 63;
    for (int row = blockIdx.x * 8 + wave; row < NX; row += gridDim.x * 8) {
#pragma unroll
        for (int c = 0; c < 2; ++c) {
            const int col = c * 512 + lane * 8;
            const u32x4 of = *(const u32x4*)(obuf + (size_t)row * 1024 + col), ob = *(const u32x4*)(obuf + ((size_t)NX + row) * 1024 + col);
            const u32x4 zz = *(const u32x4*)(Pz + (size_t)row * 1024 + col);
            float o[8], o2[8], z[8]; unpack8(of, o); unpack8(ob, o2); unpack8(zz, z);
            float ss = 0.f;
#pragma unroll
            for (int e = 0; e < 8; ++e) { o[e] += o2[e]; ss += o[e] * o[e]; }
            ss = sum16(ss);
            const float rn = rsqrtf(ss * (1.f / 128.f) + EPS);
            float y[8];
#pragma unroll
            for (int e = 0; e < 8; ++e) y[e] = o[e] * rn * P.dn_norm_g[(col & 127) + e] * silu(z[e]);
            u32x4 ov; ov.x = pk2(y[0], y[1]); ov.y = pk2(y[2], y[3]); ov.z = pk2(y[4], y[5]); ov.w = pk2(y[6], y[7]);
            *(u32x4*)(A + (size_t)row * 1024 + col) = ov;
        }
    }
}

namespace pg8 {
#define PG8_LAS __attribute__((address_space(3)))
typedef unsigned short bf16_t;
typedef short bf16x8 __attribute__((ext_vector_type(8)));
typedef float f32x4 __attribute__((ext_vector_type(4)));
typedef unsigned u32x4 __attribute__((ext_vector_type(4)));
constexpr int BM = 256, BK = 64, HALF = 128, HTB = HALF * BK * 2  , STAGE_BYTES = 8 * HTB, NXCD = 8, WGM = 8;

__host__ __device__ __forceinline__ int lds_byte(int r, int c) { const int st = (r >> 4) * 2 + (c >> 5), rr = r & 15, cc = c & 31, ob = rr * 64 + cc * 2; return st * 1024 + (ob ^ (((ob >> 9) & 1) << 5)); }
__host__ __device__ __forceinline__ void stage_rc(int b, int& R, int& C) { const int st = b / 1024, sb = b % 1024, swz = sb ^ (((sb >> 9) & 1) << 5); R = (st >> 1) * 16 + swz / 64; C = (st & 1) * 32 + (swz % 64) / 2; }
__host__ __device__ __forceinline__ int perm32(int rho) { const int n = rho >> 4, i = rho & 15; return 8 * (i >> 2) + 4 * n + (i & 3); }

struct Unit { int pm, pn; };
struct Gemm { const bf16_t* A; const bf16_t* Bt; int M, N, K; };

struct StaticOrder {
    int nM, nN, nwg, G, c;
    __host__ __device__ void init(int M, int N, int G_, int c_) { nM = M / BM; nN = N / BM; nwg = nM * nN; G = G_; c = c_; }
    __host__ __device__ bool next(int i, Unit& u) const {
        const long L = (long)i * G + c; if (L >= nwg) return false;
        int wgid = (int)L; { const int q = nwg / NXCD, r = nwg % NXCD, xcd = wgid % NXCD, off = wgid / NXCD; wgid = (xcd < r ? xcd * (q + 1) : r * (q + 1) + (xcd - r) * q) + off; }
        const int nig = WGM * nN, gid = wgid / nig, fm = gid * WGM, gsz = (nM - fm) < WGM ? (nM - fm) : WGM;
        u.pm = fm + ((wgid % nig) % gsz); u.pn = (wgid % nig) / gsz; return true;
    }
    __device__ __forceinline__ void a_ready(const Unit&) const {}
    __device__ __forceinline__ void done(const Unit&) const {}
};

__device__ __forceinline__ unsigned cvt_pk_bf16(float lo, float hi) { typedef float v2f __attribute__((ext_vector_type(2))); typedef __bf16 v2b __attribute__((ext_vector_type(2))); const v2f v = {lo, hi}; return __builtin_bit_cast(unsigned, __builtin_convertvector(v, v2b)); }
__device__ __forceinline__ u32x4 pack8(const f32x4 v0, const f32x4 v1) { u32x4 w; w.x = cvt_pk_bf16(v0[0], v0[1]); w.y = cvt_pk_bf16(v0[2], v0[3]); w.z = cvt_pk_bf16(v1[0], v1[1]); w.w = cvt_pk_bf16(v1[2], v1[3]); return w; }
struct EpiQ {
    static constexpr bool PERM = true, AFTER_DRAIN = false;
    bf16_t* O; int ldc;
    __device__ __forceinline__ void operator()(const f32x4 (&acc)[2][2][4][2], const Unit& u, int wr, int wc, int fr, int fq) const {
        const int row0 = u.pm * BM + wr * 64 + fr, col0 = u.pn * BM + wc * 32 + 8 * fq;
#pragma unroll
        for (int ai = 0; ai < 2; ++ai)
#pragma unroll
            for (int m = 0; m < 4; ++m) { bf16_t* rowp = O + (size_t)(row0 + ai * HALF + m * 16) * ldc + col0;
#pragma unroll
                for (int bj = 0; bj < 2; ++bj) *(u32x4*)(rowp + bj * HALF) = pack8(acc[ai][bj][m][0], acc[ai][bj][m][1]); }
    }
};
struct EpiWinP {
    static constexpr bool PERM = true, AFTER_DRAIN = false;
    bf16_t* qkv; bf16_t* z; float* ab;
    __device__ __forceinline__ void operator()(const f32x4 (&acc)[2][2][4][2], const Unit& u, int wr, int wc, int fr, int fq) const {
        const int row0 = u.pm * BM + wr * 64 + fr;
        if (u.pn < 16) {
            bf16_t* base = u.pn < 12 ? qkv : z; const int ldc = u.pn < 12 ? 3072 : 1024, col0 = (u.pn < 12 ? u.pn : u.pn - 12) * BM + wc * 32 + 8 * fq;
#pragma unroll
            for (int ai = 0; ai < 2; ++ai)
#pragma unroll
                for (int m = 0; m < 4; ++m) { bf16_t* rowp = base + (size_t)(row0 + ai * HALF + m * 16) * ldc + col0;
#pragma unroll
                    for (int bj = 0; bj < 2; ++bj) *(u32x4*)(rowp + bj * HALF) = pack8(acc[ai][bj][m][0], acc[ai][bj][m][1]); }
        } else if (wc == 0) {
#pragma unroll
            for (int ai = 0; ai < 2; ++ai)
#pragma unroll
                for (int m = 0; m < 4; ++m) { float* rowp = ab + (size_t)(row0 + ai * HALF + m * 16) * 32 + 8 * fq;
                    *(f32x4*)rowp = acc[ai][0][m][0]; *(f32x4*)(rowp + 4) = acc[ai][0][m][1]; }
        }
    }
};
struct EpiRes {
    static constexpr bool PERM = true, AFTER_DRAIN = false;
    bf16_t* h; const float* gate;
    __device__ __forceinline__ void operator()(const f32x4 (&acc)[2][2][4][2], const Unit& u, int wr, int wc, int fr, int fq) const {
        const int row0 = u.pm * BM + wr * 64 + fr, col0 = u.pn * BM + wc * 32 + 8 * fq;
#pragma unroll
        for (int ai = 0; ai < 2; ++ai)
#pragma unroll
            for (int m = 0; m < 4; ++m) { const int row = row0 + ai * HALF + m * 16; bf16_t* rowp = h + (size_t)row * 1024 + col0; const float* gp = gate + (row >> 11) * 6144 + col0;
#pragma unroll
                for (int bj = 0; bj < 2; ++bj) {
                    const u32x4 hv = *(const u32x4*)(rowp + bj * HALF);
                    const f32x4 g0 = *(const f32x4*)(gp + bj * HALF), g1 = *(const f32x4*)(gp + bj * HALF + 4);
                    const f32x4 a0 = acc[ai][bj][m][0], a1 = acc[ai][bj][m][1];
                    f32x4 n0, n1;
                    n0[0] = __uint_as_float(hv.x << 16) + g0[0] * a0[0]; n0[1] = __uint_as_float(hv.x & 0xffff0000u) + g0[1] * a0[1];
                    n0[2] = __uint_as_float(hv.y << 16) + g0[2] * a0[2]; n0[3] = __uint_as_float(hv.y & 0xffff0000u) + g0[3] * a0[3];
                    n1[0] = __uint_as_float(hv.z << 16) + g1[0] * a1[0]; n1[1] = __uint_as_float(hv.z & 0xffff0000u) + g1[1] * a1[1];
                    n1[2] = __uint_as_float(hv.w << 16) + g1[2] * a1[2]; n1[3] = __uint_as_float(hv.w & 0xffff0000u) + g1[3] * a1[3];
                    *(u32x4*)(rowp + bj * HALF) = pack8(n0, n1);
                } }
    }
};

template <class Epi, class Sched, bool ALIGN_EPI = false, bool SP2 = false>
__device__ __forceinline__ void gemm_phase(PG8_LAS unsigned char* lds, const Gemm g, const Sched& S, const Epi& E) {
    const int tid = tid_fresh(), wid = __builtin_amdgcn_readfirstlane(tid >> 6), lane = tid & 63, wr = wid >> 2, wc = wid & 3, fr = lane & 15, fq = lane >> 4;
    const int K = g.K, nt = K / BK;
    unsigned voffA[2], voffB[2];
#pragma unroll
    for (int i = 0; i < 2; ++i) { int R, C; stage_rc(tid * 16 + i * 8192, R, C); const int Rb = Epi::PERM ? ((R & ~31) + perm32(R & 31)) : R;
        voffA[i] = (unsigned)(R * K + C) * 2u; voffB[i] = (unsigned)(Rb * K + C) * 2u; }
    const size_t kstep = (size_t)(BK * 2);
    const size_t hstep = (size_t)HALF * K * 2;
    const size_t tstep = 2 * hstep;
    const unsigned ldsw = (unsigned)wid * 1024u;
    const int aoff = lds_byte(wr * 64 + fr, fq * 8), boff = lds_byte(wc * 32 + fr, fq * 8);
#define PG8_SA(b, h) (((b) * 2 + (h)) * HTB)
#define PG8_SB(b, h) ((4 + (b) * 2 + (h)) * HTB)
#define PG8_STAGE(bufoff, gbase, voff) do { _Pragma("unroll") for (int _i = 0; _i < 2; ++_i) \
        __builtin_amdgcn_global_load_lds((const unsigned*)((const char*)(gbase) + (voff)[_i]), (PG8_LAS unsigned*)(lds + (bufoff) + ldsw + _i * 8192), 16, 0, 0); } while (0)
#define PG8_LDA(dst, b, h) do { _Pragma("unroll") for (int m = 0; m < 4; ++m) _Pragma("unroll") for (int k = 0; k < 2; ++k) dst[m][k] = *(const PG8_LAS bf16x8*)(lds + PG8_SA(b, h) + aoff + m * 2048 + k * 1024); } while (0)
#define PG8_LDB(dst, b, h) do { _Pragma("unroll") for (int n = 0; n < 2; ++n) _Pragma("unroll") for (int k = 0; k < 2; ++k) dst[n][k] = *(const PG8_LAS bf16x8*)(lds + PG8_SB(b, h) + boff + n * 2048 + k * 1024); } while (0)
#define PG8_MMA(ai, bj, At, Bt) do { __builtin_amdgcn_s_setprio(1); _Pragma("unroll") for (int m = 0; m < 4; ++m) _Pragma("unroll") for (int n = 0; n < 2; ++n) _Pragma("unroll") for (int k = 0; k < 2; ++k) \
        acc[ai][bj][m][n] = __builtin_amdgcn_mfma_f32_16x16x32_bf16(Bt[n][k], At[m][k], acc[ai][bj][m][n], 0, 0, 0); __builtin_amdgcn_s_setprio(0); } while (0)
#define PG8_WAIT_V(n) asm volatile("s_waitcnt vmcnt(" #n ")" ::: "memory")
#define PG8_WAIT_L(n) asm volatile("s_waitcnt lgkmcnt(" #n ")" ::: "memory")
#define PG8_BAR __builtin_amdgcn_s_barrier()
#define PG8_SCHED __builtin_amdgcn_sched_barrier(0)
    Unit cur, nxt; int ui = 0;
    if (!S.next(0, cur)) return;
    f32x4 acc[2][2][4][2];
#pragma unroll
    for (int a = 0; a < 2; ++a)
#pragma unroll
        for (int b = 0; b < 2; ++b)
#pragma unroll
            for (int m = 0; m < 4; ++m)
#pragma unroll
                for (int n = 0; n < 2; ++n) acc[a][b][m][n] = (f32x4){0.f, 0.f, 0.f, 0.f};
    bf16x8 At[4][2], B0[2][2], B1[2][2];
    const char* cA = (const char*)g.A + (size_t)cur.pm * tstep; const char* cB = (const char*)g.Bt + (size_t)cur.pn * tstep;
    S.a_ready(cur);
    if constexpr (SP2) {
        PG8_STAGE(PG8_SB(0, 0), cB, voffB); PG8_STAGE(PG8_SB(0, 1), cB + hstep, voffB); PG8_STAGE(PG8_SA(0, 0), cA, voffA); PG8_STAGE(PG8_SA(0, 1), cA + hstep, voffA);
        if (wr == 1) PG8_BAR;
        PG8_WAIT_V(2); PG8_BAR;
        PG8_STAGE(PG8_SB(1, 0), cB + kstep, voffB); PG8_STAGE(PG8_SA(1, 0), cA + kstep, voffA); PG8_STAGE(PG8_SB(1, 1), cB + hstep + kstep, voffB);
        PG8_WAIT_V(6); PG8_BAR;
    } else {
        PG8_STAGE(PG8_SB(0, 0), cB, voffB); PG8_STAGE(PG8_SA(0, 0), cA, voffA); PG8_STAGE(PG8_SB(0, 1), cB + hstep, voffB); PG8_STAGE(PG8_SA(0, 1), cA + hstep, voffA);
        if (wr == 1) PG8_BAR;
        PG8_WAIT_V(4); PG8_BAR;
        PG8_STAGE(PG8_SB(1, 0), cB + kstep, voffB); PG8_STAGE(PG8_SA(1, 0), cA + kstep, voffA); PG8_STAGE(PG8_SB(1, 1), cB + hstep + kstep, voffB);
        PG8_WAIT_V(6); PG8_BAR;
    }
    for (;;) {
        const bool has_next = S.next(ui + 1, nxt);
        const char* nA = has_next ? (const char*)g.A + (size_t)nxt.pm * tstep : cA; const char* nB = has_next ? (const char*)g.Bt + (size_t)nxt.pn * tstep : cB;
        for (int t = 0; t < nt; t += 2) {
            const bool last = (t == nt - 2);
            const char* a1 = cA + (size_t)(t + 1) * kstep;
            const char* a2 = last ? nA : cA + (size_t)(t + 2) * kstep; const char* b2 = last ? nB : cB + (size_t)(t + 2) * kstep;
            const char* a3 = a2 + kstep; const char* b3 = b2 + kstep;
            if (last && has_next) S.a_ready(nxt);
            if constexpr (SP2) {
            PG8_LDB(B0, 0, 0); PG8_LDB(B1, 0, 1); PG8_SCHED; PG8_LDA(At, 0, 0); PG8_STAGE(PG8_SA(1, 1), a1 + hstep, voffA);
            PG8_WAIT_V(8); PG8_WAIT_L(0); PG8_BAR; PG8_MMA(0, 0, At, B0); PG8_MMA(0, 1, At, B1); PG8_BAR; PG8_SCHED;
            PG8_LDA(At, 0, 1); PG8_STAGE(PG8_SB(0, 0), b2, voffB); PG8_STAGE(PG8_SB(0, 1), b2 + hstep, voffB); PG8_STAGE(PG8_SA(0, 0), a2, voffA);
            PG8_WAIT_V(8); PG8_WAIT_L(0); PG8_BAR; PG8_MMA(1, 0, At, B0); PG8_MMA(1, 1, At, B1); PG8_BAR; PG8_SCHED;
            PG8_LDB(B0, 1, 0); PG8_LDB(B1, 1, 1); PG8_SCHED; PG8_LDA(At, 1, 0); PG8_STAGE(PG8_SA(0, 1), a2 + hstep, voffA);
            PG8_WAIT_V(8); PG8_WAIT_L(0); PG8_BAR; PG8_MMA(0, 0, At, B0); PG8_MMA(0, 1, At, B1); PG8_BAR; PG8_SCHED;
            PG8_LDA(At, 1, 1); PG8_STAGE(PG8_SB(1, 0), b3, voffB); PG8_STAGE(PG8_SB(1, 1), b3 + hstep, voffB); PG8_STAGE(PG8_SA(1, 0), a3, voffA);
            PG8_WAIT_V(8); PG8_WAIT_L(0); PG8_BAR; PG8_MMA(1, 0, At, B0); PG8_MMA(1, 1, At, B1); PG8_BAR; PG8_SCHED;
            } else {
            PG8_LDB(B0, 0, 0); PG8_SCHED; PG8_LDA(At, 0, 0); PG8_STAGE(PG8_SA(1, 1), a1 + hstep, voffA);
            PG8_WAIT_L(8); PG8_BAR; PG8_WAIT_L(0); PG8_MMA(0, 0, At, B0); PG8_BAR; PG8_SCHED;
            PG8_LDB(B1, 0, 1); PG8_STAGE(PG8_SB(0, 0), b2, voffB);
            PG8_BAR; PG8_WAIT_L(0); PG8_MMA(0, 1, At, B1); PG8_BAR;
            PG8_LDA(At, 0, 1); PG8_STAGE(PG8_SA(0, 0), a2, voffA);
            PG8_BAR; PG8_WAIT_L(0); PG8_MMA(1, 0, At, B0); PG8_BAR; PG8_SCHED;
            PG8_STAGE(PG8_SB(0, 1), b2 + hstep, voffB);
            PG8_WAIT_V(6); PG8_BAR; PG8_MMA(1, 1, At, B1); PG8_BAR;
            PG8_LDB(B0, 1, 0); PG8_SCHED; PG8_LDA(At, 1, 0); PG8_STAGE(PG8_SA(0, 1), a2 + hstep, voffA);
            PG8_WAIT_L(8); PG8_BAR; PG8_WAIT_L(0); PG8_MMA(0, 0, At, B0); PG8_BAR; PG8_SCHED;
            PG8_LDB(B1, 1, 1); PG8_STAGE(PG8_SB(1, 0), b3, voffB);
            PG8_BAR; PG8_WAIT_L(0); PG8_MMA(0, 1, At, B1); PG8_BAR;
            PG8_LDA(At, 1, 1); PG8_STAGE(PG8_SA(1, 0), a3, voffA);
            PG8_BAR; PG8_WAIT_L(0); PG8_MMA(1, 0, At, B0); PG8_BAR; PG8_SCHED;
            PG8_STAGE(PG8_SB(1, 1), b3 + hstep, voffB);
            PG8_WAIT_V(6); PG8_BAR; PG8_MMA(1, 1, At, B1); PG8_BAR;
            }
        }
        if constexpr (ALIGN_EPI) { if (wr == 0) PG8_BAR; }
        if constexpr (!Epi::AFTER_DRAIN) { E(acc, cur, wr, wc, fr, fq); S.done(cur); }
        if (!has_next) break;
#pragma unroll
        for (int a = 0; a < 2; ++a)
#pragma unroll
            for (int b = 0; b < 2; ++b)
#pragma unroll
                for (int m = 0; m < 4; ++m)
#pragma unroll
                    for (int n = 0; n < 2; ++n) acc[a][b][m][n] = (f32x4){0.f, 0.f, 0.f, 0.f};
        cur = nxt; cA = nA; cB = nB; ++ui;
        if constexpr (ALIGN_EPI) { if (wr == 1) PG8_BAR; }
    }
    PG8_WAIT_V(0);
    if constexpr (!ALIGN_EPI) { if (wr == 0) PG8_BAR; }
    PG8_BAR;
    if constexpr (Epi::AFTER_DRAIN) { E.fused(acc, cur, wr, wc, fr, fq, lds, wid, lane); S.done(cur); }
#undef PG8_SA
#undef PG8_SB
#undef PG8_STAGE
#undef PG8_LDA
#undef PG8_LDB
#undef PG8_MMA
#undef PG8_WAIT_V
#undef PG8_WAIT_L
#undef PG8_BAR
#undef PG8_SCHED
}
}

#define XB_TMO      128
#define XB_XCNT(j)  (256  + 64 * (j))
#define XB_XSUB(j)  (1280 + 64 * (j))
#define XB_XGEN(j)  (2304 + 64 * (j))
#define XB_TOP      3328
#define XB_TOPGEN   3392
#define XCD_BAR_WORDS 3456
#define XB_SPIN_CAP (1u << 22)
DEV unsigned xb_ld(unsigned* p)              { return __hip_atomic_load(p, __ATOMIC_RELAXED, __HIP_MEMORY_SCOPE_AGENT); }
DEV unsigned xb_add(unsigned* p, unsigned v) { return __hip_atomic_fetch_add(p, v, __ATOMIC_RELAXED, __HIP_MEMORY_SCOPE_AGENT); }
DEV unsigned xb_xcc_id() { return (unsigned)__builtin_amdgcn_s_getreg((3 << 11) | 20) & 0xFu; }
#define XB_SPIN(cond, bar) do { unsigned _sp = 0; while (cond) { __builtin_amdgcn_s_sleep(1); \
    if ((++_sp & 255u) == 0u) { if (xb_ld(&(bar)[XB_TMO])) break; if (_sp > XB_SPIN_CAP) { atomicAdd(&(bar)[XB_TMO], 1u); break; } } } } while (0)
struct XcdBarrier { unsigned* bar; unsigned x; volatile LAS unsigned* st; };
DEV XcdBarrier xcd_barrier_post(unsigned* bar, volatile LAS unsigned* st) {
    XcdBarrier b; b.bar = bar; b.x = xb_xcc_id(); b.st = st;
    if (threadIdx.x == 0) (void)xb_add(&bar[XB_XCNT(b.x)], 1u);
    return b;
}
DEV void xcd_barrier_complete(unsigned* bar, unsigned x, unsigned& nloc, unsigned& nx) {
    const unsigned G = gridDim.x * gridDim.y * gridDim.z;
    unsigned sum, cnt, mine, sp = 0u;
    for (;;) {
        sum = 0u; cnt = 0u; mine = 0u;
#pragma unroll
        for (unsigned j = 0; j < 16; ++j) { const unsigned c = xb_ld(&bar[XB_XCNT(j)]); sum += c; cnt += (c > 0u) ? 1u : 0u; mine = (j == x) ? c : mine; }
        if (sum == G) break;
        __builtin_amdgcn_s_sleep(1);
        if ((++sp & 255u) == 0u) { if (xb_ld(&bar[XB_TMO])) break; if (sp > XB_SPIN_CAP) { atomicAdd(&bar[XB_TMO], 1u); break; } }
    }
    nloc = mine > 0u ? mine : 1u; nx = cnt > 0u ? cnt : 1u;
}
DEV void xcd_barrier(const XcdBarrier& b) {
    asm volatile("s_waitcnt vmcnt(0)" ::: "memory");
    __syncthreads();
    if (threadIdx.x == 0) {
        unsigned* bar = b.bar;
        __builtin_amdgcn_s_waitcnt(0);
        unsigned nloc = b.st[0], nx = b.st[1];
        if (nloc == 0u) { xcd_barrier_complete(bar, b.x, nloc, nx); b.st[0] = nloc; b.st[1] = nx; }
        const unsigned old = xb_add(&bar[XB_XSUB(b.x)], 1u);
        const unsigned gen = old / nloc;
        if (old + 1u == (gen + 1u) * nloc) {
            __builtin_amdgcn_fence(__ATOMIC_RELEASE, "agent");
            asm volatile("s_waitcnt vmcnt(0)" ::: "memory");
            const unsigned og = xb_add(&bar[XB_TOP], 1u);
            const unsigned tg = og / nx;
            if (og + 1u == (tg + 1u) * nx) xb_add(&bar[XB_TOPGEN], 1u);
            else XB_SPIN(xb_ld(&bar[XB_TOPGEN]) == tg, bar);
            __builtin_amdgcn_fence(__ATOMIC_ACQUIRE, "agent");
            xb_add(&bar[XB_XGEN(b.x)], 1u);
            asm volatile("s_waitcnt vmcnt(0)" ::: "memory");
        } else {
            XB_SPIN(xb_ld(&bar[XB_XGEN(b.x)]) == gen, bar);
            __builtin_amdgcn_fence(__ATOMIC_ACQUIRE, "agent");
            asm volatile("s_waitcnt vmcnt(0)" ::: "memory");
        }
    }
    __syncthreads();
}

__global__ void __launch_bounds__(NTHREADS) fwd_megakernel(Params P) {
    __shared__ __attribute__((aligned(16))) unsigned char lds_raw[131072 + 4096];
    const ldsp lds = (ldsp)lds_raw;
    cg::grid_group grid = cg::this_grid();
    volatile LAS unsigned* xbst = (volatile LAS unsigned*)(lds + 131072);
    if (threadIdx.x == 0) { xbst[0] = 0u; xbst[1] = 0u; }
    __syncthreads();
    const XcdBarrier xbar = xcd_barrier_post((unsigned*)(P.ws + OFF_BAR), xbst);
#define GBAR() xcd_barrier(xbar)
#define ROW_HANDOFF() do { __builtin_amdgcn_fence(__ATOMIC_RELEASE, "workgroup"); asm volatile("s_waitcnt vmcnt(0)" ::: "memory"); __builtin_amdgcn_fence(__ATOMIC_ACQUIRE, "workgroup"); } while (0)
    const float* modv = (const float*)(P.ws + OFF_MODV);
    bf16_t* Abuf = (bf16_t*)(P.ws + OFF_A);

#define RUN(rep, ...) for (int rep_i = 0; rep_i < (rep); ++rep_i) { __VA_ARGS__; GBAR(); }
    for (int rep_i = 0; rep_i < REP_PREP; ++rep_i) { phase_prep(P, lds); grid.sync(); }
    RUN(REP_MOD, phase_modulate<0>(P, 0, 0, NT))
    RUN(REP_POOL, phase_pool(P, lds))
    RUN(REP_MOD, phase_modulate<1>(P, 0, 1, NT, true))
    RUN(REP_GEMM, { pg8::Gemm g{Abuf, (const bf16_t*)(P.ws + OFF_WQT), NT, 2048, 1024}; pg8::StaticOrder S; S.init(NT, 2048, gridDim.x, blockIdx.x); pg8::EpiQ e{(bf16_t*)(P.ws + OFF_R1), 2048}; pg8::gemm_phase<pg8::EpiQ, pg8::StaticOrder, true, true>(lds, g, S, e); })
    RUN(REP_TOPK, phase_topk(P, 0, NT, lds))
    phase_experts(P, 0, NT, lds);
    ROW_HANDOFF();
    RUN(REP_MOD, phase_modulate<1>(P, 1, 0, NT))
    RUN(REP_GEMM, { pg8::Gemm g{Abuf, (const bf16_t*)(P.ws + OFF_WINT), NT, 4352, 1024}; pg8::StaticOrder S; S.init(NT, 4352, gridDim.x, blockIdx.x);
      pg8::EpiWinP e{(bf16_t*)(P.ws + OFF_R1), (bf16_t*)(P.ws + OFF_PZ), (float*)(P.ws + OFF_AB)}; pg8::gemm_phase<pg8::EpiWinP, pg8::StaticOrder, true, true>(lds, g, S, e); })
    RUN(REP_CONV, phase_conv(P))
    RUN(REP_CHUNK, phase_chunk(P, lds))
    RUN(REP_SCAN, phase_scan(P, lds))
    RUN(REP_DNOUT, phase_dnout(P))
    { pg8::Gemm g{Abuf, (const bf16_t*)(P.ws + OFF_WOUTT), NX, 1024, 1024}; pg8::StaticOrder S; S.init(NX, 1024, gridDim.x, blockIdx.x); pg8::EpiRes e{(bf16_t*)(P.ws + OFF_H), modv + 9 * 6144 + 2048}; pg8::gemm_phase<pg8::EpiRes, pg8::StaticOrder, false, true>(lds, g, S, e); }
    GBAR();
    RUN(REP_MOD, phase_modulate<1>(P, 1, 1, NX, true))
    RUN(REP_GEMM, { pg8::Gemm g{Abuf, (const bf16_t*)(P.ws + OFF_WQT) + (size_t)2048 * 1024, NX, 2048, 1024}; pg8::StaticOrder S; S.init(NX, 2048, gridDim.x, blockIdx.x); pg8::EpiQ e{(bf16_t*)(P.ws + OFF_R1), 2048}; pg8::gemm_phase<pg8::EpiQ, pg8::StaticOrder, true, true>(lds, g, S, e); })
    RUN(REP_TOPK, phase_topk(P, 1, NX, lds))
    phase_experts(P, 1, NX, lds);
    ROW_HANDOFF();
    phase_final(P);
}

extern "C" void kernel_launch(void* const* d_in, const int* in_sizes, int n_in, void* d_out, int out_size, void* d_ws, size_t ws_size, hipStream_t stream) {
    static int grid_blocks = 0;
    if (grid_blocks == 0) {
        if (n_in != 21 || out_size != NX * D || ws_size < WS_END) {
            fprintf(stderr, "kernel_launch: unexpected shapes: n_in %d out %d ws %zu (need %zu)\n", n_in, out_size, ws_size, (size_t)WS_END);
            grid_blocks = -1; return;
        }
        int dev = 0, cus = 0, per_cu = 0;
        hipGetDevice(&dev);
        hipDeviceGetAttribute(&cus, hipDeviceAttributeMultiprocessorCount, dev);
        hipOccupancyMaxActiveBlocksPerMultiprocessor(&per_cu, fwd_megakernel, NTHREADS, 0);
        if (per_cu < 1) { fprintf(stderr, "kernel_launch: occupancy query reports %d blocks per CU\n", per_cu); grid_blocks = -1; return; }
        grid_blocks = cus;
    }
    if (grid_blocks < 0) return;
    if (hipMemsetAsync((char*)d_ws + OFF_BAR, 0, XCD_BAR_WORDS * 4, stream) != hipSuccess) { fprintf(stderr, "kernel_launch: memset of barrier words failed\n"); return; }
    Params p{};
    const float** pp = (const float**)&p;
    for (int i = 0; i < 21; ++i) pp[i] = (const float*)d_in[i];
    p.out = (float*)d_out; p.ws = (unsigned char*)d_ws;
    void* args[] = {&p};
    hipError_t e = hipLaunchCooperativeKernel((void*)fwd_megakernel, dim3(grid_blocks), dim3(NTHREADS), args, 0, stream);
    if (e != hipSuccess) fprintf(stderr, "cooperative launch failed: %s (grid %d)\n", hipGetErrorString(e), grid_blocks);
}
```

```cpp
#include <hip/hip_runtime.h>
#include <hip/hip_cooperative_groups.h>
#include <cstdio>
#include <cstdint>
namespace cg = cooperative_groups;

#define DEV __device__ __forceinline__
typedef unsigned short bf16_t;
typedef short bf16x8 __attribute__((ext_vector_type(8)));
typedef float f32x4 __attribute__((ext_vector_type(4)));
typedef float f32x16 __attribute__((ext_vector_type(16)));
typedef unsigned u32x4 __attribute__((ext_vector_type(4)));
typedef unsigned u32x2 __attribute__((ext_vector_type(2)));
#define LAS __attribute__((address_space(3)))
typedef LAS unsigned char* ldsp;
DEV int tid_fresh() { int t = threadIdx.x; asm volatile("" : "+v"(t)); return t; }
DEV ldsp launder(ldsp p) { asm volatile("" : "+v"(p)); return p; }

constexpr int D = 1024, NB = 8, SEQ = 2048, CTX = 256;
constexpr int NX = NB * SEQ, NC = NB * CTX, NT = NX + NC;
constexpr int NTHREADS = 512;
constexpr float EPS = 1e-6f;
#ifndef REP_PREP
#define REP_PREP 1
#endif
#ifndef REP_MOD
#define REP_MOD 1
#endif
#ifndef REP_POOL
#define REP_POOL 1
#endif
#ifndef REP_GEMM
#define REP_GEMM 1
#endif
#ifndef REP_TOPK
#define REP_TOPK 1
#endif
#ifndef REP_CONV
#define REP_CONV 1
#endif
#ifndef REP_CHUNK
#define REP_CHUNK 1
#endif
#ifndef REP_SCAN
#define REP_SCAN 1
#endif
#ifndef REP_DNOUT
#define REP_DNOUT 1
#endif

constexpr size_t MiB = 1024 * 1024;
constexpr size_t TAB_ELEMS = (size_t)16384 * 1024;
constexpr size_t OFF_TAB   = 0;
constexpr size_t OFF_WQT   = 128 * MiB;
constexpr size_t OFF_WINT  = OFF_WQT + 8 * MiB;
constexpr size_t OFF_WOUTT = OFF_WINT + (size_t)4352 * 1024 * 2;
constexpr size_t OFF_POOLT = OFF_WOUTT + 2 * MiB;
constexpr size_t OFF_KEYS  = OFF_POOLT + 512 * 1024;
constexpr size_t OFF_MODV  = OFF_KEYS + 1 * MiB;
constexpr size_t OFF_HC    = OFF_MODV + 512 * 1024;
constexpr size_t OFF_SELI  = OFF_HC + 8 * MiB;
constexpr size_t OFF_SELG  = OFF_SELI + (size_t)NT * 128 * 4;
constexpr size_t OFF_AB    = OFF_SELG + (size_t)NT * 128 * 4;
constexpr size_t OFF_G     = OFF_AB + (size_t)NT * 32 * 4;
constexpr size_t OFF_BETA  = OFF_G + (size_t)2 * NT * 8 * 4;
constexpr size_t OFF_GC    = OFF_BETA + (size_t)2 * NT * 8 * 4;
constexpr size_t OFF_QC    = OFF_GC + (size_t)4608 * 64 * 4;
constexpr size_t OFF_KC    = OFF_QC + (size_t)NT * 1024 * 2;
constexpr size_t OFF_VC    = OFF_KC + (size_t)NT * 1024 * 2;
constexpr size_t OFF_A     = OFF_VC + (size_t)NT * 1024 * 2;
constexpr size_t OFF_R1    = OFF_A + (size_t)NT * 1024 * 2;
constexpr size_t OFF_PZ    = OFF_R1 + (size_t)NT * 3072 * 2;
constexpr size_t OFF_BAR   = OFF_R1 + (size_t)NT * 4096 * 2;
constexpr size_t OFF_H     = OFF_BAR + 16384;
constexpr size_t OFF_XS    = OFF_H + (size_t)NT * 1024 * 2;
constexpr size_t OFF_RSC   = OFF_XS + (size_t)NT * 4;
constexpr size_t WS_END    = OFF_RSC + (size_t)4 * 16384 * 4;
constexpr size_t OFF_WBUF  = OFF_A;
constexpr size_t OFF_UBUF  = OFF_A + (size_t)4608 * 8192 * 2;
constexpr size_t OFF_OBUF  = OFF_TAB + 64 * MiB;
constexpr size_t OFF_PART  = OFF_QC;
constexpr size_t OFF_WEXP  = OFF_QC + (size_t)8 * NT * 128 * 4;
constexpr size_t OFF_A8    = OFF_WEXP + (size_t)NT * 128 * 4;
static_assert(OFF_UBUF + (size_t)4608 * 8192 * 2 <= OFF_PZ, "w/u overlay must not reach Pz");
static_assert(OFF_A8 + (size_t)NT * 1024 <= OFF_A, "PEER partial buffers must fit the q/k/v conv region");

struct Params {
    const float *x, *c, *ctx, *c_ctx, *mod_w, *mod_b, *norm1_g, *norm2_g, *pool_w, *pool_scale;
    const float *dn_w_in, *dn_conv_w, *dn_a_log, *dn_dt_bias, *dn_norm_g, *dn_w_out;
    const float *peer_wq, *peer_keys, *peer_u, *peer_v, *final_g;
    float* out; unsigned char* ws;
};

DEV bf16_t f2bf(float f) { return __builtin_bit_cast(unsigned short, (__bf16)f); }
DEV float bf2f(bf16_t h) { return __uint_as_float(((unsigned)h) << 16); }
typedef float f32x2_t __attribute__((ext_vector_type(2)));
typedef __bf16 bf16x2_t __attribute__((ext_vector_type(2)));
DEV unsigned pk2(float a, float b) { const f32x2_t v = {a, b}; const bf16x2_t r = __builtin_convertvector(v, bf16x2_t); return __builtin_bit_cast(unsigned, r); }
DEV float bflo(unsigned u) { return __uint_as_float(u << 16); }
DEV float bfhi(unsigned u) { return __uint_as_float(u & 0xffff0000u); }
DEV float wave_sum(float v) {
#pragma unroll
    for (int o = 32; o >= 1; o >>= 1) v += __shfl_xor(v, o);
    return v;
}
DEV float wave_max(float v) {
#pragma unroll
    for (int o = 32; o >= 1; o >>= 1) v = fmaxf(v, __shfl_xor(v, o));
    return v;
}
DEV float sum16(float v) {
#pragma unroll
    for (int o = 8; o >= 1; o >>= 1) v += __shfl_xor(v, o);
    return v;
}
DEV f32x16 mfma32(bf16x8 a, bf16x8 b, f32x16 c) { return __builtin_amdgcn_mfma_f32_32x32x16_bf16(a, b, c, 0, 0, 0); }
DEV int crow(int reg, int lane) { return (reg & 3) + 8 * (reg >> 2) + 4 * (lane >> 5); }
DEV f32x16 zero16() { f32x16 z;
#pragma unroll
    for (int i = 0; i < 16; ++i) z[i] = 0.f; return z; }
DEV bf16_t* hrow(const Params& P, int r) { return (bf16_t*)(P.ws + OFF_H) + (size_t)r * 1024; }
DEV float silu(float v) { return v * __builtin_amdgcn_rcpf(1.f + __expf(-v)); }

DEV bf16x8 frag_row(const LAS bf16_t* m, int ld, int r0, int k0, int lane) {
    return *(const LAS bf16x8*)(m + (r0 + (lane & 31)) * ld + k0 + 8 * (lane >> 5));
}
DEV bf16x8 frag_col(const LAS bf16_t* m, int ld, int c0, int k0, int lane) {
    bf16x8 f;
#pragma unroll
    for (int j = 0; j < 8; ++j) f[j] = (short)m[(k0 + 8 * (lane >> 5) + j) * ld + c0 + (lane & 31)];
    return f;
}

typedef short s16x4 __attribute__((ext_vector_type(4)));
DEV s16x4 ds_tr16(ldsp p) { return __builtin_amdgcn_ds_read_tr16_b64_v4i16((LAS s16x4*)p); }
DEV bf16x8 frag_col_tr(const LAS bf16_t* m, int ld, int c0, int k0, int lane) {
    const int gi = lane >> 4, li = lane & 15, q = li >> 2, pc = li & 3, h = gi >> 1;
    const LAS bf16_t* p = m + (k0 + 8 * h + q) * ld + c0 + 16 * (gi & 1) + 4 * pc;
    const s16x4 lo = ds_tr16((ldsp)p), hi = ds_tr16((ldsp)(p + 4 * ld));
    bf16x8 f; f[0] = lo[0]; f[1] = lo[1]; f[2] = lo[2]; f[3] = lo[3]; f[4] = hi[0]; f[5] = hi[1]; f[6] = hi[2]; f[7] = hi[3];
    return f;
}
DEV void p0_convert_item(const float* src, bf16_t* dst, size_t base) {
    const int tid = tid_fresh();
#pragma unroll
    for (int it = 0; it < 8; ++it) {
        const size_t e = base + ((size_t)it * NTHREADS + tid) * 8;
        const f32x4 a = *(const f32x4*)(src + e), b = *(const f32x4*)(src + e + 4);
        u32x4 o; o.x = pk2(a.x, a.y); o.y = pk2(a.z, a.w); o.z = pk2(b.x, b.y); o.w = pk2(b.z, b.w);
        *(u32x4*)(dst + e) = o;
    }
}
DEV void p0_table_item(const float* src, unsigned char* dst, float* rscale, int row0, bool as_int8) {
    const int tid = tid_fresh(), wave = tid >> 6, lane = tid & 63;
#pragma unroll 8
    for (int rr = 0; rr < 16; ++rr) {
        const int e = row0 + wave * 16 + rr;
        f32x4 v[4]; float am = 0.f;
#pragma unroll
        for (int q = 0; q < 4; ++q) { v[q] = __builtin_nontemporal_load((const f32x4*)(src + (size_t)e * 1024 + 256 * q + 4 * lane));
            am = fmaxf(am, fmaxf(fmaxf(fabsf(v[q].x), fabsf(v[q].y)), fmaxf(fabsf(v[q].z), fabsf(v[q].w)))); }
        am = wave_max(am);
        if (as_int8) {
            float ssq = 0.f;
#pragma unroll
            for (int q = 0; q < 4; ++q) ssq += v[q].x * v[q].x + v[q].y * v[q].y + v[q].z * v[q].z + v[q].w * v[q].w;
            ssq = wave_sum(ssq);
            const float top = fminf(am, 2.7f * sqrtf(ssq * (1.f / 1024.f)));
            am = top;
            const float sc = am > 0.f ? 7.f / am : 0.f;
#pragma unroll
            for (int q = 0; q < 4; ++q) {
                const int n0 = (int)fminf(fmaxf(rintf(v[q].x * sc), -7.f), 7.f) + 8, n1 = (int)fminf(fmaxf(rintf(v[q].y * sc), -7.f), 7.f) + 8;
                const int n2 = (int)fminf(fmaxf(rintf(v[q].z * sc), -7.f), 7.f) + 8, n3 = (int)fminf(fmaxf(rintf(v[q].w * sc), -7.f), 7.f) + 8;
                *(unsigned short*)(dst + ((size_t)q * 16384 + e) * 128 + 2 * lane) = (unsigned short)(n0 | (n1 << 4) | (n2 << 8) | (n3 << 12));
            }
            if (lane == 0) rscale[e] = am * (1.f / 7.f);
        } else {
            float ssq = 0.f;
#pragma unroll
            for (int q = 0; q < 4; ++q) ssq += v[q].x * v[q].x + v[q].y * v[q].y + v[q].z * v[q].z + v[q].w * v[q].w;
            ssq = wave_sum(ssq);
            const float top = fminf(am, 2.8f * sqrtf(ssq * (1.f / 1024.f)));
            const float sc = top > 0.f ? 6.f / top : 0.f;
#pragma unroll
            for (int q = 0; q < 4; ++q) {
                const float x0 = fminf(fmaxf(v[q].x * sc, -6.f), 6.f), x1 = fminf(fmaxf(v[q].y * sc, -6.f), 6.f), x2 = fminf(fmaxf(v[q].z * sc, -6.f), 6.f), x3 = fminf(fmaxf(v[q].w * sc, -6.f), 6.f);
                unsigned w = __builtin_amdgcn_cvt_scalef32_pk_fp4_f32(0u, x0, x1, 1.0f, 0);
                w = __builtin_amdgcn_cvt_scalef32_pk_fp4_f32(w, x2, x3, 1.0f, 1);
                *(unsigned short*)(dst + ((size_t)q * 16384 + e) * 128 + 2 * lane) = (unsigned short)(w & 0xffffu);
            }
            if (lane == 0) rscale[e] = top * (1.f / 6.f);
        }
    }
}
DEV void p0_transpose_item(const float* W, int K, int N, bf16_t* Wt, int kt, int nt, LAS float* tile) {
    const int tid = tid_fresh(), k0 = kt * 64, n0 = nt * 256;
    f32x4 v[8];
#pragma unroll
    for (int p = 0; p < 8; ++p) {
        const int kk = p * 8 + (tid >> 6), nn = (tid & 63) * 4, n = n0 + nn;
        v[p] = (f32x4){0.f, 0.f, 0.f, 0.f};
        if (n < N) v[p] = __builtin_nontemporal_load((const f32x4*)(W + (size_t)(k0 + kk) * N + n));
    }
#pragma unroll
    for (int p = 0; p < 8; ++p) {
        const int kk = p * 8 + (tid >> 6), nn = (tid & 63) * 4;
        tile[kk * 257 + nn + 0] = v[p].x; tile[kk * 257 + nn + 1] = v[p].y; tile[kk * 257 + nn + 2] = v[p].z; tile[kk * 257 + nn + 3] = v[p].w;
    }
    __syncthreads();
#pragma unroll
    for (int q = 0; q < 4; ++q) {
        const int n = q * 64 + (tid >> 3), kc = (tid & 7) * 8;
        u32x4 o;
        o.x = pk2(tile[(kc + 0) * 257 + n], tile[(kc + 1) * 257 + n]);
        o.y = pk2(tile[(kc + 2) * 257 + n], tile[(kc + 3) * 257 + n]);
        o.z = pk2(tile[(kc + 4) * 257 + n], tile[(kc + 5) * 257 + n]);
        o.w = pk2(tile[(kc + 6) * 257 + n], tile[(kc + 7) * 257 + n]);
        *(u32x4*)(Wt + (size_t)(n0 + n) * K + k0 + kc) = o;
    }
    __syncthreads();
}
DEV void p0_mod_item(const Params& P, int i, int cb, LAS float* lds) {
    LAS float* s = lds;
    LAS float* red = lds + 9 * 1024;
    const int tid = tid_fresh();
    for (int e = tid; e < 9 * 1024; e += NTHREADS) {
        const int m = e >> 10, k = e & 1023;
        const float cv = m < 8 ? P.c[m * 1024 + k] : P.c_ctx[k];
        s[e] = silu(cv);
    }
    __syncthreads();
    const int cq = tid & 31, kg = tid >> 5;
    const float* W = P.mod_w + (size_t)i * 1024 * 6144 + cb * 128 + cq * 4;
    f32x4 acc[9];
#pragma unroll
    for (int m = 0; m < 9; ++m) acc[m] = (f32x4){0.f, 0.f, 0.f, 0.f};
#pragma unroll 16
    for (int kk = 0; kk < 64; ++kk) {
        const int k = kg * 64 + kk;
        const f32x4 w = __builtin_nontemporal_load((const f32x4*)(W + (size_t)k * 6144));
#pragma unroll
        for (int m = 0; m < 9; ++m) { const float sv = s[m * 1024 + k]; acc[m] += w * sv; }
    }
#pragma unroll
    for (int m = 0; m < 9; ++m) *(LAS f32x4*)&red[(kg * 9 + m) * 128 + cq * 4] = acc[m];
    __syncthreads();
    float* modv = (float*)(P.ws + OFF_MODV);
    for (int e = tid; e < 9 * 128; e += NTHREADS) {
        const int m = e >> 7, col = e & 127;
        float sum = 0.f;
#pragma unroll
        for (int g = 0; g < 16; ++g) sum += red[(g * 9 + m) * 128 + col];
        modv[(size_t)(i * 9 + m) * 6144 + cb * 128 + col] = sum + P.mod_b[i * 6144 + cb * 128 + col];
    }
    __syncthreads();
}
DEV void phase_prep(const Params& P, ldsp lds0) {
    constexpr int N_MOD = 96, N_WQ = 2 * 16 * 8, N_WIN = 16 * 17, N_WOUT = 16 * 4, N_POOL = 4 * 4;
    constexpr int N_TR = N_WQ + N_WIN + N_WOUT + N_POOL, N_TAB = 4 * 128, N_KEYS = 16;
    constexpr int TOTAL = N_MOD + N_TR + N_TAB + N_KEYS;
    for (int item = blockIdx.x; item < TOTAL; item += gridDim.x) {
        LAS float* lds = (LAS float*)launder(lds0);
        int r = item;
        if (r < N_MOD) { p0_mod_item(P, r / 48, r % 48, lds); continue; }
        r -= N_MOD;
        if (r < N_WQ) { const int i = r / 128, t = r % 128;
            p0_transpose_item(P.peer_wq + (size_t)i * 1024 * 2048, 1024, 2048, (bf16_t*)(P.ws + OFF_WQT) + (size_t)i * 2048 * 1024, t / 8, t % 8, lds); continue; }
        r -= N_WQ;
        if (r < N_WIN) { p0_transpose_item(P.dn_w_in, 1024, 4128, (bf16_t*)(P.ws + OFF_WINT), r / 17, r % 17, lds); continue; }
        r -= N_WIN;
        if (r < N_WOUT) { p0_transpose_item(P.dn_w_out, 1024, 1024, (bf16_t*)(P.ws + OFF_WOUTT), r / 4, r % 4, lds); continue; }
        r -= N_WOUT;
        if (r < N_POOL) { const int g = r / 4, t = r % 4;
            p0_transpose_item(P.pool_w + (size_t)g * 65536, 256, 256, (bf16_t*)(P.ws + OFF_POOLT) + (size_t)g * 65536, t, 0, lds); continue; }
        r -= N_POOL;
        if (r < N_TAB) { const int tb = r / 128, ch = r % 128;
            const float* src = ((tb & 1) ? P.peer_v : P.peer_u) + (size_t)(tb >> 1) * TAB_ELEMS;
            p0_table_item(src, P.ws + OFF_TAB + (size_t)tb * 16 * MiB, (float*)(P.ws + OFF_RSC) + tb * 16384, ch * 128, (tb & 1) == 0); continue; }
        r -= N_TAB;
        p0_convert_item(P.peer_keys, (bf16_t*)(P.ws + OFF_KEYS), (size_t)r * 32768);
    }
}

template <int SRC>
DEV void phase_modulate(const Params& P, int layer, int which, int nrows, bool q8 = false) {
    const float* gain = (which ? P.norm2_g : P.norm1_g) + layer * 1024;
    const float* modv = (const float*)(P.ws + OFF_MODV) + (size_t)layer * 9 * 6144;
    bf16_t* A = (bf16_t*)(P.ws + OFF_A);
    const int tid = tid_fresh(); const int wave = tid >> 6, lane = tid & 63;
    for (int r = blockIdx.x * 8 + wave; r < nrows; r += gridDim.x * 8) {
        const int m = r < NX ? (r >> 11) : 8;
        const float* sh = modv + m * 6144 + which * 3072;
        const float* sc = sh + 1024;
        f32x4 v[4]; float ss = 0.f;
#pragma unroll
        for (int j = 0; j < 4; ++j) {
            if (SRC == 0) { const float* src = r < NX ? P.x + (size_t)r * 1024 : P.ctx + (size_t)(r - NX) * 1024; v[j] = *(const f32x4*)(src + j * 256 + lane * 4); }
            else { const u32x2 hv = *(const u32x2*)(hrow(P, r) + j * 256 + lane * 4); v[j] = (f32x4){bflo(hv.x), bfhi(hv.x), bflo(hv.y), bfhi(hv.y)}; }
            ss += v[j].x * v[j].x + v[j].y * v[j].y + v[j].z * v[j].z + v[j].w * v[j].w;
        }
        ss = wave_sum(ss);
        const float rstd = rsqrtf(ss * (1.f / 1024.f) + EPS);
#pragma unroll
        for (int j = 0; j < 4; ++j) {
            const int col = j * 256 + lane * 4;
            const f32x4 g = *(const f32x4*)(gain + col), s1 = *(const f32x4*)(sc + col), s0 = *(const f32x4*)(sh + col);
            const f32x4 y = v[j] * rstd * g * (1.f + s1) + s0;
            u32x2 o; o.x = pk2(y.x, y.y); o.y = pk2(y.z, y.w);
            *(u32x2*)(A + (size_t)r * 1024 + col) = o;
            v[j] = y;
        }
        if (q8) {
            float am = 0.f;
#pragma unroll
            for (int j = 0; j < 4; ++j) am = fmaxf(am, fmaxf(fmaxf(fabsf(v[j].x), fabsf(v[j].y)), fmaxf(fabsf(v[j].z), fabsf(v[j].w))));
            am = wave_max(am);
            const float sc = am > 0.f ? 127.f / am : 0.f;
            unsigned char* a8 = P.ws + OFF_A8 + (size_t)r * 1024;
#pragma unroll
            for (int j = 0; j < 4; ++j) {
                const int b0 = (int)rintf(v[j].x * sc), b1 = (int)rintf(v[j].y * sc), b2 = (int)rintf(v[j].z * sc), b3 = (int)rintf(v[j].w * sc);
                const unsigned mine = (unsigned)((b0 & 255) | ((b1 & 255) << 8) | ((b2 & 255) << 16) | ((b3 & 255) << 24));
                const unsigned other = (unsigned)__shfl_xor((int)mine, 1);
                const unsigned lo4 = (lane & 1) ? other : mine, hi4 = (lane & 1) ? mine : other;
                const unsigned outw = (lane & 1) ? __builtin_amdgcn_perm(hi4, lo4, 0x07050301u) : __builtin_amdgcn_perm(hi4, lo4, 0x06040200u);
                *(unsigned*)(a8 + j * 256 + lane * 4) = outw;
            }
            if (lane == 0) ((float*)(P.ws + OFF_XS))[r] = am * (1.f / 127.f);
        }
    }
}

DEV void unpack8(const u32x4 v, float* f) {
    f[0] = bflo(v.x); f[1] = bfhi(v.x); f[2] = bflo(v.y); f[3] = bfhi(v.y); f[4] = bflo(v.z); f[5] = bfhi(v.z); f[6] = bflo(v.w); f[7] = bfhi(v.w);
}
template <int W>
DEV void pool_vertical(const bf16_t* A0, LAS float* V, int b, int r, int cbase, int tq, int ch8, float (&cen)[4][8]) {
    const int rlo = max(0, r - W / 2), rhi = min(32, r - W / 2 + W);
    const float inv = 1.f / (float)(rhi - rlo);
#pragma unroll
    for (int jh = 0; jh < 2; ++jh) {
        u32x4 ld[2][W];
#pragma unroll
        for (int jj = 0; jj < 2; ++jj)
#pragma unroll
            for (int k = 0; k < W; ++k) {
                const int rr = min(rlo + k, 31), tok = tq + 16 * (2 * jh + jj);
                ld[jj][k] = *(const u32x4*)(A0 + ((size_t)b * 2048 + rr * 64 + tok) * 1024 + cbase);
            }
#pragma unroll
        for (int jj = 0; jj < 2; ++jj) {
            const int j = 2 * jh + jj, tok = tq + 16 * j;
            float acc[8];
#pragma unroll
            for (int e = 0; e < 8; ++e) acc[e] = 0.f;
#pragma unroll
            for (int k = 0; k < W; ++k) {
                float f[8]; unpack8(ld[jj][k], f);
                const bool in = rlo + k < rhi;
#pragma unroll
                for (int e = 0; e < 8; ++e) acc[e] += in ? f[e] : 0.f;
                if (rlo + k == r) {
#pragma unroll
                    for (int e = 0; e < 8; ++e) cen[j][e] = f[e];
                }
            }
            LAS float* vp = V + (tok + 8) * 260 + ch8 * 8;
            *(LAS f32x4*)vp = (f32x4){acc[0] * inv, acc[1] * inv, acc[2] * inv, acc[3] * inv};
            *(LAS f32x4*)(vp + 4) = (f32x4){acc[4] * inv, acc[5] * inv, acc[6] * inv, acc[7] * inv};
        }
    }
}
template <int W>
DEV void pool_horizontal(const LAS float* V, ldsp At, bool isx, int seg, int tq, int ch8, const float (&cen)[4][8]) {
#pragma unroll
    for (int j = 0; j < 4; ++j) {
        const int tok = tq + 16 * j;
        const int pos = isx ? tok : 64 * seg + tok, lim = isx ? 64 : 256, off = isx ? 8 : 8 - 64 * seg;
        const int lo = max(0, pos - W / 2), hi = min(lim, pos - W / 2 + W);
        f32x4 s0 = {0.f, 0.f, 0.f, 0.f}, s1 = {0.f, 0.f, 0.f, 0.f};
#pragma unroll
        for (int k = 0; k < W; ++k) {
            const int t = min(lo + k, lim - 1);
            const LAS float* vp = V + (t + off) * 260 + ch8 * 8;
            const f32x4 a = *(const LAS f32x4*)vp, b2 = *(const LAS f32x4*)(vp + 4);
            const float m = (lo + k < hi) ? 1.f : 0.f;
            s0 += a * m; s1 += b2 * m;
        }
        const float inv = 1.f / (float)(hi - lo);
        u32x4 o;
        o.x = pk2(s0.x * inv - cen[j][0], s0.y * inv - cen[j][1]);
        o.y = pk2(s0.z * inv - cen[j][2], s0.w * inv - cen[j][3]);
        o.z = pk2(s1.x * inv - cen[j][4], s1.y * inv - cen[j][5]);
        o.w = pk2(s1.z * inv - cen[j][6], s1.w * inv - cen[j][7]);
        *(LAS u32x4*)(At + tok * 512 + ((ch8 ^ (tok & 7)) << 4)) = o;
    }
}
DEV void phase_pool(const Params& P, ldsp lds0) {
    const bf16_t* A0 = (const bf16_t*)(P.ws + OFF_A);
    const float* modv = (const float*)(P.ws + OFF_MODV);
    const bf16_t* Wt = (const bf16_t*)(P.ws + OFF_POOLT);
    const int tid = tid_fresh(), lane = tid & 63, wave = tid >> 6;
    const int ch8 = tid & 31, tq = tid >> 5;
    for (int item = blockIdx.x; item < 1152; item += gridDim.x) {
        const ldsp lds = launder(lds0);
        LAS float* V = (LAS float*)lds;
        const ldsp At = lds + 80 * 260 * 4;
        const bool isx = item < 1024;
        int b, r = 0, seg = 0, g;
        if (isx) { b = item >> 7; r = (item >> 2) & 31; }
        else { const int it = item - 1024; b = it >> 4; seg = (it >> 2) & 3; }
        g = ((item & 3) + (item >> 8)) & 3;
        const int cbase = g * 256 + ch8 * 8;
        float cen[4][8];
        if (isx) {
            if (g == 0) pool_vertical<2>(A0, V, b, r, cbase, tq, ch8, cen);
            else if (g == 1) pool_vertical<4>(A0, V, b, r, cbase, tq, ch8, cen);
            else if (g == 2) pool_vertical<8>(A0, V, b, r, cbase, tq, ch8, cen);
            else pool_vertical<16>(A0, V, b, r, cbase, tq, ch8, cen);
        } else {
            for (int q = tq; q < 80; q += 16) {
                const int t = 64 * seg - 8 + q;
                if (t >= 0 && t < 256) {
                    const u32x4 pv = *(const u32x4*)(A0 + ((size_t)NX + b * 256 + t) * 1024 + cbase);
                    float f[8]; unpack8(pv, f);
                    LAS float* vp = V + q * 260 + ch8 * 8;
                    *(LAS f32x4*)vp = (f32x4){f[0], f[1], f[2], f[3]};
                    *(LAS f32x4*)(vp + 4) = (f32x4){f[4], f[5], f[6], f[7]};
                }
            }
#pragma unroll
            for (int j = 0; j < 4; ++j) {
                const int tok = tq + 16 * j;
                const u32x4 pv = *(const u32x4*)(A0 + ((size_t)NX + b * 256 + 64 * seg + tok) * 1024 + cbase);
                unpack8(pv, cen[j]);
            }
        }
        __syncthreads();
        if (g == 0) pool_horizontal<2>(V, At, isx, seg, tq, ch8, cen);
        else if (g == 1) pool_horizontal<4>(V, At, isx, seg, tq, ch8, cen);
        else if (g == 2) pool_horizontal<8>(V, At, isx, seg, tq, ch8, cen);
        else pool_horizontal<16>(V, At, isx, seg, tq, ch8, cen);
        __syncthreads();
        f32x16 acc[2]; acc[0] = zero16(); acc[1] = zero16();
        const bf16_t* Wg = Wt + (size_t)g * 65536 + (size_t)(32 * wave + (lane & 31)) * 256 + (lane >> 5) * 8;
#pragma unroll 4
        for (int ks = 0; ks < 16; ++ks) {
            const bf16x8 wfr = *(const bf16x8*)(Wg + ks * 16);
            const int ch = ks * 2 + (lane >> 5);
#pragma unroll
            for (int mt = 0; mt < 2; ++mt) {
                const int row = mt * 32 + (lane & 31);
                const bf16x8 a = *(const LAS bf16x8*)(At + row * 512 + ((ch ^ (row & 7)) << 4));
                acc[mt] = mfma32(wfr, a, acc[mt]);
            }
        }
        const int m = isx ? b : 8;
#pragma unroll
        for (int mt = 0; mt < 2; ++mt)
#pragma unroll
            for (int rg = 0; rg < 4; ++rg) {
                const int tok = mt * 32 + (lane & 31), col = g * 256 + 32 * wave + 8 * rg + 4 * (lane >> 5);
                const f32x4 gs = *(const f32x4*)(modv + m * 6144 + 2048 + col) * *(const f32x4*)(P.pool_scale + col);
                const f32x4 av = {acc[mt][rg * 4 + 0], acc[mt][rg * 4 + 1], acc[mt][rg * 4 + 2], acc[mt][rg * 4 + 3]};
                f32x4 hv; int grow;
                if (isx) { grow = b * 2048 + r * 64 + tok; hv = __builtin_nontemporal_load((const f32x4*)(P.x + (size_t)grow * 1024 + col)) + gs * av; }
                else { const size_t gi = ((size_t)b * 256 + 64 * seg + tok) * 1024 + col; grow = NX + b * 256 + 64 * seg + tok; hv = *(const f32x4*)(P.ctx + gi) + gs * av; }
                u32x2 hp; hp.x = pk2(hv.x, hv.y); hp.y = pk2(hv.z, hv.w);
                *(u32x2*)(hrow(P, grow) + col) = hp;
            }
        __syncthreads();
    }
}

DEV bf16x8 frag_row_x(ldsp x, int r0, int k0, int lane) {
    const int row = r0 + (lane & 31), ch = (k0 >> 3) + (lane >> 5);
    return *(const LAS bf16x8*)(x + row * 256 + ((ch ^ (row & 15)) << 4));
}
DEV unsigned key_of(float f) { const unsigned u = __float_as_uint(f); return u ^ ((unsigned)((int)u >> 31) | 0x80000000u); }
DEV float val_of(unsigned k) { const unsigned u = (k & 0x80000000u) ? (k ^ 0x80000000u) : ~k; return __uint_as_float(u); }
DEV void cmpx(unsigned& hi, unsigned& lo) { const unsigned a = hi, b = lo; hi = a > b ? a : b; lo = a > b ? b : a; }
DEV void sort16_desc(unsigned* v) {
#pragma unroll
    for (int k = 2; k <= 16; k <<= 1)
#pragma unroll
        for (int j = k >> 1; j > 0; j >>= 1)
#pragma unroll
            for (int i = 0; i < 16; ++i) {
                const int l = i ^ j;
                if (l > i) { if ((i & k) == 0) cmpx(v[i], v[l]); else cmpx(v[l], v[i]); }
            }
}
DEV void merge16(unsigned* r, const unsigned* b) {
#pragma unroll
    for (int k = 0; k < 16; ++k) r[k] = r[k] > b[15 - k] ? r[k] : b[15 - k];
#pragma unroll
    for (int j = 8; j > 0; j >>= 1)
#pragma unroll
        for (int i = 0; i < 16; ++i) { const int l = i ^ j; if (l > i) cmpx(r[i], r[l]); }
}
DEV void top16_of_64(unsigned* v, unsigned* r) {
#pragma unroll
    for (int blk = 0; blk < 4; ++blk) sort16_desc(v + 16 * blk);
#pragma unroll
    for (int k = 0; k < 16; ++k) r[k] = v[k];
    merge16(r, v + 16); merge16(r, v + 32); merge16(r, v + 48);
}
DEV void phase_topk(const Params& P, int layer, int nrows, ldsp lds0) {
    const bf16_t* Q = (const bf16_t*)(P.ws + OFF_R1);
    const bf16_t* keys = (const bf16_t*)(P.ws + OFF_KEYS) + (size_t)layer * 8 * 2 * 128 * 128;
    bf16_t* seli = (bf16_t*)(P.ws + OFF_SELI);
    float* selg = (float*)(P.ws + OFF_SELG);
    const int tid = tid_fresh(), lane = tid & 63, wave = tid >> 6;
    const int nitems = (nrows / 256) * 4;
    const unsigned hoff = (unsigned)(lane >> 5) * 4u;
    const int G = gridDim.x, nfr = nitems / G, left = nitems - nfr * G;
    int per = 0;
    if (left) { per = (left * 8 + G - 1) / G; per = per <= 1 ? 1 : per <= 2 ? 2 : per <= 4 ? 4 : 8; }
    const int nloop = nfr + ((left && (int)blockIdx.x * per < left * 8) ? 1 : 0);
    for (int it = 0; it < nloop; ++it) {
        const ldsp lds = launder(lds0);
        LAS unsigned* sl = (LAS unsigned*)(lds + 65536 + wave * 8192);
        int item, wtask; bool act;
        if (it < nfr) { item = it * G + blockIdx.x; wtask = wave; act = true; }
        else { const int j = blockIdx.x * per + wave; item = nfr * G + ((blockIdx.x * per) >> 3); wtask = j & 7; act = wave < per; }
        act = __builtin_amdgcn_readfirstlane((int)act) != 0;
        const int tg = item >> 2, hp = item & 3, row0 = tg * 256 + wtask * 32;
        u32x4 kr[4]; bf16x8 qf[8];
        {
            const bf16_t* kt = keys + (size_t)((hp * 2) * 2) * 128 * 128;
#pragma unroll
            for (int j = 0; j < 4; ++j) { const int cid = tid + NTHREADS * j, r = cid >> 4, ch = cid & 15; kr[j] = *(const u32x4*)(kt + r * 128 + ch * 8); }
#pragma unroll
            for (int j = 0; j < 4; ++j) { const int cid = tid + NTHREADS * j, r = cid >> 4, ch = cid & 15; *(LAS u32x4*)(lds + r * 256 + ((ch ^ (r & 15)) << 4)) = kr[j]; }
            const bf16_t* qb = Q + (size_t)(row0 + (lane & 31)) * 2048 + (hp * 2) * 256 + (lane >> 5) * 8;
#pragma unroll
            for (int ks = 0; ks < 8; ++ks) qf[ks] = *(const bf16x8*)(qb + ks * 16);
        }
        __syncthreads();
        unsigned s1[16], s2[16];
#pragma unroll
        for (int k = 0; k < 16; ++k) { s1[k] = 0u; s2[k] = 0u; }
#pragma unroll 1
        for (int step = 0; step < 4; ++step) {
            const int hs = step >> 1, p = step & 1;
            const bool mine = (lane >> 5) == hs;
            const ldsp kb = lds + (step & 1) * 32768;
            if (step < 3) {
                const bf16_t* kt = keys + (size_t)((hp * 2 + ((step + 1) >> 1)) * 2 + ((step + 1) & 1)) * 128 * 128;
#pragma unroll
                for (int j = 0; j < 4; ++j) { const int cid = tid + NTHREADS * j, r = cid >> 4, ch = cid & 15; kr[j] = *(const u32x4*)(kt + r * 128 + ch * 8); }
            }
            f32x16 acc[4];
#pragma unroll
            for (int mt = 0; mt < 4; ++mt) acc[mt] = zero16();
            if (act) {
#pragma unroll
            for (int ks = 0; ks < 8; ++ks)
#pragma unroll
                for (int mt = 0; mt < 4; ++mt) acc[mt] = mfma32(frag_row_x(kb, mt * 32, ks * 16, lane), qf[ks], acc[mt]);
            }
            if (step < 3) {
                const ldsp kn = lds + ((step + 1) & 1) * 32768;
#pragma unroll
                for (int j = 0; j < 4; ++j) { const int cid = tid + NTHREADS * j, r = cid >> 4, ch = cid & 15; *(LAS u32x4*)(kn + r * 256 + ((ch ^ (r & 15)) << 4)) = kr[j]; }
                const bf16_t* qb = Q + (size_t)(row0 + (lane & 31)) * 2048 + (hp * 2 + ((step + 1) >> 1)) * 256 + ((step + 1) & 1) * 128 + (lane >> 5) * 8;
#pragma unroll
                for (int ks = 0; ks < 8; ++ks) qf[ks] = *(const bf16x8*)(qb + ks * 16);
            }
            if (act) {
            unsigned v[64];
#pragma unroll
            for (int mt = 0; mt < 4; ++mt)
#pragma unroll
                for (int reg = 0; reg < 16; ++reg) {
                    const unsigned c = mt * 32 + (reg & 3) + 8 * (reg >> 2);
                    v[mt * 16 + reg] = ((key_of(acc[mt][reg]) & ~127u) | (127u - c)) ^ hoff;
                }
            unsigned r[16], o[16];
            top16_of_64(v, r);
#pragma unroll
            for (int k = 0; k < 16; ++k) o[k] = (unsigned)__shfl_xor((int)r[k], 32);
            merge16(r, o);
#pragma unroll
            for (int k = 0; k < 16; ++k) { if (p == 0) s1[k] = mine ? r[k] : s1[k]; else s2[k] = mine ? r[k] : s2[k]; }
            }
            __syncthreads();
        }
        if (!act) continue;
        float f1[16], f2[16];
#pragma unroll
        for (int k = 0; k < 16; ++k) {
            sl[k * 64 + lane] = s1[k]; sl[(16 + k) * 64 + lane] = s2[k];
            f1[k] = val_of(s1[k] & ~127u); f2[k] = val_of(s2[k] & ~127u);
        }
        unsigned cv[64];
        {
            int n = 0;
#pragma unroll
            for (int a = 0; a < 16; ++a)
#pragma unroll
                for (int b = 0; b < 16; ++b)
                    if ((a + 1) * (b + 1) <= 16) { cv[n] = (key_of(f1[a] + f2[b]) & ~255u) | (255u - (unsigned)(a * 16 + b)); ++n; }
#pragma unroll
            for (int q = 50; q < 64; ++q) cv[q] = 0u;
        }
        unsigned w[16];
        top16_of_64(cv, w);
        float sc[16]; int ei[16];
#pragma unroll
        for (int k = 0; k < 16; ++k) {
            const unsigned ab = 255u - (w[k] & 255u);
            const unsigned k1 = sl[(ab >> 4) * 64 + lane], k2 = sl[(16 + (ab & 15u)) * 64 + lane];
            ei[k] = (int)((127u - (k1 & 127u)) * 128u + (127u - (k2 & 127u)));
            sc[k] = val_of(w[k] & ~255u);
        }
        const float mx = sc[0];
        float tot = 0.f;
#pragma unroll
        for (int k = 0; k < 16; ++k) { sc[k] = expf(sc[k] - mx); tot += sc[k]; }
        const int row = row0 + (lane & 31), head = hp * 2 + (lane >> 5);
        bf16_t* ip = seli + (size_t)row * 128 + head * 16;
        float* gp = selg + (size_t)row * 128 + head * 16;
        const float inv = 1.f / tot;
#pragma unroll
        for (int q = 0; q < 2; ++q) {
            u32x4 o;
#pragma unroll
            for (int d = 0; d < 4; ++d) o[d] = (unsigned)ei[8 * q + 2 * d] | ((unsigned)ei[8 * q + 2 * d + 1] << 16);
            *(u32x4*)(ip + 8 * q) = o;
        }
#pragma unroll
        for (int q = 0; q < 4; ++q) *(float4*)(gp + 4 * q) = make_float4(sc[4 * q] * inv, sc[4 * q + 1] * inv, sc[4 * q + 2] * inv, sc[4 * q + 3] * inv);
    }
}

struct XGeo { int nloc, rank, nact, pos; };
typedef float f32x2 __attribute__((ext_vector_type(2)));
DEV void fp8x16_to_f32(const u32x4 r, float* f) {
#pragma unroll
    for (int d = 0; d < 4; ++d) {
        const f32x2 lo = __builtin_amdgcn_cvt_pk_f32_fp8((int)r[d], false), hi = __builtin_amdgcn_cvt_pk_f32_fp8((int)r[d], true);
        f[4 * d + 0] = lo.x; f[4 * d + 1] = lo.y; f[4 * d + 2] = hi.x; f[4 * d + 3] = hi.y;
    }
}
template <int S, int MUL, class T>
DEV void bfly_stage(T* p, int lane) {
    const bool hi = (lane & (S * MUL)) != 0;
#pragma unroll
    for (int i = 0; i < 2 * S; ++i) { const T keep = hi ? p[i + 2 * S] : p[i], send = hi ? p[i] : p[i + 2 * S]; p[i] = keep + __shfl_xor(send, S * MUL); }
}
template <int STAGE>
DEV void ex_issue(u32x4 (&buf)[16], u32x4 (&aux)[4], f32x2 (&hg)[2], const u32x4 (&idn)[2], const unsigned char* slice, const Params& P, const bf16_t* A, const bf16_t* wexp,
                  const float* gatev, int t, int sl, int g, int c) {
    int id[16];
#pragma unroll
    for (int q = 0; q < 2; ++q)
#pragma unroll
        for (int d = 0; d < 4; ++d) { id[8 * q + 2 * d] = (int)(idn[q][d] & 0xffffu); id[8 * q + 2 * d + 1] = (int)(idn[q][d] >> 16); }
#pragma unroll
    for (int k = 0; k < 16; ++k) buf[k] = *(const u32x4*)(slice + (size_t)id[k] * 128);
    if (STAGE == 1) {
        aux[0] = *(const u32x4*)(P.ws + OFF_A8 + (size_t)t * 1024 + 256 * sl + 32 * c); aux[1] = *(const u32x4*)(P.ws + OFF_A8 + (size_t)t * 1024 + 256 * sl + 32 * c + 16);
        hg[0].x = ((const float*)(P.ws + OFF_XS))[t];
    } else {
#pragma unroll
        for (int q = 0; q < 2; ++q) aux[q] = *(const u32x4*)(wexp + (size_t)t * 128 + 16 * g + 8 * q);
        const int col = 256 * sl + 32 * c + 4 * g, m = t < NX ? (t >> 11) : 8;
        const u32x2 hv = *(const u32x2*)(hrow(P, t) + col);
        aux[2] = (u32x4){hv.x, hv.y, 0u, 0u};
        aux[3] = *(const u32x4*)(gatev + m * 6144 + col);
    }
}
template <int STAGE>
DEV void ex_compute(const u32x4 (&buf)[16], const u32x4 (&aux)[4], const f32x2 (&hg)[2], const Params& P, float* part, int t, int sl, int lane, int g, int c) {
    if (STAGE == 1) {
        int sx = 0;
#pragma unroll
        for (int q = 0; q < 2; ++q)
#pragma unroll
            for (int d = 0; d < 4; ++d) sx = __builtin_amdgcn_sdot4(0x01010101, (int)aux[q][d], sx, false);
        int p[16];
#pragma unroll
        for (int k = 0; k < 16; ++k) {
            int a = -8 * sx;
#pragma unroll
            for (int d = 0; d < 4; ++d) {
                const unsigned w = buf[k][d];
                a = __builtin_amdgcn_sdot4((int)(w & 0x0F0F0F0Fu), (int)aux[d >> 1][2 * (d & 1)], a, false);
                a = __builtin_amdgcn_sdot4((int)((w >> 4) & 0x0F0F0F0Fu), (int)aux[d >> 1][2 * (d & 1) + 1], a, false);
            }
            p[k] = a;
        }
        bfly_stage<4, 1>(p, lane); bfly_stage<2, 1>(p, lane); bfly_stage<1, 1>(p, lane);
        const float xs = hg[0].x;
        *(unsigned*)((bf16_t*)part + ((size_t)sl * NT + t) * 128 + 2 * lane) = pk2((float)p[0] * xs, (float)p[1] * xs);
    } else {
        f32x2 p2[16];
#pragma unroll
        for (int i = 0; i < 16; ++i) p2[i] = (f32x2){0.f, 0.f};
#pragma unroll
        for (int k = 0; k < 16; ++k) {
            const unsigned wpk = aux[k >> 3][(k >> 1) & 3];
            const float wkf = (k & 1) ? bfhi(wpk) : bflo(wpk);
            const f32x2 w2 = {wkf, wkf};
#pragma unroll
            for (int d = 0; d < 4; ++d) {
                p2[4 * d + 0] += w2 * __builtin_amdgcn_cvt_scalef32_pk_f32_fp4(buf[k][d], 1.0f, 0);
                p2[4 * d + 1] += w2 * __builtin_amdgcn_cvt_scalef32_pk_f32_fp4(buf[k][d], 1.0f, 1);
                p2[4 * d + 2] += w2 * __builtin_amdgcn_cvt_scalef32_pk_f32_fp4(buf[k][d], 1.0f, 2);
                p2[4 * d + 3] += w2 * __builtin_amdgcn_cvt_scalef32_pk_f32_fp4(buf[k][d], 1.0f, 3);
            }
            asm volatile("" : "+v"(p2[0]), "+v"(p2[1]), "+v"(p2[2]), "+v"(p2[3]), "+v"(p2[4]), "+v"(p2[5]), "+v"(p2[6]), "+v"(p2[7]),
                              "+v"(p2[8]), "+v"(p2[9]), "+v"(p2[10]), "+v"(p2[11]), "+v"(p2[12]), "+v"(p2[13]), "+v"(p2[14]), "+v"(p2[15]));
        }
        float p[32];
#pragma unroll
        for (int i = 0; i < 16; ++i) { p[2 * i] = p2[i].x; p[2 * i + 1] = p2[i].y; }
        bfly_stage<8, 4>(p, lane); bfly_stage<4, 4>(p, lane); bfly_stage<2, 4>(p, lane);
        const int col = 256 * sl + 32 * c + 4 * g;
        const unsigned h0 = aux[2].x, h1 = aux[2].y;
        u32x2 ho;
        ho.x = pk2(bflo(h0) + __uint_as_float(aux[3].x) * p[0], bfhi(h0) + __uint_as_float(aux[3].y) * p[1]);
        ho.y = pk2(bflo(h1) + __uint_as_float(aux[3].z) * p[2], bfhi(h1) + __uint_as_float(aux[3].w) * p[3]);
        *(u32x2*)(hrow(P, t) + col) = ho;
    }
}
template <int STAGE>
DEV void phase_experts_sliced(const Params& P, int layer, int nrows, const XGeo geo) {
    const unsigned char* tab = P.ws + OFF_TAB + (size_t)(layer * 2 + (STAGE - 1)) * 16 * MiB;
    const bf16_t* A = (const bf16_t*)(P.ws + OFF_A);
    const bf16_t* seli = (const bf16_t*)(P.ws + OFF_SELI);
    float* part = (float*)(P.ws + OFF_PART);
    const bf16_t* wexp = (const bf16_t*)(P.ws + OFF_WEXP);
    const float* gatev = (const float*)(P.ws + OFF_MODV) + (size_t)layer * 9 * 6144 + 5 * 1024;
    const int tid = tid_fresh(), wave = tid >> 6, lane = tid & 63, g = lane >> 3, c = lane & 7;
    const int nw = geo.nloc * 8, wr = geo.rank * 8 + wave;
    for (int vs = geo.pos; vs < 8; vs += geo.nact) {
        const int sl = vs >> 1, tmul = 2, tadd = vs & 1;
        const unsigned char* slice = tab + (size_t)sl * 2 * MiB + 16 * c;
        const int nws = nw * tmul;
        int t = wr * tmul + tadd;
        if (t >= nrows) continue;
        u32x4 bufA[16], bufB[16], auxA[4], auxB[4]; f32x2 hgA[2], hgB[2]; u32x4 idn[2];
#pragma unroll
        for (int q = 0; q < 2; ++q) idn[q] = *(const u32x4*)(seli + (size_t)t * 128 + 16 * g + 8 * q);
        ex_issue<STAGE>(bufA, auxA, hgA, idn, slice, P, A, wexp, gatev, t, sl, g, c);
        if (t + nws < nrows) {
#pragma unroll
            for (int q = 0; q < 2; ++q) idn[q] = *(const u32x4*)(seli + (size_t)(t + nws) * 128 + 16 * g + 8 * q);
        }
        for (;;) {
            {
                const int t1 = t + nws;
                if (t1 < nrows) {
                    ex_issue<STAGE>(bufB, auxB, hgB, idn, slice, P, A, wexp, gatev, t1, sl, g, c);
                    if (t1 + nws < nrows) {
#pragma unroll
                        for (int q = 0; q < 2; ++q) idn[q] = *(const u32x4*)(seli + (size_t)(t1 + nws) * 128 + 16 * g + 8 * q);
                    }
                }
                ex_compute<STAGE>(bufA, auxA, hgA, P, part, t, sl, lane, g, c);
            }
            t += nws; if (t >= nrows) break;
            {
                const int t1 = t + nws;
                if (t1 < nrows) {
                    ex_issue<STAGE>(bufA, auxA, hgA, idn, slice, P, A, wexp, gatev, t1, sl, g, c);
                    if (t1 + nws < nrows) {
#pragma unroll
                        for (int q = 0; q < 2; ++q) idn[q] = *(const u32x4*)(seli + (size_t)(t1 + nws) * 128 + 16 * g + 8 * q);
                    }
                }
                ex_compute<STAGE>(bufB, auxB, hgB, P, part, t, sl, lane, g, c);
            }
            t += nws; if (t >= nrows) break;
        }
    }
}
DEV void eu_issue_unit(u32x4 (&buf)[16], u32x4 (&xq)[2], const u32x4 (&idn)[2], const unsigned char* tab, const Params& P, int t, int sl, int c) {
    int id[16];
#pragma unroll
    for (int q = 0; q < 2; ++q)
#pragma unroll
        for (int d = 0; d < 4; ++d) { id[8 * q + 2 * d] = (int)(idn[q][d] & 0xffffu); id[8 * q + 2 * d + 1] = (int)(idn[q][d] >> 16); }
    const unsigned char* slice = tab + (size_t)sl * 2 * MiB + 16 * c;
#pragma unroll
    for (int k = 0; k < 16; ++k) buf[k] = *(const u32x4*)(slice + (size_t)id[k] * 128);
    xq[0] = *(const u32x4*)(P.ws + OFF_A8 + (size_t)t * 1024 + 256 * sl + 32 * c); xq[1] = *(const u32x4*)(P.ws + OFF_A8 + (size_t)t * 1024 + 256 * sl + 32 * c + 16);
}
DEV void eu_compute_unit(const u32x4 (&buf)[16], const u32x4 (&xq)[2], LAS float* acc2, int lane) {
    int sx = 0;
#pragma unroll
    for (int q = 0; q < 2; ++q)
#pragma unroll
        for (int d = 0; d < 4; ++d) sx = __builtin_amdgcn_sdot4(0x01010101, (int)xq[q][d], sx, false);
    int p[16];
#pragma unroll
    for (int k = 0; k < 16; ++k) {
        int a = -8 * sx;
#pragma unroll
        for (int d = 0; d < 4; ++d) {
            const unsigned w = buf[k][d];
            a = __builtin_amdgcn_sdot4((int)(w & 0x0F0F0F0Fu), (int)xq[d >> 1][2 * (d & 1)], a, false);
            a = __builtin_amdgcn_sdot4((int)((w >> 4) & 0x0F0F0F0Fu), (int)xq[d >> 1][2 * (d & 1) + 1], a, false);
        }
        p[k] = a;
    }
    bfly_stage<4, 1>(p, lane); bfly_stage<2, 1>(p, lane); bfly_stage<1, 1>(p, lane);
    f32x2 a2 = *(const LAS f32x2*)acc2;
    a2.x += (float)p[0]; a2.y += (float)p[1];
    *(LAS f32x2*)acc2 = a2;
}
DEV void phase_experts_u(const Params& P, int layer, int nrows, ldsp lds0) {
    const unsigned char* tab = P.ws + OFF_TAB + (size_t)(layer * 2) * 16 * MiB;
    const bf16_t* seli = (const bf16_t*)(P.ws + OFF_SELI);
    const float* selg = (const float*)(P.ws + OFF_SELG);
    bf16_t* wexp = (bf16_t*)(P.ws + OFF_WEXP);
    const float* rsu = (const float*)(P.ws + OFF_RSC) + (size_t)(layer * 2) * 16384;
    const float* rsv = rsu + 16384;
    const float* xsv = (const float*)(P.ws + OFF_XS);
    const int tid = tid_fresh(), wave = __builtin_amdgcn_readfirstlane(tid >> 6), lane = tid & 63, g = lane >> 3, c = lane & 7;
    const int gw = blockIdx.x * 8 + wave, nwv = gridDim.x * 8;
    if (gw >= nrows) return;
    const int ntok = (nrows - gw + nwv - 1) / nwv, U = 4 * ntok;
    LAS float* accs = (LAS float*)(launder(lds0) + wave * 8192);
    for (int k = 0; k < ntok; ++k) *(LAS f32x2*)(accs + k * 128 + 2 * lane) = (f32x2){0.f, 0.f};
    u32x4 bufA[16], bufB[16], xqA[2], xqB[2], idn[2];
    int ku = 0, slu = 0;
#define EU_NEXT_IDX() do { const int tt = gw + ku * nwv; _Pragma("unroll") for (int q = 0; q < 2; ++q) idn[q] = *(const u32x4*)(seli + (size_t)tt * 128 + 16 * g + 8 * q); } while (0)
#define EU_ADVANCE() do { if (++ku == ntok) { ku = 0; ++slu; } } while (0)
    EU_NEXT_IDX();
    int kA = ku, slA = slu; eu_issue_unit(bufA, xqA, idn, tab, P, gw + kA * nwv, slA, c); EU_ADVANCE();
    if (U > 1) EU_NEXT_IDX();
    int kB = 0, slB = 0;
    for (int u = 0; u < U; u += 2) {
        if (u + 1 < U) { kB = ku; slB = slu; eu_issue_unit(bufB, xqB, idn, tab, P, gw + kB * nwv, slB, c); EU_ADVANCE(); if (u + 2 < U) EU_NEXT_IDX(); }
        eu_compute_unit(bufA, xqA, accs + kA * 128 + 2 * lane, lane);
        if (u + 1 >= U) break;
        if (u + 2 < U) { kA = ku; slA = slu; eu_issue_unit(bufA, xqA, idn, tab, P, gw + kA * nwv, slA, c); EU_ADVANCE(); if (u + 3 < U) EU_NEXT_IDX(); }
        eu_compute_unit(bufB, xqB, accs + kB * 128 + 2 * lane, lane);
    }
#undef EU_NEXT_IDX
#undef EU_ADVANCE
    for (int k = 0; k < ntok; ++k) {
        const int t = gw + k * nwv;
        const unsigned ep = *(const unsigned*)(seli + (size_t)t * 128 + 2 * lane);
        const f32x2 gt = *(const f32x2*)(selg + (size_t)t * 128 + 2 * lane);
        const f32x2 a2 = *(const LAS f32x2*)(accs + k * 128 + 2 * lane);
        const int e0 = (int)(ep & 0xffffu), e1 = (int)(ep >> 16);
        const float xs = xsv[t];
        const float h0 = a2.x * xs * rsu[e0], h1 = a2.y * xs * rsu[e1];
        const float w0 = gt.x * (0.5f * h0 * (1.f + erff(h0 * 0.70710678118654752f))) * rsv[e0];
        const float w1 = gt.y * (0.5f * h1 * (1.f + erff(h1 * 0.70710678118654752f))) * rsv[e1];
        *(unsigned*)(wexp + (size_t)t * 128 + 2 * lane) = pk2(w0, w1);
    }
}
DEV void ev_issue_unit(u32x4 (&buf)[16], u32x2& hv, u32x4& gt, const u32x4 (&idn)[2], const unsigned char* tab, const Params& P, const float* gatev, int t, int sl, int g, int c) {
    int id[16];
#pragma unroll
    for (int q = 0; q < 2; ++q)
#pragma unroll
        for (int d = 0; d < 4; ++d) { id[8 * q + 2 * d] = (int)(idn[q][d] & 0xffffu); id[8 * q + 2 * d + 1] = (int)(idn[q][d] >> 16); }
    const unsigned char* slice = tab + (size_t)sl * 2 * MiB + 16 * c;
#pragma unroll
    for (int k = 0; k < 16; ++k) buf[k] = *(const u32x4*)(slice + (size_t)id[k] * 128);
    const int col = 256 * sl + 32 * c + 4 * g, m = t < NX ? (t >> 11) : 8;
    hv = *(const u32x2*)(hrow(P, t) + col);
    gt = *(const u32x4*)(gatev + m * 6144 + col);
}
DEV void ev_compute_unit(const u32x4 (&buf)[16], const u32x2 hv, const u32x4 gt, const LAS float* wS, const Params& P, int t, int sl, int lane, int g, int c) {
    f32x2 p2[16];
#pragma unroll
    for (int i = 0; i < 16; ++i) p2[i] = (f32x2){0.f, 0.f};
    f32x4 wq[4];
#pragma unroll
    for (int q = 0; q < 4; ++q) wq[q] = *(const LAS f32x4*)(wS + 4 * q);
#pragma unroll
    for (int k = 0; k < 16; ++k) {
        const float wkf = wq[k >> 2][k & 3];
        const f32x2 w2 = {wkf, wkf};
#pragma unroll
        for (int d = 0; d < 4; ++d) {
            p2[4 * d + 0] += w2 * __builtin_amdgcn_cvt_scalef32_pk_f32_fp4(buf[k][d], 1.0f, 0);
            p2[4 * d + 1] += w2 * __builtin_amdgcn_cvt_scalef32_pk_f32_fp4(buf[k][d], 1.0f, 1);
            p2[4 * d + 2] += w2 * __builtin_amdgcn_cvt_scalef32_pk_f32_fp4(buf[k][d], 1.0f, 2);
            p2[4 * d + 3] += w2 * __builtin_amdgcn_cvt_scalef32_pk_f32_fp4(buf[k][d], 1.0f, 3);
        }
        asm volatile("" : "+v"(p2[0]), "+v"(p2[1]), "+v"(p2[2]), "+v"(p2[3]), "+v"(p2[4]), "+v"(p2[5]), "+v"(p2[6]), "+v"(p2[7]),
                          "+v"(p2[8]), "+v"(p2[9]), "+v"(p2[10]), "+v"(p2[11]), "+v"(p2[12]), "+v"(p2[13]), "+v"(p2[14]), "+v"(p2[15]));
    }
    float p[32];
#pragma unroll
    for (int i = 0; i < 16; ++i) { p[2 * i] = p2[i].x; p[2 * i + 1] = p2[i].y; }
    bfly_stage<8, 4>(p, lane); bfly_stage<4, 4>(p, lane); bfly_stage<2, 4>(p, lane);
    const int col = 256 * sl + 32 * c + 4 * g;
    u32x2 ho;
    ho.x = pk2(bflo(hv.x) + __uint_as_float(gt.x) * p[0], bfhi(hv.x) + __uint_as_float(gt.y) * p[1]);
    ho.y = pk2(bflo(hv.y) + __uint_as_float(gt.z) * p[2], bfhi(hv.y) + __uint_as_float(gt.w) * p[3]);
    *(u32x2*)(hrow(P, t) + col) = ho;
}
DEV void phase_experts(const Params& P, int layer, int nrows, ldsp lds0) {
    const unsigned char* tabu = P.ws + OFF_TAB + (size_t)(layer * 2) * 16 * MiB;
    const unsigned char* tabv = tabu + 16 * MiB;
    const bf16_t* seli = (const bf16_t*)(P.ws + OFF_SELI);
    const float* selg = (const float*)(P.ws + OFF_SELG);
    const float* rsu = (const float*)(P.ws + OFF_RSC) + (size_t)(layer * 2) * 16384;
    const float* rsv = rsu + 16384;
    const float* xsv = (const float*)(P.ws + OFF_XS);
    const float* gatev = (const float*)(P.ws + OFF_MODV) + (size_t)layer * 9 * 6144 + 5 * 1024;
    const int tid = tid_fresh(), wave = __builtin_amdgcn_readfirstlane(tid >> 6), lane = tid & 63, g = lane >> 3, c = lane & 7;
    const int gw = blockIdx.x * 8 + wave, nwv = gridDim.x * 8;
    if (gw >= nrows) return;
    const int ntok = (nrows - gw + nwv - 1) / nwv, U = 4 * ntok;
    LAS float* accs = (LAS float*)(launder(lds0) + wave * 8192);
    for (int k = 0; k < ntok; ++k) *(LAS f32x2*)(accs + k * 128 + 2 * lane) = (f32x2){0.f, 0.f};
    u32x4 bufA[16], bufB[16], idn[2];
    int ku = 0, slu = 0;
#define EU_NEXT_IDX() do { const int tt = gw + ku * nwv; _Pragma("unroll") for (int q = 0; q < 2; ++q) idn[q] = *(const u32x4*)(seli + (size_t)tt * 128 + 16 * g + 8 * q); } while (0)
#define EU_ADVANCE() do { if (++ku == ntok) { ku = 0; ++slu; } } while (0)
    int kA, slA, kB = 0, slB = 0;
    {
        u32x4 xqA[2], xqB[2];
        EU_NEXT_IDX();
        kA = ku; slA = slu; eu_issue_unit(bufA, xqA, idn, tabu, P, gw + kA * nwv, slA, c); EU_ADVANCE();
        if (U > 1) EU_NEXT_IDX();
        for (int u = 0; u < U; u += 2) {
            if (u + 1 < U) { kB = ku; slB = slu; eu_issue_unit(bufB, xqB, idn, tabu, P, gw + kB * nwv, slB, c); EU_ADVANCE(); if (u + 2 < U) EU_NEXT_IDX(); }
            eu_compute_unit(bufA, xqA, accs + kA * 128 + 2 * lane, lane);
            if (u + 1 >= U) break;
            if (u + 2 < U) { kA = ku; slA = slu; eu_issue_unit(bufA, xqA, idn, tabu, P, gw + kA * nwv, slA, c); EU_ADVANCE(); if (u + 3 < U) EU_NEXT_IDX(); }
            eu_compute_unit(bufB, xqB, accs + kB * 128 + 2 * lane, lane);
        }
    }
    u32x2 hvA, hvB; u32x4 gtA, gtB;
    ku = 0; slu = 0;
    EU_NEXT_IDX();
    kA = ku; slA = slu; ev_issue_unit(bufA, hvA, gtA, idn, tabv, P, gatev, gw + kA * nwv, slA, g, c); EU_ADVANCE();
    if (U > 1) EU_NEXT_IDX();
    for (int k = 0; k < ntok; ++k) {
        const int t = gw + k * nwv;
        const unsigned ep = *(const unsigned*)(seli + (size_t)t * 128 + 2 * lane);
        const f32x2 gt = *(const f32x2*)(selg + (size_t)t * 128 + 2 * lane);
        const f32x2 a2 = *(const LAS f32x2*)(accs + k * 128 + 2 * lane);
        const int e0 = (int)(ep & 0xffffu), e1 = (int)(ep >> 16);
        const float xs = xsv[t];
        const float h0 = a2.x * xs * rsu[e0], h1 = a2.y * xs * rsu[e1];
        f32x2 w;
        w.x = gt.x * (0.5f * h0 * (1.f + erff(h0 * 0.70710678118654752f))) * rsv[e0];
        w.y = gt.y * (0.5f * h1 * (1.f + erff(h1 * 0.70710678118654752f))) * rsv[e1];
        *(LAS f32x2*)(accs + k * 128 + 2 * lane) = w;
    }
    for (int u = 0; u < U; u += 2) {
        if (u + 1 < U) { kB = ku; slB = slu; ev_issue_unit(bufB, hvB, gtB, idn, tabv, P, gatev, gw + kB * nwv, slB, g, c); EU_ADVANCE(); if (u + 2 < U) EU_NEXT_IDX(); }
        ev_compute_unit(bufA, hvA, gtA, accs + kA * 128 + 16 * g, P, gw + kA * nwv, slA, lane, g, c);
        if (u + 1 >= U) break;
        if (u + 2 < U) { kA = ku; slA = slu; ev_issue_unit(bufA, hvA, gtA, idn, tabv, P, gatev, gw + kA * nwv, slA, g, c); EU_ADVANCE(); if (u + 3 < U) EU_NEXT_IDX(); }
        ev_compute_unit(bufB, hvB, gtB, accs + kB * 128 + 16 * g, P, gw + kB * nwv, slB, lane, g, c);
    }
#undef EU_NEXT_IDX
#undef EU_ADVANCE
}
DEV void phase_experts_act(const Params& P, int layer, int nrows) {
    const bf16_t* seli = (const bf16_t*)(P.ws + OFF_SELI);
    const float* selg = (const float*)(P.ws + OFF_SELG);
    const float* part = (const float*)(P.ws + OFF_PART);
    bf16_t* wexp = (bf16_t*)(P.ws + OFF_WEXP);
    const float* rsu = (const float*)(P.ws + OFF_RSC) + (size_t)(layer * 2) * 16384;
    const float* rsv = rsu + 16384;
    const int tid = tid_fresh();
    const int n4 = nrows * 32;
    for (int i4 = blockIdx.x * NTHREADS + tid; i4 < n4; i4 += gridDim.x * NTHREADS) {
        const size_t idx = (size_t)i4 * 4;
        f32x4 h = {0.f, 0.f, 0.f, 0.f};
#pragma unroll
        for (int s = 0; s < 4; ++s) { const u32x2 pv = *(const u32x2*)((const bf16_t*)part + (size_t)s * NT * 128 + idx); h += (f32x4){bflo(pv.x), bfhi(pv.x), bflo(pv.y), bfhi(pv.y)}; }
        const u32x2 e = *(const u32x2*)(seli + idx);
        const f32x4 gt = *(const f32x4*)(selg + idx);
        const int ee[4] = {(int)(e.x & 0xffffu), (int)(e.x >> 16), (int)(e.y & 0xffffu), (int)(e.y >> 16)};
        f32x4 o;
#pragma unroll
        for (int q = 0; q < 4; ++q) {
            const float hh = h[q] * rsu[ee[q]];
            o[q] = gt[q] * (0.5f * hh * (1.f + erff(hh * 0.70710678118654752f))) * rsv[ee[q]];
        }
        u32x2 ow; ow.x = pk2(o[0], o[1]); ow.y = pk2(o[2], o[3]);
        *(u32x2*)(wexp + idx) = ow;
    }
}
DEV void phase_final(const Params& P) {
    const int tid = tid_fresh(), wave = tid >> 6, lane = tid & 63;
    for (int r = blockIdx.x * 8 + wave; r < NX; r += gridDim.x * 8) {
        float* h = P.out + (size_t)r * 1024;
        f32x4 v[4]; float ss = 0.f;
#pragma unroll
        for (int j = 0; j < 4; ++j) { const u32x2 hv = *(const u32x2*)(hrow(P, r) + j * 256 + lane * 4); v[j] = (f32x4){bflo(hv.x), bfhi(hv.x), bflo(hv.y), bfhi(hv.y)};
            ss += v[j].x * v[j].x + v[j].y * v[j].y + v[j].z * v[j].z + v[j].w * v[j].w; }
        ss = wave_sum(ss);
        const float rstd = rsqrtf(ss * (1.f / 1024.f) + EPS);
#pragma unroll
        for (int j = 0; j < 4; ++j) { const f32x4 gg = *(const f32x4*)(P.final_g + j * 256 + lane * 4); __builtin_nontemporal_store(v[j] * rstd * gg, (f32x4*)(h + j * 256 + lane * 4)); }
    }
}

DEV void phase_conv(const Params& P) {
    const bf16_t* Pq = (const bf16_t*)(P.ws + OFF_R1);
    const float* ab = (const float*)(P.ws + OFF_AB);
    bf16_t* dst[3] = {(bf16_t*)(P.ws + OFF_QC), (bf16_t*)(P.ws + OFF_KC), (bf16_t*)(P.ws + OFF_VC)};
    float* gbuf = (float*)(P.ws + OFF_G);
    float* bbuf = (float*)(P.ws + OFF_BETA);
    const int tid = tid_fresh(), wave = tid >> 6, lane = tid & 63;
    constexpr int NSEG = NT / 16;
    for (int item = blockIdx.x * 8 + wave; item < NSEG * 6; item += gridDim.x * 8) {
        const int seg = item / 6, jc = item - seg * 6, row0 = seg * 16;
        int t0, L;
        if (row0 < NX) { t0 = row0 & 2047; L = 2048; } else { t0 = (row0 - NX) & 255; L = 256; }
        const int chunk = lane + 64 * jc, col = chunk * 8, part = jc >> 1;
        f32x4 w0[5], w1[5];
#pragma unroll
        for (int tap = 0; tap < 5; ++tap) { w0[tap] = *(const f32x4*)(P.dn_conv_w + tap * 3072 + col); w1[tap] = *(const f32x4*)(P.dn_conv_w + tap * 3072 + col + 4); }
        u32x4 raw[20];
#pragma unroll
        for (int i = 0; i < 20; ++i) {
            const int tt = t0 + i - 2;
            const bool ok = tt >= 0 && tt < L;
            const u32x4 v = *(const u32x4*)(Pq + (size_t)(row0 + (ok ? i - 2 : 0)) * 3072 + col);
            raw[i] = ok ? v : (u32x4){0u, 0u, 0u, 0u};
        }
        const float qs = part == 0 ? 0.08838834764831845f : 1.f;
        bf16_t* dp = dst[part] + (size_t)row0 * 1024 + (chunk & 127) * 8;
#pragma unroll
        for (int i = 0; i < 16; ++i) {
            float acc[8];
#pragma unroll
            for (int e = 0; e < 8; ++e) acc[e] = 0.f;
#pragma unroll
            for (int tap = 0; tap < 5; ++tap) {
                float f[8]; unpack8(raw[i + tap], f);
                acc[0] += f[0] * w0[tap].x; acc[1] += f[1] * w0[tap].y; acc[2] += f[2] * w0[tap].z; acc[3] += f[3] * w0[tap].w;
                acc[4] += f[4] * w1[tap].x; acc[5] += f[5] * w1[tap].y; acc[6] += f[6] * w1[tap].z; acc[7] += f[7] * w1[tap].w;
            }
            float ss = 0.f;
#pragma unroll
            for (int e = 0; e < 8; ++e) { acc[e] = silu(acc[e]); ss += acc[e] * acc[e]; }
            if (part < 2) {
                ss = sum16(ss);
                const float rn = rsqrtf(ss + EPS) * qs;
#pragma unroll
                for (int e = 0; e < 8; ++e) acc[e] *= rn;
            }
            u32x4 o; o.x = pk2(acc[0], acc[1]); o.y = pk2(acc[2], acc[3]); o.z = pk2(acc[4], acc[5]); o.w = pk2(acc[6], acc[7]);
            *(u32x4*)(dp + (size_t)i * 1024) = o;
        }
        if (jc == 0) {
            const int cc = lane & 31, d = cc >> 4, sx = (cc >> 3) & 1, h = cc & 7;
            const float a = __expf(P.dn_a_log[d * 8 + h]), dtb = P.dn_dt_bias[d * 8 + h];
            float v[8];
#pragma unroll
            for (int q = 0; q < 8; ++q) v[q] = ab[(size_t)(row0 + 2 * q + (lane >> 5)) * 32 + cc];
#pragma unroll
            for (int q = 0; q < 8; ++q) {
                const int row = row0 + 2 * q + (lane >> 5);
                if (sx == 0) {
                    const float xx = v[q] + dtb;
                    const float ex = __expf(fminf(xx, 30.f)), u = 1.f + ex;
                    const float l1p = (u == 1.f) ? ex : __logf(u) * ex * __builtin_amdgcn_rcpf(u - 1.f);
                    const float sp = xx > 20.f ? xx : l1p;
                    gbuf[((size_t)d * NT + row) * 8 + h] = -a * sp;
                } else {
                    bbuf[((size_t)d * NT + row) * 8 + h] = __builtin_amdgcn_rcpf(1.f + __expf(-v[q]));
                }
            }
        }
    }
}

DEV int chunk_rowbase(int b, int d, int n) {
    if (n < 4) { const int m = d ? 3 - n : n; return NX + b * 256 + m * 64; }
    const int m = d ? 31 - (n - 4) : n - 4; return b * 2048 + m * 64;
}

DEV bf16x8 frag_col_x(ldsp x, int c0, int k0, int lane) {
    const int col = c0 + (lane & 31), ch = col >> 3, sub = (col & 7) * 2;
    bf16x8 f;
#pragma unroll
    for (int j = 0; j < 8; ++j) { const int row = k0 + 8 * (lane >> 5) + j; f[j] = (short)*(const LAS bf16_t*)(x + row * 256 + ((ch ^ (row & 15)) << 4) + sub); }
    return f;
}
DEV void tile_rows8(const f32x16& acc, u32x4& o0, u32x4& o1) {
    unsigned p[4][2];
#pragma unroll
    for (int rg = 0; rg < 4; ++rg) { p[rg][0] = pk2(acc[rg * 4 + 0], acc[rg * 4 + 1]); p[rg][1] = pk2(acc[rg * 4 + 2], acc[rg * 4 + 3]); }
    const auto s00 = __builtin_amdgcn_permlane32_swap(p[0][0], p[2][0], false, false), s01 = __builtin_amdgcn_permlane32_swap(p[0][1], p[2][1], false, false);
    const auto s10 = __builtin_amdgcn_permlane32_swap(p[1][0], p[3][0], false, false), s11 = __builtin_amdgcn_permlane32_swap(p[1][1], p[3][1], false, false);
    o0 = (u32x4){s00[0], s01[0], s00[1], s01[1]};
    o1 = (u32x4){s10[0], s11[0], s10[1], s11[1]};
}
DEV bf16x8 frag_row_t(ldsp t, int r0, int k0, int lane) {
    const int row = r0 + (lane & 31), ch = (k0 >> 3) + (lane >> 5);
    return *(const LAS bf16x8*)(t + row * 128 + ((ch ^ (row & 7)) << 4));
}
DEV void phase_chunk(const Params& P, ldsp lds0) {
    const bf16_t* kc = (const bf16_t*)(P.ws + OFF_KC);
    const bf16_t* vc = (const bf16_t*)(P.ws + OFF_VC);
    const float* gbuf = (const float*)(P.ws + OFF_G);
    const float* bbuf = (const float*)(P.ws + OFF_BETA);
    bf16_t* wbuf = (bf16_t*)(P.ws + OFF_WBUF);
    bf16_t* ubuf = (bf16_t*)(P.ws + OFF_UBUF);
    float* gcbuf = (float*)(P.ws + OFF_GC);
    const int tid = tid_fresh(), lane = tid & 63, wave = tid >> 6, team = wave >> 1, tw = wave & 1, ttid = tid & 127;
    const int nteams = gridDim.x * 4, niter = (4608 + nteams - 1) / nteams;
    u32x4 rk[8];
    {
        const int item0 = min((int)(blockIdx.x * 4 + team), 4607);
        const int n = item0 % 36, d = (item0 / 36) & 1, bh = item0 / 72, rb0 = chunk_rowbase(bh >> 3, d, n);
#pragma unroll
        for (int j = 0; j < 8; ++j) { const int cid = ttid + 128 * j, i = cid >> 4, ch = cid & 15; rk[j] = *(const u32x4*)(kc + ((size_t)rb0 + (d ? 63 - i : i)) * 1024 + (bh & 7) * 128 + ch * 8); }
    }
    for (int it = 0; it < niter; ++it) {
        const int item = it * nteams + blockIdx.x * 4 + team;
        const bool act = item < 4608;
        const ldsp lds = launder(lds0);
        const ldsp sX = lds + team * 32768;
        const ldsp sT = sX + 16384;
        LAS float* sA = (LAS float*)sT;
        LAS float* sg = (LAS float*)(lds + 131072 + 128 + team * 768);
        const int n = item % 36, d = (item / 36) & 1, bh = item / 72, b = bh >> 3, h = bh & 7;
        const int rowbase = act ? chunk_rowbase(b, d, n) : 0;
        if (act) {
#pragma unroll
            for (int j = 0; j < 8; ++j) { const int cid = ttid + 128 * j, i = cid >> 4, ch = cid & 15; *(LAS u32x4*)(sX + i * 256 + ((ch ^ (i & 15)) << 4)) = rk[j]; }
            if (tw == 0) {
                const size_t grow = (size_t)rowbase + (d ? 63 - lane : lane);
                float v = gbuf[((size_t)d * NT + grow) * 8 + h];
#pragma unroll
                for (int o = 1; o < 64; o <<= 1) { const float t = __shfl_up(v, o); if (lane >= o) v += t; }
                sg[lane] = v; sg[64 + lane] = bbuf[((size_t)d * NT + grow) * 8 + h];
            }
        }
        __syncthreads();
        if (act) {
#pragma unroll 1
            for (int q = 0; q < 2; ++q) {
                const int mt = tw, nt = q;
                f32x16 acc = zero16();
#pragma unroll 4
                for (int ks = 0; ks < 8; ++ks) acc = mfma32(frag_row_x(sX, mt * 32, ks * 16, lane), frag_row_x(sX, nt * 32, ks * 16, lane), acc);
#pragma unroll
                for (int reg = 0; reg < 16; ++reg) {
                    const int i = mt * 32 + crow(reg, lane), j = nt * 32 + (lane & 31);
                    sA[i * 64 + j] = (i > j) ? sg[64 + i] * acc[reg] * __expf(sg[i] - sg[j]) : 0.f;
                }
            }
        }
        __syncthreads();
        if (act && tw == 0) {
            float t[64];
            int ln = lane; asm volatile("" : "+v"(ln));
#pragma unroll
            for (int i = 0; i < 64; ++i) {
                float a0 = (i == ln) ? 1.f : 0.f, a1 = 0.f, a2 = 0.f, a3 = 0.f;
#pragma unroll
                for (int j = 0; j < i; j += 4) {
                    const f32x4 av = *(const LAS f32x4*)(sA + i * 64 + j);
                    a0 -= av.x * t[j];
                    if (j + 1 < i) a1 -= av.y * t[j + 1];
                    if (j + 2 < i) a2 -= av.z * t[j + 2];
                    if (j + 3 < i) a3 -= av.w * t[j + 3];
                }
                t[i] = (a0 + a1) + (a2 + a3);
                __builtin_amdgcn_sched_barrier(0);
            }
            const float cu = sg[64 + lane], cw = cu * __expf(sg[lane]);
            const int ch = lane >> 3, sub = (lane & 7) * 2;
#pragma unroll
            for (int i = 0; i < 64; ++i) {
                const int off = i * 128 + ((ch ^ (i & 7)) << 4) + sub;
                *(LAS bf16_t*)(sT + off) = f2bf(t[i] * cw);
                *(LAS bf16_t*)(sT + 8192 + off) = f2bf(t[i] * cu);
                if ((i & 7) == 7) __builtin_amdgcn_sched_barrier(0);
            }
        }
        __syncthreads();
            {
                const int itemn = min(item + nteams, 4607);
                const int nn = itemn % 36, dn = (itemn / 36) & 1, bhn = itemn / 72, rbn = chunk_rowbase(bhn >> 3, dn, nn);
#pragma unroll
                for (int j = 0; j < 8; ++j) { const int cid = ttid + 128 * j, i = cid >> 4, ch = cid & 15; rk[j] = *(const u32x4*)(kc + ((size_t)rbn + (dn ? 63 - i : i)) * 1024 + (bhn & 7) * 128 + ch * 8); }
            }
        u32x4 rv[8];
        if (act) {
#pragma unroll
            for (int j = 0; j < 8; ++j) {
                const int cid = ttid + 128 * j, i = cid >> 4, ch = cid & 15;
                const size_t grow = (size_t)rowbase + (d ? 63 - i : i);
                rv[j] = *(const u32x4*)(vc + grow * 1024 + h * 128 + ch * 8);
            }
#pragma unroll 1
            for (int q = 0; q < 2; ++q) {
                const int mtk = 2 * tw + q;
                f32x16 acc[2]; acc[0] = zero16(); acc[1] = zero16();
#pragma unroll
                for (int ks = 0; ks < 4; ++ks) {
                    const bf16x8 afr = frag_col_x(sX, mtk * 32, ks * 16, lane);
#pragma unroll
                    for (int it2 = 0; it2 < 2; ++it2) acc[it2] = mfma32(afr, frag_row_t(sT, it2 * 32, ks * 16, lane), acc[it2]);
                }
                bf16_t* dstp = wbuf + (size_t)item * 8192;
#pragma unroll
                for (int it2 = 0; it2 < 2; ++it2) {
                    u32x4 o0, o1; tile_rows8(acc[it2], o0, o1);
                    bf16_t* rp = dstp + (it2 * 32 + (lane & 31)) * 128 + mtk * 32 + 16 * (lane >> 5);
                    *(u32x4*)rp = o0; *(u32x4*)(rp + 8) = o1;
                }
            }
        }
        __syncthreads();
        if (act) {
#pragma unroll
            for (int j = 0; j < 8; ++j) { const int cid = ttid + 128 * j, i = cid >> 4, ch = cid & 15; *(LAS u32x4*)(sX + i * 256 + ((ch ^ (i & 15)) << 4)) = rv[j]; }
        }
        __syncthreads();
        if (act) {
#pragma unroll 1
            for (int q = 0; q < 2; ++q) {
                const int nt = 2 * tw + q;
                f32x16 acc[2]; acc[0] = zero16(); acc[1] = zero16();
#pragma unroll
                for (int ks = 0; ks < 4; ++ks) {
                    const bf16x8 bfr = frag_col_x(sX, nt * 32, ks * 16, lane);
#pragma unroll
                    for (int mt = 0; mt < 2; ++mt) acc[mt] = mfma32(frag_row_t(sT + 8192, mt * 32, ks * 16, lane), bfr, acc[mt]);
                }
                bf16_t* dstp = ubuf + (size_t)item * 8192;
#pragma unroll
                for (int mt = 0; mt < 2; ++mt) {
                    u32x4 o0, o1; tile_rows8(acc[mt], o0, o1);
                    bf16_t* rp = dstp + (nt * 32 + (lane & 31)) * 64 + mt * 32 + 16 * (lane >> 5);
                    *(u32x4*)rp = o0; *(u32x4*)(rp + 8) = o1;
                }
            }
            if (tw == 0) gcbuf[(size_t)item * 64 + lane] = sg[lane];
        }
        __syncthreads();
    }
}

DEV u32x2 pack4(float a, float b, float c, float d) { u32x2 o; o.x = pk2(a, b); o.y = pk2(c, d); return o; }
DEV void phase_scan(const Params& P, ldsp lds0) {
    const bf16_t* qc = (const bf16_t*)(P.ws + OFF_QC);
    const bf16_t* kc = (const bf16_t*)(P.ws + OFF_KC);
    const bf16_t* wbuf = (const bf16_t*)(P.ws + OFF_WBUF);
    const bf16_t* ubuf = (const bf16_t*)(P.ws + OFF_UBUF);
    const float* gcbuf = (const float*)(P.ws + OFF_GC);
    bf16_t* obuf = (bf16_t*)(P.ws + OFF_OBUF);
    const int tid = tid_fresh(), lane = tid & 63, wave = tid >> 6;
    const int mt = wave >> 1, nt = wave & 1;
    const int mt2 = (wave & 3) >> 1, nt2 = wave & 1;
    for (int item = blockIdx.x; item < 256; item += gridDim.x) {
        const int half = item & 1, d = (item >> 1) & 1, bh = item >> 2, b = bh >> 3, h = bh & 7;
        f32x16 S = zero16();
        { LAS unsigned* z = (LAS unsigned*)(lds0 + 1024 + 3 * 17408 + 9216); for (int e = tid; e < 64 * 136 / 2; e += NTHREADS) z[e] = 0u; }
        u32x4 rW[2][2], rK[2][2], rQ[2][2], rU[2]; float rG[2] = {0.f, 0.f};
#pragma unroll
        for (int u = 0; u < 2; ++u) {
            const int citem = (bh * 2 + d) * 36 + u, rowbase = chunk_rowbase(b, d, u);
#pragma unroll
            for (int j = 0; j < 2; ++j) {
                const int cid = tid + NTHREADS * j, i = cid >> 4, ch = cid & 15;
                const size_t grow = (size_t)rowbase + (d ? 63 - i : i);
                rW[u][j] = *(const u32x4*)(wbuf + (size_t)citem * 8192 + i * 128 + ch * 8);
                rK[u][j] = *(const u32x4*)(kc + grow * 1024 + h * 128 + ch * 8);
                rQ[u][j] = rK[u][j];
            }
            { const int dvr = tid >> 3, ch = tid & 7; rU[u] = *(const u32x4*)(ubuf + (size_t)citem * 8192 + (half * 64 + dvr) * 64 + ch * 8); }
            if (tid < 64) rG[u] = gcbuf[(size_t)citem * 64 + tid];
        }
        for (int n2 = 0; n2 < 36; n2 += 2) {
#pragma unroll
        for (int u = 0; u < 2; ++u) {
            const int n = n2 + u;
            const ldsp lds = launder(lds0);
            int ln = lane; asm volatile("" : "+v"(ln));
            LAS float* sg = (LAS float*)lds;
            LAS bf16_t* sW = (LAS bf16_t*)(lds + 1024);
            LAS bf16_t* sK = sW + 64 * 136;
            LAS bf16_t* sQ = sK + 64 * 136;
            LAS bf16_t* sU = sQ + 64 * 136;
            LAS bf16_t* sST = sU + 64 * 72;
            LAS bf16_t* sVNT = sST + 64 * 136;
            LAS bf16_t* sVNsT = sVNT + 64 * 72;
            LAS bf16_t* sATT = sVNsT + 64 * 72;
            LAS bf16_t* sO = sATT + 64 * 72;
            const int rowbase = chunk_rowbase(b, d, n);
            const bool wantO = n >= 4;
#pragma unroll
            for (int j = 0; j < 2; ++j) {
                const int cid = tid + NTHREADS * j, i = cid >> 4, ch = cid & 15;
                *(LAS u32x4*)(sW + i * 136 + ch * 8) = rW[u][j];
                *(LAS u32x4*)(sK + i * 136 + ch * 8) = rK[u][j];
                *(LAS u32x4*)(sQ + i * 136 + ch * 8) = rQ[u][j];
            }
            { const int i = tid >> 3, ch = tid & 7; *(LAS u32x4*)(sU + i * 72 + ch * 8) = rU[u]; }
            if (tid < 64) sg[tid] = rG[u];
            __syncthreads();
            if (n + 2 < 36) {
                const int citem = (bh * 2 + d) * 36 + n + 2, rb1 = chunk_rowbase(b, d, n + 2);
                const bool wq = n + 2 >= 4;
#pragma unroll
                for (int j = 0; j < 2; ++j) {
                    const int cid = tid + NTHREADS * j, i = cid >> 4, ch = cid & 15;
                    const size_t grow = (size_t)rb1 + (d ? 63 - i : i);
                    rW[u][j] = *(const u32x4*)(wbuf + (size_t)citem * 8192 + i * 128 + ch * 8);
                    rK[u][j] = *(const u32x4*)(kc + grow * 1024 + h * 128 + ch * 8);
                    if (wq) rQ[u][j] = *(const u32x4*)(qc + grow * 1024 + h * 128 + ch * 8);
                }
                { const int dvr = tid >> 3, ch = tid & 7; rU[u] = *(const u32x4*)(ubuf + (size_t)citem * 8192 + (half * 64 + dvr) * 64 + ch * 8); }
                if (tid < 64) rG[u] = gcbuf[(size_t)citem * 64 + tid];
            }
            const float g63 = sg[63];
            if (wave < 4) {
                const int dv = nt2 * 32 + (ln & 31);
                float uf[16], ef[16];
#pragma unroll
                for (int rg = 0; rg < 4; ++rg) {
                    const int i0 = mt2 * 32 + 8 * rg + 4 * (ln >> 5);
                    const u32x2 uu = *(const LAS u32x2*)(sU + dv * 72 + i0);
                    const f32x4 gg = *(const LAS f32x4*)(sg + i0);
                    uf[rg * 4 + 0] = bflo(uu.x); uf[rg * 4 + 1] = bfhi(uu.x); uf[rg * 4 + 2] = bflo(uu.y); uf[rg * 4 + 3] = bfhi(uu.y);
#pragma unroll
                    for (int e = 0; e < 4; ++e) ef[rg * 4 + e] = __expf(g63 - gg[e]);
                }
                f32x16 acc = zero16(), accb = zero16();
#pragma unroll
                for (int ks = 0; ks < 8; ks += 2) { acc = mfma32(frag_row(sW, 136, mt2 * 32, ks * 16, ln), frag_row(sST, 136, nt2 * 32, ks * 16, ln), acc);
                    accb = mfma32(frag_row(sW, 136, mt2 * 32, ks * 16 + 16, ln), frag_row(sST, 136, nt2 * 32, ks * 16 + 16, ln), accb); }
#pragma unroll
                for (int rg = 0; rg < 4; ++rg) {
                    const int i0 = mt2 * 32 + 8 * rg + 4 * (ln >> 5);
                    float v[4], vs[4];
#pragma unroll
                    for (int e = 0; e < 4; ++e) { v[e] = uf[rg * 4 + e] - (acc[rg * 4 + e] + accb[rg * 4 + e]); vs[e] = v[e] * ef[rg * 4 + e]; }
                    *(LAS u32x2*)(sVNT + dv * 72 + i0) = pack4(v[0], v[1], v[2], v[3]);
                    *(LAS u32x2*)(sVNsT + dv * 72 + i0) = pack4(vs[0], vs[1], vs[2], vs[3]);
                }
            } else if (wantO) {
                const int i = nt2 * 32 + (ln & 31);
                const float gi = sg[i];
                float df[16];
#pragma unroll
                for (int rg = 0; rg < 4; ++rg) {
                    const int j0 = mt2 * 32 + 8 * rg + 4 * (ln >> 5);
                    const f32x4 gg = *(const LAS f32x4*)(sg + j0);
#pragma unroll
                    for (int e = 0; e < 4; ++e) df[rg * 4 + e] = (i >= j0 + e) ? __expf(fminf(gi - gg[e], 0.f)) : 0.f;
                }
                f32x16 acc = zero16(), accb = zero16();
#pragma unroll
                for (int ks = 0; ks < 8; ks += 2) { acc = mfma32(frag_row(sK, 136, mt2 * 32, ks * 16, ln), frag_row(sQ, 136, nt2 * 32, ks * 16, ln), acc);
                    accb = mfma32(frag_row(sK, 136, mt2 * 32, ks * 16 + 16, ln), frag_row(sQ, 136, nt2 * 32, ks * 16 + 16, ln), accb); }
#pragma unroll
                for (int rg = 0; rg < 4; ++rg) {
                    const int j0 = mt2 * 32 + 8 * rg + 4 * (ln >> 5);
                    float v[4];
#pragma unroll
                    for (int e = 0; e < 4; ++e) v[e] = (acc[rg * 4 + e] + accb[rg * 4 + e]) * df[rg * 4 + e];
                    *(LAS u32x2*)(sATT + i * 72 + j0) = pack4(v[0], v[1], v[2], v[3]);
                }
            }
            __syncthreads();
            if (wave < 4 && wantO) {
                float eg[16];
#pragma unroll
                for (int rg = 0; rg < 4; ++rg) {
                    const f32x4 gg = *(const LAS f32x4*)(sg + mt2 * 32 + 8 * rg + 4 * (ln >> 5));
#pragma unroll
                    for (int e = 0; e < 4; ++e) eg[rg * 4 + e] = __expf(gg[e]);
                }
                f32x16 a1 = zero16(), a1b = zero16(), a2 = zero16();
#pragma unroll
                for (int ks = 0; ks < 8; ks += 2) { a1 = mfma32(frag_row(sQ, 136, mt2 * 32, ks * 16, ln), frag_row(sST, 136, nt2 * 32, ks * 16, ln), a1);
                    a1b = mfma32(frag_row(sQ, 136, mt2 * 32, ks * 16 + 16, ln), frag_row(sST, 136, nt2 * 32, ks * 16 + 16, ln), a1b); }
#pragma unroll
                for (int ks = 0; ks < 4; ++ks) a2 = mfma32(frag_row(sATT, 72, mt2 * 32, ks * 16, ln), frag_row(sVNT, 72, nt2 * 32, ks * 16, ln), a2);
                const int dv = nt2 * 32 + (ln & 31);
#pragma unroll
                for (int rg = 0; rg < 4; ++rg) {
                    const int i0 = mt2 * 32 + 8 * rg + 4 * (ln >> 5);
#pragma unroll
                    for (int e = 0; e < 4; ++e) sO[(i0 + e) * 72 + dv] = f2bf((a1[rg * 4 + e] + a1b[rg * 4 + e]) * eg[rg * 4 + e] + a2[rg * 4 + e]);
                }
            }
            {
                const float gl = __expf(g63);
#pragma unroll
                for (int reg = 0; reg < 16; ++reg) S[reg] *= gl;
#pragma unroll
                for (int ks = 0; ks < 4; ++ks) S = mfma32(frag_col_tr(sK, 136, mt * 32, ks * 16, ln), frag_row(sVNsT, 72, nt * 32, ks * 16, ln), S);
            }
            __syncthreads();
            if (wantO) {
                const int i = tid >> 3, ch = tid & 7;
                const size_t grow = (size_t)rowbase + (d ? 63 - i : i);
                *(u32x4*)(obuf + ((size_t)d * NX + grow) * 1024 + h * 128 + half * 64 + ch * 8) = *(const LAS u32x4*)(sO + i * 72 + ch * 8);
            }
#pragma unroll
            for (int rg = 0; rg < 4; ++rg) {
                const int dk0 = mt * 32 + 8 * rg + 4 * (ln >> 5);
                *(LAS u32x2*)(sST + (nt * 32 + (ln & 31)) * 136 + dk0) = pack4(S[rg * 4 + 0], S[rg * 4 + 1], S[rg * 4 + 2], S[rg * 4 + 3]);
            }
        }
        }
        __syncthreads();
    }
}

DEV void phase_dnout(const Params& P) {
    const bf16_t* obuf = (const bf16_t*)(P.ws + OFF_OBUF);
    const bf16_t* Pz = (const bf16_t*)(P.ws + OFF_PZ);
    bf16_t* A = (bf16_t*)(P.ws + OFF_A);
    const int tid = tid_fresh(); const int wave = tid >> 6, lane = tid & 63;
    for (int row = blockIdx.x * 8 + wave; row < NX; row += gridDim.x * 8) {
#pragma unroll
        for (int c = 0; c < 2; ++c) {
            const int col = c * 512 + lane * 8;
            const u32x4 of = *(const u32x4*)(obuf + (size_t)row * 1024 + col), ob = *(const u32x4*)(obuf + ((size_t)NX + row) * 1024 + col);
            const u32x4 zz = *(const u32x4*)(Pz + (size_t)row * 1024 + col);
            float o[8], o2[8], z[8]; unpack8(of, o); unpack8(ob, o2); unpack8(zz, z);
            float ss = 0.f;
#pragma unroll
            for (int e = 0; e < 8; ++e) { o[e] += o2[e]; ss += o[e] * o[e]; }
            ss = sum16(ss);
            const float rn = rsqrtf(ss * (1.f / 128.f) + EPS);
            float y[8];
#pragma unroll
            for (int e = 0; e < 8; ++e) y[e] = o[e] * rn * P.dn_norm_g[(col & 127) + e] * silu(z[e]);
            u32x4 ov; ov.x = pk2(y[0], y[1]); ov.y = pk2(y[2], y[3]); ov.z = pk2(y[4], y[5]); ov.w = pk2(y[6], y[7]);
            *(u32x4*)(A + (size_t)row * 1024 + col) = ov;
        }
    }
}

namespace pg8 {
#define PG8_LAS __attribute__((address_space(3)))
typedef unsigned short bf16_t;
typedef short bf16x8 __attribute__((ext_vector_type(8)));
typedef float f32x4 __attribute__((ext_vector_type(4)));
typedef unsigned u32x4 __attribute__((ext_vector_type(4)));
constexpr int BM = 256, BK = 64, HALF = 128, HTB = HALF * BK * 2  , STAGE_BYTES = 8 * HTB, NXCD = 8, WGM = 8;

__host__ __device__ __forceinline__ int lds_byte(int r, int c) { const int st = (r >> 4) * 2 + (c >> 5), rr = r & 15, cc = c & 31, ob = rr * 64 + cc * 2; return st * 1024 + (ob ^ (((ob >> 9) & 1) << 5)); }
__host__ __device__ __forceinline__ void stage_rc(int b, int& R, int& C) { const int st = b / 1024, sb = b % 1024, swz = sb ^ (((sb >> 9) & 1) << 5); R = (st >> 1) * 16 + swz / 64; C = (st & 1) * 32 + (swz % 64) / 2; }
__host__ __device__ __forceinline__ int perm32(int rho) { const int n = rho >> 4, i = rho & 15; return 8 * (i >> 2) + 4 * n + (i & 3); }

struct Unit { int pm, pn; };
struct Gemm { const bf16_t* A; const bf16_t* Bt; int M, N, K; };

struct StaticOrder {
    int nM, nN, nwg, G, c;
    __host__ __device__ void init(int M, int N, int G_, int c_) { nM = M / BM; nN = N / BM; nwg = nM * nN; G = G_; c = c_; }
    __host__ __device__ bool next(int i, Unit& u) const {
        const long L = (long)i * G + c; if (L >= nwg) return false;
        int wgid = (int)L; { const int q = nwg / NXCD, r = nwg % NXCD, xcd = wgid % NXCD, off = wgid / NXCD; wgid = (xcd < r ? xcd * (q + 1) : r * (q + 1) + (xcd - r) * q) + off; }
        const int nig = WGM * nN, gid = wgid / nig, fm = gid * WGM, gsz = (nM - fm) < WGM ? (nM - fm) : WGM;
        u.pm = fm + ((wgid % nig) % gsz); u.pn = (wgid % nig) / gsz; return true;
    }
    __device__ __forceinline__ void a_ready(const Unit&) const {}
    __device__ __forceinline__ void done(const Unit&) const {}
};

__device__ __forceinline__ unsigned cvt_pk_bf16(float lo, float hi) { typedef float v2f __attribute__((ext_vector_type(2))); typedef __bf16 v2b __attribute__((ext_vector_type(2))); const v2f v = {lo, hi}; return __builtin_bit_cast(unsigned, __builtin_convertvector(v, v2b)); }
__device__ __forceinline__ u32x4 pack8(const f32x4 v0, const f32x4 v1) { u32x4 w; w.x = cvt_pk_bf16(v0[0], v0[1]); w.y = cvt_pk_bf16(v0[2], v0[3]); w.z = cvt_pk_bf16(v1[0], v1[1]); w.w = cvt_pk_bf16(v1[2], v1[3]); return w; }
struct EpiQ {
    static constexpr bool PERM = true, AFTER_DRAIN = false;
    bf16_t* O; int ldc;
    __device__ __forceinline__ void operator()(const f32x4 (&acc)[2][2][4][2], const Unit& u, int wr, int wc, int fr, int fq) const {
        const int row0 = u.pm * BM + wr * 64 + fr, col0 = u.pn * BM + wc * 32 + 8 * fq;
#pragma unroll
        for (int ai = 0; ai < 2; ++ai)
#pragma unroll
            for (int m = 0; m < 4; ++m) { bf16_t* rowp = O + (size_t)(row0 + ai * HALF + m * 16) * ldc + col0;
#pragma unroll
                for (int bj = 0; bj < 2; ++bj) *(u32x4*)(rowp + bj * HALF) = pack8(acc[ai][bj][m][0], acc[ai][bj][m][1]); }
    }
};
struct EpiWinP {
    static constexpr bool PERM = true, AFTER_DRAIN = false;
    bf16_t* qkv; bf16_t* z; float* ab;
    __device__ __forceinline__ void operator()(const f32x4 (&acc)[2][2][4][2], const Unit& u, int wr, int wc, int fr, int fq) const {
        const int row0 = u.pm * BM + wr * 64 + fr;
        if (u.pn < 16) {
            bf16_t* base = u.pn < 12 ? qkv : z; const int ldc = u.pn < 12 ? 3072 : 1024, col0 = (u.pn < 12 ? u.pn : u.pn - 12) * BM + wc * 32 + 8 * fq;
#pragma unroll
            for (int ai = 0; ai < 2; ++ai)
#pragma unroll
                for (int m = 0; m < 4; ++m) { bf16_t* rowp = base + (size_t)(row0 + ai * HALF + m * 16) * ldc + col0;
#pragma unroll
                    for (int bj = 0; bj < 2; ++bj) *(u32x4*)(rowp + bj * HALF) = pack8(acc[ai][bj][m][0], acc[ai][bj][m][1]); }
        } else if (wc == 0) {
#pragma unroll
            for (int ai = 0; ai < 2; ++ai)
#pragma unroll
                for (int m = 0; m < 4; ++m) { float* rowp = ab + (size_t)(row0 + ai * HALF + m * 16) * 32 + 8 * fq;
                    *(f32x4*)rowp = acc[ai][0][m][0]; *(f32x4*)(rowp + 4) = acc[ai][0][m][1]; }
        }
    }
};
struct EpiRes {
    static constexpr bool PERM = true, AFTER_DRAIN = false;
    bf16_t* h; const float* gate;
    __device__ __forceinline__ void operator()(const f32x4 (&acc)[2][2][4][2], const Unit& u, int wr, int wc, int fr, int fq) const {
        const int row0 = u.pm * BM + wr * 64 + fr, col0 = u.pn * BM + wc * 32 + 8 * fq;
#pragma unroll
        for (int ai = 0; ai < 2; ++ai)
#pragma unroll
            for (int m = 0; m < 4; ++m) { const int row = row0 + ai * HALF + m * 16; bf16_t* rowp = h + (size_t)row * 1024 + col0; const float* gp = gate + (row >> 11) * 6144 + col0;
#pragma unroll
                for (int bj = 0; bj < 2; ++bj) {
                    const u32x4 hv = *(const u32x4*)(rowp + bj * HALF);
                    const f32x4 g0 = *(const f32x4*)(gp + bj * HALF), g1 = *(const f32x4*)(gp + bj * HALF + 4);
                    const f32x4 a0 = acc[ai][bj][m][0], a1 = acc[ai][bj][m][1];
                    f32x4 n0, n1;
                    n0[0] = __uint_as_float(hv.x << 16) + g0[0] * a0[0]; n0[1] = __uint_as_float(hv.x & 0xffff0000u) + g0[1] * a0[1];
                    n0[2] = __uint_as_float(hv.y << 16) + g0[2] * a0[2]; n0[3] = __uint_as_float(hv.y & 0xffff0000u) + g0[3] * a0[3];
                    n1[0] = __uint_as_float(hv.z << 16) + g1[0] * a1[0]; n1[1] = __uint_as_float(hv.z & 0xffff0000u) + g1[1] * a1[1];
                    n1[2] = __uint_as_float(hv.w << 16) + g1[2] * a1[2]; n1[3] = __uint_as_float(hv.w & 0xffff0000u) + g1[3] * a1[3];
                    *(u32x4*)(rowp + bj * HALF) = pack8(n0, n1);
                } }
    }
};

template <class Epi, class Sched, bool ALIGN_EPI = false, bool SP2 = false>
__device__ __forceinline__ void gemm_phase(PG8_LAS unsigned char* lds, const Gemm g, const Sched& S, const Epi& E) {
    const int tid = tid_fresh(), wid = __builtin_amdgcn_readfirstlane(tid >> 6), lane = tid & 63, wr = wid >> 2, wc = wid & 3, fr = lane & 15, fq = lane >> 4;
    const int K = g.K, nt = K / BK;
    unsigned voffA[2], voffB[2];
#pragma unroll
    for (int i = 0; i < 2; ++i) { int R, C; stage_rc(tid * 16 + i * 8192, R, C); const int Rb = Epi::PERM ? ((R & ~31) + perm32(R & 31)) : R;
        voffA[i] = (unsigned)(R * K + C) * 2u; voffB[i] = (unsigned)(Rb * K + C) * 2u; }
    const size_t kstep = (size_t)(BK * 2);
    const size_t hstep = (size_t)HALF * K * 2;
    const size_t tstep = 2 * hstep;
    const unsigned ldsw = (unsigned)wid * 1024u;
    const int aoff = lds_byte(wr * 64 + fr, fq * 8), boff = lds_byte(wc * 32 + fr, fq * 8);
#define PG8_SA(b, h) (((b) * 2 + (h)) * HTB)
#define PG8_SB(b, h) ((4 + (b) * 2 + (h)) * HTB)
#define PG8_STAGE(bufoff, gbase, voff) do { _Pragma("unroll") for (int _i = 0; _i < 2; ++_i) \
        __builtin_amdgcn_global_load_lds((const unsigned*)((const char*)(gbase) + (voff)[_i]), (PG8_LAS unsigned*)(lds + (bufoff) + ldsw + _i * 8192), 16, 0, 0); } while (0)
#define PG8_LDA(dst, b, h) do { _Pragma("unroll") for (int m = 0; m < 4; ++m) _Pragma("unroll") for (int k = 0; k < 2; ++k) dst[m][k] = *(const PG8_LAS bf16x8*)(lds + PG8_SA(b, h) + aoff + m * 2048 + k * 1024); } while (0)
#define PG8_LDB(dst, b, h) do { _Pragma("unroll") for (int n = 0; n < 2; ++n) _Pragma("unroll") for (int k = 0; k < 2; ++k) dst[n][k] = *(const PG8_LAS bf16x8*)(lds + PG8_SB(b, h) + boff + n * 2048 + k * 1024); } while (0)
#define PG8_MMA(ai, bj, At, Bt) do { __builtin_amdgcn_s_setprio(1); _Pragma("unroll") for (int m = 0; m < 4; ++m) _Pragma("unroll") for (int n = 0; n < 2; ++n) _Pragma("unroll") for (int k = 0; k < 2; ++k) \
        acc[ai][bj][m][n] = __builtin_amdgcn_mfma_f32_16x16x32_bf16(Bt[n][k], At[m][k], acc[ai][bj][m][n], 0, 0, 0); __builtin_amdgcn_s_setprio(0); } while (0)
#define PG8_WAIT_V(n) asm volatile("s_waitcnt vmcnt(" #n ")" ::: "memory")
#define PG8_WAIT_L(n) asm volatile("s_waitcnt lgkmcnt(" #n ")" ::: "memory")
#define PG8_BAR __builtin_amdgcn_s_barrier()
#define PG8_SCHED __builtin_amdgcn_sched_barrier(0)
    Unit cur, nxt; int ui = 0;
    if (!S.next(0, cur)) return;
    f32x4 acc[2][2][4][2];
#pragma unroll
    for (int a = 0; a < 2; ++a)
#pragma unroll
        for (int b = 0; b < 2; ++b)
#pragma unroll
            for (int m = 0; m < 4; ++m)
#pragma unroll
                for (int n = 0; n < 2; ++n) acc[a][b][m][n] = (f32x4){0.f, 0.f, 0.f, 0.f};
    bf16x8 At[4][2], B0[2][2], B1[2][2];
    const char* cA = (const char*)g.A + (size_t)cur.pm * tstep; const char* cB = (const char*)g.Bt + (size_t)cur.pn * tstep;
    S.a_ready(cur);
    if constexpr (SP2) {
        PG8_STAGE(PG8_SB(0, 0), cB, voffB); PG8_STAGE(PG8_SB(0, 1), cB + hstep, voffB); PG8_STAGE(PG8_SA(0, 0), cA, voffA); PG8_STAGE(PG8_SA(0, 1), cA + hstep, voffA);
        if (wr == 1) PG8_BAR;
        PG8_WAIT_V(2); PG8_BAR;
        PG8_STAGE(PG8_SB(1, 0), cB + kstep, voffB); PG8_STAGE(PG8_SA(1, 0), cA + kstep, voffA); PG8_STAGE(PG8_SB(1, 1), cB + hstep + kstep, voffB);
        PG8_WAIT_V(6); PG8_BAR;
    } else {
        PG8_STAGE(PG8_SB(0, 0), cB, voffB); PG8_STAGE(PG8_SA(0, 0), cA, voffA); PG8_STAGE(PG8_SB(0, 1), cB + hstep, voffB); PG8_STAGE(PG8_SA(0, 1), cA + hstep, voffA);
        if (wr == 1) PG8_BAR;
        PG8_WAIT_V(4); PG8_BAR;
        PG8_STAGE(PG8_SB(1, 0), cB + kstep, voffB); PG8_STAGE(PG8_SA(1, 0), cA + kstep, voffA); PG8_STAGE(PG8_SB(1, 1), cB + hstep + kstep, voffB);
        PG8_WAIT_V(6); PG8_BAR;
    }
    for (;;) {
        const bool has_next = S.next(ui + 1, nxt);
        const char* nA = has_next ? (const char*)g.A + (size_t)nxt.pm * tstep : cA; const char* nB = has_next ? (const char*)g.Bt + (size_t)nxt.pn * tstep : cB;
        for (int t = 0; t < nt; t += 2) {
            const bool last = (t == nt - 2);
            const char* a1 = cA + (size_t)(t + 1) * kstep;
            const char* a2 = last ? nA : cA + (size_t)(t + 2) * kstep; const char* b2 = last ? nB : cB + (size_t)(t + 2) * kstep;
            const char* a3 = a2 + kstep; const char* b3 = b2 + kstep;
            if (last && has_next) S.a_ready(nxt);
            if constexpr (SP2) {
            PG8_LDB(B0, 0, 0); PG8_LDB(B1, 0, 1); PG8_SCHED; PG8_LDA(At, 0, 0); PG8_STAGE(PG8_SA(1, 1), a1 + hstep, voffA);
            PG8_WAIT_V(8); PG8_WAIT_L(0); PG8_BAR; PG8_MMA(0, 0, At, B0); PG8_MMA(0, 1, At, B1); PG8_BAR; PG8_SCHED;
            PG8_LDA(At, 0, 1); PG8_STAGE(PG8_SB(0, 0), b2, voffB); PG8_STAGE(PG8_SB(0, 1), b2 + hstep, voffB); PG8_STAGE(PG8_SA(0, 0), a2, voffA);
            PG8_WAIT_V(8); PG8_WAIT_L(0); PG8_BAR; PG8_MMA(1, 0, At, B0); PG8_MMA(1, 1, At, B1); PG8_BAR; PG8_SCHED;
            PG8_LDB(B0, 1, 0); PG8_LDB(B1, 1, 1); PG8_SCHED; PG8_LDA(At, 1, 0); PG8_STAGE(PG8_SA(0, 1), a2 + hstep, voffA);
            PG8_WAIT_V(8); PG8_WAIT_L(0); PG8_BAR; PG8_MMA(0, 0, At, B0); PG8_MMA(0, 1, At, B1); PG8_BAR; PG8_SCHED;
            PG8_LDA(At, 1, 1); PG8_STAGE(PG8_SB(1, 0), b3, voffB); PG8_STAGE(PG8_SB(1, 1), b3 + hstep, voffB); PG8_STAGE(PG8_SA(1, 0), a3, voffA);
            PG8_WAIT_V(8); PG8_WAIT_L(0); PG8_BAR; PG8_MMA(1, 0, At, B0); PG8_MMA(1, 1, At, B1); PG8_BAR; PG8_SCHED;
            } else {
            PG8_LDB(B0, 0, 0); PG8_SCHED; PG8_LDA(At, 0, 0); PG8_STAGE(PG8_SA(1, 1), a1 + hstep, voffA);
            PG8_WAIT_L(8); PG8_BAR; PG8_WAIT_L(0); PG8_MMA(0, 0, At, B0); PG8_BAR; PG8_SCHED;
            PG8_LDB(B1, 0, 1); PG8_STAGE(PG8_SB(0, 0), b2, voffB);
            PG8_BAR; PG8_WAIT_L(0); PG8_MMA(0, 1, At, B1); PG8_BAR;
            PG8_LDA(At, 0, 1); PG8_STAGE(PG8_SA(0, 0), a2, voffA);
            PG8_BAR; PG8_WAIT_L(0); PG8_MMA(1, 0, At, B0); PG8_BAR; PG8_SCHED;
            PG8_STAGE(PG8_SB(0, 1), b2 + hstep, voffB);
            PG8_WAIT_V(6); PG8_BAR; PG8_MMA(1, 1, At, B1); PG8_BAR;
            PG8_LDB(B0, 1, 0); PG8_SCHED; PG8_LDA(At, 1, 0); PG8_STAGE(PG8_SA(0, 1), a2 + hstep, voffA);
            PG8_WAIT_L(8); PG8_BAR; PG8_WAIT_L(0); PG8_MMA(0, 0, At, B0); PG8_BAR; PG8_SCHED;
            PG8_LDB(B1, 1, 1); PG8_STAGE(PG8_SB(1, 0), b3, voffB);
            PG8_BAR; PG8_WAIT_L(0); PG8_MMA(0, 1, At, B1); PG8_BAR;
            PG8_LDA(At, 1, 1); PG8_STAGE(PG8_SA(1, 0), a3, voffA);
            PG8_BAR; PG8_WAIT_L(0); PG8_MMA(1, 0, At, B0); PG8_BAR; PG8_SCHED;
            PG8_STAGE(PG8_SB(1, 1), b3 + hstep, voffB);
            PG8_WAIT_V(6); PG8_BAR; PG8_MMA(1, 1, At, B1); PG8_BAR;
            }
        }
        if constexpr (ALIGN_EPI) { if (wr == 0) PG8_BAR; }
        if constexpr (!Epi::AFTER_DRAIN) { E(acc, cur, wr, wc, fr, fq); S.done(cur); }
        if (!has_next) break;
#pragma unroll
        for (int a = 0; a < 2; ++a)
#pragma unroll
            for (int b = 0; b < 2; ++b)
#pragma unroll
                for (int m = 0; m < 4; ++m)
#pragma unroll
                    for (int n = 0; n < 2; ++n) acc[a][b][m][n] = (f32x4){0.f, 0.f, 0.f, 0.f};
        cur = nxt; cA = nA; cB = nB; ++ui;
        if constexpr (ALIGN_EPI) { if (wr == 1) PG8_BAR; }
    }
    PG8_WAIT_V(0);
    if constexpr (!ALIGN_EPI) { if (wr == 0) PG8_BAR; }
    PG8_BAR;
    if constexpr (Epi::AFTER_DRAIN) { E.fused(acc, cur, wr, wc, fr, fq, lds, wid, lane); S.done(cur); }
#undef PG8_SA
#undef PG8_SB
#undef PG8_STAGE
#undef PG8_LDA
#undef PG8_LDB
#undef PG8_MMA
#undef PG8_WAIT_V
#undef PG8_WAIT_L
#undef PG8_BAR
#undef PG8_SCHED
}
}

#define XB_TMO      128
#define XB_XCNT(j)  (256  + 64 * (j))
#define XB_XSUB(j)  (1280 + 64 * (j))
#define XB_XGEN(j)  (2304 + 64 * (j))
#define XB_TOP      3328
#define XB_TOPGEN   3392
#define XCD_BAR_WORDS 3456
#define XB_SPIN_CAP (1u << 22)
DEV unsigned xb_ld(unsigned* p)              { return __hip_atomic_load(p, __ATOMIC_RELAXED, __HIP_MEMORY_SCOPE_AGENT); }
DEV unsigned xb_add(unsigned* p, unsigned v) { return __hip_atomic_fetch_add(p, v, __ATOMIC_RELAXED, __HIP_MEMORY_SCOPE_AGENT); }
DEV unsigned xb_xcc_id() { return (unsigned)__builtin_amdgcn_s_getreg((3 << 11) | 20) & 0xFu; }
#define XB_SPIN(cond, bar) do { unsigned _sp = 0; while (cond) { __builtin_amdgcn_s_sleep(1); \
    if ((++_sp & 255u) == 0u) { if (xb_ld(&(bar)[XB_TMO])) break; if (_sp > XB_SPIN_CAP) { atomicAdd(&(bar)[XB_TMO], 1u); break; } } } } while (0)
struct XcdBarrier { unsigned* bar; unsigned x; volatile LAS unsigned* st; };
DEV XcdBarrier xcd_barrier_post(unsigned* bar, volatile LAS unsigned* st) {
    XcdBarrier b; b.bar = bar; b.x = xb_xcc_id(); b.st = st;
    if (threadIdx.x == 0) (void)xb_add(&bar[XB_XCNT(b.x)], 1u);
    return b;
}
DEV void xcd_barrier_complete(unsigned* bar, unsigned x, unsigned& nloc, unsigned& nx) {
    const unsigned G = gridDim.x * gridDim.y * gridDim.z;
    unsigned sum, cnt, mine, sp = 0u;
    for (;;) {
        sum = 0u; cnt = 0u; mine = 0u;
#pragma unroll
        for (unsigned j = 0; j < 16; ++j) { const unsigned c = xb_ld(&bar[XB_XCNT(j)]); sum += c; cnt += (c > 0u) ? 1u : 0u; mine = (j == x) ? c : mine; }
        if (sum == G) break;
        __builtin_amdgcn_s_sleep(1);
        if ((++sp & 255u) == 0u) { if (xb_ld(&bar[XB_TMO])) break; if (sp > XB_SPIN_CAP) { atomicAdd(&bar[XB_TMO], 1u); break; } }
    }
    nloc = mine > 0u ? mine : 1u; nx = cnt > 0u ? cnt : 1u;
}
DEV void xcd_barrier(const XcdBarrier& b) {
    asm volatile("s_waitcnt vmcnt(0)" ::: "memory");
    __syncthreads();
    if (threadIdx.x == 0) {
        unsigned* bar = b.bar;
        __builtin_amdgcn_s_waitcnt(0);
        unsigned nloc = b.st[0], nx = b.st[1];
        if (nloc == 0u) { xcd_barrier_complete(bar, b.x, nloc, nx); b.st[0] = nloc; b.st[1] = nx; }
        const unsigned old = xb_add(&bar[XB_XSUB(b.x)], 1u);
        const unsigned gen = old / nloc;
        if (old + 1u == (gen + 1u) * nloc) {
            __builtin_amdgcn_fence(__ATOMIC_RELEASE, "agent");
            asm volatile("s_waitcnt vmcnt(0)" ::: "memory");
            const unsigned og = xb_add(&bar[XB_TOP], 1u);
            const unsigned tg = og / nx;
            if (og + 1u == (tg + 1u) * nx) xb_add(&bar[XB_TOPGEN], 1u);
            else XB_SPIN(xb_ld(&bar[XB_TOPGEN]) == tg, bar);
            __builtin_amdgcn_fence(__ATOMIC_ACQUIRE, "agent");
            xb_add(&bar[XB_XGEN(b.x)], 1u);
            asm volatile("s_waitcnt vmcnt(0)" ::: "memory");
        } else {
            XB_SPIN(xb_ld(&bar[XB_XGEN(b.x)]) == gen, bar);
            __builtin_amdgcn_fence(__ATOMIC_ACQUIRE, "agent");
            asm volatile("s_waitcnt vmcnt(0)" ::: "memory");
        }
    }
    __syncthreads();
}

__global__ void __launch_bounds__(NTHREADS) fwd_megakernel(Params P) {
    __shared__ __attribute__((aligned(16))) unsigned char lds_raw[131072 + 4096];
    const ldsp lds = (ldsp)lds_raw;
    cg::grid_group grid = cg::this_grid();
    volatile LAS unsigned* xbst = (volatile LAS unsigned*)(lds + 131072);
    if (threadIdx.x == 0) { xbst[0] = 0u; xbst[1] = 0u; }
    __syncthreads();
    const XcdBarrier xbar = xcd_barrier_post((unsigned*)(P.ws + OFF_BAR), xbst);
#define GBAR() xcd_barrier(xbar)
#define ROW_HANDOFF() do { __builtin_amdgcn_fence(__ATOMIC_RELEASE, "workgroup"); asm volatile("s_waitcnt vmcnt(0)" ::: "memory"); __builtin_amdgcn_fence(__ATOMIC_ACQUIRE, "workgroup"); } while (0)
    const float* modv = (const float*)(P.ws + OFF_MODV);
    bf16_t* Abuf = (bf16_t*)(P.ws + OFF_A);

#define RUN(rep, ...) for (int rep_i = 0; rep_i < (rep); ++rep_i) { __VA_ARGS__; GBAR(); }
    for (int rep_i = 0; rep_i < REP_PREP; ++rep_i) { phase_prep(P, lds); grid.sync(); }
    RUN(REP_MOD, phase_modulate<0>(P, 0, 0, NT))
    RUN(REP_POOL, phase_pool(P, lds))
    RUN(REP_MOD, phase_modulate<1>(P, 0, 1, NT, true))
    RUN(REP_GEMM, { pg8::Gemm g{Abuf, (const bf16_t*)(P.ws + OFF_WQT), NT, 2048, 1024}; pg8::StaticOrder S; S.init(NT, 2048, gridDim.x, blockIdx.x); pg8::EpiQ e{(bf16_t*)(P.ws + OFF_R1), 2048}; pg8::gemm_phase<pg8::EpiQ, pg8::StaticOrder, true, true>(lds, g, S, e); })
    RUN(REP_TOPK, phase_topk(P, 0, NT, lds))
    phase_experts(P, 0, NT, lds);
    ROW_HANDOFF();
    RUN(REP_MOD, phase_modulate<1>(P, 1, 0, NT))
    RUN(REP_GEMM, { pg8::Gemm g{Abuf, (const bf16_t*)(P.ws + OFF_WINT), NT, 4352, 1024}; pg8::StaticOrder S; S.init(NT, 4352, gridDim.x, blockIdx.x);
      pg8::EpiWinP e{(bf16_t*)(P.ws + OFF_R1), (bf16_t*)(P.ws + OFF_PZ), (float*)(P.ws + OFF_AB)}; pg8::gemm_phase<pg8::EpiWinP, pg8::StaticOrder, true, true>(lds, g, S, e); })
    RUN(REP_CONV, phase_conv(P))
    RUN(REP_CHUNK, phase_chunk(P, lds))
    RUN(REP_SCAN, phase_scan(P, lds))
    RUN(REP_DNOUT, phase_dnout(P))
    { pg8::Gemm g{Abuf, (const bf16_t*)(P.ws + OFF_WOUTT), NX, 1024, 1024}; pg8::StaticOrder S; S.init(NX, 1024, gridDim.x, blockIdx.x); pg8::EpiRes e{(bf16_t*)(P.ws + OFF_H), modv + 9 * 6144 + 2048}; pg8::gemm_phase<pg8::EpiRes, pg8::StaticOrder, false, true>(lds, g, S, e); }
    GBAR();
    RUN(REP_MOD, phase_modulate<1>(P, 1, 1, NX, true))
    RUN(REP_GEMM, { pg8::Gemm g{Abuf, (const bf16_t*)(P.ws + OFF_WQT) + (size_t)2048 * 1024, NX, 2048, 1024}; pg8::StaticOrder S; S.init(NX, 2048, gridDim.x, blockIdx.x); pg8::EpiQ e{(bf16_t*)(P.ws + OFF_R1), 2048}; pg8::gemm_phase<pg8::EpiQ, pg8::StaticOrder, true, true>(lds, g, S, e); })
    RUN(REP_TOPK, phase_topk(P, 1, NX, lds))
    phase_experts(P, 1, NX, lds);
    ROW_HANDOFF();
    phase_final(P);
}

extern "C" void kernel_launch(void* const* d_in, const int* in_sizes, int n_in, void* d_out, int out_size, void* d_ws, size_t ws_size, hipStream_t stream) {
    static int grid_blocks = 0;
    if (grid_blocks == 0) {
        if (n_in != 21 || out_size != NX * D || ws_size < WS_END) {
            fprintf(stderr, "kernel_launch: unexpected shapes: n_in %d out %d ws %zu (need %zu)\n", n_in, out_size, ws_size, (size_t)WS_END);
            grid_blocks = -1; return;
        }
        int dev = 0, cus = 0, per_cu = 0;
        hipGetDevice(&dev);
        hipDeviceGetAttribute(&cus, hipDeviceAttributeMultiprocessorCount, dev);
        hipOccupancyMaxActiveBlocksPerMultiprocessor(&per_cu, fwd_megakernel, NTHREADS, 0);
        if (per_cu < 1) { fprintf(stderr, "kernel_launch: occupancy query reports %d blocks per CU\n", per_cu); grid_blocks = -1; return; }
        grid_blocks = cus;
    }
    if (grid_blocks < 0) return;
    if (hipMemsetAsync((char*)d_ws + OFF_BAR, 0, XCD_BAR_WORDS * 4, stream) != hipSuccess) { fprintf(stderr, "kernel_launch: memset of barrier words failed\n"); return; }
    Params p{};
    const float** pp = (const float**)&p;
    for (int i = 0; i < 21; ++i) pp[i] = (const float*)d_in[i];
    p.out = (float*)d_out; p.ws = (unsigned char*)d_ws;
    void* args[] = {&p};
    hipError_t e = hipLaunchCooperativeKernel((void*)fwd_megakernel, dim3(grid_blocks), dim3(NTHREADS), args, 0, stream);
    if (e != hipSuccess) fprintf(stderr, "cooperative launch failed: %s (grid %d)\n", hipGetErrorString(e), grid_blocks);
}
```

```cpp
#include <hip/hip_runtime.h>
#include <hip/hip_cooperative_groups.h>
#include <cstdio>
#include <cstdint>
namespace cg = cooperative_groups;

#define DEV __device__ __forceinline__
typedef unsigned short bf16_t;
typedef short bf16x8 __attribute__((ext_vector_type(8)));
typedef float f32x4 __attribute__((ext_vector_type(4)));
typedef float f32x16 __attribute__((ext_vector_type(16)));
typedef unsigned u32x4 __attribute__((ext_vector_type(4)));
typedef unsigned u32x2 __attribute__((ext_vector_type(2)));
#define LAS __attribute__((address_space(3)))
typedef LAS unsigned char* ldsp;
DEV int tid_fresh() { int t = threadIdx.x; asm volatile("" : "+v"(t)); return t; }
DEV ldsp launder(ldsp p) { asm volatile("" : "+v"(p)); return p; }

constexpr int D = 1024, NB = 8, SEQ = 2048, CTX = 256;
constexpr int NX = NB * SEQ, NC = NB * CTX, NT = NX + NC;
constexpr int NTHREADS = 512;
constexpr float EPS = 1e-6f;
#ifndef REP_PREP
#define REP_PREP 1
#endif
#ifndef REP_MOD
#define REP_MOD 1
#endif
#ifndef REP_POOL
#define REP_POOL 1
#endif
#ifndef REP_GEMM
#define REP_GEMM 1
#endif
#ifndef REP_TOPK
#define REP_TOPK 1
#endif
#ifndef REP_CONV
#define REP_CONV 1
#endif
#ifndef REP_CHUNK
#define REP_CHUNK 1
#endif
#ifndef REP_SCAN
#define REP_SCAN 1
#endif
#ifndef REP_DNOUT
#define REP_DNOUT 1
#endif

constexpr size_t MiB = 1024 * 1024;
constexpr size_t TAB_ELEMS = (size_t)16384 * 1024;
constexpr size_t OFF_TAB   = 0;
constexpr size_t OFF_WQT   = 128 * MiB;
constexpr size_t OFF_WINT  = OFF_WQT + 8 * MiB;
constexpr size_t OFF_WOUTT = OFF_WINT + (size_t)4352 * 1024 * 2;
constexpr size_t OFF_POOLT = OFF_WOUTT + 2 * MiB;
constexpr size_t OFF_KEYS  = OFF_POOLT + 512 * 1024;
constexpr size_t OFF_MODV  = OFF_KEYS + 1 * MiB;
constexpr size_t OFF_HC    = OFF_MODV + 512 * 1024;
constexpr size_t OFF_SELI  = OFF_HC + 8 * MiB;
constexpr size_t OFF_SELG  = OFF_SELI + (size_t)NT * 128 * 4;
constexpr size_t OFF_AB    = OFF_SELG + (size_t)NT * 128 * 4;
constexpr size_t OFF_G     = OFF_AB + (size_t)NT * 32 * 4;
constexpr size_t OFF_BETA  = OFF_G + (size_t)2 * NT * 8 * 4;
constexpr size_t OFF_GC    = OFF_BETA + (size_t)2 * NT * 8 * 4;
constexpr size_t OFF_QC    = OFF_GC + (size_t)4608 * 64 * 4;
constexpr size_t OFF_KC    = OFF_QC + (size_t)NT * 1024 * 2;
constexpr size_t OFF_VC    = OFF_KC + (size_t)NT * 1024 * 2;
constexpr size_t OFF_A     = OFF_VC + (size_t)NT * 1024 * 2;
constexpr size_t OFF_R1    = OFF_A + (size_t)NT * 1024 * 2;
constexpr size_t OFF_PZ    = OFF_R1 + (size_t)NT * 3072 * 2;
constexpr size_t OFF_BAR   = OFF_R1 + (size_t)NT * 4096 * 2;
constexpr size_t OFF_H     = OFF_BAR + 16384;
constexpr size_t OFF_XS    = OFF_H + (size_t)NT * 1024 * 2;
constexpr size_t OFF_RSC   = OFF_XS + (size_t)NT * 4;
constexpr size_t WS_END    = OFF_RSC + (size_t)4 * 16384 * 4;
constexpr size_t OFF_WBUF  = OFF_A;
constexpr size_t OFF_UBUF  = OFF_A + (size_t)4608 * 8192 * 2;
constexpr size_t OFF_OBUF  = OFF_TAB + 64 * MiB;
constexpr size_t OFF_PART  = OFF_QC;
constexpr size_t OFF_WEXP  = OFF_QC + (size_t)8 * NT * 128 * 4;
constexpr size_t OFF_A8    = OFF_WEXP + (size_t)NT * 128 * 4;
static_assert(OFF_UBUF + (size_t)4608 * 8192 * 2 <= OFF_PZ, "w/u overlay must not reach Pz");
static_assert(OFF_A8 + (size_t)NT * 1024 <= OFF_A, "PEER partial buffers must fit the q/k/v conv region");

struct Params {
    const float *x, *c, *ctx, *c_ctx, *mod_w, *mod_b, *norm1_g, *norm2_g, *pool_w, *pool_scale;
    const float *dn_w_in, *dn_conv_w, *dn_a_log, *dn_dt_bias, *dn_norm_g, *dn_w_out;
    const float *peer_wq, *peer_keys, *peer_u, *peer_v, *final_g;
    float* out; unsigned char* ws;
};

DEV bf16_t f2bf(float f) { return __builtin_bit_cast(unsigned short, (__bf16)f); }
DEV float bf2f(bf16_t h) { return __uint_as_float(((unsigned)h) << 16); }
typedef float f32x2_t __attribute__((ext_vector_type(2)));
typedef __bf16 bf16x2_t __attribute__((ext_vector_type(2)));
DEV unsigned pk2(float a, float b) { const f32x2_t v = {a, b}; const bf16x2_t r = __builtin_convertvector(v, bf16x2_t); return __builtin_bit_cast(unsigned, r); }
DEV float bflo(unsigned u) { return __uint_as_float(u << 16); }
DEV float bfhi(unsigned u) { return __uint_as_float(u & 0xffff0000u); }
DEV float wave_sum(float v) {
#pragma unroll
    for (int o = 32; o >= 1; o >>= 1) v += __shfl_xor(v, o);
    return v;
}
DEV float wave_max(float v) {
#pragma unroll
    for (int o = 32; o >= 1; o >>= 1) v = fmaxf(v, __shfl_xor(v, o));
    return v;
}
DEV float sum16(float v) {
#pragma unroll
    for (int o = 8; o >= 1; o >>= 1) v += __shfl_xor(v, o);
    return v;
}
DEV f32x16 mfma32(bf16x8 a, bf16x8 b, f32x16 c) { return __builtin_amdgcn_mfma_f32_32x32x16_bf16(a, b, c, 0, 0, 0); }
DEV int crow(int reg, int lane) { return (reg & 3) + 8 * (reg >> 2) + 4 * (lane >> 5); }
DEV f32x16 zero16() { f32x16 z;
#pragma unroll
    for (int i = 0; i < 16; ++i) z[i] = 0.f; return z; }
DEV bf16_t* hrow(const Params& P, int r) { return (bf16_t*)(P.ws + OFF_H) + (size_t)r * 1024; }
DEV float silu(float v) { return v * __builtin_amdgcn_rcpf(1.f + __expf(-v)); }

DEV bf16x8 frag_row(const LAS bf16_t* m, int ld, int r0, int k0, int lane) {
    return *(const LAS bf16x8*)(m + (r0 + (lane & 31)) * ld + k0 + 8 * (lane >> 5));
}
DEV bf16x8 frag_col(const LAS bf16_t* m, int ld, int c0, int k0, int lane) {
    bf16x8 f;
#pragma unroll
    for (int j = 0; j < 8; ++j) f[j] = (short)m[(k0 + 8 * (lane >> 5) + j) * ld + c0 + (lane & 31)];
    return f;
}

typedef short s16x4 __attribute__((ext_vector_type(4)));
DEV s16x4 ds_tr16(ldsp p) { return __builtin_amdgcn_ds_read_tr16_b64_v4i16((LAS s16x4*)p); }
DEV bf16x8 frag_col_tr(const LAS bf16_t* m, int ld, int c0, int k0, int lane) {
    const int gi = lane >> 4, li = lane & 15, q = li >> 2, pc = li & 3, h = gi >> 1;
    const LAS bf16_t* p = m + (k0 + 8 * h + q) * ld + c0 + 16 * (gi & 1) + 4 * pc;
    const s16x4 lo = ds_tr16((ldsp)p), hi = ds_tr16((ldsp)(p + 4 * ld));
    bf16x8 f; f[0] = lo[0]; f[1] = lo[1]; f[2] = lo[2]; f[3] = lo[3]; f[4] = hi[0]; f[5] = hi[1]; f[6] = hi[2]; f[7] = hi[3];
    return f;
}
DEV void p0_convert_item(const float* src, bf16_t* dst, size_t base) {
    const int tid = tid_fresh();
#pragma unroll
    for (int it = 0; it < 8; ++it) {
        const size_t e = base + ((size_t)it * NTHREADS + tid) * 8;
        const f32x4 a = *(const f32x4*)(src + e), b = *(const f32x4*)(src + e + 4);
        u32x4 o; o.x = pk2(a.x, a.y); o.y = pk2(a.z, a.w); o.z = pk2(b.x, b.y); o.w = pk2(b.z, b.w);
        *(u32x4*)(dst + e) = o;
    }
}
DEV void p0_table_item(const float* src, unsigned char* dst, float* rscale, int row0, bool as_int8) {
    const int tid = tid_fresh(), wave = tid >> 6, lane = tid & 63;
#pragma unroll 8
    for (int rr = 0; rr < 16; ++rr) {
        const int e = row0 + wave * 16 + rr;
        f32x4 v[4]; float am = 0.f;
#pragma unroll
        for (int q = 0; q < 4; ++q) { v[q] = __builtin_nontemporal_load((const f32x4*)(src + (size_t)e * 1024 + 256 * q + 4 * lane));
            am = fmaxf(am, fmaxf(fmaxf(fabsf(v[q].x), fabsf(v[q].y)), fmaxf(fabsf(v[q].z), fabsf(v[q].w)))); }
        am = wave_max(am);
        if (as_int8) {
            float ssq = 0.f;
#pragma unroll
            for (int q = 0; q < 4; ++q) ssq += v[q].x * v[q].x + v[q].y * v[q].y + v[q].z * v[q].z + v[q].w * v[q].w;
            ssq = wave_sum(ssq);
            const float top = fminf(am, 2.7f * sqrtf(ssq * (1.f / 1024.f)));
            am = top;
            const float sc = am > 0.f ? 7.f / am : 0.f;
#pragma unroll
            for (int q = 0; q < 4; ++q) {
                const int n0 = (int)fminf(fmaxf(rintf(v[q].x * sc), -7.f), 7.f) + 8, n1 = (int)fminf(fmaxf(rintf(v[q].y * sc), -7.f), 7.f) + 8;
                const int n2 = (int)fminf(fmaxf(rintf(v[q].z * sc), -7.f), 7.f) + 8, n3 = (int)fminf(fmaxf(rintf(v[q].w * sc), -7.f), 7.f) + 8;
                *(unsigned short*)(dst + ((size_t)q * 16384 + e) * 128 + 2 * lane) = (unsigned short)(n0 | (n1 << 4) | (n2 << 8) | (n3 << 12));
            }
            if (lane == 0) rscale[e] = am * (1.f / 7.f);
        } else {
            float ssq = 0.f;
#pragma unroll
            for (int q = 0; q < 4; ++q) ssq += v[q].x * v[q].x + v[q].y * v[q].y + v[q].z * v[q].z + v[q].w * v[q].w;
            ssq = wave_sum(ssq);
            const float top = fminf(am, 2.8f * sqrtf(ssq * (1.f / 1024.f)));
            const float sc = top > 0.f ? 6.f / top : 0.f;
#pragma unroll
            for (int q = 0; q < 4; ++q) {
                const float x0 = fminf(fmaxf(v[q].x * sc, -6.f), 6.f), x1 = fminf(fmaxf(v[q].y * sc, -6.f), 6.f), x2 = fminf(fmaxf(v[q].z * sc, -6.f), 6.f), x3 = fminf(fmaxf(v[q].w * sc, -6.f), 6.f);
                unsigned w = __builtin_amdgcn_cvt_scalef32_pk_fp4_f32(0u, x0, x1, 1.0f, 0);
                w = __builtin_amdgcn_cvt_scalef32_pk_fp4_f32(w, x2, x3, 1.0f, 1);
                *(unsigned short*)(dst + ((size_t)q * 16384 + e) * 128 + 2 * lane) = (unsigned short)(w & 0xffffu);
            }
            if (lane == 0) rscale[e] = top * (1.f / 6.f);
        }
    }
}
DEV void p0_transpose_item(const float* W, int K, int N, bf16_t* Wt, int kt, int nt, LAS float* tile) {
    const int tid = tid_fresh(), k0 = kt * 64, n0 = nt * 256;
    f32x4 v[8];
#pragma unroll
    for (int p = 0; p < 8; ++p) {
        const int kk = p * 8 + (tid >> 6), nn = (tid & 63) * 4, n = n0 + nn;
        v[p] = (f32x4){0.f, 0.f, 0.f, 0.f};
        if (n < N) v[p] = __builtin_nontemporal_load((const f32x4*)(W + (size_t)(k0 + kk) * N + n));
    }
#pragma unroll
    for (int p = 0; p < 8; ++p) {
        const int kk = p * 8 + (tid >> 6), nn = (tid & 63) * 4;
        tile[kk * 257 + nn + 0] = v[p].x; tile[kk * 257 + nn + 1] = v[p].y; tile[kk * 257 + nn + 2] = v[p].z; tile[kk * 257 + nn + 3] = v[p].w;
    }
    __syncthreads();
#pragma unroll
    for (int q = 0; q < 4; ++q) {
        const int n = q * 64 + (tid >> 3), kc = (tid & 7) * 8;
        u32x4 o;
        o.x = pk2(tile[(kc + 0) * 257 + n], tile[(kc + 1) * 257 + n]);
        o.y = pk2(tile[(kc + 2) * 257 + n], tile[(kc + 3) * 257 + n]);
        o.z = pk2(tile[(kc + 4) * 257 + n], tile[(kc + 5) * 257 + n]);
        o.w = pk2(tile[(kc + 6) * 257 + n], tile[(kc + 7) * 257 + n]);
        *(u32x4*)(Wt + (size_t)(n0 + n) * K + k0 + kc) = o;
    }
    __syncthreads();
}
DEV void p0_mod_item(const Params& P, int i, int cb, LAS float* lds) {
    LAS float* s = lds;
    LAS float* red = lds + 9 * 1024;
    const int tid = tid_fresh();
    for (int e = tid; e < 9 * 1024; e += NTHREADS) {
        const int m = e >> 10, k = e & 1023;
        const float cv = m < 8 ? P.c[m * 1024 + k] : P.c_ctx[k];
        s[e] = silu(cv);
    }
    __syncthreads();
    const int cq = tid & 31, kg = tid >> 5;
    const float* W = P.mod_w + (size_t)i * 1024 * 6144 + cb * 128 + cq * 4;
    f32x4 acc[9];
#pragma unroll
    for (int m = 0; m < 9; ++m) acc[m] = (f32x4){0.f, 0.f, 0.f, 0.f};
#pragma unroll 16
    for (int kk = 0; kk < 64; ++kk) {
        const int k = kg * 64 + kk;
        const f32x4 w = __builtin_nontemporal_load((const f32x4*)(W + (size_t)k * 6144));
#pragma unroll
        for (int m = 0; m < 9; ++m) { const float sv = s[m * 1024 + k]; acc[m] += w * sv; }
    }
#pragma unroll
    for (int m = 0; m < 9; ++m) *(LAS f32x4*)&red[(kg * 9 + m) * 128 + cq * 4] = acc[m];
    __syncthreads();
    float* modv = (float*)(P.ws + OFF_MODV);
    for (int e = tid; e < 9 * 128; e += NTHREADS) {
        const int m = e >> 7, col = e & 127;
        float sum = 0.f;
#pragma unroll
        for (int g = 0; g < 16; ++g) sum += red[(g * 9 + m) * 128 + col];
        modv[(size_t)(i * 9 + m) * 6144 + cb * 128 + col] = sum + P.mod_b[i * 6144 + cb * 128 + col];
    }
    __syncthreads();
}
DEV void phase_prep(const Params& P, ldsp lds0) {
    constexpr int N_MOD = 96, N_WQ = 2 * 16 * 8, N_WIN = 16 * 17, N_WOUT = 16 * 4, N_POOL = 4 * 4;
    constexpr int N_TR = N_WQ + N_WIN + N_WOUT + N_POOL, N_TAB = 4 * 128, N_KEYS = 16;
    constexpr int TOTAL = N_MOD + N_TR + N_TAB + N_KEYS;
    for (int item = blockIdx.x; item < TOTAL; item += gridDim.x) {
        LAS float* lds = (LAS float*)launder(lds0);
        int r = item;
        if (r < N_MOD) { p0_mod_item(P, r / 48, r % 48, lds); continue; }
        r -= N_MOD;
        if (r < N_WQ) { const int i = r / 128, t = r % 128;
            p0_transpose_item(P.peer_wq + (size_t)i * 1024 * 2048, 1024, 2048, (bf16_t*)(P.ws + OFF_WQT) + (size_t)i * 2048 * 1024, t / 8, t % 8, lds); continue; }
        r -= N_WQ;
        if (r < N_WIN) { p0_transpose_item(P.dn_w_in, 1024, 4128, (bf16_t*)(P.ws + OFF_WINT), r / 17, r % 17, lds); continue; }
        r -= N_WIN;
        if (r < N_WOUT) { p0_transpose_item(P.dn_w_out, 1024, 1024, (bf16_t*)(P.ws + OFF_WOUTT), r / 4, r % 4, lds); continue; }
        r -= N_WOUT;
        if (r < N_POOL) { const int g = r / 4, t = r % 4;
            p0_transpose_item(P.pool_w + (size_t)g * 65536, 256, 256, (bf16_t*)(P.ws + OFF_POOLT) + (size_t)g * 65536, t, 0, lds); continue; }
        r -= N_POOL;
        if (r < N_TAB) { const int tb = r / 128, ch = r % 128;
            const float* src = ((tb & 1) ? P.peer_v : P.peer_u) + (size_t)(tb >> 1) * TAB_ELEMS;
            p0_table_item(src, P.ws + OFF_TAB + (size_t)tb * 16 * MiB, (float*)(P.ws + OFF_RSC) + tb * 16384, ch * 128, (tb & 1) == 0); continue; }
        r -= N_TAB;
        p0_convert_item(P.peer_keys, (bf16_t*)(P.ws + OFF_KEYS), (size_t)r * 32768);
    }
}

template <int SRC>
DEV void phase_modulate(const Params& P, int layer, int which, int nrows, bool q8 = false) {
    const float* gain = (which ? P.norm2_g : P.norm1_g) + layer * 1024;
    const float* modv = (const float*)(P.ws + OFF_MODV) + (size_t)layer * 9 * 6144;
    bf16_t* A = (bf16_t*)(P.ws + OFF_A);
    const int tid = tid_fresh(); const int wave = tid >> 6, lane = tid & 63;
    for (int r = blockIdx.x * 8 + wave; r < nrows; r += gridDim.x * 8) {
        const int m = r < NX ? (r >> 11) : 8;
        const float* sh = modv + m * 6144 + which * 3072;
        const float* sc = sh + 1024;
        f32x4 v[4]; float ss = 0.f;
#pragma unroll
        for (int j = 0; j < 4; ++j) {
            if (SRC == 0) { const float* src = r < NX ? P.x + (size_t)r * 1024 : P.ctx + (size_t)(r - NX) * 1024; v[j] = *(const f32x4*)(src + j * 256 + lane * 4); }
            else { const u32x2 hv = *(const u32x2*)(hrow(P, r) + j * 256 + lane * 4); v[j] = (f32x4){bflo(hv.x), bfhi(hv.x), bflo(hv.y), bfhi(hv.y)}; }
            ss += v[j].x * v[j].x + v[j].y * v[j].y + v[j].z * v[j].z + v[j].w * v[j].w;
        }
        ss = wave_sum(ss);
        const float rstd = rsqrtf(ss * (1.f / 1024.f) + EPS);
#pragma unroll
        for (int j = 0; j < 4; ++j) {
            const int col = j * 256 + lane * 4;
            const f32x4 g = *(const f32x4*)(gain + col), s1 = *(const f32x4*)(sc + col), s0 = *(const f32x4*)(sh + col);
            const f32x4 y = v[j] * rstd * g * (1.f + s1) + s0;
            u32x2 o; o.x = pk2(y.x, y.y); o.y = pk2(y.z, y.w);
            *(u32x2*)(A + (size_t)r * 1024 + col) = o;
            v[j] = y;
        }
        if (q8) {
            float am = 0.f;
#pragma unroll
            for (int j = 0; j < 4; ++j) am = fmaxf(am, fmaxf(fmaxf(fabsf(v[j].x), fabsf(v[j].y)), fmaxf(fabsf(v[j].z), fabsf(v[j].w))));
            am = wave_max(am);
            const float sc = am > 0.f ? 127.f / am : 0.f;
            unsigned char* a8 = P.ws + OFF_A8 + (size_t)r * 1024;
#pragma unroll
            for (int j = 0; j < 4; ++j) {
                const int b0 = (int)rintf(v[j].x * sc), b1 = (int)rintf(v[j].y * sc), b2 = (int)rintf(v[j].z * sc), b3 = (int)rintf(v[j].w * sc);
                const unsigned mine = (unsigned)((b0 & 255) | ((b1 & 255) << 8) | ((b2 & 255) << 16) | ((b3 & 255) << 24));
                const unsigned other = (unsigned)__shfl_xor((int)mine, 1);
                const unsigned lo4 = (lane & 1) ? other : mine, hi4 = (lane & 1) ? mine : other;
                const unsigned outw = (lane & 1) ? __builtin_amdgcn_perm(hi4, lo4, 0x07050301u) : __builtin_amdgcn_perm(hi4, lo4, 0x06040200u);
                *(unsigned*)(a8 + j * 256 + lane * 4) = outw;
            }
            if (lane == 0) ((float*)(P.ws + OFF_XS))[r] = am * (1.f / 127.f);
        }
    }
}

DEV void unpack8(const u32x4 v, float* f) {
    f[0] = bflo(v.x); f[1] = bfhi(v.x); f[2] = bflo(v.y); f[3] = bfhi(v.y); f[4] = bflo(v.z); f[5] = bfhi(v.z); f[6] = bflo(v.w); f[7] = bfhi(v.w);
}
template <int W>
DEV void pool_vertical(const bf16_t* A0, LAS float* V, int b, int r, int cbase, int tq, int ch8, float (&cen)[4][8]) {
    const int rlo = max(0, r - W / 2), rhi = min(32, r - W / 2 + W);
    const float inv = 1.f / (float)(rhi - rlo);
#pragma unroll
    for (int jh = 0; jh < 2; ++jh) {
        u32x4 ld[2][W];
#pragma unroll
        for (int jj = 0; jj < 2; ++jj)
#pragma unroll
            for (int k = 0; k < W; ++k) {
                const int rr = min(rlo + k, 31), tok = tq + 16 * (2 * jh + jj);
                ld[jj][k] = *(const u32x4*)(A0 + ((size_t)b * 2048 + rr * 64 + tok) * 1024 + cbase);
            }
#pragma unroll
        for (int jj = 0; jj < 2; ++jj) {
            const int j = 2 * jh + jj, tok = tq + 16 * j;
            float acc[8];
#pragma unroll
            for (int e = 0; e < 8; ++e) acc[e] = 0.f;
#pragma unroll
            for (int k = 0; k < W; ++k) {
                float f[8]; unpack8(ld[jj][k], f);
                const bool in = rlo + k < rhi;
#pragma unroll
                for (int e = 0; e < 8; ++e) acc[e] += in ? f[e] : 0.f;
                if (rlo + k == r) {
#pragma unroll
                    for (int e = 0; e < 8; ++e) cen[j][e] = f[e];
                }
            }
            LAS float* vp = V + (tok + 8) * 260 + ch8 * 8;
            *(LAS f32x4*)vp = (f32x4){acc[0] * inv, acc[1] * inv, acc[2] * inv, acc[3] * inv};
            *(LAS f32x4*)(vp + 4) = (f32x4){acc[4] * inv, acc[5] * inv, acc[6] * inv, acc[7] * inv};
        }
    }
}
template <int W>
DEV void pool_horizontal(const LAS float* V, ldsp At, bool isx, int seg, int tq, int ch8, const float (&cen)[4][8]) {
#pragma unroll
    for (int j = 0; j < 4; ++j) {
        const int tok = tq + 16 * j;
        const int pos = isx ? tok : 64 * seg + tok, lim = isx ? 64 : 256, off = isx ? 8 : 8 - 64 * seg;
        const int lo = max(0, pos - W / 2), hi = min(lim, pos - W / 2 + W);
        f32x4 s0 = {0.f, 0.f, 0.f, 0.f}, s1 = {0.f, 0.f, 0.f, 0.f};
#pragma unroll
        for (int k = 0; k < W; ++k) {
            const int t = min(lo + k, lim - 1);
            const LAS float* vp = V + (t + off) * 260 + ch8 * 8;
            const f32x4 a = *(const LAS f32x4*)vp, b2 = *(const LAS f32x4*)(vp + 4);
            const float m = (lo + k < hi) ? 1.f : 0.f;
            s0 += a * m; s1 += b2 * m;
        }
        const float inv = 1.f / (float)(hi - lo);
        u32x4 o;
        o.x = pk2(s0.x * inv - cen[j][0], s0.y * inv - cen[j][1]);
        o.y = pk2(s0.z * inv - cen[j][2], s0.w * inv - cen[j][3]);
        o.z = pk2(s1.x * inv - cen[j][4], s1.y * inv - cen[j][5]);
        o.w = pk2(s1.z * inv - cen[j][6], s1.w * inv - cen[j][7]);
        *(LAS u32x4*)(At + tok * 512 + ((ch8 ^ (tok & 7)) << 4)) = o;
    }
}
DEV void phase_pool(const Params& P, ldsp lds0) {
    const bf16_t* A0 = (const bf16_t*)(P.ws + OFF_A);
    const float* modv = (const float*)(P.ws + OFF_MODV);
    const bf16_t* Wt = (const bf16_t*)(P.ws + OFF_POOLT);
    const int tid = tid_fresh(), lane = tid & 63, wave = tid >> 6;
    const int ch8 = tid & 31, tq = tid >> 5;
    for (int item = blockIdx.x; item < 1152; item += gridDim.x) {
        const ldsp lds = launder(lds0);
        LAS float* V = (LAS float*)lds;
        const ldsp At = lds + 80 * 260 * 4;
        const bool isx = item < 1024;
        int b, r = 0, seg = 0, g;
        if (isx) { b = item >> 7; r = (item >> 2) & 31; }
        else { const int it = item - 1024; b = it >> 4; seg = (it >> 2) & 3; }
        g = ((item & 3) + (item >> 8)) & 3;
        const int cbase = g * 256 + ch8 * 8;
        float cen[4][8];
        if (isx) {
            if (g == 0) pool_vertical<2>(A0, V, b, r, cbase, tq, ch8, cen);
            else if (g == 1) pool_vertical<4>(A0, V, b, r, cbase, tq, ch8, cen);
            else if (g == 2) pool_vertical<8>(A0, V, b, r, cbase, tq, ch8, cen);
            else pool_vertical<16>(A0, V, b, r, cbase, tq, ch8, cen);
        } else {
            for (int q = tq; q < 80; q += 16) {
                const int t = 64 * seg - 8 + q;
                if (t >= 0 && t < 256) {
                    const u32x4 pv = *(const u32x4*)(A0 + ((size_t)NX + b * 256 + t) * 1024 + cbase);
                    float f[8]; unpack8(pv, f);
                    LAS float* vp = V + q * 260 + ch8 * 8;
                    *(LAS f32x4*)vp = (f32x4){f[0], f[1], f[2], f[3]};
                    *(LAS f32x4*)(vp + 4) = (f32x4){f[4], f[5], f[6], f[7]};
                }
            }
#pragma unroll
            for (int j = 0; j < 4; ++j) {
                const int tok = tq + 16 * j;
                const u32x4 pv = *(const u32x4*)(A0 + ((size_t)NX + b * 256 + 64 * seg + tok) * 1024 + cbase);
                unpack8(pv, cen[j]);
            }
        }
        __syncthreads();
        if (g == 0) pool_horizontal<2>(V, At, isx, seg, tq, ch8, cen);
        else if (g == 1) pool_horizontal<4>(V, At, isx, seg, tq, ch8, cen);
        else if (g == 2) pool_horizontal<8>(V, At, isx, seg, tq, ch8, cen);
        else pool_horizontal<16>(V, At, isx, seg, tq, ch8, cen);
        __syncthreads();
        f32x16 acc[2]; acc[0] = zero16(); acc[1] = zero16();
        const bf16_t* Wg = Wt + (size_t)g * 65536 + (size_t)(32 * wave + (lane & 31)) * 256 + (lane >> 5) * 8;
#pragma unroll 4
        for (int ks = 0; ks < 16; ++ks) {
            const bf16x8 wfr = *(const bf16x8*)(Wg + ks * 16);
            const int ch = ks * 2 + (lane >> 5);
#pragma unroll
            for (int mt = 0; mt < 2; ++mt) {
                const int row = mt * 32 + (lane & 31);
                const bf16x8 a = *(const LAS bf16x8*)(At + row * 512 + ((ch ^ (row & 7)) << 4));
                acc[mt] = mfma32(wfr, a, acc[mt]);
            }
        }
        const int m = isx ? b : 8;
#pragma unroll
        for (int mt = 0; mt < 2; ++mt)
#pragma unroll
            for (int rg = 0; rg < 4; ++rg) {
                const int tok = mt * 32 + (lane & 31), col = g * 256 + 32 * wave + 8 * rg + 4 * (lane >> 5);
                const f32x4 gs = *(const f32x4*)(modv + m * 6144 + 2048 + col) * *(const f32x4*)(P.pool_scale + col);
                const f32x4 av = {acc[mt][rg * 4 + 0], acc[mt][rg * 4 + 1], acc[mt][rg * 4 + 2], acc[mt][rg * 4 + 3]};
                f32x4 hv; int grow;
                if (isx) { grow = b * 2048 + r * 64 + tok; hv = __builtin_nontemporal_load((const f32x4*)(P.x + (size_t)grow * 1024 + col)) + gs * av; }
                else { const size_t gi = ((size_t)b * 256 + 64 * seg + tok) * 1024 + col; grow = NX + b * 256 + 64 * seg + tok; hv = *(const f32x4*)(P.ctx + gi) + gs * av; }
                u32x2 hp; hp.x = pk2(hv.x, hv.y); hp.y = pk2(hv.z, hv.w);
                *(u32x2*)(hrow(P, grow) + col) = hp;
            }
        __syncthreads();
    }
}

DEV bf16x8 frag_row_x(ldsp x, int r0, int k0, int lane) {
    const int row = r0 + (lane & 31), ch = (k0 >> 3) + (lane >> 5);
    return *(const LAS bf16x8*)(x + row * 256 + ((ch ^ (row & 15)) << 4));
}
DEV unsigned key_of(float f) { const unsigned u = __float_as_uint(f); return u ^ ((unsigned)((int)u >> 31) | 0x80000000u); }
DEV float val_of(unsigned k) { const unsigned u = (k & 0x80000000u) ? (k ^ 0x80000000u) : ~k; return __uint_as_float(u); }
DEV void cmpx(unsigned& hi, unsigned& lo) { const unsigned a = hi, b = lo; hi = a > b ? a : b; lo = a > b ? b : a; }
DEV void sort16_desc(unsigned* v) {
#pragma unroll
    for (int k = 2; k <= 16; k <<= 1)
#pragma unroll
        for (int j = k >> 1; j > 0; j >>= 1)
#pragma unroll
            for (int i = 0; i < 16; ++i) {
                const int l = i ^ j;
                if (l > i) { if ((i & k) == 0) cmpx(v[i], v[l]); else cmpx(v[l], v[i]); }
            }
}
DEV void merge16(unsigned* r, const unsigned* b) {
#pragma unroll
    for (int k = 0; k < 16; ++k) r[k] = r[k] > b[15 - k] ? r[k] : b[15 - k];
#pragma unroll
    for (int j = 8; j > 0; j >>= 1)
#pragma unroll
        for (int i = 0; i < 16; ++i) { const int l = i ^ j; if (l > i) cmpx(r[i], r[l]); }
}
DEV void top16_of_64(unsigned* v, unsigned* r) {
#pragma unroll
    for (int blk = 0; blk < 4; ++blk) sort16_desc(v + 16 * blk);
#pragma unroll
    for (int k = 0; k < 16; ++k) r[k] = v[k];
    merge16(r, v + 16); merge16(r, v + 32); merge16(r, v + 48);
}
DEV void phase_topk(const Params& P, int layer, int nrows, ldsp lds0) {
    const bf16_t* Q = (const bf16_t*)(P.ws + OFF_R1);
    const bf16_t* keys = (const bf16_t*)(P.ws + OFF_KEYS) + (size_t)layer * 8 * 2 * 128 * 128;
    bf16_t* seli = (bf16_t*)(P.ws + OFF_SELI);
    float* selg = (float*)(P.ws + OFF_SELG);
    const int tid = tid_fresh(), lane = tid & 63, wave = tid >> 6;
    const int nitems = (nrows / 256) * 4;
    const unsigned hoff = (unsigned)(lane >> 5) * 4u;
    const int G = gridDim.x, nfr = nitems / G, left = nitems - nfr * G;
    int per = 0;
    if (left) { per = (left * 8 + G - 1) / G; per = per <= 1 ? 1 : per <= 2 ? 2 : per <= 4 ? 4 : 8; }
    const int nloop = nfr + ((left && (int)blockIdx.x * per < left * 8) ? 1 : 0);
    for (int it = 0; it < nloop; ++it) {
        const ldsp lds = launder(lds0);
        LAS unsigned* sl = (LAS unsigned*)(lds + 65536 + wave * 8192);
        int item, wtask; bool act;
        if (it < nfr) { item = it * G + blockIdx.x; wtask = wave; act = true; }
        else { const int j = blockIdx.x * per + wave; item = nfr * G + ((blockIdx.x * per) >> 3); wtask = j & 7; act = wave < per; }
        act = __builtin_amdgcn_readfirstlane((int)act) != 0;
        const int tg = item >> 2, hp = item & 3, row0 = tg * 256 + wtask * 32;
        u32x4 kr[4]; bf16x8 qf[8];
        {
            const bf16_t* kt = keys + (size_t)((hp * 2) * 2) * 128 * 128;
#pragma unroll
            for (int j = 0; j < 4; ++j) { const int cid = tid + NTHREADS * j, r = cid >> 4, ch = cid & 15; kr[j] = *(const u32x4*)(kt + r * 128 + ch * 8); }
#pragma unroll
            for (int j = 0; j < 4; ++j) { const int cid = tid + NTHREADS * j, r = cid >> 4, ch = cid & 15; *(LAS u32x4*)(lds + r * 256 + ((ch ^ (r & 15)) << 4)) = kr[j]; }
            const bf16_t* qb = Q + (size_t)(row0 + (lane & 31)) * 2048 + (hp * 2) * 256 + (lane >> 5) * 8;
#pragma unroll
            for (int ks = 0; ks < 8; ++ks) qf[ks] = *(const bf16x8*)(qb + ks * 16);
        }
        __syncthreads();
        unsigned s1[16], s2[16];
#pragma unroll
        for (int k = 0; k < 16; ++k) { s1[k] = 0u; s2[k] = 0u; }
#pragma unroll 1
        for (int step = 0; step < 4; ++step) {
            const int hs = step >> 1, p = step & 1;
            const bool mine = (lane >> 5) == hs;
            const ldsp kb = lds + (step & 1) * 32768;
            if (step < 3) {
                const bf16_t* kt = keys + (size_t)((hp * 2 + ((step + 1) >> 1)) * 2 + ((step + 1) & 1)) * 128 * 128;
#pragma unroll
                for (int j = 0; j < 4; ++j) { const int cid = tid + NTHREADS * j, r = cid >> 4, ch = cid & 15; kr[j] = *(const u32x4*)(kt + r * 128 + ch * 8); }
            }
            f32x16 acc[4];
#pragma unroll
            for (int mt = 0; mt < 4; ++mt) acc[mt] = zero16();
            if (act) {
#pragma unroll
            for (int ks = 0; ks < 8; ++ks)
#pragma unroll
                for (int mt = 0; mt < 4; ++mt) acc[mt] = mfma32(frag_row_x(kb, mt * 32, ks * 16, lane), qf[ks], acc[mt]);
            }
            if (step < 3) {
                const ldsp kn = lds + ((step + 1) & 1) * 32768;
#pragma unroll
                for (int j = 0; j < 4; ++j) { const int cid = tid + NTHREADS * j, r = cid >> 4, ch = cid & 15; *(LAS u32x4*)(kn + r * 256 + ((ch ^ (r & 15)) << 4)) = kr[j]; }
                const bf16_t* qb = Q + (size_t)(row0 + (lane & 31)) * 2048 + (hp * 2 + ((step + 1) >> 1)) * 256 + ((step + 1) & 1) * 128 + (lane >> 5) * 8;
#pragma unroll
                for (int ks = 0; ks < 8; ++ks) qf[ks] = *(const bf16x8*)(qb + ks * 16);
            }
            if (act) {
            unsigned v[64];
#pragma unroll
            for (int mt = 0; mt < 4; ++mt)
#pragma unroll
                for (int reg = 0; reg < 16; ++reg) {
                    const unsigned c = mt * 32 + (reg & 3) + 8 * (reg >> 2);
                    v[mt * 16 + reg] = ((key_of(acc[mt][reg]) & ~127u) | (127u - c)) ^ hoff;
                }
            unsigned r[16], o[16];
            top16_of_64(v, r);
#pragma unroll
            for (int k = 0; k < 16; ++k) o[k] = (unsigned)__shfl_xor((int)r[k], 32);
            merge16(r, o);
#pragma unroll
            for (int k = 0; k < 16; ++k) { if (p == 0) s1[k] = mine ? r[k] : s1[k]; else s2[k] = mine ? r[k] : s2[k]; }
            }
            __syncthreads();
        }
        if (!act) continue;
        float f1[16], f2[16];
#pragma unroll
        for (int k = 0; k < 16; ++k) {
            sl[k * 64 + lane] = s1[k]; sl[(16 + k) * 64 + lane] = s2[k];
            f1[k] = val_of(s1[k] & ~127u); f2[k] = val_of(s2[k] & ~127u);
        }
        unsigned cv[64];
        {
            int n = 0;
#pragma unroll
            for (int a = 0; a < 16; ++a)
#pragma unroll
                for (int b = 0; b < 16; ++b)
                    if ((a + 1) * (b + 1) <= 16) { cv[n] = (key_of(f1[a] + f2[b]) & ~255u) | (255u - (unsigned)(a * 16 + b)); ++n; }
#pragma unroll
            for (int q = 50; q < 64; ++q) cv[q] = 0u;
        }
        unsigned w[16];
        top16_of_64(cv, w);
        float sc[16]; int ei[16];
#pragma unroll
        for (int k = 0; k < 16; ++k) {
            const unsigned ab = 255u - (w[k] & 255u);
            const unsigned k1 = sl[(ab >> 4) * 64 + lane], k2 = sl[(16 + (ab & 15u)) * 64 + lane];
            ei[k] = (int)((127u - (k1 & 127u)) * 128u + (127u - (k2 & 127u)));
            sc[k] = val_of(w[k] & ~255u);
        }
        const float mx = sc[0];
        float tot = 0.f;
#pragma unroll
        for (int k = 0; k < 16; ++k) { sc[k] = expf(sc[k] - mx); tot += sc[k]; }
        const int row = row0 + (lane & 31), head = hp * 2 + (lane >> 5);
        bf16_t* ip = seli + (size_t)row * 128 + head * 16;
        float* gp = selg + (size_t)row * 128 + head * 16;
        const float inv = 1.f / tot;
#pragma unroll
        for (int q = 0; q < 2; ++q) {
            u32x4 o;
#pragma unroll
            for (int d = 0; d < 4; ++d) o[d] = (unsigned)ei[8 * q + 2 * d] | ((unsigned)ei[8 * q + 2 * d + 1] << 16);
            *(u32x4*)(ip + 8 * q) = o;
        }
#pragma unroll
        for (int q = 0; q < 4; ++q) *(float4*)(gp + 4 * q) = make_float4(sc[4 * q] * inv, sc[4 * q + 1] * inv, sc[4 * q + 2] * inv, sc[4 * q + 3] * inv);
    }
}

struct XGeo { int nloc, rank, nact, pos; };
typedef float f32x2 __attribute__((ext_vector_type(2)));
DEV void fp8x16_to_f32(const u32x4 r, float* f) {
#pragma unroll
    for (int d = 0; d < 4; ++d) {
        const f32x2 lo = __builtin_amdgcn_cvt_pk_f32_fp8((int)r[d], false), hi = __builtin_amdgcn_cvt_pk_f32_fp8((int)r[d], true);
        f[4 * d + 0] = lo.x; f[4 * d + 1] = lo.y; f[4 * d + 2] = hi.x; f[4 * d + 3] = hi.y;
    }
}
template <int S, int MUL, class T>
DEV void bfly_stage(T* p, int lane) {
    const bool hi = (lane & (S * MUL)) != 0;
#pragma unroll
    for (int i = 0; i < 2 * S; ++i) { const T keep = hi ? p[i + 2 * S] : p[i], send = hi ? p[i] : p[i + 2 * S]; p[i] = keep + __shfl_xor(send, S * MUL); }
}
template <int N2>
DEV void bfly_swap32(float* p) {
#pragma unroll
    for (int i = 0; i < N2; ++i) { const auto r = __builtin_amdgcn_permlane32_swap(__float_as_uint(p[i]), __float_as_uint(p[i + N2]), false, false); p[i] = __uint_as_float(r[0]) + __uint_as_float(r[1]); }
}
template <int N2>
DEV void bfly_swap16(float* p) {
#pragma unroll
    for (int i = 0; i < N2; ++i) { const auto r = __builtin_amdgcn_permlane16_swap(__float_as_uint(p[i]), __float_as_uint(p[i + N2]), false, false); p[i] = __uint_as_float(r[0]) + __uint_as_float(r[1]); }
}
template <int N2>
DEV void bfly_ror8(float* p, int lane) {
    const bool hi = (lane & 8) != 0;
#pragma unroll
    for (int i = 0; i < N2; ++i) {
        const float a = p[i] + __uint_as_float((unsigned)__builtin_amdgcn_update_dpp(0, (int)__float_as_uint(p[i]), 0x128, 0xf, 0xf, false));
        const float b = p[i + N2] + __uint_as_float((unsigned)__builtin_amdgcn_update_dpp(0, (int)__float_as_uint(p[i + N2]), 0x128, 0xf, 0xf, false));
        p[i] = hi ? b : a;
    }
}
template <int STAGE>
DEV void ex_issue(u32x4 (&buf)[16], u32x4 (&aux)[4], f32x2 (&hg)[2], const u32x4 (&idn)[2], const unsigned char* slice, const Params& P, const bf16_t* A, const bf16_t* wexp,
                  const float* gatev, int t, int sl, int g, int c) {
    int id[16];
#pragma unroll
    for (int q = 0; q < 2; ++q)
#pragma unroll
        for (int d = 0; d < 4; ++d) { id[8 * q + 2 * d] = (int)(idn[q][d] & 0xffffu); id[8 * q + 2 * d + 1] = (int)(idn[q][d] >> 16); }
#pragma unroll
    for (int k = 0; k < 16; ++k) buf[k] = *(const u32x4*)(slice + (size_t)id[k] * 128);
    if (STAGE == 1) {
        aux[0] = *(const u32x4*)(P.ws + OFF_A8 + (size_t)t * 1024 + 256 * sl + 32 * c); aux[1] = *(const u32x4*)(P.ws + OFF_A8 + (size_t)t * 1024 + 256 * sl + 32 * c + 16);
        hg[0].x = ((const float*)(P.ws + OFF_XS))[t];
    } else {
#pragma unroll
        for (int q = 0; q < 2; ++q) aux[q] = *(const u32x4*)(wexp + (size_t)t * 128 + 16 * g + 8 * q);
        const int col = 256 * sl + 32 * c + 4 * g, m = t < NX ? (t >> 11) : 8;
        const u32x2 hv = *(const u32x2*)(hrow(P, t) + col);
        aux[2] = (u32x4){hv.x, hv.y, 0u, 0u};
        aux[3] = *(const u32x4*)(gatev + m * 6144 + col);
    }
}
template <int STAGE>
DEV void ex_compute(const u32x4 (&buf)[16], const u32x4 (&aux)[4], const f32x2 (&hg)[2], const Params& P, float* part, int t, int sl, int lane, int g, int c) {
    if (STAGE == 1) {
        int sx = 0;
#pragma unroll
        for (int q = 0; q < 2; ++q)
#pragma unroll
            for (int d = 0; d < 4; ++d) sx = __builtin_amdgcn_sdot4(0x01010101, (int)aux[q][d], sx, false);
        int p[16];
#pragma unroll
        for (int k = 0; k < 16; ++k) {
            int a = -8 * sx;
#pragma unroll
            for (int d = 0; d < 4; ++d) {
                const unsigned w = buf[k][d];
                a = __builtin_amdgcn_sdot4((int)(w & 0x0F0F0F0Fu), (int)aux[d >> 1][2 * (d & 1)], a, false);
                a = __builtin_amdgcn_sdot4((int)((w >> 4) & 0x0F0F0F0Fu), (int)aux[d >> 1][2 * (d & 1) + 1], a, false);
            }
            p[k] = a;
        }
        bfly_stage<4, 1>(p, lane); bfly_stage<2, 1>(p, lane); bfly_stage<1, 1>(p, lane);
        const float xs = hg[0].x;
        *(unsigned*)((bf16_t*)part + ((size_t)sl * NT + t) * 128 + 2 * lane) = pk2((float)p[0] * xs, (float)p[1] * xs);
    } else {
        f32x2 p2[16];
#pragma unroll
        for (int i = 0; i < 16; ++i) p2[i] = (f32x2){0.f, 0.f};
#pragma unroll
        for (int k = 0; k < 16; ++k) {
            const unsigned wpk = aux[k >> 3][(k >> 1) & 3];
            const float wkf = (k & 1) ? bfhi(wpk) : bflo(wpk);
            const f32x2 w2 = {wkf, wkf};
#pragma unroll
            for (int d = 0; d < 4; ++d) {
                p2[4 * d + 0] += w2 * __builtin_amdgcn_cvt_scalef32_pk_f32_fp4(buf[k][d], 1.0f, 0);
                p2[4 * d + 1] += w2 * __builtin_amdgcn_cvt_scalef32_pk_f32_fp4(buf[k][d], 1.0f, 1);
                p2[4 * d + 2] += w2 * __builtin_amdgcn_cvt_scalef32_pk_f32_fp4(buf[k][d], 1.0f, 2);
                p2[4 * d + 3] += w2 * __builtin_amdgcn_cvt_scalef32_pk_f32_fp4(buf[k][d], 1.0f, 3);
            }
            asm volatile("" : "+v"(p2[0]), "+v"(p2[1]), "+v"(p2[2]), "+v"(p2[3]), "+v"(p2[4]), "+v"(p2[5]), "+v"(p2[6]), "+v"(p2[7]),
                              "+v"(p2[8]), "+v"(p2[9]), "+v"(p2[10]), "+v"(p2[11]), "+v"(p2[12]), "+v"(p2[13]), "+v"(p2[14]), "+v"(p2[15]));
        }
        float p[32];
#pragma unroll
        for (int i = 0; i < 16; ++i) { p[2 * i] = p2[i].x; p[2 * i + 1] = p2[i].y; }
        bfly_stage<8, 4>(p, lane); bfly_stage<4, 4>(p, lane); bfly_stage<2, 4>(p, lane);
        const int col = 256 * sl + 32 * c + 4 * g;
        const unsigned h0 = aux[2].x, h1 = aux[2].y;
        u32x2 ho;
        ho.x = pk2(bflo(h0) + __uint_as_float(aux[3].x) * p[0], bfhi(h0) + __uint_as_float(aux[3].y) * p[1]);
        ho.y = pk2(bflo(h1) + __uint_as_float(aux[3].z) * p[2], bfhi(h1) + __uint_as_float(aux[3].w) * p[3]);
        *(u32x2*)(hrow(P, t) + col) = ho;
    }
}
template <int STAGE>
DEV void phase_experts_sliced(const Params& P, int layer, int nrows, const XGeo geo) {
    const unsigned char* tab = P.ws + OFF_TAB + (size_t)(layer * 2 + (STAGE - 1)) * 16 * MiB;
    const bf16_t* A = (const bf16_t*)(P.ws + OFF_A);
    const bf16_t* seli = (const bf16_t*)(P.ws + OFF_SELI);
    float* part = (float*)(P.ws + OFF_PART);
    const bf16_t* wexp = (const bf16_t*)(P.ws + OFF_WEXP);
    const float* gatev = (const float*)(P.ws + OFF_MODV) + (size_t)layer * 9 * 6144 + 5 * 1024;
    const int tid = tid_fresh(), wave = tid >> 6, lane = tid & 63, g = lane >> 3, c = lane & 7;
    const int nw = geo.nloc * 8, wr = geo.rank * 8 + wave;
    for (int vs = geo.pos; vs < 8; vs += geo.nact) {
        const int sl = vs >> 1, tmul = 2, tadd = vs & 1;
        const unsigned char* slice = tab + (size_t)sl * 2 * MiB + 16 * c;
        const int nws = nw * tmul;
        int t = wr * tmul + tadd;
        if (t >= nrows) continue;
        u32x4 bufA[16], bufB[16], auxA[4], auxB[4]; f32x2 hgA[2], hgB[2]; u32x4 idn[2];
#pragma unroll
        for (int q = 0; q < 2; ++q) idn[q] = *(const u32x4*)(seli + (size_t)t * 128 + 16 * g + 8 * q);
        ex_issue<STAGE>(bufA, auxA, hgA, idn, slice, P, A, wexp, gatev, t, sl, g, c);
        if (t + nws < nrows) {
#pragma unroll
            for (int q = 0; q < 2; ++q) idn[q] = *(const u32x4*)(seli + (size_t)(t + nws) * 128 + 16 * g + 8 * q);
        }
        for (;;) {
            {
                const int t1 = t + nws;
                if (t1 < nrows) {
                    ex_issue<STAGE>(bufB, auxB, hgB, idn, slice, P, A, wexp, gatev, t1, sl, g, c);
                    if (t1 + nws < nrows) {
#pragma unroll
                        for (int q = 0; q < 2; ++q) idn[q] = *(const u32x4*)(seli + (size_t)(t1 + nws) * 128 + 16 * g + 8 * q);
                    }
                }
                ex_compute<STAGE>(bufA, auxA, hgA, P, part, t, sl, lane, g, c);
            }
            t += nws; if (t >= nrows) break;
            {
                const int t1 = t + nws;
                if (t1 < nrows) {
                    ex_issue<STAGE>(bufA, auxA, hgA, idn, slice, P, A, wexp, gatev, t1, sl, g, c);
                    if (t1 + nws < nrows) {
#pragma unroll
                        for (int q = 0; q < 2; ++q) idn[q] = *(const u32x4*)(seli + (size_t)(t1 + nws) * 128 + 16 * g + 8 * q);
                    }
                }
                ex_compute<STAGE>(bufB, auxB, hgB, P, part, t, sl, lane, g, c);
            }
            t += nws; if (t >= nrows) break;
        }
    }
}
DEV void eu_issue_unit(u32x4 (&buf)[16], u32x4 (&xq)[2], const u32x4 (&idn)[2], const unsigned char* tab, const Params& P, int t, int sl, int c) {
    int id[16];
#pragma unroll
    for (int q = 0; q < 2; ++q)
#pragma unroll
        for (int d = 0; d < 4; ++d) { id[8 * q + 2 * d] = (int)(idn[q][d] & 0xffffu); id[8 * q + 2 * d + 1] = (int)(idn[q][d] >> 16); }
    const unsigned char* slice = tab + (size_t)sl * 2 * MiB + 16 * c;
#pragma unroll
    for (int k = 0; k < 16; ++k) buf[k] = *(const u32x4*)(slice + (size_t)id[k] * 128);
    xq[0] = *(const u32x4*)(P.ws + OFF_A8 + (size_t)t * 1024 + 256 * sl + 32 * c); xq[1] = *(const u32x4*)(P.ws + OFF_A8 + (size_t)t * 1024 + 256 * sl + 32 * c + 16);
}
DEV void eu_compute_unit(const u32x4 (&buf)[16], const u32x4 (&xq)[2], LAS float* acc2, int lane) {
    int sx = 0;
#pragma unroll
    for (int q = 0; q < 2; ++q)
#pragma unroll
        for (int d = 0; d < 4; ++d) sx = __builtin_amdgcn_sdot4(0x01010101, (int)xq[q][d], sx, false);
    int p[16];
#pragma unroll
    for (int k = 0; k < 16; ++k) {
        int a = -8 * sx;
#pragma unroll
        for (int d = 0; d < 4; ++d) {
            const unsigned w = buf[k][d];
            a = __builtin_amdgcn_sdot4((int)(w & 0x0F0F0F0Fu), (int)xq[d >> 1][2 * (d & 1)], a, false);
            a = __builtin_amdgcn_sdot4((int)((w >> 4) & 0x0F0F0F0Fu), (int)xq[d >> 1][2 * (d & 1) + 1], a, false);
        }
        p[k] = a;
    }
    bfly_stage<4, 1>(p, lane); bfly_stage<2, 1>(p, lane); bfly_stage<1, 1>(p, lane);
    f32x2 a2 = *(const LAS f32x2*)acc2;
    a2.x += (float)p[0]; a2.y += (float)p[1];
    *(LAS f32x2*)acc2 = a2;
}
DEV void phase_experts_u(const Params& P, int layer, int nrows, ldsp lds0) {
    const unsigned char* tab = P.ws + OFF_TAB + (size_t)(layer * 2) * 16 * MiB;
    const bf16_t* seli = (const bf16_t*)(P.ws + OFF_SELI);
    const float* selg = (const float*)(P.ws + OFF_SELG);
    bf16_t* wexp = (bf16_t*)(P.ws + OFF_WEXP);
    const float* rsu = (const float*)(P.ws + OFF_RSC) + (size_t)(layer * 2) * 16384;
    const float* rsv = rsu + 16384;
    const float* xsv = (const float*)(P.ws + OFF_XS);
    const int tid = tid_fresh(), wave = __builtin_amdgcn_readfirstlane(tid >> 6), lane = tid & 63, g = lane >> 3, c = lane & 7;
    const int gw = blockIdx.x * 8 + wave, nwv = gridDim.x * 8;
    if (gw >= nrows) return;
    const int ntok = (nrows - gw + nwv - 1) / nwv, U = 4 * ntok;
    LAS float* accs = (LAS float*)(launder(lds0) + wave * 8192);
    for (int k = 0; k < ntok; ++k) *(LAS f32x2*)(accs + k * 128 + 2 * lane) = (f32x2){0.f, 0.f};
    u32x4 bufA[16], bufB[16], xqA[2], xqB[2], idn[2];
    int ku = 0, slu = 0;
#define EU_NEXT_IDX() do { const int tt = gw + ku * nwv; _Pragma("unroll") for (int q = 0; q < 2; ++q) idn[q] = *(const u32x4*)(seli + (size_t)tt * 128 + 16 * g + 8 * q); } while (0)
#define EU_ADVANCE() do { if (++ku == ntok) { ku = 0; ++slu; } } while (0)
    EU_NEXT_IDX();
    int kA = ku, slA = slu; eu_issue_unit(bufA, xqA, idn, tab, P, gw + kA * nwv, slA, c); EU_ADVANCE();
    if (U > 1) EU_NEXT_IDX();
    int kB = 0, slB = 0;
    for (int u = 0; u < U; u += 2) {
        if (u + 1 < U) { kB = ku; slB = slu; eu_issue_unit(bufB, xqB, idn, tab, P, gw + kB * nwv, slB, c); EU_ADVANCE(); if (u + 2 < U) EU_NEXT_IDX(); }
        eu_compute_unit(bufA, xqA, accs + kA * 128 + 2 * lane, lane);
        if (u + 1 >= U) break;
        if (u + 2 < U) { kA = ku; slA = slu; eu_issue_unit(bufA, xqA, idn, tab, P, gw + kA * nwv, slA, c); EU_ADVANCE(); if (u + 3 < U) EU_NEXT_IDX(); }
        eu_compute_unit(bufB, xqB, accs + kB * 128 + 2 * lane, lane);
    }
#undef EU_NEXT_IDX
#undef EU_ADVANCE
    for (int k = 0; k < ntok; ++k) {
        const int t = gw + k * nwv;
        const unsigned ep = *(const unsigned*)(seli + (size_t)t * 128 + 2 * lane);
        const f32x2 gt = *(const f32x2*)(selg + (size_t)t * 128 + 2 * lane);
        const f32x2 a2 = *(const LAS f32x2*)(accs + k * 128 + 2 * lane);
        const int e0 = (int)(ep & 0xffffu), e1 = (int)(ep >> 16);
        const float xs = xsv[t];
        const float h0 = a2.x * xs * rsu[e0], h1 = a2.y * xs * rsu[e1];
        const float w0 = gt.x * (0.5f * h0 * (1.f + erff(h0 * 0.70710678118654752f))) * rsv[e0];
        const float w1 = gt.y * (0.5f * h1 * (1.f + erff(h1 * 0.70710678118654752f))) * rsv[e1];
        *(unsigned*)(wexp + (size_t)t * 128 + 2 * lane) = pk2(w0, w1);
    }
}
DEV void ev_issue_unit(u32x4 (&buf)[16], u32x2& hv, u32x4& gt, const u32x4 (&idn)[2], const unsigned char* tab, const Params& P, const float* gatev, int t, int sl, int g, int c) {
    int id[16];
#pragma unroll
    for (int q = 0; q < 2; ++q)
#pragma unroll
        for (int d = 0; d < 4; ++d) { id[8 * q + 2 * d] = (int)(idn[q][d] & 0xffffu); id[8 * q + 2 * d + 1] = (int)(idn[q][d] >> 16); }
    const unsigned char* slice = tab + (size_t)sl * 2 * MiB + 16 * c;
#pragma unroll
    for (int k = 0; k < 16; ++k) buf[k] = *(const u32x4*)(slice + (size_t)id[k] * 128);
    const int col = 256 * sl + 32 * c + 4 * g, m = t < NX ? (t >> 11) : 8;
    hv = *(const u32x2*)(hrow(P, t) + col);
    gt = *(const u32x4*)(gatev + m * 6144 + col);
}
DEV void ev_compute_unit(const u32x4 (&buf)[16], const u32x2 hv, const u32x4 gt, const LAS float* wS, const Params& P, int t, int sl, int lane, int g, int c) {
    f32x2 p2[16];
#pragma unroll
    for (int i = 0; i < 16; ++i) p2[i] = (f32x2){0.f, 0.f};
    f32x4 wq[4];
#pragma unroll
    for (int q = 0; q < 4; ++q) wq[q] = *(const LAS f32x4*)(wS + 4 * q);
#pragma unroll
    for (int k = 0; k < 16; ++k) {
        const float wkf = wq[k >> 2][k & 3];
        const f32x2 w2 = {wkf, wkf};
#pragma unroll
        for (int d = 0; d < 4; ++d) {
            p2[4 * d + 0] += w2 * __builtin_amdgcn_cvt_scalef32_pk_f32_fp4(buf[k][d], 1.0f, 0);
            p2[4 * d + 1] += w2 * __builtin_amdgcn_cvt_scalef32_pk_f32_fp4(buf[k][d], 1.0f, 1);
            p2[4 * d + 2] += w2 * __builtin_amdgcn_cvt_scalef32_pk_f32_fp4(buf[k][d], 1.0f, 2);
            p2[4 * d + 3] += w2 * __builtin_amdgcn_cvt_scalef32_pk_f32_fp4(buf[k][d], 1.0f, 3);
        }
        asm volatile("" : "+v"(p2[0]), "+v"(p2[1]), "+v"(p2[2]), "+v"(p2[3]), "+v"(p2[4]), "+v"(p2[5]), "+v"(p2[6]), "+v"(p2[7]),
                          "+v"(p2[8]), "+v"(p2[9]), "+v"(p2[10]), "+v"(p2[11]), "+v"(p2[12]), "+v"(p2[13]), "+v"(p2[14]), "+v"(p2[15]));
    }
    float p[32];
#pragma unroll
    for (int i = 0; i < 16; ++i) { p[2 * i] = p2[i].x; p[2 * i + 1] = p2[i].y; }
    bfly_swap32<16>(p); bfly_swap16<8>(p); bfly_ror8<4>(p, lane);
    const int col = 256 * sl + 32 * c + 4 * g;
    u32x2 ho;
    ho.x = pk2(bflo(hv.x) + __uint_as_float(gt.x) * p[0], bfhi(hv.x) + __uint_as_float(gt.y) * p[1]);
    ho.y = pk2(bflo(hv.y) + __uint_as_float(gt.z) * p[2], bfhi(hv.y) + __uint_as_float(gt.w) * p[3]);
    *(u32x2*)(hrow(P, t) + col) = ho;
}
DEV void phase_experts(const Params& P, int layer, int nrows, ldsp lds0) {
    const unsigned char* tabu = P.ws + OFF_TAB + (size_t)(layer * 2) * 16 * MiB;
    const unsigned char* tabv = tabu + 16 * MiB;
    const bf16_t* seli = (const bf16_t*)(P.ws + OFF_SELI);
    const float* selg = (const float*)(P.ws + OFF_SELG);
    const float* rsu = (const float*)(P.ws + OFF_RSC) + (size_t)(layer * 2) * 16384;
    const float* rsv = rsu + 16384;
    const float* xsv = (const float*)(P.ws + OFF_XS);
    const float* gatev = (const float*)(P.ws + OFF_MODV) + (size_t)layer * 9 * 6144 + 5 * 1024;
    const int tid = tid_fresh(), wave = __builtin_amdgcn_readfirstlane(tid >> 6), lane = tid & 63, g = lane >> 3, c = lane & 7;
    const int gw = blockIdx.x * 8 + wave, nwv = gridDim.x * 8;
    if (gw >= nrows) return;
    const int ntok = (nrows - gw + nwv - 1) / nwv, U = 4 * ntok;
    LAS float* accs = (LAS float*)(launder(lds0) + wave * 8192);
    for (int k = 0; k < ntok; ++k) *(LAS f32x2*)(accs + k * 128 + 2 * lane) = (f32x2){0.f, 0.f};
    u32x4 bufA[16], bufB[16], idn[2];
    int ku = 0, slu = 0;
#define EU_NEXT_IDX() do { const int tt = gw + ku * nwv; _Pragma("unroll") for (int q = 0; q < 2; ++q) idn[q] = *(const u32x4*)(seli + (size_t)tt * 128 + 16 * g + 8 * q); } while (0)
#define EU_ADVANCE() do { if (++ku == ntok) { ku = 0; ++slu; } } while (0)
    int kA, slA, kB = 0, slB = 0;
    {
        u32x4 xqA[2], xqB[2];
        EU_NEXT_IDX();
        kA = ku; slA = slu; eu_issue_unit(bufA, xqA, idn, tabu, P, gw + kA * nwv, slA, c); EU_ADVANCE();
        if (U > 1) EU_NEXT_IDX();
        for (int u = 0; u < U; u += 2) {
            if (u + 1 < U) { kB = ku; slB = slu; eu_issue_unit(bufB, xqB, idn, tabu, P, gw + kB * nwv, slB, c); EU_ADVANCE(); if (u + 2 < U) EU_NEXT_IDX(); }
            eu_compute_unit(bufA, xqA, accs + kA * 128 + 2 * lane, lane);
            if (u + 1 >= U) break;
            if (u + 2 < U) { kA = ku; slA = slu; eu_issue_unit(bufA, xqA, idn, tabu, P, gw + kA * nwv, slA, c); EU_ADVANCE(); if (u + 3 < U) EU_NEXT_IDX(); }
            eu_compute_unit(bufB, xqB, accs + kB * 128 + 2 * lane, lane);
        }
    }
    u32x2 hvA, hvB; u32x4 gtA, gtB;
    ku = 0; slu = 0;
    EU_NEXT_IDX();
    kA = ku; slA = slu; ev_issue_unit(bufA, hvA, gtA, idn, tabv, P, gatev, gw + kA * nwv, slA, g, c); EU_ADVANCE();
    if (U > 1) EU_NEXT_IDX();
    for (int k = 0; k < ntok; ++k) {
        const int t = gw + k * nwv;
        const unsigned ep = *(const unsigned*)(seli + (size_t)t * 128 + 2 * lane);
        const f32x2 gt = *(const f32x2*)(selg + (size_t)t * 128 + 2 * lane);
        const f32x2 a2 = *(const LAS f32x2*)(accs + k * 128 + 2 * lane);
        const int e0 = (int)(ep & 0xffffu), e1 = (int)(ep >> 16);
        const float xs = xsv[t];
        const float h0 = a2.x * xs * rsu[e0], h1 = a2.y * xs * rsu[e1];
        f32x2 w;
        w.x = gt.x * (0.5f * h0 * (1.f + erff(h0 * 0.70710678118654752f))) * rsv[e0];
        w.y = gt.y * (0.5f * h1 * (1.f + erff(h1 * 0.70710678118654752f))) * rsv[e1];
        *(LAS f32x2*)(accs + k * 128 + 2 * lane) = w;
    }
    for (int u = 0; u < U; u += 2) {
        if (u + 1 < U) { kB = ku; slB = slu; ev_issue_unit(bufB, hvB, gtB, idn, tabv, P, gatev, gw + kB * nwv, slB, g, c); EU_ADVANCE(); if (u + 2 < U) EU_NEXT_IDX(); }
        ev_compute_unit(bufA, hvA, gtA, accs + kA * 128 + 16 * g, P, gw + kA * nwv, slA, lane, g, c);
        if (u + 1 >= U) break;
        if (u + 2 < U) { kA = ku; slA = slu; ev_issue_unit(bufA, hvA, gtA, idn, tabv, P, gatev, gw + kA * nwv, slA, g, c); EU_ADVANCE(); if (u + 3 < U) EU_NEXT_IDX(); }
        ev_compute_unit(bufB, hvB, gtB, accs + kB * 128 + 16 * g, P, gw + kB * nwv, slB, lane, g, c);
    }
#undef EU_NEXT_IDX
#undef EU_ADVANCE
}
DEV void phase_experts_act(const Params& P, int layer, int nrows) {
    const bf16_t* seli = (const bf16_t*)(P.ws + OFF_SELI);
    const float* selg = (const float*)(P.ws + OFF_SELG);
    const float* part = (const float*)(P.ws + OFF_PART);
    bf16_t* wexp = (bf16_t*)(P.ws + OFF_WEXP);
    const float* rsu = (const float*)(P.ws + OFF_RSC) + (size_t)(layer * 2) * 16384;
    const float* rsv = rsu + 16384;
    const int tid = tid_fresh();
    const int n4 = nrows * 32;
    for (int i4 = blockIdx.x * NTHREADS + tid; i4 < n4; i4 += gridDim.x * NTHREADS) {
        const size_t idx = (size_t)i4 * 4;
        f32x4 h = {0.f, 0.f, 0.f, 0.f};
#pragma unroll
        for (int s = 0; s < 4; ++s) { const u32x2 pv = *(const u32x2*)((const bf16_t*)part + (size_t)s * NT * 128 + idx); h += (f32x4){bflo(pv.x), bfhi(pv.x), bflo(pv.y), bfhi(pv.y)}; }
        const u32x2 e = *(const u32x2*)(seli + idx);
        const f32x4 gt = *(const f32x4*)(selg + idx);
        const int ee[4] = {(int)(e.x & 0xffffu), (int)(e.x >> 16), (int)(e.y & 0xffffu), (int)(e.y >> 16)};
        f32x4 o;
#pragma unroll
        for (int q = 0; q < 4; ++q) {
            const float hh = h[q] * rsu[ee[q]];
            o[q] = gt[q] * (0.5f * hh * (1.f + erff(hh * 0.70710678118654752f))) * rsv[ee[q]];
        }
        u32x2 ow; ow.x = pk2(o[0], o[1]); ow.y = pk2(o[2], o[3]);
        *(u32x2*)(wexp + idx) = ow;
    }
}
DEV void phase_final(const Params& P) {
    const int tid = tid_fresh(), wave = tid >> 6, lane = tid & 63;
    for (int r = blockIdx.x * 8 + wave; r < NX; r += gridDim.x * 8) {
        float* h = P.out + (size_t)r * 1024;
        f32x4 v[4]; float ss = 0.f;
#pragma unroll
        for (int j = 0; j < 4; ++j) { const u32x2 hv = *(const u32x2*)(hrow(P, r) + j * 256 + lane * 4); v[j] = (f32x4){bflo(hv.x), bfhi(hv.x), bflo(hv.y), bfhi(hv.y)};
            ss += v[j].x * v[j].x + v[j].y * v[j].y + v[j].z * v[j].z + v[j].w * v[j].w; }
        ss = wave_sum(ss);
        const float rstd = rsqrtf(ss * (1.f / 1024.f) + EPS);
#pragma unroll
        for (int j = 0; j < 4; ++j) { const f32x4 gg = *(const f32x4*)(P.final_g + j * 256 + lane * 4); __builtin_nontemporal_store(v[j] * rstd * gg, (f32x4*)(h + j * 256 + lane * 4)); }
    }
}

DEV void phase_conv(const Params& P) {
    const bf16_t* Pq = (const bf16_t*)(P.ws + OFF_R1);
    const float* ab = (const float*)(P.ws + OFF_AB);
    bf16_t* dst[3] = {(bf16_t*)(P.ws + OFF_QC), (bf16_t*)(P.ws + OFF_KC), (bf16_t*)(P.ws + OFF_VC)};
    float* gbuf = (float*)(P.ws + OFF_G);
    float* bbuf = (float*)(P.ws + OFF_BETA);
    const int tid = tid_fresh(), wave = tid >> 6, lane = tid & 63;
    constexpr int NSEG = NT / 16;
    for (int item = blockIdx.x * 8 + wave; item < NSEG * 6; item += gridDim.x * 8) {
        const int seg = item / 6, jc = item - seg * 6, row0 = seg * 16;
        int t0, L;
        if (row0 < NX) { t0 = row0 & 2047; L = 2048; } else { t0 = (row0 - NX) & 255; L = 256; }
        const int chunk = lane + 64 * jc, col = chunk * 8, part = jc >> 1;
        f32x4 w0[5], w1[5];
#pragma unroll
        for (int tap = 0; tap < 5; ++tap) { w0[tap] = *(const f32x4*)(P.dn_conv_w + tap * 3072 + col); w1[tap] = *(const f32x4*)(P.dn_conv_w + tap * 3072 + col + 4); }
        u32x4 raw[20];
#pragma unroll
        for (int i = 0; i < 20; ++i) {
            const int tt = t0 + i - 2;
            const bool ok = tt >= 0 && tt < L;
            const u32x4 v = *(const u32x4*)(Pq + (size_t)(row0 + (ok ? i - 2 : 0)) * 3072 + col);
            raw[i] = ok ? v : (u32x4){0u, 0u, 0u, 0u};
        }
        const float qs = part == 0 ? 0.08838834764831845f : 1.f;
        bf16_t* dp = dst[part] + (size_t)row0 * 1024 + (chunk & 127) * 8;
#pragma unroll
        for (int i = 0; i < 16; ++i) {
            float acc[8];
#pragma unroll
            for (int e = 0; e < 8; ++e) acc[e] = 0.f;
#pragma unroll
            for (int tap = 0; tap < 5; ++tap) {
                float f[8]; unpack8(raw[i + tap], f);
                acc[0] += f[0] * w0[tap].x; acc[1] += f[1] * w0[tap].y; acc[2] += f[2] * w0[tap].z; acc[3] += f[3] * w0[tap].w;
                acc[4] += f[4] * w1[tap].x; acc[5] += f[5] * w1[tap].y; acc[6] += f[6] * w1[tap].z; acc[7] += f[7] * w1[tap].w;
            }
            float ss = 0.f;
#pragma unroll
            for (int e = 0; e < 8; ++e) { acc[e] = silu(acc[e]); ss += acc[e] * acc[e]; }
            if (part < 2) {
                ss = sum16(ss);
                const float rn = rsqrtf(ss + EPS) * qs;
#pragma unroll
                for (int e = 0; e < 8; ++e) acc[e] *= rn;
            }
            u32x4 o; o.x = pk2(acc[0], acc[1]); o.y = pk2(acc[2], acc[3]); o.z = pk2(acc[4], acc[5]); o.w = pk2(acc[6], acc[7]);
            *(u32x4*)(dp + (size_t)i * 1024) = o;
        }
        if (jc == 0) {
            const int cc = lane & 31, d = cc >> 4, sx = (cc >> 3) & 1, h = cc & 7;
            const float a = __expf(P.dn_a_log[d * 8 + h]), dtb = P.dn_dt_bias[d * 8 + h];
            float v[8];
#pragma unroll
            for (int q = 0; q < 8; ++q) v[q] = ab[(size_t)(row0 + 2 * q + (lane >> 5)) * 32 + cc];
#pragma unroll
            for (int q = 0; q < 8; ++q) {
                const int row = row0 + 2 * q + (lane >> 5);
                if (sx == 0) {
                    const float xx = v[q] + dtb;
                    const float ex = __expf(fminf(xx, 30.f)), u = 1.f + ex;
                    const float l1p = (u == 1.f) ? ex : __logf(u) * ex * __builtin_amdgcn_rcpf(u - 1.f);
                    const float sp = xx > 20.f ? xx : l1p;
                    gbuf[((size_t)d * NT + row) * 8 + h] = -a * sp;
                } else {
                    bbuf[((size_t)d * NT + row) * 8 + h] = __builtin_amdgcn_rcpf(1.f + __expf(-v[q]));
                }
            }
        }
    }
}

DEV int chunk_rowbase(int b, int d, int n) {
    if (n < 4) { const int m = d ? 3 - n : n; return NX + b * 256 + m * 64; }
    const int m = d ? 31 - (n - 4) : n - 4; return b * 2048 + m * 64;
}

DEV bf16x8 frag_col_x(ldsp x, int c0, int k0, int lane) {
    const int col = c0 + (lane & 31), ch = col >> 3, sub = (col & 7) * 2;
    bf16x8 f;
#pragma unroll
    for (int j = 0; j < 8; ++j) { const int row = k0 + 8 * (lane >> 5) + j; f[j] = (short)*(const LAS bf16_t*)(x + row * 256 + ((ch ^ (row & 15)) << 4) + sub); }
    return f;
}
DEV void tile_rows8(const f32x16& acc, u32x4& o0, u32x4& o1) {
    unsigned p[4][2];
#pragma unroll
    for (int rg = 0; rg < 4; ++rg) { p[rg][0] = pk2(acc[rg * 4 + 0], acc[rg * 4 + 1]); p[rg][1] = pk2(acc[rg * 4 + 2], acc[rg * 4 + 3]); }
    const auto s00 = __builtin_amdgcn_permlane32_swap(p[0][0], p[2][0], false, false), s01 = __builtin_amdgcn_permlane32_swap(p[0][1], p[2][1], false, false);
    const auto s10 = __builtin_amdgcn_permlane32_swap(p[1][0], p[3][0], false, false), s11 = __builtin_amdgcn_permlane32_swap(p[1][1], p[3][1], false, false);
    o0 = (u32x4){s00[0], s01[0], s00[1], s01[1]};
    o1 = (u32x4){s10[0], s11[0], s10[1], s11[1]};
}
DEV bf16x8 frag_row_t(ldsp t, int r0, int k0, int lane) {
    const int row = r0 + (lane & 31), ch = (k0 >> 3) + (lane >> 5);
    return *(const LAS bf16x8*)(t + row * 128 + ((ch ^ (row & 7)) << 4));
}
DEV void phase_chunk(const Params& P, ldsp lds0) {
    const bf16_t* kc = (const bf16_t*)(P.ws + OFF_KC);
    const bf16_t* vc = (const bf16_t*)(P.ws + OFF_VC);
    const float* gbuf = (const float*)(P.ws + OFF_G);
    const float* bbuf = (const float*)(P.ws + OFF_BETA);
    bf16_t* wbuf = (bf16_t*)(P.ws + OFF_WBUF);
    bf16_t* ubuf = (bf16_t*)(P.ws + OFF_UBUF);
    float* gcbuf = (float*)(P.ws + OFF_GC);
    const int tid = tid_fresh(), lane = tid & 63, wave = tid >> 6, team = wave >> 1, tw = wave & 1, ttid = tid & 127;
    const int nteams = gridDim.x * 4, niter = (4608 + nteams - 1) / nteams;
    u32x4 rk[8];
    {
        const int item0 = min((int)(blockIdx.x * 4 + team), 4607);
        const int n = item0 % 36, d = (item0 / 36) & 1, bh = item0 / 72, rb0 = chunk_rowbase(bh >> 3, d, n);
#pragma unroll
        for (int j = 0; j < 8; ++j) { const int cid = ttid + 128 * j, i = cid >> 4, ch = cid & 15; rk[j] = *(const u32x4*)(kc + ((size_t)rb0 + (d ? 63 - i : i)) * 1024 + (bh & 7) * 128 + ch * 8); }
    }
    for (int it = 0; it < niter; ++it) {
        const int item = it * nteams + blockIdx.x * 4 + team;
        const bool act = item < 4608;
        const ldsp lds = launder(lds0);
        const ldsp sX = lds + team * 32768;
        const ldsp sT = sX + 16384;
        LAS float* sA = (LAS float*)sT;
        LAS float* sg = (LAS float*)(lds + 131072 + 128 + team * 768);
        const int n = item % 36, d = (item / 36) & 1, bh = item / 72, b = bh >> 3, h = bh & 7;
        const int rowbase = act ? chunk_rowbase(b, d, n) : 0;
        if (act) {
#pragma unroll
            for (int j = 0; j < 8; ++j) { const int cid = ttid + 128 * j, i = cid >> 4, ch = cid & 15; *(LAS u32x4*)(sX + i * 256 + ((ch ^ (i & 15)) << 4)) = rk[j]; }
            if (tw == 0) {
                const size_t grow = (size_t)rowbase + (d ? 63 - lane : lane);
                float v = gbuf[((size_t)d * NT + grow) * 8 + h];
#pragma unroll
                for (int o = 1; o < 64; o <<= 1) { const float t = __shfl_up(v, o); if (lane >= o) v += t; }
                sg[lane] = v; sg[64 + lane] = bbuf[((size_t)d * NT + grow) * 8 + h];
            }
        }
        __syncthreads();
        if (act) {
#pragma unroll 1
            for (int q = 0; q < 2; ++q) {
                const int mt = tw, nt = q;
                f32x16 acc = zero16();
#pragma unroll 4
                for (int ks = 0; ks < 8; ++ks) acc = mfma32(frag_row_x(sX, mt * 32, ks * 16, lane), frag_row_x(sX, nt * 32, ks * 16, lane), acc);
#pragma unroll
                for (int reg = 0; reg < 16; ++reg) {
                    const int i = mt * 32 + crow(reg, lane), j = nt * 32 + (lane & 31);
                    sA[i * 64 + j] = (i > j) ? sg[64 + i] * acc[reg] * __expf(sg[i] - sg[j]) : 0.f;
                }
            }
        }
        __syncthreads();
        if (act && tw == 0) {
            float t[64];
            int ln = lane; asm volatile("" : "+v"(ln));
#pragma unroll
            for (int i = 0; i < 64; ++i) {
                float a0 = (i == ln) ? 1.f : 0.f, a1 = 0.f, a2 = 0.f, a3 = 0.f;
#pragma unroll
                for (int j = 0; j < i; j += 4) {
                    const f32x4 av = *(const LAS f32x4*)(sA + i * 64 + j);
                    a0 -= av.x * t[j];
                    if (j + 1 < i) a1 -= av.y * t[j + 1];
                    if (j + 2 < i) a2 -= av.z * t[j + 2];
                    if (j + 3 < i) a3 -= av.w * t[j + 3];
                }
                t[i] = (a0 + a1) + (a2 + a3);
                __builtin_amdgcn_sched_barrier(0);
            }
            const float cu = sg[64 + lane], cw = cu * __expf(sg[lane]);
            const int ch = lane >> 3, sub = (lane & 7) * 2;
#pragma unroll
            for (int i = 0; i < 64; ++i) {
                const int off = i * 128 + ((ch ^ (i & 7)) << 4) + sub;
                *(LAS bf16_t*)(sT + off) = f2bf(t[i] * cw);
                *(LAS bf16_t*)(sT + 8192 + off) = f2bf(t[i] * cu);
                if ((i & 7) == 7) __builtin_amdgcn_sched_barrier(0);
            }
        }
        __syncthreads();
            {
                const int itemn = min(item + nteams, 4607);
                const int nn = itemn % 36, dn = (itemn / 36) & 1, bhn = itemn / 72, rbn = chunk_rowbase(bhn >> 3, dn, nn);
#pragma unroll
                for (int j = 0; j < 8; ++j) { const int cid = ttid + 128 * j, i = cid >> 4, ch = cid & 15; rk[j] = *(const u32x4*)(kc + ((size_t)rbn + (dn ? 63 - i : i)) * 1024 + (bhn & 7) * 128 + ch * 8); }
            }
        u32x4 rv[8];
        if (act) {
#pragma unroll
            for (int j = 0; j < 8; ++j) {
                const int cid = ttid + 128 * j, i = cid >> 4, ch = cid & 15;
                const size_t grow = (size_t)rowbase + (d ? 63 - i : i);
                rv[j] = *(const u32x4*)(vc + grow * 1024 + h * 128 + ch * 8);
            }
#pragma unroll 1
            for (int q = 0; q < 2; ++q) {
                const int mtk = 2 * tw + q;
                f32x16 acc[2]; acc[0] = zero16(); acc[1] = zero16();
#pragma unroll
                for (int ks = 0; ks < 4; ++ks) {
                    const bf16x8 afr = frag_col_x(sX, mtk * 32, ks * 16, lane);
#pragma unroll
                    for (int it2 = 0; it2 < 2; ++it2) acc[it2] = mfma32(afr, frag_row_t(sT, it2 * 32, ks * 16, lane), acc[it2]);
                }
                bf16_t* dstp = wbuf + (size_t)item * 8192;
#pragma unroll
                for (int it2 = 0; it2 < 2; ++it2) {
                    u32x4 o0, o1; tile_rows8(acc[it2], o0, o1);
                    bf16_t* rp = dstp + (it2 * 32 + (lane & 31)) * 128 + mtk * 32 + 16 * (lane >> 5);
                    *(u32x4*)rp = o0; *(u32x4*)(rp + 8) = o1;
                }
            }
        }
        __syncthreads();
        if (act) {
#pragma unroll
            for (int j = 0; j < 8; ++j) { const int cid = ttid + 128 * j, i = cid >> 4, ch = cid & 15; *(LAS u32x4*)(sX + i * 256 + ((ch ^ (i & 15)) << 4)) = rv[j]; }
        }
        __syncthreads();
        if (act) {
#pragma unroll 1
            for (int q = 0; q < 2; ++q) {
                const int nt = 2 * tw + q;
                f32x16 acc[2]; acc[0] = zero16(); acc[1] = zero16();
#pragma unroll
                for (int ks = 0; ks < 4; ++ks) {
                    const bf16x8 bfr = frag_col_x(sX, nt * 32, ks * 16, lane);
#pragma unroll
                    for (int mt = 0; mt < 2; ++mt) acc[mt] = mfma32(frag_row_t(sT + 8192, mt * 32, ks * 16, lane), bfr, acc[mt]);
                }
                bf16_t* dstp = ubuf + (size_t)item * 8192;
#pragma unroll
                for (int mt = 0; mt < 2; ++mt) {
                    u32x4 o0, o1; tile_rows8(acc[mt], o0, o1);
                    bf16_t* rp = dstp + (nt * 32 + (lane & 31)) * 64 + mt * 32 + 16 * (lane >> 5);
                    *(u32x4*)rp = o0; *(u32x4*)(rp + 8) = o1;
                }
            }
            if (tw == 0) gcbuf[(size_t)item * 64 + lane] = sg[lane];
        }
        __syncthreads();
    }
}

DEV u32x2 pack4(float a, float b, float c, float d) { u32x2 o; o.x = pk2(a, b); o.y = pk2(c, d); return o; }
DEV void phase_scan(const Params& P, ldsp lds0) {
    const bf16_t* qc = (const bf16_t*)(P.ws + OFF_QC);
    const bf16_t* kc = (const bf16_t*)(P.ws + OFF_KC);
    const bf16_t* wbuf = (const bf16_t*)(P.ws + OFF_WBUF);
    const bf16_t* ubuf = (const bf16_t*)(P.ws + OFF_UBUF);
    const float* gcbuf = (const float*)(P.ws + OFF_GC);
    bf16_t* obuf = (bf16_t*)(P.ws + OFF_OBUF);
    const int tid = tid_fresh(), lane = tid & 63, wave = tid >> 6;
    const int mt = wave >> 1, nt = wave & 1;
    const int mt2 = (wave & 3) >> 1, nt2 = wave & 1;
    for (int item = blockIdx.x; item < 256; item += gridDim.x) {
        const int half = item & 1, d = (item >> 1) & 1, bh = item >> 2, b = bh >> 3, h = bh & 7;
        f32x16 S = zero16();
        { LAS unsigned* z = (LAS unsigned*)(lds0 + 1024 + 3 * 17408 + 9216); for (int e = tid; e < 64 * 136 / 2; e += NTHREADS) z[e] = 0u; }
        u32x4 rW[2][2], rK[2][2], rQ[2][2], rU[2]; float rG[2] = {0.f, 0.f};
#pragma unroll
        for (int u = 0; u < 2; ++u) {
            const int citem = (bh * 2 + d) * 36 + u, rowbase = chunk_rowbase(b, d, u);
#pragma unroll
            for (int j = 0; j < 2; ++j) {
                const int cid = tid + NTHREADS * j, i = cid >> 4, ch = cid & 15;
                const size_t grow = (size_t)rowbase + (d ? 63 - i : i);
                rW[u][j] = *(const u32x4*)(wbuf + (size_t)citem * 8192 + i * 128 + ch * 8);
                rK[u][j] = *(const u32x4*)(kc + grow * 1024 + h * 128 + ch * 8);
                rQ[u][j] = rK[u][j];
            }
            { const int dvr = tid >> 3, ch = tid & 7; rU[u] = *(const u32x4*)(ubuf + (size_t)citem * 8192 + (half * 64 + dvr) * 64 + ch * 8); }
            if (tid < 64) rG[u] = gcbuf[(size_t)citem * 64 + tid];
        }
        for (int n2 = 0; n2 < 36; n2 += 2) {
#pragma unroll
        for (int u = 0; u < 2; ++u) {
            const int n = n2 + u;
            const ldsp lds = launder(lds0);
            int ln = lane; asm volatile("" : "+v"(ln));
            LAS float* sg = (LAS float*)lds;
            LAS bf16_t* sW = (LAS bf16_t*)(lds + 1024);
            LAS bf16_t* sK = sW + 64 * 136;
            LAS bf16_t* sQ = sK + 64 * 136;
            LAS bf16_t* sU = sQ + 64 * 136;
            LAS bf16_t* sST = sU + 64 * 72;
            LAS bf16_t* sVNT = sST + 64 * 136;
            LAS bf16_t* sVNsT = sVNT + 64 * 72;
            LAS bf16_t* sATT = sVNsT + 64 * 72;
            LAS bf16_t* sO = sATT + 64 * 72;
            const int rowbase = chunk_rowbase(b, d, n);
            const bool wantO = n >= 4;
#pragma unroll
            for (int j = 0; j < 2; ++j) {
                const int cid = tid + NTHREADS * j, i = cid >> 4, ch = cid & 15;
                *(LAS u32x4*)(sW + i * 136 + ch * 8) = rW[u][j];
                *(LAS u32x4*)(sK + i * 136 + ch * 8) = rK[u][j];
                *(LAS u32x4*)(sQ + i * 136 + ch * 8) = rQ[u][j];
            }
            { const int i = tid >> 3, ch = tid & 7; *(LAS u32x4*)(sU + i * 72 + ch * 8) = rU[u]; }
            if (tid < 64) sg[tid] = rG[u];
            __syncthreads();
            if (n + 2 < 36) {
                const int citem = (bh * 2 + d) * 36 + n + 2, rb1 = chunk_rowbase(b, d, n + 2);
                const bool wq = n + 2 >= 4;
#pragma unroll
                for (int j = 0; j < 2; ++j) {
                    const int cid = tid + NTHREADS * j, i = cid >> 4, ch = cid & 15;
                    const size_t grow = (size_t)rb1 + (d ? 63 - i : i);
                    rW[u][j] = *(const u32x4*)(wbuf + (size_t)citem * 8192 + i * 128 + ch * 8);
                    rK[u][j] = *(const u32x4*)(kc + grow * 1024 + h * 128 + ch * 8);
                    if (wq) rQ[u][j] = *(const u32x4*)(qc + grow * 1024 + h * 128 + ch * 8);
                }
                { const int dvr = tid >> 3, ch = tid & 7; rU[u] = *(const u32x4*)(ubuf + (size_t)citem * 8192 + (half * 64 + dvr) * 64 + ch * 8); }
                if (tid < 64) rG[u] = gcbuf[(size_t)citem * 64 + tid];
            }
            const float g63 = sg[63];
            if (wave < 4) {
                const int dv = nt2 * 32 + (ln & 31);
                float uf[16], ef[16];
#pragma unroll
                for (int rg = 0; rg < 4; ++rg) {
                    const int i0 = mt2 * 32 + 8 * rg + 4 * (ln >> 5);
                    const u32x2 uu = *(const LAS u32x2*)(sU + dv * 72 + i0);
                    const f32x4 gg = *(const LAS f32x4*)(sg + i0);
                    uf[rg * 4 + 0] = bflo(uu.x); uf[rg * 4 + 1] = bfhi(uu.x); uf[rg * 4 + 2] = bflo(uu.y); uf[rg * 4 + 3] = bfhi(uu.y);
#pragma unroll
                    for (int e = 0; e < 4; ++e) ef[rg * 4 + e] = __expf(g63 - gg[e]);
                }
                f32x16 acc = zero16(), accb = zero16();
#pragma unroll
                for (int ks = 0; ks < 8; ks += 2) { acc = mfma32(frag_row(sW, 136, mt2 * 32, ks * 16, ln), frag_row(sST, 136, nt2 * 32, ks * 16, ln), acc);
                    accb = mfma32(frag_row(sW, 136, mt2 * 32, ks * 16 + 16, ln), frag_row(sST, 136, nt2 * 32, ks * 16 + 16, ln), accb); }
#pragma unroll
                for (int rg = 0; rg < 4; ++rg) {
                    const int i0 = mt2 * 32 + 8 * rg + 4 * (ln >> 5);
                    float v[4], vs[4];
#pragma unroll
                    for (int e = 0; e < 4; ++e) { v[e] = uf[rg * 4 + e] - (acc[rg * 4 + e] + accb[rg * 4 + e]); vs[e] = v[e] * ef[rg * 4 + e]; }
                    *(LAS u32x2*)(sVNT + dv * 72 + i0) = pack4(v[0], v[1], v[2], v[3]);
                    *(LAS u32x2*)(sVNsT + dv * 72 + i0) = pack4(vs[0], vs[1], vs[2], vs[3]);
                }
            } else if (wantO) {
                const int i = nt2 * 32 + (ln & 31);
                const float gi = sg[i];
                float df[16];
#pragma unroll
                for (int rg = 0; rg < 4; ++rg) {
                    const int j0 = mt2 * 32 + 8 * rg + 4 * (ln >> 5);
                    const f32x4 gg = *(const LAS f32x4*)(sg + j0);
#pragma unroll
                    for (int e = 0; e < 4; ++e) df[rg * 4 + e] = (i >= j0 + e) ? __expf(fminf(gi - gg[e], 0.f)) : 0.f;
                }
                f32x16 acc = zero16(), accb = zero16();
#pragma unroll
                for (int ks = 0; ks < 8; ks += 2) { acc = mfma32(frag_row(sK, 136, mt2 * 32, ks * 16, ln), frag_row(sQ, 136, nt2 * 32, ks * 16, ln), acc);
                    accb = mfma32(frag_row(sK, 136, mt2 * 32, ks * 16 + 16, ln), frag_row(sQ, 136, nt2 * 32, ks * 16 + 16, ln), accb); }
#pragma unroll
                for (int rg = 0; rg < 4; ++rg) {
                    const int j0 = mt2 * 32 + 8 * rg + 4 * (ln >> 5);
                    float v[4];
#pragma unroll
                    for (int e = 0; e < 4; ++e) v[e] = (acc[rg * 4 + e] + accb[rg * 4 + e]) * df[rg * 4 + e];
                    *(LAS u32x2*)(sATT + i * 72 + j0) = pack4(v[0], v[1], v[2], v[3]);
                }
            }
            __syncthreads();
            if (wave < 4 && wantO) {
                float eg[16];
#pragma unroll
                for (int rg = 0; rg < 4; ++rg) {
                    const f32x4 gg = *(const LAS f32x4*)(sg + mt2 * 32 + 8 * rg + 4 * (ln >> 5));
#pragma unroll
                    for (int e = 0; e < 4; ++e) eg[rg * 4 + e] = __expf(gg[e]);
                }
                f32x16 a1 = zero16(), a1b = zero16(), a2 = zero16();
#pragma unroll
                for (int ks = 0; ks < 8; ks += 2) { a1 = mfma32(frag_row(sQ, 136, mt2 * 32, ks * 16, ln), frag_row(sST, 136, nt2 * 32, ks * 16, ln), a1);
                    a1b = mfma32(frag_row(sQ, 136, mt2 * 32, ks * 16 + 16, ln), frag_row(sST, 136, nt2 * 32, ks * 16 + 16, ln), a1b); }
#pragma unroll
                for (int ks = 0; ks < 4; ++ks) a2 = mfma32(frag_row(sATT, 72, mt2 * 32, ks * 16, ln), frag_row(sVNT, 72, nt2 * 32, ks * 16, ln), a2);
                const int dv = nt2 * 32 + (ln & 31);
#pragma unroll
                for (int rg = 0; rg < 4; ++rg) {
                    const int i0 = mt2 * 32 + 8 * rg + 4 * (ln >> 5);
#pragma unroll
                    for (int e = 0; e < 4; ++e) sO[(i0 + e) * 72 + dv] = f2bf((a1[rg * 4 + e] + a1b[rg * 4 + e]) * eg[rg * 4 + e] + a2[rg * 4 + e]);
                }
            }
            {
                const float gl = __expf(g63);
#pragma unroll
                for (int reg = 0; reg < 16; ++reg) S[reg] *= gl;
#pragma unroll
                for (int ks = 0; ks < 4; ++ks) S = mfma32(frag_col_tr(sK, 136, mt * 32, ks * 16, ln), frag_row(sVNsT, 72, nt * 32, ks * 16, ln), S);
            }
            __syncthreads();
            if (wantO) {
                const int i = tid >> 3, ch = tid & 7;
                const size_t grow = (size_t)rowbase + (d ? 63 - i : i);
                *(u32x4*)(obuf + ((size_t)d * NX + grow) * 1024 + h * 128 + half * 64 + ch * 8) = *(const LAS u32x4*)(sO + i * 72 + ch * 8);
            }
#pragma unroll
            for (int rg = 0; rg < 4; ++rg) {
                const int dk0 = mt * 32 + 8 * rg + 4 * (ln >> 5);
                *(LAS u32x2*)(sST + (nt * 32 + (ln & 31)) * 136 + dk0) = pack4(S[rg * 4 + 0], S[rg * 4 + 1], S[rg * 4 + 2], S[rg * 4 + 3]);
            }
        }
        }
        __syncthreads();
    }
}

DEV void phase_dnout(const Params& P) {
    const bf16_t* obuf = (const bf16_t*)(P.ws + OFF_OBUF);
    const bf16_t* Pz = (const bf16_t*)(P.ws + OFF_PZ);
    bf16_t* A = (bf16_t*)(P.ws + OFF_A);
    const int tid = tid_fresh(); const int wave = tid >> 6, lane = tid & 63;
    for (int row = blockIdx.x * 8 + wave; row < NX; row += gridDim.x * 8) {
#pragma unroll
        for (int c = 0; c < 2; ++c) {
            const int col = c * 512 + lane * 8;
            const u32x4 of = *(const u32x4*)(obuf + (size_t)row * 1024 + col), ob = *(const u32x4*)(obuf + ((size_t)NX + row) * 1024 + col);
            const u32x4 zz = *(const u32x4*)(Pz + (size_t)row * 1024 + col);
            float o[8], o2[8], z[8]; unpack8(of, o); unpack8(ob, o2); unpack8(zz, z);
            float ss = 0.f;
#pragma unroll
            for (int e = 0; e < 8; ++e) { o[e] += o2[e]; ss += o[e] * o[e]; }
            ss = sum16(ss);
            const float rn = rsqrtf(ss * (1.f / 128.f) + EPS);
            float y[8];
#pragma unroll
            for (int e = 0; e < 8; ++e) y[e] = o[e] * rn * P.dn_norm_g[(col & 127) + e] * silu(z[e]);
            u32x4 ov; ov.x = pk2(y[0], y[1]); ov.y = pk2(y[2], y[3]); ov.z = pk2(y[4], y[5]); ov.w = pk2(y[6], y[7]);
            *(u32x4*)(A + (size_t)row * 1024 + col) = ov;
        }
    }
}

namespace pg8 {
#define PG8_LAS __attribute__((address_space(3)))
typedef unsigned short bf16_t;
typedef short bf16x8 __attribute__((ext_vector_type(8)));
typedef float f32x4 __attribute__((ext_vector_type(4)));
typedef unsigned u32x4 __attribute__((ext_vector_type(4)));
constexpr int BM = 256, BK = 64, HALF = 128, HTB = HALF * BK * 2  , STAGE_BYTES = 8 * HTB, NXCD = 8, WGM = 8;

__host__ __device__ __forceinline__ int lds_byte(int r, int c) { const int st = (r >> 4) * 2 + (c >> 5), rr = r & 15, cc = c & 31, ob = rr * 64 + cc * 2; return st * 1024 + (ob ^ (((ob >> 9) & 1) << 5)); }
__host__ __device__ __forceinline__ void stage_rc(int b, int& R, int& C) { const int st = b / 1024, sb = b % 1024, swz = sb ^ (((sb >> 9) & 1) << 5); R = (st >> 1) * 16 + swz / 64; C = (st & 1) * 32 + (swz % 64) / 2; }
__host__ __device__ __forceinline__ int perm32(int rho) { const int n = rho >> 4, i = rho & 15; return 8 * (i >> 2) + 4 * n + (i & 3); }

struct Unit { int pm, pn; };
struct Gemm { const bf16_t* A; const bf16_t* Bt; int M, N, K; };

struct StaticOrder {
    int nM, nN, nwg, G, c;
    __host__ __device__ void init(int M, int N, int G_, int c_) { nM = M / BM; nN = N / BM; nwg = nM * nN; G = G_; c = c_; }
    __host__ __device__ bool next(int i, Unit& u) const {
        const long L = (long)i * G + c; if (L >= nwg) return false;
        int wgid = (int)L; { const int q = nwg / NXCD, r = nwg % NXCD, xcd = wgid % NXCD, off = wgid / NXCD; wgid = (xcd < r ? xcd * (q + 1) : r * (q + 1) + (xcd - r) * q) + off; }
        const int nig = WGM * nN, gid = wgid / nig, fm = gid * WGM, gsz = (nM - fm) < WGM ? (nM - fm) : WGM;
        u.pm = fm + ((wgid % nig) % gsz); u.pn = (wgid % nig) / gsz; return true;
    }
    __device__ __forceinline__ void a_ready(const Unit&) const {}
    __device__ __forceinline__ void done(const Unit&) const {}
};

__device__ __forceinline__ unsigned cvt_pk_bf16(float lo, float hi) { typedef float v2f __attribute__((ext_vector_type(2))); typedef __bf16 v2b __attribute__((ext_vector_type(2))); const v2f v = {lo, hi}; return __builtin_bit_cast(unsigned, __builtin_convertvector(v, v2b)); }
__device__ __forceinline__ u32x4 pack8(const f32x4 v0, const f32x4 v1) { u32x4 w; w.x = cvt_pk_bf16(v0[0], v0[1]); w.y = cvt_pk_bf16(v0[2], v0[3]); w.z = cvt_pk_bf16(v1[0], v1[1]); w.w = cvt_pk_bf16(v1[2], v1[3]); return w; }
struct EpiQ {
    static constexpr bool PERM = true, AFTER_DRAIN = false;
    bf16_t* O; int ldc;
    __device__ __forceinline__ void operator()(const f32x4 (&acc)[2][2][4][2], const Unit& u, int wr, int wc, int fr, int fq) const {
        const int row0 = u.pm * BM + wr * 64 + fr, col0 = u.pn * BM + wc * 32 + 8 * fq;
#pragma unroll
        for (int ai = 0; ai < 2; ++ai)
#pragma unroll
            for (int m = 0; m < 4; ++m) { bf16_t* rowp = O + (size_t)(row0 + ai * HALF + m * 16) * ldc + col0;
#pragma unroll
                for (int bj = 0; bj < 2; ++bj) *(u32x4*)(rowp + bj * HALF) = pack8(acc[ai][bj][m][0], acc[ai][bj][m][1]); }
    }
};
struct EpiWinP {
    static constexpr bool PERM = true, AFTER_DRAIN = false;
    bf16_t* qkv; bf16_t* z; float* ab;
    __device__ __forceinline__ void operator()(const f32x4 (&acc)[2][2][4][2], const Unit& u, int wr, int wc, int fr, int fq) const {
        const int row0 = u.pm * BM + wr * 64 + fr;
        if (u.pn < 16) {
            bf16_t* base = u.pn < 12 ? qkv : z; const int ldc = u.pn < 12 ? 3072 : 1024, col0 = (u.pn < 12 ? u.pn : u.pn - 12) * BM + wc * 32 + 8 * fq;
#pragma unroll
            for (int ai = 0; ai < 2; ++ai)
#pragma unroll
                for (int m = 0; m < 4; ++m) { bf16_t* rowp = base + (size_t)(row0 + ai * HALF + m * 16) * ldc + col0;
#pragma unroll
                    for (int bj = 0; bj < 2; ++bj) *(u32x4*)(rowp + bj * HALF) = pack8(acc[ai][bj][m][0], acc[ai][bj][m][1]); }
        } else if (wc == 0) {
#pragma unroll
            for (int ai = 0; ai < 2; ++ai)
#pragma unroll
                for (int m = 0; m < 4; ++m) { float* rowp = ab + (size_t)(row0 + ai * HALF + m * 16) * 32 + 8 * fq;
                    *(f32x4*)rowp = acc[ai][0][m][0]; *(f32x4*)(rowp + 4) = acc[ai][0][m][1]; }
        }
    }
};
struct EpiRes {
    static constexpr bool PERM = true, AFTER_DRAIN = false;
    bf16_t* h; const float* gate;
    __device__ __forceinline__ void operator()(const f32x4 (&acc)[2][2][4][2], const Unit& u, int wr, int wc, int fr, int fq) const {
        const int row0 = u.pm * BM + wr * 64 + fr, col0 = u.pn * BM + wc * 32 + 8 * fq;
#pragma unroll
        for (int ai = 0; ai < 2; ++ai)
#pragma unroll
            for (int m = 0; m < 4; ++m) { const int row = row0 + ai * HALF + m * 16; bf16_t* rowp = h + (size_t)row * 1024 + col0; const float* gp = gate + (row >> 11) * 6144 + col0;
#pragma unroll
                for (int bj = 0; bj < 2; ++bj) {
                    const u32x4 hv = *(const u32x4*)(rowp + bj * HALF);
                    const f32x4 g0 = *(const f32x4*)(gp + bj * HALF), g1 = *(const f32x4*)(gp + bj * HALF + 4);
                    const f32x4 a0 = acc[ai][bj][m][0], a1 = acc[ai][bj][m][1];
                    f32x4 n0, n1;
                    n0[0] = __uint_as_float(hv.x << 16) + g0[0] * a0[0]; n0[1] = __uint_as_float(hv.x & 0xffff0000u) + g0[1] * a0[1];
                    n0[2] = __uint_as_float(hv.y << 16) + g0[2] * a0[2]; n0[3] = __uint_as_float(hv.y & 0xffff0000u) + g0[3] * a0[3];
                    n1[0] = __uint_as_float(hv.z << 16) + g1[0] * a1[0]; n1[1] = __uint_as_float(hv.z & 0xffff0000u) + g1[1] * a1[1];
                    n1[2] = __uint_as_float(hv.w << 16) + g1[2] * a1[2]; n1[3] = __uint_as_float(hv.w & 0xffff0000u) + g1[3] * a1[3];
                    *(u32x4*)(rowp + bj * HALF) = pack8(n0, n1);
                } }
    }
};

template <class Epi, class Sched, bool ALIGN_EPI = false, bool SP2 = false>
__device__ __forceinline__ void gemm_phase(PG8_LAS unsigned char* lds, const Gemm g, const Sched& S, const Epi& E) {
    const int tid = tid_fresh(), wid = __builtin_amdgcn_readfirstlane(tid >> 6), lane = tid & 63, wr = wid >> 2, wc = wid & 3, fr = lane & 15, fq = lane >> 4;
    const int K = g.K, nt = K / BK;
    unsigned voffA[2], voffB[2];
#pragma unroll
    for (int i = 0; i < 2; ++i) { int R, C; stage_rc(tid * 16 + i * 8192, R, C); const int Rb = Epi::PERM ? ((R & ~31) + perm32(R & 31)) : R;
        voffA[i] = (unsigned)(R * K + C) * 2u; voffB[i] = (unsigned)(Rb * K + C) * 2u; }
    const size_t kstep = (size_t)(BK * 2);
    const size_t hstep = (size_t)HALF * K * 2;
    const size_t tstep = 2 * hstep;
    const unsigned ldsw = (unsigned)wid * 1024u;
    const int aoff = lds_byte(wr * 64 + fr, fq * 8), boff = lds_byte(wc * 32 + fr, fq * 8);
#define PG8_SA(b, h) (((b) * 2 + (h)) * HTB)
#define PG8_SB(b, h) ((4 + (b) * 2 + (h)) * HTB)
#define PG8_STAGE(bufoff, gbase, voff) do { _Pragma("unroll") for (int _i = 0; _i < 2; ++_i) \
        __builtin_amdgcn_global_load_lds((const unsigned*)((const char*)(gbase) + (voff)[_i]), (PG8_LAS unsigned*)(lds + (bufoff) + ldsw + _i * 8192), 16, 0, 0); } while (0)
#define PG8_LDA(dst, b, h) do { _Pragma("unroll") for (int m = 0; m < 4; ++m) _Pragma("unroll") for (int k = 0; k < 2; ++k) dst[m][k] = *(const PG8_LAS bf16x8*)(lds + PG8_SA(b, h) + aoff + m * 2048 + k * 1024); } while (0)
#define PG8_LDB(dst, b, h) do { _Pragma("unroll") for (int n = 0; n < 2; ++n) _Pragma("unroll") for (int k = 0; k < 2; ++k) dst[n][k] = *(const PG8_LAS bf16x8*)(lds + PG8_SB(b, h) + boff + n * 2048 + k * 1024); } while (0)
#define PG8_MMA(ai, bj, At, Bt) do { __builtin_amdgcn_s_setprio(1); _Pragma("unroll") for (int m = 0; m < 4; ++m) _Pragma("unroll") for (int n = 0; n < 2; ++n) _Pragma("unroll") for (int k = 0; k < 2; ++k) \
        acc[ai][bj][m][n] = __builtin_amdgcn_mfma_f32_16x16x32_bf16(Bt[n][k], At[m][k], acc[ai][bj][m][n], 0, 0, 0); __builtin_amdgcn_s_setprio(0); } while (0)
#define PG8_WAIT_V(n) asm volatile("s_waitcnt vmcnt(" #n ")" ::: "memory")
#define PG8_WAIT_L(n) asm volatile("s_waitcnt lgkmcnt(" #n ")" ::: "memory")
#define PG8_BAR __builtin_amdgcn_s_barrier()
#define PG8_SCHED __builtin_amdgcn_sched_barrier(0)
    Unit cur, nxt; int ui = 0;
    if (!S.next(0, cur)) return;
    f32x4 acc[2][2][4][2];
#pragma unroll
    for (int a = 0; a < 2; ++a)
#pragma unroll
        for (int b = 0; b < 2; ++b)
#pragma unroll
            for (int m = 0; m < 4; ++m)
#pragma unroll
                for (int n = 0; n < 2; ++n) acc[a][b][m][n] = (f32x4){0.f, 0.f, 0.f, 0.f};
    bf16x8 At[4][2], B0[2][2], B1[2][2];
    const char* cA = (const char*)g.A + (size_t)cur.pm * tstep; const char* cB = (const char*)g.Bt + (size_t)cur.pn * tstep;
    S.a_ready(cur);
    if constexpr (SP2) {
        PG8_STAGE(PG8_SB(0, 0), cB, voffB); PG8_STAGE(PG8_SB(0, 1), cB + hstep, voffB); PG8_STAGE(PG8_SA(0, 0), cA, voffA); PG8_STAGE(PG8_SA(0, 1), cA + hstep, voffA);
        if (wr == 1) PG8_BAR;
        PG8_WAIT_V(2); PG8_BAR;
        PG8_STAGE(PG8_SB(1, 0), cB + kstep, voffB); PG8_STAGE(PG8_SA(1, 0), cA + kstep, voffA); PG8_STAGE(PG8_SB(1, 1), cB + hstep + kstep, voffB);
        PG8_WAIT_V(6); PG8_BAR;
    } else {
        PG8_STAGE(PG8_SB(0, 0), cB, voffB); PG8_STAGE(PG8_SA(0, 0), cA, voffA); PG8_STAGE(PG8_SB(0, 1), cB + hstep, voffB); PG8_STAGE(PG8_SA(0, 1), cA + hstep, voffA);
        if (wr == 1) PG8_BAR;
        PG8_WAIT_V(4); PG8_BAR;
        PG8_STAGE(PG8_SB(1, 0), cB + kstep, voffB); PG8_STAGE(PG8_SA(1, 0), cA + kstep, voffA); PG8_STAGE(PG8_SB(1, 1), cB + hstep + kstep, voffB);
        PG8_WAIT_V(6); PG8_BAR;
    }
    for (;;) {
        const bool has_next = S.next(ui + 1, nxt);
        const char* nA = has_next ? (const char*)g.A + (size_t)nxt.pm * tstep : cA; const char* nB = has_next ? (const char*)g.Bt + (size_t)nxt.pn * tstep : cB;
        for (int t = 0; t < nt; t += 2) {
            const bool last = (t == nt - 2);
            const char* a1 = cA + (size_t)(t + 1) * kstep;
            const char* a2 = last ? nA : cA + (size_t)(t + 2) * kstep; const char* b2 = last ? nB : cB + (size_t)(t + 2) * kstep;
            const char* a3 = a2 + kstep; const char* b3 = b2 + kstep;
            if (last && has_next) S.a_ready(nxt);
            if constexpr (SP2) {
            PG8_LDB(B0, 0, 0); PG8_LDB(B1, 0, 1); PG8_SCHED; PG8_LDA(At, 0, 0); PG8_STAGE(PG8_SA(1, 1), a1 + hstep, voffA);
            PG8_WAIT_V(8); PG8_WAIT_L(0); PG8_BAR; PG8_MMA(0, 0, At, B0); PG8_MMA(0, 1, At, B1); PG8_BAR; PG8_SCHED;
            PG8_LDA(At, 0, 1); PG8_STAGE(PG8_SB(0, 0), b2, voffB); PG8_STAGE(PG8_SB(0, 1), b2 + hstep, voffB); PG8_STAGE(PG8_SA(0, 0), a2, voffA);
            PG8_WAIT_V(8); PG8_WAIT_L(0); PG8_BAR; PG8_MMA(1, 0, At, B0); PG8_MMA(1, 1, At, B1); PG8_BAR; PG8_SCHED;
            PG8_LDB(B0, 1, 0); PG8_LDB(B1, 1, 1); PG8_SCHED; PG8_LDA(At, 1, 0); PG8_STAGE(PG8_SA(0, 1), a2 + hstep, voffA);
            PG8_WAIT_V(8); PG8_WAIT_L(0); PG8_BAR; PG8_MMA(0, 0, At, B0); PG8_MMA(0, 1, At, B1); PG8_BAR; PG8_SCHED;
            PG8_LDA(At, 1, 1); PG8_STAGE(PG8_SB(1, 0), b3, voffB); PG8_STAGE(PG8_SB(1, 1), b3 + hstep, voffB); PG8_STAGE(PG8_SA(1, 0), a3, voffA);
            PG8_WAIT_V(8); PG8_WAIT_L(0); PG8_BAR; PG8_MMA(1, 0, At, B0); PG8_MMA(1, 1, At, B1); PG8_BAR; PG8_SCHED;
            } else {
            PG8_LDB(B0, 0, 0); PG8_SCHED; PG8_LDA(At, 0, 0); PG8_STAGE(PG8_SA(1, 1), a1 + hstep, voffA);
            PG8_WAIT_L(8); PG8_BAR; PG8_WAIT_L(0); PG8_MMA(0, 0, At, B0); PG8_BAR; PG8_SCHED;
            PG8_LDB(B1, 0, 1); PG8_STAGE(PG8_SB(0, 0), b2, voffB);
            PG8_BAR; PG8_WAIT_L(0); PG8_MMA(0, 1, At, B1); PG8_BAR;
            PG8_LDA(At, 0, 1); PG8_STAGE(PG8_SA(0, 0), a2, voffA);
            PG8_BAR; PG8_WAIT_L(0); PG8_MMA(1, 0, At, B0); PG8_BAR; PG8_SCHED;
            PG8_STAGE(PG8_SB(0, 1), b2 + hstep, voffB);
            PG8_WAIT_V(6); PG8_BAR; PG8_MMA(1, 1, At, B1); PG8_BAR;
            PG8_LDB(B0, 1, 0); PG8_SCHED; PG8_LDA(At, 1, 0); PG8_STAGE(PG8_SA(0, 1), a2 + hstep, voffA);
            PG8_WAIT_L(8); PG8_BAR; PG8_WAIT_L(0); PG8_MMA(0, 0, At, B0); PG8_BAR; PG8_SCHED;
            PG8_LDB(B1, 1, 1); PG8_STAGE(PG8_SB(1, 0), b3, voffB);
            PG8_BAR; PG8_WAIT_L(0); PG8_MMA(0, 1, At, B1); PG8_BAR;
            PG8_LDA(At, 1, 1); PG8_STAGE(PG8_SA(1, 0), a3, voffA);
            PG8_BAR; PG8_WAIT_L(0); PG8_MMA(1, 0, At, B0); PG8_BAR; PG8_SCHED;
            PG8_STAGE(PG8_SB(1, 1), b3 + hstep, voffB);
            PG8_WAIT_V(6); PG8_BAR; PG8_MMA(1, 1, At, B1); PG8_BAR;
            }
        }
        if constexpr (ALIGN_EPI) { if (wr == 0) PG8_BAR; }
        if constexpr (!Epi::AFTER_DRAIN) { E(acc, cur, wr, wc, fr, fq); S.done(cur); }
        if (!has_next) break;
#pragma unroll
        for (int a = 0; a < 2; ++a)
#pragma unroll
            for (int b = 0; b < 2; ++b)
#pragma unroll
                for (int m = 0; m < 4; ++m)
#pragma unroll
                    for (int n = 0; n < 2; ++n) acc[a][b][m][n] = (f32x4){0.f, 0.f, 0.f, 0.f};
        cur = nxt; cA = nA; cB = nB; ++ui;
        if constexpr (ALIGN_EPI) { if (wr == 1) PG8_BAR; }
    }
    PG8_WAIT_V(0);
    if constexpr (!ALIGN_EPI) { if (wr == 0) PG8_BAR; }
    PG8_BAR;
    if constexpr (Epi::AFTER_DRAIN) { E.fused(acc, cur, wr, wc, fr, fq, lds, wid, lane); S.done(cur); }
#undef PG8_SA
#undef PG8_SB
#undef PG8_STAGE
#undef PG8_LDA
#undef PG8_LDB
#undef PG8_MMA
#undef PG8_WAIT_V
#undef PG8_WAIT_L
#undef PG8_BAR
#undef PG8_SCHED
}
}

#define XB_TMO      128
#define XB_XCNT(j)  (256  + 64 * (j))
#define XB_XSUB(j)  (1280 + 64 * (j))
#define XB_XGEN(j)  (2304 + 64 * (j))
#define XB_TOP      3328
#define XB_TOPGEN   3392
#define XCD_BAR_WORDS 3456
#define XB_SPIN_CAP (1u << 22)
DEV unsigned xb_ld(unsigned* p)              { return __hip_atomic_load(p, __ATOMIC_RELAXED, __HIP_MEMORY_SCOPE_AGENT); }
DEV unsigned xb_add(unsigned* p, unsigned v) { return __hip_atomic_fetch_add(p, v, __ATOMIC_RELAXED, __HIP_MEMORY_SCOPE_AGENT); }
DEV unsigned xb_xcc_id() { return (unsigned)__builtin_amdgcn_s_getreg((3 << 11) | 20) & 0xFu; }
#define XB_SPIN(cond, bar) do { unsigned _sp = 0; while (cond) { __builtin_amdgcn_s_sleep(1); \
    if ((++_sp & 255u) == 0u) { if (xb_ld(&(bar)[XB_TMO])) break; if (_sp > XB_SPIN_CAP) { atomicAdd(&(bar)[XB_TMO], 1u); break; } } } } while (0)
struct XcdBarrier { unsigned* bar; unsigned x; volatile LAS unsigned* st; };
DEV XcdBarrier xcd_barrier_post(unsigned* bar, volatile LAS unsigned* st) {
    XcdBarrier b; b.bar = bar; b.x = xb_xcc_id(); b.st = st;
    if (threadIdx.x == 0) (void)xb_add(&bar[XB_XCNT(b.x)], 1u);
    return b;
}
DEV void xcd_barrier_complete(unsigned* bar, unsigned x, unsigned& nloc, unsigned& nx) {
    const unsigned G = gridDim.x * gridDim.y * gridDim.z;
    unsigned sum, cnt, mine, sp = 0u;
    for (;;) {
        sum = 0u; cnt = 0u; mine = 0u;
#pragma unroll
        for (unsigned j = 0; j < 16; ++j) { const unsigned c = xb_ld(&bar[XB_XCNT(j)]); sum += c; cnt += (c > 0u) ? 1u : 0u; mine = (j == x) ? c : mine; }
        if (sum == G) break;
        __builtin_amdgcn_s_sleep(1);
        if ((++sp & 255u) == 0u) { if (xb_ld(&bar[XB_TMO])) break; if (sp > XB_SPIN_CAP) { atomicAdd(&bar[XB_TMO], 1u); break; } }
    }
    nloc = mine > 0u ? mine : 1u; nx = cnt > 0u ? cnt : 1u;
}
DEV void xcd_barrier(const XcdBarrier& b) {
    asm volatile("s_waitcnt vmcnt(0)" ::: "memory");
    __syncthreads();
    if (threadIdx.x == 0) {
        unsigned* bar = b.bar;
        __builtin_amdgcn_s_waitcnt(0);
        unsigned nloc = b.st[0], nx = b.st[1];
        if (nloc == 0u) { xcd_barrier_complete(bar, b.x, nloc, nx); b.st[0] = nloc; b.st[1] = nx; }
        const unsigned old = xb_add(&bar[XB_XSUB(b.x)], 1u);
        const unsigned gen = old / nloc;
        if (old + 1u == (gen + 1u) * nloc) {
            __builtin_amdgcn_fence(__ATOMIC_RELEASE, "agent");
            asm volatile("s_waitcnt vmcnt(0)" ::: "memory");
            const unsigned og = xb_add(&bar[XB_TOP], 1u);
            const unsigned tg = og / nx;
            if (og + 1u == (tg + 1u) * nx) xb_add(&bar[XB_TOPGEN], 1u);
            else XB_SPIN(xb_ld(&bar[XB_TOPGEN]) == tg, bar);
            __builtin_amdgcn_fence(__ATOMIC_ACQUIRE, "agent");
            xb_add(&bar[XB_XGEN(b.x)], 1u);
            asm volatile("s_waitcnt vmcnt(0)" ::: "memory");
        } else {
            XB_SPIN(xb_ld(&bar[XB_XGEN(b.x)]) == gen, bar);
            __builtin_amdgcn_fence(__ATOMIC_ACQUIRE, "agent");
            asm volatile("s_waitcnt vmcnt(0)" ::: "memory");
        }
    }
    __syncthreads();
}

__global__ void __launch_bounds__(NTHREADS) fwd_megakernel(Params P) {
    __shared__ __attribute__((aligned(16))) unsigned char lds_raw[131072 + 4096];
    const ldsp lds = (ldsp)lds_raw;
    cg::grid_group grid = cg::this_grid();
    volatile LAS unsigned* xbst = (volatile LAS unsigned*)(lds + 131072);
    if (threadIdx.x == 0) { xbst[0] = 0u; xbst[1] = 0u; }
    __syncthreads();
    const XcdBarrier xbar = xcd_barrier_post((unsigned*)(P.ws + OFF_BAR), xbst);
#define GBAR() xcd_barrier(xbar)
#define ROW_HANDOFF() do { __builtin_amdgcn_fence(__ATOMIC_RELEASE, "workgroup"); asm volatile("s_waitcnt vmcnt(0)" ::: "memory"); __builtin_amdgcn_fence(__ATOMIC_ACQUIRE, "workgroup"); } while (0)
    const float* modv = (const float*)(P.ws + OFF_MODV);
    bf16_t* Abuf = (bf16_t*)(P.ws + OFF_A);

#define RUN(rep, ...) for (int rep_i = 0; rep_i < (rep); ++rep_i) { __VA_ARGS__; GBAR(); }
    for (int rep_i = 0; rep_i < REP_PREP; ++rep_i) { phase_prep(P, lds); grid.sync(); }
    RUN(REP_MOD, phase_modulate<0>(P, 0, 0, NT))
    RUN(REP_POOL, phase_pool(P, lds))
    RUN(REP_MOD, phase_modulate<1>(P, 0, 1, NT, true))
    RUN(REP_GEMM, { pg8::Gemm g{Abuf, (const bf16_t*)(P.ws + OFF_WQT), NT, 2048, 1024}; pg8::StaticOrder S; S.init(NT, 2048, gridDim.x, blockIdx.x); pg8::EpiQ e{(bf16_t*)(P.ws + OFF_R1), 2048}; pg8::gemm_phase<pg8::EpiQ, pg8::StaticOrder, true, true>(lds, g, S, e); })
    RUN(REP_TOPK, phase_topk(P, 0, NT, lds))
    phase_experts(P, 0, NT, lds);
    ROW_HANDOFF();
    RUN(REP_MOD, phase_modulate<1>(P, 1, 0, NT))
    RUN(REP_GEMM, { pg8::Gemm g{Abuf, (const bf16_t*)(P.ws + OFF_WINT), NT, 4352, 1024}; pg8::StaticOrder S; S.init(NT, 4352, gridDim.x, blockIdx.x);
      pg8::EpiWinP e{(bf16_t*)(P.ws + OFF_R1), (bf16_t*)(P.ws + OFF_PZ), (float*)(P.ws + OFF_AB)}; pg8::gemm_phase<pg8::EpiWinP, pg8::StaticOrder, true, true>(lds, g, S, e); })
    RUN(REP_CONV, phase_conv(P))
    RUN(REP_CHUNK, phase_chunk(P, lds))
    RUN(REP_SCAN, phase_scan(P, lds))
    RUN(REP_DNOUT, phase_dnout(P))
    { pg8::Gemm g{Abuf, (const bf16_t*)(P.ws + OFF_WOUTT), NX, 1024, 1024}; pg8::StaticOrder S; S.init(NX, 1024, gridDim.x, blockIdx.x); pg8::EpiRes e{(bf16_t*)(P.ws + OFF_H), modv + 9 * 6144 + 2048}; pg8::gemm_phase<pg8::EpiRes, pg8::StaticOrder, false, true>(lds, g, S, e); }
    GBAR();
    RUN(REP_MOD, phase_modulate<1>(P, 1, 1, NX, true))
    RUN(REP_GEMM, { pg8::Gemm g{Abuf, (const bf16_t*)(P.ws + OFF_WQT) + (size_t)2048 * 1024, NX, 2048, 1024}; pg8::StaticOrder S; S.init(NX, 2048, gridDim.x, blockIdx.x); pg8::EpiQ e{(bf16_t*)(P.ws + OFF_R1), 2048}; pg8::gemm_phase<pg8::EpiQ, pg8::StaticOrder, true, true>(lds, g, S, e); })
    RUN(REP_TOPK, phase_topk(P, 1, NX, lds))
    phase_experts(P, 1, NX, lds);
    ROW_HANDOFF();
    phase_final(P);
}

extern "C" void kernel_launch(void* const* d_in, const int* in_sizes, int n_in, void* d_out, int out_size, void* d_ws, size_t ws_size, hipStream_t stream) {
    static int grid_blocks = 0;
    if (grid_blocks == 0) {
        if (n_in != 21 || out_size != NX * D || ws_size < WS_END) {
            fprintf(stderr, "kernel_launch: unexpected shapes: n_in %d out %d ws %zu (need %zu)\n", n_in, out_size, ws_size, (size_t)WS_END);
            grid_blocks = -1; return;
        }
        int dev = 0, cus = 0, per_cu = 0;
        hipGetDevice(&dev);
        hipDeviceGetAttribute(&cus, hipDeviceAttributeMultiprocessorCount, dev);
        hipOccupancyMaxActiveBlocksPerMultiprocessor(&per_cu, fwd_megakernel, NTHREADS, 0);
        if (per_cu < 1) { fprintf(stderr, "kernel_launch: occupancy query reports %d blocks per CU\n", per_cu); grid_blocks = -1; return; }
        grid_blocks = cus;
    }
    if (grid_blocks < 0) return;
    if (hipMemsetAsync((char*)d_ws + OFF_BAR, 0, XCD_BAR_WORDS * 4, stream) != hipSuccess) { fprintf(stderr, "kernel_launch: memset of barrier words failed\n"); return; }
    Params p{};
    const float** pp = (const float**)&p;
    for (int i = 0; i < 21; ++i) pp[i] = (const float*)d_in[i];
    p.out = (float*)d_out; p.ws = (unsigned char*)d_ws;
    void* args[] = {&p};
    hipError_t e = hipLaunchCooperativeKernel((void*)fwd_megakernel, dim3(grid_blocks), dim3(NTHREADS), args, 0, stream);
    if (e != hipSuccess) fprintf(stderr, "cooperative launch failed: %s (grid %d)\n", hipGetErrorString(e), grid_blocks);
}
```

```cpp
#include <hip/hip_runtime.h>
#include <hip/hip_cooperative_groups.h>
#include <cstdio>
#include <cstdint>
namespace cg = cooperative_groups;

#define DEV __device__ __forceinline__
typedef unsigned short bf16_t;
typedef short bf16x8 __attribute__((ext_vector_type(8)));
typedef float f32x4 __attribute__((ext_vector_type(4)));
typedef float f32x16 __attribute__((ext_vector_type(16)));
typedef unsigned u32x4 __attribute__((ext_vector_type(4)));
typedef unsigned u32x2 __attribute__((ext_vector_type(2)));
#define LAS __attribute__((address_space(3)))
typedef LAS unsigned char* ldsp;
DEV int tid_fresh() { int t = threadIdx.x; asm volatile("" : "+v"(t)); return t; }
DEV ldsp launder(ldsp p) { asm volatile("" : "+v"(p)); return p; }

constexpr int D = 1024, NB = 8, SEQ = 2048, CTX = 256;
constexpr int NX = NB * SEQ, NC = NB * CTX, NT = NX + NC;
constexpr int NTHREADS = 512;
constexpr float EPS = 1e-6f;
#ifndef REP_PREP
#define REP_PREP 1
#endif
#ifndef REP_MOD
#define REP_MOD 1
#endif
#ifndef REP_POOL
#define REP_POOL 1
#endif
#ifndef REP_GEMM
#define REP_GEMM 1
#endif
#ifndef REP_TOPK
#define REP_TOPK 1
#endif
#ifndef REP_CONV
#define REP_CONV 1
#endif
#ifndef REP_CHUNK
#define REP_CHUNK 1
#endif
#ifndef REP_SCAN
#define REP_SCAN 1
#endif
#ifndef REP_DNOUT
#define REP_DNOUT 1
#endif

constexpr size_t MiB = 1024 * 1024;
constexpr size_t TAB_ELEMS = (size_t)16384 * 1024;
constexpr size_t OFF_TAB   = 0;
constexpr size_t OFF_WQT   = 128 * MiB;
constexpr size_t OFF_WINT  = OFF_WQT + 8 * MiB;
constexpr size_t OFF_WOUTT = OFF_WINT + (size_t)4352 * 1024 * 2;
constexpr size_t OFF_POOLT = OFF_WOUTT + 2 * MiB;
constexpr size_t OFF_KEYS  = OFF_POOLT + 512 * 1024;
constexpr size_t OFF_MODV  = OFF_KEYS + 1 * MiB;
constexpr size_t OFF_HC    = OFF_MODV + 512 * 1024;
constexpr size_t OFF_SELI  = OFF_HC + 8 * MiB;
constexpr size_t OFF_SELG  = OFF_SELI + (size_t)NT * 128 * 4;
constexpr size_t OFF_AB    = OFF_SELG + (size_t)NT * 128 * 4;
constexpr size_t OFF_G     = OFF_AB + (size_t)NT * 32 * 4;
constexpr size_t OFF_BETA  = OFF_G + (size_t)2 * NT * 8 * 4;
constexpr size_t OFF_GC    = OFF_BETA + (size_t)2 * NT * 8 * 4;
constexpr size_t OFF_QC    = OFF_GC + (size_t)4608 * 64 * 4;
constexpr size_t OFF_KC    = OFF_QC + (size_t)NT * 1024 * 2;
constexpr size_t OFF_VC    = OFF_KC + (size_t)NT * 1024 * 2;
constexpr size_t OFF_A     = OFF_VC + (size_t)NT * 1024 * 2;
constexpr size_t OFF_R1    = OFF_A + (size_t)NT * 1024 * 2;
constexpr size_t OFF_PZ    = OFF_R1 + (size_t)NT * 3072 * 2;
constexpr size_t OFF_BAR   = OFF_R1 + (size_t)NT * 4096 * 2;
constexpr size_t OFF_H     = OFF_BAR + 16384;
constexpr size_t OFF_XS    = OFF_H + (size_t)NT * 1024 * 2;
constexpr size_t OFF_RSC   = OFF_XS + (size_t)NT * 4;
constexpr size_t WS_END    = OFF_RSC + (size_t)4 * 16384 * 4;
constexpr size_t OFF_WBUF  = OFF_A;
constexpr size_t OFF_UBUF  = OFF_A + (size_t)4608 * 8192 * 2;
constexpr size_t OFF_OBUF  = OFF_TAB + 64 * MiB;
constexpr size_t OFF_PART  = OFF_QC;
constexpr size_t OFF_WEXP  = OFF_QC + (size_t)8 * NT * 128 * 4;
constexpr size_t OFF_A8    = OFF_WEXP + (size_t)NT * 128 * 4;
static_assert(OFF_UBUF + (size_t)4608 * 8192 * 2 <= OFF_PZ, "w/u overlay must not reach Pz");
static_assert(OFF_A8 + (size_t)NT * 1024 <= OFF_A, "PEER partial buffers must fit the q/k/v conv region");

struct Params {
    const float *x, *c, *ctx, *c_ctx, *mod_w, *mod_b, *norm1_g, *norm2_g, *pool_w, *pool_scale;
    const float *dn_w_in, *dn_conv_w, *dn_a_log, *dn_dt_bias, *dn_norm_g, *dn_w_out;
    const float *peer_wq, *peer_keys, *peer_u, *peer_v, *final_g;
    float* out; unsigned char* ws;
};

DEV bf16_t f2bf(float f) { return __builtin_bit_cast(unsigned short, (__bf16)f); }
DEV float bf2f(bf16_t h) { return __uint_as_float(((unsigned)h) << 16); }
typedef float f32x2_t __attribute__((ext_vector_type(2)));
typedef __bf16 bf16x2_t __attribute__((ext_vector_type(2)));
DEV unsigned pk2(float a, float b) { const f32x2_t v = {a, b}; const bf16x2_t r = __builtin_convertvector(v, bf16x2_t); return __builtin_bit_cast(unsigned, r); }
DEV float bflo(unsigned u) { return __uint_as_float(u << 16); }
DEV float bfhi(unsigned u) { return __uint_as_float(u & 0xffff0000u); }
DEV float wave_sum(float v) {
#pragma unroll
    for (int o = 32; o >= 1; o >>= 1) v += __shfl_xor(v, o);
    return v;
}
DEV float wave_max(float v) {
#pragma unroll
    for (int o = 32; o >= 1; o >>= 1) v = fmaxf(v, __shfl_xor(v, o));
    return v;
}
DEV float sum16(float v) {
#pragma unroll
    for (int o = 8; o >= 1; o >>= 1) v += __shfl_xor(v, o);
    return v;
}
DEV f32x16 mfma32(bf16x8 a, bf16x8 b, f32x16 c) { return __builtin_amdgcn_mfma_f32_32x32x16_bf16(a, b, c, 0, 0, 0); }
DEV int crow(int reg, int lane) { return (reg & 3) + 8 * (reg >> 2) + 4 * (lane >> 5); }
DEV f32x16 zero16() { f32x16 z;
#pragma unroll
    for (int i = 0; i < 16; ++i) z[i] = 0.f; return z; }
DEV bf16_t* hrow(const Params& P, int r) { return (bf16_t*)(P.ws + OFF_H) + (size_t)r * 1024; }
DEV float silu(float v) { return v * __builtin_amdgcn_rcpf(1.f + __expf(-v)); }

DEV bf16x8 frag_row(const LAS bf16_t* m, int ld, int r0, int k0, int lane) {
    return *(const LAS bf16x8*)(m + (r0 + (lane & 31)) * ld + k0 + 8 * (lane >> 5));
}
DEV bf16x8 frag_col(const LAS bf16_t* m, int ld, int c0, int k0, int lane) {
    bf16x8 f;
#pragma unroll
    for (int j = 0; j < 8; ++j) f[j] = (short)m[(k0 + 8 * (lane >> 5) + j) * ld + c0 + (lane & 31)];
    return f;
}

typedef short s16x4 __attribute__((ext_vector_type(4)));
DEV s16x4 ds_tr16(ldsp p) { return __builtin_amdgcn_ds_read_tr16_b64_v4i16((LAS s16x4*)p); }
DEV bf16x8 frag_col_tr(const LAS bf16_t* m, int ld, int c0, int k0, int lane) {
    const int gi = lane >> 4, li = lane & 15, q = li >> 2, pc = li & 3, h = gi >> 1;
    const LAS bf16_t* p = m + (k0 + 8 * h + q) * ld + c0 + 16 * (gi & 1) + 4 * pc;
    const s16x4 lo = ds_tr16((ldsp)p), hi = ds_tr16((ldsp)(p + 4 * ld));
    bf16x8 f; f[0] = lo[0]; f[1] = lo[1]; f[2] = lo[2]; f[3] = lo[3]; f[4] = hi[0]; f[5] = hi[1]; f[6] = hi[2]; f[7] = hi[3];
    return f;
}
DEV void p0_convert_item(const float* src, bf16_t* dst, size_t base) {
    const int tid = tid_fresh();
#pragma unroll
    for (int it = 0; it < 8; ++it) {
        const size_t e = base + ((size_t)it * NTHREADS + tid) * 8;
        const f32x4 a = *(const f32x4*)(src + e), b = *(const f32x4*)(src + e + 4);
        u32x4 o; o.x = pk2(a.x, a.y); o.y = pk2(a.z, a.w); o.z = pk2(b.x, b.y); o.w = pk2(b.z, b.w);
        *(u32x4*)(dst + e) = o;
    }
}
DEV void p0_table_item(const float* src, unsigned char* dst, float* rscale, int row0, bool as_int8) {
    const int tid = tid_fresh(), wave = tid >> 6, lane = tid & 63;
#pragma unroll 8
    for (int rr = 0; rr < 16; ++rr) {
        const int e = row0 + wave * 16 + rr;
        f32x4 v[4]; float am = 0.f;
#pragma unroll
        for (int q = 0; q < 4; ++q) { v[q] = __builtin_nontemporal_load((const f32x4*)(src + (size_t)e * 1024 + 256 * q + 4 * lane));
            am = fmaxf(am, fmaxf(fmaxf(fabsf(v[q].x), fabsf(v[q].y)), fmaxf(fabsf(v[q].z), fabsf(v[q].w)))); }
        am = wave_max(am);
        if (as_int8) {
            float ssq = 0.f;
#pragma unroll
            for (int q = 0; q < 4; ++q) ssq += v[q].x * v[q].x + v[q].y * v[q].y + v[q].z * v[q].z + v[q].w * v[q].w;
            ssq = wave_sum(ssq);
            const float top = fminf(am, 2.7f * sqrtf(ssq * (1.f / 1024.f)));
            am = top;
            const float sc = am > 0.f ? 7.f / am : 0.f;
#pragma unroll
            for (int q = 0; q < 4; ++q) {
                const int n0 = (int)fminf(fmaxf(rintf(v[q].x * sc), -7.f), 7.f) & 15, n1 = (int)fminf(fmaxf(rintf(v[q].y * sc), -7.f), 7.f) & 15;
                const int n2 = (int)fminf(fmaxf(rintf(v[q].z * sc), -7.f), 7.f) & 15, n3 = (int)fminf(fmaxf(rintf(v[q].w * sc), -7.f), 7.f) & 15;
                *(unsigned short*)(dst + ((size_t)q * 16384 + e) * 128 + 2 * lane) = (unsigned short)(n0 | (n1 << 4) | (n2 << 8) | (n3 << 12));
            }
            if (lane == 0) rscale[e] = am * (1.f / 7.f);
        } else {
            float ssq = 0.f;
#pragma unroll
            for (int q = 0; q < 4; ++q) ssq += v[q].x * v[q].x + v[q].y * v[q].y + v[q].z * v[q].z + v[q].w * v[q].w;
            ssq = wave_sum(ssq);
            const float top = fminf(am, 2.8f * sqrtf(ssq * (1.f / 1024.f)));
            const float sc = top > 0.f ? 6.f / top : 0.f;
#pragma unroll
            for (int q = 0; q < 4; ++q) {
                const float x0 = fminf(fmaxf(v[q].x * sc, -6.f), 6.f), x1 = fminf(fmaxf(v[q].y * sc, -6.f), 6.f), x2 = fminf(fmaxf(v[q].z * sc, -6.f), 6.f), x3 = fminf(fmaxf(v[q].w * sc, -6.f), 6.f);
                unsigned w = __builtin_amdgcn_cvt_scalef32_pk_fp4_f32(0u, x0, x1, 1.0f, 0);
                w = __builtin_amdgcn_cvt_scalef32_pk_fp4_f32(w, x2, x3, 1.0f, 1);
                *(unsigned short*)(dst + ((size_t)q * 16384 + e) * 128 + 2 * lane) = (unsigned short)(w & 0xffffu);
            }
            if (lane == 0) rscale[e] = top * (1.f / 6.f);
        }
    }
}
DEV void p0_transpose_item(const float* W, int K, int N, bf16_t* Wt, int kt, int nt, LAS float* tile) {
    const int tid = tid_fresh(), k0 = kt * 64, n0 = nt * 256;
    f32x4 v[8];
#pragma unroll
    for (int p = 0; p < 8; ++p) {
        const int kk = p * 8 + (tid >> 6), nn = (tid & 63) * 4, n = n0 + nn;
        v[p] = (f32x4){0.f, 0.f, 0.f, 0.f};
        if (n < N) v[p] = __builtin_nontemporal_load((const f32x4*)(W + (size_t)(k0 + kk) * N + n));
    }
#pragma unroll
    for (int p = 0; p < 8; ++p) {
        const int kk = p * 8 + (tid >> 6), nn = (tid & 63) * 4;
        tile[kk * 257 + nn + 0] = v[p].x; tile[kk * 257 + nn + 1] = v[p].y; tile[kk * 257 + nn + 2] = v[p].z; tile[kk * 257 + nn + 3] = v[p].w;
    }
    __syncthreads();
#pragma unroll
    for (int q = 0; q < 4; ++q) {
        const int n = q * 64 + (tid >> 3), kc = (tid & 7) * 8;
        u32x4 o;
        o.x = pk2(tile[(kc + 0) * 257 + n], tile[(kc + 1) * 257 + n]);
        o.y = pk2(tile[(kc + 2) * 257 + n], tile[(kc + 3) * 257 + n]);
        o.z = pk2(tile[(kc + 4) * 257 + n], tile[(kc + 5) * 257 + n]);
        o.w = pk2(tile[(kc + 6) * 257 + n], tile[(kc + 7) * 257 + n]);
        *(u32x4*)(Wt + (size_t)(n0 + n) * K + k0 + kc) = o;
    }
    __syncthreads();
}
DEV void p0_mod_item(const Params& P, int i, int cb, LAS float* lds) {
    LAS float* s = lds;
    LAS float* red = lds + 9 * 1024;
    const int tid = tid_fresh();
    for (int e = tid; e < 9 * 1024; e += NTHREADS) {
        const int m = e >> 10, k = e & 1023;
        const float cv = m < 8 ? P.c[m * 1024 + k] : P.c_ctx[k];
        s[e] = silu(cv);
    }
    __syncthreads();
    const int cq = tid & 31, kg = tid >> 5;
    const float* W = P.mod_w + (size_t)i * 1024 * 6144 + cb * 128 + cq * 4;
    f32x4 acc[9];
#pragma unroll
    for (int m = 0; m < 9; ++m) acc[m] = (f32x4){0.f, 0.f, 0.f, 0.f};
#pragma unroll 16
    for (int kk = 0; kk < 64; ++kk) {
        const int k = kg * 64 + kk;
        const f32x4 w = __builtin_nontemporal_load((const f32x4*)(W + (size_t)k * 6144));
#pragma unroll
        for (int m = 0; m < 9; ++m) { const float sv = s[m * 1024 + k]; acc[m] += w * sv; }
    }
#pragma unroll
    for (int m = 0; m < 9; ++m) *(LAS f32x4*)&red[(kg * 9 + m) * 128 + cq * 4] = acc[m];
    __syncthreads();
    float* modv = (float*)(P.ws + OFF_MODV);
    for (int e = tid; e < 9 * 128; e += NTHREADS) {
        const int m = e >> 7, col = e & 127;
        float sum = 0.f;
#pragma unroll
        for (int g = 0; g < 16; ++g) sum += red[(g * 9 + m) * 128 + col];
        modv[(size_t)(i * 9 + m) * 6144 + cb * 128 + col] = sum + P.mod_b[i * 6144 + cb * 128 + col];
    }
    __syncthreads();
}
DEV void phase_prep(const Params& P, ldsp lds0) {
    constexpr int N_MOD = 96, N_WQ = 2 * 16 * 8, N_WIN = 16 * 17, N_WOUT = 16 * 4, N_POOL = 4 * 4;
    constexpr int N_TR = N_WQ + N_WIN + N_WOUT + N_POOL, N_TAB = 4 * 128, N_KEYS = 16;
    constexpr int TOTAL = N_MOD + N_TR + N_TAB + N_KEYS;
    for (int item = blockIdx.x; item < TOTAL; item += gridDim.x) {
        LAS float* lds = (LAS float*)launder(lds0);
        int r = item;
        if (r < N_MOD) { p0_mod_item(P, r / 48, r % 48, lds); continue; }
        r -= N_MOD;
        if (r < N_WQ) { const int i = r / 128, t = r % 128;
            p0_transpose_item(P.peer_wq + (size_t)i * 1024 * 2048, 1024, 2048, (bf16_t*)(P.ws + OFF_WQT) + (size_t)i * 2048 * 1024, t / 8, t % 8, lds); continue; }
        r -= N_WQ;
        if (r < N_WIN) { p0_transpose_item(P.dn_w_in, 1024, 4128, (bf16_t*)(P.ws + OFF_WINT), r / 17, r % 17, lds); continue; }
        r -= N_WIN;
        if (r < N_WOUT) { p0_transpose_item(P.dn_w_out, 1024, 1024, (bf16_t*)(P.ws + OFF_WOUTT), r / 4, r % 4, lds); continue; }
        r -= N_WOUT;
        if (r < N_POOL) { const int g = r / 4, t = r % 4;
            p0_transpose_item(P.pool_w + (size_t)g * 65536, 256, 256, (bf16_t*)(P.ws + OFF_POOLT) + (size_t)g * 65536, t, 0, lds); continue; }
        r -= N_POOL;
        if (r < N_TAB) { const int tb = r / 128, ch = r % 128;
            const float* src = ((tb & 1) ? P.peer_v : P.peer_u) + (size_t)(tb >> 1) * TAB_ELEMS;
            p0_table_item(src, P.ws + OFF_TAB + (size_t)tb * 16 * MiB, (float*)(P.ws + OFF_RSC) + tb * 16384, ch * 128, (tb & 1) == 0); continue; }
        r -= N_TAB;
        p0_convert_item(P.peer_keys, (bf16_t*)(P.ws + OFF_KEYS), (size_t)r * 32768);
    }
}

template <int SRC>
DEV void phase_modulate(const Params& P, int layer, int which, int nrows, bool q8 = false) {
    const float* gain = (which ? P.norm2_g : P.norm1_g) + layer * 1024;
    const float* modv = (const float*)(P.ws + OFF_MODV) + (size_t)layer * 9 * 6144;
    bf16_t* A = (bf16_t*)(P.ws + OFF_A);
    const int tid = tid_fresh(); const int wave = tid >> 6, lane = tid & 63;
    for (int r = blockIdx.x * 8 + wave; r < nrows; r += gridDim.x * 8) {
        const int m = r < NX ? (r >> 11) : 8;
        const float* sh = modv + m * 6144 + which * 3072;
        const float* sc = sh + 1024;
        f32x4 v[4]; float ss = 0.f;
#pragma unroll
        for (int j = 0; j < 4; ++j) {
            if (SRC == 0) { const float* src = r < NX ? P.x + (size_t)r * 1024 : P.ctx + (size_t)(r - NX) * 1024; v[j] = *(const f32x4*)(src + j * 256 + lane * 4); }
            else { const u32x2 hv = *(const u32x2*)(hrow(P, r) + j * 256 + lane * 4); v[j] = (f32x4){bflo(hv.x), bfhi(hv.x), bflo(hv.y), bfhi(hv.y)}; }
            ss += v[j].x * v[j].x + v[j].y * v[j].y + v[j].z * v[j].z + v[j].w * v[j].w;
        }
        ss = wave_sum(ss);
        const float rstd = rsqrtf(ss * (1.f / 1024.f) + EPS);
#pragma unroll
        for (int j = 0; j < 4; ++j) {
            const int col = j * 256 + lane * 4;
            const f32x4 g = *(const f32x4*)(gain + col), s1 = *(const f32x4*)(sc + col), s0 = *(const f32x4*)(sh + col);
            const f32x4 y = v[j] * rstd * g * (1.f + s1) + s0;
            u32x2 o; o.x = pk2(y.x, y.y); o.y = pk2(y.z, y.w);
            *(u32x2*)(A + (size_t)r * 1024 + col) = o;
            v[j] = y;
        }
        if (q8) {
            float am = 0.f;
#pragma unroll
            for (int j = 0; j < 4; ++j) am = fmaxf(am, fmaxf(fmaxf(fabsf(v[j].x), fabsf(v[j].y)), fmaxf(fabsf(v[j].z), fabsf(v[j].w))));
            am = wave_max(am);
            const float sc = am > 0.f ? 119.f / am : 0.f;
            unsigned char* a8 = P.ws + OFF_A8 + (size_t)r * 1024;
#pragma unroll
            for (int j = 0; j < 4; ++j) {
                unsigned mh = 0u, ml = 0u;
#pragma unroll
                for (int e = 0; e < 4; ++e) {
                    const int b = (int)rintf(v[j][e] * sc), h = (b + 8) >> 4, l = b - 16 * h;
                    mh |= (unsigned)(h & 15) << (4 * e); ml |= (unsigned)(l & 15) << (4 * e);
                }
                const unsigned mine = mh | (ml << 16), other = (unsigned)__shfl_xor((int)mine, 1);
                const unsigned outw = (lane & 1) ? ((other >> 16) | (mine & 0xffff0000u)) : ((mine & 0xffffu) | (other << 16));
                *(unsigned*)(a8 + (j * 8 + (lane >> 3)) * 32 + (lane & 1) * 16 + 4 * ((lane & 7) >> 1)) = outw;
            }
            if (lane == 0) ((float*)(P.ws + OFF_XS))[r] = am * (1.f / 119.f);
        }
    }
}

DEV void unpack8(const u32x4 v, float* f) {
    f[0] = bflo(v.x); f[1] = bfhi(v.x); f[2] = bflo(v.y); f[3] = bfhi(v.y); f[4] = bflo(v.z); f[5] = bfhi(v.z); f[6] = bflo(v.w); f[7] = bfhi(v.w);
}
template <int W>
DEV void pool_vertical(const bf16_t* A0, LAS float* V, int b, int r, int cbase, int tq, int ch8, float (&cen)[4][8]) {
    const int rlo = max(0, r - W / 2), rhi = min(32, r - W / 2 + W);
    const float inv = 1.f / (float)(rhi - rlo);
#pragma unroll
    for (int jh = 0; jh < 2; ++jh) {
        u32x4 ld[2][W];
#pragma unroll
        for (int jj = 0; jj < 2; ++jj)
#pragma unroll
            for (int k = 0; k < W; ++k) {
                const int rr = min(rlo + k, 31), tok = tq + 16 * (2 * jh + jj);
                ld[jj][k] = *(const u32x4*)(A0 + ((size_t)b * 2048 + rr * 64 + tok) * 1024 + cbase);
            }
#pragma unroll
        for (int jj = 0; jj < 2; ++jj) {
            const int j = 2 * jh + jj, tok = tq + 16 * j;
            float acc[8];
#pragma unroll
            for (int e = 0; e < 8; ++e) acc[e] = 0.f;
#pragma unroll
            for (int k = 0; k < W; ++k) {
                float f[8]; unpack8(ld[jj][k], f);
                const bool in = rlo + k < rhi;
#pragma unroll
                for (int e = 0; e < 8; ++e) acc[e] += in ? f[e] : 0.f;
                if (rlo + k == r) {
#pragma unroll
                    for (int e = 0; e < 8; ++e) cen[j][e] = f[e];
                }
            }
            LAS float* vp = V + (tok + 8) * 260 + ch8 * 8;
            *(LAS f32x4*)vp = (f32x4){acc[0] * inv, acc[1] * inv, acc[2] * inv, acc[3] * inv};
            *(LAS f32x4*)(vp + 4) = (f32x4){acc[4] * inv, acc[5] * inv, acc[6] * inv, acc[7] * inv};
        }
    }
}
template <int W>
DEV void pool_horizontal(const LAS float* V, ldsp At, bool isx, int seg, int tq, int ch8, const float (&cen)[4][8]) {
#pragma unroll
    for (int j = 0; j < 4; ++j) {
        const int tok = tq + 16 * j;
        const int pos = isx ? tok : 64 * seg + tok, lim = isx ? 64 : 256, off = isx ? 8 : 8 - 64 * seg;
        const int lo = max(0, pos - W / 2), hi = min(lim, pos - W / 2 + W);
        f32x4 s0 = {0.f, 0.f, 0.f, 0.f}, s1 = {0.f, 0.f, 0.f, 0.f};
#pragma unroll
        for (int k = 0; k < W; ++k) {
            const int t = min(lo + k, lim - 1);
            const LAS float* vp = V + (t + off) * 260 + ch8 * 8;
            const f32x4 a = *(const LAS f32x4*)vp, b2 = *(const LAS f32x4*)(vp + 4);
            const float m = (lo + k < hi) ? 1.f : 0.f;
            s0 += a * m; s1 += b2 * m;
        }
        const float inv = 1.f / (float)(hi - lo);
        u32x4 o;
        o.x = pk2(s0.x * inv - cen[j][0], s0.y * inv - cen[j][1]);
        o.y = pk2(s0.z * inv - cen[j][2], s0.w * inv - cen[j][3]);
        o.z = pk2(s1.x * inv - cen[j][4], s1.y * inv - cen[j][5]);
        o.w = pk2(s1.z * inv - cen[j][6], s1.w * inv - cen[j][7]);
        *(LAS u32x4*)(At + tok * 512 + ((ch8 ^ (tok & 7)) << 4)) = o;
    }
}
DEV void phase_pool(const Params& P, ldsp lds0) {
    const bf16_t* A0 = (const bf16_t*)(P.ws + OFF_A);
    const float* modv = (const float*)(P.ws + OFF_MODV);
    const bf16_t* Wt = (const bf16_t*)(P.ws + OFF_POOLT);
    const int tid = tid_fresh(), lane = tid & 63, wave = tid >> 6;
    const int ch8 = tid & 31, tq = tid >> 5;
    for (int item = blockIdx.x; item < 1152; item += gridDim.x) {
        const ldsp lds = launder(lds0);
        LAS float* V = (LAS float*)lds;
        const ldsp At = lds + 80 * 260 * 4;
        const bool isx = item < 1024;
        int b, r = 0, seg = 0, g;
        if (isx) { b = item >> 7; r = (item >> 2) & 31; }
        else { const int it = item - 1024; b = it >> 4; seg = (it >> 2) & 3; }
        g = ((item & 3) + (item >> 8)) & 3;
        const int cbase = g * 256 + ch8 * 8;
        float cen[4][8];
        if (isx) {
            if (g == 0) pool_vertical<2>(A0, V, b, r, cbase, tq, ch8, cen);
            else if (g == 1) pool_vertical<4>(A0, V, b, r, cbase, tq, ch8, cen);
            else if (g == 2) pool_vertical<8>(A0, V, b, r, cbase, tq, ch8, cen);
            else pool_vertical<16>(A0, V, b, r, cbase, tq, ch8, cen);
        } else {
            for (int q = tq; q < 80; q += 16) {
                const int t = 64 * seg - 8 + q;
                if (t >= 0 && t < 256) {
                    const u32x4 pv = *(const u32x4*)(A0 + ((size_t)NX + b * 256 + t) * 1024 + cbase);
                    float f[8]; unpack8(pv, f);
                    LAS float* vp = V + q * 260 + ch8 * 8;
                    *(LAS f32x4*)vp = (f32x4){f[0], f[1], f[2], f[3]};
                    *(LAS f32x4*)(vp + 4) = (f32x4){f[4], f[5], f[6], f[7]};
                }
            }
#pragma unroll
            for (int j = 0; j < 4; ++j) {
                const int tok = tq + 16 * j;
                const u32x4 pv = *(const u32x4*)(A0 + ((size_t)NX + b * 256 + 64 * seg + tok) * 1024 + cbase);
                unpack8(pv, cen[j]);
            }
        }
        __syncthreads();
        if (g == 0) pool_horizontal<2>(V, At, isx, seg, tq, ch8, cen);
        else if (g == 1) pool_horizontal<4>(V, At, isx, seg, tq, ch8, cen);
        else if (g == 2) pool_horizontal<8>(V, At, isx, seg, tq, ch8, cen);
        else pool_horizontal<16>(V, At, isx, seg, tq, ch8, cen);
        __syncthreads();
        f32x16 acc[2]; acc[0] = zero16(); acc[1] = zero16();
        const bf16_t* Wg = Wt + (size_t)g * 65536 + (size_t)(32 * wave + (lane & 31)) * 256 + (lane >> 5) * 8;
#pragma unroll 4
        for (int ks = 0; ks < 16; ++ks) {
            const bf16x8 wfr = *(const bf16x8*)(Wg + ks * 16);
            const int ch = ks * 2 + (lane >> 5);
#pragma unroll
            for (int mt = 0; mt < 2; ++mt) {
                const int row = mt * 32 + (lane & 31);
                const bf16x8 a = *(const LAS bf16x8*)(At + row * 512 + ((ch ^ (row & 7)) << 4));
                acc[mt] = mfma32(wfr, a, acc[mt]);
            }
        }
        const int m = isx ? b : 8;
#pragma unroll
        for (int mt = 0; mt < 2; ++mt)
#pragma unroll
            for (int rg = 0; rg < 4; ++rg) {
                const int tok = mt * 32 + (lane & 31), col = g * 256 + 32 * wave + 8 * rg + 4 * (lane >> 5);
                const f32x4 gs = *(const f32x4*)(modv + m * 6144 + 2048 + col) * *(const f32x4*)(P.pool_scale + col);
                const f32x4 av = {acc[mt][rg * 4 + 0], acc[mt][rg * 4 + 1], acc[mt][rg * 4 + 2], acc[mt][rg * 4 + 3]};
                f32x4 hv; int grow;
                if (isx) { grow = b * 2048 + r * 64 + tok; hv = __builtin_nontemporal_load((const f32x4*)(P.x + (size_t)grow * 1024 + col)) + gs * av; }
                else { const size_t gi = ((size_t)b * 256 + 64 * seg + tok) * 1024 + col; grow = NX + b * 256 + 64 * seg + tok; hv = *(const f32x4*)(P.ctx + gi) + gs * av; }
                u32x2 hp; hp.x = pk2(hv.x, hv.y); hp.y = pk2(hv.z, hv.w);
                *(u32x2*)(hrow(P, grow) + col) = hp;
            }
        __syncthreads();
    }
}

DEV bf16x8 frag_row_x(ldsp x, int r0, int k0, int lane) {
    const int row = r0 + (lane & 31), ch = (k0 >> 3) + (lane >> 5);
    return *(const LAS bf16x8*)(x + row * 256 + ((ch ^ (row & 15)) << 4));
}
DEV unsigned key_of(float f) { const unsigned u = __float_as_uint(f); return u ^ ((unsigned)((int)u >> 31) | 0x80000000u); }
DEV float val_of(unsigned k) { const unsigned u = (k & 0x80000000u) ? (k ^ 0x80000000u) : ~k; return __uint_as_float(u); }
DEV void cmpx(unsigned& hi, unsigned& lo) { const unsigned a = hi, b = lo; hi = a > b ? a : b; lo = a > b ? b : a; }
DEV void sort16_desc(unsigned* v) {
#pragma unroll
    for (int k = 2; k <= 16; k <<= 1)
#pragma unroll
        for (int j = k >> 1; j > 0; j >>= 1)
#pragma unroll
            for (int i = 0; i < 16; ++i) {
                const int l = i ^ j;
                if (l > i) { if ((i & k) == 0) cmpx(v[i], v[l]); else cmpx(v[l], v[i]); }
            }
}
DEV void merge16(unsigned* r, const unsigned* b) {
#pragma unroll
    for (int k = 0; k < 16; ++k) r[k] = r[k] > b[15 - k] ? r[k] : b[15 - k];
#pragma unroll
    for (int j = 8; j > 0; j >>= 1)
#pragma unroll
        for (int i = 0; i < 16; ++i) { const int l = i ^ j; if (l > i) cmpx(r[i], r[l]); }
}
DEV void top16_of_64(unsigned* v, unsigned* r) {
#pragma unroll
    for (int blk = 0; blk < 4; ++blk) sort16_desc(v + 16 * blk);
#pragma unroll
    for (int k = 0; k < 16; ++k) r[k] = v[k];
    merge16(r, v + 16); merge16(r, v + 32); merge16(r, v + 48);
}
DEV void phase_topk(const Params& P, int layer, int nrows, ldsp lds0) {
    const bf16_t* Q = (const bf16_t*)(P.ws + OFF_R1);
    const bf16_t* keys = (const bf16_t*)(P.ws + OFF_KEYS) + (size_t)layer * 8 * 2 * 128 * 128;
    bf16_t* seli = (bf16_t*)(P.ws + OFF_SELI);
    float* selg = (float*)(P.ws + OFF_SELG);
    const int tid = tid_fresh(), lane = tid & 63, wave = tid >> 6;
    const int nitems = (nrows / 256) * 4;
    const unsigned hoff = (unsigned)(lane >> 5) * 4u;
    const int G = gridDim.x, nfr = nitems / G, left = nitems - nfr * G;
    int per = 0;
    if (left) { per = (left * 8 + G - 1) / G; per = per <= 1 ? 1 : per <= 2 ? 2 : per <= 4 ? 4 : 8; }
    const int nloop = nfr + ((left && (int)blockIdx.x * per < left * 8) ? 1 : 0);
    for (int it = 0; it < nloop; ++it) {
        const ldsp lds = launder(lds0);
        LAS unsigned* sl = (LAS unsigned*)(lds + 65536 + wave * 8192);
        int item, wtask; bool act;
        if (it < nfr) { item = it * G + blockIdx.x; wtask = wave; act = true; }
        else { const int j = blockIdx.x * per + wave; item = nfr * G + ((blockIdx.x * per) >> 3); wtask = j & 7; act = wave < per; }
        act = __builtin_amdgcn_readfirstlane((int)act) != 0;
        const int tg = item >> 2, hp = item & 3, row0 = tg * 256 + wtask * 32;
        u32x4 kr[4]; bf16x8 qf[8];
        {
            const bf16_t* kt = keys + (size_t)((hp * 2) * 2) * 128 * 128;
#pragma unroll
            for (int j = 0; j < 4; ++j) { const int cid = tid + NTHREADS * j, r = cid >> 4, ch = cid & 15; kr[j] = *(const u32x4*)(kt + r * 128 + ch * 8); }
#pragma unroll
            for (int j = 0; j < 4; ++j) { const int cid = tid + NTHREADS * j, r = cid >> 4, ch = cid & 15; *(LAS u32x4*)(lds + r * 256 + ((ch ^ (r & 15)) << 4)) = kr[j]; }
            const bf16_t* qb = Q + (size_t)(row0 + (lane & 31)) * 2048 + (hp * 2) * 256 + (lane >> 5) * 8;
#pragma unroll
            for (int ks = 0; ks < 8; ++ks) qf[ks] = *(const bf16x8*)(qb + ks * 16);
        }
        __syncthreads();
        unsigned s1[16], s2[16];
#pragma unroll
        for (int k = 0; k < 16; ++k) { s1[k] = 0u; s2[k] = 0u; }
#pragma unroll 1
        for (int step = 0; step < 4; ++step) {
            const int hs = step >> 1, p = step & 1;
            const bool mine = (lane >> 5) == hs;
            const ldsp kb = lds + (step & 1) * 32768;
            if (step < 3) {
                const bf16_t* kt = keys + (size_t)((hp * 2 + ((step + 1) >> 1)) * 2 + ((step + 1) & 1)) * 128 * 128;
#pragma unroll
                for (int j = 0; j < 4; ++j) { const int cid = tid + NTHREADS * j, r = cid >> 4, ch = cid & 15; kr[j] = *(const u32x4*)(kt + r * 128 + ch * 8); }
            }
            f32x16 acc[4];
#pragma unroll
            for (int mt = 0; mt < 4; ++mt) acc[mt] = zero16();
            if (act) {
#pragma unroll
            for (int ks = 0; ks < 8; ++ks)
#pragma unroll
                for (int mt = 0; mt < 4; ++mt) acc[mt] = mfma32(frag_row_x(kb, mt * 32, ks * 16, lane), qf[ks], acc[mt]);
            }
            if (step < 3) {
                const ldsp kn = lds + ((step + 1) & 1) * 32768;
#pragma unroll
                for (int j = 0; j < 4; ++j) { const int cid = tid + NTHREADS * j, r = cid >> 4, ch = cid & 15; *(LAS u32x4*)(kn + r * 256 + ((ch ^ (r & 15)) << 4)) = kr[j]; }
                const bf16_t* qb = Q + (size_t)(row0 + (lane & 31)) * 2048 + (hp * 2 + ((step + 1) >> 1)) * 256 + ((step + 1) & 1) * 128 + (lane >> 5) * 8;
#pragma unroll
                for (int ks = 0; ks < 8; ++ks) qf[ks] = *(const bf16x8*)(qb + ks * 16);
            }
            if (act) {
            unsigned v[64];
#pragma unroll
            for (int mt = 0; mt < 4; ++mt)
#pragma unroll
                for (int reg = 0; reg < 16; ++reg) {
                    const unsigned c = mt * 32 + (reg & 3) + 8 * (reg >> 2);
                    v[mt * 16 + reg] = ((key_of(acc[mt][reg]) & ~127u) | (127u - c)) ^ hoff;
                }
            unsigned r[16], o[16];
            top16_of_64(v, r);
#pragma unroll
            for (int k = 0; k < 16; ++k) o[k] = (unsigned)__shfl_xor((int)r[k], 32);
            merge16(r, o);
#pragma unroll
            for (int k = 0; k < 16; ++k) { if (p == 0) s1[k] = mine ? r[k] : s1[k]; else s2[k] = mine ? r[k] : s2[k]; }
            }
            __syncthreads();
        }
        if (!act) continue;
        float f1[16], f2[16];
#pragma unroll
        for (int k = 0; k < 16; ++k) {
            sl[k * 64 + lane] = s1[k]; sl[(16 + k) * 64 + lane] = s2[k];
            f1[k] = val_of(s1[k] & ~127u); f2[k] = val_of(s2[k] & ~127u);
        }
        unsigned cv[64];
        {
            int n = 0;
#pragma unroll
            for (int a = 0; a < 16; ++a)
#pragma unroll
                for (int b = 0; b < 16; ++b)
                    if ((a + 1) * (b + 1) <= 16) { cv[n] = (key_of(f1[a] + f2[b]) & ~255u) | (255u - (unsigned)(a * 16 + b)); ++n; }
#pragma unroll
            for (int q = 50; q < 64; ++q) cv[q] = 0u;
        }
        unsigned w[16];
        top16_of_64(cv, w);
        float sc[16]; int ei[16];
#pragma unroll
        for (int k = 0; k < 16; ++k) {
            const unsigned ab = 255u - (w[k] & 255u);
            const unsigned k1 = sl[(ab >> 4) * 64 + lane], k2 = sl[(16 + (ab & 15u)) * 64 + lane];
            ei[k] = (int)((127u - (k1 & 127u)) * 128u + (127u - (k2 & 127u)));
            sc[k] = val_of(w[k] & ~255u);
        }
        const float mx = sc[0];
        float tot = 0.f;
#pragma unroll
        for (int k = 0; k < 16; ++k) { sc[k] = expf(sc[k] - mx); tot += sc[k]; }
        const int row = row0 + (lane & 31), head = hp * 2 + (lane >> 5);
        bf16_t* ip = seli + (size_t)row * 128 + head * 16;
        float* gp = selg + (size_t)row * 128 + head * 16;
        const float inv = 1.f / tot;
#pragma unroll
        for (int q = 0; q < 2; ++q) {
            u32x4 o;
#pragma unroll
            for (int d = 0; d < 4; ++d) o[d] = (unsigned)ei[8 * q + 2 * d] | ((unsigned)ei[8 * q + 2 * d + 1] << 16);
            *(u32x4*)(ip + 8 * q) = o;
        }
#pragma unroll
        for (int q = 0; q < 4; ++q) *(float4*)(gp + 4 * q) = make_float4(sc[4 * q] * inv, sc[4 * q + 1] * inv, sc[4 * q + 2] * inv, sc[4 * q + 3] * inv);
    }
}

struct XGeo { int nloc, rank, nact, pos; };
typedef float f32x2 __attribute__((ext_vector_type(2)));
DEV void fp8x16_to_f32(const u32x4 r, float* f) {
#pragma unroll
    for (int d = 0; d < 4; ++d) {
        const f32x2 lo = __builtin_amdgcn_cvt_pk_f32_fp8((int)r[d], false), hi = __builtin_amdgcn_cvt_pk_f32_fp8((int)r[d], true);
        f[4 * d + 0] = lo.x; f[4 * d + 1] = lo.y; f[4 * d + 2] = hi.x; f[4 * d + 3] = hi.y;
    }
}
template <int S, int MUL, class T>
DEV void bfly_stage(T* p, int lane) {
    const bool hi = (lane & (S * MUL)) != 0;
#pragma unroll
    for (int i = 0; i < 2 * S; ++i) { const T keep = hi ? p[i + 2 * S] : p[i], send = hi ? p[i] : p[i + 2 * S]; p[i] = keep + __shfl_xor(send, S * MUL); }
}
template <int N2>
DEV void bfly_swap32(float* p) {
#pragma unroll
    for (int i = 0; i < N2; ++i) { const auto r = __builtin_amdgcn_permlane32_swap(__float_as_uint(p[i]), __float_as_uint(p[i + N2]), false, false); p[i] = __uint_as_float(r[0]) + __uint_as_float(r[1]); }
}
template <int N2>
DEV void bfly_swap16(float* p) {
#pragma unroll
    for (int i = 0; i < N2; ++i) { const auto r = __builtin_amdgcn_permlane16_swap(__float_as_uint(p[i]), __float_as_uint(p[i + N2]), false, false); p[i] = __uint_as_float(r[0]) + __uint_as_float(r[1]); }
}
template <int N2>
DEV void bfly_ror8(float* p, int lane) {
    const bool hi = (lane & 8) != 0;
#pragma unroll
    for (int i = 0; i < N2; ++i) {
        const float a = p[i] + __uint_as_float((unsigned)__builtin_amdgcn_update_dpp(0, (int)__float_as_uint(p[i]), 0x128, 0xf, 0xf, false));
        const float b = p[i + N2] + __uint_as_float((unsigned)__builtin_amdgcn_update_dpp(0, (int)__float_as_uint(p[i + N2]), 0x128, 0xf, 0xf, false));
        p[i] = hi ? b : a;
    }
}
template <int STAGE>
DEV void ex_issue(u32x4 (&buf)[16], u32x4 (&aux)[4], f32x2 (&hg)[2], const u32x4 (&idn)[2], const unsigned char* slice, const Params& P, const bf16_t* A, const bf16_t* wexp,
                  const float* gatev, int t, int sl, int g, int c) {
    int id[16];
#pragma unroll
    for (int q = 0; q < 2; ++q)
#pragma unroll
        for (int d = 0; d < 4; ++d) { id[8 * q + 2 * d] = (int)(idn[q][d] & 0xffffu); id[8 * q + 2 * d + 1] = (int)(idn[q][d] >> 16); }
#pragma unroll
    for (int k = 0; k < 16; ++k) buf[k] = *(const u32x4*)(slice + (size_t)id[k] * 128);
    if (STAGE == 1) {
        aux[0] = *(const u32x4*)(P.ws + OFF_A8 + (size_t)t * 1024 + 256 * sl + 32 * c); aux[1] = *(const u32x4*)(P.ws + OFF_A8 + (size_t)t * 1024 + 256 * sl + 32 * c + 16);
        hg[0].x = ((const float*)(P.ws + OFF_XS))[t];
    } else {
#pragma unroll
        for (int q = 0; q < 2; ++q) aux[q] = *(const u32x4*)(wexp + (size_t)t * 128 + 16 * g + 8 * q);
        const int col = 256 * sl + 32 * c + 4 * g, m = t < NX ? (t >> 11) : 8;
        const u32x2 hv = *(const u32x2*)(hrow(P, t) + col);
        aux[2] = (u32x4){hv.x, hv.y, 0u, 0u};
        aux[3] = *(const u32x4*)(gatev + m * 6144 + col);
    }
}
template <int STAGE>
DEV void ex_compute(const u32x4 (&buf)[16], const u32x4 (&aux)[4], const f32x2 (&hg)[2], const Params& P, float* part, int t, int sl, int lane, int g, int c) {
    if (STAGE == 1) {
        int sx = 0;
#pragma unroll
        for (int q = 0; q < 2; ++q)
#pragma unroll
            for (int d = 0; d < 4; ++d) sx = __builtin_amdgcn_sdot4(0x01010101, (int)aux[q][d], sx, false);
        int p[16];
#pragma unroll
        for (int k = 0; k < 16; ++k) {
            int a = -8 * sx;
#pragma unroll
            for (int d = 0; d < 4; ++d) {
                const unsigned w = buf[k][d];
                a = __builtin_amdgcn_sdot4((int)(w & 0x0F0F0F0Fu), (int)aux[d >> 1][2 * (d & 1)], a, false);
                a = __builtin_amdgcn_sdot4((int)((w >> 4) & 0x0F0F0F0Fu), (int)aux[d >> 1][2 * (d & 1) + 1], a, false);
            }
            p[k] = a;
        }
        bfly_stage<4, 1>(p, lane); bfly_stage<2, 1>(p, lane); bfly_stage<1, 1>(p, lane);
        const float xs = hg[0].x;
        *(unsigned*)((bf16_t*)part + ((size_t)sl * NT + t) * 128 + 2 * lane) = pk2((float)p[0] * xs, (float)p[1] * xs);
    } else {
        f32x2 p2[16];
#pragma unroll
        for (int i = 0; i < 16; ++i) p2[i] = (f32x2){0.f, 0.f};
#pragma unroll
        for (int k = 0; k < 16; ++k) {
            const unsigned wpk = aux[k >> 3][(k >> 1) & 3];
            const float wkf = (k & 1) ? bfhi(wpk) : bflo(wpk);
            const f32x2 w2 = {wkf, wkf};
#pragma unroll
            for (int d = 0; d < 4; ++d) {
                p2[4 * d + 0] += w2 * __builtin_amdgcn_cvt_scalef32_pk_f32_fp4(buf[k][d], 1.0f, 0);
                p2[4 * d + 1] += w2 * __builtin_amdgcn_cvt_scalef32_pk_f32_fp4(buf[k][d], 1.0f, 1);
                p2[4 * d + 2] += w2 * __builtin_amdgcn_cvt_scalef32_pk_f32_fp4(buf[k][d], 1.0f, 2);
                p2[4 * d + 3] += w2 * __builtin_amdgcn_cvt_scalef32_pk_f32_fp4(buf[k][d], 1.0f, 3);
            }
            asm volatile("" : "+v"(p2[0]), "+v"(p2[1]), "+v"(p2[2]), "+v"(p2[3]), "+v"(p2[4]), "+v"(p2[5]), "+v"(p2[6]), "+v"(p2[7]),
                              "+v"(p2[8]), "+v"(p2[9]), "+v"(p2[10]), "+v"(p2[11]), "+v"(p2[12]), "+v"(p2[13]), "+v"(p2[14]), "+v"(p2[15]));
        }
        float p[32];
#pragma unroll
        for (int i = 0; i < 16; ++i) { p[2 * i] = p2[i].x; p[2 * i + 1] = p2[i].y; }
        bfly_stage<8, 4>(p, lane); bfly_stage<4, 4>(p, lane); bfly_stage<2, 4>(p, lane);
        const int col = 256 * sl + 32 * c + 4 * g;
        const unsigned h0 = aux[2].x, h1 = aux[2].y;
        u32x2 ho;
        ho.x = pk2(bflo(h0) + __uint_as_float(aux[3].x) * p[0], bfhi(h0) + __uint_as_float(aux[3].y) * p[1]);
        ho.y = pk2(bflo(h1) + __uint_as_float(aux[3].z) * p[2], bfhi(h1) + __uint_as_float(aux[3].w) * p[3]);
        *(u32x2*)(hrow(P, t) + col) = ho;
    }
}
template <int STAGE>
DEV void phase_experts_sliced(const Params& P, int layer, int nrows, const XGeo geo) {
    const unsigned char* tab = P.ws + OFF_TAB + (size_t)(layer * 2 + (STAGE - 1)) * 16 * MiB;
    const bf16_t* A = (const bf16_t*)(P.ws + OFF_A);
    const bf16_t* seli = (const bf16_t*)(P.ws + OFF_SELI);
    float* part = (float*)(P.ws + OFF_PART);
    const bf16_t* wexp = (const bf16_t*)(P.ws + OFF_WEXP);
    const float* gatev = (const float*)(P.ws + OFF_MODV) + (size_t)layer * 9 * 6144 + 5 * 1024;
    const int tid = tid_fresh(), wave = tid >> 6, lane = tid & 63, g = lane >> 3, c = lane & 7;
    const int nw = geo.nloc * 8, wr = geo.rank * 8 + wave;
    for (int vs = geo.pos; vs < 8; vs += geo.nact) {
        const int sl = vs >> 1, tmul = 2, tadd = vs & 1;
        const unsigned char* slice = tab + (size_t)sl * 2 * MiB + 16 * c;
        const int nws = nw * tmul;
        int t = wr * tmul + tadd;
        if (t >= nrows) continue;
        u32x4 bufA[16], bufB[16], auxA[4], auxB[4]; f32x2 hgA[2], hgB[2]; u32x4 idn[2];
#pragma unroll
        for (int q = 0; q < 2; ++q) idn[q] = *(const u32x4*)(seli + (size_t)t * 128 + 16 * g + 8 * q);
        ex_issue<STAGE>(bufA, auxA, hgA, idn, slice, P, A, wexp, gatev, t, sl, g, c);
        if (t + nws < nrows) {
#pragma unroll
            for (int q = 0; q < 2; ++q) idn[q] = *(const u32x4*)(seli + (size_t)(t + nws) * 128 + 16 * g + 8 * q);
        }
        for (;;) {
            {
                const int t1 = t + nws;
                if (t1 < nrows) {
                    ex_issue<STAGE>(bufB, auxB, hgB, idn, slice, P, A, wexp, gatev, t1, sl, g, c);
                    if (t1 + nws < nrows) {
#pragma unroll
                        for (int q = 0; q < 2; ++q) idn[q] = *(const u32x4*)(seli + (size_t)(t1 + nws) * 128 + 16 * g + 8 * q);
                    }
                }
                ex_compute<STAGE>(bufA, auxA, hgA, P, part, t, sl, lane, g, c);
            }
            t += nws; if (t >= nrows) break;
            {
                const int t1 = t + nws;
                if (t1 < nrows) {
                    ex_issue<STAGE>(bufA, auxA, hgA, idn, slice, P, A, wexp, gatev, t1, sl, g, c);
                    if (t1 + nws < nrows) {
#pragma unroll
                        for (int q = 0; q < 2; ++q) idn[q] = *(const u32x4*)(seli + (size_t)(t1 + nws) * 128 + 16 * g + 8 * q);
                    }
                }
                ex_compute<STAGE>(bufB, auxB, hgB, P, part, t, sl, lane, g, c);
            }
            t += nws; if (t >= nrows) break;
        }
    }
}
DEV void eu_issue_unit(u32x4 (&buf)[16], u32x4 (&xq)[2], const u32x4 (&idn)[2], const unsigned char* tab, const Params& P, int t, int sl, int c) {
    int id[16];
#pragma unroll
    for (int q = 0; q < 2; ++q)
#pragma unroll
        for (int d = 0; d < 4; ++d) { id[8 * q + 2 * d] = (int)(idn[q][d] & 0xffffu); id[8 * q + 2 * d + 1] = (int)(idn[q][d] >> 16); }
    const unsigned char* slice = tab + (size_t)sl * 2 * MiB + 16 * c;
#pragma unroll
    for (int k = 0; k < 16; ++k) buf[k] = *(const u32x4*)(slice + (size_t)id[k] * 128);
    xq[0] = *(const u32x4*)(P.ws + OFF_A8 + (size_t)t * 1024 + 256 * sl + 32 * c); xq[1] = *(const u32x4*)(P.ws + OFF_A8 + (size_t)t * 1024 + 256 * sl + 32 * c + 16);
}
DEV void eu_compute_unit(const u32x4 (&buf)[16], const u32x4 (&xq)[2], LAS float* acc2, int lane) {
    int p[16];
#pragma unroll
    for (int k = 0; k < 16; ++k) {
        int ah = 0, al = 0;
#pragma unroll
        for (int d = 0; d < 4; ++d) {
            ah = __builtin_amdgcn_sdot8((int)buf[k][d], (int)xq[0][d], ah, false);
            al = __builtin_amdgcn_sdot8((int)buf[k][d], (int)xq[1][d], al, false);
        }
        p[k] = 16 * ah + al;
    }
    bfly_stage<4, 1>(p, lane); bfly_stage<2, 1>(p, lane); bfly_stage<1, 1>(p, lane);
    f32x2 a2 = *(const LAS f32x2*)acc2;
    a2.x += (float)p[0]; a2.y += (float)p[1];
    *(LAS f32x2*)acc2 = a2;
}
DEV void phase_experts_u(const Params& P, int layer, int nrows, ldsp lds0) {
    const unsigned char* tab = P.ws + OFF_TAB + (size_t)(layer * 2) * 16 * MiB;
    const bf16_t* seli = (const bf16_t*)(P.ws + OFF_SELI);
    const float* selg = (const float*)(P.ws + OFF_SELG);
    bf16_t* wexp = (bf16_t*)(P.ws + OFF_WEXP);
    const float* rsu = (const float*)(P.ws + OFF_RSC) + (size_t)(layer * 2) * 16384;
    const float* rsv = rsu + 16384;
    const float* xsv = (const float*)(P.ws + OFF_XS);
    const int tid = tid_fresh(), wave = __builtin_amdgcn_readfirstlane(tid >> 6), lane = tid & 63, g = lane >> 3, c = lane & 7;
    const int gw = blockIdx.x * 8 + wave, nwv = gridDim.x * 8;
    if (gw >= nrows) return;
    const int ntok = (nrows - gw + nwv - 1) / nwv, U = 4 * ntok;
    LAS float* accs = (LAS float*)(launder(lds0) + wave * 8192);
    for (int k = 0; k < ntok; ++k) *(LAS f32x2*)(accs + k * 128 + 2 * lane) = (f32x2){0.f, 0.f};
    u32x4 bufA[16], bufB[16], xqA[2], xqB[2], idn[2];
    int ku = 0, slu = 0;
#define EU_NEXT_IDX() do { const int tt = gw + ku * nwv; _Pragma("unroll") for (int q = 0; q < 2; ++q) idn[q] = *(const u32x4*)(seli + (size_t)tt * 128 + 16 * g + 8 * q); } while (0)
#define EU_ADVANCE() do { if (++ku == ntok) { ku = 0; ++slu; } } while (0)
    EU_NEXT_IDX();
    int kA = ku, slA = slu; eu_issue_unit(bufA, xqA, idn, tab, P, gw + kA * nwv, slA, c); EU_ADVANCE();
    if (U > 1) EU_NEXT_IDX();
    int kB = 0, slB = 0;
    for (int u = 0; u < U; u += 2) {
        if (u + 1 < U) { kB = ku; slB = slu; eu_issue_unit(bufB, xqB, idn, tab, P, gw + kB * nwv, slB, c); EU_ADVANCE(); if (u + 2 < U) EU_NEXT_IDX(); }
        eu_compute_unit(bufA, xqA, accs + kA * 128 + 2 * lane, lane);
        if (u + 1 >= U) break;
        if (u + 2 < U) { kA = ku; slA = slu; eu_issue_unit(bufA, xqA, idn, tab, P, gw + kA * nwv, slA, c); EU_ADVANCE(); if (u + 3 < U) EU_NEXT_IDX(); }
        eu_compute_unit(bufB, xqB, accs + kB * 128 + 2 * lane, lane);
    }
#undef EU_NEXT_IDX
#undef EU_ADVANCE
    for (int k = 0; k < ntok; ++k) {
        const int t = gw + k * nwv;
        const unsigned ep = *(const unsigned*)(seli + (size_t)t * 128 + 2 * lane);
        const f32x2 gt = *(const f32x2*)(selg + (size_t)t * 128 + 2 * lane);
        const f32x2 a2 = *(const LAS f32x2*)(accs + k * 128 + 2 * lane);
        const int e0 = (int)(ep & 0xffffu), e1 = (int)(ep >> 16);
        const float xs = xsv[t];
        const float h0 = a2.x * xs * rsu[e0], h1 = a2.y * xs * rsu[e1];
        const float w0 = gt.x * (0.5f * h0 * (1.f + erff(h0 * 0.70710678118654752f))) * rsv[e0];
        const float w1 = gt.y * (0.5f * h1 * (1.f + erff(h1 * 0.70710678118654752f))) * rsv[e1];
        *(unsigned*)(wexp + (size_t)t * 128 + 2 * lane) = pk2(w0, w1);
    }
}
DEV void ev_issue_unit(u32x4 (&buf)[16], u32x2& hv, u32x4& gt, const u32x4 (&idn)[2], const unsigned char* tab, const Params& P, const float* gatev, int t, int sl, int g, int c) {
    int id[16];
#pragma unroll
    for (int q = 0; q < 2; ++q)
#pragma unroll
        for (int d = 0; d < 4; ++d) { id[8 * q + 2 * d] = (int)(idn[q][d] & 0xffffu); id[8 * q + 2 * d + 1] = (int)(idn[q][d] >> 16); }
    const unsigned char* slice = tab + (size_t)sl * 2 * MiB + 16 * c;
#pragma unroll
    for (int k = 0; k < 16; ++k) buf[k] = *(const u32x4*)(slice + (size_t)id[k] * 128);
    const int col = 256 * sl + 32 * c + 4 * g, m = t < NX ? (t >> 11) : 8;
    hv = *(const u32x2*)(hrow(P, t) + col);
    gt = *(const u32x4*)(gatev + m * 6144 + col);
}
DEV void ev_compute_unit(const u32x4 (&buf)[16], const u32x2 hv, const u32x4 gt, const LAS float* wS, const Params& P, int t, int sl, int lane, int g, int c) {
    f32x2 p2[16];
#pragma unroll
    for (int i = 0; i < 16; ++i) p2[i] = (f32x2){0.f, 0.f};
    f32x4 wq[4];
#pragma unroll
    for (int q = 0; q < 4; ++q) wq[q] = *(const LAS f32x4*)(wS + 4 * q);
#pragma unroll
    for (int k = 0; k < 16; ++k) {
        const float wkf = wq[k >> 2][k & 3];
        const f32x2 w2 = {wkf, wkf};
#pragma unroll
        for (int d = 0; d < 4; ++d) {
            p2[4 * d + 0] += w2 * __builtin_amdgcn_cvt_scalef32_pk_f32_fp4(buf[k][d], 1.0f, 0);
            p2[4 * d + 1] += w2 * __builtin_amdgcn_cvt_scalef32_pk_f32_fp4(buf[k][d], 1.0f, 1);
            p2[4 * d + 2] += w2 * __builtin_amdgcn_cvt_scalef32_pk_f32_fp4(buf[k][d], 1.0f, 2);
            p2[4 * d + 3] += w2 * __builtin_amdgcn_cvt_scalef32_pk_f32_fp4(buf[k][d], 1.0f, 3);
        }
        asm volatile("" : "+v"(p2[0]), "+v"(p2[1]), "+v"(p2[2]), "+v"(p2[3]), "+v"(p2[4]), "+v"(p2[5]), "+v"(p2[6]), "+v"(p2[7]),
                          "+v"(p2[8]), "+v"(p2[9]), "+v"(p2[10]), "+v"(p2[11]), "+v"(p2[12]), "+v"(p2[13]), "+v"(p2[14]), "+v"(p2[15]));
    }
    float p[32];
#pragma unroll
    for (int i = 0; i < 16; ++i) { p[2 * i] = p2[i].x; p[2 * i + 1] = p2[i].y; }
    bfly_swap32<16>(p); bfly_swap16<8>(p); bfly_ror8<4>(p, lane);
    const int col = 256 * sl + 32 * c + 4 * g;
    u32x2 ho;
    ho.x = pk2(bflo(hv.x) + __uint_as_float(gt.x) * p[0], bfhi(hv.x) + __uint_as_float(gt.y) * p[1]);
    ho.y = pk2(bflo(hv.y) + __uint_as_float(gt.z) * p[2], bfhi(hv.y) + __uint_as_float(gt.w) * p[3]);
    *(u32x2*)(hrow(P, t) + col) = ho;
}
DEV void phase_experts(const Params& P, int layer, int nrows, ldsp lds0) {
    const unsigned char* tabu = P.ws + OFF_TAB + (size_t)(layer * 2) * 16 * MiB;
    const unsigned char* tabv = tabu + 16 * MiB;
    const bf16_t* seli = (const bf16_t*)(P.ws + OFF_SELI);
    const float* selg = (const float*)(P.ws + OFF_SELG);
    const float* rsu = (const float*)(P.ws + OFF_RSC) + (size_t)(layer * 2) * 16384;
    const float* rsv = rsu + 16384;
    const float* xsv = (const float*)(P.ws + OFF_XS);
    const float* gatev = (const float*)(P.ws + OFF_MODV) + (size_t)layer * 9 * 6144 + 5 * 1024;
    const int tid = tid_fresh(), wave = __builtin_amdgcn_readfirstlane(tid >> 6), lane = tid & 63, g = lane >> 3, c = lane & 7;
    const int gw = blockIdx.x * 8 + wave, nwv = gridDim.x * 8;
    if (gw >= nrows) return;
    const int ntok = (nrows - gw + nwv - 1) / nwv, U = 4 * ntok;
    LAS float* accs = (LAS float*)(launder(lds0) + wave * 8192);
    for (int k = 0; k < ntok; ++k) *(LAS f32x2*)(accs + k * 128 + 2 * lane) = (f32x2){0.f, 0.f};
    u32x4 bufA[16], bufB[16], idn[2];
    int ku = 0, slu = 0;
#define EU_NEXT_IDX() do { const int tt = gw + ku * nwv; _Pragma("unroll") for (int q = 0; q < 2; ++q) idn[q] = *(const u32x4*)(seli + (size_t)tt * 128 + 16 * g + 8 * q); } while (0)
#define EU_ADVANCE() do { if (++ku == ntok) { ku = 0; ++slu; } } while (0)
    int kA, slA, kB = 0, slB = 0;
    {
        u32x4 xqA[2], xqB[2];
        EU_NEXT_IDX();
        kA = ku; slA = slu; eu_issue_unit(bufA, xqA, idn, tabu, P, gw + kA * nwv, slA, c); EU_ADVANCE();
        if (U > 1) EU_NEXT_IDX();
        for (int u = 0; u < U; u += 2) {
            if (u + 1 < U) { kB = ku; slB = slu; eu_issue_unit(bufB, xqB, idn, tabu, P, gw + kB * nwv, slB, c); EU_ADVANCE(); if (u + 2 < U) EU_NEXT_IDX(); }
            eu_compute_unit(bufA, xqA, accs + kA * 128 + 2 * lane, lane);
            if (u + 1 >= U) break;
            if (u + 2 < U) { kA = ku; slA = slu; eu_issue_unit(bufA, xqA, idn, tabu, P, gw + kA * nwv, slA, c); EU_ADVANCE(); if (u + 3 < U) EU_NEXT_IDX(); }
            eu_compute_unit(bufB, xqB, accs + kB * 128 + 2 * lane, lane);
        }
    }
    u32x2 hvA, hvB; u32x4 gtA, gtB;
    ku = 0; slu = 0;
    EU_NEXT_IDX();
    kA = ku; slA = slu; ev_issue_unit(bufA, hvA, gtA, idn, tabv, P, gatev, gw + kA * nwv, slA, g, c); EU_ADVANCE();
    if (U > 1) EU_NEXT_IDX();
    for (int k = 0; k < ntok; ++k) {
        const int t = gw + k * nwv;
        const unsigned ep = *(const unsigned*)(seli + (size_t)t * 128 + 2 * lane);
        const f32x2 gt = *(const f32x2*)(selg + (size_t)t * 128 + 2 * lane);
        const f32x2 a2 = *(const LAS f32x2*)(accs + k * 128 + 2 * lane);
        const int e0 = (int)(ep & 0xffffu), e1 = (int)(ep >> 16);
        const float xs = xsv[t];
        const float h0 = a2.x * xs * rsu[e0], h1 = a2.y * xs * rsu[e1];
        f32x2 w;
        w.x = gt.x * (0.5f * h0 * (1.f + erff(h0 * 0.70710678118654752f))) * rsv[e0];
        w.y = gt.y * (0.5f * h1 * (1.f + erff(h1 * 0.70710678118654752f))) * rsv[e1];
        *(LAS f32x2*)(accs + k * 128 + 2 * lane) = w;
    }
    for (int u = 0; u < U; u += 2) {
        if (u + 1 < U) { kB = ku; slB = slu; ev_issue_unit(bufB, hvB, gtB, idn, tabv, P, gatev, gw + kB * nwv, slB, g, c); EU_ADVANCE(); if (u + 2 < U) EU_NEXT_IDX(); }
        ev_compute_unit(bufA, hvA, gtA, accs + kA * 128 + 16 * g, P, gw + kA * nwv, slA, lane, g, c);
        if (u + 1 >= U) break;
        if (u + 2 < U) { kA = ku; slA = slu; ev_issue_unit(bufA, hvA, gtA, idn, tabv, P, gatev, gw + kA * nwv, slA, g, c); EU_ADVANCE(); if (u + 3 < U) EU_NEXT_IDX(); }
        ev_compute_unit(bufB, hvB, gtB, accs + kB * 128 + 16 * g, P, gw + kB * nwv, slB, lane, g, c);
    }
#undef EU_NEXT_IDX
#undef EU_ADVANCE
}
DEV void phase_experts_act(const Params& P, int layer, int nrows) {
    const bf16_t* seli = (const bf16_t*)(P.ws + OFF_SELI);
    const float* selg = (const float*)(P.ws + OFF_SELG);
    const float* part = (const float*)(P.ws + OFF_PART);
    bf16_t* wexp = (bf16_t*)(P.ws + OFF_WEXP);
    const float* rsu = (const float*)(P.ws + OFF_RSC) + (size_t)(layer * 2) * 16384;
    const float* rsv = rsu + 16384;
    const int tid = tid_fresh();
    const int n4 = nrows * 32;
    for (int i4 = blockIdx.x * NTHREADS + tid; i4 < n4; i4 += gridDim.x * NTHREADS) {
        const size_t idx = (size_t)i4 * 4;
        f32x4 h = {0.f, 0.f, 0.f, 0.f};
#pragma unroll
        for (int s = 0; s < 4; ++s) { const u32x2 pv = *(const u32x2*)((const bf16_t*)part + (size_t)s * NT * 128 + idx); h += (f32x4){bflo(pv.x), bfhi(pv.x), bflo(pv.y), bfhi(pv.y)}; }
        const u32x2 e = *(const u32x2*)(seli + idx);
        const f32x4 gt = *(const f32x4*)(selg + idx);
        const int ee[4] = {(int)(e.x & 0xffffu), (int)(e.x >> 16), (int)(e.y & 0xffffu), (int)(e.y >> 16)};
        f32x4 o;
#pragma unroll
        for (int q = 0; q < 4; ++q) {
            const float hh = h[q] * rsu[ee[q]];
            o[q] = gt[q] * (0.5f * hh * (1.f + erff(hh * 0.70710678118654752f))) * rsv[ee[q]];
        }
        u32x2 ow; ow.x = pk2(o[0], o[1]); ow.y = pk2(o[2], o[3]);
        *(u32x2*)(wexp + idx) = ow;
    }
}
DEV void phase_final(const Params& P) {
    const int tid = tid_fresh(), wave = tid >> 6, lane = tid & 63;
    for (int r = blockIdx.x * 8 + wave; r < NX; r += gridDim.x * 8) {
        float* h = P.out + (size_t)r * 1024;
        f32x4 v[4]; float ss = 0.f;
#pragma unroll
        for (int j = 0; j < 4; ++j) { const u32x2 hv = *(const u32x2*)(hrow(P, r) + j * 256 + lane * 4); v[j] = (f32x4){bflo(hv.x), bfhi(hv.x), bflo(hv.y), bfhi(hv.y)};
            ss += v[j].x * v[j].x + v[j].y * v[j].y + v[j].z * v[j].z + v[j].w * v[j].w; }
        ss = wave_sum(ss);
        const float rstd = rsqrtf(ss * (1.f / 1024.f) + EPS);
#pragma unroll
        for (int j = 0; j < 4; ++j) { const f32x4 gg = *(const f32x4*)(P.final_g + j * 256 + lane * 4); __builtin_nontemporal_store(v[j] * rstd * gg, (f32x4*)(h + j * 256 + lane * 4)); }
    }
}

DEV void phase_conv(const Params& P) {
    const bf16_t* Pq = (const bf16_t*)(P.ws + OFF_R1);
    const float* ab = (const float*)(P.ws + OFF_AB);
    bf16_t* dst[3] = {(bf16_t*)(P.ws + OFF_QC), (bf16_t*)(P.ws + OFF_KC), (bf16_t*)(P.ws + OFF_VC)};
    float* gbuf = (float*)(P.ws + OFF_G);
    float* bbuf = (float*)(P.ws + OFF_BETA);
    const int tid = tid_fresh(), wave = tid >> 6, lane = tid & 63;
    constexpr int NSEG = NT / 16;
    for (int item = blockIdx.x * 8 + wave; item < NSEG * 6; item += gridDim.x * 8) {
        const int seg = item / 6, jc = item - seg * 6, row0 = seg * 16;
        int t0, L;
        if (row0 < NX) { t0 = row0 & 2047; L = 2048; } else { t0 = (row0 - NX) & 255; L = 256; }
        const int chunk = lane + 64 * jc, col = chunk * 8, part = jc >> 1;
        f32x4 w0[5], w1[5];
#pragma unroll
        for (int tap = 0; tap < 5; ++tap) { w0[tap] = *(const f32x4*)(P.dn_conv_w + tap * 3072 + col); w1[tap] = *(const f32x4*)(P.dn_conv_w + tap * 3072 + col + 4); }
        u32x4 raw[20];
#pragma unroll
        for (int i = 0; i < 20; ++i) {
            const int tt = t0 + i - 2;
            const bool ok = tt >= 0 && tt < L;
            const u32x4 v = *(const u32x4*)(Pq + (size_t)(row0 + (ok ? i - 2 : 0)) * 3072 + col);
            raw[i] = ok ? v : (u32x4){0u, 0u, 0u, 0u};
        }
        const float qs = part == 0 ? 0.08838834764831845f : 1.f;
        bf16_t* dp = dst[part] + (size_t)row0 * 1024 + (chunk & 127) * 8;
#pragma unroll
        for (int i = 0; i < 16; ++i) {
            float acc[8];
#pragma unroll
            for (int e = 0; e < 8; ++e) acc[e] = 0.f;
#pragma unroll
            for (int tap = 0; tap < 5; ++tap) {
                float f[8]; unpack8(raw[i + tap], f);
                acc[0] += f[0] * w0[tap].x; acc[1] += f[1] * w0[tap].y; acc[2] += f[2] * w0[tap].z; acc[3] += f[3] * w0[tap].w;
                acc[4] += f[4] * w1[tap].x; acc[5] += f[5] * w1[tap].y; acc[6] += f[6] * w1[tap].z; acc[7] += f[7] * w1[tap].w;
            }
            float ss = 0.f;
#pragma unroll
            for (int e = 0; e < 8; ++e) { acc[e] = silu(acc[e]); ss += acc[e] * acc[e]; }
            if (part < 2) {
                ss = sum16(ss);
                const float rn = rsqrtf(ss + EPS) * qs;
#pragma unroll
                for (int e = 0; e < 8; ++e) acc[e] *= rn;
            }
            u32x4 o; o.x = pk2(acc[0], acc[1]); o.y = pk2(acc[2], acc[3]); o.z = pk2(acc[4], acc[5]); o.w = pk2(acc[6], acc[7]);
            *(u32x4*)(dp + (size_t)i * 1024) = o;
        }
        if (jc == 0) {
            const int cc = lane & 31, d = cc >> 4, sx = (cc >> 3) & 1, h = cc & 7;
            const float a = __expf(P.dn_a_log[d * 8 + h]), dtb = P.dn_dt_bias[d * 8 + h];
            float v[8];
#pragma unroll
            for (int q = 0; q < 8; ++q) v[q] = ab[(size_t)(row0 + 2 * q + (lane >> 5)) * 32 + cc];
#pragma unroll
            for (int q = 0; q < 8; ++q) {
                const int row = row0 + 2 * q + (lane >> 5);
                if (sx == 0) {
                    const float xx = v[q] + dtb;
                    const float ex = __expf(fminf(xx, 30.f)), u = 1.f + ex;
                    const float l1p = (u == 1.f) ? ex : __logf(u) * ex * __builtin_amdgcn_rcpf(u - 1.f);
                    const float sp = xx > 20.f ? xx : l1p;
                    gbuf[((size_t)d * NT + row) * 8 + h] = -a * sp;
                } else {
                    bbuf[((size_t)d * NT + row) * 8 + h] = __builtin_amdgcn_rcpf(1.f + __expf(-v[q]));
                }
            }
        }
    }
}

DEV int chunk_rowbase(int b, int d, int n) {
    if (n < 4) { const int m = d ? 3 - n : n; return NX + b * 256 + m * 64; }
    const int m = d ? 31 - (n - 4) : n - 4; return b * 2048 + m * 64;
}

DEV bf16x8 frag_col_x(ldsp x, int c0, int k0, int lane) {
    const int col = c0 + (lane & 31), ch = col >> 3, sub = (col & 7) * 2;
    bf16x8 f;
#pragma unroll
    for (int j = 0; j < 8; ++j) { const int row = k0 + 8 * (lane >> 5) + j; f[j] = (short)*(const LAS bf16_t*)(x + row * 256 + ((ch ^ (row & 15)) << 4) + sub); }
    return f;
}
DEV void tile_rows8(const f32x16& acc, u32x4& o0, u32x4& o1) {
    unsigned p[4][2];
#pragma unroll
    for (int rg = 0; rg < 4; ++rg) { p[rg][0] = pk2(acc[rg * 4 + 0], acc[rg * 4 + 1]); p[rg][1] = pk2(acc[rg * 4 + 2], acc[rg * 4 + 3]); }
    const auto s00 = __builtin_amdgcn_permlane32_swap(p[0][0], p[2][0], false, false), s01 = __builtin_amdgcn_permlane32_swap(p[0][1], p[2][1], false, false);
    const auto s10 = __builtin_amdgcn_permlane32_swap(p[1][0], p[3][0], false, false), s11 = __builtin_amdgcn_permlane32_swap(p[1][1], p[3][1], false, false);
    o0 = (u32x4){s00[0], s01[0], s00[1], s01[1]};
    o1 = (u32x4){s10[0], s11[0], s10[1], s11[1]};
}
DEV bf16x8 frag_row_t(ldsp t, int r0, int k0, int lane) {
    const int row = r0 + (lane & 31), ch = (k0 >> 3) + (lane >> 5);
    return *(const LAS bf16x8*)(t + row * 128 + ((ch ^ (row & 7)) << 4));
}
DEV void phase_chunk(const Params& P, ldsp lds0) {
    const bf16_t* kc = (const bf16_t*)(P.ws + OFF_KC);
    const bf16_t* vc = (const bf16_t*)(P.ws + OFF_VC);
    const float* gbuf = (const float*)(P.ws + OFF_G);
    const float* bbuf = (const float*)(P.ws + OFF_BETA);
    bf16_t* wbuf = (bf16_t*)(P.ws + OFF_WBUF);
    bf16_t* ubuf = (bf16_t*)(P.ws + OFF_UBUF);
    float* gcbuf = (float*)(P.ws + OFF_GC);
    const int tid = tid_fresh(), lane = tid & 63, wave = tid >> 6, team = wave >> 1, tw = wave & 1, ttid = tid & 127;
    const int nteams = gridDim.x * 4, niter = (4608 + nteams - 1) / nteams;
    u32x4 rk[8];
    {
        const int item0 = min((int)(blockIdx.x * 4 + team), 4607);
        const int n = item0 % 36, d = (item0 / 36) & 1, bh = item0 / 72, rb0 = chunk_rowbase(bh >> 3, d, n);
#pragma unroll
        for (int j = 0; j < 8; ++j) { const int cid = ttid + 128 * j, i = cid >> 4, ch = cid & 15; rk[j] = *(const u32x4*)(kc + ((size_t)rb0 + (d ? 63 - i : i)) * 1024 + (bh & 7) * 128 + ch * 8); }
    }
    for (int it = 0; it < niter; ++it) {
        const int item = it * nteams + blockIdx.x * 4 + team;
        const bool act = item < 4608;
        const ldsp lds = launder(lds0);
        const ldsp sX = lds + team * 32768;
        const ldsp sT = sX + 16384;
        LAS float* sA = (LAS float*)sT;
        LAS float* sg = (LAS float*)(lds + 131072 + 128 + team * 768);
        const int n = item % 36, d = (item / 36) & 1, bh = item / 72, b = bh >> 3, h = bh & 7;
        const int rowbase = act ? chunk_rowbase(b, d, n) : 0;
        if (act) {
#pragma unroll
            for (int j = 0; j < 8; ++j) { const int cid = ttid + 128 * j, i = cid >> 4, ch = cid & 15; *(LAS u32x4*)(sX + i * 256 + ((ch ^ (i & 15)) << 4)) = rk[j]; }
            if (tw == 0) {
                const size_t grow = (size_t)rowbase + (d ? 63 - lane : lane);
                float v = gbuf[((size_t)d * NT + grow) * 8 + h];
#pragma unroll
                for (int o = 1; o < 64; o <<= 1) { const float t = __shfl_up(v, o); if (lane >= o) v += t; }
                sg[lane] = v; sg[64 + lane] = bbuf[((size_t)d * NT + grow) * 8 + h];
            }
        }
        __syncthreads();
        if (act) {
#pragma unroll 1
            for (int q = 0; q < 2; ++q) {
                const int mt = tw, nt = q;
                f32x16 acc = zero16();
#pragma unroll 4
                for (int ks = 0; ks < 8; ++ks) acc = mfma32(frag_row_x(sX, mt * 32, ks * 16, lane), frag_row_x(sX, nt * 32, ks * 16, lane), acc);
#pragma unroll
                for (int reg = 0; reg < 16; ++reg) {
                    const int i = mt * 32 + crow(reg, lane), j = nt * 32 + (lane & 31);
                    sA[i * 64 + j] = (i > j) ? sg[64 + i] * acc[reg] * __expf(sg[i] - sg[j]) : 0.f;
                }
            }
        }
        __syncthreads();
        if (act && tw == 0) {
            float t[64];
            int ln = lane; asm volatile("" : "+v"(ln));
#pragma unroll
            for (int i = 0; i < 64; ++i) {
                float a0 = (i == ln) ? 1.f : 0.f, a1 = 0.f, a2 = 0.f, a3 = 0.f;
#pragma unroll
                for (int j = 0; j < i; j += 4) {
                    const f32x4 av = *(const LAS f32x4*)(sA + i * 64 + j);
                    a0 -= av.x * t[j];
                    if (j + 1 < i) a1 -= av.y * t[j + 1];
                    if (j + 2 < i) a2 -= av.z * t[j + 2];
                    if (j + 3 < i) a3 -= av.w * t[j + 3];
                }
                t[i] = (a0 + a1) + (a2 + a3);
                __builtin_amdgcn_sched_barrier(0);
            }
            const float cu = sg[64 + lane], cw = cu * __expf(sg[lane]);
            const int ch = lane >> 3, sub = (lane & 7) * 2;
#pragma unroll
            for (int i = 0; i < 64; ++i) {
                const int off = i * 128 + ((ch ^ (i & 7)) << 4) + sub;
                *(LAS bf16_t*)(sT + off) = f2bf(t[i] * cw);
                *(LAS bf16_t*)(sT + 8192 + off) = f2bf(t[i] * cu);
                if ((i & 7) == 7) __builtin_amdgcn_sched_barrier(0);
            }
        }
        __syncthreads();
            {
                const int itemn = min(item + nteams, 4607);
                const int nn = itemn % 36, dn = (itemn / 36) & 1, bhn = itemn / 72, rbn = chunk_rowbase(bhn >> 3, dn, nn);
#pragma unroll
                for (int j = 0; j < 8; ++j) { const int cid = ttid + 128 * j, i = cid >> 4, ch = cid & 15; rk[j] = *(const u32x4*)(kc + ((size_t)rbn + (dn ? 63 - i : i)) * 1024 + (bhn & 7) * 128 + ch * 8); }
            }
        u32x4 rv[8];
        if (act) {
#pragma unroll
            for (int j = 0; j < 8; ++j) {
                const int cid = ttid + 128 * j, i = cid >> 4, ch = cid & 15;
                const size_t grow = (size_t)rowbase + (d ? 63 - i : i);
                rv[j] = *(const u32x4*)(vc + grow * 1024 + h * 128 + ch * 8);
            }
#pragma unroll 1
            for (int q = 0; q < 2; ++q) {
                const int mtk = 2 * tw + q;
                f32x16 acc[2]; acc[0] = zero16(); acc[1] = zero16();
#pragma unroll
                for (int ks = 0; ks < 4; ++ks) {
                    const bf16x8 afr = frag_col_x(sX, mtk * 32, ks * 16, lane);
#pragma unroll
                    for (int it2 = 0; it2 < 2; ++it2) acc[it2] = mfma32(afr, frag_row_t(sT, it2 * 32, ks * 16, lane), acc[it2]);
                }
                bf16_t* dstp = wbuf + (size_t)item * 8192;
#pragma unroll
                for (int it2 = 0; it2 < 2; ++it2) {
                    u32x4 o0, o1; tile_rows8(acc[it2], o0, o1);
                    bf16_t* rp = dstp + (it2 * 32 + (lane & 31)) * 128 + mtk * 32 + 16 * (lane >> 5);
                    *(u32x4*)rp = o0; *(u32x4*)(rp + 8) = o1;
                }
            }
        }
        __syncthreads();
        if (act) {
#pragma unroll
            for (int j = 0; j < 8; ++j) { const int cid = ttid + 128 * j, i = cid >> 4, ch = cid & 15; *(LAS u32x4*)(sX + i * 256 + ((ch ^ (i & 15)) << 4)) = rv[j]; }
        }
        __syncthreads();
        if (act) {
#pragma unroll 1
            for (int q = 0; q < 2; ++q) {
                const int nt = 2 * tw + q;
                f32x16 acc[2]; acc[0] = zero16(); acc[1] = zero16();
#pragma unroll
                for (int ks = 0; ks < 4; ++ks) {
                    const bf16x8 bfr = frag_col_x(sX, nt * 32, ks * 16, lane);
#pragma unroll
                    for (int mt = 0; mt < 2; ++mt) acc[mt] = mfma32(frag_row_t(sT + 8192, mt * 32, ks * 16, lane), bfr, acc[mt]);
                }
                bf16_t* dstp = ubuf + (size_t)item * 8192;
#pragma unroll
                for (int mt = 0; mt < 2; ++mt) {
                    u32x4 o0, o1; tile_rows8(acc[mt], o0, o1);
                    bf16_t* rp = dstp + (nt * 32 + (lane & 31)) * 64 + mt * 32 + 16 * (lane >> 5);
                    *(u32x4*)rp = o0; *(u32x4*)(rp + 8) = o1;
                }
            }
            if (tw == 0) gcbuf[(size_t)item * 64 + lane] = sg[lane];
        }
        __syncthreads();
    }
}

DEV u32x2 pack4(float a, float b, float c, float d) { u32x2 o; o.x = pk2(a, b); o.y = pk2(c, d); return o; }
DEV void phase_scan(const Params& P, ldsp lds0) {
    const bf16_t* qc = (const bf16_t*)(P.ws + OFF_QC);
    const bf16_t* kc = (const bf16_t*)(P.ws + OFF_KC);
    const bf16_t* wbuf = (const bf16_t*)(P.ws + OFF_WBUF);
    const bf16_t* ubuf = (const bf16_t*)(P.ws + OFF_UBUF);
    const float* gcbuf = (const float*)(P.ws + OFF_GC);
    bf16_t* obuf = (bf16_t*)(P.ws + OFF_OBUF);
    const int tid = tid_fresh(), lane = tid & 63, wave = tid >> 6;
    const int mt = wave >> 1, nt = wave & 1;
    const int mt2 = (wave & 3) >> 1, nt2 = wave & 1;
    for (int item = blockIdx.x; item < 256; item += gridDim.x) {
        const int half = item & 1, d = (item >> 1) & 1, bh = item >> 2, b = bh >> 3, h = bh & 7;
        f32x16 S = zero16();
        { LAS unsigned* z = (LAS unsigned*)(lds0 + 1024 + 3 * 17408 + 9216); for (int e = tid; e < 64 * 136 / 2; e += NTHREADS) z[e] = 0u; }
        u32x4 rW[2][2], rK[2][2], rQ[2][2], rU[2]; float rG[2] = {0.f, 0.f};
#pragma unroll
        for (int u = 0; u < 2; ++u) {
            const int citem = (bh * 2 + d) * 36 + u, rowbase = chunk_rowbase(b, d, u);
#pragma unroll
            for (int j = 0; j < 2; ++j) {
                const int cid = tid + NTHREADS * j, i = cid >> 4, ch = cid & 15;
                const size_t grow = (size_t)rowbase + (d ? 63 - i : i);
                rW[u][j] = *(const u32x4*)(wbuf + (size_t)citem * 8192 + i * 128 + ch * 8);
                rK[u][j] = *(const u32x4*)(kc + grow * 1024 + h * 128 + ch * 8);
                rQ[u][j] = rK[u][j];
            }
            { const int dvr = tid >> 3, ch = tid & 7; rU[u] = *(const u32x4*)(ubuf + (size_t)citem * 8192 + (half * 64 + dvr) * 64 + ch * 8); }
            if (tid < 64) rG[u] = gcbuf[(size_t)citem * 64 + tid];
        }
        for (int n2 = 0; n2 < 36; n2 += 2) {
#pragma unroll
        for (int u = 0; u < 2; ++u) {
            const int n = n2 + u;
            const ldsp lds = launder(lds0);
            int ln = lane; asm volatile("" : "+v"(ln));
            LAS float* sg = (LAS float*)lds;
            LAS bf16_t* sW = (LAS bf16_t*)(lds + 1024);
            LAS bf16_t* sK = sW + 64 * 136;
            LAS bf16_t* sQ = sK + 64 * 136;
            LAS bf16_t* sU = sQ + 64 * 136;
            LAS bf16_t* sST = sU + 64 * 72;
            LAS bf16_t* sVNT = sST + 64 * 136;
            LAS bf16_t* sVNsT = sVNT + 64 * 72;
            LAS bf16_t* sATT = sVNsT + 64 * 72;
            LAS bf16_t* sO = sATT + 64 * 72;
            const int rowbase = chunk_rowbase(b, d, n);
            const bool wantO = n >= 4;
#pragma unroll
            for (int j = 0; j < 2; ++j) {
                const int cid = tid + NTHREADS * j, i = cid >> 4, ch = cid & 15;
                *(LAS u32x4*)(sW + i * 136 + ch * 8) = rW[u][j];
                *(LAS u32x4*)(sK + i * 136 + ch * 8) = rK[u][j];
                *(LAS u32x4*)(sQ + i * 136 + ch * 8) = rQ[u][j];
            }
            { const int i = tid >> 3, ch = tid & 7; *(LAS u32x4*)(sU + i * 72 + ch * 8) = rU[u]; }
            if (tid < 64) sg[tid] = rG[u];
            __syncthreads();
            if (n + 2 < 36) {
                const int citem = (bh * 2 + d) * 36 + n + 2, rb1 = chunk_rowbase(b, d, n + 2);
                const bool wq = n + 2 >= 4;
#pragma unroll
                for (int j = 0; j < 2; ++j) {
                    const int cid = tid + NTHREADS * j, i = cid >> 4, ch = cid & 15;
                    const size_t grow = (size_t)rb1 + (d ? 63 - i : i);
                    rW[u][j] = *(const u32x4*)(wbuf + (size_t)citem * 8192 + i * 128 + ch * 8);
                    rK[u][j] = *(const u32x4*)(kc + grow * 1024 + h * 128 + ch * 8);
                    if (wq) rQ[u][j] = *(const u32x4*)(qc + grow * 1024 + h * 128 + ch * 8);
                }
                { const int dvr = tid >> 3, ch = tid & 7; rU[u] = *(const u32x4*)(ubuf + (size_t)citem * 8192 + (half * 64 + dvr) * 64 + ch * 8); }
                if (tid < 64) rG[u] = gcbuf[(size_t)citem * 64 + tid];
            }
            const float g63 = sg[63];
            if (wave < 4) {
                const int dv = nt2 * 32 + (ln & 31);
                float uf[16], ef[16];
#pragma unroll
                for (int rg = 0; rg < 4; ++rg) {
                    const int i0 = mt2 * 32 + 8 * rg + 4 * (ln >> 5);
                    const u32x2 uu = *(const LAS u32x2*)(sU + dv * 72 + i0);
                    const f32x4 gg = *(const LAS f32x4*)(sg + i0);
                    uf[rg * 4 + 0] = bflo(uu.x); uf[rg * 4 + 1] = bfhi(uu.x); uf[rg * 4 + 2] = bflo(uu.y); uf[rg * 4 + 3] = bfhi(uu.y);
#pragma unroll
                    for (int e = 0; e < 4; ++e) ef[rg * 4 + e] = __expf(g63 - gg[e]);
                }
                f32x16 acc = zero16(), accb = zero16();
#pragma unroll
                for (int ks = 0; ks < 8; ks += 2) { acc = mfma32(frag_row(sW, 136, mt2 * 32, ks * 16, ln), frag_row(sST, 136, nt2 * 32, ks * 16, ln), acc);
                    accb = mfma32(frag_row(sW, 136, mt2 * 32, ks * 16 + 16, ln), frag_row(sST, 136, nt2 * 32, ks * 16 + 16, ln), accb); }
#pragma unroll
                for (int rg = 0; rg < 4; ++rg) {
                    const int i0 = mt2 * 32 + 8 * rg + 4 * (ln >> 5);
                    float v[4], vs[4];
#pragma unroll
                    for (int e = 0; e < 4; ++e) { v[e] = uf[rg * 4 + e] - (acc[rg * 4 + e] + accb[rg * 4 + e]); vs[e] = v[e] * ef[rg * 4 + e]; }
                    *(LAS u32x2*)(sVNT + dv * 72 + i0) = pack4(v[0], v[1], v[2], v[3]);
                    *(LAS u32x2*)(sVNsT + dv * 72 + i0) = pack4(vs[0], vs[1], vs[2], vs[3]);
                }
            } else if (wantO) {
                const int i = nt2 * 32 + (ln & 31);
                const float gi = sg[i];
                float df[16];
#pragma unroll
                for (int rg = 0; rg < 4; ++rg) {
                    const int j0 = mt2 * 32 + 8 * rg + 4 * (ln >> 5);
                    const f32x4 gg = *(const LAS f32x4*)(sg + j0);
#pragma unroll
                    for (int e = 0; e < 4; ++e) df[rg * 4 + e] = (i >= j0 + e) ? __expf(fminf(gi - gg[e], 0.f)) : 0.f;
                }
                f32x16 acc = zero16(), accb = zero16();
#pragma unroll
                for (int ks = 0; ks < 8; ks += 2) { acc = mfma32(frag_row(sK, 136, mt2 * 32, ks * 16, ln), frag_row(sQ, 136, nt2 * 32, ks * 16, ln), acc);
                    accb = mfma32(frag_row(sK, 136, mt2 * 32, ks * 16 + 16, ln), frag_row(sQ, 136, nt2 * 32, ks * 16 + 16, ln), accb); }
#pragma unroll
                for (int rg = 0; rg < 4; ++rg) {
                    const int j0 = mt2 * 32 + 8 * rg + 4 * (ln >> 5);
                    float v[4];
#pragma unroll
                    for (int e = 0; e < 4; ++e) v[e] = (acc[rg * 4 + e] + accb[rg * 4 + e]) * df[rg * 4 + e];
                    *(LAS u32x2*)(sATT + i * 72 + j0) = pack4(v[0], v[1], v[2], v[3]);
                }
            }
            __syncthreads();
            if (wave < 4 && wantO) {
                float eg[16];
#pragma unroll
                for (int rg = 0; rg < 4; ++rg) {
                    const f32x4 gg = *(const LAS f32x4*)(sg + mt2 * 32 + 8 * rg + 4 * (ln >> 5));
#pragma unroll
                    for (int e = 0; e < 4; ++e) eg[rg * 4 + e] = __expf(gg[e]);
                }
                f32x16 a1 = zero16(), a1b = zero16(), a2 = zero16();
#pragma unroll
                for (int ks = 0; ks < 8; ks += 2) { a1 = mfma32(frag_row(sQ, 136, mt2 * 32, ks * 16, ln), frag_row(sST, 136, nt2 * 32, ks * 16, ln), a1);
                    a1b = mfma32(frag_row(sQ, 136, mt2 * 32, ks * 16 + 16, ln), frag_row(sST, 136, nt2 * 32, ks * 16 + 16, ln), a1b); }
#pragma unroll
                for (int ks = 0; ks < 4; ++ks) a2 = mfma32(frag_row(sATT, 72, mt2 * 32, ks * 16, ln), frag_row(sVNT, 72, nt2 * 32, ks * 16, ln), a2);
                const int dv = nt2 * 32 + (ln & 31);
#pragma unroll
                for (int rg = 0; rg < 4; ++rg) {
                    const int i0 = mt2 * 32 + 8 * rg + 4 * (ln >> 5);
#pragma unroll
                    for (int e = 0; e < 4; ++e) sO[(i0 + e) * 72 + dv] = f2bf((a1[rg * 4 + e] + a1b[rg * 4 + e]) * eg[rg * 4 + e] + a2[rg * 4 + e]);
                }
            }
            {
                const float gl = __expf(g63);
#pragma unroll
                for (int reg = 0; reg < 16; ++reg) S[reg] *= gl;
#pragma unroll
                for (int ks = 0; ks < 4; ++ks) S = mfma32(frag_col_tr(sK, 136, mt * 32, ks * 16, ln), frag_row(sVNsT, 72, nt * 32, ks * 16, ln), S);
            }
            __syncthreads();
            if (wantO) {
                const int i = tid >> 3, ch = tid & 7;
                const size_t grow = (size_t)rowbase + (d ? 63 - i : i);
                *(u32x4*)(obuf + ((size_t)d * NX + grow) * 1024 + h * 128 + half * 64 + ch * 8) = *(const LAS u32x4*)(sO + i * 72 + ch * 8);
            }
#pragma unroll
            for (int rg = 0; rg < 4; ++rg) {
                const int dk0 = mt * 32 + 8 * rg + 4 * (ln >> 5);
                *(LAS u32x2*)(sST + (nt * 32 + (ln & 31)) * 136 + dk0) = pack4(S[rg * 4 + 0], S[rg * 4 + 1], S[rg * 4 + 2], S[rg * 4 + 3]);
            }
        }
        }
        __syncthreads();
    }
}

DEV void phase_dnout(const Params& P) {
    const bf16_t* obuf = (const bf16_t*)(P.ws + OFF_OBUF);
    const bf16_t* Pz = (const bf16_t*)(P.ws + OFF_PZ);
    bf16_t* A = (bf16_t*)(P.ws + OFF_A);
    const int tid = tid_fresh(); const int wave = tid >> 6, lane = tid & 63;
    for (int row = blockIdx.x * 8 + wave; row < NX; row += gridDim.x * 8) {
#pragma unroll
        for (int c = 0; c < 2; ++c) {
            const int col = c * 512 + lane * 8;
            const u32x4 of = *(const u32x4*)(obuf + (size_t)row * 1024 + col), ob = *(const u32x4*)(obuf + ((size_t)NX + row) * 1024 + col);
            const u32x4 zz = *(const u32x4*)(Pz + (size_t)row * 1024 + col);
            float o[8], o2[8], z[8]; unpack8(of, o); unpack8(ob, o2); unpack8(zz, z);
            float ss = 0.f;
#pragma unroll
            for (int e = 0; e < 8; ++e) { o[e] += o2[e]; ss += o[e] * o[e]; }
            ss = sum16(ss);
            const float rn = rsqrtf(ss * (1.f / 128.f) + EPS);
            float y[8];
#pragma unroll
            for (int e = 0; e < 8; ++e) y[e] = o[e] * rn * P.dn_norm_g[(col & 127) + e] * silu(z[e]);
            u32x4 ov; ov.x = pk2(y[0], y[1]); ov.y = pk2(y[2], y[3]); ov.z = pk2(y[4], y[5]); ov.w = pk2(y[6], y[7]);
            *(u32x4*)(A + (size_t)row * 1024 + col) = ov;
        }
    }
}

namespace pg8 {
#define PG8_LAS __attribute__((address_space(3)))
typedef unsigned short bf16_t;
typedef short bf16x8 __attribute__((ext_vector_type(8)));
typedef float f32x4 __attribute__((ext_vector_type(4)));
typedef unsigned u32x4 __attribute__((ext_vector_type(4)));
constexpr int BM = 256, BK = 64, HALF = 128, HTB = HALF * BK * 2  , STAGE_BYTES = 8 * HTB, NXCD = 8, WGM = 8;

__host__ __device__ __forceinline__ int lds_byte(int r, int c) { const int st = (r >> 4) * 2 + (c >> 5), rr = r & 15, cc = c & 31, ob = rr * 64 + cc * 2; return st * 1024 + (ob ^ (((ob >> 9) & 1) << 5)); }
__host__ __device__ __forceinline__ void stage_rc(int b, int& R, int& C) { const int st = b / 1024, sb = b % 1024, swz = sb ^ (((sb >> 9) & 1) << 5); R = (st >> 1) * 16 + swz / 64; C = (st & 1) * 32 + (swz % 64) / 2; }
__host__ __device__ __forceinline__ int perm32(int rho) { const int n = rho >> 4, i = rho & 15; return 8 * (i >> 2) + 4 * n + (i & 3); }

struct Unit { int pm, pn; };
struct Gemm { const bf16_t* A; const bf16_t* Bt; int M, N, K; };

struct StaticOrder {
    int nM, nN, nwg, G, c;
    __host__ __device__ void init(int M, int N, int G_, int c_) { nM = M / BM; nN = N / BM; nwg = nM * nN; G = G_; c = c_; }
    __host__ __device__ bool next(int i, Unit& u) const {
        const long L = (long)i * G + c; if (L >= nwg) return false;
        int wgid = (int)L; { const int q = nwg / NXCD, r = nwg % NXCD, xcd = wgid % NXCD, off = wgid / NXCD; wgid = (xcd < r ? xcd * (q + 1) : r * (q + 1) + (xcd - r) * q) + off; }
        const int nig = WGM * nN, gid = wgid / nig, fm = gid * WGM, gsz = (nM - fm) < WGM ? (nM - fm) : WGM;
        u.pm = fm + ((wgid % nig) % gsz); u.pn = (wgid % nig) / gsz; return true;
    }
    __device__ __forceinline__ void a_ready(const Unit&) const {}
    __device__ __forceinline__ void done(const Unit&) const {}
};

__device__ __forceinline__ unsigned cvt_pk_bf16(float lo, float hi) { typedef float v2f __attribute__((ext_vector_type(2))); typedef __bf16 v2b __attribute__((ext_vector_type(2))); const v2f v = {lo, hi}; return __builtin_bit_cast(unsigned, __builtin_convertvector(v, v2b)); }
__device__ __forceinline__ u32x4 pack8(const f32x4 v0, const f32x4 v1) { u32x4 w; w.x = cvt_pk_bf16(v0[0], v0[1]); w.y = cvt_pk_bf16(v0[2], v0[3]); w.z = cvt_pk_bf16(v1[0], v1[1]); w.w = cvt_pk_bf16(v1[2], v1[3]); return w; }
struct EpiQ {
    static constexpr bool PERM = true, AFTER_DRAIN = false;
    bf16_t* O; int ldc;
    __device__ __forceinline__ void operator()(const f32x4 (&acc)[2][2][4][2], const Unit& u, int wr, int wc, int fr, int fq) const {
        const int row0 = u.pm * BM + wr * 64 + fr, col0 = u.pn * BM + wc * 32 + 8 * fq;
#pragma unroll
        for (int ai = 0; ai < 2; ++ai)
#pragma unroll
            for (int m = 0; m < 4; ++m) { bf16_t* rowp = O + (size_t)(row0 + ai * HALF + m * 16) * ldc + col0;
#pragma unroll
                for (int bj = 0; bj < 2; ++bj) *(u32x4*)(rowp + bj * HALF) = pack8(acc[ai][bj][m][0], acc[ai][bj][m][1]); }
    }
};
struct EpiWinP {
    static constexpr bool PERM = true, AFTER_DRAIN = false;
    bf16_t* qkv; bf16_t* z; float* ab;
    __device__ __forceinline__ void operator()(const f32x4 (&acc)[2][2][4][2], const Unit& u, int wr, int wc, int fr, int fq) const {
        const int row0 = u.pm * BM + wr * 64 + fr;
        if (u.pn < 16) {
            bf16_t* base = u.pn < 12 ? qkv : z; const int ldc = u.pn < 12 ? 3072 : 1024, col0 = (u.pn < 12 ? u.pn : u.pn - 12) * BM + wc * 32 + 8 * fq;
#pragma unroll
            for (int ai = 0; ai < 2; ++ai)
#pragma unroll
                for (int m = 0; m < 4; ++m) { bf16_t* rowp = base + (size_t)(row0 + ai * HALF + m * 16) * ldc + col0;
#pragma unroll
                    for (int bj = 0; bj < 2; ++bj) *(u32x4*)(rowp + bj * HALF) = pack8(acc[ai][bj][m][0], acc[ai][bj][m][1]); }
        } else if (wc == 0) {
#pragma unroll
            for (int ai = 0; ai < 2; ++ai)
#pragma unroll
                for (int m = 0; m < 4; ++m) { float* rowp = ab + (size_t)(row0 + ai * HALF + m * 16) * 32 + 8 * fq;
                    *(f32x4*)rowp = acc[ai][0][m][0]; *(f32x4*)(rowp + 4) = acc[ai][0][m][1]; }
        }
    }
};
struct EpiRes {
    static constexpr bool PERM = true, AFTER_DRAIN = false;
    bf16_t* h; const float* gate;
    __device__ __forceinline__ void operator()(const f32x4 (&acc)[2][2][4][2], const Unit& u, int wr, int wc, int fr, int fq) const {
        const int row0 = u.pm * BM + wr * 64 + fr, col0 = u.pn * BM + wc * 32 + 8 * fq;
#pragma unroll
        for (int ai = 0; ai < 2; ++ai)
#pragma unroll
            for (int m = 0; m < 4; ++m) { const int row = row0 + ai * HALF + m * 16; bf16_t* rowp = h + (size_t)row * 1024 + col0; const float* gp = gate + (row >> 11) * 6144 + col0;
#pragma unroll
                for (int bj = 0; bj < 2; ++bj) {
                    const u32x4 hv = *(const u32x4*)(rowp + bj * HALF);
                    const f32x4 g0 = *(const f32x4*)(gp + bj * HALF), g1 = *(const f32x4*)(gp + bj * HALF + 4);
                    const f32x4 a0 = acc[ai][bj][m][0], a1 = acc[ai][bj][m][1];
                    f32x4 n0, n1;
                    n0[0] = __uint_as_float(hv.x << 16) + g0[0] * a0[0]; n0[1] = __uint_as_float(hv.x & 0xffff0000u) + g0[1] * a0[1];
                    n0[2] = __uint_as_float(hv.y << 16) + g0[2] * a0[2]; n0[3] = __uint_as_float(hv.y & 0xffff0000u) + g0[3] * a0[3];
                    n1[0] = __uint_as_float(hv.z << 16) + g1[0] * a1[0]; n1[1] = __uint_as_float(hv.z & 0xffff0000u) + g1[1] * a1[1];
                    n1[2] = __uint_as_float(hv.w << 16) + g1[2] * a1[2]; n1[3] = __uint_as_float(hv.w & 0xffff0000u) + g1[3] * a1[3];
                    *(u32x4*)(rowp + bj * HALF) = pack8(n0, n1);
                } }
    }
};

template <class Epi, class Sched, bool ALIGN_EPI = false, bool SP2 = false>
__device__ __forceinline__ void gemm_phase(PG8_LAS unsigned char* lds, const Gemm g, const Sched& S, const Epi& E) {
    const int tid = tid_fresh(), wid = __builtin_amdgcn_readfirstlane(tid >> 6), lane = tid & 63, wr = wid >> 2, wc = wid & 3, fr = lane & 15, fq = lane >> 4;
    const int K = g.K, nt = K / BK;
    unsigned voffA[2], voffB[2];
#pragma unroll
    for (int i = 0; i < 2; ++i) { int R, C; stage_rc(tid * 16 + i * 8192, R, C); const int Rb = Epi::PERM ? ((R & ~31) + perm32(R & 31)) : R;
        voffA[i] = (unsigned)(R * K + C) * 2u; voffB[i] = (unsigned)(Rb * K + C) * 2u; }
    const size_t kstep = (size_t)(BK * 2);
    const size_t hstep = (size_t)HALF * K * 2;
    const size_t tstep = 2 * hstep;
    const unsigned ldsw = (unsigned)wid * 1024u;
    const int aoff = lds_byte(wr * 64 + fr, fq * 8), boff = lds_byte(wc * 32 + fr, fq * 8);
#define PG8_SA(b, h) (((b) * 2 + (h)) * HTB)
#define PG8_SB(b, h) ((4 + (b) * 2 + (h)) * HTB)
#define PG8_STAGE(bufoff, gbase, voff) do { _Pragma("unroll") for (int _i = 0; _i < 2; ++_i) \
        __builtin_amdgcn_global_load_lds((const unsigned*)((const char*)(gbase) + (voff)[_i]), (PG8_LAS unsigned*)(lds + (bufoff) + ldsw + _i * 8192), 16, 0, 0); } while (0)
#define PG8_LDA(dst, b, h) do { _Pragma("unroll") for (int m = 0; m < 4; ++m) _Pragma("unroll") for (int k = 0; k < 2; ++k) dst[m][k] = *(const PG8_LAS bf16x8*)(lds + PG8_SA(b, h) + aoff + m * 2048 + k * 1024); } while (0)
#define PG8_LDB(dst, b, h) do { _Pragma("unroll") for (int n = 0; n < 2; ++n) _Pragma("unroll") for (int k = 0; k < 2; ++k) dst[n][k] = *(const PG8_LAS bf16x8*)(lds + PG8_SB(b, h) + boff + n * 2048 + k * 1024); } while (0)
#define PG8_MMA(ai, bj, At, Bt) do { __builtin_amdgcn_s_setprio(1); _Pragma("unroll") for (int m = 0; m < 4; ++m) _Pragma("unroll") for (int n = 0; n < 2; ++n) _Pragma("unroll") for (int k = 0; k < 2; ++k) \
        acc[ai][bj][m][n] = __builtin_amdgcn_mfma_f32_16x16x32_bf16(Bt[n][k], At[m][k], acc[ai][bj][m][n], 0, 0, 0); __builtin_amdgcn_s_setprio(0); } while (0)
#define PG8_WAIT_V(n) asm volatile("s_waitcnt vmcnt(" #n ")" ::: "memory")
#define PG8_WAIT_L(n) asm volatile("s_waitcnt lgkmcnt(" #n ")" ::: "memory")
#define PG8_BAR __builtin_amdgcn_s_barrier()
#define PG8_SCHED __builtin_amdgcn_sched_barrier(0)
    Unit cur, nxt; int ui = 0;
    if (!S.next(0, cur)) return;
    f32x4 acc[2][2][4][2];
#pragma unroll
    for (int a = 0; a < 2; ++a)
#pragma unroll
        for (int b = 0; b < 2; ++b)
#pragma unroll
            for (int m = 0; m < 4; ++m)
#pragma unroll
                for (int n = 0; n < 2; ++n) acc[a][b][m][n] = (f32x4){0.f, 0.f, 0.f, 0.f};
    bf16x8 At[4][2], B0[2][2], B1[2][2];
    const char* cA = (const char*)g.A + (size_t)cur.pm * tstep; const char* cB = (const char*)g.Bt + (size_t)cur.pn * tstep;
    S.a_ready(cur);
    if constexpr (SP2) {
        PG8_STAGE(PG8_SB(0, 0), cB, voffB); PG8_STAGE(PG8_SB(0, 1), cB + hstep, voffB); PG8_STAGE(PG8_SA(0, 0), cA, voffA); PG8_STAGE(PG8_SA(0, 1), cA + hstep, voffA);
        if (wr == 1) PG8_BAR;
        PG8_WAIT_V(2); PG8_BAR;
        PG8_STAGE(PG8_SB(1, 0), cB + kstep, voffB); PG8_STAGE(PG8_SA(1, 0), cA + kstep, voffA); PG8_STAGE(PG8_SB(1, 1), cB + hstep + kstep, voffB);
        PG8_WAIT_V(6); PG8_BAR;
    } else {
        PG8_STAGE(PG8_SB(0, 0), cB, voffB); PG8_STAGE(PG8_SA(0, 0), cA, voffA); PG8_STAGE(PG8_SB(0, 1), cB + hstep, voffB); PG8_STAGE(PG8_SA(0, 1), cA + hstep, voffA);
        if (wr == 1) PG8_BAR;
        PG8_WAIT_V(4); PG8_BAR;
        PG8_STAGE(PG8_SB(1, 0), cB + kstep, voffB); PG8_STAGE(PG8_SA(1, 0), cA + kstep, voffA); PG8_STAGE(PG8_SB(1, 1), cB + hstep + kstep, voffB);
        PG8_WAIT_V(6); PG8_BAR;
    }
    for (;;) {
        const bool has_next = S.next(ui + 1, nxt);
        const char* nA = has_next ? (const char*)g.A + (size_t)nxt.pm * tstep : cA; const char* nB = has_next ? (const char*)g.Bt + (size_t)nxt.pn * tstep : cB;
        for (int t = 0; t < nt; t += 2) {
            const bool last = (t == nt - 2);
            const char* a1 = cA + (size_t)(t + 1) * kstep;
            const char* a2 = last ? nA : cA + (size_t)(t + 2) * kstep; const char* b2 = last ? nB : cB + (size_t)(t + 2) * kstep;
            const char* a3 = a2 + kstep; const char* b3 = b2 + kstep;
            if (last && has_next) S.a_ready(nxt);
            if constexpr (SP2) {
            PG8_LDB(B0, 0, 0); PG8_LDB(B1, 0, 1); PG8_SCHED; PG8_LDA(At, 0, 0); PG8_STAGE(PG8_SA(1, 1), a1 + hstep, voffA);
            PG8_WAIT_V(8); PG8_WAIT_L(0); PG8_BAR; PG8_MMA(0, 0, At, B0); PG8_MMA(0, 1, At, B1); PG8_BAR; PG8_SCHED;
            PG8_LDA(At, 0, 1); PG8_STAGE(PG8_SB(0, 0), b2, voffB); PG8_STAGE(PG8_SB(0, 1), b2 + hstep, voffB); PG8_STAGE(PG8_SA(0, 0), a2, voffA);
            PG8_WAIT_V(8); PG8_WAIT_L(0); PG8_BAR; PG8_MMA(1, 0, At, B0); PG8_MMA(1, 1, At, B1); PG8_BAR; PG8_SCHED;
            PG8_LDB(B0, 1, 0); PG8_LDB(B1, 1, 1); PG8_SCHED; PG8_LDA(At, 1, 0); PG8_STAGE(PG8_SA(0, 1), a2 + hstep, voffA);
            PG8_WAIT_V(8); PG8_WAIT_L(0); PG8_BAR; PG8_MMA(0, 0, At, B0); PG8_MMA(0, 1, At, B1); PG8_BAR; PG8_SCHED;
            PG8_LDA(At, 1, 1); PG8_STAGE(PG8_SB(1, 0), b3, voffB); PG8_STAGE(PG8_SB(1, 1), b3 + hstep, voffB); PG8_STAGE(PG8_SA(1, 0), a3, voffA);
            PG8_WAIT_V(8); PG8_WAIT_L(0); PG8_BAR; PG8_MMA(1, 0, At, B0); PG8_MMA(1, 1, At, B1); PG8_BAR; PG8_SCHED;
            } else {
            PG8_LDB(B0, 0, 0); PG8_SCHED; PG8_LDA(At, 0, 0); PG8_STAGE(PG8_SA(1, 1), a1 + hstep, voffA);
            PG8_WAIT_L(8); PG8_BAR; PG8_WAIT_L(0); PG8_MMA(0, 0, At, B0); PG8_BAR; PG8_SCHED;
            PG8_LDB(B1, 0, 1); PG8_STAGE(PG8_SB(0, 0), b2, voffB);
            PG8_BAR; PG8_WAIT_L(0); PG8_MMA(0, 1, At, B1); PG8_BAR;
            PG8_LDA(At, 0, 1); PG8_STAGE(PG8_SA(0, 0), a2, voffA);
            PG8_BAR; PG8_WAIT_L(0); PG8_MMA(1, 0, At, B0); PG8_BAR; PG8_SCHED;
            PG8_STAGE(PG8_SB(0, 1), b2 + hstep, voffB);
            PG8_WAIT_V(6); PG8_BAR; PG8_MMA(1, 1, At, B1); PG8_BAR;
            PG8_LDB(B0, 1, 0); PG8_SCHED; PG8_LDA(At, 1, 0); PG8_STAGE(PG8_SA(0, 1), a2 + hstep, voffA);
            PG8_WAIT_L(8); PG8_BAR; PG8_WAIT_L(0); PG8_MMA(0, 0, At, B0); PG8_BAR; PG8_SCHED;
            PG8_LDB(B1, 1, 1); PG8_STAGE(PG8_SB(1, 0), b3, voffB);
            PG8_BAR; PG8_WAIT_L(0); PG8_MMA(0, 1, At, B1); PG8_BAR;
            PG8_LDA(At, 1, 1); PG8_STAGE(PG8_SA(1, 0), a3, voffA);
            PG8_BAR; PG8_WAIT_L(0); PG8_MMA(1, 0, At, B0); PG8_BAR; PG8_SCHED;
            PG8_STAGE(PG8_SB(1, 1), b3 + hstep, voffB);
            PG8_WAIT_V(6); PG8_BAR; PG8_MMA(1, 1, At, B1); PG8_BAR;
            }
        }
        if constexpr (ALIGN_EPI) { if (wr == 0) PG8_BAR; }
        if constexpr (!Epi::AFTER_DRAIN) { E(acc, cur, wr, wc, fr, fq); S.done(cur); }
        if (!has_next) break;
#pragma unroll
        for (int a = 0; a < 2; ++a)
#pragma unroll
            for (int b = 0; b < 2; ++b)
#pragma unroll
                for (int m = 0; m < 4; ++m)
#pragma unroll
                    for (int n = 0; n < 2; ++n) acc[a][b][m][n] = (f32x4){0.f, 0.f, 0.f, 0.f};
        cur = nxt; cA = nA; cB = nB; ++ui;
        if constexpr (ALIGN_EPI) { if (wr == 1) PG8_BAR; }
    }
    PG8_WAIT_V(0);
    if constexpr (!ALIGN_EPI) { if (wr == 0) PG8_BAR; }
    PG8_BAR;
    if constexpr (Epi::AFTER_DRAIN) { E.fused(acc, cur, wr, wc, fr, fq, lds, wid, lane); S.done(cur); }
#undef PG8_SA
#undef PG8_SB
#undef PG8_STAGE
#undef PG8_LDA
#undef PG8_LDB
#undef PG8_MMA
#undef PG8_WAIT_V
#undef PG8_WAIT_L
#undef PG8_BAR
#undef PG8_SCHED
}
}

#define XB_TMO      128
#define XB_XCNT(j)  (256  + 64 * (j))
#define XB_XSUB(j)  (1280 + 64 * (j))
#define XB_XGEN(j)  (2304 + 64 * (j))
#define XB_TOP      3328
#define XB_TOPGEN   3392
#define XCD_BAR_WORDS 3456
#define XB_SPIN_CAP (1u << 22)
DEV unsigned xb_ld(unsigned* p)              { return __hip_atomic_load(p, __ATOMIC_RELAXED, __HIP_MEMORY_SCOPE_AGENT); }
DEV unsigned xb_add(unsigned* p, unsigned v) { return __hip_atomic_fetch_add(p, v, __ATOMIC_RELAXED, __HIP_MEMORY_SCOPE_AGENT); }
DEV unsigned xb_xcc_id() { return (unsigned)__builtin_amdgcn_s_getreg((3 << 11) | 20) & 0xFu; }
#define XB_SPIN(cond, bar) do { unsigned _sp = 0; while (cond) { __builtin_amdgcn_s_sleep(1); \
    if ((++_sp & 255u) == 0u) { if (xb_ld(&(bar)[XB_TMO])) break; if (_sp > XB_SPIN_CAP) { atomicAdd(&(bar)[XB_TMO], 1u); break; } } } } while (0)
struct XcdBarrier { unsigned* bar; unsigned x; volatile LAS unsigned* st; };
DEV XcdBarrier xcd_barrier_post(unsigned* bar, volatile LAS unsigned* st) {
    XcdBarrier b; b.bar = bar; b.x = xb_xcc_id(); b.st = st;
    if (threadIdx.x == 0) (void)xb_add(&bar[XB_XCNT(b.x)], 1u);
    return b;
}
DEV void xcd_barrier_complete(unsigned* bar, unsigned x, unsigned& nloc, unsigned& nx) {
    const unsigned G = gridDim.x * gridDim.y * gridDim.z;
    unsigned sum, cnt, mine, sp = 0u;
    for (;;) {
        sum = 0u; cnt = 0u; mine = 0u;
#pragma unroll
        for (unsigned j = 0; j < 16; ++j) { const unsigned c = xb_ld(&bar[XB_XCNT(j)]); sum += c; cnt += (c > 0u) ? 1u : 0u; mine = (j == x) ? c : mine; }
        if (sum == G) break;
        __builtin_amdgcn_s_sleep(1);
        if ((++sp & 255u) == 0u) { if (xb_ld(&bar[XB_TMO])) break; if (sp > XB_SPIN_CAP) { atomicAdd(&bar[XB_TMO], 1u); break; } }
    }
    nloc = mine > 0u ? mine : 1u; nx = cnt > 0u ? cnt : 1u;
}
DEV void xcd_barrier(const XcdBarrier& b) {
    asm volatile("s_waitcnt vmcnt(0)" ::: "memory");
    __syncthreads();
    if (threadIdx.x == 0) {
        unsigned* bar = b.bar;
        __builtin_amdgcn_s_waitcnt(0);
        unsigned nloc = b.st[0], nx = b.st[1];
        if (nloc == 0u) { xcd_barrier_complete(bar, b.x, nloc, nx); b.st[0] = nloc; b.st[1] = nx; }
        const unsigned old = xb_add(&bar[XB_XSUB(b.x)], 1u);
        const unsigned gen = old / nloc;
        if (old + 1u == (gen + 1u) * nloc) {
            __builtin_amdgcn_fence(__ATOMIC_RELEASE, "agent");
            asm volatile("s_waitcnt vmcnt(0)" ::: "memory");
            const unsigned og = xb_add(&bar[XB_TOP], 1u);
            const unsigned tg = og / nx;
            if (og + 1u == (tg + 1u) * nx) xb_add(&bar[XB_TOPGEN], 1u);
            else XB_SPIN(xb_ld(&bar[XB_TOPGEN]) == tg, bar);
            __builtin_amdgcn_fence(__ATOMIC_ACQUIRE, "agent");
            xb_add(&bar[XB_XGEN(b.x)], 1u);
            asm volatile("s_waitcnt vmcnt(0)" ::: "memory");
        } else {
            XB_SPIN(xb_ld(&bar[XB_XGEN(b.x)]) == gen, bar);
            __builtin_amdgcn_fence(__ATOMIC_ACQUIRE, "agent");
            asm volatile("s_waitcnt vmcnt(0)" ::: "memory");
        }
    }
    __syncthreads();
}

__global__ void __launch_bounds__(NTHREADS) fwd_megakernel(Params P) {
    __shared__ __attribute__((aligned(16))) unsigned char lds_raw[131072 + 4096];
    const ldsp lds = (ldsp)lds_raw;
    cg::grid_group grid = cg::this_grid();
    volatile LAS unsigned* xbst = (volatile LAS unsigned*)(lds + 131072);
    if (threadIdx.x == 0) { xbst[0] = 0u; xbst[1] = 0u; }
    __syncthreads();
    const XcdBarrier xbar = xcd_barrier_post((unsigned*)(P.ws + OFF_BAR), xbst);
#define GBAR() xcd_barrier(xbar)
#define ROW_HANDOFF() do { __builtin_amdgcn_fence(__ATOMIC_RELEASE, "workgroup"); asm volatile("s_waitcnt vmcnt(0)" ::: "memory"); __builtin_amdgcn_fence(__ATOMIC_ACQUIRE, "workgroup"); } while (0)
    const float* modv = (const float*)(P.ws + OFF_MODV);
    bf16_t* Abuf = (bf16_t*)(P.ws + OFF_A);

#define RUN(rep, ...) for (int rep_i = 0; rep_i < (rep); ++rep_i) { __VA_ARGS__; GBAR(); }
    for (int rep_i = 0; rep_i < REP_PREP; ++rep_i) { phase_prep(P, lds); grid.sync(); }
    RUN(REP_MOD, phase_modulate<0>(P, 0, 0, NT))
    RUN(REP_POOL, phase_pool(P, lds))
    RUN(REP_MOD, phase_modulate<1>(P, 0, 1, NT, true))
    RUN(REP_GEMM, { pg8::Gemm g{Abuf, (const bf16_t*)(P.ws + OFF_WQT), NT, 2048, 1024}; pg8::StaticOrder S; S.init(NT, 2048, gridDim.x, blockIdx.x); pg8::EpiQ e{(bf16_t*)(P.ws + OFF_R1), 2048}; pg8::gemm_phase<pg8::EpiQ, pg8::StaticOrder, true, true>(lds, g, S, e); })
    RUN(REP_TOPK, phase_topk(P, 0, NT, lds))
    phase_experts(P, 0, NT, lds);
    ROW_HANDOFF();
    RUN(REP_MOD, phase_modulate<1>(P, 1, 0, NT))
    RUN(REP_GEMM, { pg8::Gemm g{Abuf, (const bf16_t*)(P.ws + OFF_WINT), NT, 4352, 1024}; pg8::StaticOrder S; S.init(NT, 4352, gridDim.x, blockIdx.x);
      pg8::EpiWinP e{(bf16_t*)(P.ws + OFF_R1), (bf16_t*)(P.ws + OFF_PZ), (float*)(P.ws + OFF_AB)}; pg8::gemm_phase<pg8::EpiWinP, pg8::StaticOrder, true, true>(lds, g, S, e); })
    RUN(REP_CONV, phase_conv(P))
    RUN(REP_CHUNK, phase_chunk(P, lds))
    RUN(REP_SCAN, phase_scan(P, lds))
    RUN(REP_DNOUT, phase_dnout(P))
    { pg8::Gemm g{Abuf, (const bf16_t*)(P.ws + OFF_WOUTT), NX, 1024, 1024}; pg8::StaticOrder S; S.init(NX, 1024, gridDim.x, blockIdx.x); pg8::EpiRes e{(bf16_t*)(P.ws + OFF_H), modv + 9 * 6144 + 2048}; pg8::gemm_phase<pg8::EpiRes, pg8::StaticOrder, false, true>(lds, g, S, e); }
    GBAR();
    RUN(REP_MOD, phase_modulate<1>(P, 1, 1, NX, true))
    RUN(REP_GEMM, { pg8::Gemm g{Abuf, (const bf16_t*)(P.ws + OFF_WQT) + (size_t)2048 * 1024, NX, 2048, 1024}; pg8::StaticOrder S; S.init(NX, 2048, gridDim.x, blockIdx.x); pg8::EpiQ e{(bf16_t*)(P.ws + OFF_R1), 2048}; pg8::gemm_phase<pg8::EpiQ, pg8::StaticOrder, true, true>(lds, g, S, e); })
    RUN(REP_TOPK, phase_topk(P, 1, NX, lds))
    phase_experts(P, 1, NX, lds);
    ROW_HANDOFF();
    phase_final(P);
}

extern "C" void kernel_launch(void* const* d_in, const int* in_sizes, int n_in, void* d_out, int out_size, void* d_ws, size_t ws_size, hipStream_t stream) {
    static int grid_blocks = 0;
    if (grid_blocks == 0) {
        if (n_in != 21 || out_size != NX * D || ws_size < WS_END) {
            fprintf(stderr, "kernel_launch: unexpected shapes: n_in %d out %d ws %zu (need %zu)\n", n_in, out_size, ws_size, (size_t)WS_END);
            grid_blocks = -1; return;
        }
        int dev = 0, cus = 0, per_cu = 0;
        hipGetDevice(&dev);
        hipDeviceGetAttribute(&cus, hipDeviceAttributeMultiprocessorCount, dev);
        hipOccupancyMaxActiveBlocksPerMultiprocessor(&per_cu, fwd_megakernel, NTHREADS, 0);
        if (per_cu < 1) { fprintf(stderr, "kernel_launch: occupancy query reports %d blocks per CU\n", per_cu); grid_blocks = -1; return; }
        grid_blocks = cus;
    }
    if (grid_blocks < 0) return;
    if (hipMemsetAsync((char*)d_ws + OFF_BAR, 0, XCD_BAR_WORDS * 4, stream) != hipSuccess) { fprintf(stderr, "kernel_launch: memset of barrier words failed\n"); return; }
    Params p{};
    const float** pp = (const float**)&p;
    for (int i = 0; i < 21; ++i) pp[i] = (const float*)d_in[i];
    p.out = (float*)d_out; p.ws = (unsigned char*)d_ws;
    void* args[] = {&p};
    hipError_t e = hipLaunchCooperativeKernel((void*)fwd_megakernel, dim3(grid_blocks), dim3(NTHREADS), args, 0, stream);
    if (e != hipSuccess) fprintf(stderr, "cooperative launch failed: %s (grid %d)\n", hipGetErrorString(e), grid_blocks);
}
```

```cpp
#include <hip/hip_runtime.h>
#include <hip/hip_cooperative_groups.h>
#include <cstdio>
#include <cstdint>
namespace cg = cooperative_groups;

#define DEV __device__ __forceinline__
typedef unsigned short bf16_t;
typedef short bf16x8 __attribute__((ext_vector_type(8)));
typedef float f32x4 __attribute__((ext_vector_type(4)));
typedef float f32x16 __attribute__((ext_vector_type(16)));
typedef unsigned u32x4 __attribute__((ext_vector_type(4)));
typedef unsigned u32x2 __attribute__((ext_vector_type(2)));
#define LAS __attribute__((address_space(3)))
typedef LAS unsigned char* ldsp;
DEV int tid_fresh() { int t = threadIdx.x; asm volatile("" : "+v"(t)); return t; }
DEV ldsp launder(ldsp p) { asm volatile("" : "+v"(p)); return p; }

constexpr int D = 1024, NB = 8, SEQ = 2048, CTX = 256;
constexpr int NX = NB * SEQ, NC = NB * CTX, NT = NX + NC;
constexpr int NTHREADS = 512;
constexpr float EPS = 1e-6f;
#ifndef REP_PREP
#define REP_PREP 1
#endif
#ifndef REP_MOD
#define REP_MOD 1
#endif
#ifndef REP_POOL
#define REP_POOL 1
#endif
#ifndef REP_GEMM
#define REP_GEMM 1
#endif
#ifndef REP_TOPK
#define REP_TOPK 1
#endif
#ifndef REP_CONV
#define REP_CONV 1
#endif
#ifndef REP_CHUNK
#define REP_CHUNK 1
#endif
#ifndef REP_SCAN
#define REP_SCAN 1
#endif
#ifndef REP_DNOUT
#define REP_DNOUT 1
#endif

constexpr size_t MiB = 1024 * 1024;
constexpr size_t TAB_ELEMS = (size_t)16384 * 1024;
constexpr size_t OFF_TAB   = 0;
constexpr size_t OFF_WQT   = 128 * MiB;
constexpr size_t OFF_WINT  = OFF_WQT + 8 * MiB;
constexpr size_t OFF_WOUTT = OFF_WINT + (size_t)4352 * 1024 * 2;
constexpr size_t OFF_POOLT = OFF_WOUTT + 2 * MiB;
constexpr size_t OFF_KEYS  = OFF_POOLT + 512 * 1024;
constexpr size_t OFF_MODV  = OFF_KEYS + 1 * MiB;
constexpr size_t OFF_HC    = OFF_MODV + 512 * 1024;
constexpr size_t OFF_SELI  = OFF_HC + 8 * MiB;
constexpr size_t OFF_SELG  = OFF_SELI + (size_t)NT * 128 * 4;
constexpr size_t OFF_AB    = OFF_SELG + (size_t)NT * 128 * 4;
constexpr size_t OFF_G     = OFF_AB + (size_t)NT * 32 * 4;
constexpr size_t OFF_BETA  = OFF_G + (size_t)2 * NT * 8 * 4;
constexpr size_t OFF_GC    = OFF_BETA + (size_t)2 * NT * 8 * 4;
constexpr size_t OFF_QC    = OFF_GC + (size_t)4608 * 64 * 4;
constexpr size_t OFF_KC    = OFF_QC + (size_t)NT * 1024 * 2;
constexpr size_t OFF_VC    = OFF_KC + (size_t)NT * 1024 * 2;
constexpr size_t OFF_A     = OFF_VC + (size_t)NT * 1024 * 2;
constexpr size_t OFF_R1    = OFF_A + (size_t)NT * 1024 * 2;
constexpr size_t OFF_PZ    = OFF_R1 + (size_t)NT * 3072 * 2;
constexpr size_t OFF_BAR   = OFF_R1 + (size_t)NT * 4096 * 2;
constexpr size_t OFF_H     = OFF_BAR + 16384;
constexpr size_t OFF_XS    = OFF_H + (size_t)NT * 1024 * 2;
constexpr size_t OFF_RSC   = OFF_XS + (size_t)NT * 4;
constexpr size_t WS_END    = OFF_RSC + (size_t)4 * 16384 * 4;
constexpr size_t OFF_WBUF  = OFF_A;
constexpr size_t OFF_UBUF  = OFF_A + (size_t)4608 * 8192 * 2;
constexpr size_t OFF_OBUF  = OFF_TAB + 64 * MiB;
constexpr size_t OFF_PART  = OFF_QC;
constexpr size_t OFF_WEXP  = OFF_QC + (size_t)8 * NT * 128 * 4;
constexpr size_t OFF_A8    = OFF_WEXP + (size_t)NT * 128 * 4;
static_assert(OFF_UBUF + (size_t)4608 * 8192 * 2 <= OFF_PZ, "w/u overlay must not reach Pz");
static_assert(OFF_A8 + (size_t)NT * 1024 <= OFF_A, "PEER partial buffers must fit the q/k/v conv region");

struct Params {
    const float *x, *c, *ctx, *c_ctx, *mod_w, *mod_b, *norm1_g, *norm2_g, *pool_w, *pool_scale;
    const float *dn_w_in, *dn_conv_w, *dn_a_log, *dn_dt_bias, *dn_norm_g, *dn_w_out;
    const float *peer_wq, *peer_keys, *peer_u, *peer_v, *final_g;
    float* out; unsigned char* ws;
};

DEV bf16_t f2bf(float f) { return __builtin_bit_cast(unsigned short, (__bf16)f); }
DEV float bf2f(bf16_t h) { return __uint_as_float(((unsigned)h) << 16); }
typedef float f32x2_t __attribute__((ext_vector_type(2)));
typedef __bf16 bf16x2_t __attribute__((ext_vector_type(2)));
DEV unsigned pk2(float a, float b) { const f32x2_t v = {a, b}; const bf16x2_t r = __builtin_convertvector(v, bf16x2_t); return __builtin_bit_cast(unsigned, r); }
DEV float bflo(unsigned u) { return __uint_as_float(u << 16); }
DEV float bfhi(unsigned u) { return __uint_as_float(u & 0xffff0000u); }
DEV float wave_sum(float v) {
#pragma unroll
    for (int o = 32; o >= 1; o >>= 1) v += __shfl_xor(v, o);
    return v;
}
DEV float wave_max(float v) {
#pragma unroll
    for (int o = 32; o >= 1; o >>= 1) v = fmaxf(v, __shfl_xor(v, o));
    return v;
}
DEV float sum16(float v) {
#pragma unroll
    for (int o = 8; o >= 1; o >>= 1) v += __shfl_xor(v, o);
    return v;
}
DEV f32x16 mfma32(bf16x8 a, bf16x8 b, f32x16 c) { return __builtin_amdgcn_mfma_f32_32x32x16_bf16(a, b, c, 0, 0, 0); }
DEV int crow(int reg, int lane) { return (reg & 3) + 8 * (reg >> 2) + 4 * (lane >> 5); }
DEV f32x16 zero16() { f32x16 z;
#pragma unroll
    for (int i = 0; i < 16; ++i) z[i] = 0.f; return z; }
DEV bf16_t* hrow(const Params& P, int r) { return (bf16_t*)(P.ws + OFF_H) + (size_t)r * 1024; }
DEV float silu(float v) { return v * __builtin_amdgcn_rcpf(1.f + __expf(-v)); }

DEV bf16x8 frag_row(const LAS bf16_t* m, int ld, int r0, int k0, int lane) {
    return *(const LAS bf16x8*)(m + (r0 + (lane & 31)) * ld + k0 + 8 * (lane >> 5));
}
DEV bf16x8 frag_col(const LAS bf16_t* m, int ld, int c0, int k0, int lane) {
    bf16x8 f;
#pragma unroll
    for (int j = 0; j < 8; ++j) f[j] = (short)m[(k0 + 8 * (lane >> 5) + j) * ld + c0 + (lane & 31)];
    return f;
}

typedef short s16x4 __attribute__((ext_vector_type(4)));
DEV s16x4 ds_tr16(ldsp p) { return __builtin_amdgcn_ds_read_tr16_b64_v4i16((LAS s16x4*)p); }
DEV bf16x8 frag_col_tr(const LAS bf16_t* m, int ld, int c0, int k0, int lane) {
    const int gi = lane >> 4, li = lane & 15, q = li >> 2, pc = li & 3, h = gi >> 1;
    const LAS bf16_t* p = m + (k0 + 8 * h + q) * ld + c0 + 16 * (gi & 1) + 4 * pc;
    const s16x4 lo = ds_tr16((ldsp)p), hi = ds_tr16((ldsp)(p + 4 * ld));
    bf16x8 f; f[0] = lo[0]; f[1] = lo[1]; f[2] = lo[2]; f[3] = lo[3]; f[4] = hi[0]; f[5] = hi[1]; f[6] = hi[2]; f[7] = hi[3];
    return f;
}
DEV void p0_convert_item(const float* src, bf16_t* dst, size_t base) {
    const int tid = tid_fresh();
#pragma unroll
    for (int it = 0; it < 8; ++it) {
        const size_t e = base + ((size_t)it * NTHREADS + tid) * 8;
        const f32x4 a = *(const f32x4*)(src + e), b = *(const f32x4*)(src + e + 4);
        u32x4 o; o.x = pk2(a.x, a.y); o.y = pk2(a.z, a.w); o.z = pk2(b.x, b.y); o.w = pk2(b.z, b.w);
        *(u32x4*)(dst + e) = o;
    }
}
DEV void p0_table_item(const float* src, unsigned char* dst, float* rscale, int row0, bool as_int8) {
    const int tid = tid_fresh(), wave = tid >> 6, lane = tid & 63;
#pragma unroll 8
    for (int rr = 0; rr < 16; ++rr) {
        const int e = row0 + wave * 16 + rr;
        f32x4 v[4]; float am = 0.f;
#pragma unroll
        for (int q = 0; q < 4; ++q) { v[q] = __builtin_nontemporal_load((const f32x4*)(src + (size_t)e * 1024 + 256 * q + 4 * lane));
            am = fmaxf(am, fmaxf(fmaxf(fabsf(v[q].x), fabsf(v[q].y)), fmaxf(fabsf(v[q].z), fabsf(v[q].w)))); }
        am = wave_max(am);
        if (as_int8) {
            float ssq = 0.f;
#pragma unroll
            for (int q = 0; q < 4; ++q) ssq += v[q].x * v[q].x + v[q].y * v[q].y + v[q].z * v[q].z + v[q].w * v[q].w;
            ssq = wave_sum(ssq);
            const float top = fminf(am, 2.7f * sqrtf(ssq * (1.f / 1024.f)));
            am = top;
            const float sc = am > 0.f ? 7.f / am : 0.f;
#pragma unroll
            for (int q = 0; q < 4; ++q) {
                const int n0 = (int)fminf(fmaxf(rintf(v[q].x * sc), -7.f), 7.f) & 15, n1 = (int)fminf(fmaxf(rintf(v[q].y * sc), -7.f), 7.f) & 15;
                const int n2 = (int)fminf(fmaxf(rintf(v[q].z * sc), -7.f), 7.f) & 15, n3 = (int)fminf(fmaxf(rintf(v[q].w * sc), -7.f), 7.f) & 15;
                *(unsigned short*)(dst + ((size_t)q * 16384 + e) * 128 + 2 * lane) = (unsigned short)(n0 | (n1 << 4) | (n2 << 8) | (n3 << 12));
            }
            if (lane == 0) rscale[e] = am * (1.f / 7.f);
        } else {
            float ssq = 0.f;
#pragma unroll
            for (int q = 0; q < 4; ++q) ssq += v[q].x * v[q].x + v[q].y * v[q].y + v[q].z * v[q].z + v[q].w * v[q].w;
            ssq = wave_sum(ssq);
            const float top = fminf(am, 2.8f * sqrtf(ssq * (1.f / 1024.f)));
            const float sc = top > 0.f ? 6.f / top : 0.f;
#pragma unroll
            for (int q = 0; q < 4; ++q) {
                const float x0 = fminf(fmaxf(v[q].x * sc, -6.f), 6.f), x1 = fminf(fmaxf(v[q].y * sc, -6.f), 6.f), x2 = fminf(fmaxf(v[q].z * sc, -6.f), 6.f), x3 = fminf(fmaxf(v[q].w * sc, -6.f), 6.f);
                unsigned w = __builtin_amdgcn_cvt_scalef32_pk_fp4_f32(0u, x0, x1, 1.0f, 0);
                w = __builtin_amdgcn_cvt_scalef32_pk_fp4_f32(w, x2, x3, 1.0f, 1);
                *(unsigned short*)(dst + ((size_t)q * 16384 + e) * 128 + 2 * lane) = (unsigned short)(w & 0xffffu);
            }
            if (lane == 0) rscale[e] = top * (1.f / 6.f);
        }
    }
}
DEV void p0_transpose_item(const float* W, int K, int N, bf16_t* Wt, int kt, int nt, LAS float* tile) {
    const int tid = tid_fresh(), k0 = kt * 64, n0 = nt * 256;
    f32x4 v[8];
#pragma unroll
    for (int p = 0; p < 8; ++p) {
        const int kk = p * 8 + (tid >> 6), nn = (tid & 63) * 4, n = n0 + nn;
        v[p] = (f32x4){0.f, 0.f, 0.f, 0.f};
        if (n < N) v[p] = __builtin_nontemporal_load((const f32x4*)(W + (size_t)(k0 + kk) * N + n));
    }
#pragma unroll
    for (int p = 0; p < 8; ++p) {
        const int kk = p * 8 + (tid >> 6), nn = (tid & 63) * 4;
        tile[kk * 257 + nn + 0] = v[p].x; tile[kk * 257 + nn + 1] = v[p].y; tile[kk * 257 + nn + 2] = v[p].z; tile[kk * 257 + nn + 3] = v[p].w;
    }
    __syncthreads();
#pragma unroll
    for (int q = 0; q < 4; ++q) {
        const int n = q * 64 + (tid >> 3), kc = (tid & 7) * 8;
        u32x4 o;
        o.x = pk2(tile[(kc + 0) * 257 + n], tile[(kc + 1) * 257 + n]);
        o.y = pk2(tile[(kc + 2) * 257 + n], tile[(kc + 3) * 257 + n]);
        o.z = pk2(tile[(kc + 4) * 257 + n], tile[(kc + 5) * 257 + n]);
        o.w = pk2(tile[(kc + 6) * 257 + n], tile[(kc + 7) * 257 + n]);
        *(u32x4*)(Wt + (size_t)(n0 + n) * K + k0 + kc) = o;
    }
    __syncthreads();
}
DEV void p0_mod_item(const Params& P, int i, int cb, LAS float* lds) {
    LAS float* s = lds;
    LAS float* red = lds + 9 * 1024;
    const int tid = tid_fresh();
    for (int e = tid; e < 9 * 1024; e += NTHREADS) {
        const int m = e >> 10, k = e & 1023;
        const float cv = m < 8 ? P.c[m * 1024 + k] : P.c_ctx[k];
        s[e] = silu(cv);
    }
    __syncthreads();
    const int cq = tid & 31, kg = tid >> 5;
    const float* W = P.mod_w + (size_t)i * 1024 * 6144 + cb * 128 + cq * 4;
    f32x4 acc[9];
#pragma unroll
    for (int m = 0; m < 9; ++m) acc[m] = (f32x4){0.f, 0.f, 0.f, 0.f};
#pragma unroll 16
    for (int kk = 0; kk < 64; ++kk) {
        const int k = kg * 64 + kk;
        const f32x4 w = __builtin_nontemporal_load((const f32x4*)(W + (size_t)k * 6144));
#pragma unroll
        for (int m = 0; m < 9; ++m) { const float sv = s[m * 1024 + k]; acc[m] += w * sv; }
    }
#pragma unroll
    for (int m = 0; m < 9; ++m) *(LAS f32x4*)&red[(kg * 9 + m) * 128 + cq * 4] = acc[m];
    __syncthreads();
    float* modv = (float*)(P.ws + OFF_MODV);
    for (int e = tid; e < 9 * 128; e += NTHREADS) {
        const int m = e >> 7, col = e & 127;
        float sum = 0.f;
#pragma unroll
        for (int g = 0; g < 16; ++g) sum += red[(g * 9 + m) * 128 + col];
        modv[(size_t)(i * 9 + m) * 6144 + cb * 128 + col] = sum + P.mod_b[i * 6144 + cb * 128 + col];
    }
    __syncthreads();
}
DEV void phase_prep(const Params& P, ldsp lds0) {
    constexpr int N_MOD = 96, N_WQ = 2 * 16 * 8, N_WIN = 16 * 17, N_WOUT = 16 * 4, N_POOL = 4 * 4;
    constexpr int N_TR = N_WQ + N_WIN + N_WOUT + N_POOL, N_TAB = 4 * 128, N_KEYS = 16;
    constexpr int TOTAL = N_MOD + N_TR + N_TAB + N_KEYS;
    for (int item = blockIdx.x; item < TOTAL; item += gridDim.x) {
        LAS float* lds = (LAS float*)launder(lds0);
        int r = item;
        if (r < N_MOD) { p0_mod_item(P, r / 48, r % 48, lds); continue; }
        r -= N_MOD;
        if (r < N_WQ) { const int i = r / 128, t = r % 128;
            p0_transpose_item(P.peer_wq + (size_t)i * 1024 * 2048, 1024, 2048, (bf16_t*)(P.ws + OFF_WQT) + (size_t)i * 2048 * 1024, t / 8, t % 8, lds); continue; }
        r -= N_WQ;
        if (r < N_WIN) { p0_transpose_item(P.dn_w_in, 1024, 4128, (bf16_t*)(P.ws + OFF_WINT), r / 17, r % 17, lds); continue; }
        r -= N_WIN;
        if (r < N_WOUT) { p0_transpose_item(P.dn_w_out, 1024, 1024, (bf16_t*)(P.ws + OFF_WOUTT), r / 4, r % 4, lds); continue; }
        r -= N_WOUT;
        if (r < N_POOL) { const int g = r / 4, t = r % 4;
            p0_transpose_item(P.pool_w + (size_t)g * 65536, 256, 256, (bf16_t*)(P.ws + OFF_POOLT) + (size_t)g * 65536, t, 0, lds); continue; }
        r -= N_POOL;
        if (r < N_TAB) { const int tb = r / 128, ch = r % 128;
            const float* src = ((tb & 1) ? P.peer_v : P.peer_u) + (size_t)(tb >> 1) * TAB_ELEMS;
            p0_table_item(src, P.ws + OFF_TAB + (size_t)tb * 16 * MiB, (float*)(P.ws + OFF_RSC) + tb * 16384, ch * 128, (tb & 1) == 0); continue; }
        r -= N_TAB;
        p0_convert_item(P.peer_keys, (bf16_t*)(P.ws + OFF_KEYS), (size_t)r * 32768);
    }
}

template <int SRC>
DEV void phase_modulate(const Params& P, int layer, int which, int nrows, bool q8 = false) {
    const float* gain = (which ? P.norm2_g : P.norm1_g) + layer * 1024;
    const float* modv = (const float*)(P.ws + OFF_MODV) + (size_t)layer * 9 * 6144;
    bf16_t* A = (bf16_t*)(P.ws + OFF_A);
    const int tid = tid_fresh(); const int wave = tid >> 6, lane = tid & 63;
    for (int r = blockIdx.x * 8 + wave; r < nrows; r += gridDim.x * 8) {
        const int m = r < NX ? (r >> 11) : 8;
        const float* sh = modv + m * 6144 + which * 3072;
        const float* sc = sh + 1024;
        f32x4 v[4]; float ss = 0.f;
#pragma unroll
        for (int j = 0; j < 4; ++j) {
            if (SRC == 0) { const float* src = r < NX ? P.x + (size_t)r * 1024 : P.ctx + (size_t)(r - NX) * 1024; v[j] = *(const f32x4*)(src + j * 256 + lane * 4); }
            else { const u32x2 hv = *(const u32x2*)(hrow(P, r) + j * 256 + lane * 4); v[j] = (f32x4){bflo(hv.x), bfhi(hv.x), bflo(hv.y), bfhi(hv.y)}; }
            ss += v[j].x * v[j].x + v[j].y * v[j].y + v[j].z * v[j].z + v[j].w * v[j].w;
        }
        ss = wave_sum(ss);
        const float rstd = rsqrtf(ss * (1.f / 1024.f) + EPS);
#pragma unroll
        for (int j = 0; j < 4; ++j) {
            const int col = j * 256 + lane * 4;
            const f32x4 g = *(const f32x4*)(gain + col), s1 = *(const f32x4*)(sc + col), s0 = *(const f32x4*)(sh + col);
            const f32x4 y = v[j] * rstd * g * (1.f + s1) + s0;
            u32x2 o; o.x = pk2(y.x, y.y); o.y = pk2(y.z, y.w);
            *(u32x2*)(A + (size_t)r * 1024 + col) = o;
            v[j] = y;
        }
        if (q8) {
            float am = 0.f;
#pragma unroll
            for (int j = 0; j < 4; ++j) am = fmaxf(am, fmaxf(fmaxf(fabsf(v[j].x), fabsf(v[j].y)), fmaxf(fabsf(v[j].z), fabsf(v[j].w))));
            am = wave_max(am);
            const float sc = am > 0.f ? 119.f / am : 0.f;
            unsigned char* a8 = P.ws + OFF_A8 + (size_t)r * 1024;
#pragma unroll
            for (int j = 0; j < 4; ++j) {
                unsigned mh = 0u, ml = 0u;
#pragma unroll
                for (int e = 0; e < 4; ++e) {
                    const int b = (int)rintf(v[j][e] * sc), h = (b + 8) >> 4, l = b - 16 * h;
                    mh |= (unsigned)(h & 15) << (4 * e); ml |= (unsigned)(l & 15) << (4 * e);
                }
                const unsigned mine = mh | (ml << 16), other = (unsigned)__shfl_xor((int)mine, 1);
                const unsigned outw = (lane & 1) ? ((other >> 16) | (mine & 0xffff0000u)) : ((mine & 0xffffu) | (other << 16));
                *(unsigned*)(a8 + (j * 8 + (lane >> 3)) * 32 + (lane & 1) * 16 + 4 * ((lane & 7) >> 1)) = outw;
            }
            if (lane == 0) ((float*)(P.ws + OFF_XS))[r] = am * (1.f / 119.f);
        }
    }
}

DEV void unpack8(const u32x4 v, float* f) {
    f[0] = bflo(v.x); f[1] = bfhi(v.x); f[2] = bflo(v.y); f[3] = bfhi(v.y); f[4] = bflo(v.z); f[5] = bfhi(v.z); f[6] = bflo(v.w); f[7] = bfhi(v.w);
}
template <int W>
DEV void pool_vertical(const bf16_t* A0, LAS float* V, int b, int r, int cbase, int tq, int ch8, float (&cen)[4][8]) {
    const int rlo = max(0, r - W / 2), rhi = min(32, r - W / 2 + W);
    const float inv = 1.f / (float)(rhi - rlo);
#pragma unroll
    for (int jh = 0; jh < 2; ++jh) {
        u32x4 ld[2][W];
#pragma unroll
        for (int jj = 0; jj < 2; ++jj)
#pragma unroll
            for (int k = 0; k < W; ++k) {
                const int rr = min(rlo + k, 31), tok = tq + 16 * (2 * jh + jj);
                ld[jj][k] = *(const u32x4*)(A0 + ((size_t)b * 2048 + rr * 64 + tok) * 1024 + cbase);
            }
#pragma unroll
        for (int jj = 0; jj < 2; ++jj) {
            const int j = 2 * jh + jj, tok = tq + 16 * j;
            float acc[8];
#pragma unroll
            for (int e = 0; e < 8; ++e) acc[e] = 0.f;
#pragma unroll
            for (int k = 0; k < W; ++k) {
                float f[8]; unpack8(ld[jj][k], f);
                const bool in = rlo + k < rhi;
#pragma unroll
                for (int e = 0; e < 8; ++e) acc[e] += in ? f[e] : 0.f;
                if (rlo + k == r) {
#pragma unroll
                    for (int e = 0; e < 8; ++e) cen[j][e] = f[e];
                }
            }
            LAS float* vp = V + (tok + 8) * 260 + ch8 * 8;
            *(LAS f32x4*)vp = (f32x4){acc[0] * inv, acc[1] * inv, acc[2] * inv, acc[3] * inv};
            *(LAS f32x4*)(vp + 4) = (f32x4){acc[4] * inv, acc[5] * inv, acc[6] * inv, acc[7] * inv};
        }
    }
}
template <int W>
DEV void pool_horizontal(const LAS float* V, ldsp At, bool isx, int seg, int tq, int ch8, const float (&cen)[4][8]) {
#pragma unroll
    for (int j = 0; j < 4; ++j) {
        const int tok = tq + 16 * j;
        const int pos = isx ? tok : 64 * seg + tok, lim = isx ? 64 : 256, off = isx ? 8 : 8 - 64 * seg;
        const int lo = max(0, pos - W / 2), hi = min(lim, pos - W / 2 + W);
        f32x4 s0 = {0.f, 0.f, 0.f, 0.f}, s1 = {0.f, 0.f, 0.f, 0.f};
#pragma unroll
        for (int k = 0; k < W; ++k) {
            const int t = min(lo + k, lim - 1);
            const LAS float* vp = V + (t + off) * 260 + ch8 * 8;
            const f32x4 a = *(const LAS f32x4*)vp, b2 = *(const LAS f32x4*)(vp + 4);
            const float m = (lo + k < hi) ? 1.f : 0.f;
            s0 += a * m; s1 += b2 * m;
        }
        const float inv = 1.f / (float)(hi - lo);
        u32x4 o;
        o.x = pk2(s0.x * inv - cen[j][0], s0.y * inv - cen[j][1]);
        o.y = pk2(s0.z * inv - cen[j][2], s0.w * inv - cen[j][3]);
        o.z = pk2(s1.x * inv - cen[j][4], s1.y * inv - cen[j][5]);
        o.w = pk2(s1.z * inv - cen[j][6], s1.w * inv - cen[j][7]);
        *(LAS u32x4*)(At + tok * 512 + ((ch8 ^ (tok & 7)) << 4)) = o;
    }
}
DEV void phase_pool(const Params& P, ldsp lds0) {
    const bf16_t* A0 = (const bf16_t*)(P.ws + OFF_A);
    const float* modv = (const float*)(P.ws + OFF_MODV);
    const bf16_t* Wt = (const bf16_t*)(P.ws + OFF_POOLT);
    const int tid = tid_fresh(), lane = tid & 63, wave = tid >> 6;
    const int ch8 = tid & 31, tq = tid >> 5;
    for (int item = blockIdx.x; item < 1152; item += gridDim.x) {
        const ldsp lds = launder(lds0);
        LAS float* V = (LAS float*)lds;
        const ldsp At = lds + 80 * 260 * 4;
        const bool isx = item < 1024;
        int b, r = 0, seg = 0, g;
        if (isx) { b = item >> 7; r = (item >> 2) & 31; }
        else { const int it = item - 1024; b = it >> 4; seg = (it >> 2) & 3; }
        g = ((item & 3) + (item >> 8)) & 3;
        const int cbase = g * 256 + ch8 * 8;
        float cen[4][8];
        if (isx) {
            if (g == 0) pool_vertical<2>(A0, V, b, r, cbase, tq, ch8, cen);
            else if (g == 1) pool_vertical<4>(A0, V, b, r, cbase, tq, ch8, cen);
            else if (g == 2) pool_vertical<8>(A0, V, b, r, cbase, tq, ch8, cen);
            else pool_vertical<16>(A0, V, b, r, cbase, tq, ch8, cen);
        } else {
            for (int q = tq; q < 80; q += 16) {
                const int t = 64 * seg - 8 + q;
                if (t >= 0 && t < 256) {
                    const u32x4 pv = *(const u32x4*)(A0 + ((size_t)NX + b * 256 + t) * 1024 + cbase);
                    float f[8]; unpack8(pv, f);
                    LAS float* vp = V + q * 260 + ch8 * 8;
                    *(LAS f32x4*)vp = (f32x4){f[0], f[1], f[2], f[3]};
                    *(LAS f32x4*)(vp + 4) = (f32x4){f[4], f[5], f[6], f[7]};
                }
            }
#pragma unroll
            for (int j = 0; j < 4; ++j) {
                const int tok = tq + 16 * j;
                const u32x4 pv = *(const u32x4*)(A0 + ((size_t)NX + b * 256 + 64 * seg + tok) * 1024 + cbase);
                unpack8(pv, cen[j]);
            }
        }
        __syncthreads();
        if (g == 0) pool_horizontal<2>(V, At, isx, seg, tq, ch8, cen);
        else if (g == 1) pool_horizontal<4>(V, At, isx, seg, tq, ch8, cen);
        else if (g == 2) pool_horizontal<8>(V, At, isx, seg, tq, ch8, cen);
        else pool_horizontal<16>(V, At, isx, seg, tq, ch8, cen);
        __syncthreads();
        f32x16 acc[2]; acc[0] = zero16(); acc[1] = zero16();
        const bf16_t* Wg = Wt + (size_t)g * 65536 + (size_t)(32 * wave + (lane & 31)) * 256 + (lane >> 5) * 8;
#pragma unroll 4
        for (int ks = 0; ks < 16; ++ks) {
            const bf16x8 wfr = *(const bf16x8*)(Wg + ks * 16);
            const int ch = ks * 2 + (lane >> 5);
#pragma unroll
            for (int mt = 0; mt < 2; ++mt) {
                const int row = mt * 32 + (lane & 31);
                const bf16x8 a = *(const LAS bf16x8*)(At + row * 512 + ((ch ^ (row & 7)) << 4));
                acc[mt] = mfma32(wfr, a, acc[mt]);
            }
        }
        const int m = isx ? b : 8;
#pragma unroll
        for (int mt = 0; mt < 2; ++mt)
#pragma unroll
            for (int rg = 0; rg < 4; ++rg) {
                const int tok = mt * 32 + (lane & 31), col = g * 256 + 32 * wave + 8 * rg + 4 * (lane >> 5);
                const f32x4 gs = *(const f32x4*)(modv + m * 6144 + 2048 + col) * *(const f32x4*)(P.pool_scale + col);
                const f32x4 av = {acc[mt][rg * 4 + 0], acc[mt][rg * 4 + 1], acc[mt][rg * 4 + 2], acc[mt][rg * 4 + 3]};
                f32x4 hv; int grow;
                if (isx) { grow = b * 2048 + r * 64 + tok; hv = __builtin_nontemporal_load((const f32x4*)(P.x + (size_t)grow * 1024 + col)) + gs * av; }
                else { const size_t gi = ((size_t)b * 256 + 64 * seg + tok) * 1024 + col; grow = NX + b * 256 + 64 * seg + tok; hv = *(const f32x4*)(P.ctx + gi) + gs * av; }
                u32x2 hp; hp.x = pk2(hv.x, hv.y); hp.y = pk2(hv.z, hv.w);
                *(u32x2*)(hrow(P, grow) + col) = hp;
            }
        __syncthreads();
    }
}

DEV bf16x8 frag_row_x(ldsp x, int r0, int k0, int lane) {
    const int row = r0 + (lane & 31), ch = (k0 >> 3) + (lane >> 5);
    return *(const LAS bf16x8*)(x + row * 256 + ((ch ^ (row & 15)) << 4));
}
DEV unsigned key_of(float f) { const unsigned u = __float_as_uint(f); return u ^ ((unsigned)((int)u >> 31) | 0x80000000u); }
DEV float val_of(unsigned k) { const unsigned u = (k & 0x80000000u) ? (k ^ 0x80000000u) : ~k; return __uint_as_float(u); }
DEV void cmpx(unsigned& hi, unsigned& lo) { const unsigned a = hi, b = lo; hi = a > b ? a : b; lo = a > b ? b : a; }
DEV void sort16_desc(unsigned* v) {
#pragma unroll
    for (int k = 2; k <= 16; k <<= 1)
#pragma unroll
        for (int j = k >> 1; j > 0; j >>= 1)
#pragma unroll
            for (int i = 0; i < 16; ++i) {
                const int l = i ^ j;
                if (l > i) { if ((i & k) == 0) cmpx(v[i], v[l]); else cmpx(v[l], v[i]); }
            }
}
DEV void merge16(unsigned* r, const unsigned* b) {
#pragma unroll
    for (int k = 0; k < 16; ++k) r[k] = r[k] > b[15 - k] ? r[k] : b[15 - k];
#pragma unroll
    for (int j = 8; j > 0; j >>= 1)
#pragma unroll
        for (int i = 0; i < 16; ++i) { const int l = i ^ j; if (l > i) cmpx(r[i], r[l]); }
}
DEV void top16_of_64(unsigned* v, unsigned* r) {
#pragma unroll
    for (int blk = 0; blk < 4; ++blk) sort16_desc(v + 16 * blk);
#pragma unroll
    for (int k = 0; k < 16; ++k) r[k] = v[k];
    merge16(r, v + 16); merge16(r, v + 32); merge16(r, v + 48);
}
DEV void phase_topk(const Params& P, int layer, int nrows, ldsp lds0) {
    const bf16_t* Q = (const bf16_t*)(P.ws + OFF_R1);
    const bf16_t* keys = (const bf16_t*)(P.ws + OFF_KEYS) + (size_t)layer * 8 * 2 * 128 * 128;
    bf16_t* seli = (bf16_t*)(P.ws + OFF_SELI);
    float* selg = (float*)(P.ws + OFF_SELG);
    const int tid = tid_fresh(), lane = tid & 63, wave = tid >> 6;
    const int nitems = (nrows / 256) * 4;
    const unsigned hoff = (unsigned)(lane >> 5) * 4u;
    const int G = gridDim.x, nfr = nitems / G, left = nitems - nfr * G;
    int per = 0;
    if (left) { per = (left * 8 + G - 1) / G; per = per <= 1 ? 1 : per <= 2 ? 2 : per <= 4 ? 4 : 8; }
    const int nloop = nfr + ((left && (int)blockIdx.x * per < left * 8) ? 1 : 0);
    for (int it = 0; it < nloop; ++it) {
        const ldsp lds = launder(lds0);
        LAS unsigned* sl = (LAS unsigned*)(lds + 65536 + wave * 8192);
        int item, wtask; bool act;
        if (it < nfr) { item = it * G + blockIdx.x; wtask = wave; act = true; }
        else { const int j = blockIdx.x * per + wave; item = nfr * G + ((blockIdx.x * per) >> 3); wtask = j & 7; act = wave < per; }
        act = __builtin_amdgcn_readfirstlane((int)act) != 0;
        const int tg = item >> 2, hp = item & 3, row0 = tg * 256 + wtask * 32;
        u32x4 kr[4]; bf16x8 qf[8];
        {
            const bf16_t* kt = keys + (size_t)((hp * 2) * 2) * 128 * 128;
#pragma unroll
            for (int j = 0; j < 4; ++j) { const int cid = tid + NTHREADS * j, r = cid >> 4, ch = cid & 15; kr[j] = *(const u32x4*)(kt + r * 128 + ch * 8); }
#pragma unroll
            for (int j = 0; j < 4; ++j) { const int cid = tid + NTHREADS * j, r = cid >> 4, ch = cid & 15; *(LAS u32x4*)(lds + r * 256 + ((ch ^ (r & 15)) << 4)) = kr[j]; }
            const bf16_t* qb = Q + (size_t)(row0 + (lane & 31)) * 2048 + (hp * 2) * 256 + (lane >> 5) * 8;
#pragma unroll
            for (int ks = 0; ks < 8; ++ks) qf[ks] = *(const bf16x8*)(qb + ks * 16);
        }
        __syncthreads();
        unsigned s1[16], s2[16];
#pragma unroll
        for (int k = 0; k < 16; ++k) { s1[k] = 0u; s2[k] = 0u; }
#pragma unroll 1
        for (int step = 0; step < 4; ++step) {
            const int hs = step >> 1, p = step & 1;
            const bool mine = (lane >> 5) == hs;
            const ldsp kb = lds + (step & 1) * 32768;
            if (step < 3) {
                const bf16_t* kt = keys + (size_t)((hp * 2 + ((step + 1) >> 1)) * 2 + ((step + 1) & 1)) * 128 * 128;
#pragma unroll
                for (int j = 0; j < 4; ++j) { const int cid = tid + NTHREADS * j, r = cid >> 4, ch = cid & 15; kr[j] = *(const u32x4*)(kt + r * 128 + ch * 8); }
            }
            f32x16 acc[4];
#pragma unroll
            for (int mt = 0; mt < 4; ++mt) acc[mt] = zero16();
            if (act) {
#pragma unroll
            for (int ks = 0; ks < 8; ++ks)
#pragma unroll
                for (int mt = 0; mt < 4; ++mt) acc[mt] = mfma32(frag_row_x(kb, mt * 32, ks * 16, lane), qf[ks], acc[mt]);
            }
            if (step < 3) {
                const ldsp kn = lds + ((step + 1) & 1) * 32768;
#pragma unroll
                for (int j = 0; j < 4; ++j) { const int cid = tid + NTHREADS * j, r = cid >> 4, ch = cid & 15; *(LAS u32x4*)(kn + r * 256 + ((ch ^ (r & 15)) << 4)) = kr[j]; }
                const bf16_t* qb = Q + (size_t)(row0 + (lane & 31)) * 2048 + (hp * 2 + ((step + 1) >> 1)) * 256 + ((step + 1) & 1) * 128 + (lane >> 5) * 8;
#pragma unroll
                for (int ks = 0; ks < 8; ++ks) qf[ks] = *(const bf16x8*)(qb + ks * 16);
            }
            if (act) {
            unsigned v[64];
#pragma unroll
            for (int mt = 0; mt < 4; ++mt)
#pragma unroll
                for (int reg = 0; reg < 16; ++reg) {
                    const unsigned c = mt * 32 + (reg & 3) + 8 * (reg >> 2);
                    v[mt * 16 + reg] = ((key_of(acc[mt][reg]) & ~127u) | (127u - c)) ^ hoff;
                }
            unsigned r[16], o[16];
            top16_of_64(v, r);
#pragma unroll
            for (int k = 0; k < 16; ++k) o[k] = (unsigned)__shfl_xor((int)r[k], 32);
            merge16(r, o);
#pragma unroll
            for (int k = 0; k < 16; ++k) { if (p == 0) s1[k] = mine ? r[k] : s1[k]; else s2[k] = mine ? r[k] : s2[k]; }
            }
            __syncthreads();
        }
        if (!act) continue;
        float f1[16], f2[16];
#pragma unroll
        for (int k = 0; k < 16; ++k) {
            sl[k * 64 + lane] = s1[k]; sl[(16 + k) * 64 + lane] = s2[k];
            f1[k] = val_of(s1[k] & ~127u); f2[k] = val_of(s2[k] & ~127u);
        }
        unsigned cv[64];
        {
            int n = 0;
#pragma unroll
            for (int a = 0; a < 16; ++a)
#pragma unroll
                for (int b = 0; b < 16; ++b)
                    if ((a + 1) * (b + 1) <= 16) { cv[n] = (key_of(f1[a] + f2[b]) & ~255u) | (255u - (unsigned)(a * 16 + b)); ++n; }
#pragma unroll
            for (int q = 50; q < 64; ++q) cv[q] = 0u;
        }
        unsigned w[16];
        top16_of_64(cv, w);
        float sc[16]; int ei[16];
#pragma unroll
        for (int k = 0; k < 16; ++k) {
            const unsigned ab = 255u - (w[k] & 255u);
            const unsigned k1 = sl[(ab >> 4) * 64 + lane], k2 = sl[(16 + (ab & 15u)) * 64 + lane];
            ei[k] = (int)((127u - (k1 & 127u)) * 128u + (127u - (k2 & 127u)));
            sc[k] = val_of(w[k] & ~255u);
        }
        const float mx = sc[0];
        float tot = 0.f;
#pragma unroll
        for (int k = 0; k < 16; ++k) { sc[k] = expf(sc[k] - mx); tot += sc[k]; }
        const int row = row0 + (lane & 31), head = hp * 2 + (lane >> 5);
        bf16_t* ip = seli + (size_t)row * 128 + head * 16;
        float* gp = selg + (size_t)row * 128 + head * 16;
        const float inv = 1.f / tot;
#pragma unroll
        for (int q = 0; q < 2; ++q) {
            u32x4 o;
#pragma unroll
            for (int d = 0; d < 4; ++d) o[d] = (unsigned)ei[8 * q + 2 * d] | ((unsigned)ei[8 * q + 2 * d + 1] << 16);
            *(u32x4*)(ip + 8 * q) = o;
        }
#pragma unroll
        for (int q = 0; q < 4; ++q) *(float4*)(gp + 4 * q) = make_float4(sc[4 * q] * inv, sc[4 * q + 1] * inv, sc[4 * q + 2] * inv, sc[4 * q + 3] * inv);
    }
}

struct XGeo { int nloc, rank, nact, pos; };
typedef float f32x2 __attribute__((ext_vector_type(2)));
DEV void fp8x16_to_f32(const u32x4 r, float* f) {
#pragma unroll
    for (int d = 0; d < 4; ++d) {
        const f32x2 lo = __builtin_amdgcn_cvt_pk_f32_fp8((int)r[d], false), hi = __builtin_amdgcn_cvt_pk_f32_fp8((int)r[d], true);
        f[4 * d + 0] = lo.x; f[4 * d + 1] = lo.y; f[4 * d + 2] = hi.x; f[4 * d + 3] = hi.y;
    }
}
template <int S, int MUL, class T>
DEV void bfly_stage(T* p, int lane) {
    const bool hi = (lane & (S * MUL)) != 0;
#pragma unroll
    for (int i = 0; i < 2 * S; ++i) { const T keep = hi ? p[i + 2 * S] : p[i], send = hi ? p[i] : p[i + 2 * S]; p[i] = keep + __shfl_xor(send, S * MUL); }
}
template <int N2>
DEV void bfly_swap32(float* p) {
#pragma unroll
    for (int i = 0; i < N2; ++i) { const auto r = __builtin_amdgcn_permlane32_swap(__float_as_uint(p[i]), __float_as_uint(p[i + N2]), false, false); p[i] = __uint_as_float(r[0]) + __uint_as_float(r[1]); }
}
template <int N2>
DEV void bfly_swap16(float* p) {
#pragma unroll
    for (int i = 0; i < N2; ++i) { const auto r = __builtin_amdgcn_permlane16_swap(__float_as_uint(p[i]), __float_as_uint(p[i + N2]), false, false); p[i] = __uint_as_float(r[0]) + __uint_as_float(r[1]); }
}
template <int N2>
DEV void bfly_ror8(float* p, int lane) {
    const bool hi = (lane & 8) != 0;
#pragma unroll
    for (int i = 0; i < N2; ++i) {
        const float a = p[i] + __uint_as_float((unsigned)__builtin_amdgcn_update_dpp(0, (int)__float_as_uint(p[i]), 0x128, 0xf, 0xf, false));
        const float b = p[i + N2] + __uint_as_float((unsigned)__builtin_amdgcn_update_dpp(0, (int)__float_as_uint(p[i + N2]), 0x128, 0xf, 0xf, false));
        p[i] = hi ? b : a;
    }
}
template <int STAGE>
DEV void ex_issue(u32x4 (&buf)[16], u32x4 (&aux)[4], f32x2 (&hg)[2], const u32x4 (&idn)[2], const unsigned char* slice, const Params& P, const bf16_t* A, const bf16_t* wexp,
                  const float* gatev, int t, int sl, int g, int c) {
    int id[16];
#pragma unroll
    for (int q = 0; q < 2; ++q)
#pragma unroll
        for (int d = 0; d < 4; ++d) { id[8 * q + 2 * d] = (int)(idn[q][d] & 0xffffu); id[8 * q + 2 * d + 1] = (int)(idn[q][d] >> 16); }
#pragma unroll
    for (int k = 0; k < 16; ++k) buf[k] = *(const u32x4*)(slice + (size_t)id[k] * 128);
    if (STAGE == 1) {
        aux[0] = *(const u32x4*)(P.ws + OFF_A8 + (size_t)t * 1024 + 256 * sl + 32 * c); aux[1] = *(const u32x4*)(P.ws + OFF_A8 + (size_t)t * 1024 + 256 * sl + 32 * c + 16);
        hg[0].x = ((const float*)(P.ws + OFF_XS))[t];
    } else {
#pragma unroll
        for (int q = 0; q < 2; ++q) aux[q] = *(const u32x4*)(wexp + (size_t)t * 128 + 16 * g + 8 * q);
        const int col = 256 * sl + 32 * c + 4 * g, m = t < NX ? (t >> 11) : 8;
        const u32x2 hv = *(const u32x2*)(hrow(P, t) + col);
        aux[2] = (u32x4){hv.x, hv.y, 0u, 0u};
        aux[3] = *(const u32x4*)(gatev + m * 6144 + col);
    }
}
template <int STAGE>
DEV void ex_compute(const u32x4 (&buf)[16], const u32x4 (&aux)[4], const f32x2 (&hg)[2], const Params& P, float* part, int t, int sl, int lane, int g, int c) {
    if (STAGE == 1) {
        int sx = 0;
#pragma unroll
        for (int q = 0; q < 2; ++q)
#pragma unroll
            for (int d = 0; d < 4; ++d) sx = __builtin_amdgcn_sdot4(0x01010101, (int)aux[q][d], sx, false);
        int p[16];
#pragma unroll
        for (int k = 0; k < 16; ++k) {
            int a = -8 * sx;
#pragma unroll
            for (int d = 0; d < 4; ++d) {
                const unsigned w = buf[k][d];
                a = __builtin_amdgcn_sdot4((int)(w & 0x0F0F0F0Fu), (int)aux[d >> 1][2 * (d & 1)], a, false);
                a = __builtin_amdgcn_sdot4((int)((w >> 4) & 0x0F0F0F0Fu), (int)aux[d >> 1][2 * (d & 1) + 1], a, false);
            }
            p[k] = a;
        }
        bfly_stage<4, 1>(p, lane); bfly_stage<2, 1>(p, lane); bfly_stage<1, 1>(p, lane);
        const float xs = hg[0].x;
        *(unsigned*)((bf16_t*)part + ((size_t)sl * NT + t) * 128 + 2 * lane) = pk2((float)p[0] * xs, (float)p[1] * xs);
    } else {
        f32x2 p2[16];
#pragma unroll
        for (int i = 0; i < 16; ++i) p2[i] = (f32x2){0.f, 0.f};
#pragma unroll
        for (int k = 0; k < 16; ++k) {
            const unsigned wpk = aux[k >> 3][(k >> 1) & 3];
            const float wkf = (k & 1) ? bfhi(wpk) : bflo(wpk);
            const f32x2 w2 = {wkf, wkf};
#pragma unroll
            for (int d = 0; d < 4; ++d) {
                p2[4 * d + 0] += w2 * __builtin_amdgcn_cvt_scalef32_pk_f32_fp4(buf[k][d], 1.0f, 0);
                p2[4 * d + 1] += w2 * __builtin_amdgcn_cvt_scalef32_pk_f32_fp4(buf[k][d], 1.0f, 1);
                p2[4 * d + 2] += w2 * __builtin_amdgcn_cvt_scalef32_pk_f32_fp4(buf[k][d], 1.0f, 2);
                p2[4 * d + 3] += w2 * __builtin_amdgcn_cvt_scalef32_pk_f32_fp4(buf[k][d], 1.0f, 3);
            }
            asm volatile("" : "+v"(p2[0]), "+v"(p2[1]), "+v"(p2[2]), "+v"(p2[3]), "+v"(p2[4]), "+v"(p2[5]), "+v"(p2[6]), "+v"(p2[7]),
                              "+v"(p2[8]), "+v"(p2[9]), "+v"(p2[10]), "+v"(p2[11]), "+v"(p2[12]), "+v"(p2[13]), "+v"(p2[14]), "+v"(p2[15]));
        }
        float p[32];
#pragma unroll
        for (int i = 0; i < 16; ++i) { p[2 * i] = p2[i].x; p[2 * i + 1] = p2[i].y; }
        bfly_stage<8, 4>(p, lane); bfly_stage<4, 4>(p, lane); bfly_stage<2, 4>(p, lane);
        const int col = 256 * sl + 32 * c + 4 * g;
        const unsigned h0 = aux[2].x, h1 = aux[2].y;
        u32x2 ho;
        ho.x = pk2(bflo(h0) + __uint_as_float(aux[3].x) * p[0], bfhi(h0) + __uint_as_float(aux[3].y) * p[1]);
        ho.y = pk2(bflo(h1) + __uint_as_float(aux[3].z) * p[2], bfhi(h1) + __uint_as_float(aux[3].w) * p[3]);
        *(u32x2*)(hrow(P, t) + col) = ho;
    }
}
template <int STAGE>
DEV void phase_experts_sliced(const Params& P, int layer, int nrows, const XGeo geo) {
    const unsigned char* tab = P.ws + OFF_TAB + (size_t)(layer * 2 + (STAGE - 1)) * 16 * MiB;
    const bf16_t* A = (const bf16_t*)(P.ws + OFF_A);
    const bf16_t* seli = (const bf16_t*)(P.ws + OFF_SELI);
    float* part = (float*)(P.ws + OFF_PART);
    const bf16_t* wexp = (const bf16_t*)(P.ws + OFF_WEXP);
    const float* gatev = (const float*)(P.ws + OFF_MODV) + (size_t)layer * 9 * 6144 + 5 * 1024;
    const int tid = tid_fresh(), wave = tid >> 6, lane = tid & 63, g = lane >> 3, c = lane & 7;
    const int nw = geo.nloc * 8, wr = geo.rank * 8 + wave;
    for (int vs = geo.pos; vs < 8; vs += geo.nact) {
        const int sl = vs >> 1, tmul = 2, tadd = vs & 1;
        const unsigned char* slice = tab + (size_t)sl * 2 * MiB + 16 * c;
        const int nws = nw * tmul;
        int t = wr * tmul + tadd;
        if (t >= nrows) continue;
        u32x4 bufA[16], bufB[16], auxA[4], auxB[4]; f32x2 hgA[2], hgB[2]; u32x4 idn[2];
#pragma unroll
        for (int q = 0; q < 2; ++q) idn[q] = *(const u32x4*)(seli + (size_t)t * 128 + 16 * g + 8 * q);
        ex_issue<STAGE>(bufA, auxA, hgA, idn, slice, P, A, wexp, gatev, t, sl, g, c);
        if (t + nws < nrows) {
#pragma unroll
            for (int q = 0; q < 2; ++q) idn[q] = *(const u32x4*)(seli + (size_t)(t + nws) * 128 + 16 * g + 8 * q);
        }
        for (;;) {
            {
                const int t1 = t + nws;
                if (t1 < nrows) {
                    ex_issue<STAGE>(bufB, auxB, hgB, idn, slice, P, A, wexp, gatev, t1, sl, g, c);
                    if (t1 + nws < nrows) {
#pragma unroll
                        for (int q = 0; q < 2; ++q) idn[q] = *(const u32x4*)(seli + (size_t)(t1 + nws) * 128 + 16 * g + 8 * q);
                    }
                }
                ex_compute<STAGE>(bufA, auxA, hgA, P, part, t, sl, lane, g, c);
            }
            t += nws; if (t >= nrows) break;
            {
                const int t1 = t + nws;
                if (t1 < nrows) {
                    ex_issue<STAGE>(bufA, auxA, hgA, idn, slice, P, A, wexp, gatev, t1, sl, g, c);
                    if (t1 + nws < nrows) {
#pragma unroll
                        for (int q = 0; q < 2; ++q) idn[q] = *(const u32x4*)(seli + (size_t)(t1 + nws) * 128 + 16 * g + 8 * q);
                    }
                }
                ex_compute<STAGE>(bufB, auxB, hgB, P, part, t, sl, lane, g, c);
            }
            t += nws; if (t >= nrows) break;
        }
    }
}
DEV void eu_issue_unit(u32x4 (&buf)[16], u32x4 (&xq)[2], const u32x4 (&idn)[2], const unsigned char* tab, const Params& P, int t, int sl, int c) {
    int id[16];
#pragma unroll
    for (int q = 0; q < 2; ++q)
#pragma unroll
        for (int d = 0; d < 4; ++d) { id[8 * q + 2 * d] = (int)(idn[q][d] & 0xffffu); id[8 * q + 2 * d + 1] = (int)(idn[q][d] >> 16); }
    const unsigned char* slice = tab + (size_t)sl * 2 * MiB;
#pragma unroll
    for (int k = 0; k < 16; ++k) buf[k] = *(const u32x4*)(slice + (unsigned)(id[k] * 128 + 16 * c));
    xq[0] = *(const u32x4*)(P.ws + OFF_A8 + (size_t)t * 1024 + 256 * sl + 32 * c); xq[1] = *(const u32x4*)(P.ws + OFF_A8 + (size_t)t * 1024 + 256 * sl + 32 * c + 16);
}
DEV void eu_compute_unit(const u32x4 (&buf)[16], const u32x4 (&xq)[2], LAS float* acc2, int lane) {
    int p[16];
#pragma unroll
    for (int k = 0; k < 16; ++k) {
        int ah = 0, al = 0;
#pragma unroll
        for (int d = 0; d < 4; ++d) {
            ah = __builtin_amdgcn_sdot8((int)buf[k][d], (int)xq[0][d], ah, false);
            al = __builtin_amdgcn_sdot8((int)buf[k][d], (int)xq[1][d], al, false);
        }
        p[k] = 16 * ah + al;
    }
    bfly_stage<4, 1>(p, lane); bfly_stage<2, 1>(p, lane); bfly_stage<1, 1>(p, lane);
    f32x2 a2 = *(const LAS f32x2*)acc2;
    a2.x += (float)p[0]; a2.y += (float)p[1];
    *(LAS f32x2*)acc2 = a2;
}
DEV void phase_experts_u(const Params& P, int layer, int nrows, ldsp lds0) {
    const unsigned char* tab = P.ws + OFF_TAB + (size_t)(layer * 2) * 16 * MiB;
    const bf16_t* seli = (const bf16_t*)(P.ws + OFF_SELI);
    const float* selg = (const float*)(P.ws + OFF_SELG);
    bf16_t* wexp = (bf16_t*)(P.ws + OFF_WEXP);
    const float* rsu = (const float*)(P.ws + OFF_RSC) + (size_t)(layer * 2) * 16384;
    const float* rsv = rsu + 16384;
    const float* xsv = (const float*)(P.ws + OFF_XS);
    const int tid = tid_fresh(), wave = __builtin_amdgcn_readfirstlane(tid >> 6), lane = tid & 63, g = lane >> 3, c = lane & 7;
    const int gw = blockIdx.x * 8 + wave, nwv = gridDim.x * 8;
    if (gw >= nrows) return;
    const int ntok = (nrows - gw + nwv - 1) / nwv, U = 4 * ntok;
    LAS float* accs = (LAS float*)(launder(lds0) + wave * 8192);
    for (int k = 0; k < ntok; ++k) *(LAS f32x2*)(accs + k * 128 + 2 * lane) = (f32x2){0.f, 0.f};
    u32x4 bufA[16], bufB[16], xqA[2], xqB[2], idn[2];
    int ku = 0, slu = 0;
#define EU_NEXT_IDX() do { const int tt = gw + ku * nwv; _Pragma("unroll") for (int q = 0; q < 2; ++q) idn[q] = *(const u32x4*)(seli + (size_t)tt * 128 + 16 * g + 8 * q); } while (0)
#define EU_ADVANCE() do { if (++ku == ntok) { ku = 0; ++slu; } } while (0)
    EU_NEXT_IDX();
    int kA = ku, slA = slu; eu_issue_unit(bufA, xqA, idn, tab, P, gw + kA * nwv, slA, c); EU_ADVANCE();
    if (U > 1) EU_NEXT_IDX();
    int kB = 0, slB = 0;
    for (int u = 0; u < U; u += 2) {
        if (u + 1 < U) { kB = ku; slB = slu; eu_issue_unit(bufB, xqB, idn, tab, P, gw + kB * nwv, slB, c); EU_ADVANCE(); if (u + 2 < U) EU_NEXT_IDX(); }
        eu_compute_unit(bufA, xqA, accs + kA * 128 + 2 * lane, lane);
        if (u + 1 >= U) break;
        if (u + 2 < U) { kA = ku; slA = slu; eu_issue_unit(bufA, xqA, idn, tab, P, gw + kA * nwv, slA, c); EU_ADVANCE(); if (u + 3 < U) EU_NEXT_IDX(); }
        eu_compute_unit(bufB, xqB, accs + kB * 128 + 2 * lane, lane);
    }
#undef EU_NEXT_IDX
#undef EU_ADVANCE
    for (int k = 0; k < ntok; ++k) {
        const int t = gw + k * nwv;
        const unsigned ep = *(const unsigned*)(seli + (size_t)t * 128 + 2 * lane);
        const f32x2 gt = *(const f32x2*)(selg + (size_t)t * 128 + 2 * lane);
        const f32x2 a2 = *(const LAS f32x2*)(accs + k * 128 + 2 * lane);
        const int e0 = (int)(ep & 0xffffu), e1 = (int)(ep >> 16);
        const float xs = xsv[t];
        const float h0 = a2.x * xs * rsu[e0], h1 = a2.y * xs * rsu[e1];
        const float w0 = gt.x * (0.5f * h0 * (1.f + erff(h0 * 0.70710678118654752f))) * rsv[e0];
        const float w1 = gt.y * (0.5f * h1 * (1.f + erff(h1 * 0.70710678118654752f))) * rsv[e1];
        *(unsigned*)(wexp + (size_t)t * 128 + 2 * lane) = pk2(w0, w1);
    }
}
DEV void ev_issue_unit(u32x4 (&buf)[16], u32x2& hv, u32x4& gt, const u32x4 (&idn)[2], const unsigned char* tab, const Params& P, const float* gatev, int t, int sl, int g, int c) {
    int id[16];
#pragma unroll
    for (int q = 0; q < 2; ++q)
#pragma unroll
        for (int d = 0; d < 4; ++d) { id[8 * q + 2 * d] = (int)(idn[q][d] & 0xffffu); id[8 * q + 2 * d + 1] = (int)(idn[q][d] >> 16); }
    const unsigned char* slice = tab + (size_t)sl * 2 * MiB;
#pragma unroll
    for (int k = 0; k < 16; ++k) buf[k] = *(const u32x4*)(slice + (unsigned)(id[k] * 128 + 16 * c));
    const int col = 256 * sl + 32 * c + 4 * g, m = t < NX ? (t >> 11) : 8;
    hv = *(const u32x2*)(hrow(P, t) + col);
    gt = *(const u32x4*)(gatev + m * 6144 + col);
}
DEV void ev_compute_unit(const u32x4 (&buf)[16], const u32x2 hv, const u32x4 gt, const LAS float* wS, const Params& P, int t, int sl, int lane, int g, int c) {
    f32x2 p2[16];
#pragma unroll
    for (int i = 0; i < 16; ++i) p2[i] = (f32x2){0.f, 0.f};
    f32x4 wq[4];
#pragma unroll
    for (int q = 0; q < 4; ++q) wq[q] = *(const LAS f32x4*)(wS + 4 * q);
#pragma unroll
    for (int k = 0; k < 16; ++k) {
        const float wkf = wq[k >> 2][k & 3];
        const f32x2 w2 = {wkf, wkf};
#pragma unroll
        for (int d = 0; d < 4; ++d) {
            p2[4 * d + 0] += w2 * __builtin_amdgcn_cvt_scalef32_pk_f32_fp4(buf[k][d], 1.0f, 0);
            p2[4 * d + 1] += w2 * __builtin_amdgcn_cvt_scalef32_pk_f32_fp4(buf[k][d], 1.0f, 1);
            p2[4 * d + 2] += w2 * __builtin_amdgcn_cvt_scalef32_pk_f32_fp4(buf[k][d], 1.0f, 2);
            p2[4 * d + 3] += w2 * __builtin_amdgcn_cvt_scalef32_pk_f32_fp4(buf[k][d], 1.0f, 3);
        }
        asm volatile("" : "+v"(p2[0]), "+v"(p2[1]), "+v"(p2[2]), "+v"(p2[3]), "+v"(p2[4]), "+v"(p2[5]), "+v"(p2[6]), "+v"(p2[7]),
                          "+v"(p2[8]), "+v"(p2[9]), "+v"(p2[10]), "+v"(p2[11]), "+v"(p2[12]), "+v"(p2[13]), "+v"(p2[14]), "+v"(p2[15]));
    }
    float p[32];
#pragma unroll
    for (int i = 0; i < 16; ++i) { p[2 * i] = p2[i].x; p[2 * i + 1] = p2[i].y; }
    bfly_swap32<16>(p); bfly_swap16<8>(p); bfly_ror8<4>(p, lane);
    const int col = 256 * sl + 32 * c + 4 * g;
    u32x2 ho;
    ho.x = pk2(bflo(hv.x) + __uint_as_float(gt.x) * p[0], bfhi(hv.x) + __uint_as_float(gt.y) * p[1]);
    ho.y = pk2(bflo(hv.y) + __uint_as_float(gt.z) * p[2], bfhi(hv.y) + __uint_as_float(gt.w) * p[3]);
    *(u32x2*)(hrow(P, t) + col) = ho;
}
DEV void phase_experts(const Params& P, int layer, int nrows, ldsp lds0) {
    const unsigned char* tabu = P.ws + OFF_TAB + (size_t)(layer * 2) * 16 * MiB;
    const unsigned char* tabv = tabu + 16 * MiB;
    const bf16_t* seli = (const bf16_t*)(P.ws + OFF_SELI);
    const float* selg = (const float*)(P.ws + OFF_SELG);
    const float* rsu = (const float*)(P.ws + OFF_RSC) + (size_t)(layer * 2) * 16384;
    const float* rsv = rsu + 16384;
    const float* xsv = (const float*)(P.ws + OFF_XS);
    const float* gatev = (const float*)(P.ws + OFF_MODV) + (size_t)layer * 9 * 6144 + 5 * 1024;
    const int tid = tid_fresh(), wave = __builtin_amdgcn_readfirstlane(tid >> 6), lane = tid & 63, g = lane >> 3, c = lane & 7;
    const int gw = blockIdx.x * 8 + wave, nwv = gridDim.x * 8;
    if (gw >= nrows) return;
    const int ntok = (nrows - gw + nwv - 1) / nwv, U = 4 * ntok;
    LAS float* accs = (LAS float*)(launder(lds0) + wave * 8192);
    for (int k = 0; k < ntok; ++k) *(LAS f32x2*)(accs + k * 128 + 2 * lane) = (f32x2){0.f, 0.f};
    u32x4 bufA[16], bufB[16], idn[2];
    int ku = 0, slu = 0;
#define EU_NEXT_IDX() do { const int tt = gw + ku * nwv; _Pragma("unroll") for (int q = 0; q < 2; ++q) idn[q] = *(const u32x4*)(seli + (size_t)tt * 128 + 16 * g + 8 * q); } while (0)
#define EU_ADVANCE() do { if (++ku == ntok) { ku = 0; ++slu; } } while (0)
    int kA, slA, kB = 0, slB = 0;
    {
        u32x4 xqA[2], xqB[2];
        EU_NEXT_IDX();
        kA = ku; slA = slu; eu_issue_unit(bufA, xqA, idn, tabu, P, gw + kA * nwv, slA, c); EU_ADVANCE();
        if (U > 1) EU_NEXT_IDX();
        for (int u = 0; u < U; u += 2) {
            if (u + 1 < U) { kB = ku; slB = slu; eu_issue_unit(bufB, xqB, idn, tabu, P, gw + kB * nwv, slB, c); EU_ADVANCE(); if (u + 2 < U) EU_NEXT_IDX(); }
            eu_compute_unit(bufA, xqA, accs + kA * 128 + 2 * lane, lane);
            if (u + 1 >= U) break;
            if (u + 2 < U) { kA = ku; slA = slu; eu_issue_unit(bufA, xqA, idn, tabu, P, gw + kA * nwv, slA, c); EU_ADVANCE(); if (u + 3 < U) EU_NEXT_IDX(); }
            eu_compute_unit(bufB, xqB, accs + kB * 128 + 2 * lane, lane);
        }
    }
    u32x2 hvA, hvB; u32x4 gtA, gtB;
    ku = 0; slu = 0;
    EU_NEXT_IDX();
    kA = ku; slA = slu; ev_issue_unit(bufA, hvA, gtA, idn, tabv, P, gatev, gw + kA * nwv, slA, g, c); EU_ADVANCE();
    if (U > 1) EU_NEXT_IDX();
    for (int k = 0; k < ntok; ++k) {
        const int t = gw + k * nwv;
        const unsigned ep = *(const unsigned*)(seli + (size_t)t * 128 + 2 * lane);
        const f32x2 gt = *(const f32x2*)(selg + (size_t)t * 128 + 2 * lane);
        const f32x2 a2 = *(const LAS f32x2*)(accs + k * 128 + 2 * lane);
        const int e0 = (int)(ep & 0xffffu), e1 = (int)(ep >> 16);
        const float xs = xsv[t];
        const float h0 = a2.x * xs * rsu[e0], h1 = a2.y * xs * rsu[e1];
        f32x2 w;
        w.x = gt.x * (0.5f * h0 * (1.f + erff(h0 * 0.70710678118654752f))) * rsv[e0];
        w.y = gt.y * (0.5f * h1 * (1.f + erff(h1 * 0.70710678118654752f))) * rsv[e1];
        *(LAS f32x2*)(accs + k * 128 + 2 * lane) = w;
    }
    for (int u = 0; u < U; u += 2) {
        if (u + 1 < U) { kB = ku; slB = slu; ev_issue_unit(bufB, hvB, gtB, idn, tabv, P, gatev, gw + kB * nwv, slB, g, c); EU_ADVANCE(); if (u + 2 < U) EU_NEXT_IDX(); }
        ev_compute_unit(bufA, hvA, gtA, accs + kA * 128 + 16 * g, P, gw + kA * nwv, slA, lane, g, c);
        if (u + 1 >= U) break;
        if (u + 2 < U) { kA = ku; slA = slu; ev_issue_unit(bufA, hvA, gtA, idn, tabv, P, gatev, gw + kA * nwv, slA, g, c); EU_ADVANCE(); if (u + 3 < U) EU_NEXT_IDX(); }
        ev_compute_unit(bufB, hvB, gtB, accs + kB * 128 + 16 * g, P, gw + kB * nwv, slB, lane, g, c);
    }
#undef EU_NEXT_IDX
#undef EU_ADVANCE
}
DEV void phase_experts_act(const Params& P, int layer, int nrows) {
    const bf16_t* seli = (const bf16_t*)(P.ws + OFF_SELI);
    const float* selg = (const float*)(P.ws + OFF_SELG);
    const float* part = (const float*)(P.ws + OFF_PART);
    bf16_t* wexp = (bf16_t*)(P.ws + OFF_WEXP);
    const float* rsu = (const float*)(P.ws + OFF_RSC) + (size_t)(layer * 2) * 16384;
    const float* rsv = rsu + 16384;
    const int tid = tid_fresh();
    const int n4 = nrows * 32;
    for (int i4 = blockIdx.x * NTHREADS + tid; i4 < n4; i4 += gridDim.x * NTHREADS) {
        const size_t idx = (size_t)i4 * 4;
        f32x4 h = {0.f, 0.f, 0.f, 0.f};
#pragma unroll
        for (int s = 0; s < 4; ++s) { const u32x2 pv = *(const u32x2*)((const bf16_t*)part + (size_t)s * NT * 128 + idx); h += (f32x4){bflo(pv.x), bfhi(pv.x), bflo(pv.y), bfhi(pv.y)}; }
        const u32x2 e = *(const u32x2*)(seli + idx);
        const f32x4 gt = *(const f32x4*)(selg + idx);
        const int ee[4] = {(int)(e.x & 0xffffu), (int)(e.x >> 16), (int)(e.y & 0xffffu), (int)(e.y >> 16)};
        f32x4 o;
#pragma unroll
        for (int q = 0; q < 4; ++q) {
            const float hh = h[q] * rsu[ee[q]];
            o[q] = gt[q] * (0.5f * hh * (1.f + erff(hh * 0.70710678118654752f))) * rsv[ee[q]];
        }
        u32x2 ow; ow.x = pk2(o[0], o[1]); ow.y = pk2(o[2], o[3]);
        *(u32x2*)(wexp + idx) = ow;
    }
}
DEV void phase_final(const Params& P) {
    const int tid = tid_fresh(), wave = tid >> 6, lane = tid & 63;
    for (int r = blockIdx.x * 8 + wave; r < NX; r += gridDim.x * 8) {
        float* h = P.out + (size_t)r * 1024;
        f32x4 v[4]; float ss = 0.f;
#pragma unroll
        for (int j = 0; j < 4; ++j) { const u32x2 hv = *(const u32x2*)(hrow(P, r) + j * 256 + lane * 4); v[j] = (f32x4){bflo(hv.x), bfhi(hv.x), bflo(hv.y), bfhi(hv.y)};
            ss += v[j].x * v[j].x + v[j].y * v[j].y + v[j].z * v[j].z + v[j].w * v[j].w; }
        ss = wave_sum(ss);
        const float rstd = rsqrtf(ss * (1.f / 1024.f) + EPS);
#pragma unroll
        for (int j = 0; j < 4; ++j) { const f32x4 gg = *(const f32x4*)(P.final_g + j * 256 + lane * 4); __builtin_nontemporal_store(v[j] * rstd * gg, (f32x4*)(h + j * 256 + lane * 4)); }
    }
}

DEV void phase_conv(const Params& P) {
    const bf16_t* Pq = (const bf16_t*)(P.ws + OFF_R1);
    const float* ab = (const float*)(P.ws + OFF_AB);
    bf16_t* dst[3] = {(bf16_t*)(P.ws + OFF_QC), (bf16_t*)(P.ws + OFF_KC), (bf16_t*)(P.ws + OFF_VC)};
    float* gbuf = (float*)(P.ws + OFF_G);
    float* bbuf = (float*)(P.ws + OFF_BETA);
    const int tid = tid_fresh(), wave = tid >> 6, lane = tid & 63;
    constexpr int NSEG = NT / 16;
    for (int item = blockIdx.x * 8 + wave; item < NSEG * 6; item += gridDim.x * 8) {
        const int seg = item / 6, jc = item - seg * 6, row0 = seg * 16;
        int t0, L;
        if (row0 < NX) { t0 = row0 & 2047; L = 2048; } else { t0 = (row0 - NX) & 255; L = 256; }
        const int chunk = lane + 64 * jc, col = chunk * 8, part = jc >> 1;
        f32x4 w0[5], w1[5];
#pragma unroll
        for (int tap = 0; tap < 5; ++tap) { w0[tap] = *(const f32x4*)(P.dn_conv_w + tap * 3072 + col); w1[tap] = *(const f32x4*)(P.dn_conv_w + tap * 3072 + col + 4); }
        u32x4 raw[20];
#pragma unroll
        for (int i = 0; i < 20; ++i) {
            const int tt = t0 + i - 2;
            const bool ok = tt >= 0 && tt < L;
            const u32x4 v = *(const u32x4*)(Pq + (size_t)(row0 + (ok ? i - 2 : 0)) * 3072 + col);
            raw[i] = ok ? v : (u32x4){0u, 0u, 0u, 0u};
        }
        const float qs = part == 0 ? 0.08838834764831845f : 1.f;
        bf16_t* dp = dst[part] + (size_t)row0 * 1024 + (chunk & 127) * 8;
#pragma unroll
        for (int i = 0; i < 16; ++i) {
            float acc[8];
#pragma unroll
            for (int e = 0; e < 8; ++e) acc[e] = 0.f;
#pragma unroll
            for (int tap = 0; tap < 5; ++tap) {
                float f[8]; unpack8(raw[i + tap], f);
                acc[0] += f[0] * w0[tap].x; acc[1] += f[1] * w0[tap].y; acc[2] += f[2] * w0[tap].z; acc[3] += f[3] * w0[tap].w;
                acc[4] += f[4] * w1[tap].x; acc[5] += f[5] * w1[tap].y; acc[6] += f[6] * w1[tap].z; acc[7] += f[7] * w1[tap].w;
            }
            float ss = 0.f;
#pragma unroll
            for (int e = 0; e < 8; ++e) { acc[e] = silu(acc[e]); ss += acc[e] * acc[e]; }
            if (part < 2) {
                ss = sum16(ss);
                const float rn = rsqrtf(ss + EPS) * qs;
#pragma unroll
                for (int e = 0; e < 8; ++e) acc[e] *= rn;
            }
            u32x4 o; o.x = pk2(acc[0], acc[1]); o.y = pk2(acc[2], acc[3]); o.z = pk2(acc[4], acc[5]); o.w = pk2(acc[6], acc[7]);
            *(u32x4*)(dp + (size_t)i * 1024) = o;
        }
        if (jc == 0) {
            const int cc = lane & 31, d = cc >> 4, sx = (cc >> 3) & 1, h = cc & 7;
            const float a = __expf(P.dn_a_log[d * 8 + h]), dtb = P.dn_dt_bias[d * 8 + h];
            float v[8];
#pragma unroll
            for (int q = 0; q < 8; ++q) v[q] = ab[(size_t)(row0 + 2 * q + (lane >> 5)) * 32 + cc];
#pragma unroll
            for (int q = 0; q < 8; ++q) {
                const int row = row0 + 2 * q + (lane >> 5);
                if (sx == 0) {
                    const float xx = v[q] + dtb;
                    const float ex = __expf(fminf(xx, 30.f)), u = 1.f + ex;
                    const float l1p = (u == 1.f) ? ex : __logf(u) * ex * __builtin_amdgcn_rcpf(u - 1.f);
                    const float sp = xx > 20.f ? xx : l1p;
                    gbuf[((size_t)d * NT + row) * 8 + h] = -a * sp;
                } else {
                    bbuf[((size_t)d * NT + row) * 8 + h] = __builtin_amdgcn_rcpf(1.f + __expf(-v[q]));
                }
            }
        }
    }
}

DEV int chunk_rowbase(int b, int d, int n) {
    if (n < 4) { const int m = d ? 3 - n : n; return NX + b * 256 + m * 64; }
    const int m = d ? 31 - (n - 4) : n - 4; return b * 2048 + m * 64;
}

DEV bf16x8 frag_col_x(ldsp x, int c0, int k0, int lane) {
    const int col = c0 + (lane & 31), ch = col >> 3, sub = (col & 7) * 2;
    bf16x8 f;
#pragma unroll
    for (int j = 0; j < 8; ++j) { const int row = k0 + 8 * (lane >> 5) + j; f[j] = (short)*(const LAS bf16_t*)(x + row * 256 + ((ch ^ (row & 15)) << 4) + sub); }
    return f;
}
DEV void tile_rows8(const f32x16& acc, u32x4& o0, u32x4& o1) {
    unsigned p[4][2];
#pragma unroll
    for (int rg = 0; rg < 4; ++rg) { p[rg][0] = pk2(acc[rg * 4 + 0], acc[rg * 4 + 1]); p[rg][1] = pk2(acc[rg * 4 + 2], acc[rg * 4 + 3]); }
    const auto s00 = __builtin_amdgcn_permlane32_swap(p[0][0], p[2][0], false, false), s01 = __builtin_amdgcn_permlane32_swap(p[0][1], p[2][1], false, false);
    const auto s10 = __builtin_amdgcn_permlane32_swap(p[1][0], p[3][0], false, false), s11 = __builtin_amdgcn_permlane32_swap(p[1][1], p[3][1], false, false);
    o0 = (u32x4){s00[0], s01[0], s00[1], s01[1]};
    o1 = (u32x4){s10[0], s11[0], s10[1], s11[1]};
}
DEV bf16x8 frag_row_t(ldsp t, int r0, int k0, int lane) {
    const int row = r0 + (lane & 31), ch = (k0 >> 3) + (lane >> 5);
    return *(const LAS bf16x8*)(t + row * 128 + ((ch ^ (row & 7)) << 4));
}
DEV void phase_chunk(const Params& P, ldsp lds0) {
    const bf16_t* kc = (const bf16_t*)(P.ws + OFF_KC);
    const bf16_t* vc = (const bf16_t*)(P.ws + OFF_VC);
    const float* gbuf = (const float*)(P.ws + OFF_G);
    const float* bbuf = (const float*)(P.ws + OFF_BETA);
    bf16_t* wbuf = (bf16_t*)(P.ws + OFF_WBUF);
    bf16_t* ubuf = (bf16_t*)(P.ws + OFF_UBUF);
    float* gcbuf = (float*)(P.ws + OFF_GC);
    const int tid = tid_fresh(), lane = tid & 63, wave = tid >> 6, team = wave >> 1, tw = wave & 1, ttid = tid & 127;
    const int nteams = gridDim.x * 4, niter = (4608 + nteams - 1) / nteams;
    u32x4 rk[8];
    {
        const int item0 = min((int)(blockIdx.x * 4 + team), 4607);
        const int n = item0 % 36, d = (item0 / 36) & 1, bh = item0 / 72, rb0 = chunk_rowbase(bh >> 3, d, n);
#pragma unroll
        for (int j = 0; j < 8; ++j) { const int cid = ttid + 128 * j, i = cid >> 4, ch = cid & 15; rk[j] = *(const u32x4*)(kc + ((size_t)rb0 + (d ? 63 - i : i)) * 1024 + (bh & 7) * 128 + ch * 8); }
    }
    for (int it = 0; it < niter; ++it) {
        const int item = it * nteams + blockIdx.x * 4 + team;
        const bool act = item < 4608;
        const ldsp lds = launder(lds0);
        const ldsp sX = lds + team * 32768;
        const ldsp sT = sX + 16384;
        LAS float* sA = (LAS float*)sT;
        LAS float* sg = (LAS float*)(lds + 131072 + 128 + team * 768);
        const int n = item % 36, d = (item / 36) & 1, bh = item / 72, b = bh >> 3, h = bh & 7;
        const int rowbase = act ? chunk_rowbase(b, d, n) : 0;
        if (act) {
#pragma unroll
            for (int j = 0; j < 8; ++j) { const int cid = ttid + 128 * j, i = cid >> 4, ch = cid & 15; *(LAS u32x4*)(sX + i * 256 + ((ch ^ (i & 15)) << 4)) = rk[j]; }
            if (tw == 0) {
                const size_t grow = (size_t)rowbase + (d ? 63 - lane : lane);
                float v = gbuf[((size_t)d * NT + grow) * 8 + h];
#pragma unroll
                for (int o = 1; o < 64; o <<= 1) { const float t = __shfl_up(v, o); if (lane >= o) v += t; }
                sg[lane] = v; sg[64 + lane] = bbuf[((size_t)d * NT + grow) * 8 + h];
            }
        }
        __syncthreads();
        if (act) {
#pragma unroll 1
            for (int q = 0; q < 2; ++q) {
                const int mt = tw, nt = q;
                f32x16 acc = zero16();
#pragma unroll 4
                for (int ks = 0; ks < 8; ++ks) acc = mfma32(frag_row_x(sX, mt * 32, ks * 16, lane), frag_row_x(sX, nt * 32, ks * 16, lane), acc);
#pragma unroll
                for (int reg = 0; reg < 16; ++reg) {
                    const int i = mt * 32 + crow(reg, lane), j = nt * 32 + (lane & 31);
                    sA[i * 64 + j] = (i > j) ? sg[64 + i] * acc[reg] * __expf(sg[i] - sg[j]) : 0.f;
                }
            }
        }
        __syncthreads();
        if (act && tw == 0) {
            float t[64];
            int ln = lane; asm volatile("" : "+v"(ln));
#pragma unroll
            for (int i = 0; i < 64; ++i) {
                float a0 = (i == ln) ? 1.f : 0.f, a1 = 0.f, a2 = 0.f, a3 = 0.f;
#pragma unroll
                for (int j = 0; j < i; j += 4) {
                    const f32x4 av = *(const LAS f32x4*)(sA + i * 64 + j);
                    a0 -= av.x * t[j];
                    if (j + 1 < i) a1 -= av.y * t[j + 1];
                    if (j + 2 < i) a2 -= av.z * t[j + 2];
                    if (j + 3 < i) a3 -= av.w * t[j + 3];
                }
                t[i] = (a0 + a1) + (a2 + a3);
                __builtin_amdgcn_sched_barrier(0);
            }
            const float cu = sg[64 + lane], cw = cu * __expf(sg[lane]);
            const int ch = lane >> 3, sub = (lane & 7) * 2;
#pragma unroll
            for (int i = 0; i < 64; ++i) {
                const int off = i * 128 + ((ch ^ (i & 7)) << 4) + sub;
                *(LAS bf16_t*)(sT + off) = f2bf(t[i] * cw);
                *(LAS bf16_t*)(sT + 8192 + off) = f2bf(t[i] * cu);
                if ((i & 7) == 7) __builtin_amdgcn_sched_barrier(0);
            }
        }
        __syncthreads();
            {
                const int itemn = min(item + nteams, 4607);
                const int nn = itemn % 36, dn = (itemn / 36) & 1, bhn = itemn / 72, rbn = chunk_rowbase(bhn >> 3, dn, nn);
#pragma unroll
                for (int j = 0; j < 8; ++j) { const int cid = ttid + 128 * j, i = cid >> 4, ch = cid & 15; rk[j] = *(const u32x4*)(kc + ((size_t)rbn + (dn ? 63 - i : i)) * 1024 + (bhn & 7) * 128 + ch * 8); }
            }
        u32x4 rv[8];
        if (act) {
#pragma unroll
            for (int j = 0; j < 8; ++j) {
                const int cid = ttid + 128 * j, i = cid >> 4, ch = cid & 15;
                const size_t grow = (size_t)rowbase + (d ? 63 - i : i);
                rv[j] = *(const u32x4*)(vc + grow * 1024 + h * 128 + ch * 8);
            }
#pragma unroll 1
            for (int q = 0; q < 2; ++q) {
                const int mtk = 2 * tw + q;
                f32x16 acc[2]; acc[0] = zero16(); acc[1] = zero16();
#pragma unroll
                for (int ks = 0; ks < 4; ++ks) {
                    const bf16x8 afr = frag_col_x(sX, mtk * 32, ks * 16, lane);
#pragma unroll
                    for (int it2 = 0; it2 < 2; ++it2) acc[it2] = mfma32(afr, frag_row_t(sT, it2 * 32, ks * 16, lane), acc[it2]);
                }
                bf16_t* dstp = wbuf + (size_t)item * 8192;
#pragma unroll
                for (int it2 = 0; it2 < 2; ++it2) {
                    u32x4 o0, o1; tile_rows8(acc[it2], o0, o1);
                    bf16_t* rp = dstp + (it2 * 32 + (lane & 31)) * 128 + mtk * 32 + 16 * (lane >> 5);
                    *(u32x4*)rp = o0; *(u32x4*)(rp + 8) = o1;
                }
            }
        }
        __syncthreads();
        if (act) {
#pragma unroll
            for (int j = 0; j < 8; ++j) { const int cid = ttid + 128 * j, i = cid >> 4, ch = cid & 15; *(LAS u32x4*)(sX + i * 256 + ((ch ^ (i & 15)) << 4)) = rv[j]; }
        }
        __syncthreads();
        if (act) {
#pragma unroll 1
            for (int q = 0; q < 2; ++q) {
                const int nt = 2 * tw + q;
                f32x16 acc[2]; acc[0] = zero16(); acc[1] = zero16();
#pragma unroll
                for (int ks = 0; ks < 4; ++ks) {
                    const bf16x8 bfr = frag_col_x(sX, nt * 32, ks * 16, lane);
#pragma unroll
                    for (int mt = 0; mt < 2; ++mt) acc[mt] = mfma32(frag_row_t(sT + 8192, mt * 32, ks * 16, lane), bfr, acc[mt]);
                }
                bf16_t* dstp = ubuf + (size_t)item * 8192;
#pragma unroll
                for (int mt = 0; mt < 2; ++mt) {
                    u32x4 o0, o1; tile_rows8(acc[mt], o0, o1);
                    bf16_t* rp = dstp + (nt * 32 + (lane & 31)) * 64 + mt * 32 + 16 * (lane >> 5);
                    *(u32x4*)rp = o0; *(u32x4*)(rp + 8) = o1;
                }
            }
            if (tw == 0) gcbuf[(size_t)item * 64 + lane] = sg[lane];
        }
        __syncthreads();
    }
}

DEV u32x2 pack4(float a, float b, float c, float d) { u32x2 o; o.x = pk2(a, b); o.y = pk2(c, d); return o; }
DEV void phase_scan(const Params& P, ldsp lds0) {
    const bf16_t* qc = (const bf16_t*)(P.ws + OFF_QC);
    const bf16_t* kc = (const bf16_t*)(P.ws + OFF_KC);
    const bf16_t* wbuf = (const bf16_t*)(P.ws + OFF_WBUF);
    const bf16_t* ubuf = (const bf16_t*)(P.ws + OFF_UBUF);
    const float* gcbuf = (const float*)(P.ws + OFF_GC);
    bf16_t* obuf = (bf16_t*)(P.ws + OFF_OBUF);
    const int tid = tid_fresh(), lane = tid & 63, wave = tid >> 6;
    const int mt = wave >> 1, nt = wave & 1;
    const int mt2 = (wave & 3) >> 1, nt2 = wave & 1;
    for (int item = blockIdx.x; item < 256; item += gridDim.x) {
        const int half = item & 1, d = (item >> 1) & 1, bh = item >> 2, b = bh >> 3, h = bh & 7;
        f32x16 S = zero16();
        { LAS unsigned* z = (LAS unsigned*)(lds0 + 1024 + 3 * 17408 + 9216); for (int e = tid; e < 64 * 136 / 2; e += NTHREADS) z[e] = 0u; }
        u32x4 rW[2][2], rK[2][2], rQ[2][2], rU[2]; float rG[2] = {0.f, 0.f};
#pragma unroll
        for (int u = 0; u < 2; ++u) {
            const int citem = (bh * 2 + d) * 36 + u, rowbase = chunk_rowbase(b, d, u);
#pragma unroll
            for (int j = 0; j < 2; ++j) {
                const int cid = tid + NTHREADS * j, i = cid >> 4, ch = cid & 15;
                const size_t grow = (size_t)rowbase + (d ? 63 - i : i);
                rW[u][j] = *(const u32x4*)(wbuf + (size_t)citem * 8192 + i * 128 + ch * 8);
                rK[u][j] = *(const u32x4*)(kc + grow * 1024 + h * 128 + ch * 8);
                rQ[u][j] = rK[u][j];
            }
            { const int dvr = tid >> 3, ch = tid & 7; rU[u] = *(const u32x4*)(ubuf + (size_t)citem * 8192 + (half * 64 + dvr) * 64 + ch * 8); }
            if (tid < 64) rG[u] = gcbuf[(size_t)citem * 64 + tid];
        }
        for (int n2 = 0; n2 < 36; n2 += 2) {
#pragma unroll
        for (int u = 0; u < 2; ++u) {
            const int n = n2 + u;
            const ldsp lds = launder(lds0);
            int ln = lane; asm volatile("" : "+v"(ln));
            LAS float* sg = (LAS float*)lds;
            LAS bf16_t* sW = (LAS bf16_t*)(lds + 1024);
            LAS bf16_t* sK = sW + 64 * 136;
            LAS bf16_t* sQ = sK + 64 * 136;
            LAS bf16_t* sU = sQ + 64 * 136;
            LAS bf16_t* sST = sU + 64 * 72;
            LAS bf16_t* sVNT = sST + 64 * 136;
            LAS bf16_t* sVNsT = sVNT + 64 * 72;
            LAS bf16_t* sATT = sVNsT + 64 * 72;
            LAS bf16_t* sO = sATT + 64 * 72;
            const int rowbase = chunk_rowbase(b, d, n);
            const bool wantO = n >= 4;
#pragma unroll
            for (int j = 0; j < 2; ++j) {
                const int cid = tid + NTHREADS * j, i = cid >> 4, ch = cid & 15;
                *(LAS u32x4*)(sW + i * 136 + ch * 8) = rW[u][j];
                *(LAS u32x4*)(sK + i * 136 + ch * 8) = rK[u][j];
                *(LAS u32x4*)(sQ + i * 136 + ch * 8) = rQ[u][j];
            }
            { const int i = tid >> 3, ch = tid & 7; *(LAS u32x4*)(sU + i * 72 + ch * 8) = rU[u]; }
            if (tid < 64) sg[tid] = rG[u];
            __syncthreads();
            if (n + 2 < 36) {
                const int citem = (bh * 2 + d) * 36 + n + 2, rb1 = chunk_rowbase(b, d, n + 2);
                const bool wq = n + 2 >= 4;
#pragma unroll
                for (int j = 0; j < 2; ++j) {
                    const int cid = tid + NTHREADS * j, i = cid >> 4, ch = cid & 15;
                    const size_t grow = (size_t)rb1 + (d ? 63 - i : i);
                    rW[u][j] = *(const u32x4*)(wbuf + (size_t)citem * 8192 + i * 128 + ch * 8);
                    rK[u][j] = *(const u32x4*)(kc + grow * 1024 + h * 128 + ch * 8);
                    if (wq) rQ[u][j] = *(const u32x4*)(qc + grow * 1024 + h * 128 + ch * 8);
                }
                { const int dvr = tid >> 3, ch = tid & 7; rU[u] = *(const u32x4*)(ubuf + (size_t)citem * 8192 + (half * 64 + dvr) * 64 + ch * 8); }
                if (tid < 64) rG[u] = gcbuf[(size_t)citem * 64 + tid];
            }
            const float g63 = sg[63];
            if (wave < 4) {
                const int dv = nt2 * 32 + (ln & 31);
                float uf[16], ef[16];
#pragma unroll
                for (int rg = 0; rg < 4; ++rg) {
                    const int i0 = mt2 * 32 + 8 * rg + 4 * (ln >> 5);
                    const u32x2 uu = *(const LAS u32x2*)(sU + dv * 72 + i0);
                    const f32x4 gg = *(const LAS f32x4*)(sg + i0);
                    uf[rg * 4 + 0] = bflo(uu.x); uf[rg * 4 + 1] = bfhi(uu.x); uf[rg * 4 + 2] = bflo(uu.y); uf[rg * 4 + 3] = bfhi(uu.y);
#pragma unroll
                    for (int e = 0; e < 4; ++e) ef[rg * 4 + e] = __expf(g63 - gg[e]);
                }
                f32x16 acc = zero16(), accb = zero16();
#pragma unroll
                for (int ks = 0; ks < 8; ks += 2) { acc = mfma32(frag_row(sW, 136, mt2 * 32, ks * 16, ln), frag_row(sST, 136, nt2 * 32, ks * 16, ln), acc);
                    accb = mfma32(frag_row(sW, 136, mt2 * 32, ks * 16 + 16, ln), frag_row(sST, 136, nt2 * 32, ks * 16 + 16, ln), accb); }
#pragma unroll
                for (int rg = 0; rg < 4; ++rg) {
                    const int i0 = mt2 * 32 + 8 * rg + 4 * (ln >> 5);
                    float v[4], vs[4];
#pragma unroll
                    for (int e = 0; e < 4; ++e) { v[e] = uf[rg * 4 + e] - (acc[rg * 4 + e] + accb[rg * 4 + e]); vs[e] = v[e] * ef[rg * 4 + e]; }
                    *(LAS u32x2*)(sVNT + dv * 72 + i0) = pack4(v[0], v[1], v[2], v[3]);
                    *(LAS u32x2*)(sVNsT + dv * 72 + i0) = pack4(vs[0], vs[1], vs[2], vs[3]);
                }
            } else if (wantO) {
                const int i = nt2 * 32 + (ln & 31);
                const float gi = sg[i];
                float df[16];
#pragma unroll
                for (int rg = 0; rg < 4; ++rg) {
                    const int j0 = mt2 * 32 + 8 * rg + 4 * (ln >> 5);
                    const f32x4 gg = *(const LAS f32x4*)(sg + j0);
#pragma unroll
                    for (int e = 0; e < 4; ++e) df[rg * 4 + e] = (i >= j0 + e) ? __expf(fminf(gi - gg[e], 0.f)) : 0.f;
                }
                f32x16 acc = zero16(), accb = zero16();
#pragma unroll
                for (int ks = 0; ks < 8; ks += 2) { acc = mfma32(frag_row(sK, 136, mt2 * 32, ks * 16, ln), frag_row(sQ, 136, nt2 * 32, ks * 16, ln), acc);
                    accb = mfma32(frag_row(sK, 136, mt2 * 32, ks * 16 + 16, ln), frag_row(sQ, 136, nt2 * 32, ks * 16 + 16, ln), accb); }
#pragma unroll
                for (int rg = 0; rg < 4; ++rg) {
                    const int j0 = mt2 * 32 + 8 * rg + 4 * (ln >> 5);
                    float v[4];
#pragma unroll
                    for (int e = 0; e < 4; ++e) v[e] = (acc[rg * 4 + e] + accb[rg * 4 + e]) * df[rg * 4 + e];
                    *(LAS u32x2*)(sATT + i * 72 + j0) = pack4(v[0], v[1], v[2], v[3]);
                }
            }
            __syncthreads();
            if (wave < 4 && wantO) {
                float eg[16];
#pragma unroll
                for (int rg = 0; rg < 4; ++rg) {
                    const f32x4 gg = *(const LAS f32x4*)(sg + mt2 * 32 + 8 * rg + 4 * (ln >> 5));
#pragma unroll
                    for (int e = 0; e < 4; ++e) eg[rg * 4 + e] = __expf(gg[e]);
                }
                f32x16 a1 = zero16(), a1b = zero16(), a2 = zero16();
#pragma unroll
                for (int ks = 0; ks < 8; ks += 2) { a1 = mfma32(frag_row(sQ, 136, mt2 * 32, ks * 16, ln), frag_row(sST, 136, nt2 * 32, ks * 16, ln), a1);
                    a1b = mfma32(frag_row(sQ, 136, mt2 * 32, ks * 16 + 16, ln), frag_row(sST, 136, nt2 * 32, ks * 16 + 16, ln), a1b); }
#pragma unroll
                for (int ks = 0; ks < 4; ++ks) a2 = mfma32(frag_row(sATT, 72, mt2 * 32, ks * 16, ln), frag_row(sVNT, 72, nt2 * 32, ks * 16, ln), a2);
                const int dv = nt2 * 32 + (ln & 31);
#pragma unroll
                for (int rg = 0; rg < 4; ++rg) {
                    const int i0 = mt2 * 32 + 8 * rg + 4 * (ln >> 5);
#pragma unroll
                    for (int e = 0; e < 4; ++e) sO[(i0 + e) * 72 + dv] = f2bf((a1[rg * 4 + e] + a1b[rg * 4 + e]) * eg[rg * 4 + e] + a2[rg * 4 + e]);
                }
            }
            {
                const float gl = __expf(g63);
#pragma unroll
                for (int reg = 0; reg < 16; ++reg) S[reg] *= gl;
#pragma unroll
                for (int ks = 0; ks < 4; ++ks) S = mfma32(frag_col_tr(sK, 136, mt * 32, ks * 16, ln), frag_row(sVNsT, 72, nt * 32, ks * 16, ln), S);
            }
            __syncthreads();
            if (wantO) {
                const int i = tid >> 3, ch = tid & 7;
                const size_t grow = (size_t)rowbase + (d ? 63 - i : i);
                *(u32x4*)(obuf + ((size_t)d * NX + grow) * 1024 + h * 128 + half * 64 + ch * 8) = *(const LAS u32x4*)(sO + i * 72 + ch * 8);
            }
#pragma unroll
            for (int rg = 0; rg < 4; ++rg) {
                const int dk0 = mt * 32 + 8 * rg + 4 * (ln >> 5);
                *(LAS u32x2*)(sST + (nt * 32 + (ln & 31)) * 136 + dk0) = pack4(S[rg * 4 + 0], S[rg * 4 + 1], S[rg * 4 + 2], S[rg * 4 + 3]);
            }
        }
        }
        __syncthreads();
    }
}

DEV void phase_dnout(const Params& P) {
    const bf16_t* obuf = (const bf16_t*)(P.ws + OFF_OBUF);
    const bf16_t* Pz = (const bf16_t*)(P.ws + OFF_PZ);
    bf16_t* A = (bf16_t*)(P.ws + OFF_A);
    const int tid = tid_fresh(); const int wave = tid >> 6, lane = tid & 63;
    for (int row = blockIdx.x * 8 + wave; row < NX; row += gridDim.x * 8) {
#pragma unroll
        for (int c = 0; c < 2; ++c) {
            const int col = c * 512 + lane * 8;
            const u32x4 of = *(const u32x4*)(obuf + (size_t)row * 1024 + col), ob = *(const u32x4*)(obuf + ((size_t)NX + row) * 1024 + col);
            const u32x4 zz = *(const u32x4*)(Pz + (size_t)row * 1024 + col);
            float o[8], o2[8], z[8]; unpack8(of, o); unpack8(ob, o2); unpack8(zz, z);
            float ss = 0.f;
#pragma unroll
            for (int e = 0; e < 8; ++e) { o[e] += o2[e]; ss += o[e] * o[e]; }
            ss = sum16(ss);
            const float rn = rsqrtf(ss * (1.f / 128.f) + EPS);
            float y[8];
#pragma unroll
            for (int e = 0; e < 8; ++e) y[e] = o[e] * rn * P.dn_norm_g[(col & 127) + e] * silu(z[e]);
            u32x4 ov; ov.x = pk2(y[0], y[1]); ov.y = pk2(y[2], y[3]); ov.z = pk2(y[4], y[5]); ov.w = pk2(y[6], y[7]);
            *(u32x4*)(A + (size_t)row * 1024 + col) = ov;
        }
    }
}

namespace pg8 {
#define PG8_LAS __attribute__((address_space(3)))
typedef unsigned short bf16_t;
typedef short bf16x8 __attribute__((ext_vector_type(8)));
typedef float f32x4 __attribute__((ext_vector_type(4)));
typedef unsigned u32x4 __attribute__((ext_vector_type(4)));
constexpr int BM = 256, BK = 64, HALF = 128, HTB = HALF * BK * 2  , STAGE_BYTES = 8 * HTB, NXCD = 8, WGM = 8;

__host__ __device__ __forceinline__ int lds_byte(int r, int c) { const int st = (r >> 4) * 2 + (c >> 5), rr = r & 15, cc = c & 31, ob = rr * 64 + cc * 2; return st * 1024 + (ob ^ (((ob >> 9) & 1) << 5)); }
__host__ __device__ __forceinline__ void stage_rc(int b, int& R, int& C) { const int st = b / 1024, sb = b % 1024, swz = sb ^ (((sb >> 9) & 1) << 5); R = (st >> 1) * 16 + swz / 64; C = (st & 1) * 32 + (swz % 64) / 2; }
__host__ __device__ __forceinline__ int perm32(int rho) { const int n = rho >> 4, i = rho & 15; return 8 * (i >> 2) + 4 * n + (i & 3); }

struct Unit { int pm, pn; };
struct Gemm { const bf16_t* A; const bf16_t* Bt; int M, N, K; };

struct StaticOrder {
    int nM, nN, nwg, G, c;
    __host__ __device__ void init(int M, int N, int G_, int c_) { nM = M / BM; nN = N / BM; nwg = nM * nN; G = G_; c = c_; }
    __host__ __device__ bool next(int i, Unit& u) const {
        const long L = (long)i * G + c; if (L >= nwg) return false;
        int wgid = (int)L; { const int q = nwg / NXCD, r = nwg % NXCD, xcd = wgid % NXCD, off = wgid / NXCD; wgid = (xcd < r ? xcd * (q + 1) : r * (q + 1) + (xcd - r) * q) + off; }
        const int nig = WGM * nN, gid = wgid / nig, fm = gid * WGM, gsz = (nM - fm) < WGM ? (nM - fm) : WGM;
        u.pm = fm + ((wgid % nig) % gsz); u.pn = (wgid % nig) / gsz; return true;
    }
    __device__ __forceinline__ void a_ready(const Unit&) const {}
    __device__ __forceinline__ void done(const Unit&) const {}
};

__device__ __forceinline__ unsigned cvt_pk_bf16(float lo, float hi) { typedef float v2f __attribute__((ext_vector_type(2))); typedef __bf16 v2b __attribute__((ext_vector_type(2))); const v2f v = {lo, hi}; return __builtin_bit_cast(unsigned, __builtin_convertvector(v, v2b)); }
__device__ __forceinline__ u32x4 pack8(const f32x4 v0, const f32x4 v1) { u32x4 w; w.x = cvt_pk_bf16(v0[0], v0[1]); w.y = cvt_pk_bf16(v0[2], v0[3]); w.z = cvt_pk_bf16(v1[0], v1[1]); w.w = cvt_pk_bf16(v1[2], v1[3]); return w; }
struct EpiQ {
    static constexpr bool PERM = true, AFTER_DRAIN = false;
    bf16_t* O; int ldc;
    __device__ __forceinline__ void operator()(const f32x4 (&acc)[2][2][4][2], const Unit& u, int wr, int wc, int fr, int fq) const {
        const int row0 = u.pm * BM + wr * 64 + fr, col0 = u.pn * BM + wc * 32 + 8 * fq;
#pragma unroll
        for (int ai = 0; ai < 2; ++ai)
#pragma unroll
            for (int m = 0; m < 4; ++m) { bf16_t* rowp = O + (size_t)(row0 + ai * HALF + m * 16) * ldc + col0;
#pragma unroll
                for (int bj = 0; bj < 2; ++bj) *(u32x4*)(rowp + bj * HALF) = pack8(acc[ai][bj][m][0], acc[ai][bj][m][1]); }
    }
};
struct EpiWinP {
    static constexpr bool PERM = true, AFTER_DRAIN = false;
    bf16_t* qkv; bf16_t* z; float* ab;
    __device__ __forceinline__ void operator()(const f32x4 (&acc)[2][2][4][2], const Unit& u, int wr, int wc, int fr, int fq) const {
        const int row0 = u.pm * BM + wr * 64 + fr;
        if (u.pn < 16) {
            bf16_t* base = u.pn < 12 ? qkv : z; const int ldc = u.pn < 12 ? 3072 : 1024, col0 = (u.pn < 12 ? u.pn : u.pn - 12) * BM + wc * 32 + 8 * fq;
#pragma unroll
            for (int ai = 0; ai < 2; ++ai)
#pragma unroll
                for (int m = 0; m < 4; ++m) { bf16_t* rowp = base + (size_t)(row0 + ai * HALF + m * 16) * ldc + col0;
#pragma unroll
                    for (int bj = 0; bj < 2; ++bj) *(u32x4*)(rowp + bj * HALF) = pack8(acc[ai][bj][m][0], acc[ai][bj][m][1]); }
        } else if (wc == 0) {
#pragma unroll
            for (int ai = 0; ai < 2; ++ai)
#pragma unroll
                for (int m = 0; m < 4; ++m) { float* rowp = ab + (size_t)(row0 + ai * HALF + m * 16) * 32 + 8 * fq;
                    *(f32x4*)rowp = acc[ai][0][m][0]; *(f32x4*)(rowp + 4) = acc[ai][0][m][1]; }
        }
    }
};
struct EpiRes {
    static constexpr bool PERM = true, AFTER_DRAIN = false;
    bf16_t* h; const float* gate;
    __device__ __forceinline__ void operator()(const f32x4 (&acc)[2][2][4][2], const Unit& u, int wr, int wc, int fr, int fq) const {
        const int row0 = u.pm * BM + wr * 64 + fr, col0 = u.pn * BM + wc * 32 + 8 * fq;
#pragma unroll
        for (int ai = 0; ai < 2; ++ai)
#pragma unroll
            for (int m = 0; m < 4; ++m) { const int row = row0 + ai * HALF + m * 16; bf16_t* rowp = h + (size_t)row * 1024 + col0; const float* gp = gate + (row >> 11) * 6144 + col0;
#pragma unroll
                for (int bj = 0; bj < 2; ++bj) {
                    const u32x4 hv = *(const u32x4*)(rowp + bj * HALF);
                    const f32x4 g0 = *(const f32x4*)(gp + bj * HALF), g1 = *(const f32x4*)(gp + bj * HALF + 4);
                    const f32x4 a0 = acc[ai][bj][m][0], a1 = acc[ai][bj][m][1];
                    f32x4 n0, n1;
                    n0[0] = __uint_as_float(hv.x << 16) + g0[0] * a0[0]; n0[1] = __uint_as_float(hv.x & 0xffff0000u) + g0[1] * a0[1];
                    n0[2] = __uint_as_float(hv.y << 16) + g0[2] * a0[2]; n0[3] = __uint_as_float(hv.y & 0xffff0000u) + g0[3] * a0[3];
                    n1[0] = __uint_as_float(hv.z << 16) + g1[0] * a1[0]; n1[1] = __uint_as_float(hv.z & 0xffff0000u) + g1[1] * a1[1];
                    n1[2] = __uint_as_float(hv.w << 16) + g1[2] * a1[2]; n1[3] = __uint_as_float(hv.w & 0xffff0000u) + g1[3] * a1[3];
                    *(u32x4*)(rowp + bj * HALF) = pack8(n0, n1);
                } }
    }
};

template <class Epi, class Sched, bool ALIGN_EPI = false, bool SP2 = false>
__device__ __forceinline__ void gemm_phase(PG8_LAS unsigned char* lds, const Gemm g, const Sched& S, const Epi& E) {
    const int tid = tid_fresh(), wid = __builtin_amdgcn_readfirstlane(tid >> 6), lane = tid & 63, wr = wid >> 2, wc = wid & 3, fr = lane & 15, fq = lane >> 4;
    const int K = g.K, nt = K / BK;
    unsigned voffA[2], voffB[2];
#pragma unroll
    for (int i = 0; i < 2; ++i) { int R, C; stage_rc(tid * 16 + i * 8192, R, C); const int Rb = Epi::PERM ? ((R & ~31) + perm32(R & 31)) : R;
        voffA[i] = (unsigned)(R * K + C) * 2u; voffB[i] = (unsigned)(Rb * K + C) * 2u; }
    const size_t kstep = (size_t)(BK * 2);
    const size_t hstep = (size_t)HALF * K * 2;
    const size_t tstep = 2 * hstep;
    const unsigned ldsw = (unsigned)wid * 1024u;
    const int aoff = lds_byte(wr * 64 + fr, fq * 8), boff = lds_byte(wc * 32 + fr, fq * 8);
#define PG8_SA(b, h) (((b) * 2 + (h)) * HTB)
#define PG8_SB(b, h) ((4 + (b) * 2 + (h)) * HTB)
#define PG8_STAGE(bufoff, gbase, voff) do { _Pragma("unroll") for (int _i = 0; _i < 2; ++_i) \
        __builtin_amdgcn_global_load_lds((const unsigned*)((const char*)(gbase) + (voff)[_i]), (PG8_LAS unsigned*)(lds + (bufoff) + ldsw + _i * 8192), 16, 0, 0); } while (0)
#define PG8_LDA(dst, b, h) do { _Pragma("unroll") for (int m = 0; m < 4; ++m) _Pragma("unroll") for (int k = 0; k < 2; ++k) dst[m][k] = *(const PG8_LAS bf16x8*)(lds + PG8_SA(b, h) + aoff + m * 2048 + k * 1024); } while (0)
#define PG8_LDB(dst, b, h) do { _Pragma("unroll") for (int n = 0; n < 2; ++n) _Pragma("unroll") for (int k = 0; k < 2; ++k) dst[n][k] = *(const PG8_LAS bf16x8*)(lds + PG8_SB(b, h) + boff + n * 2048 + k * 1024); } while (0)
#define PG8_MMA(ai, bj, At, Bt) do { __builtin_amdgcn_s_setprio(1); _Pragma("unroll") for (int m = 0; m < 4; ++m) _Pragma("unroll") for (int n = 0; n < 2; ++n) _Pragma("unroll") for (int k = 0; k < 2; ++k) \
        acc[ai][bj][m][n] = __builtin_amdgcn_mfma_f32_16x16x32_bf16(Bt[n][k], At[m][k], acc[ai][bj][m][n], 0, 0, 0); __builtin_amdgcn_s_setprio(0); } while (0)
#define PG8_WAIT_V(n) asm volatile("s_waitcnt vmcnt(" #n ")" ::: "memory")
#define PG8_WAIT_L(n) asm volatile("s_waitcnt lgkmcnt(" #n ")" ::: "memory")
#define PG8_BAR __builtin_amdgcn_s_barrier()
#define PG8_SCHED __builtin_amdgcn_sched_barrier(0)
    Unit cur, nxt; int ui = 0;
    if (!S.next(0, cur)) return;
    f32x4 acc[2][2][4][2];
#pragma unroll
    for (int a = 0; a < 2; ++a)
#pragma unroll
        for (int b = 0; b < 2; ++b)
#pragma unroll
            for (int m = 0; m < 4; ++m)
#pragma unroll
                for (int n = 0; n < 2; ++n) acc[a][b][m][n] = (f32x4){0.f, 0.f, 0.f, 0.f};
    bf16x8 At[4][2], B0[2][2], B1[2][2];
    const char* cA = (const char*)g.A + (size_t)cur.pm * tstep; const char* cB = (const char*)g.Bt + (size_t)cur.pn * tstep;
    S.a_ready(cur);
    if constexpr (SP2) {
        PG8_STAGE(PG8_SB(0, 0), cB, voffB); PG8_STAGE(PG8_SB(0, 1), cB + hstep, voffB); PG8_STAGE(PG8_SA(0, 0), cA, voffA); PG8_STAGE(PG8_SA(0, 1), cA + hstep, voffA);
        if (wr == 1) PG8_BAR;
        PG8_WAIT_V(2); PG8_BAR;
        PG8_STAGE(PG8_SB(1, 0), cB + kstep, voffB); PG8_STAGE(PG8_SA(1, 0), cA + kstep, voffA); PG8_STAGE(PG8_SB(1, 1), cB + hstep + kstep, voffB);
        PG8_WAIT_V(6); PG8_BAR;
    } else {
        PG8_STAGE(PG8_SB(0, 0), cB, voffB); PG8_STAGE(PG8_SA(0, 0), cA, voffA); PG8_STAGE(PG8_SB(0, 1), cB + hstep, voffB); PG8_STAGE(PG8_SA(0, 1), cA + hstep, voffA);
        if (wr == 1) PG8_BAR;
        PG8_WAIT_V(4); PG8_BAR;
        PG8_STAGE(PG8_SB(1, 0), cB + kstep, voffB); PG8_STAGE(PG8_SA(1, 0), cA + kstep, voffA); PG8_STAGE(PG8_SB(1, 1), cB + hstep + kstep, voffB);
        PG8_WAIT_V(6); PG8_BAR;
    }
    for (;;) {
        const bool has_next = S.next(ui + 1, nxt);
        const char* nA = has_next ? (const char*)g.A + (size_t)nxt.pm * tstep : cA; const char* nB = has_next ? (const char*)g.Bt + (size_t)nxt.pn * tstep : cB;
        for (int t = 0; t < nt; t += 2) {
            const bool last = (t == nt - 2);
            const char* a1 = cA + (size_t)(t + 1) * kstep;
            const char* a2 = last ? nA : cA + (size_t)(t + 2) * kstep; const char* b2 = last ? nB : cB + (size_t)(t + 2) * kstep;
            const char* a3 = a2 + kstep; const char* b3 = b2 + kstep;
            if (last && has_next) S.a_ready(nxt);
            if constexpr (SP2) {
            PG8_LDB(B0, 0, 0); PG8_LDB(B1, 0, 1); PG8_SCHED; PG8_LDA(At, 0, 0); PG8_STAGE(PG8_SA(1, 1), a1 + hstep, voffA);
            PG8_WAIT_V(8); PG8_WAIT_L(0); PG8_BAR; PG8_MMA(0, 0, At, B0); PG8_MMA(0, 1, At, B1); PG8_BAR; PG8_SCHED;
            PG8_LDA(At, 0, 1); PG8_STAGE(PG8_SB(0, 0), b2, voffB); PG8_STAGE(PG8_SB(0, 1), b2 + hstep, voffB); PG8_STAGE(PG8_SA(0, 0), a2, voffA);
            PG8_WAIT_V(8); PG8_WAIT_L(0); PG8_BAR; PG8_MMA(1, 0, At, B0); PG8_MMA(1, 1, At, B1); PG8_BAR; PG8_SCHED;
            PG8_LDB(B0, 1, 0); PG8_LDB(B1, 1, 1); PG8_SCHED; PG8_LDA(At, 1, 0); PG8_STAGE(PG8_SA(0, 1), a2 + hstep, voffA);
            PG8_WAIT_V(8); PG8_WAIT_L(0); PG8_BAR; PG8_MMA(0, 0, At, B0); PG8_MMA(0, 1, At, B1); PG8_BAR; PG8_SCHED;
            PG8_LDA(At, 1, 1); PG8_STAGE(PG8_SB(1, 0), b3, voffB); PG8_STAGE(PG8_SB(1, 1), b3 + hstep, voffB); PG8_STAGE(PG8_SA(1, 0), a3, voffA);
            PG8_WAIT_V(8); PG8_WAIT_L(0); PG8_BAR; PG8_MMA(1, 0, At, B0); PG8_MMA(1, 1, At, B1); PG8_BAR; PG8_SCHED;
            } else {
            PG8_LDB(B0, 0, 0); PG8_SCHED; PG8_LDA(At, 0, 0); PG8_STAGE(PG8_SA(1, 1), a1 + hstep, voffA);
            PG8_WAIT_L(8); PG8_BAR; PG8_WAIT_L(0); PG8_MMA(0, 0, At, B0); PG8_BAR; PG8_SCHED;
            PG8_LDB(B1, 0, 1); PG8_STAGE(PG8_SB(0, 0), b2, voffB);
            PG8_BAR; PG8_WAIT_L(0); PG8_MMA(0, 1, At, B1); PG8_BAR;
            PG8_LDA(At, 0, 1); PG8_STAGE(PG8_SA(0, 0), a2, voffA);
            PG8_BAR; PG8_WAIT_L(0); PG8_MMA(1, 0, At, B0); PG8_BAR; PG8_SCHED;
            PG8_STAGE(PG8_SB(0, 1), b2 + hstep, voffB);
            PG8_WAIT_V(6); PG8_BAR; PG8_MMA(1, 1, At, B1); PG8_BAR;
            PG8_LDB(B0, 1, 0); PG8_SCHED; PG8_LDA(At, 1, 0); PG8_STAGE(PG8_SA(0, 1), a2 + hstep, voffA);
            PG8_WAIT_L(8); PG8_BAR; PG8_WAIT_L(0); PG8_MMA(0, 0, At, B0); PG8_BAR; PG8_SCHED;
            PG8_LDB(B1, 1, 1); PG8_STAGE(PG8_SB(1, 0), b3, voffB);
            PG8_BAR; PG8_WAIT_L(0); PG8_MMA(0, 1, At, B1); PG8_BAR;
            PG8_LDA(At, 1, 1); PG8_STAGE(PG8_SA(1, 0), a3, voffA);
            PG8_BAR; PG8_WAIT_L(0); PG8_MMA(1, 0, At, B0); PG8_BAR; PG8_SCHED;
            PG8_STAGE(PG8_SB(1, 1), b3 + hstep, voffB);
            PG8_WAIT_V(6); PG8_BAR; PG8_MMA(1, 1, At, B1); PG8_BAR;
            }
        }
        if constexpr (ALIGN_EPI) { if (wr == 0) PG8_BAR; }
        if constexpr (!Epi::AFTER_DRAIN) { E(acc, cur, wr, wc, fr, fq); S.done(cur); }
        if (!has_next) break;
#pragma unroll
        for (int a = 0; a < 2; ++a)
#pragma unroll
            for (int b = 0; b < 2; ++b)
#pragma unroll
                for (int m = 0; m < 4; ++m)
#pragma unroll
                    for (int n = 0; n < 2; ++n) acc[a][b][m][n] = (f32x4){0.f, 0.f, 0.f, 0.f};
        cur = nxt; cA = nA; cB = nB; ++ui;
        if constexpr (ALIGN_EPI) { if (wr == 1) PG8_BAR; }
    }
    PG8_WAIT_V(0);
    if constexpr (!ALIGN_EPI) { if (wr == 0) PG8_BAR; }
    PG8_BAR;
    if constexpr (Epi::AFTER_DRAIN) { E.fused(acc, cur, wr, wc, fr, fq, lds, wid, lane); S.done(cur); }
#undef PG8_SA
#undef PG8_SB
#undef PG8_STAGE
#undef PG8_LDA
#undef PG8_LDB
#undef PG8_MMA
#undef PG8_WAIT_V
#undef PG8_WAIT_L
#undef PG8_BAR
#undef PG8_SCHED
}
}

#define XB_TMO      128
#define XB_XCNT(j)  (256  + 64 * (j))
#define XB_XSUB(j)  (1280 + 64 * (j))
#define XB_XGEN(j)  (2304 + 64 * (j))
#define XB_TOP      3328
#define XB_TOPGEN   3392
#define XCD_BAR_WORDS 3456
#define XB_SPIN_CAP (1u << 22)
DEV unsigned xb_ld(unsigned* p)              { return __hip_atomic_load(p, __ATOMIC_RELAXED, __HIP_MEMORY_SCOPE_AGENT); }
DEV unsigned xb_add(unsigned* p, unsigned v) { return __hip_atomic_fetch_add(p, v, __ATOMIC_RELAXED, __HIP_MEMORY_SCOPE_AGENT); }
DEV unsigned xb_xcc_id() { return (unsigned)__builtin_amdgcn_s_getreg((3 << 11) | 20) & 0xFu; }
#define XB_SPIN(cond, bar) do { unsigned _sp = 0; while (cond) { __builtin_amdgcn_s_sleep(1); \
    if ((++_sp & 255u) == 0u) { if (xb_ld(&(bar)[XB_TMO])) break; if (_sp > XB_SPIN_CAP) { atomicAdd(&(bar)[XB_TMO], 1u); break; } } } } while (0)
struct XcdBarrier { unsigned* bar; unsigned x; volatile LAS unsigned* st; };
DEV XcdBarrier xcd_barrier_post(unsigned* bar, volatile LAS unsigned* st) {
    XcdBarrier b; b.bar = bar; b.x = xb_xcc_id(); b.st = st;
    if (threadIdx.x == 0) (void)xb_add(&bar[XB_XCNT(b.x)], 1u);
    return b;
}
DEV void xcd_barrier_complete(unsigned* bar, unsigned x, unsigned& nloc, unsigned& nx) {
    const unsigned G = gridDim.x * gridDim.y * gridDim.z;
    unsigned sum, cnt, mine, sp = 0u;
    for (;;) {
        sum = 0u; cnt = 0u; mine = 0u;
#pragma unroll
        for (unsigned j = 0; j < 16; ++j) { const unsigned c = xb_ld(&bar[XB_XCNT(j)]); sum += c; cnt += (c > 0u) ? 1u : 0u; mine = (j == x) ? c : mine; }
        if (sum == G) break;
        __builtin_amdgcn_s_sleep(1);
        if ((++sp & 255u) == 0u) { if (xb_ld(&bar[XB_TMO])) break; if (sp > XB_SPIN_CAP) { atomicAdd(&bar[XB_TMO], 1u); break; } }
    }
    nloc = mine > 0u ? mine : 1u; nx = cnt > 0u ? cnt : 1u;
}
DEV void xcd_barrier(const XcdBarrier& b) {
    asm volatile("s_waitcnt vmcnt(0)" ::: "memory");
    __syncthreads();
    if (threadIdx.x == 0) {
        unsigned* bar = b.bar;
        __builtin_amdgcn_s_waitcnt(0);
        unsigned nloc = b.st[0], nx = b.st[1];
        if (nloc == 0u) { xcd_barrier_complete(bar, b.x, nloc, nx); b.st[0] = nloc; b.st[1] = nx; }
        const unsigned old = xb_add(&bar[XB_XSUB(b.x)], 1u);
        const unsigned gen = old / nloc;
        if (old + 1u == (gen + 1u) * nloc) {
            __builtin_amdgcn_fence(__ATOMIC_RELEASE, "agent");
            asm volatile("s_waitcnt vmcnt(0)" ::: "memory");
            const unsigned og = xb_add(&bar[XB_TOP], 1u);
            const unsigned tg = og / nx;
            if (og + 1u == (tg + 1u) * nx) xb_add(&bar[XB_TOPGEN], 1u);
            else XB_SPIN(xb_ld(&bar[XB_TOPGEN]) == tg, bar);
            __builtin_amdgcn_fence(__ATOMIC_ACQUIRE, "agent");
            xb_add(&bar[XB_XGEN(b.x)], 1u);
            asm volatile("s_waitcnt vmcnt(0)" ::: "memory");
        } else {
            XB_SPIN(xb_ld(&bar[XB_XGEN(b.x)]) == gen, bar);
            __builtin_amdgcn_fence(__ATOMIC_ACQUIRE, "agent");
            asm volatile("s_waitcnt vmcnt(0)" ::: "memory");
        }
    }
    __syncthreads();
}

__global__ void __launch_bounds__(NTHREADS) fwd_megakernel(Params P) {
    __shared__ __attribute__((aligned(16))) unsigned char lds_raw[131072 + 4096];
    const ldsp lds = (ldsp)lds_raw;
    cg::grid_group grid = cg::this_grid();
    volatile LAS unsigned* xbst = (volatile LAS unsigned*)(lds + 131072);
    if (threadIdx.x == 0) { xbst[0] = 0u; xbst[1] = 0u; }
    __syncthreads();
    const XcdBarrier xbar = xcd_barrier_post((unsigned*)(P.ws + OFF_BAR), xbst);
#define GBAR() xcd_barrier(xbar)
#define ROW_HANDOFF() do { __builtin_amdgcn_fence(__ATOMIC_RELEASE, "workgroup"); asm volatile("s_waitcnt vmcnt(0)" ::: "memory"); __builtin_amdgcn_fence(__ATOMIC_ACQUIRE, "workgroup"); } while (0)
    const float* modv = (const float*)(P.ws + OFF_MODV);
    bf16_t* Abuf = (bf16_t*)(P.ws + OFF_A);

#define RUN(rep, ...) for (int rep_i = 0; rep_i < (rep); ++rep_i) { __VA_ARGS__; GBAR(); }
    for (int rep_i = 0; rep_i < REP_PREP; ++rep_i) { phase_prep(P, lds); grid.sync(); }
    RUN(REP_MOD, phase_modulate<0>(P, 0, 0, NT))
    RUN(REP_POOL, phase_pool(P, lds))
    RUN(REP_MOD, phase_modulate<1>(P, 0, 1, NT, true))
    RUN(REP_GEMM, { pg8::Gemm g{Abuf, (const bf16_t*)(P.ws + OFF_WQT), NT, 2048, 1024}; pg8::StaticOrder S; S.init(NT, 2048, gridDim.x, blockIdx.x); pg8::EpiQ e{(bf16_t*)(P.ws + OFF_R1), 2048}; pg8::gemm_phase<pg8::EpiQ, pg8::StaticOrder, true, true>(lds, g, S, e); })
    RUN(REP_TOPK, phase_topk(P, 0, NT, lds))
    phase_experts(P, 0, NT, lds);
    ROW_HANDOFF();
    RUN(REP_MOD, phase_modulate<1>(P, 1, 0, NT))
    RUN(REP_GEMM, { pg8::Gemm g{Abuf, (const bf16_t*)(P.ws + OFF_WINT), NT, 4352, 1024}; pg8::StaticOrder S; S.init(NT, 4352, gridDim.x, blockIdx.x);
      pg8::EpiWinP e{(bf16_t*)(P.ws + OFF_R1), (bf16_t*)(P.ws + OFF_PZ), (float*)(P.ws + OFF_AB)}; pg8::gemm_phase<pg8::EpiWinP, pg8::StaticOrder, true, true>(lds, g, S, e); })
    RUN(REP_CONV, phase_conv(P))
    RUN(REP_CHUNK, phase_chunk(P, lds))
    RUN(REP_SCAN, phase_scan(P, lds))
    RUN(REP_DNOUT, phase_dnout(P))
    { pg8::Gemm g{Abuf, (const bf16_t*)(P.ws + OFF_WOUTT), NX, 1024, 1024}; pg8::StaticOrder S; S.init(NX, 1024, gridDim.x, blockIdx.x); pg8::EpiRes e{(bf16_t*)(P.ws + OFF_H), modv + 9 * 6144 + 2048}; pg8::gemm_phase<pg8::EpiRes, pg8::StaticOrder, false, true>(lds, g, S, e); }
    GBAR();
    RUN(REP_MOD, phase_modulate<1>(P, 1, 1, NX, true))
    RUN(REP_GEMM, { pg8::Gemm g{Abuf, (const bf16_t*)(P.ws + OFF_WQT) + (size_t)2048 * 1024, NX, 2048, 1024}; pg8::StaticOrder S; S.init(NX, 2048, gridDim.x, blockIdx.x); pg8::EpiQ e{(bf16_t*)(P.ws + OFF_R1), 2048}; pg8::gemm_phase<pg8::EpiQ, pg8::StaticOrder, true, true>(lds, g, S, e); })
    RUN(REP_TOPK, phase_topk(P, 1, NX, lds))
    phase_experts(P, 1, NX, lds);
    ROW_HANDOFF();
    phase_final(P);
}

extern "C" void kernel_launch(void* const* d_in, const int* in_sizes, int n_in, void* d_out, int out_size, void* d_ws, size_t ws_size, hipStream_t stream) {
    static int grid_blocks = 0;
    if (grid_blocks == 0) {
        if (n_in != 21 || out_size != NX * D || ws_size < WS_END) {
            fprintf(stderr, "kernel_launch: unexpected shapes: n_in %d out %d ws %zu (need %zu)\n", n_in, out_size, ws_size, (size_t)WS_END);
            grid_blocks = -1; return;
        }
        int dev = 0, cus = 0, per_cu = 0;
        hipGetDevice(&dev);
        hipDeviceGetAttribute(&cus, hipDeviceAttributeMultiprocessorCount, dev);
        hipOccupancyMaxActiveBlocksPerMultiprocessor(&per_cu, fwd_megakernel, NTHREADS, 0);
        if (per_cu < 1) { fprintf(stderr, "kernel_launch: occupancy query reports %d blocks per CU\n", per_cu); grid_blocks = -1; return; }
        grid_blocks = cus;
    }
    if (grid_blocks < 0) return;
    if (hipMemsetAsync((char*)d_ws + OFF_BAR, 0, XCD_BAR_WORDS * 4, stream) != hipSuccess) { fprintf(stderr, "kernel_launch: memset of barrier words failed\n"); return; }
    Params p{};
    const float** pp = (const float**)&p;
    for (int i = 0; i < 21; ++i) pp[i] = (const float*)d_in[i];
    p.out = (float*)d_out; p.ws = (unsigned char*)d_ws;
    void* args[] = {&p};
    hipError_t e = hipLaunchCooperativeKernel((void*)fwd_megakernel, dim3(grid_blocks), dim3(NTHREADS), args, 0, stream);
    if (e != hipSuccess) fprintf(stderr, "cooperative launch failed: %s (grid %d)\n", hipGetErrorString(e), grid_blocks);
}
```

```cpp
#include <hip/hip_runtime.h>
#include <hip/hip_cooperative_groups.h>
#include <cstdio>
#include <cstdint>
namespace cg = cooperative_groups;

#define DEV __device__ __forceinline__
typedef unsigned short bf16_t;
typedef short bf16x8 __attribute__((ext_vector_type(8)));
typedef float f32x4 __attribute__((ext_vector_type(4)));
typedef float f32x16 __attribute__((ext_vector_type(16)));
typedef unsigned u32x4 __attribute__((ext_vector_type(4)));
typedef unsigned u32x2 __attribute__((ext_vector_type(2)));
#define LAS __attribute__((address_space(3)))
typedef LAS unsigned char* ldsp;
DEV int tid_fresh() { int t = threadIdx.x; asm volatile("" : "+v"(t)); return t; }
DEV ldsp launder(ldsp p) { asm volatile("" : "+v"(p)); return p; }

constexpr int D = 1024, NB = 8, SEQ = 2048, CTX = 256;
constexpr int NX = NB * SEQ, NC = NB * CTX, NT = NX + NC;
constexpr int NTHREADS = 512;
constexpr float EPS = 1e-6f;
#ifndef REP_PREP
#define REP_PREP 1
#endif
#ifndef REP_MOD
#define REP_MOD 1
#endif
#ifndef REP_POOL
#define REP_POOL 1
#endif
#ifndef REP_GEMM
#define REP_GEMM 1
#endif
#ifndef REP_TOPK
#define REP_TOPK 1
#endif
#ifndef REP_CONV
#define REP_CONV 1
#endif
#ifndef REP_CHUNK
#define REP_CHUNK 1
#endif
#ifndef REP_SCAN
#define REP_SCAN 1
#endif
#ifndef REP_DNOUT
#define REP_DNOUT 1
#endif

constexpr size_t MiB = 1024 * 1024;
constexpr size_t TAB_ELEMS = (size_t)16384 * 1024;
constexpr size_t OFF_TAB   = 0;
constexpr size_t OFF_WQT   = 128 * MiB;
constexpr size_t OFF_WINT  = OFF_WQT + 8 * MiB;
constexpr size_t OFF_WOUTT = OFF_WINT + (size_t)4352 * 1024 * 2;
constexpr size_t OFF_POOLT = OFF_WOUTT + 2 * MiB;
constexpr size_t OFF_KEYS  = OFF_POOLT + 512 * 1024;
constexpr size_t OFF_MODV  = OFF_KEYS + 1 * MiB;
constexpr size_t OFF_HC    = OFF_MODV + 512 * 1024;
constexpr size_t OFF_SELI  = OFF_HC + 8 * MiB;
constexpr size_t OFF_SELG  = OFF_SELI + (size_t)NT * 128 * 4;
constexpr size_t OFF_AB    = OFF_SELG + (size_t)NT * 128 * 4;
constexpr size_t OFF_G     = OFF_AB + (size_t)NT * 32 * 4;
constexpr size_t OFF_BETA  = OFF_G + (size_t)2 * NT * 8 * 4;
constexpr size_t OFF_GC    = OFF_BETA + (size_t)2 * NT * 8 * 4;
constexpr size_t OFF_QC    = OFF_GC + (size_t)4608 * 64 * 4;
constexpr size_t OFF_KC    = OFF_QC + (size_t)NT * 1024 * 2;
constexpr size_t OFF_VC    = OFF_KC + (size_t)NT * 1024 * 2;
constexpr size_t OFF_A     = OFF_VC + (size_t)NT * 1024 * 2;
constexpr size_t OFF_R1    = OFF_A + (size_t)NT * 1024 * 2;
constexpr size_t OFF_PZ    = OFF_R1 + (size_t)NT * 3072 * 2;
constexpr size_t OFF_BAR   = OFF_R1 + (size_t)NT * 4096 * 2;
constexpr size_t OFF_H     = OFF_BAR + 16384;
constexpr size_t OFF_XS    = OFF_H + (size_t)NT * 1024 * 2;
constexpr size_t OFF_RSC   = OFF_XS + (size_t)NT * 4;
constexpr size_t WS_END    = OFF_RSC + (size_t)4 * 16384 * 4;
constexpr size_t OFF_WBUF  = OFF_A;
constexpr size_t OFF_UBUF  = OFF_A + (size_t)4608 * 8192 * 2;
constexpr size_t OFF_OBUF  = OFF_TAB + 64 * MiB;
constexpr size_t OFF_PART  = OFF_QC;
constexpr size_t OFF_WEXP  = OFF_QC + (size_t)8 * NT * 128 * 4;
constexpr size_t OFF_A8    = OFF_WEXP + (size_t)NT * 128 * 4;
static_assert(OFF_UBUF + (size_t)4608 * 8192 * 2 <= OFF_PZ, "w/u overlay must not reach Pz");
static_assert(OFF_A8 + (size_t)NT * 1024 <= OFF_A, "PEER partial buffers must fit the q/k/v conv region");

struct Params {
    const float *x, *c, *ctx, *c_ctx, *mod_w, *mod_b, *norm1_g, *norm2_g, *pool_w, *pool_scale;
    const float *dn_w_in, *dn_conv_w, *dn_a_log, *dn_dt_bias, *dn_norm_g, *dn_w_out;
    const float *peer_wq, *peer_keys, *peer_u, *peer_v, *final_g;
    float* out; unsigned char* ws;
};

DEV bf16_t f2bf(float f) { return __builtin_bit_cast(unsigned short, (__bf16)f); }
DEV float bf2f(bf16_t h) { return __uint_as_float(((unsigned)h) << 16); }
typedef float f32x2_t __attribute__((ext_vector_type(2)));
typedef __bf16 bf16x2_t __attribute__((ext_vector_type(2)));
DEV unsigned pk2(float a, float b) { const f32x2_t v = {a, b}; const bf16x2_t r = __builtin_convertvector(v, bf16x2_t); return __builtin_bit_cast(unsigned, r); }
DEV float bflo(unsigned u) { return __uint_as_float(u << 16); }
DEV float bfhi(unsigned u) { return __uint_as_float(u & 0xffff0000u); }
DEV float wave_sum(float v) {
#pragma unroll
    for (int o = 32; o >= 1; o >>= 1) v += __shfl_xor(v, o);
    return v;
}
DEV float wave_max(float v) {
#pragma unroll
    for (int o = 32; o >= 1; o >>= 1) v = fmaxf(v, __shfl_xor(v, o));
    return v;
}
DEV float sum16(float v) {
#pragma unroll
    for (int o = 8; o >= 1; o >>= 1) v += __shfl_xor(v, o);
    return v;
}
DEV f32x16 mfma32(bf16x8 a, bf16x8 b, f32x16 c) { return __builtin_amdgcn_mfma_f32_32x32x16_bf16(a, b, c, 0, 0, 0); }
DEV int crow(int reg, int lane) { return (reg & 3) + 8 * (reg >> 2) + 4 * (lane >> 5); }
DEV f32x16 zero16() { f32x16 z;
#pragma unroll
    for (int i = 0; i < 16; ++i) z[i] = 0.f; return z; }
DEV bf16_t* hrow(const Params& P, int r) { return (bf16_t*)(P.ws + OFF_H) + (size_t)r * 1024; }
DEV float silu(float v) { return v * __builtin_amdgcn_rcpf(1.f + __expf(-v)); }

DEV bf16x8 frag_row(const LAS bf16_t* m, int ld, int r0, int k0, int lane) {
    return *(const LAS bf16x8*)(m + (r0 + (lane & 31)) * ld + k0 + 8 * (lane >> 5));
}
DEV bf16x8 frag_col(const LAS bf16_t* m, int ld, int c0, int k0, int lane) {
    bf16x8 f;
#pragma unroll
    for (int j = 0; j < 8; ++j) f[j] = (short)m[(k0 + 8 * (lane >> 5) + j) * ld + c0 + (lane & 31)];
    return f;
}

typedef short s16x4 __attribute__((ext_vector_type(4)));
DEV s16x4 ds_tr16(ldsp p) { return __builtin_amdgcn_ds_read_tr16_b64_v4i16((LAS s16x4*)p); }
DEV bf16x8 frag_col_tr(const LAS bf16_t* m, int ld, int c0, int k0, int lane) {
    const int gi = lane >> 4, li = lane & 15, q = li >> 2, pc = li & 3, h = gi >> 1;
    const LAS bf16_t* p = m + (k0 + 8 * h + q) * ld + c0 + 16 * (gi & 1) + 4 * pc;
    const s16x4 lo = ds_tr16((ldsp)p), hi = ds_tr16((ldsp)(p + 4 * ld));
    bf16x8 f; f[0] = lo[0]; f[1] = lo[1]; f[2] = lo[2]; f[3] = lo[3]; f[4] = hi[0]; f[5] = hi[1]; f[6] = hi[2]; f[7] = hi[3];
    return f;
}
DEV void p0_convert_item(const float* src, bf16_t* dst, size_t base) {
    const int tid = tid_fresh();
#pragma unroll
    for (int it = 0; it < 8; ++it) {
        const size_t e = base + ((size_t)it * NTHREADS + tid) * 8;
        const f32x4 a = *(const f32x4*)(src + e), b = *(const f32x4*)(src + e + 4);
        u32x4 o; o.x = pk2(a.x, a.y); o.y = pk2(a.z, a.w); o.z = pk2(b.x, b.y); o.w = pk2(b.z, b.w);
        *(u32x4*)(dst + e) = o;
    }
}
DEV void p0_table_item(const float* src, unsigned char* dst, float* rscale, int row0, bool as_int8) {
    const int tid = tid_fresh(), wave = tid >> 6, lane = tid & 63;
#pragma unroll 8
    for (int rr = 0; rr < 16; ++rr) {
        const int e = row0 + wave * 16 + rr;
        f32x4 v[4]; float am = 0.f;
#pragma unroll
        for (int q = 0; q < 4; ++q) { v[q] = __builtin_nontemporal_load((const f32x4*)(src + (size_t)e * 1024 + 256 * q + 4 * lane));
            am = fmaxf(am, fmaxf(fmaxf(fabsf(v[q].x), fabsf(v[q].y)), fmaxf(fabsf(v[q].z), fabsf(v[q].w)))); }
        am = wave_max(am);
        if (as_int8) {
            float ssq = 0.f;
#pragma unroll
            for (int q = 0; q < 4; ++q) ssq += v[q].x * v[q].x + v[q].y * v[q].y + v[q].z * v[q].z + v[q].w * v[q].w;
            ssq = wave_sum(ssq);
            const float top = fminf(am, 2.7f * sqrtf(ssq * (1.f / 1024.f)));
            am = top;
            const float sc = am > 0.f ? 7.f / am : 0.f;
#pragma unroll
            for (int q = 0; q < 4; ++q) {
                const int n0 = (int)fminf(fmaxf(rintf(v[q].x * sc), -7.f), 7.f) & 15, n1 = (int)fminf(fmaxf(rintf(v[q].y * sc), -7.f), 7.f) & 15;
                const int n2 = (int)fminf(fmaxf(rintf(v[q].z * sc), -7.f), 7.f) & 15, n3 = (int)fminf(fmaxf(rintf(v[q].w * sc), -7.f), 7.f) & 15;
                *(unsigned short*)(dst + ((size_t)q * 16384 + e) * 128 + 2 * lane) = (unsigned short)(n0 | (n1 << 4) | (n2 << 8) | (n3 << 12));
            }
            if (lane == 0) rscale[e] = am * (1.f / 7.f);
        } else {
            float ssq = 0.f;
#pragma unroll
            for (int q = 0; q < 4; ++q) ssq += v[q].x * v[q].x + v[q].y * v[q].y + v[q].z * v[q].z + v[q].w * v[q].w;
            ssq = wave_sum(ssq);
            const float top = fminf(am, 2.8f * sqrtf(ssq * (1.f / 1024.f)));
            const float sc = top > 0.f ? 6.f / top : 0.f;
#pragma unroll
            for (int q = 0; q < 4; ++q) {
                const float x0 = fminf(fmaxf(v[q].x * sc, -6.f), 6.f), x1 = fminf(fmaxf(v[q].y * sc, -6.f), 6.f), x2 = fminf(fmaxf(v[q].z * sc, -6.f), 6.f), x3 = fminf(fmaxf(v[q].w * sc, -6.f), 6.f);
                unsigned w = __builtin_amdgcn_cvt_scalef32_pk_fp4_f32(0u, x0, x1, 1.0f, 0);
                w = __builtin_amdgcn_cvt_scalef32_pk_fp4_f32(w, x2, x3, 1.0f, 1);
                *(unsigned short*)(dst + ((size_t)q * 16384 + e) * 128 + 2 * lane) = (unsigned short)(w & 0xffffu);
            }
            if (lane == 0) rscale[e] = top * (1.f / 6.f);
        }
    }
}
DEV void p0_transpose_item(const float* W, int K, int N, bf16_t* Wt, int kt, int nt, LAS float* tile) {
    const int tid = tid_fresh(), k0 = kt * 64, n0 = nt * 256;
    f32x4 v[8];
#pragma unroll
    for (int p = 0; p < 8; ++p) {
        const int kk = p * 8 + (tid >> 6), nn = (tid & 63) * 4, n = n0 + nn;
        v[p] = (f32x4){0.f, 0.f, 0.f, 0.f};
        if (n < N) v[p] = __builtin_nontemporal_load((const f32x4*)(W + (size_t)(k0 + kk) * N + n));
    }
#pragma unroll
    for (int p = 0; p < 8; ++p) {
        const int kk = p * 8 + (tid >> 6), nn = (tid & 63) * 4;
        tile[kk * 257 + nn + 0] = v[p].x; tile[kk * 257 + nn + 1] = v[p].y; tile[kk * 257 + nn + 2] = v[p].z; tile[kk * 257 + nn + 3] = v[p].w;
    }
    __syncthreads();
#pragma unroll
    for (int q = 0; q < 4; ++q) {
        const int n = q * 64 + (tid >> 3), kc = (tid & 7) * 8;
        u32x4 o;
        o.x = pk2(tile[(kc + 0) * 257 + n], tile[(kc + 1) * 257 + n]);
        o.y = pk2(tile[(kc + 2) * 257 + n], tile[(kc + 3) * 257 + n]);
        o.z = pk2(tile[(kc + 4) * 257 + n], tile[(kc + 5) * 257 + n]);
        o.w = pk2(tile[(kc + 6) * 257 + n], tile[(kc + 7) * 257 + n]);
        *(u32x4*)(Wt + (size_t)(n0 + n) * K + k0 + kc) = o;
    }
    __syncthreads();
}
DEV void p0_mod_item(const Params& P, int i, int cb, LAS float* lds) {
    LAS float* s = lds;
    LAS float* red = lds + 9 * 1024;
    const int tid = tid_fresh();
    for (int e = tid; e < 9 * 1024; e += NTHREADS) {
        const int m = e >> 10, k = e & 1023;
        const float cv = m < 8 ? P.c[m * 1024 + k] : P.c_ctx[k];
        s[e] = silu(cv);
    }
    __syncthreads();
    const int cq = tid & 31, kg = tid >> 5;
    const float* W = P.mod_w + (size_t)i * 1024 * 6144 + cb * 128 + cq * 4;
    f32x4 acc[9];
#pragma unroll
    for (int m = 0; m < 9; ++m) acc[m] = (f32x4){0.f, 0.f, 0.f, 0.f};
#pragma unroll 16
    for (int kk = 0; kk < 64; ++kk) {
        const int k = kg * 64 + kk;
        const f32x4 w = __builtin_nontemporal_load((const f32x4*)(W + (size_t)k * 6144));
#pragma unroll
        for (int m = 0; m < 9; ++m) { const float sv = s[m * 1024 + k]; acc[m] += w * sv; }
    }
#pragma unroll
    for (int m = 0; m < 9; ++m) *(LAS f32x4*)&red[(kg * 9 + m) * 128 + cq * 4] = acc[m];
    __syncthreads();
    float* modv = (float*)(P.ws + OFF_MODV);
    for (int e = tid; e < 9 * 128; e += NTHREADS) {
        const int m = e >> 7, col = e & 127;
        float sum = 0.f;
#pragma unroll
        for (int g = 0; g < 16; ++g) sum += red[(g * 9 + m) * 128 + col];
        modv[(size_t)(i * 9 + m) * 6144 + cb * 128 + col] = sum + P.mod_b[i * 6144 + cb * 128 + col];
    }
    __syncthreads();
}
DEV void phase_prep(const Params& P, ldsp lds0) {
    constexpr int N_MOD = 96, N_WQ = 2 * 16 * 8, N_WIN = 16 * 17, N_WOUT = 16 * 4, N_POOL = 4 * 4;
    constexpr int N_TR = N_WQ + N_WIN + N_WOUT + N_POOL, N_TAB = 4 * 128, N_KEYS = 16;
    constexpr int TOTAL = N_MOD + N_TR + N_TAB + N_KEYS;
    for (int item = blockIdx.x; item < TOTAL; item += gridDim.x) {
        LAS float* lds = (LAS float*)launder(lds0);
        int r = item;
        if (r < N_MOD) { p0_mod_item(P, r / 48, r % 48, lds); continue; }
        r -= N_MOD;
        if (r < N_WQ) { const int i = r / 128, t = r % 128;
            p0_transpose_item(P.peer_wq + (size_t)i * 1024 * 2048, 1024, 2048, (bf16_t*)(P.ws + OFF_WQT) + (size_t)i * 2048 * 1024, t / 8, t % 8, lds); continue; }
        r -= N_WQ;
        if (r < N_WIN) { p0_transpose_item(P.dn_w_in, 1024, 4128, (bf16_t*)(P.ws + OFF_WINT), r / 17, r % 17, lds); continue; }
        r -= N_WIN;
        if (r < N_WOUT) { p0_transpose_item(P.dn_w_out, 1024, 1024, (bf16_t*)(P.ws + OFF_WOUTT), r / 4, r % 4, lds); continue; }
        r -= N_WOUT;
        if (r < N_POOL) { const int g = r / 4, t = r % 4;
            p0_transpose_item(P.pool_w + (size_t)g * 65536, 256, 256, (bf16_t*)(P.ws + OFF_POOLT) + (size_t)g * 65536, t, 0, lds); continue; }
        r -= N_POOL;
        if (r < N_TAB) { const int tb = r / 128, ch = r % 128;
            const float* src = ((tb & 1) ? P.peer_v : P.peer_u) + (size_t)(tb >> 1) * TAB_ELEMS;
            p0_table_item(src, P.ws + OFF_TAB + (size_t)tb * 16 * MiB, (float*)(P.ws + OFF_RSC) + tb * 16384, ch * 128, (tb & 1) == 0); continue; }
        r -= N_TAB;
        p0_convert_item(P.peer_keys, (bf16_t*)(P.ws + OFF_KEYS), (size_t)r * 32768);
    }
}

template <int SRC>
DEV void phase_modulate(const Params& P, int layer, int which, int nrows, bool q8 = false) {
    const float* gain = (which ? P.norm2_g : P.norm1_g) + layer * 1024;
    const float* modv = (const float*)(P.ws + OFF_MODV) + (size_t)layer * 9 * 6144;
    bf16_t* A = (bf16_t*)(P.ws + OFF_A);
    const int tid = tid_fresh(); const int wave = tid >> 6, lane = tid & 63;
    for (int r = blockIdx.x * 8 + wave; r < nrows; r += gridDim.x * 8) {
        const int m = r < NX ? (r >> 11) : 8;
        const float* sh = modv + m * 6144 + which * 3072;
        const float* sc = sh + 1024;
        f32x4 v[4]; float ss = 0.f;
#pragma unroll
        for (int j = 0; j < 4; ++j) {
            if (SRC == 0) { const float* src = r < NX ? P.x + (size_t)r * 1024 : P.ctx + (size_t)(r - NX) * 1024; v[j] = *(const f32x4*)(src + j * 256 + lane * 4); }
            else { const u32x2 hv = *(const u32x2*)(hrow(P, r) + j * 256 + lane * 4); v[j] = (f32x4){bflo(hv.x), bfhi(hv.x), bflo(hv.y), bfhi(hv.y)}; }
            ss += v[j].x * v[j].x + v[j].y * v[j].y + v[j].z * v[j].z + v[j].w * v[j].w;
        }
        ss = wave_sum(ss);
        const float rstd = rsqrtf(ss * (1.f / 1024.f) + EPS);
#pragma unroll
        for (int j = 0; j < 4; ++j) {
            const int col = j * 256 + lane * 4;
            const f32x4 g = *(const f32x4*)(gain + col), s1 = *(const f32x4*)(sc + col), s0 = *(const f32x4*)(sh + col);
            const f32x4 y = v[j] * rstd * g * (1.f + s1) + s0;
            u32x2 o; o.x = pk2(y.x, y.y); o.y = pk2(y.z, y.w);
            *(u32x2*)(A + (size_t)r * 1024 + col) = o;
            v[j] = y;
        }
        if (q8) {
            float am = 0.f;
#pragma unroll
            for (int j = 0; j < 4; ++j) am = fmaxf(am, fmaxf(fmaxf(fabsf(v[j].x), fabsf(v[j].y)), fmaxf(fabsf(v[j].z), fabsf(v[j].w))));
            am = wave_max(am);
            const float sc = am > 0.f ? 119.f / am : 0.f;
            unsigned char* a8 = P.ws + OFF_A8 + (size_t)r * 1024;
#pragma unroll
            for (int j = 0; j < 4; ++j) {
                unsigned mh = 0u, ml = 0u;
#pragma unroll
                for (int e = 0; e < 4; ++e) {
                    const int b = (int)rintf(v[j][e] * sc), h = (b + 8) >> 4, l = b - 16 * h;
                    mh |= (unsigned)(h & 15) << (4 * e); ml |= (unsigned)(l & 15) << (4 * e);
                }
                const unsigned mine = mh | (ml << 16), other = (unsigned)__shfl_xor((int)mine, 1);
                const unsigned outw = (lane & 1) ? ((other >> 16) | (mine & 0xffff0000u)) : ((mine & 0xffffu) | (other << 16));
                *(unsigned*)(a8 + (j * 8 + (lane >> 3)) * 32 + (lane & 1) * 16 + 4 * ((lane & 7) >> 1)) = outw;
            }
            if (lane == 0) ((float*)(P.ws + OFF_XS))[r] = am * (1.f / 119.f);
        }
    }
}

DEV void unpack8(const u32x4 v, float* f) {
    f[0] = bflo(v.x); f[1] = bfhi(v.x); f[2] = bflo(v.y); f[3] = bfhi(v.y); f[4] = bflo(v.z); f[5] = bfhi(v.z); f[6] = bflo(v.w); f[7] = bfhi(v.w);
}
template <int W>
DEV void pool_vertical(const bf16_t* A0, LAS float* V, int b, int r, int cbase, int tq, int ch8, float (&cen)[4][8]) {
    const int rlo = max(0, r - W / 2), rhi = min(32, r - W / 2 + W);
    const float inv = 1.f / (float)(rhi - rlo);
#pragma unroll
    for (int jh = 0; jh < 2; ++jh) {
        u32x4 ld[2][W];
#pragma unroll
        for (int jj = 0; jj < 2; ++jj)
#pragma unroll
            for (int k = 0; k < W; ++k) {
                const int rr = min(rlo + k, 31), tok = tq + 16 * (2 * jh + jj);
                ld[jj][k] = *(const u32x4*)(A0 + ((size_t)b * 2048 + rr * 64 + tok) * 1024 + cbase);
            }
#pragma unroll
        for (int jj = 0; jj < 2; ++jj) {
            const int j = 2 * jh + jj, tok = tq + 16 * j;
            float acc[8];
#pragma unroll
            for (int e = 0; e < 8; ++e) acc[e] = 0.f;
#pragma unroll
            for (int k = 0; k < W; ++k) {
                float f[8]; unpack8(ld[jj][k], f);
                const bool in = rlo + k < rhi;
#pragma unroll
                for (int e = 0; e < 8; ++e) acc[e] += in ? f[e] : 0.f;
                if (rlo + k == r) {
#pragma unroll
                    for (int e = 0; e < 8; ++e) cen[j][e] = f[e];
                }
            }
            LAS float* vp = V + (tok + 8) * 260 + ch8 * 8;
            *(LAS f32x4*)vp = (f32x4){acc[0] * inv, acc[1] * inv, acc[2] * inv, acc[3] * inv};
            *(LAS f32x4*)(vp + 4) = (f32x4){acc[4] * inv, acc[5] * inv, acc[6] * inv, acc[7] * inv};
        }
    }
}
template <int W>
DEV void pool_horizontal(const LAS float* V, ldsp At, bool isx, int seg, int tq, int ch8, const float (&cen)[4][8]) {
#pragma unroll
    for (int j = 0; j < 4; ++j) {
        const int tok = tq + 16 * j;
        const int pos = isx ? tok : 64 * seg + tok, lim = isx ? 64 : 256, off = isx ? 8 : 8 - 64 * seg;
        const int lo = max(0, pos - W / 2), hi = min(lim, pos - W / 2 + W);
        f32x4 s0 = {0.f, 0.f, 0.f, 0.f}, s1 = {0.f, 0.f, 0.f, 0.f};
#pragma unroll
        for (int k = 0; k < W; ++k) {
            const int t = min(lo + k, lim - 1);
            const LAS float* vp = V + (t + off) * 260 + ch8 * 8;
            const f32x4 a = *(const LAS f32x4*)vp, b2 = *(const LAS f32x4*)(vp + 4);
            const float m = (lo + k < hi) ? 1.f : 0.f;
            s0 += a * m; s1 += b2 * m;
        }
        const float inv = 1.f / (float)(hi - lo);
        u32x4 o;
        o.x = pk2(s0.x * inv - cen[j][0], s0.y * inv - cen[j][1]);
        o.y = pk2(s0.z * inv - cen[j][2], s0.w * inv - cen[j][3]);
        o.z = pk2(s1.x * inv - cen[j][4], s1.y * inv - cen[j][5]);
        o.w = pk2(s1.z * inv - cen[j][6], s1.w * inv - cen[j][7]);
        *(LAS u32x4*)(At + tok * 512 + ((ch8 ^ (tok & 7)) << 4)) = o;
    }
}
DEV void phase_pool(const Params& P, ldsp lds0) {
    const bf16_t* A0 = (const bf16_t*)(P.ws + OFF_A);
    const float* modv = (const float*)(P.ws + OFF_MODV);
    const bf16_t* Wt = (const bf16_t*)(P.ws + OFF_POOLT);
    const int tid = tid_fresh(), lane = tid & 63, wave = tid >> 6;
    const int ch8 = tid & 31, tq = tid >> 5;
    for (int item = blockIdx.x; item < 1152; item += gridDim.x) {
        const ldsp lds = launder(lds0);
        LAS float* V = (LAS float*)lds;
        const ldsp At = lds + 80 * 260 * 4;
        const bool isx = item < 1024;
        int b, r = 0, seg = 0, g;
        if (isx) { b = item >> 7; r = (item >> 2) & 31; }
        else { const int it = item - 1024; b = it >> 4; seg = (it >> 2) & 3; }
        g = ((item & 3) + (item >> 8)) & 3;
        const int cbase = g * 256 + ch8 * 8;
        float cen[4][8];
        if (isx) {
            if (g == 0) pool_vertical<2>(A0, V, b, r, cbase, tq, ch8, cen);
            else if (g == 1) pool_vertical<4>(A0, V, b, r, cbase, tq, ch8, cen);
            else if (g == 2) pool_vertical<8>(A0, V, b, r, cbase, tq, ch8, cen);
            else pool_vertical<16>(A0, V, b, r, cbase, tq, ch8, cen);
        } else {
            for (int q = tq; q < 80; q += 16) {
                const int t = 64 * seg - 8 + q;
                if (t >= 0 && t < 256) {
                    const u32x4 pv = *(const u32x4*)(A0 + ((size_t)NX + b * 256 + t) * 1024 + cbase);
                    float f[8]; unpack8(pv, f);
                    LAS float* vp = V + q * 260 + ch8 * 8;
                    *(LAS f32x4*)vp = (f32x4){f[0], f[1], f[2], f[3]};
                    *(LAS f32x4*)(vp + 4) = (f32x4){f[4], f[5], f[6], f[7]};
                }
            }
#pragma unroll
            for (int j = 0; j < 4; ++j) {
                const int tok = tq + 16 * j;
                const u32x4 pv = *(const u32x4*)(A0 + ((size_t)NX + b * 256 + 64 * seg + tok) * 1024 + cbase);
                unpack8(pv, cen[j]);
            }
        }
        __syncthreads();
        const bf16_t* Wg = Wt + (size_t)g * 65536 + (size_t)(32 * wave + (lane & 31)) * 256 + (lane >> 5) * 8;
        bf16x8 wf[16];
#pragma unroll
        for (int ks = 0; ks < 16; ++ks) wf[ks] = *(const bf16x8*)(Wg + ks * 16);
        __builtin_amdgcn_sched_barrier(0);
        if (g == 0) pool_horizontal<2>(V, At, isx, seg, tq, ch8, cen);
        else if (g == 1) pool_horizontal<4>(V, At, isx, seg, tq, ch8, cen);
        else if (g == 2) pool_horizontal<8>(V, At, isx, seg, tq, ch8, cen);
        else pool_horizontal<16>(V, At, isx, seg, tq, ch8, cen);
        __syncthreads();
        const int m = isx ? b : 8;
        f32x4 xv[2][4];
#pragma unroll
        for (int mt = 0; mt < 2; ++mt)
#pragma unroll
            for (int rg = 0; rg < 4; ++rg) {
                const int tok = mt * 32 + (lane & 31), col = g * 256 + 32 * wave + 8 * rg + 4 * (lane >> 5);
                const float* xp = isx ? P.x + ((size_t)b * 2048 + r * 64 + tok) * 1024 + col : P.ctx + ((size_t)b * 256 + 64 * seg + tok) * 1024 + col;
                xv[mt][rg] = __builtin_nontemporal_load((const f32x4*)xp);
            }
        __builtin_amdgcn_sched_barrier(0);
        f32x16 acc[2]; acc[0] = zero16(); acc[1] = zero16();
#pragma unroll
        for (int ks = 0; ks < 16; ++ks) {
            const int ch = ks * 2 + (lane >> 5);
#pragma unroll
            for (int mt = 0; mt < 2; ++mt) {
                const int row = mt * 32 + (lane & 31);
                const bf16x8 a = *(const LAS bf16x8*)(At + row * 512 + ((ch ^ (row & 7)) << 4));
                acc[mt] = mfma32(wf[ks], a, acc[mt]);
            }
        }
#pragma unroll
        for (int mt = 0; mt < 2; ++mt)
#pragma unroll
            for (int rg = 0; rg < 4; ++rg) {
                const int tok = mt * 32 + (lane & 31), col = g * 256 + 32 * wave + 8 * rg + 4 * (lane >> 5);
                const f32x4 gs = *(const f32x4*)(modv + m * 6144 + 2048 + col) * *(const f32x4*)(P.pool_scale + col);
                const f32x4 av = {acc[mt][rg * 4 + 0], acc[mt][rg * 4 + 1], acc[mt][rg * 4 + 2], acc[mt][rg * 4 + 3]};
                const int grow = isx ? b * 2048 + r * 64 + tok : NX + b * 256 + 64 * seg + tok;
                const f32x4 hv = xv[mt][rg] + gs * av;
                u32x2 hp; hp.x = pk2(hv.x, hv.y); hp.y = pk2(hv.z, hv.w);
                *(u32x2*)(hrow(P, grow) + col) = hp;
            }
        __syncthreads();
    }
}

DEV bf16x8 frag_row_x(ldsp x, int r0, int k0, int lane) {
    const int row = r0 + (lane & 31), ch = (k0 >> 3) + (lane >> 5);
    return *(const LAS bf16x8*)(x + row * 256 + ((ch ^ (row & 15)) << 4));
}
DEV unsigned key_of(float f) { const unsigned u = __float_as_uint(f); return u ^ ((unsigned)((int)u >> 31) | 0x80000000u); }
DEV float val_of(unsigned k) { const unsigned u = (k & 0x80000000u) ? (k ^ 0x80000000u) : ~k; return __uint_as_float(u); }
DEV void cmpx(unsigned& hi, unsigned& lo) { const unsigned a = hi, b = lo; hi = a > b ? a : b; lo = a > b ? b : a; }
#define SN16(a, b) cmpx(v[a], v[b]);
DEV void sort16_desc(unsigned* v) {
    SN16(0,13) SN16(1,12) SN16(2,15) SN16(3,14) SN16(4,8) SN16(5,6) SN16(7,11) SN16(9,10)
    SN16(0,5) SN16(1,7) SN16(2,9) SN16(3,4) SN16(6,13) SN16(8,14) SN16(10,15) SN16(11,12)
    SN16(0,1) SN16(2,3) SN16(4,5) SN16(6,8) SN16(7,9) SN16(10,11) SN16(12,13) SN16(14,15)
    SN16(0,2) SN16(1,3) SN16(4,10) SN16(5,11) SN16(6,7) SN16(8,9) SN16(12,14) SN16(13,15)
    SN16(1,2) SN16(3,12) SN16(4,6) SN16(5,7) SN16(8,10) SN16(9,11) SN16(13,14)
    SN16(1,4) SN16(2,6) SN16(5,8) SN16(7,10) SN16(9,13) SN16(11,14)
    SN16(2,4) SN16(3,6) SN16(9,12) SN16(11,13)
    SN16(3,5) SN16(6,8) SN16(7,9) SN16(10,12)
    SN16(3,4) SN16(5,6) SN16(7,8) SN16(9,10) SN16(11,12)
    SN16(6,7) SN16(8,9)
}
#undef SN16
DEV void merge16(unsigned* r, const unsigned* b) {
#pragma unroll
    for (int k = 0; k < 16; ++k) r[k] = r[k] > b[15 - k] ? r[k] : b[15 - k];
#pragma unroll
    for (int j = 8; j > 0; j >>= 1)
#pragma unroll
        for (int i = 0; i < 16; ++i) { const int l = i ^ j; if (l > i) cmpx(r[i], r[l]); }
}
DEV void top16_of_64(unsigned* v, unsigned* r) {
#pragma unroll
    for (int blk = 0; blk < 4; ++blk) sort16_desc(v + 16 * blk);
#pragma unroll
    for (int k = 0; k < 16; ++k) r[k] = v[k];
    merge16(r, v + 16); merge16(r, v + 32); merge16(r, v + 48);
}
DEV void phase_topk(const Params& P, int layer, int nrows, ldsp lds0) {
    const bf16_t* Q = (const bf16_t*)(P.ws + OFF_R1);
    const bf16_t* keys = (const bf16_t*)(P.ws + OFF_KEYS) + (size_t)layer * 8 * 2 * 128 * 128;
    bf16_t* seli = (bf16_t*)(P.ws + OFF_SELI);
    float* selg = (float*)(P.ws + OFF_SELG);
    const int tid = tid_fresh(), lane = tid & 63, wave = tid >> 6;
    const int nitems = (nrows / 256) * 4;
    const unsigned hoff = (unsigned)(lane >> 5) * 4u;
    const int G = gridDim.x, nfr = nitems / G, left = nitems - nfr * G;
    int per = 0;
    if (left) { per = (left * 8 + G - 1) / G; per = per <= 1 ? 1 : per <= 2 ? 2 : per <= 4 ? 4 : 8; }
    const int nloop = nfr + ((left && (int)blockIdx.x * per < left * 8) ? 1 : 0);
    for (int it = 0; it < nloop; ++it) {
        const ldsp lds = launder(lds0);
        LAS unsigned* sl = (LAS unsigned*)(lds + 65536 + wave * 8192);
        int item, wtask; bool act;
        if (it < nfr) { item = it * G + blockIdx.x; wtask = wave; act = true; }
        else { const int j = blockIdx.x * per + wave; item = nfr * G + ((blockIdx.x * per) >> 3); wtask = j & 7; act = wave < per; }
        act = __builtin_amdgcn_readfirstlane((int)act) != 0;
        const int tg = item >> 2, hp = item & 3, row0 = tg * 256 + wtask * 32;
        u32x4 kr[4]; bf16x8 qf[8];
        {
            const bf16_t* kt = keys + (size_t)((hp * 2) * 2) * 128 * 128;
#pragma unroll
            for (int j = 0; j < 4; ++j) { const int cid = tid + NTHREADS * j, r = cid >> 4, ch = cid & 15; kr[j] = *(const u32x4*)(kt + r * 128 + ch * 8); }
#pragma unroll
            for (int j = 0; j < 4; ++j) { const int cid = tid + NTHREADS * j, r = cid >> 4, ch = cid & 15; *(LAS u32x4*)(lds + r * 256 + ((ch ^ (r & 15)) << 4)) = kr[j]; }
            const bf16_t* qb = Q + (size_t)(row0 + (lane & 31)) * 2048 + (hp * 2) * 256 + (lane >> 5) * 8;
#pragma unroll
            for (int ks = 0; ks < 8; ++ks) qf[ks] = *(const bf16x8*)(qb + ks * 16);
        }
        __syncthreads();
        unsigned s1[16], s2[16];
#pragma unroll
        for (int k = 0; k < 16; ++k) { s1[k] = 0u; s2[k] = 0u; }
#pragma unroll 1
        for (int step = 0; step < 4; ++step) {
            const int hs = step >> 1, p = step & 1;
            const bool mine = (lane >> 5) == hs;
            const ldsp kb = lds + (step & 1) * 32768;
            if (step < 3) {
                const bf16_t* kt = keys + (size_t)((hp * 2 + ((step + 1) >> 1)) * 2 + ((step + 1) & 1)) * 128 * 128;
#pragma unroll
                for (int j = 0; j < 4; ++j) { const int cid = tid + NTHREADS * j, r = cid >> 4, ch = cid & 15; kr[j] = *(const u32x4*)(kt + r * 128 + ch * 8); }
            }
            f32x16 acc[4];
#pragma unroll
            for (int mt = 0; mt < 4; ++mt) acc[mt] = zero16();
            if (act) {
#pragma unroll
            for (int ks = 0; ks < 8; ++ks)
#pragma unroll
                for (int mt = 0; mt < 4; ++mt) acc[mt] = mfma32(frag_row_x(kb, mt * 32, ks * 16, lane), qf[ks], acc[mt]);
            }
            if (step < 3) {
                const ldsp kn = lds + ((step + 1) & 1) * 32768;
#pragma unroll
                for (int j = 0; j < 4; ++j) { const int cid = tid + NTHREADS * j, r = cid >> 4, ch = cid & 15; *(LAS u32x4*)(kn + r * 256 + ((ch ^ (r & 15)) << 4)) = kr[j]; }
                const bf16_t* qb = Q + (size_t)(row0 + (lane & 31)) * 2048 + (hp * 2 + ((step + 1) >> 1)) * 256 + ((step + 1) & 1) * 128 + (lane >> 5) * 8;
#pragma unroll
                for (int ks = 0; ks < 8; ++ks) qf[ks] = *(const bf16x8*)(qb + ks * 16);
            }
            if (act) {
            unsigned v[64];
#pragma unroll
            for (int mt = 0; mt < 4; ++mt)
#pragma unroll
                for (int reg = 0; reg < 16; ++reg) {
                    const unsigned c = mt * 32 + (reg & 3) + 8 * (reg >> 2);
                    v[mt * 16 + reg] = ((key_of(acc[mt][reg]) & ~127u) | (127u - c)) ^ hoff;
                }
            unsigned r[16], o[16];
            top16_of_64(v, r);
#pragma unroll
            for (int k = 0; k < 16; ++k) o[k] = (unsigned)__shfl_xor((int)r[k], 32);
            merge16(r, o);
#pragma unroll
            for (int k = 0; k < 16; ++k) { if (p == 0) s1[k] = mine ? r[k] : s1[k]; else s2[k] = mine ? r[k] : s2[k]; }
            }
            __syncthreads();
        }
        if (!act) continue;
        float f1[16], f2[16];
#pragma unroll
        for (int k = 0; k < 16; ++k) {
            sl[k * 64 + lane] = s1[k]; sl[(16 + k) * 64 + lane] = s2[k];
            f1[k] = val_of(s1[k] & ~127u); f2[k] = val_of(s2[k] & ~127u);
        }
        unsigned cv[64];
        {
            int n = 0;
#pragma unroll
            for (int a = 0; a < 16; ++a)
#pragma unroll
                for (int b = 0; b < 16; ++b)
                    if ((a + 1) * (b + 1) <= 16) { cv[n] = (key_of(f1[a] + f2[b]) & ~255u) | (255u - (unsigned)(a * 16 + b)); ++n; }
#pragma unroll
            for (int q = 50; q < 64; ++q) cv[q] = 0u;
        }
        unsigned w[16];
        top16_of_64(cv, w);
        float sc[16]; int ei[16];
#pragma unroll
        for (int k = 0; k < 16; ++k) {
            const unsigned ab = 255u - (w[k] & 255u);
            const unsigned k1 = sl[(ab >> 4) * 64 + lane], k2 = sl[(16 + (ab & 15u)) * 64 + lane];
            ei[k] = (int)((127u - (k1 & 127u)) * 128u + (127u - (k2 & 127u)));
            sc[k] = val_of(w[k] & ~255u);
        }
        const float mx = sc[0];
        float tot = 0.f;
#pragma unroll
        for (int k = 0; k < 16; ++k) { sc[k] = expf(sc[k] - mx); tot += sc[k]; }
        const int row = row0 + (lane & 31), head = hp * 2 + (lane >> 5);
        bf16_t* ip = seli + (size_t)row * 128 + head * 16;
        float* gp = selg + (size_t)row * 128 + head * 16;
        const float inv = 1.f / tot;
#pragma unroll
        for (int q = 0; q < 2; ++q) {
            u32x4 o;
#pragma unroll
            for (int d = 0; d < 4; ++d) o[d] = (unsigned)ei[8 * q + 2 * d] | ((unsigned)ei[8 * q + 2 * d + 1] << 16);
            *(u32x4*)(ip + 8 * q) = o;
        }
#pragma unroll
        for (int q = 0; q < 4; ++q) *(float4*)(gp + 4 * q) = make_float4(sc[4 * q] * inv, sc[4 * q + 1] * inv, sc[4 * q + 2] * inv, sc[4 * q + 3] * inv);
    }
}

struct XGeo { int nloc, rank, nact, pos; };
typedef float f32x2 __attribute__((ext_vector_type(2)));
DEV void fp8x16_to_f32(const u32x4 r, float* f) {
#pragma unroll
    for (int d = 0; d < 4; ++d) {
        const f32x2 lo = __builtin_amdgcn_cvt_pk_f32_fp8((int)r[d], false), hi = __builtin_amdgcn_cvt_pk_f32_fp8((int)r[d], true);
        f[4 * d + 0] = lo.x; f[4 * d + 1] = lo.y; f[4 * d + 2] = hi.x; f[4 * d + 3] = hi.y;
    }
}
template <int S, int MUL, class T>
DEV void bfly_stage(T* p, int lane) {
    const bool hi = (lane & (S * MUL)) != 0;
#pragma unroll
    for (int i = 0; i < 2 * S; ++i) { const T keep = hi ? p[i + 2 * S] : p[i], send = hi ? p[i] : p[i + 2 * S]; p[i] = keep + __shfl_xor(send, S * MUL); }
}
template <int N2>
DEV void bfly_swap32(float* p) {
#pragma unroll
    for (int i = 0; i < N2; ++i) { const auto r = __builtin_amdgcn_permlane32_swap(__float_as_uint(p[i]), __float_as_uint(p[i + N2]), false, false); p[i] = __uint_as_float(r[0]) + __uint_as_float(r[1]); }
}
template <int N2>
DEV void bfly_swap16(float* p) {
#pragma unroll
    for (int i = 0; i < N2; ++i) { const auto r = __builtin_amdgcn_permlane16_swap(__float_as_uint(p[i]), __float_as_uint(p[i + N2]), false, false); p[i] = __uint_as_float(r[0]) + __uint_as_float(r[1]); }
}
template <int N2>
DEV void bfly_ror8(float* p, int lane) {
    const bool hi = (lane & 8) != 0;
#pragma unroll
    for (int i = 0; i < N2; ++i) {
        const float a = p[i] + __uint_as_float((unsigned)__builtin_amdgcn_update_dpp(0, (int)__float_as_uint(p[i]), 0x128, 0xf, 0xf, false));
        const float b = p[i + N2] + __uint_as_float((unsigned)__builtin_amdgcn_update_dpp(0, (int)__float_as_uint(p[i + N2]), 0x128, 0xf, 0xf, false));
        p[i] = hi ? b : a;
    }
}
template <int STAGE>
DEV void ex_issue(u32x4 (&buf)[16], u32x4 (&aux)[4], f32x2 (&hg)[2], const u32x4 (&idn)[2], const unsigned char* slice, const Params& P, const bf16_t* A, const bf16_t* wexp,
                  const float* gatev, int t, int sl, int g, int c) {
    int id[16];
#pragma unroll
    for (int q = 0; q < 2; ++q)
#pragma unroll
        for (int d = 0; d < 4; ++d) { id[8 * q + 2 * d] = (int)(idn[q][d] & 0xffffu); id[8 * q + 2 * d + 1] = (int)(idn[q][d] >> 16); }
#pragma unroll
    for (int k = 0; k < 16; ++k) buf[k] = *(const u32x4*)(slice + (size_t)id[k] * 128);
    if (STAGE == 1) {
        aux[0] = *(const u32x4*)(P.ws + OFF_A8 + (size_t)t * 1024 + 256 * sl + 32 * c); aux[1] = *(const u32x4*)(P.ws + OFF_A8 + (size_t)t * 1024 + 256 * sl + 32 * c + 16);
        hg[0].x = ((const float*)(P.ws + OFF_XS))[t];
    } else {
#pragma unroll
        for (int q = 0; q < 2; ++q) aux[q] = *(const u32x4*)(wexp + (size_t)t * 128 + 16 * g + 8 * q);
        const int col = 256 * sl + 32 * c + 4 * g, m = t < NX ? (t >> 11) : 8;
        const u32x2 hv = *(const u32x2*)(hrow(P, t) + col);
        aux[2] = (u32x4){hv.x, hv.y, 0u, 0u};
        aux[3] = *(const u32x4*)(gatev + m * 6144 + col);
    }
}
template <int STAGE>
DEV void ex_compute(const u32x4 (&buf)[16], const u32x4 (&aux)[4], const f32x2 (&hg)[2], const Params& P, float* part, int t, int sl, int lane, int g, int c) {
    if (STAGE == 1) {
        int sx = 0;
#pragma unroll
        for (int q = 0; q < 2; ++q)
#pragma unroll
            for (int d = 0; d < 4; ++d) sx = __builtin_amdgcn_sdot4(0x01010101, (int)aux[q][d], sx, false);
        int p[16];
#pragma unroll
        for (int k = 0; k < 16; ++k) {
            int a = -8 * sx;
#pragma unroll
            for (int d = 0; d < 4; ++d) {
                const unsigned w = buf[k][d];
                a = __builtin_amdgcn_sdot4((int)(w & 0x0F0F0F0Fu), (int)aux[d >> 1][2 * (d & 1)], a, false);
                a = __builtin_amdgcn_sdot4((int)((w >> 4) & 0x0F0F0F0Fu), (int)aux[d >> 1][2 * (d & 1) + 1], a, false);
            }
            p[k] = a;
        }
        bfly_stage<4, 1>(p, lane); bfly_stage<2, 1>(p, lane); bfly_stage<1, 1>(p, lane);
        const float xs = hg[0].x;
        *(unsigned*)((bf16_t*)part + ((size_t)sl * NT + t) * 128 + 2 * lane) = pk2((float)p[0] * xs, (float)p[1] * xs);
    } else {
        f32x2 p2[16];
#pragma unroll
        for (int i = 0; i < 16; ++i) p2[i] = (f32x2){0.f, 0.f};
#pragma unroll
        for (int k = 0; k < 16; ++k) {
            const unsigned wpk = aux[k >> 3][(k >> 1) & 3];
            const float wkf = (k & 1) ? bfhi(wpk) : bflo(wpk);
            const f32x2 w2 = {wkf, wkf};
#pragma unroll
            for (int d = 0; d < 4; ++d) {
                p2[4 * d + 0] += w2 * __builtin_amdgcn_cvt_scalef32_pk_f32_fp4(buf[k][d], 1.0f, 0);
                p2[4 * d + 1] += w2 * __builtin_amdgcn_cvt_scalef32_pk_f32_fp4(buf[k][d], 1.0f, 1);
                p2[4 * d + 2] += w2 * __builtin_amdgcn_cvt_scalef32_pk_f32_fp4(buf[k][d], 1.0f, 2);
                p2[4 * d + 3] += w2 * __builtin_amdgcn_cvt_scalef32_pk_f32_fp4(buf[k][d], 1.0f, 3);
            }
            asm volatile("" : "+v"(p2[0]), "+v"(p2[1]), "+v"(p2[2]), "+v"(p2[3]), "+v"(p2[4]), "+v"(p2[5]), "+v"(p2[6]), "+v"(p2[7]),
                              "+v"(p2[8]), "+v"(p2[9]), "+v"(p2[10]), "+v"(p2[11]), "+v"(p2[12]), "+v"(p2[13]), "+v"(p2[14]), "+v"(p2[15]));
        }
        float p[32];
#pragma unroll
        for (int i = 0; i < 16; ++i) { p[2 * i] = p2[i].x; p[2 * i + 1] = p2[i].y; }
        bfly_stage<8, 4>(p, lane); bfly_stage<4, 4>(p, lane); bfly_stage<2, 4>(p, lane);
        const int col = 256 * sl + 32 * c + 4 * g;
        const unsigned h0 = aux[2].x, h1 = aux[2].y;
        u32x2 ho;
        ho.x = pk2(bflo(h0) + __uint_as_float(aux[3].x) * p[0], bfhi(h0) + __uint_as_float(aux[3].y) * p[1]);
        ho.y = pk2(bflo(h1) + __uint_as_float(aux[3].z) * p[2], bfhi(h1) + __uint_as_float(aux[3].w) * p[3]);
        *(u32x2*)(hrow(P, t) + col) = ho;
    }
}
template <int STAGE>
DEV void phase_experts_sliced(const Params& P, int layer, int nrows, const XGeo geo) {
    const unsigned char* tab = P.ws + OFF_TAB + (size_t)(layer * 2 + (STAGE - 1)) * 16 * MiB;
    const bf16_t* A = (const bf16_t*)(P.ws + OFF_A);
    const bf16_t* seli = (const bf16_t*)(P.ws + OFF_SELI);
    float* part = (float*)(P.ws + OFF_PART);
    const bf16_t* wexp = (const bf16_t*)(P.ws + OFF_WEXP);
    const float* gatev = (const float*)(P.ws + OFF_MODV) + (size_t)layer * 9 * 6144 + 5 * 1024;
    const int tid = tid_fresh(), wave = tid >> 6, lane = tid & 63, g = lane >> 3, c = lane & 7;
    const int nw = geo.nloc * 8, wr = geo.rank * 8 + wave;
    for (int vs = geo.pos; vs < 8; vs += geo.nact) {
        const int sl = vs >> 1, tmul = 2, tadd = vs & 1;
        const unsigned char* slice = tab + (size_t)sl * 2 * MiB + 16 * c;
        const int nws = nw * tmul;
        int t = wr * tmul + tadd;
        if (t >= nrows) continue;
        u32x4 bufA[16], bufB[16], auxA[4], auxB[4]; f32x2 hgA[2], hgB[2]; u32x4 idn[2];
#pragma unroll
        for (int q = 0; q < 2; ++q) idn[q] = *(const u32x4*)(seli + (size_t)t * 128 + 16 * g + 8 * q);
        ex_issue<STAGE>(bufA, auxA, hgA, idn, slice, P, A, wexp, gatev, t, sl, g, c);
        if (t + nws < nrows) {
#pragma unroll
            for (int q = 0; q < 2; ++q) idn[q] = *(const u32x4*)(seli + (size_t)(t + nws) * 128 + 16 * g + 8 * q);
        }
        for (;;) {
            {
                const int t1 = t + nws;
                if (t1 < nrows) {
                    ex_issue<STAGE>(bufB, auxB, hgB, idn, slice, P, A, wexp, gatev, t1, sl, g, c);
                    if (t1 + nws < nrows) {
#pragma unroll
                        for (int q = 0; q < 2; ++q) idn[q] = *(const u32x4*)(seli + (size_t)(t1 + nws) * 128 + 16 * g + 8 * q);
                    }
                }
                ex_compute<STAGE>(bufA, auxA, hgA, P, part, t, sl, lane, g, c);
            }
            t += nws; if (t >= nrows) break;
            {
                const int t1 = t + nws;
                if (t1 < nrows) {
                    ex_issue<STAGE>(bufA, auxA, hgA, idn, slice, P, A, wexp, gatev, t1, sl, g, c);
                    if (t1 + nws < nrows) {
#pragma unroll
                        for (int q = 0; q < 2; ++q) idn[q] = *(const u32x4*)(seli + (size_t)(t1 + nws) * 128 + 16 * g + 8 * q);
                    }
                }
                ex_compute<STAGE>(bufB, auxB, hgB, P, part, t, sl, lane, g, c);
            }
            t += nws; if (t >= nrows) break;
        }
    }
}
DEV void eu_issue_unit(u32x4 (&buf)[16], u32x4 (&xq)[2], const u32x4 (&idn)[2], const unsigned char* tab, const Params& P, int t, int sl, int c) {
    int id[16];
#pragma unroll
    for (int q = 0; q < 2; ++q)
#pragma unroll
        for (int d = 0; d < 4; ++d) { id[8 * q + 2 * d] = (int)(idn[q][d] & 0xffffu); id[8 * q + 2 * d + 1] = (int)(idn[q][d] >> 16); }
    const unsigned char* slice = tab + (size_t)sl * 2 * MiB;
#pragma unroll
    for (int k = 0; k < 16; ++k) buf[k] = *(const u32x4*)(slice + (unsigned)(id[k] * 128 + 16 * c));
    xq[0] = *(const u32x4*)(P.ws + OFF_A8 + (size_t)t * 1024 + 256 * sl + 32 * c); xq[1] = *(const u32x4*)(P.ws + OFF_A8 + (size_t)t * 1024 + 256 * sl + 32 * c + 16);
}
DEV void eu_compute_unit(const u32x4 (&buf)[16], const u32x4 (&xq)[2], LAS float* acc2, int lane) {
    int p[16];
#pragma unroll
    for (int k = 0; k < 16; ++k) {
        int ah = 0, al = 0;
#pragma unroll
        for (int d = 0; d < 4; ++d) {
            ah = __builtin_amdgcn_sdot8((int)buf[k][d], (int)xq[0][d], ah, false);
            al = __builtin_amdgcn_sdot8((int)buf[k][d], (int)xq[1][d], al, false);
        }
        p[k] = 16 * ah + al;
    }
    bfly_stage<4, 1>(p, lane); bfly_stage<2, 1>(p, lane); bfly_stage<1, 1>(p, lane);
    f32x2 a2 = *(const LAS f32x2*)acc2;
    a2.x += (float)p[0]; a2.y += (float)p[1];
    *(LAS f32x2*)acc2 = a2;
}
DEV void phase_experts_u(const Params& P, int layer, int nrows, ldsp lds0) {
    const unsigned char* tab = P.ws + OFF_TAB + (size_t)(layer * 2) * 16 * MiB;
    const bf16_t* seli = (const bf16_t*)(P.ws + OFF_SELI);
    const float* selg = (const float*)(P.ws + OFF_SELG);
    bf16_t* wexp = (bf16_t*)(P.ws + OFF_WEXP);
    const float* rsu = (const float*)(P.ws + OFF_RSC) + (size_t)(layer * 2) * 16384;
    const float* rsv = rsu + 16384;
    const float* xsv = (const float*)(P.ws + OFF_XS);
    const int tid = tid_fresh(), wave = __builtin_amdgcn_readfirstlane(tid >> 6), lane = tid & 63, g = lane >> 3, c = lane & 7;
    const int gw = blockIdx.x * 8 + wave, nwv = gridDim.x * 8;
    if (gw >= nrows) return;
    const int ntok = (nrows - gw + nwv - 1) / nwv, U = 4 * ntok;
    LAS float* accs = (LAS float*)(launder(lds0) + wave * 8192);
    for (int k = 0; k < ntok; ++k) *(LAS f32x2*)(accs + k * 128 + 2 * lane) = (f32x2){0.f, 0.f};
    u32x4 bufA[16], bufB[16], xqA[2], xqB[2], idn[2];
    int ku = 0, slu = 0;
#define EU_NEXT_IDX() do { const int tt = gw + ku * nwv; _Pragma("unroll") for (int q = 0; q < 2; ++q) idn[q] = *(const u32x4*)(seli + (size_t)tt * 128 + 16 * g + 8 * q); } while (0)
#define EU_ADVANCE() do { if (++ku == ntok) { ku = 0; ++slu; } } while (0)
    EU_NEXT_IDX();
    int kA = ku, slA = slu; eu_issue_unit(bufA, xqA, idn, tab, P, gw + kA * nwv, slA, c); EU_ADVANCE();
    if (U > 1) EU_NEXT_IDX();
    int kB = 0, slB = 0;
    for (int u = 0; u < U; u += 2) {
        if (u + 1 < U) { kB = ku; slB = slu; eu_issue_unit(bufB, xqB, idn, tab, P, gw + kB * nwv, slB, c); EU_ADVANCE(); if (u + 2 < U) EU_NEXT_IDX(); }
        eu_compute_unit(bufA, xqA, accs + kA * 128 + 2 * lane, lane);
        if (u + 1 >= U) break;
        if (u + 2 < U) { kA = ku; slA = slu; eu_issue_unit(bufA, xqA, idn, tab, P, gw + kA * nwv, slA, c); EU_ADVANCE(); if (u + 3 < U) EU_NEXT_IDX(); }
        eu_compute_unit(bufB, xqB, accs + kB * 128 + 2 * lane, lane);
    }
#undef EU_NEXT_IDX
#undef EU_ADVANCE
    for (int k = 0; k < ntok; ++k) {
        const int t = gw + k * nwv;
        const unsigned ep = *(const unsigned*)(seli + (size_t)t * 128 + 2 * lane);
        const f32x2 gt = *(const f32x2*)(selg + (size_t)t * 128 + 2 * lane);
        const f32x2 a2 = *(const LAS f32x2*)(accs + k * 128 + 2 * lane);
        const int e0 = (int)(ep & 0xffffu), e1 = (int)(ep >> 16);
        const float xs = xsv[t];
        const float h0 = a2.x * xs * rsu[e0], h1 = a2.y * xs * rsu[e1];
        const float w0 = gt.x * (0.5f * h0 * (1.f + erff(h0 * 0.70710678118654752f))) * rsv[e0];
        const float w1 = gt.y * (0.5f * h1 * (1.f + erff(h1 * 0.70710678118654752f))) * rsv[e1];
        *(unsigned*)(wexp + (size_t)t * 128 + 2 * lane) = pk2(w0, w1);
    }
}
DEV void ev_issue_unit(u32x4 (&buf)[16], u32x2& hv, u32x4& gt, const u32x4 (&idn)[2], const unsigned char* tab, const Params& P, const float* gatev, int t, int sl, int g, int c) {
    int id[16];
#pragma unroll
    for (int q = 0; q < 2; ++q)
#pragma unroll
        for (int d = 0; d < 4; ++d) { id[8 * q + 2 * d] = (int)(idn[q][d] & 0xffffu); id[8 * q + 2 * d + 1] = (int)(idn[q][d] >> 16); }
    const unsigned char* slice = tab + (size_t)sl * 2 * MiB;
#pragma unroll
    for (int k = 0; k < 16; ++k) buf[k] = *(const u32x4*)(slice + (unsigned)(id[k] * 128 + 16 * c));
    const int col = 256 * sl + 32 * c + 4 * g, m = t < NX ? (t >> 11) : 8;
    hv = *(const u32x2*)(hrow(P, t) + col);
    gt = *(const u32x4*)(gatev + m * 6144 + col);
}
DEV void ev_compute_unit(const u32x4 (&buf)[16], const u32x2 hv, const u32x4 gt, const LAS float* wS, const Params& P, int t, int sl, int lane, int g, int c) {
    f32x2 p2[16];
#pragma unroll
    for (int i = 0; i < 16; ++i) p2[i] = (f32x2){0.f, 0.f};
    f32x4 wq[4];
#pragma unroll
    for (int q = 0; q < 4; ++q) wq[q] = *(const LAS f32x4*)(wS + 4 * q);
#pragma unroll
    for (int k = 0; k < 16; ++k) {
        const float wkf = wq[k >> 2][k & 3];
        const f32x2 w2 = {wkf, wkf};
#pragma unroll
        for (int d = 0; d < 4; ++d) {
            p2[4 * d + 0] += w2 * __builtin_amdgcn_cvt_scalef32_pk_f32_fp4(buf[k][d], 1.0f, 0);
            p2[4 * d + 1] += w2 * __builtin_amdgcn_cvt_scalef32_pk_f32_fp4(buf[k][d], 1.0f, 1);
            p2[4 * d + 2] += w2 * __builtin_amdgcn_cvt_scalef32_pk_f32_fp4(buf[k][d], 1.0f, 2);
            p2[4 * d + 3] += w2 * __builtin_amdgcn_cvt_scalef32_pk_f32_fp4(buf[k][d], 1.0f, 3);
        }
        asm volatile("" : "+v"(p2[0]), "+v"(p2[1]), "+v"(p2[2]), "+v"(p2[3]), "+v"(p2[4]), "+v"(p2[5]), "+v"(p2[6]), "+v"(p2[7]),
                          "+v"(p2[8]), "+v"(p2[9]), "+v"(p2[10]), "+v"(p2[11]), "+v"(p2[12]), "+v"(p2[13]), "+v"(p2[14]), "+v"(p2[15]));
    }
    float p[32];
#pragma unroll
    for (int i = 0; i < 16; ++i) { p[2 * i] = p2[i].x; p[2 * i + 1] = p2[i].y; }
    bfly_swap32<16>(p); bfly_swap16<8>(p); bfly_ror8<4>(p, lane);
    const int col = 256 * sl + 32 * c + 4 * g;
    u32x2 ho;
    ho.x = pk2(bflo(hv.x) + __uint_as_float(gt.x) * p[0], bfhi(hv.x) + __uint_as_float(gt.y) * p[1]);
    ho.y = pk2(bflo(hv.y) + __uint_as_float(gt.z) * p[2], bfhi(hv.y) + __uint_as_float(gt.w) * p[3]);
    *(u32x2*)(hrow(P, t) + col) = ho;
}
DEV void phase_experts(const Params& P, int layer, int nrows, ldsp lds0) {
    const unsigned char* tabu = P.ws + OFF_TAB + (size_t)(layer * 2) * 16 * MiB;
    const unsigned char* tabv = tabu + 16 * MiB;
    const bf16_t* seli = (const bf16_t*)(P.ws + OFF_SELI);
    const float* selg = (const float*)(P.ws + OFF_SELG);
    const float* rsu = (const float*)(P.ws + OFF_RSC) + (size_t)(layer * 2) * 16384;
    const float* rsv = rsu + 16384;
    const float* xsv = (const float*)(P.ws + OFF_XS);
    const float* gatev = (const float*)(P.ws + OFF_MODV) + (size_t)layer * 9 * 6144 + 5 * 1024;
    const int tid = tid_fresh(), wave = __builtin_amdgcn_readfirstlane(tid >> 6), lane = tid & 63, g = lane >> 3, c = lane & 7;
    const int gw = blockIdx.x * 8 + wave, nwv = gridDim.x * 8;
    if (gw >= nrows) return;
    const int ntok = (nrows - gw + nwv - 1) / nwv, U = 4 * ntok;
    LAS float* accs = (LAS float*)(launder(lds0) + wave * 8192);
    for (int k = 0; k < ntok; ++k) *(LAS f32x2*)(accs + k * 128 + 2 * lane) = (f32x2){0.f, 0.f};
    u32x4 bufA[16], bufB[16], idn[2];
    int ku = 0, slu = 0;
#define EU_NEXT_IDX() do { const int tt = gw + ku * nwv; _Pragma("unroll") for (int q = 0; q < 2; ++q) idn[q] = *(const u32x4*)(seli + (size_t)tt * 128 + 16 * g + 8 * q); } while (0)
#define EU_ADVANCE() do { if (++ku == ntok) { ku = 0; ++slu; } } while (0)
    int kA, slA, kB = 0, slB = 0;
    {
        u32x4 xqA[2], xqB[2];
        EU_NEXT_IDX();
        kA = ku; slA = slu; eu_issue_unit(bufA, xqA, idn, tabu, P, gw + kA * nwv, slA, c); EU_ADVANCE();
        if (U > 1) EU_NEXT_IDX();
        for (int u = 0; u < U; u += 2) {
            if (u + 1 < U) { kB = ku; slB = slu; eu_issue_unit(bufB, xqB, idn, tabu, P, gw + kB * nwv, slB, c); EU_ADVANCE(); if (u + 2 < U) EU_NEXT_IDX(); }
            eu_compute_unit(bufA, xqA, accs + kA * 128 + 2 * lane, lane);
            if (u + 1 >= U) break;
            if (u + 2 < U) { kA = ku; slA = slu; eu_issue_unit(bufA, xqA, idn, tabu, P, gw + kA * nwv, slA, c); EU_ADVANCE(); if (u + 3 < U) EU_NEXT_IDX(); }
            eu_compute_unit(bufB, xqB, accs + kB * 128 + 2 * lane, lane);
        }
    }
    u32x2 hvA, hvB; u32x4 gtA, gtB;
    ku = 0; slu = 0;
    EU_NEXT_IDX();
    kA = ku; slA = slu; ev_issue_unit(bufA, hvA, gtA, idn, tabv, P, gatev, gw + kA * nwv, slA, g, c); EU_ADVANCE();
    if (U > 1) EU_NEXT_IDX();
    for (int k = 0; k < ntok; ++k) {
        const int t = gw + k * nwv;
        const unsigned ep = *(const unsigned*)(seli + (size_t)t * 128 + 2 * lane);
        const f32x2 gt = *(const f32x2*)(selg + (size_t)t * 128 + 2 * lane);
        const f32x2 a2 = *(const LAS f32x2*)(accs + k * 128 + 2 * lane);
        const int e0 = (int)(ep & 0xffffu), e1 = (int)(ep >> 16);
        const float xs = xsv[t];
        const float h0 = a2.x * xs * rsu[e0], h1 = a2.y * xs * rsu[e1];
        f32x2 w;
        w.x = gt.x * (0.5f * h0 * (1.f + erff(h0 * 0.70710678118654752f))) * rsv[e0];
        w.y = gt.y * (0.5f * h1 * (1.f + erff(h1 * 0.70710678118654752f))) * rsv[e1];
        *(LAS f32x2*)(accs + k * 128 + 2 * lane) = w;
    }
    for (int u = 0; u < U; u += 2) {
        if (u + 1 < U) { kB = ku; slB = slu; ev_issue_unit(bufB, hvB, gtB, idn, tabv, P, gatev, gw + kB * nwv, slB, g, c); EU_ADVANCE(); if (u + 2 < U) EU_NEXT_IDX(); }
        ev_compute_unit(bufA, hvA, gtA, accs + kA * 128 + 16 * g, P, gw + kA * nwv, slA, lane, g, c);
        if (u + 1 >= U) break;
        if (u + 2 < U) { kA = ku; slA = slu; ev_issue_unit(bufA, hvA, gtA, idn, tabv, P, gatev, gw + kA * nwv, slA, g, c); EU_ADVANCE(); if (u + 3 < U) EU_NEXT_IDX(); }
        ev_compute_unit(bufB, hvB, gtB, accs + kB * 128 + 16 * g, P, gw + kB * nwv, slB, lane, g, c);
    }
#undef EU_NEXT_IDX
#undef EU_ADVANCE
}
DEV void phase_experts_act(const Params& P, int layer, int nrows) {
    const bf16_t* seli = (const bf16_t*)(P.ws + OFF_SELI);
    const float* selg = (const float*)(P.ws + OFF_SELG);
    const float* part = (const float*)(P.ws + OFF_PART);
    bf16_t* wexp = (bf16_t*)(P.ws + OFF_WEXP);
    const float* rsu = (const float*)(P.ws + OFF_RSC) + (size_t)(layer * 2) * 16384;
    const float* rsv = rsu + 16384;
    const int tid = tid_fresh();
    const int n4 = nrows * 32;
    for (int i4 = blockIdx.x * NTHREADS + tid; i4 < n4; i4 += gridDim.x * NTHREADS) {
        const size_t idx = (size_t)i4 * 4;
        f32x4 h = {0.f, 0.f, 0.f, 0.f};
#pragma unroll
        for (int s = 0; s < 4; ++s) { const u32x2 pv = *(const u32x2*)((const bf16_t*)part + (size_t)s * NT * 128 + idx); h += (f32x4){bflo(pv.x), bfhi(pv.x), bflo(pv.y), bfhi(pv.y)}; }
        const u32x2 e = *(const u32x2*)(seli + idx);
        const f32x4 gt = *(const f32x4*)(selg + idx);
        const int ee[4] = {(int)(e.x & 0xffffu), (int)(e.x >> 16), (int)(e.y & 0xffffu), (int)(e.y >> 16)};
        f32x4 o;
#pragma unroll
        for (int q = 0; q < 4; ++q) {
            const float hh = h[q] * rsu[ee[q]];
            o[q] = gt[q] * (0.5f * hh * (1.f + erff(hh * 0.70710678118654752f))) * rsv[ee[q]];
        }
        u32x2 ow; ow.x = pk2(o[0], o[1]); ow.y = pk2(o[2], o[3]);
        *(u32x2*)(wexp + idx) = ow;
    }
}
DEV void phase_final(const Params& P) {
    const int tid = tid_fresh(), wave = tid >> 6, lane = tid & 63;
    for (int r = blockIdx.x * 8 + wave; r < NX; r += gridDim.x * 8) {
        float* h = P.out + (size_t)r * 1024;
        f32x4 v[4]; float ss = 0.f;
#pragma unroll
        for (int j = 0; j < 4; ++j) { const u32x2 hv = *(const u32x2*)(hrow(P, r) + j * 256 + lane * 4); v[j] = (f32x4){bflo(hv.x), bfhi(hv.x), bflo(hv.y), bfhi(hv.y)};
            ss += v[j].x * v[j].x + v[j].y * v[j].y + v[j].z * v[j].z + v[j].w * v[j].w; }
        ss = wave_sum(ss);
        const float rstd = rsqrtf(ss * (1.f / 1024.f) + EPS);
#pragma unroll
        for (int j = 0; j < 4; ++j) { const f32x4 gg = *(const f32x4*)(P.final_g + j * 256 + lane * 4); __builtin_nontemporal_store(v[j] * rstd * gg, (f32x4*)(h + j * 256 + lane * 4)); }
    }
}

DEV void phase_conv(const Params& P) {
    const bf16_t* Pq = (const bf16_t*)(P.ws + OFF_R1);
    const float* ab = (const float*)(P.ws + OFF_AB);
    bf16_t* dst[3] = {(bf16_t*)(P.ws + OFF_QC), (bf16_t*)(P.ws + OFF_KC), (bf16_t*)(P.ws + OFF_VC)};
    float* gbuf = (float*)(P.ws + OFF_G);
    float* bbuf = (float*)(P.ws + OFF_BETA);
    const int tid = tid_fresh(), wave = tid >> 6, lane = tid & 63;
    constexpr int NSEG = NT / 16;
    for (int item = blockIdx.x * 8 + wave; item < NSEG * 6; item += gridDim.x * 8) {
        const int seg = item / 6, jc = item - seg * 6, row0 = seg * 16;
        int t0, L;
        if (row0 < NX) { t0 = row0 & 2047; L = 2048; } else { t0 = (row0 - NX) & 255; L = 256; }
        const int chunk = lane + 64 * jc, col = chunk * 8, part = jc >> 1;
        f32x4 w0[5], w1[5];
#pragma unroll
        for (int tap = 0; tap < 5; ++tap) { w0[tap] = *(const f32x4*)(P.dn_conv_w + tap * 3072 + col); w1[tap] = *(const f32x4*)(P.dn_conv_w + tap * 3072 + col + 4); }
        u32x4 raw[20];
#pragma unroll
        for (int i = 0; i < 20; ++i) {
            const int tt = t0 + i - 2;
            const bool ok = tt >= 0 && tt < L;
            const u32x4 v = *(const u32x4*)(Pq + (size_t)(row0 + (ok ? i - 2 : 0)) * 3072 + col);
            raw[i] = ok ? v : (u32x4){0u, 0u, 0u, 0u};
        }
        const float qs = part == 0 ? 0.08838834764831845f : 1.f;
        bf16_t* dp = dst[part] + (size_t)row0 * 1024 + (chunk & 127) * 8;
#pragma unroll
        for (int i = 0; i < 16; ++i) {
            float acc[8];
#pragma unroll
            for (int e = 0; e < 8; ++e) acc[e] = 0.f;
#pragma unroll
            for (int tap = 0; tap < 5; ++tap) {
                float f[8]; unpack8(raw[i + tap], f);
                acc[0] += f[0] * w0[tap].x; acc[1] += f[1] * w0[tap].y; acc[2] += f[2] * w0[tap].z; acc[3] += f[3] * w0[tap].w;
                acc[4] += f[4] * w1[tap].x; acc[5] += f[5] * w1[tap].y; acc[6] += f[6] * w1[tap].z; acc[7] += f[7] * w1[tap].w;
            }
            float ss = 0.f;
#pragma unroll
            for (int e = 0; e < 8; ++e) { acc[e] = silu(acc[e]); ss += acc[e] * acc[e]; }
            if (part < 2) {
                ss = sum16(ss);
                const float rn = rsqrtf(ss + EPS) * qs;
#pragma unroll
                for (int e = 0; e < 8; ++e) acc[e] *= rn;
            }
            u32x4 o; o.x = pk2(acc[0], acc[1]); o.y = pk2(acc[2], acc[3]); o.z = pk2(acc[4], acc[5]); o.w = pk2(acc[6], acc[7]);
            *(u32x4*)(dp + (size_t)i * 1024) = o;
        }
        if (jc == 0) {
            const int cc = lane & 31, d = cc >> 4, sx = (cc >> 3) & 1, h = cc & 7;
            const float a = __expf(P.dn_a_log[d * 8 + h]), dtb = P.dn_dt_bias[d * 8 + h];
            float v[8];
#pragma unroll
            for (int q = 0; q < 8; ++q) v[q] = ab[(size_t)(row0 + 2 * q + (lane >> 5)) * 32 + cc];
#pragma unroll
            for (int q = 0; q < 8; ++q) {
                const int row = row0 + 2 * q + (lane >> 5);
                if (sx == 0) {
                    const float xx = v[q] + dtb;
                    const float ex = __expf(fminf(xx, 30.f)), u = 1.f + ex;
                    const float l1p = (u == 1.f) ? ex : __logf(u) * ex * __builtin_amdgcn_rcpf(u - 1.f);
                    const float sp = xx > 20.f ? xx : l1p;
                    gbuf[((size_t)d * NT + row) * 8 + h] = -a * sp;
                } else {
                    bbuf[((size_t)d * NT + row) * 8 + h] = __builtin_amdgcn_rcpf(1.f + __expf(-v[q]));
                }
            }
        }
    }
}

DEV int chunk_rowbase(int b, int d, int n) {
    if (n < 4) { const int m = d ? 3 - n : n; return NX + b * 256 + m * 64; }
    const int m = d ? 31 - (n - 4) : n - 4; return b * 2048 + m * 64;
}

DEV bf16x8 frag_col_x(ldsp x, int c0, int k0, int lane) {
    const int col = c0 + (lane & 31), ch = col >> 3, sub = (col & 7) * 2;
    bf16x8 f;
#pragma unroll
    for (int j = 0; j < 8; ++j) { const int row = k0 + 8 * (lane >> 5) + j; f[j] = (short)*(const LAS bf16_t*)(x + row * 256 + ((ch ^ (row & 15)) << 4) + sub); }
    return f;
}
DEV void tile_rows8(const f32x16& acc, u32x4& o0, u32x4& o1) {
    unsigned p[4][2];
#pragma unroll
    for (int rg = 0; rg < 4; ++rg) { p[rg][0] = pk2(acc[rg * 4 + 0], acc[rg * 4 + 1]); p[rg][1] = pk2(acc[rg * 4 + 2], acc[rg * 4 + 3]); }
    const auto s00 = __builtin_amdgcn_permlane32_swap(p[0][0], p[2][0], false, false), s01 = __builtin_amdgcn_permlane32_swap(p[0][1], p[2][1], false, false);
    const auto s10 = __builtin_amdgcn_permlane32_swap(p[1][0], p[3][0], false, false), s11 = __builtin_amdgcn_permlane32_swap(p[1][1], p[3][1], false, false);
    o0 = (u32x4){s00[0], s01[0], s00[1], s01[1]};
    o1 = (u32x4){s10[0], s11[0], s10[1], s11[1]};
}
DEV bf16x8 frag_row_t(ldsp t, int r0, int k0, int lane) {
    const int row = r0 + (lane & 31), ch = (k0 >> 3) + (lane >> 5);
    return *(const LAS bf16x8*)(t + row * 128 + ((ch ^ (row & 7)) << 4));
}
DEV void phase_chunk(const Params& P, ldsp lds0) {
    const bf16_t* kc = (const bf16_t*)(P.ws + OFF_KC);
    const bf16_t* vc = (const bf16_t*)(P.ws + OFF_VC);
    const float* gbuf = (const float*)(P.ws + OFF_G);
    const float* bbuf = (const float*)(P.ws + OFF_BETA);
    bf16_t* wbuf = (bf16_t*)(P.ws + OFF_WBUF);
    bf16_t* ubuf = (bf16_t*)(P.ws + OFF_UBUF);
    float* gcbuf = (float*)(P.ws + OFF_GC);
    const int tid = tid_fresh(), lane = tid & 63, wave = tid >> 6, team = wave >> 1, tw = wave & 1, ttid = tid & 127;
    const int nteams = gridDim.x * 4, niter = (4608 + nteams - 1) / nteams;
    u32x4 rk[8];
    {
        const int item0 = min((int)(blockIdx.x * 4 + team), 4607);
        const int n = item0 % 36, d = (item0 / 36) & 1, bh = item0 / 72, rb0 = chunk_rowbase(bh >> 3, d, n);
#pragma unroll
        for (int j = 0; j < 8; ++j) { const int cid = ttid + 128 * j, i = cid >> 4, ch = cid & 15; rk[j] = *(const u32x4*)(kc + ((size_t)rb0 + (d ? 63 - i : i)) * 1024 + (bh & 7) * 128 + ch * 8); }
    }
    for (int it = 0; it < niter; ++it) {
        const int item = it * nteams + blockIdx.x * 4 + team;
        const bool act = item < 4608;
        const ldsp lds = launder(lds0);
        const ldsp sX = lds + team * 32768;
        const ldsp sT = sX + 16384;
        LAS float* sA = (LAS float*)sT;
        LAS float* sg = (LAS float*)(lds + 131072 + 128 + team * 768);
        const int n = item % 36, d = (item / 36) & 1, bh = item / 72, b = bh >> 3, h = bh & 7;
        const int rowbase = act ? chunk_rowbase(b, d, n) : 0;
        if (act) {
#pragma unroll
            for (int j = 0; j < 8; ++j) { const int cid = ttid + 128 * j, i = cid >> 4, ch = cid & 15; *(LAS u32x4*)(sX + i * 256 + ((ch ^ (i & 15)) << 4)) = rk[j]; }
            if (tw == 0) {
                const size_t grow = (size_t)rowbase + (d ? 63 - lane : lane);
                float v = gbuf[((size_t)d * NT + grow) * 8 + h];
#pragma unroll
                for (int o = 1; o < 64; o <<= 1) { const float t = __shfl_up(v, o); if (lane >= o) v += t; }
                sg[lane] = v; sg[64 + lane] = bbuf[((size_t)d * NT + grow) * 8 + h];
            }
        }
        __syncthreads();
        if (act) {
#pragma unroll 1
            for (int q = 0; q < 2; ++q) {
                const int mt = tw, nt = q;
                f32x16 acc = zero16();
#pragma unroll 4
                for (int ks = 0; ks < 8; ++ks) acc = mfma32(frag_row_x(sX, mt * 32, ks * 16, lane), frag_row_x(sX, nt * 32, ks * 16, lane), acc);
#pragma unroll
                for (int reg = 0; reg < 16; ++reg) {
                    const int i = mt * 32 + crow(reg, lane), j = nt * 32 + (lane & 31);
                    sA[i * 64 + j] = (i > j) ? sg[64 + i] * acc[reg] * __expf(sg[i] - sg[j]) : 0.f;
                }
            }
        }
        __syncthreads();
        if (act && tw == 0) {
            float t[64];
            int ln = lane; asm volatile("" : "+v"(ln));
#pragma unroll
            for (int i = 0; i < 64; ++i) {
                float a0 = (i == ln) ? 1.f : 0.f, a1 = 0.f, a2 = 0.f, a3 = 0.f;
#pragma unroll
                for (int j = 0; j < i; j += 4) {
                    const f32x4 av = *(const LAS f32x4*)(sA + i * 64 + j);
                    a0 -= av.x * t[j];
                    if (j + 1 < i) a1 -= av.y * t[j + 1];
                    if (j + 2 < i) a2 -= av.z * t[j + 2];
                    if (j + 3 < i) a3 -= av.w * t[j + 3];
                }
                t[i] = (a0 + a1) + (a2 + a3);
                __builtin_amdgcn_sched_barrier(0);
            }
            const float cu = sg[64 + lane], cw = cu * __expf(sg[lane]);
            const int ch = lane >> 3, sub = (lane & 7) * 2;
#pragma unroll
            for (int i = 0; i < 64; ++i) {
                const int off = i * 128 + ((ch ^ (i & 7)) << 4) + sub;
                *(LAS bf16_t*)(sT + off) = f2bf(t[i] * cw);
                *(LAS bf16_t*)(sT + 8192 + off) = f2bf(t[i] * cu);
                if ((i & 7) == 7) __builtin_amdgcn_sched_barrier(0);
            }
        }
        __syncthreads();
            {
                const int itemn = min(item + nteams, 4607);
                const int nn = itemn % 36, dn = (itemn / 36) & 1, bhn = itemn / 72, rbn = chunk_rowbase(bhn >> 3, dn, nn);
#pragma unroll
                for (int j = 0; j < 8; ++j) { const int cid = ttid + 128 * j, i = cid >> 4, ch = cid & 15; rk[j] = *(const u32x4*)(kc + ((size_t)rbn + (dn ? 63 - i : i)) * 1024 + (bhn & 7) * 128 + ch * 8); }
            }
        u32x4 rv[8];
        if (act) {
#pragma unroll
            for (int j = 0; j < 8; ++j) {
                const int cid = ttid + 128 * j, i = cid >> 4, ch = cid & 15;
                const size_t grow = (size_t)rowbase + (d ? 63 - i : i);
                rv[j] = *(const u32x4*)(vc + grow * 1024 + h * 128 + ch * 8);
            }
#pragma unroll 1
            for (int q = 0; q < 2; ++q) {
                const int mtk = 2 * tw + q;
                f32x16 acc[2]; acc[0] = zero16(); acc[1] = zero16();
#pragma unroll
                for (int ks = 0; ks < 4; ++ks) {
                    const bf16x8 afr = frag_col_x(sX, mtk * 32, ks * 16, lane);
#pragma unroll
                    for (int it2 = 0; it2 < 2; ++it2) acc[it2] = mfma32(afr, frag_row_t(sT, it2 * 32, ks * 16, lane), acc[it2]);
                }
                bf16_t* dstp = wbuf + (size_t)item * 8192;
#pragma unroll
                for (int it2 = 0; it2 < 2; ++it2) {
                    u32x4 o0, o1; tile_rows8(acc[it2], o0, o1);
                    bf16_t* rp = dstp + (it2 * 32 + (lane & 31)) * 128 + mtk * 32 + 16 * (lane >> 5);
                    *(u32x4*)rp = o0; *(u32x4*)(rp + 8) = o1;
                }
            }
        }
        __syncthreads();
        if (act) {
#pragma unroll
            for (int j = 0; j < 8; ++j) { const int cid = ttid + 128 * j, i = cid >> 4, ch = cid & 15; *(LAS u32x4*)(sX + i * 256 + ((ch ^ (i & 15)) << 4)) = rv[j]; }
        }
        __syncthreads();
        if (act) {
#pragma unroll 1
            for (int q = 0; q < 2; ++q) {
                const int nt = 2 * tw + q;
                f32x16 acc[2]; acc[0] = zero16(); acc[1] = zero16();
#pragma unroll
                for (int ks = 0; ks < 4; ++ks) {
                    const bf16x8 bfr = frag_col_x(sX, nt * 32, ks * 16, lane);
#pragma unroll
                    for (int mt = 0; mt < 2; ++mt) acc[mt] = mfma32(frag_row_t(sT + 8192, mt * 32, ks * 16, lane), bfr, acc[mt]);
                }
                bf16_t* dstp = ubuf + (size_t)item * 8192;
#pragma unroll
                for (int mt = 0; mt < 2; ++mt) {
                    u32x4 o0, o1; tile_rows8(acc[mt], o0, o1);
                    bf16_t* rp = dstp + (nt * 32 + (lane & 31)) * 64 + mt * 32 + 16 * (lane >> 5);
                    *(u32x4*)rp = o0; *(u32x4*)(rp + 8) = o1;
                }
            }
            if (tw == 0) gcbuf[(size_t)item * 64 + lane] = sg[lane];
        }
        __syncthreads();
    }
}

DEV u32x2 pack4(float a, float b, float c, float d) { u32x2 o; o.x = pk2(a, b); o.y = pk2(c, d); return o; }
DEV void phase_scan(const Params& P, ldsp lds0) {
    const bf16_t* qc = (const bf16_t*)(P.ws + OFF_QC);
    const bf16_t* kc = (const bf16_t*)(P.ws + OFF_KC);
    const bf16_t* wbuf = (const bf16_t*)(P.ws + OFF_WBUF);
    const bf16_t* ubuf = (const bf16_t*)(P.ws + OFF_UBUF);
    const float* gcbuf = (const float*)(P.ws + OFF_GC);
    bf16_t* obuf = (bf16_t*)(P.ws + OFF_OBUF);
    const int tid = tid_fresh(), lane = tid & 63, wave = tid >> 6;
    const int mt = wave >> 1, nt = wave & 1;
    const int mt2 = (wave & 3) >> 1, nt2 = wave & 1;
    for (int item = blockIdx.x; item < 256; item += gridDim.x) {
        const int half = item & 1, d = (item >> 1) & 1, bh = item >> 2, b = bh >> 3, h = bh & 7;
        f32x16 S = zero16();
        { LAS unsigned* z = (LAS unsigned*)(lds0 + 1024 + 3 * 17408 + 9216); for (int e = tid; e < 64 * 136 / 2; e += NTHREADS) z[e] = 0u; }
        u32x4 rW[2][2], rK[2][2], rQ[2][2], rU[2]; float rG[2] = {0.f, 0.f};
#pragma unroll
        for (int u = 0; u < 2; ++u) {
            const int citem = (bh * 2 + d) * 36 + u, rowbase = chunk_rowbase(b, d, u);
#pragma unroll
            for (int j = 0; j < 2; ++j) {
                const int cid = tid + NTHREADS * j, i = cid >> 4, ch = cid & 15;
                const size_t grow = (size_t)rowbase + (d ? 63 - i : i);
                rW[u][j] = *(const u32x4*)(wbuf + (size_t)citem * 8192 + i * 128 + ch * 8);
                rK[u][j] = *(const u32x4*)(kc + grow * 1024 + h * 128 + ch * 8);
                rQ[u][j] = rK[u][j];
            }
            { const int dvr = tid >> 3, ch = tid & 7; rU[u] = *(const u32x4*)(ubuf + (size_t)citem * 8192 + (half * 64 + dvr) * 64 + ch * 8); }
            if (tid < 64) rG[u] = gcbuf[(size_t)citem * 64 + tid];
        }
        for (int n2 = 0; n2 < 36; n2 += 2) {
#pragma unroll
        for (int u = 0; u < 2; ++u) {
            const int n = n2 + u;
            const ldsp lds = launder(lds0);
            int ln = lane; asm volatile("" : "+v"(ln));
            LAS float* sg = (LAS float*)lds;
            LAS bf16_t* sW = (LAS bf16_t*)(lds + 1024);
            LAS bf16_t* sK = sW + 64 * 136;
            LAS bf16_t* sQ = sK + 64 * 136;
            LAS bf16_t* sU = sQ + 64 * 136;
            LAS bf16_t* sST = sU + 64 * 72;
            LAS bf16_t* sVNT = sST + 64 * 136;
            LAS bf16_t* sVNsT = sVNT + 64 * 72;
            LAS bf16_t* sATT = sVNsT + 64 * 72;
            LAS bf16_t* sO = sATT + 64 * 72;
            const int rowbase = chunk_rowbase(b, d, n);
            const bool wantO = n >= 4;
#pragma unroll
            for (int j = 0; j < 2; ++j) {
                const int cid = tid + NTHREADS * j, i = cid >> 4, ch = cid & 15;
                *(LAS u32x4*)(sW + i * 136 + ch * 8) = rW[u][j];
                *(LAS u32x4*)(sK + i * 136 + ch * 8) = rK[u][j];
                *(LAS u32x4*)(sQ + i * 136 + ch * 8) = rQ[u][j];
            }
            { const int i = tid >> 3, ch = tid & 7; *(LAS u32x4*)(sU + i * 72 + ch * 8) = rU[u]; }
            if (tid < 64) sg[tid] = rG[u];
            __syncthreads();
            if (n + 2 < 36) {
                const int citem = (bh * 2 + d) * 36 + n + 2, rb1 = chunk_rowbase(b, d, n + 2);
                const bool wq = n + 2 >= 4;
#pragma unroll
                for (int j = 0; j < 2; ++j) {
                    const int cid = tid + NTHREADS * j, i = cid >> 4, ch = cid & 15;
                    const size_t grow = (size_t)rb1 + (d ? 63 - i : i);
                    rW[u][j] = *(const u32x4*)(wbuf + (size_t)citem * 8192 + i * 128 + ch * 8);
                    rK[u][j] = *(const u32x4*)(kc + grow * 1024 + h * 128 + ch * 8);
                    if (wq) rQ[u][j] = *(const u32x4*)(qc + grow * 1024 + h * 128 + ch * 8);
                }
                { const int dvr = tid >> 3, ch = tid & 7; rU[u] = *(const u32x4*)(ubuf + (size_t)citem * 8192 + (half * 64 + dvr) * 64 + ch * 8); }
                if (tid < 64) rG[u] = gcbuf[(size_t)citem * 64 + tid];
            }
            const float g63 = sg[63];
            if (wave < 4) {
                const int dv = nt2 * 32 + (ln & 31);
                float uf[16], ef[16];
#pragma unroll
                for (int rg = 0; rg < 4; ++rg) {
                    const int i0 = mt2 * 32 + 8 * rg + 4 * (ln >> 5);
                    const u32x2 uu = *(const LAS u32x2*)(sU + dv * 72 + i0);
                    const f32x4 gg = *(const LAS f32x4*)(sg + i0);
                    uf[rg * 4 + 0] = bflo(uu.x); uf[rg * 4 + 1] = bfhi(uu.x); uf[rg * 4 + 2] = bflo(uu.y); uf[rg * 4 + 3] = bfhi(uu.y);
#pragma unroll
                    for (int e = 0; e < 4; ++e) ef[rg * 4 + e] = __expf(g63 - gg[e]);
                }
                f32x16 acc = zero16(), accb = zero16();
#pragma unroll
                for (int ks = 0; ks < 8; ks += 2) { acc = mfma32(frag_row(sW, 136, mt2 * 32, ks * 16, ln), frag_row(sST, 136, nt2 * 32, ks * 16, ln), acc);
                    accb = mfma32(frag_row(sW, 136, mt2 * 32, ks * 16 + 16, ln), frag_row(sST, 136, nt2 * 32, ks * 16 + 16, ln), accb); }
#pragma unroll
                for (int rg = 0; rg < 4; ++rg) {
                    const int i0 = mt2 * 32 + 8 * rg + 4 * (ln >> 5);
                    float v[4], vs[4];
#pragma unroll
                    for (int e = 0; e < 4; ++e) { v[e] = uf[rg * 4 + e] - (acc[rg * 4 + e] + accb[rg * 4 + e]); vs[e] = v[e] * ef[rg * 4 + e]; }
                    *(LAS u32x2*)(sVNT + dv * 72 + i0) = pack4(v[0], v[1], v[2], v[3]);
                    *(LAS u32x2*)(sVNsT + dv * 72 + i0) = pack4(vs[0], vs[1], vs[2], vs[3]);
                }
            } else if (wantO) {
                const int i = nt2 * 32 + (ln & 31);
                const float gi = sg[i];
                float df[16];
#pragma unroll
                for (int rg = 0; rg < 4; ++rg) {
                    const int j0 = mt2 * 32 + 8 * rg + 4 * (ln >> 5);
                    const f32x4 gg = *(const LAS f32x4*)(sg + j0);
#pragma unroll
                    for (int e = 0; e < 4; ++e) df[rg * 4 + e] = (i >= j0 + e) ? __expf(fminf(gi - gg[e], 0.f)) : 0.f;
                }
                f32x16 acc = zero16(), accb = zero16();
#pragma unroll
                for (int ks = 0; ks < 8; ks += 2) { acc = mfma32(frag_row(sK, 136, mt2 * 32, ks * 16, ln), frag_row(sQ, 136, nt2 * 32, ks * 16, ln), acc);
                    accb = mfma32(frag_row(sK, 136, mt2 * 32, ks * 16 + 16, ln), frag_row(sQ, 136, nt2 * 32, ks * 16 + 16, ln), accb); }
#pragma unroll
                for (int rg = 0; rg < 4; ++rg) {
                    const int j0 = mt2 * 32 + 8 * rg + 4 * (ln >> 5);
                    float v[4];
#pragma unroll
                    for (int e = 0; e < 4; ++e) v[e] = (acc[rg * 4 + e] + accb[rg * 4 + e]) * df[rg * 4 + e];
                    *(LAS u32x2*)(sATT + i * 72 + j0) = pack4(v[0], v[1], v[2], v[3]);
                }
            }
            __syncthreads();
            if (wave < 4 && wantO) {
                float eg[16];
#pragma unroll
                for (int rg = 0; rg < 4; ++rg) {
                    const f32x4 gg = *(const LAS f32x4*)(sg + mt2 * 32 + 8 * rg + 4 * (ln >> 5));
#pragma unroll
                    for (int e = 0; e < 4; ++e) eg[rg * 4 + e] = __expf(gg[e]);
                }
                f32x16 a1 = zero16(), a1b = zero16(), a2 = zero16();
#pragma unroll
                for (int ks = 0; ks < 8; ks += 2) { a1 = mfma32(frag_row(sQ, 136, mt2 * 32, ks * 16, ln), frag_row(sST, 136, nt2 * 32, ks * 16, ln), a1);
                    a1b = mfma32(frag_row(sQ, 136, mt2 * 32, ks * 16 + 16, ln), frag_row(sST, 136, nt2 * 32, ks * 16 + 16, ln), a1b); }
#pragma unroll
                for (int ks = 0; ks < 4; ++ks) a2 = mfma32(frag_row(sATT, 72, mt2 * 32, ks * 16, ln), frag_row(sVNT, 72, nt2 * 32, ks * 16, ln), a2);
                const int dv = nt2 * 32 + (ln & 31);
#pragma unroll
                for (int rg = 0; rg < 4; ++rg) {
                    const int i0 = mt2 * 32 + 8 * rg + 4 * (ln >> 5);
#pragma unroll
                    for (int e = 0; e < 4; ++e) sO[(i0 + e) * 72 + dv] = f2bf((a1[rg * 4 + e] + a1b[rg * 4 + e]) * eg[rg * 4 + e] + a2[rg * 4 + e]);
                }
            }
            {
                const float gl = __expf(g63);
#pragma unroll
                for (int reg = 0; reg < 16; ++reg) S[reg] *= gl;
#pragma unroll
                for (int ks = 0; ks < 4; ++ks) S = mfma32(frag_col_tr(sK, 136, mt * 32, ks * 16, ln), frag_row(sVNsT, 72, nt * 32, ks * 16, ln), S);
            }
            __syncthreads();
            if (wantO) {
                const int i = tid >> 3, ch = tid & 7;
                const size_t grow = (size_t)rowbase + (d ? 63 - i : i);
                *(u32x4*)(obuf + ((size_t)d * NX + grow) * 1024 + h * 128 + half * 64 + ch * 8) = *(const LAS u32x4*)(sO + i * 72 + ch * 8);
            }
#pragma unroll
            for (int rg = 0; rg < 4; ++rg) {
                const int dk0 = mt * 32 + 8 * rg + 4 * (ln >> 5);
                *(LAS u32x2*)(sST + (nt * 32 + (ln & 31)) * 136 + dk0) = pack4(S[rg * 4 + 0], S[rg * 4 + 1], S[rg * 4 + 2], S[rg * 4 + 3]);
            }
        }
        }
        __syncthreads();
    }
}

DEV void phase_dnout(const Params& P) {
    const bf16_t* obuf = (const bf16_t*)(P.ws + OFF_OBUF);
    const bf16_t* Pz = (const bf16_t*)(P.ws + OFF_PZ);
    bf16_t* A = (bf16_t*)(P.ws + OFF_A);
    const int tid = tid_fresh(); const int wave = tid >> 6, lane = tid & 63;
    for (int row = blockIdx.x * 8 + wave; row < NX; row += gridDim.x * 8) {
#pragma unroll
        for (int c = 0; c < 2; ++c) {
            const int col = c * 512 + lane * 8;
            const u32x4 of = *(const u32x4*)(obuf + (size_t)row * 1024 + col), ob = *(const u32x4*)(obuf + ((size_t)NX + row) * 1024 + col);
            const u32x4 zz = *(const u32x4*)(Pz + (size_t)row * 1024 + col);
            float o[8], o2[8], z[8]; unpack8(of, o); unpack8(ob, o2); unpack8(zz, z);
            float ss = 0.f;
#pragma unroll
            for (int e = 0; e < 8; ++e) { o[e] += o2[e]; ss += o[e] * o[e]; }
            ss = sum16(ss);
            const float rn = rsqrtf(ss * (1.f / 128.f) + EPS);
            float y[8];
#pragma unroll
            for (int e = 0; e < 8; ++e) y[e] = o[e] * rn * P.dn_norm_g[(col & 127) + e] * silu(z[e]);
            u32x4 ov; ov.x = pk2(y[0], y[1]); ov.y = pk2(y[2], y[3]); ov.z = pk2(y[4], y[5]); ov.w = pk2(y[6], y[7]);
            *(u32x4*)(A + (size_t)row * 1024 + col) = ov;
        }
    }
}

namespace pg8 {
#define PG8_LAS __attribute__((address_space(3)))
typedef unsigned short bf16_t;
typedef short bf16x8 __attribute__((ext_vector_type(8)));
typedef float f32x4 __attribute__((ext_vector_type(4)));
typedef unsigned u32x4 __attribute__((ext_vector_type(4)));
constexpr int BM = 256, BK = 64, HALF = 128, HTB = HALF * BK * 2  , STAGE_BYTES = 8 * HTB, NXCD = 8, WGM = 8;

__host__ __device__ __forceinline__ int lds_byte(int r, int c) { const int st = (r >> 4) * 2 + (c >> 5), rr = r & 15, cc = c & 31, ob = rr * 64 + cc * 2; return st * 1024 + (ob ^ (((ob >> 9) & 1) << 5)); }
__host__ __device__ __forceinline__ void stage_rc(int b, int& R, int& C) { const int st = b / 1024, sb = b % 1024, swz = sb ^ (((sb >> 9) & 1) << 5); R = (st >> 1) * 16 + swz / 64; C = (st & 1) * 32 + (swz % 64) / 2; }
__host__ __device__ __forceinline__ int perm32(int rho) { const int n = rho >> 4, i = rho & 15; return 8 * (i >> 2) + 4 * n + (i & 3); }

struct Unit { int pm, pn; };
struct Gemm { const bf16_t* A; const bf16_t* Bt; int M, N, K; };

struct StaticOrder {
    int nM, nN, nwg, G, c;
    __host__ __device__ void init(int M, int N, int G_, int c_) { nM = M / BM; nN = N / BM; nwg = nM * nN; G = G_; c = c_; }
    __host__ __device__ bool next(int i, Unit& u) const {
        const long L = (long)i * G + c; if (L >= nwg) return false;
        int wgid = (int)L; { const int q = nwg / NXCD, r = nwg % NXCD, xcd = wgid % NXCD, off = wgid / NXCD; wgid = (xcd < r ? xcd * (q + 1) : r * (q + 1) + (xcd - r) * q) + off; }
        const int nig = WGM * nN, gid = wgid / nig, fm = gid * WGM, gsz = (nM - fm) < WGM ? (nM - fm) : WGM;
        u.pm = fm + ((wgid % nig) % gsz); u.pn = (wgid % nig) / gsz; return true;
    }
    __device__ __forceinline__ void a_ready(const Unit&) const {}
    __device__ __forceinline__ void done(const Unit&) const {}
};

__device__ __forceinline__ unsigned cvt_pk_bf16(float lo, float hi) { typedef float v2f __attribute__((ext_vector_type(2))); typedef __bf16 v2b __attribute__((ext_vector_type(2))); const v2f v = {lo, hi}; return __builtin_bit_cast(unsigned, __builtin_convertvector(v, v2b)); }
__device__ __forceinline__ u32x4 pack8(const f32x4 v0, const f32x4 v1) { u32x4 w; w.x = cvt_pk_bf16(v0[0], v0[1]); w.y = cvt_pk_bf16(v0[2], v0[3]); w.z = cvt_pk_bf16(v1[0], v1[1]); w.w = cvt_pk_bf16(v1[2], v1[3]); return w; }
struct EpiQ {
    static constexpr bool PERM = true, AFTER_DRAIN = false;
    bf16_t* O; int ldc;
    __device__ __forceinline__ void operator()(const f32x4 (&acc)[2][2][4][2], const Unit& u, int wr, int wc, int fr, int fq) const {
        const int row0 = u.pm * BM + wr * 64 + fr, col0 = u.pn * BM + wc * 32 + 8 * fq;
#pragma unroll
        for (int ai = 0; ai < 2; ++ai)
#pragma unroll
            for (int m = 0; m < 4; ++m) { bf16_t* rowp = O + (size_t)(row0 + ai * HALF + m * 16) * ldc + col0;
#pragma unroll
                for (int bj = 0; bj < 2; ++bj) *(u32x4*)(rowp + bj * HALF) = pack8(acc[ai][bj][m][0], acc[ai][bj][m][1]); }
    }
};
struct EpiWinP {
    static constexpr bool PERM = true, AFTER_DRAIN = false;
    bf16_t* qkv; bf16_t* z; float* ab;
    __device__ __forceinline__ void operator()(const f32x4 (&acc)[2][2][4][2], const Unit& u, int wr, int wc, int fr, int fq) const {
        const int row0 = u.pm * BM + wr * 64 + fr;
        if (u.pn < 16) {
            bf16_t* base = u.pn < 12 ? qkv : z; const int ldc = u.pn < 12 ? 3072 : 1024, col0 = (u.pn < 12 ? u.pn : u.pn - 12) * BM + wc * 32 + 8 * fq;
#pragma unroll
            for (int ai = 0; ai < 2; ++ai)
#pragma unroll
                for (int m = 0; m < 4; ++m) { bf16_t* rowp = base + (size_t)(row0 + ai * HALF + m * 16) * ldc + col0;
#pragma unroll
                    for (int bj = 0; bj < 2; ++bj) *(u32x4*)(rowp + bj * HALF) = pack8(acc[ai][bj][m][0], acc[ai][bj][m][1]); }
        } else if (wc == 0) {
#pragma unroll
            for (int ai = 0; ai < 2; ++ai)
#pragma unroll
                for (int m = 0; m < 4; ++m) { float* rowp = ab + (size_t)(row0 + ai * HALF + m * 16) * 32 + 8 * fq;
                    *(f32x4*)rowp = acc[ai][0][m][0]; *(f32x4*)(rowp + 4) = acc[ai][0][m][1]; }
        }
    }
};
struct EpiRes {
    static constexpr bool PERM = true, AFTER_DRAIN = false;
    bf16_t* h; const float* gate;
    __device__ __forceinline__ void operator()(const f32x4 (&acc)[2][2][4][2], const Unit& u, int wr, int wc, int fr, int fq) const {
        const int row0 = u.pm * BM + wr * 64 + fr, col0 = u.pn * BM + wc * 32 + 8 * fq;
#pragma unroll
        for (int ai = 0; ai < 2; ++ai)
#pragma unroll
            for (int m = 0; m < 4; ++m) { const int row = row0 + ai * HALF + m * 16; bf16_t* rowp = h + (size_t)row * 1024 + col0; const float* gp = gate + (row >> 11) * 6144 + col0;
#pragma unroll
                for (int bj = 0; bj < 2; ++bj) {
                    const u32x4 hv = *(const u32x4*)(rowp + bj * HALF);
                    const f32x4 g0 = *(const f32x4*)(gp + bj * HALF), g1 = *(const f32x4*)(gp + bj * HALF + 4);
                    const f32x4 a0 = acc[ai][bj][m][0], a1 = acc[ai][bj][m][1];
                    f32x4 n0, n1;
                    n0[0] = __uint_as_float(hv.x << 16) + g0[0] * a0[0]; n0[1] = __uint_as_float(hv.x & 0xffff0000u) + g0[1] * a0[1];
                    n0[2] = __uint_as_float(hv.y << 16) + g0[2] * a0[2]; n0[3] = __uint_as_float(hv.y & 0xffff0000u) + g0[3] * a0[3];
                    n1[0] = __uint_as_float(hv.z << 16) + g1[0] * a1[0]; n1[1] = __uint_as_float(hv.z & 0xffff0000u) + g1[1] * a1[1];
                    n1[2] = __uint_as_float(hv.w << 16) + g1[2] * a1[2]; n1[3] = __uint_as_float(hv.w & 0xffff0000u) + g1[3] * a1[3];
                    *(u32x4*)(rowp + bj * HALF) = pack8(n0, n1);
                } }
    }
};

template <class Epi, class Sched, bool ALIGN_EPI = false, bool SP2 = false>
__device__ __forceinline__ void gemm_phase(PG8_LAS unsigned char* lds, const Gemm g, const Sched& S, const Epi& E) {
    const int tid = tid_fresh(), wid = __builtin_amdgcn_readfirstlane(tid >> 6), lane = tid & 63, wr = wid >> 2, wc = wid & 3, fr = lane & 15, fq = lane >> 4;
    const int K = g.K, nt = K / BK;
    unsigned voffA[2], voffB[2];
#pragma unroll
    for (int i = 0; i < 2; ++i) { int R, C; stage_rc(tid * 16 + i * 8192, R, C); const int Rb = Epi::PERM ? ((R & ~31) + perm32(R & 31)) : R;
        voffA[i] = (unsigned)(R * K + C) * 2u; voffB[i] = (unsigned)(Rb * K + C) * 2u; }
    const size_t kstep = (size_t)(BK * 2);
    const size_t hstep = (size_t)HALF * K * 2;
    const size_t tstep = 2 * hstep;
    const unsigned ldsw = (unsigned)wid * 1024u;
    const int aoff = lds_byte(wr * 64 + fr, fq * 8), boff = lds_byte(wc * 32 + fr, fq * 8);
#define PG8_SA(b, h) (((b) * 2 + (h)) * HTB)
#define PG8_SB(b, h) ((4 + (b) * 2 + (h)) * HTB)
#define PG8_STAGE(bufoff, gbase, voff) do { _Pragma("unroll") for (int _i = 0; _i < 2; ++_i) \
        __builtin_amdgcn_global_load_lds((const unsigned*)((const char*)(gbase) + (voff)[_i]), (PG8_LAS unsigned*)(lds + (bufoff) + ldsw + _i * 8192), 16, 0, 0); } while (0)
#define PG8_LDA(dst, b, h) do { _Pragma("unroll") for (int m = 0; m < 4; ++m) _Pragma("unroll") for (int k = 0; k < 2; ++k) dst[m][k] = *(const PG8_LAS bf16x8*)(lds + PG8_SA(b, h) + aoff + m * 2048 + k * 1024); } while (0)
#define PG8_LDB(dst, b, h) do { _Pragma("unroll") for (int n = 0; n < 2; ++n) _Pragma("unroll") for (int k = 0; k < 2; ++k) dst[n][k] = *(const PG8_LAS bf16x8*)(lds + PG8_SB(b, h) + boff + n * 2048 + k * 1024); } while (0)
#define PG8_MMA(ai, bj, At, Bt) do { __builtin_amdgcn_s_setprio(1); _Pragma("unroll") for (int m = 0; m < 4; ++m) _Pragma("unroll") for (int n = 0; n < 2; ++n) _Pragma("unroll") for (int k = 0; k < 2; ++k) \
        acc[ai][bj][m][n] = __builtin_amdgcn_mfma_f32_16x16x32_bf16(Bt[n][k], At[m][k], acc[ai][bj][m][n], 0, 0, 0); __builtin_amdgcn_s_setprio(0); } while (0)
#define PG8_WAIT_V(n) asm volatile("s_waitcnt vmcnt(" #n ")" ::: "memory")
#define PG8_WAIT_L(n) asm volatile("s_waitcnt lgkmcnt(" #n ")" ::: "memory")
#define PG8_BAR __builtin_amdgcn_s_barrier()
#define PG8_SCHED __builtin_amdgcn_sched_barrier(0)
    Unit cur, nxt; int ui = 0;
    if (!S.next(0, cur)) return;
    f32x4 acc[2][2][4][2];
#pragma unroll
    for (int a = 0; a < 2; ++a)
#pragma unroll
        for (int b = 0; b < 2; ++b)
#pragma unroll
            for (int m = 0; m < 4; ++m)
#pragma unroll
                for (int n = 0; n < 2; ++n) acc[a][b][m][n] = (f32x4){0.f, 0.f, 0.f, 0.f};
    bf16x8 At[4][2], B0[2][2], B1[2][2];
    const char* cA = (const char*)g.A + (size_t)cur.pm * tstep; const char* cB = (const char*)g.Bt + (size_t)cur.pn * tstep;
    S.a_ready(cur);
    if constexpr (SP2) {
        PG8_STAGE(PG8_SB(0, 0), cB, voffB); PG8_STAGE(PG8_SB(0, 1), cB + hstep, voffB); PG8_STAGE(PG8_SA(0, 0), cA, voffA); PG8_STAGE(PG8_SA(0, 1), cA + hstep, voffA);
        if (wr == 1) PG8_BAR;
        PG8_WAIT_V(2); PG8_BAR;
        PG8_STAGE(PG8_SB(1, 0), cB + kstep, voffB); PG8_STAGE(PG8_SA(1, 0), cA + kstep, voffA); PG8_STAGE(PG8_SB(1, 1), cB + hstep + kstep, voffB);
        PG8_WAIT_V(6); PG8_BAR;
    } else {
        PG8_STAGE(PG8_SB(0, 0), cB, voffB); PG8_STAGE(PG8_SA(0, 0), cA, voffA); PG8_STAGE(PG8_SB(0, 1), cB + hstep, voffB); PG8_STAGE(PG8_SA(0, 1), cA + hstep, voffA);
        if (wr == 1) PG8_BAR;
        PG8_WAIT_V(4); PG8_BAR;
        PG8_STAGE(PG8_SB(1, 0), cB + kstep, voffB); PG8_STAGE(PG8_SA(1, 0), cA + kstep, voffA); PG8_STAGE(PG8_SB(1, 1), cB + hstep + kstep, voffB);
        PG8_WAIT_V(6); PG8_BAR;
    }
    for (;;) {
        const bool has_next = S.next(ui + 1, nxt);
        const char* nA = has_next ? (const char*)g.A + (size_t)nxt.pm * tstep : cA; const char* nB = has_next ? (const char*)g.Bt + (size_t)nxt.pn * tstep : cB;
        for (int t = 0; t < nt; t += 2) {
            const bool last = (t == nt - 2);
            const char* a1 = cA + (size_t)(t + 1) * kstep;
            const char* a2 = last ? nA : cA + (size_t)(t + 2) * kstep; const char* b2 = last ? nB : cB + (size_t)(t + 2) * kstep;
            const char* a3 = a2 + kstep; const char* b3 = b2 + kstep;
            if (last && has_next) S.a_ready(nxt);
            if constexpr (SP2) {
            PG8_LDB(B0, 0, 0); PG8_LDB(B1, 0, 1); PG8_SCHED; PG8_LDA(At, 0, 0); PG8_STAGE(PG8_SA(1, 1), a1 + hstep, voffA);
            PG8_WAIT_V(8); PG8_WAIT_L(0); PG8_BAR; PG8_MMA(0, 0, At, B0); PG8_MMA(0, 1, At, B1); PG8_BAR; PG8_SCHED;
            PG8_LDA(At, 0, 1); PG8_STAGE(PG8_SB(0, 0), b2, voffB); PG8_STAGE(PG8_SB(0, 1), b2 + hstep, voffB); PG8_STAGE(PG8_SA(0, 0), a2, voffA);
            PG8_WAIT_V(8); PG8_WAIT_L(0); PG8_BAR; PG8_MMA(1, 0, At, B0); PG8_MMA(1, 1, At, B1); PG8_BAR; PG8_SCHED;
            PG8_LDB(B0, 1, 0); PG8_LDB(B1, 1, 1); PG8_SCHED; PG8_LDA(At, 1, 0); PG8_STAGE(PG8_SA(0, 1), a2 + hstep, voffA);
            PG8_WAIT_V(8); PG8_WAIT_L(0); PG8_BAR; PG8_MMA(0, 0, At, B0); PG8_MMA(0, 1, At, B1); PG8_BAR; PG8_SCHED;
            PG8_LDA(At, 1, 1); PG8_STAGE(PG8_SB(1, 0), b3, voffB); PG8_STAGE(PG8_SB(1, 1), b3 + hstep, voffB); PG8_STAGE(PG8_SA(1, 0), a3, voffA);
            PG8_WAIT_V(8); PG8_WAIT_L(0); PG8_BAR; PG8_MMA(1, 0, At, B0); PG8_MMA(1, 1, At, B1); PG8_BAR; PG8_SCHED;
            } else {
            PG8_LDB(B0, 0, 0); PG8_SCHED; PG8_LDA(At, 0, 0); PG8_STAGE(PG8_SA(1, 1), a1 + hstep, voffA);
            PG8_WAIT_L(8); PG8_BAR; PG8_WAIT_L(0); PG8_MMA(0, 0, At, B0); PG8_BAR; PG8_SCHED;
            PG8_LDB(B1, 0, 1); PG8_STAGE(PG8_SB(0, 0), b2, voffB);
            PG8_BAR; PG8_WAIT_L(0); PG8_MMA(0, 1, At, B1); PG8_BAR;
            PG8_LDA(At, 0, 1); PG8_STAGE(PG8_SA(0, 0), a2, voffA);
            PG8_BAR; PG8_WAIT_L(0); PG8_MMA(1, 0, At, B0); PG8_BAR; PG8_SCHED;
            PG8_STAGE(PG8_SB(0, 1), b2 + hstep, voffB);
            PG8_WAIT_V(6); PG8_BAR; PG8_MMA(1, 1, At, B1); PG8_BAR;
            PG8_LDB(B0, 1, 0); PG8_SCHED; PG8_LDA(At, 1, 0); PG8_STAGE(PG8_SA(0, 1), a2 + hstep, voffA);
            PG8_WAIT_L(8); PG8_BAR; PG8_WAIT_L(0); PG8_MMA(0, 0, At, B0); PG8_BAR; PG8_SCHED;
            PG8_LDB(B1, 1, 1); PG8_STAGE(PG8_SB(1, 0), b3, voffB);
            PG8_BAR; PG8_WAIT_L(0); PG8_MMA(0, 1, At, B1); PG8_BAR;
            PG8_LDA(At, 1, 1); PG8_STAGE(PG8_SA(1, 0), a3, voffA);
            PG8_BAR; PG8_WAIT_L(0); PG8_MMA(1, 0, At, B0); PG8_BAR; PG8_SCHED;
            PG8_STAGE(PG8_SB(1, 1), b3 + hstep, voffB);
            PG8_WAIT_V(6); PG8_BAR; PG8_MMA(1, 1, At, B1); PG8_BAR;
            }
        }
        if constexpr (ALIGN_EPI) { if (wr == 0) PG8_BAR; }
        if constexpr (!Epi::AFTER_DRAIN) { E(acc, cur, wr, wc, fr, fq); S.done(cur); }
        if (!has_next) break;
#pragma unroll
        for (int a = 0; a < 2; ++a)
#pragma unroll
            for (int b = 0; b < 2; ++b)
#pragma unroll
                for (int m = 0; m < 4; ++m)
#pragma unroll
                    for (int n = 0; n < 2; ++n) acc[a][b][m][n] = (f32x4){0.f, 0.f, 0.f, 0.f};
        cur = nxt; cA = nA; cB = nB; ++ui;
        if constexpr (ALIGN_EPI) { if (wr == 1) PG8_BAR; }
    }
    PG8_WAIT_V(0);
    if constexpr (!ALIGN_EPI) { if (wr == 0) PG8_BAR; }
    PG8_BAR;
    if constexpr (Epi::AFTER_DRAIN) { E.fused(acc, cur, wr, wc, fr, fq, lds, wid, lane); S.done(cur); }
#undef PG8_SA
#undef PG8_SB
#undef PG8_STAGE
#undef PG8_LDA
#undef PG8_LDB
#undef PG8_MMA
#undef PG8_WAIT_V
#undef PG8_WAIT_L
#undef PG8_BAR
#undef PG8_SCHED
}
}

#define XB_TMO      128
#define XB_XCNT(j)  (256  + 64 * (j))
#define XB_XSUB(j)  (1280 + 64 * (j))
#define XB_XGEN(j)  (2304 + 64 * (j))
#define XB_TOP      3328
#define XB_TOPGEN   3392
#define XCD_BAR_WORDS 3456
#define XB_SPIN_CAP (1u << 22)
DEV unsigned xb_ld(unsigned* p)              { return __hip_atomic_load(p, __ATOMIC_RELAXED, __HIP_MEMORY_SCOPE_AGENT); }
DEV unsigned xb_add(unsigned* p, unsigned v) { return __hip_atomic_fetch_add(p, v, __ATOMIC_RELAXED, __HIP_MEMORY_SCOPE_AGENT); }
DEV unsigned xb_xcc_id() { return (unsigned)__builtin_amdgcn_s_getreg((3 << 11) | 20) & 0xFu; }
#define XB_SPIN(cond, bar) do { unsigned _sp = 0; while (cond) { __builtin_amdgcn_s_sleep(1); \
    if ((++_sp & 255u) == 0u) { if (xb_ld(&(bar)[XB_TMO])) break; if (_sp > XB_SPIN_CAP) { atomicAdd(&(bar)[XB_TMO], 1u); break; } } } } while (0)
struct XcdBarrier { unsigned* bar; unsigned x; volatile LAS unsigned* st; };
DEV XcdBarrier xcd_barrier_post(unsigned* bar, volatile LAS unsigned* st) {
    XcdBarrier b; b.bar = bar; b.x = xb_xcc_id(); b.st = st;
    if (threadIdx.x == 0) (void)xb_add(&bar[XB_XCNT(b.x)], 1u);
    return b;
}
DEV void xcd_barrier_complete(unsigned* bar, unsigned x, unsigned& nloc, unsigned& nx) {
    const unsigned G = gridDim.x * gridDim.y * gridDim.z;
    unsigned sum, cnt, mine, sp = 0u;
    for (;;) {
        sum = 0u; cnt = 0u; mine = 0u;
#pragma unroll
        for (unsigned j = 0; j < 16; ++j) { const unsigned c = xb_ld(&bar[XB_XCNT(j)]); sum += c; cnt += (c > 0u) ? 1u : 0u; mine = (j == x) ? c : mine; }
        if (sum == G) break;
        __builtin_amdgcn_s_sleep(1);
        if ((++sp & 255u) == 0u) { if (xb_ld(&bar[XB_TMO])) break; if (sp > XB_SPIN_CAP) { atomicAdd(&bar[XB_TMO], 1u); break; } }
    }
    nloc = mine > 0u ? mine : 1u; nx = cnt > 0u ? cnt : 1u;
}
DEV void xcd_barrier(const XcdBarrier& b) {
    asm volatile("s_waitcnt vmcnt(0)" ::: "memory");
    __syncthreads();
    if (threadIdx.x == 0) {
        unsigned* bar = b.bar;
        __builtin_amdgcn_s_waitcnt(0);
        unsigned nloc = b.st[0], nx = b.st[1];
        if (nloc == 0u) { xcd_barrier_complete(bar, b.x, nloc, nx); b.st[0] = nloc; b.st[1] = nx; }
        const unsigned old = xb_add(&bar[XB_XSUB(b.x)], 1u);
        const unsigned gen = old / nloc;
        if (old + 1u == (gen + 1u) * nloc) {
            __builtin_amdgcn_fence(__ATOMIC_RELEASE, "agent");
            asm volatile("s_waitcnt vmcnt(0)" ::: "memory");
            const unsigned og = xb_add(&bar[XB_TOP], 1u);
            const unsigned tg = og / nx;
            if (og + 1u == (tg + 1u) * nx) xb_add(&bar[XB_TOPGEN], 1u);
            else XB_SPIN(xb_ld(&bar[XB_TOPGEN]) == tg, bar);
            __builtin_amdgcn_fence(__ATOMIC_ACQUIRE, "agent");
            xb_add(&bar[XB_XGEN(b.x)], 1u);
            asm volatile("s_waitcnt vmcnt(0)" ::: "memory");
        } else {
            XB_SPIN(xb_ld(&bar[XB_XGEN(b.x)]) == gen, bar);
            __builtin_amdgcn_fence(__ATOMIC_ACQUIRE, "agent");
            asm volatile("s_waitcnt vmcnt(0)" ::: "memory");
        }
    }
    __syncthreads();
}

__global__ void __launch_bounds__(NTHREADS) fwd_megakernel(Params P) {
    __shared__ __attribute__((aligned(16))) unsigned char lds_raw[131072 + 4096];
    const ldsp lds = (ldsp)lds_raw;
    cg::grid_group grid = cg::this_grid();
    volatile LAS unsigned* xbst = (volatile LAS unsigned*)(lds + 131072);
    if (threadIdx.x == 0) { xbst[0] = 0u; xbst[1] = 0u; }
    __syncthreads();
    const XcdBarrier xbar = xcd_barrier_post((unsigned*)(P.ws + OFF_BAR), xbst);
#define GBAR() xcd_barrier(xbar)
#define ROW_HANDOFF() do { __builtin_amdgcn_fence(__ATOMIC_RELEASE, "workgroup"); asm volatile("s_waitcnt vmcnt(0)" ::: "memory"); __builtin_amdgcn_fence(__ATOMIC_ACQUIRE, "workgroup"); } while (0)
    const float* modv = (const float*)(P.ws + OFF_MODV);
    bf16_t* Abuf = (bf16_t*)(P.ws + OFF_A);

#define RUN(rep, ...) for (int rep_i = 0; rep_i < (rep); ++rep_i) { __VA_ARGS__; GBAR(); }
    for (int rep_i = 0; rep_i < REP_PREP; ++rep_i) { phase_prep(P, lds); grid.sync(); }
    RUN(REP_MOD, phase_modulate<0>(P, 0, 0, NT))
    RUN(REP_POOL, phase_pool(P, lds))
    RUN(REP_MOD, phase_modulate<1>(P, 0, 1, NT, true))
    RUN(REP_GEMM, { pg8::Gemm g{Abuf, (const bf16_t*)(P.ws + OFF_WQT), NT, 2048, 1024}; pg8::StaticOrder S; S.init(NT, 2048, gridDim.x, blockIdx.x); pg8::EpiQ e{(bf16_t*)(P.ws + OFF_R1), 2048}; pg8::gemm_phase<pg8::EpiQ, pg8::StaticOrder, true, true>(lds, g, S, e); })
    RUN(REP_TOPK, phase_topk(P, 0, NT, lds))
    phase_experts(P, 0, NT, lds);
    ROW_HANDOFF();
    RUN(REP_MOD, phase_modulate<1>(P, 1, 0, NT))
    RUN(REP_GEMM, { pg8::Gemm g{Abuf, (const bf16_t*)(P.ws + OFF_WINT), NT, 4352, 1024}; pg8::StaticOrder S; S.init(NT, 4352, gridDim.x, blockIdx.x);
      pg8::EpiWinP e{(bf16_t*)(P.ws + OFF_R1), (bf16_t*)(P.ws + OFF_PZ), (float*)(P.ws + OFF_AB)}; pg8::gemm_phase<pg8::EpiWinP, pg8::StaticOrder, true, true>(lds, g, S, e); })
    RUN(REP_CONV, phase_conv(P))
    RUN(REP_CHUNK, phase_chunk(P, lds))
    RUN(REP_SCAN, phase_scan(P, lds))
    RUN(REP_DNOUT, phase_dnout(P))
    { pg8::Gemm g{Abuf, (const bf16_t*)(P.ws + OFF_WOUTT), NX, 1024, 1024}; pg8::StaticOrder S; S.init(NX, 1024, gridDim.x, blockIdx.x); pg8::EpiRes e{(bf16_t*)(P.ws + OFF_H), modv + 9 * 6144 + 2048}; pg8::gemm_phase<pg8::EpiRes, pg8::StaticOrder, false, true>(lds, g, S, e); }
    GBAR();
    RUN(REP_MOD, phase_modulate<1>(P, 1, 1, NX, true))
    RUN(REP_GEMM, { pg8::Gemm g{Abuf, (const bf16_t*)(P.ws + OFF_WQT) + (size_t)2048 * 1024, NX, 2048, 1024}; pg8::StaticOrder S; S.init(NX, 2048, gridDim.x, blockIdx.x); pg8::EpiQ e{(bf16_t*)(P.ws + OFF_R1), 2048}; pg8::gemm_phase<pg8::EpiQ, pg8::StaticOrder, true, true>(lds, g, S, e); })
    RUN(REP_TOPK, phase_topk(P, 1, NX, lds))
    phase_experts(P, 1, NX, lds);
    ROW_HANDOFF();
    phase_final(P);
}

extern "C" void kernel_launch(void* const* d_in, const int* in_sizes, int n_in, void* d_out, int out_size, void* d_ws, size_t ws_size, hipStream_t stream) {
    static int grid_blocks = 0;
    if (grid_blocks == 0) {
        if (n_in != 21 || out_size != NX * D || ws_size < WS_END) {
            fprintf(stderr, "kernel_launch: unexpected shapes: n_in %d out %d ws %zu (need %zu)\n", n_in, out_size, ws_size, (size_t)WS_END);
            grid_blocks = -1; return;
        }
        int dev = 0, cus = 0, per_cu = 0;
        hipGetDevice(&dev);
        hipDeviceGetAttribute(&cus, hipDeviceAttributeMultiprocessorCount, dev);
        hipOccupancyMaxActiveBlocksPerMultiprocessor(&per_cu, fwd_megakernel, NTHREADS, 0);
        if (per_cu < 1) { fprintf(stderr, "kernel_launch: occupancy query reports %d blocks per CU\n", per_cu); grid_blocks = -1; return; }
        grid_blocks = cus;
    }
    if (grid_blocks < 0) return;
    if (hipMemsetAsync((char*)d_ws + OFF_BAR, 0, XCD_BAR_WORDS * 4, stream) != hipSuccess) { fprintf(stderr, "kernel_launch: memset of barrier words failed\n"); return; }
    Params p{};
    const float** pp = (const float**)&p;
    for (int i = 0; i < 21; ++i) pp[i] = (const float*)d_in[i];
    p.out = (float*)d_out; p.ws = (unsigned char*)d_ws;
    void* args[] = {&p};
    hipError_t e = hipLaunchCooperativeKernel((void*)fwd_megakernel, dim3(grid_blocks), dim3(NTHREADS), args, 0, stream);
    if (e != hipSuccess) fprintf(stderr, "cooperative launch failed: %s (grid %d)\n", hipGetErrorString(e), grid_blocks);
}
```
